# Optimizing an MI355X kernel written in HIP

```python
import math
import jax
import jax.numpy as jnp
from jax import lax
import numpy as np

D_MODEL = 1024
BATCH = 4
SEQ = 4096
DEPTH = 2

GRID_W = 64
CTX_LEN = 256
EPS = 1e-6
N_MOD = 6
F32 = jnp.float32

SSD_HEADS = 8
SSD_HEAD_DIM = 64
SSD_INNER = SSD_HEADS * SSD_HEAD_DIM
SSD_GROUPS = 2
SSD_STATE = 64
SSD_CONV_W = 3
SSD_CHUNK = 128
SSD_CONV_DIM = SSD_INNER + 2 * SSD_GROUPS * SSD_STATE

DIFF_HEADS = 4
DIFF_QK_DIM = 32
DIFF_V_DIM = 2 * DIFF_QK_DIM
DIFF_INNER = DIFF_HEADS * DIFF_V_DIM

MLA_HEADS = 4
MLA_Q_LORA = 192
MLA_KV_LORA = 128
MLA_NOPE = 64
MLA_ROPE = 32
MLA_V = 64
MLA_INNER = MLA_HEADS * MLA_V

MIX_WIDTH = SSD_INNER + DIFF_INNER + MLA_INNER

SSD_COLS = 2 * SSD_INNER + 2 * SSD_GROUPS * SSD_STATE + 2 * SSD_HEADS
DIFF_COLS = 3 * DIFF_HEADS * DIFF_V_DIM
MLA_COLS = MLA_Q_LORA + MLA_KV_LORA + MLA_ROPE
IN_COLS = SSD_COLS + DIFF_COLS + MLA_COLS

N_EXPERTS = 16
EC_CAPACITY = 2
EXPERT_FF = 1024

ROPE_BASE = 10000.0
Q_BLOCK = 128

kernel_name = 'hybrid_ssd_diffattn_mla_ecmoe_dit'


def rmsnorm(x, w):
    xf = x.astype(F32)
    y = xf * lax.rsqrt(jnp.mean(xf * xf, axis=-1, keepdims=True) + EPS)
    return (y * w.astype(F32)).astype(x.dtype)


def modulate(x, shift, scale):
    return x * (1 + scale) + shift


def rope_2d(x, rows, cols):
    half = x.shape[-1] // 2
    quarter = half // 2
    inv = ROPE_BASE ** (-jnp.arange(quarter, dtype=F32) / quarter)

    def rot(xh, pos):
        ang = pos[:, None] * inv[None, :]
        cos = jnp.cos(ang)[None, :, None, :].astype(x.dtype)
        sin = jnp.sin(ang)[None, :, None, :].astype(x.dtype)
        x1, x2 = xh[..., :quarter], xh[..., quarter:]
        return jnp.concatenate([x1 * cos - x2 * sin, x1 * sin + x2 * cos], axis=-1)

    return jnp.concatenate([rot(x[..., :half], rows), rot(x[..., half:], cols)], axis=-1)


def over_query_blocks(fn, *qs):
    b, s = qs[0].shape[:2]
    nb = s // Q_BLOCK
    blocks = tuple(jnp.moveaxis(q.reshape((b, nb, Q_BLOCK) + q.shape[2:]), 1, 0) for q in qs)
    out = lax.map(lambda blk: fn(*blk), blocks)
    out = jnp.moveaxis(out, 0, 1)
    return out.reshape((b, s) + out.shape[3:])


def softmax_attend(q, k, v, scale):
    s = jnp.einsum('bqhd,bkhd->bhqk', q, k).astype(F32) * scale
    p = jax.nn.softmax(s, axis=-1)
    return jnp.einsum('bhqk,bkhd->bqhd', p.astype(v.dtype), v)


def centred_dwconv(u, w, b):
    k = w.shape[0]
    out = lax.conv_general_dilated(u, w[:, None, :].astype(u.dtype), window_strides=(1,),
                                   padding=[((k - 1) // 2, (k - 1) // 2)],
                                   dimension_numbers=('NWC', 'WIO', 'NWC'),
                                   feature_group_count=u.shape[-1])
    return out + b


def ssd_scan(xs, dt, a, bm, cm, h0, with_output):
    b, L, H, P = xs.shape
    G, N = bm.shape[2], bm.shape[3]
    rep = H // G
    Q = SSD_CHUNK
    nc = L // Q
    bh = jnp.repeat(bm, rep, axis=2).reshape(b, nc, Q, H, N)
    ch = jnp.repeat(cm, rep, axis=2).reshape(b, nc, Q, H, N)
    xdt = (xs * dt[..., None]).reshape(b, nc, Q, H, P)
    acum = jnp.cumsum((dt * a).reshape(b, nc, Q, H), axis=2)
    a_last = acum[:, :, -1]
    states = jnp.einsum('bcqhn,bcqh,bcqhp->bchpn', bh, jnp.exp(a_last[:, :, None] - acum), xdt)

    def step(h, inp):
        s, al = inp
        return jnp.exp(al)[..., None, None] * h + s, h

    h_final, h_prev = lax.scan(step, h0, (jnp.moveaxis(states, 1, 0), jnp.moveaxis(a_last, 1, 0)))
    if not with_output:
        return None, h_final
    h_prev = jnp.moveaxis(h_prev, 0, 1)
    seg = acum[:, :, :, None, :] - acum[:, :, None, :, :]
    lower = jnp.tril(jnp.ones((Q, Q), bool))[None, None, :, :, None]
    decay = jnp.exp(jnp.where(lower, seg, -jnp.inf))
    cb = jnp.einsum('bcihn,bcjhn->bcijh', ch, bh)
    y_diag = jnp.einsum('bcijh,bcjhp->bcihp', cb * decay, xdt)
    y_off = jnp.einsum('bcihn,bchpn->bcihp', ch * jnp.exp(acum)[..., None], h_prev)
    return (y_diag + y_off).reshape(b, L, H, P), h_final


def ssd_mixer(p_ctx, p_lat, conv_w, conv_b, a_log, dt_bias, d_skip, norm_w, ctx_out):
    def prep(p):
        b, L, _ = p.shape
        z, xbc, dt = jnp.split(p, [SSD_INNER, SSD_INNER + SSD_CONV_DIM], axis=-1)
        xbc = jax.nn.silu(centred_dwconv(xbc, conv_w, conv_b))
        xs, bm, cm = jnp.split(xbc, [SSD_INNER, SSD_INNER + SSD_GROUPS * SSD_STATE], axis=-1)
        xs = xs.reshape(b, L, SSD_HEADS, SSD_HEAD_DIM).astype(F32)
        bm = bm.reshape(b, L, SSD_GROUPS, SSD_STATE).astype(F32)
        cm = cm.reshape(b, L, SSD_GROUPS, SSD_STATE).astype(F32)
        dt = dt.reshape(b, L, 2, SSD_HEADS).astype(F32)
        return z, xs, bm, cm, dt

    zc, xc, bc, cc, dtc = prep(p_ctx)
    zl, xl, bl, cl, dtl = prep(p_lat)
    b = p_lat.shape[0]
    dsk = d_skip.astype(F32)[:, None]
    y_lat = dsk * xl
    y_ctx = dsk * xc if ctx_out else None
    for direction in range(2):
        a = -jnp.exp(a_log[direction].astype(F32))
        bias = dt_bias[direction].astype(F32)
        flip = (lambda t: jnp.flip(t, axis=1)) if direction == 1 else (lambda t: t)
        h0 = jnp.zeros((b, SSD_HEADS, SSD_HEAD_DIM, SSD_STATE), F32)
        yc, hc = ssd_scan(flip(xc), jax.nn.softplus(flip(dtc[:, :, direction]) + bias), a,
                          flip(bc), flip(cc), h0, ctx_out)
        yl, _ = ssd_scan(flip(xl), jax.nn.softplus(flip(dtl[:, :, direction]) + bias), a,
                         flip(bl), flip(cl), hc, True)
        y_lat = y_lat + flip(yl)
        if ctx_out:
            y_ctx = y_ctx + flip(yc)

    def gate_norm(y, z):
        bb, L = y.shape[:2]
        g = y.reshape(bb, L, SSD_INNER).astype(z.dtype) * jax.nn.silu(z)
        g = g.reshape(bb, L, SSD_GROUPS, SSD_INNER // SSD_GROUPS)
        return rmsnorm(g, norm_w.reshape(SSD_GROUPS, SSD_INNER // SSD_GROUPS)).reshape(bb, L, SSD_INNER)

    out_l = gate_norm(y_lat, zl)
    out_c = gate_norm(y_ctx, zc) if ctx_out else None
    return out_l, out_c


def diff_attn_mixer(p_ctx, p_lat, lam_q1, lam_k1, lam_q2, lam_k2, subln_w, lambda_init, rows, cols, ctx_out):
    lam = (jnp.exp(jnp.sum(lam_q1.astype(F32) * lam_k1.astype(F32)))
           - jnp.exp(jnp.sum(lam_q2.astype(F32) * lam_k2.astype(F32))) + lambda_init)
    scale = DIFF_QK_DIM ** -0.5

    def split(p):
        b, L, _ = p.shape
        q, k, v = jnp.split(p, 3, axis=-1)
        q = q.reshape(b, L, DIFF_HEADS, 2, DIFF_QK_DIM)
        k = k.reshape(b, L, DIFF_HEADS, 2, DIFF_QK_DIM)
        v = v.reshape(b, L, DIFF_HEADS, DIFF_V_DIM)
        return q[..., 0, :], q[..., 1, :], k[..., 0, :], k[..., 1, :], v

    def diff_attend(q1, q2, k1, k2, v):
        s1 = jnp.einsum('bqhd,bkhd->bhqk', q1, k1).astype(F32) * scale
        s2 = jnp.einsum('bqhd,bkhd->bhqk', q2, k2).astype(F32) * scale
        amap = jax.nn.softmax(s1, axis=-1) - lam * jax.nn.softmax(s2, axis=-1)
        o = jnp.einsum('bhqk,bkhd->bqhd', amap.astype(v.dtype), v)
        return rmsnorm(o, subln_w) * (1.0 - lambda_init)

    q1c, q2c, k1c, k2c, vc = split(p_ctx)
    q1l, q2l, k1l, k2l, vl = split(p_lat)
    rp = lambda t: rope_2d(t, rows, cols)
    k1 = jnp.concatenate([k1c, rp(k1l)], axis=1)
    k2 = jnp.concatenate([k2c, rp(k2l)], axis=1)
    v = jnp.concatenate([vc, vl], axis=1)
    b, L = p_lat.shape[:2]
    out_l = over_query_blocks(lambda a1, a2: diff_attend(a1, a2, k1, k2, v), rp(q1l), rp(q2l))
    out_l = out_l.reshape(b, L, DIFF_INNER)
    out_c = None
    if ctx_out:
        out_c = diff_attend(q1c, q2c, k1c, k2c, vc).reshape(b, p_ctx.shape[1], DIFF_INNER)
    return out_l, out_c


def mla_mixer(p_ctx, p_lat, q_norm_w, w_q_up, kv_norm_w, w_kv_up, rows, cols, ctx_out):
    scale = (MLA_NOPE + MLA_ROPE) ** -0.5

    def project(p):
        b, L, _ = p.shape
        cq, ckv, k_rope = jnp.split(p, [MLA_Q_LORA, MLA_Q_LORA + MLA_KV_LORA], axis=-1)
        q = (rmsnorm(cq, q_norm_w) @ w_q_up).reshape(b, L, MLA_HEADS, MLA_NOPE + MLA_ROPE)
        kv = (rmsnorm(ckv, kv_norm_w) @ w_kv_up).reshape(b, L, MLA_HEADS, MLA_NOPE + MLA_V)
        return q[..., :MLA_NOPE], q[..., MLA_NOPE:], kv[..., :MLA_NOPE], k_rope[:, :, None, :], kv[..., MLA_NOPE:]

    def join_keys(k_nope, k_rope):
        return jnp.concatenate([k_nope, jnp.broadcast_to(k_rope, k_nope.shape[:-1] + (MLA_ROPE,))], axis=-1)

    qn_c, qr_c, kn_c, kr_c, v_c = project(p_ctx)
    qn_l, qr_l, kn_l, kr_l, v_l = project(p_lat)
    k_c = join_keys(kn_c, kr_c)
    k_all = jnp.concatenate([k_c, join_keys(kn_l, rope_2d(kr_l, rows, cols))], axis=1)
    v_all = jnp.concatenate([v_c, v_l], axis=1)
    q_l = jnp.concatenate([qn_l, rope_2d(qr_l, rows, cols)], axis=-1)
    b, L = p_lat.shape[:2]
    out_l = over_query_blocks(lambda qb: softmax_attend(qb, k_all, v_all, scale), q_l).reshape(b, L, MLA_INNER)
    out_c = None
    if ctx_out:
        q_c = jnp.concatenate([qn_c, qr_c], axis=-1)
        out_c = softmax_attend(q_c, k_c, v_c, scale).reshape(b, p_ctx.shape[1], MLA_INNER)
    return out_l, out_c


def mix_heads(h_ctx, h_lat, w_in, w_out, conv_w, conv_b, a_log, dt_bias, d_skip, ssd_norm_w,
              lam_q1, lam_k1, lam_q2, lam_k2, subln_w, q_norm_w, w_q_up, kv_norm_w, w_kv_up,
              rows, cols, lambda_init, ctx_out):
    cuts = [SSD_COLS, SSD_COLS + DIFF_COLS]
    ssd_c, diff_c, mla_c = jnp.split(h_ctx @ w_in, cuts, axis=-1)
    ssd_l, diff_l, mla_l = jnp.split(h_lat @ w_in, cuts, axis=-1)
    s_l, s_c = ssd_mixer(ssd_c, ssd_l, conv_w, conv_b, a_log, dt_bias, d_skip, ssd_norm_w, ctx_out)
    d_l, d_c = diff_attn_mixer(diff_c, diff_l, lam_q1, lam_k1, lam_q2, lam_k2, subln_w, lambda_init, rows, cols, ctx_out)
    a_l, a_c = mla_mixer(mla_c, mla_l, q_norm_w, w_q_up, kv_norm_w, w_kv_up, rows, cols, ctx_out)
    out_l = jnp.concatenate([s_l, d_l, a_l], axis=-1) @ w_out
    out_c = jnp.concatenate([s_c, d_c, a_c], axis=-1) @ w_out if ctx_out else None
    return out_l, out_c


def expert_choice_ffn(h, router_w, router_b, w_gate, w_up, w_down):
    b, n, d = h.shape
    cap = EC_CAPACITY * n // N_EXPERTS
    affinity = jax.nn.softmax((h @ router_w + router_b).astype(F32), axis=-1)
    gates, idx = lax.top_k(jnp.swapaxes(affinity, 1, 2), cap)
    xg = jax.vmap(lambda hb, ib: hb[ib])(h, idx)
    hid = jax.nn.silu(jnp.einsum('becd,edf->becf', xg, w_gate)) * jnp.einsum('becd,edf->becf', xg, w_up)
    y = jnp.einsum('becf,efd->becd', hid, w_down) * gates[..., None].astype(h.dtype)
    scatter = lambda yb, ib: jnp.zeros((n, d), h.dtype).at[ib.reshape(-1)].add(yb.reshape(-1, d))
    return jax.vmap(scatter)(y, idx)


def setup_inputs(seed: int = 0) -> dict:
    key = jax.random.key(seed)
    ks = iter(jax.random.split(key, 48))
    D = D_MODEL

    def nrm(shape, s):
        return jax.random.normal(next(ks), shape, F32) * s

    def gain(shape):
        return 1.0 + nrm(shape, 0.02)

    dt0 = jnp.exp(jax.random.uniform(next(ks), (DEPTH, 2, SSD_HEADS), F32,
                                     minval=math.log(1e-3), maxval=math.log(1e-1)))
    dt_bias = dt0 + jnp.log(-jnp.expm1(-dt0))
    a_log = jnp.log(jax.random.uniform(next(ks), (DEPTH, 2, SSD_HEADS), F32, minval=1.0, maxval=16.0))
    return {
        'x': nrm((BATCH, SEQ, D), 1.0),
        'c': nrm((BATCH, D), 1.0),
        'ctx': nrm((BATCH, CTX_LEN, D), 1.0),
        'c_ctx': nrm((D,), 1.0),
        'ada_w': nrm((DEPTH, D, N_MOD * D), 0.5 * D ** -0.5),
        'ada_b': nrm((DEPTH, N_MOD * D), 0.02),
        'norm_mix_pre': gain((DEPTH, D)),
        'norm_mix_post': gain((DEPTH, D)),
        'norm_ffn_pre': gain((DEPTH, D)),
        'norm_ffn_post': gain((DEPTH, D)),
        'w_in': nrm((DEPTH, D, IN_COLS), D ** -0.5),
        'ssd_conv_w': nrm((DEPTH, SSD_CONV_W, SSD_CONV_DIM), SSD_CONV_W ** -0.5),
        'ssd_conv_b': nrm((DEPTH, SSD_CONV_DIM), 0.02),
        'ssd_a_log': a_log,
        'ssd_dt_bias': dt_bias,
        'ssd_d': gain((DEPTH, SSD_HEADS)),
        'ssd_norm': gain((DEPTH, SSD_INNER)),
        'diff_lam_q1': nrm((DEPTH, DIFF_QK_DIM), 0.1),
        'diff_lam_k1': nrm((DEPTH, DIFF_QK_DIM), 0.1),
        'diff_lam_q2': nrm((DEPTH, DIFF_QK_DIM), 0.1),
        'diff_lam_k2': nrm((DEPTH, DIFF_QK_DIM), 0.1),
        'diff_subln': gain((DEPTH, DIFF_V_DIM)),
        'mla_q_norm': gain((DEPTH, MLA_Q_LORA)),
        'mla_w_q_up': nrm((DEPTH, MLA_Q_LORA, MLA_HEADS * (MLA_NOPE + MLA_ROPE)), MLA_Q_LORA ** -0.5),
        'mla_kv_norm': gain((DEPTH, MLA_KV_LORA)),
        'mla_w_kv_up': nrm((DEPTH, MLA_KV_LORA, MLA_HEADS * (MLA_NOPE + MLA_V)), MLA_KV_LORA ** -0.5),
        'w_out': nrm((DEPTH, MIX_WIDTH, D), MIX_WIDTH ** -0.5),
        'router_w': nrm((DEPTH, D, N_EXPERTS), D ** -0.5),
        'router_b': nrm((DEPTH, N_EXPERTS), 0.01),
        'w_gate': nrm((DEPTH, N_EXPERTS, D, EXPERT_FF), D ** -0.5),
        'w_up': nrm((DEPTH, N_EXPERTS, D, EXPERT_FF), D ** -0.5),
        'w_down': nrm((DEPTH, N_EXPERTS, EXPERT_FF, D), EXPERT_FF ** -0.5),
    }


def reference(x, c, ctx, c_ctx, ada_w, ada_b, norm_mix_pre, norm_mix_post, norm_ffn_pre, norm_ffn_post,
              w_in, ssd_conv_w, ssd_conv_b, ssd_a_log, ssd_dt_bias, ssd_d, ssd_norm,
              diff_lam_q1, diff_lam_k1, diff_lam_q2, diff_lam_k2, diff_subln,
              mla_q_norm, mla_w_q_up, mla_kv_norm, mla_w_kv_up, w_out,
              router_w, router_b, w_gate, w_up, w_down):
    n_rows = x.shape[1] // GRID_W
    rows = jnp.repeat(jnp.arange(n_rows, dtype=F32), GRID_W)
    cols = jnp.tile(jnp.arange(GRID_W, dtype=F32), n_rows)
    silu_c = jax.nn.silu(c)
    silu_cc = jax.nn.silu(c_ctx)
    for l in range(DEPTH):
        ctx_out = l < DEPTH - 1
        lambda_init = 0.8 - 0.6 * math.exp(-0.3 * l)
        mod_l = jnp.split((silu_c @ ada_w[l] + ada_b[l])[:, None, :], N_MOD, axis=-1)
        mod_c = jnp.split(silu_cc @ ada_w[l] + ada_b[l], N_MOD, axis=-1)
        h_l = modulate(rmsnorm(x, norm_mix_pre[l]), mod_l[0], mod_l[1])
        h_c = modulate(rmsnorm(ctx, norm_mix_pre[l]), mod_c[0], mod_c[1])
        m_l, m_c = mix_heads(h_c, h_l, w_in[l], w_out[l], ssd_conv_w[l], ssd_conv_b[l], ssd_a_log[l],
                             ssd_dt_bias[l], ssd_d[l], ssd_norm[l], diff_lam_q1[l], diff_lam_k1[l],
                             diff_lam_q2[l], diff_lam_k2[l], diff_subln[l], mla_q_norm[l], mla_w_q_up[l],
                             mla_kv_norm[l], mla_w_kv_up[l], rows, cols, lambda_init, ctx_out)
        x = x + mod_l[2] * rmsnorm(m_l, norm_mix_post[l])
        if ctx_out:
            ctx = ctx + mod_c[2] * rmsnorm(m_c, norm_mix_post[l])
        f_l = expert_choice_ffn(modulate(rmsnorm(x, norm_ffn_pre[l]), mod_l[3], mod_l[4]),
                                router_w[l], router_b[l], w_gate[l], w_up[l], w_down[l])
        x = x + mod_l[5] * rmsnorm(f_l, norm_ffn_post[l])
        if ctx_out:
            f_c = expert_choice_ffn(modulate(rmsnorm(ctx, norm_ffn_pre[l]), mod_c[3], mod_c[4]),
                                    router_w[l], router_b[l], w_gate[l], w_up[l], w_down[l])
            ctx = ctx + mod_c[5] * rmsnorm(f_c, norm_ffn_post[l])
    return x
```

```cpp
#ifdef HOST_EMU
#include <cmath>
#include <cstdio>
#include <cstdlib>
#include <cstring>
#define HD inline
#define SCHED_FENCE()
#else
#include <hip/hip_runtime.h>
#include <cstdio>
#define HD __device__ __forceinline__
#define SCHED_FENCE() __builtin_amdgcn_sched_barrier(0)
#endif

#ifndef CFG_D
#define CFG_D 1024
#define CFG_B 4
#define CFG_S 4096
#define CFG_CTX 256
#define CFG_FF 1024
#endif
constexpr int D = CFG_D, NB = CFG_B, S = CFG_S, CTX = CFG_CTX, FF = CFG_FF;
constexpr int DEPTH = 2, GRID_W = 64, NMOD = 6, NE = 16;
constexpr int NLAT = NB * S, NCTX = NB * CTX, NTOK = NLAT + NCTX;
constexpr int IN_COLS = 2416;
constexpr int C_Z = 0, C_XBC = 512, C_DT = 1280, C_DQ = 1296, C_DK = 1552, C_DV = 1808, C_CQ = 2064, C_CKV = 2256, C_KR = 2384;
constexpr int MIXW = 1024;
constexpr int CAP_L = 2 * S / NE, CAP_C = 2 * CTX / NE;
constexpr int EROWS = NB * (CAP_L + CAP_C);
constexpr float EPS = 1e-6f;

enum { I_X = 0, I_C, I_CTX, I_CCTX, I_ADAW, I_ADAB, I_NMPRE, I_NMPOST, I_NFPRE, I_NFPOST, I_WIN, I_CONVW, I_CONVB, I_ALOG, I_DTB, I_SSDD, I_SSDN,
       I_LQ1, I_LK1, I_LQ2, I_LK2, I_SUBLN, I_QNORM, I_WQUP, I_KVNORM, I_WKVUP, I_WOUT, I_RW, I_RB, I_WG, I_WU, I_WD, N_IN };

struct Prm { const float* in[N_IN]; float* out; char* ws; };

constexpr size_t al256(size_t x) { return (x + 255) & ~(size_t)255; }
constexpr size_t WS_CTL = 0;
constexpr size_t CTL_BYTES = 65536;
constexpr size_t WS_MOD = WS_CTL + CTL_BYTES;
constexpr size_t WS_CTXC = al256(WS_MOD + (size_t)DEPTH * (NB + 1) * NMOD * D * 4);
constexpr size_t WS_AFF = al256(WS_CTXC + (size_t)NCTX * D * 4);
constexpr size_t WS_TOKSLOT = al256(WS_AFF + (size_t)NTOK * NE * 4);
constexpr size_t WS_SELIDX = al256(WS_TOKSLOT + (size_t)NTOK * NE * 4);
constexpr size_t WS_SELGATE = al256(WS_SELIDX + (size_t)NE * EROWS * 4);
constexpr size_t WS_DT = al256(WS_SELGATE + (size_t)NE * EROWS * 4);
constexpr size_t WS_H = al256(WS_DT + (size_t)NTOK * 16 * 4);
constexpr size_t WS_P = al256(WS_H + (size_t)NTOK * D * 4);
constexpr size_t WS_G2 = al256(WS_P + (size_t)NTOK * IN_COLS * 4);
constexpr size_t WS_XBC = WS_G2;
constexpr size_t WS_MQ = al256(WS_XBC + (size_t)NTOK * 768 * 4);
constexpr size_t WS_MKV = al256(WS_MQ + (size_t)NTOK * 384 * 4);
constexpr size_t WS_MIX = al256(WS_MKV + (size_t)NTOK * 512 * 4);
constexpr size_t WS_G2END = al256(WS_MIX + (size_t)NTOK * MIXW * 4);
constexpr size_t WS_MOUT = WS_P;
constexpr size_t WS_HID = WS_P;
constexpr size_t WS_Y = WS_G2;
constexpr size_t WS_END = WS_G2END;
static_assert((size_t)NE * EROWS * FF * 4 <= WS_G2 - WS_P, "HID fits in P region");
static_assert((size_t)NE * EROWS * D * 4 <= WS_G2END - WS_G2, "Y fits in G2 region");

struct GemmDesc {
    const float* A; int lda; const int* aidx; const float* B; const float* B2; int ldb;
    float* C; int ldc; int M, N, K; int mode; const float* rowscale;
};
enum { EPI_STORE = 0, EPI_SWIGLU = 1, EPI_ROWSCALE = 2 };

HD float siluf(float x) { return x / (1.0f + expf(-x)); }
HD float softplusf(float x) { return x > 20.f ? x : log1pf(expf(x)); }

HD void rope32(float* v, int t) {
    const float prow = (float)(t / GRID_W), pcol = (float)(t % GRID_W);
#pragma unroll
    for (int i = 0; i < 8; ++i) {
        const float inv = powf(10000.0f, -(float)i / 8.0f);
        { const float ang = prow * inv, c = cosf(ang), s = sinf(ang); const float x1 = v[i], x2 = v[8 + i]; v[i] = x1 * c - x2 * s; v[8 + i] = x1 * s + x2 * c; }
        { const float ang = pcol * inv, c = cosf(ang), s = sinf(ang); const float x1 = v[16 + i], x2 = v[24 + i]; v[16 + i] = x1 * c - x2 * s; v[24 + i] = x1 * s + x2 * c; }
    }
}

HD int tok_row(bool lat, int b, int t) { return lat ? b * S + t : NLAT + b * CTX + t; }

template <class RT>
HD void forward(RT& rt, const Prm& p) {
    float* const xcur = p.out;
    float* const MOD = (float*)(p.ws + WS_MOD);
    float* const CTXC = (float*)(p.ws + WS_CTXC);
    float* const AFF = (float*)(p.ws + WS_AFF);
    int* const TOKSLOT = (int*)(p.ws + WS_TOKSLOT);
    int* const SELIDX = (int*)(p.ws + WS_SELIDX);
    float* const SELGATE = (float*)(p.ws + WS_SELGATE);
    float* const DT = (float*)(p.ws + WS_DT);
    float* const H = (float*)(p.ws + WS_H);
    float* const PB = (float*)(p.ws + WS_P);
    float* const XBC = (float*)(p.ws + WS_XBC);
    float* const DTMP = XBC;
    float* const MQ = (float*)(p.ws + WS_MQ);
    float* const MKV = (float*)(p.ws + WS_MKV);
    float* const MIX = (float*)(p.ws + WS_MIX);
    float* const MOUT = (float*)(p.ws + WS_MOUT);
    float* const HID = (float*)(p.ws + WS_HID);
    float* const Y = (float*)(p.ws + WS_Y);

    {
        const float* c = p.in[I_C]; const float* cc = p.in[I_CCTX]; const float* adaw = p.in[I_ADAW]; const float* adab = p.in[I_ADAB];
        rt.items(DEPTH * (NB + 1) * NMOD * D, [=](int i) {
            const int j = i % (NMOD * D), r = (i / (NMOD * D)) % (NB + 1), l = i / ((NB + 1) * NMOD * D);
            const float* src = r < NB ? c + (size_t)r * D : cc;
            const float* w = adaw + (size_t)l * D * NMOD * D + j;
            float acc = adab[l * NMOD * D + j];
            for (int k = 0; k < D; ++k) acc += siluf(src[k]) * w[(size_t)k * NMOD * D];
            MOD[i] = acc;
        });
        const float* x = p.in[I_X]; const float* ctx = p.in[I_CTX];
        rt.items(NLAT * D, [=](int i) { xcur[i] = x[i]; });
        rt.items(NCTX * D, [=](int i) { CTXC[i] = ctx[i]; });
    }
    rt.sync();

    for (int l = 0; l < DEPTH; ++l) {
        const bool ctx_out = l < DEPTH - 1;
        const float lambda_init = 0.8f - 0.6f * expf(-0.3f * (float)l);
        const int nrows_out = ctx_out ? NTOK : NLAT;
        const float* modl = MOD + (size_t)l * (NB + 1) * NMOD * D;

        {
            const float* w = p.in[I_NMPRE] + l * D;
            rt.items(NTOK, [=](int r) {
                const float* src = r < NLAT ? xcur + (size_t)r * D : CTXC + (size_t)(r - NLAT) * D;
                const float* md = modl + (size_t)(r < NLAT ? r / S : NB) * NMOD * D;
                float ss = 0.f;
                for (int k = 0; k < D; ++k) ss += src[k] * src[k];
                const float rs = 1.0f / sqrtf(ss / D + EPS);
                float* dst = H + (size_t)r * D;
                for (int k = 0; k < D; ++k) dst[k] = src[k] * rs * w[k] * (1.0f + md[D + k]) + md[k];
            });
        }
        rt.sync();
        {
            const float* win = p.in[I_WIN] + (size_t)l * D * IN_COLS;
            rt.gemm_batch(1, [=](int) { GemmDesc g{H, D, nullptr, win, nullptr, IN_COLS, PB, IN_COLS, NTOK, IN_COLS, D, EPI_STORE, nullptr}; return g; });
        }
        rt.sync();
        {
            const float* cw = p.in[I_CONVW] + (size_t)l * 3 * 768; const float* cb = p.in[I_CONVB] + (size_t)l * 768;
            rt.items(NTOK * 768, [=](int i) {
                const int c = i % 768, r = i / 768;
                const bool lat = r < NLAT; const int L = lat ? S : CTX; const int t = lat ? r % S : (r - NLAT) % CTX;
                const float* u = PB + (size_t)r * IN_COLS + C_XBC + c;
                float acc = cb[c] + cw[768 + c] * u[0];
                if (t > 0) acc += cw[c] * u[-IN_COLS];
                if (t < L - 1) acc += cw[2 * 768 + c] * u[IN_COLS];
                XBC[i] = siluf(acc);
            });
            const float* dtb = p.in[I_DTB] + l * 16;
            rt.items(NTOK * 16, [=](int i) { const int j = i % 16, r = i / 16; DT[i] = softplusf(PB[(size_t)r * IN_COLS + C_DT + j] + dtb[j]); });
            rt.items(NLAT * 17, [=](int i) {
                const int g = i % 17, r = i / 17, t = r % S;
                float* v = PB + (size_t)r * IN_COLS + (g < 16 ? C_DQ + g * 32 : C_KR);
                rope32(v, t);
            });
            const float* qn = p.in[I_QNORM] + l * 192; const float* kvn = p.in[I_KVNORM] + l * 128;
            rt.items(NTOK * 2, [=](int i) {
                const int which = i & 1, r = i >> 1; const int n = which ? 128 : 192;
                float* v = PB + (size_t)r * IN_COLS + (which ? C_CKV : C_CQ); const float* w = which ? kvn : qn;
                float ss = 0.f; for (int k = 0; k < n; ++k) ss += v[k] * v[k];
                const float rs = 1.0f / sqrtf(ss / n + EPS);
                for (int k = 0; k < n; ++k) v[k] = v[k] * rs * w[k];
            });
        }
        rt.sync();
        {
            const float* wq = p.in[I_WQUP] + (size_t)l * 192 * 384; const float* wkv = p.in[I_WKVUP] + (size_t)l * 128 * 512;
            rt.gemm_batch(2, [=](int e) {
                GemmDesc g{PB + (e ? C_CKV : C_CQ), IN_COLS, nullptr, e ? wkv : wq, nullptr, e ? 512 : 384, e ? MKV : MQ, e ? 512 : 384, NTOK, e ? 512 : 384, e ? 128 : 192, EPI_STORE, nullptr};
                return g; });
            const float* alog = p.in[I_ALOG] + l * 16; const float* dsk = p.in[I_SSDD] + l * 8;
#ifndef ABL_SSD
            rt.items(NB * 8 * 64, [=](int i) {
                const int pp = i % 64, hh = (i / 64) % 8, b = i / 512, g = hh / 4;
                float hst[64];
                const float ds = dsk[hh];
                for (int dir = 0; dir < 2; ++dir) {
                    const float a = -expf(alog[dir * 8 + hh]);
#pragma unroll
                    for (int n = 0; n < 64; ++n) hst[n] = 0.f;
                    for (int seg = 0; seg < 2; ++seg) {
                        const bool lat = seg == 1; const int L = lat ? S : CTX; const bool wr = lat || ctx_out;
                        for (int tt = 0; tt < L; ++tt) {
                            const int t = dir ? L - 1 - tt : tt; const int r = tok_row(lat, b, t);
                            const float dt = DT[r * 16 + dir * 8 + hh], dec = expf(dt * a);
                            const float xv = XBC[(size_t)r * 768 + hh * 64 + pp], xdt = xv * dt;
                            const float* Bv = XBC + (size_t)r * 768 + 512 + g * 64; const float* Cv = Bv + 128;
                            float y = 0.f;
#pragma unroll
                            for (int n = 0; n < 64; ++n) { hst[n] = dec * hst[n] + xdt * Bv[n]; y += hst[n] * Cv[n]; }
                            if (wr) { float* o = MIX + (size_t)r * MIXW + hh * 64 + pp; if (dir == 0) *o = ds * xv + y; else *o += y; }
                        }
                    }
                }
            });
#endif

        }
        rt.sync();
        {
            const float* nw = p.in[I_SSDN] + l * 512;
            rt.items(nrows_out * 2, [=](int i) {
                const int g = i & 1, r = i >> 1;
                float* y = MIX + (size_t)r * MIXW + g * 256; const float* z = PB + (size_t)r * IN_COLS + C_Z + g * 256;
                float ss = 0.f; for (int k = 0; k < 256; ++k) { const float v = y[k] * siluf(z[k]); ss += v * v; }
                const float rs = 1.0f / sqrtf(ss / 256 + EPS);
                for (int k = 0; k < 256; ++k) y[k] = y[k] * siluf(z[k]) * rs * nw[g * 256 + k];
            });
            for (int set = 0; set < (ctx_out ? 2 : 1); ++set) {
                const bool lat = set == 0; const int L = lat ? S : CTX;
#ifndef ABL_DIFF
                rt.items(NB * 8 * L, [=](int i) {
                    const int t = i % L, hm = (i / L) % 8, b = i / (8 * L); const int hh = hm >> 1, mp = hm & 1; const int r = tok_row(lat, b, t);
                    const float scale = 0.17677669529663687f;
                    float q[32], a1[64];
                    const float* qp = PB + (size_t)r * IN_COLS + C_DQ + hm * 32;
#pragma unroll
                    for (int k = 0; k < 32; ++k) q[k] = qp[k] * scale;
#pragma unroll
                    for (int k = 0; k < 64; ++k) a1[k] = 0.f;
                    float m1 = -1e30f, l1 = 0.f;
                    const int nk = lat ? CTX + S : CTX;
                    for (int j = 0; j < nk; ++j) {
                        const int kr = j < CTX ? tok_row(false, b, j) : tok_row(true, b, j - CTX);
                        const float* kp = PB + (size_t)kr * IN_COLS + C_DK + hm * 32; const float* vp = PB + (size_t)kr * IN_COLS + C_DV + hh * 64;
                        float s1 = 0.f;
#pragma unroll
                        for (int k = 0; k < 32; ++k) s1 += q[k] * kp[k];
                        if (s1 > m1) { const float f = expf(m1 - s1); l1 *= f;
#pragma unroll
                            for (int k = 0; k < 64; ++k) a1[k] *= f;
                            m1 = s1; }
                        const float p1 = expf(s1 - m1); l1 += p1;
#pragma unroll
                        for (int k = 0; k < 64; ++k) a1[k] += p1 * vp[k];
                    }
                    const float i1 = 1.0f / l1;
                    float* o = DTMP + (size_t)r * 512 + hm * 64;
#pragma unroll
                    for (int k = 0; k < 64; ++k) o[k] = a1[k] * i1;
                    (void)mp;
                });
#endif

#ifndef ABL_MLA
                rt.items(NB * 8 * L, [=](int i) {
                    const int t = i % L, hv = (i / L) % 8, b = i / (8 * L); const int hh = hv >> 1, half = hv & 1; const int r = tok_row(lat, b, t);
                    const float scale = 0.10206207261596575f;
                    float q[96], acc[32];
                    const float* qp = MQ + (size_t)r * 384 + hh * 96;
#pragma unroll
                    for (int k = 64; k < 96; ++k) q[k] = qp[k];
                    if (lat) rope32(q + 64, t);
                    SCHED_FENCE();
#pragma unroll
                    for (int k = 0; k < 64; ++k) q[k] = qp[k];
#pragma unroll
                    for (int k = 0; k < 96; ++k) q[k] *= scale;
#pragma unroll
                    for (int k = 0; k < 32; ++k) acc[k] = 0.f;
                    float m = -1e30f, ls = 0.f;
                    const int nk = lat ? CTX + S : CTX;
                    for (int j = 0; j < nk; ++j) {
                        const int kr = j < CTX ? tok_row(false, b, j) : tok_row(true, b, j - CTX);
                        const float* kn = MKV + (size_t)kr * 512 + hh * 128; const float* krp = PB + (size_t)kr * IN_COLS + C_KR; const float* vp = kn + 64 + half * 32;
                        float s = 0.f;
#pragma unroll
                        for (int k = 0; k < 32; ++k) s += q[k] * kn[k];
                        SCHED_FENCE();
#pragma unroll
                        for (int k = 32; k < 64; ++k) s += q[k] * kn[k];
                        SCHED_FENCE();
#pragma unroll
                        for (int k = 0; k < 32; ++k) s += q[64 + k] * krp[k];
                        SCHED_FENCE();
                        if (s > m) { const float f = expf(m - s); ls *= f;
#pragma unroll
                            for (int k = 0; k < 32; ++k) acc[k] *= f;
                            m = s; }
                        const float pr = expf(s - m); ls += pr;
#pragma unroll
                        for (int k = 0; k < 32; ++k) acc[k] += pr * vp[k];
                    }
                    const float inv = 1.0f / ls;
                    float* o = MIX + (size_t)r * MIXW + 768 + hh * 64 + half * 32;
#pragma unroll
                    for (int k = 0; k < 32; ++k) o[k] = acc[k] * inv;
                });
#endif

            }
        }
        rt.sync();
        {
            const float* lq1 = p.in[I_LQ1] + l * 32; const float* lk1 = p.in[I_LK1] + l * 32; const float* lq2 = p.in[I_LQ2] + l * 32; const float* lk2 = p.in[I_LK2] + l * 32;
            const float* subw = p.in[I_SUBLN] + l * 64;
            rt.items(nrows_out * 4, [=](int i) {
                const int hh = i & 3, r = i >> 2;
                float d1 = 0.f, d2 = 0.f; for (int k = 0; k < 32; ++k) { d1 += lq1[k] * lk1[k]; d2 += lq2[k] * lk2[k]; }
                const float lam = expf(d1) - expf(d2) + lambda_init;
                const float* o1 = DTMP + (size_t)r * 512 + hh * 128; const float* o2 = o1 + 64;
                float ss = 0.f; for (int k = 0; k < 64; ++k) { const float v = o1[k] - lam * o2[k]; ss += v * v; }
                const float rs = (1.0f - lambda_init) / sqrtf(ss / 64 + EPS);
                float* o = MIX + (size_t)r * MIXW + 512 + hh * 64;
                for (int k = 0; k < 64; ++k) o[k] = (o1[k] - lam * o2[k]) * rs * subw[k];
            });
        }
        rt.sync();
        {
            const float* wo = p.in[I_WOUT] + (size_t)l * MIXW * D;
            rt.gemm_batch(1, [=](int) { GemmDesc g{MIX, MIXW, nullptr, wo, nullptr, D, MOUT, D, nrows_out, D, MIXW, EPI_STORE, nullptr}; return g; });
        }
        rt.sync();
        {
            const float* wpost = p.in[I_NMPOST] + l * D; const float* wpre = p.in[I_NFPRE] + l * D;
            const float* rw = p.in[I_RW] + (size_t)l * D * NE; const float* rb = p.in[I_RB] + l * NE;
            rt.items(nrows_out, [=](int r) {
                float* xr = r < NLAT ? xcur + (size_t)r * D : CTXC + (size_t)(r - NLAT) * D;
                const float* md = modl + (size_t)(r < NLAT ? r / S : NB) * NMOD * D;
                const float* m = MOUT + (size_t)r * D;
                float ss = 0.f; for (int k = 0; k < D; ++k) ss += m[k] * m[k];
                const float rs = 1.0f / sqrtf(ss / D + EPS);
                float s2 = 0.f;
                for (int k = 0; k < D; ++k) { const float v = xr[k] + md[2 * D + k] * (m[k] * rs * wpost[k]); xr[k] = v; s2 += v * v; }
                const float r2 = 1.0f / sqrtf(s2 / D + EPS);
                float lg[NE];
#pragma unroll
                for (int e = 0; e < NE; ++e) lg[e] = rb[e];
                float* hr = H + (size_t)r * D;
                for (int k = 0; k < D; ++k) {
                    const float hv = xr[k] * r2 * wpre[k] * (1.0f + md[4 * D + k]) + md[3 * D + k]; hr[k] = hv;
#pragma unroll
                    for (int e = 0; e < NE; ++e) lg[e] += hv * rw[k * NE + e];
                }
                float mx = lg[0];
#pragma unroll
                for (int e = 1; e < NE; ++e) mx = fmaxf(mx, lg[e]);
                float sum = 0.f;
#pragma unroll
                for (int e = 0; e < NE; ++e) { lg[e] = expf(lg[e] - mx); sum += lg[e]; }
                const float is = 1.0f / sum;
#pragma unroll
                for (int e = 0; e < NE; ++e) AFF[(size_t)r * NE + e] = lg[e] * is;
            });
        }
        rt.sync();
        for (int set = 0; set < (ctx_out ? 2 : 1); ++set) {
            const bool lat = set == 0; const int L = lat ? S : CTX; const int cap = lat ? CAP_L : CAP_C;
            rt.items(NB * NE * L, [=](int i) {
                const int t = i % L, e = (i / L) % NE, b = i / (NE * L);
                const int base = tok_row(lat, b, 0);
                const float a = AFF[(size_t)(base + t) * NE + e];
                int rank = 0;
                for (int j = 0; j < L; ++j) { const float aj = AFF[(size_t)(base + j) * NE + e]; rank += (aj > a || (aj == a && j < t)) ? 1 : 0; }
                int slot = -1;
                if (rank < cap) { slot = lat ? b * CAP_L + rank : NB * CAP_L + b * CAP_C + rank; SELIDX[e * EROWS + slot] = base + t; SELGATE[e * EROWS + slot] = a; }
                TOKSLOT[(size_t)(base + t) * NE + e] = slot;
            });
        }
        rt.sync();
        const int erows_used = ctx_out ? EROWS : NB * CAP_L;
        {
            const float* wg = p.in[I_WG] + (size_t)l * NE * D * FF; const float* wu = p.in[I_WU] + (size_t)l * NE * D * FF;
            rt.gemm_batch(NE, [=](int e) {
                GemmDesc g{H, D, SELIDX + e * EROWS, wg + (size_t)e * D * FF, wu + (size_t)e * D * FF, FF, HID + (size_t)e * EROWS * FF, FF, erows_used, FF, D, EPI_SWIGLU, nullptr};
                return g; });
        }
        rt.sync();
        {
            const float* wd = p.in[I_WD] + (size_t)l * NE * FF * D;
            rt.gemm_batch(NE, [=](int e) {
                GemmDesc g{HID + (size_t)e * EROWS * FF, FF, nullptr, wd + (size_t)e * FF * D, nullptr, D, Y + (size_t)e * EROWS * D, D, erows_used, D, FF, EPI_ROWSCALE, SELGATE + e * EROWS};
                return g; });
        }
        rt.sync();
        {
            const float* wpost = p.in[I_NFPOST] + l * D;
            rt.items(nrows_out, [=](int r) {
                float* xr = r < NLAT ? xcur + (size_t)r * D : CTXC + (size_t)(r - NLAT) * D;
                const float* md = modl + (size_t)(r < NLAT ? r / S : NB) * NMOD * D;
                int sl[NE];
#pragma unroll
                for (int e = 0; e < NE; ++e) sl[e] = TOKSLOT[(size_t)r * NE + e];
                float ss = 0.f;
                for (int k = 0; k < D; ++k) {
                    float f = 0.f;
#pragma unroll
                    for (int e = 0; e < NE; ++e) if (sl[e] >= 0) f += Y[((size_t)e * EROWS + sl[e]) * D + k];
                    ss += f * f;
                }
                const float rs = 1.0f / sqrtf(ss / D + EPS);
                for (int k = 0; k < D; ++k) {
                    float f = 0.f;
#pragma unroll
                    for (int e = 0; e < NE; ++e) if (sl[e] >= 0) f += Y[((size_t)e * EROWS + sl[e]) * D + k];
                    xr[k] += md[5 * D + k] * (f * rs * wpost[k]);
                }
            });
        }
        rt.sync();
    }
}

#ifndef HOST_EMU
#define LAS __attribute__((address_space(3)))
#define XB_TMO      128
#define XB_XCNT(j)  (256  + 64 * (j))
#define XB_XSUB(j)  (1280 + 64 * (j))
#define XB_XGEN(j)  (2304 + 64 * (j))
#define XB_TOP      3328
#define XB_TOPGEN   3392
#define XCD_BAR_WORDS 3456
#define XB_SPIN_CAP (1u << 22)
__device__ __forceinline__ unsigned xb_ld(unsigned* p)              { return __hip_atomic_load(p, __ATOMIC_RELAXED, __HIP_MEMORY_SCOPE_AGENT); }
__device__ __forceinline__ unsigned xb_add(unsigned* p, unsigned v) { return __hip_atomic_fetch_add(p, v, __ATOMIC_RELAXED, __HIP_MEMORY_SCOPE_AGENT); }
__device__ __forceinline__ unsigned xb_xcc_id() { return (unsigned)__builtin_amdgcn_s_getreg((3 << 11) | 20) & 0xFu; }
#define XB_SPIN(cond, bar) do { unsigned _sp = 0; while (cond) { __builtin_amdgcn_s_sleep(1); \
    if ((++_sp & 255u) == 0u) { if (xb_ld(&(bar)[XB_TMO])) break; if (_sp > XB_SPIN_CAP) { atomicAdd(&(bar)[XB_TMO], 1u); break; } } } } while (0)
struct XcdBarrier { unsigned* bar; unsigned x; volatile LAS unsigned* st; };
__device__ __forceinline__ XcdBarrier xcd_barrier_post(unsigned* bar, volatile LAS unsigned* st) {
    XcdBarrier b; b.bar = bar; b.x = xb_xcc_id(); b.st = st;
    if (threadIdx.x == 0) (void)xb_add(&bar[XB_XCNT(b.x)], 1u);
    return b;
}
__device__ __forceinline__ void xcd_barrier_complete(unsigned* bar, unsigned x, unsigned& nloc, unsigned& nx) {
    const unsigned G = gridDim.x * gridDim.y * gridDim.z;
    unsigned sum, cnt, mine, sp = 0u;
    for (;;) {
        sum = 0u; cnt = 0u; mine = 0u;
#pragma unroll
        for (unsigned j = 0; j < 16; ++j) { const unsigned c = xb_ld(&bar[XB_XCNT(j)]); sum += c; cnt += (c > 0u) ? 1u : 0u; mine = (j == x) ? c : mine; }
        if (sum == G) break;
        __builtin_amdgcn_s_sleep(1);
        if ((++sp & 255u) == 0u) { if (xb_ld(&bar[XB_TMO])) break; if (sp > XB_SPIN_CAP) { atomicAdd(&bar[XB_TMO], 1u); break; } }
    }
    nloc = mine > 0u ? mine : 1u; nx = cnt > 0u ? cnt : 1u;
}
__device__ __forceinline__ void xcd_barrier(const XcdBarrier& b) {
    asm volatile("s_waitcnt vmcnt(0)" ::: "memory");
    __syncthreads();
    if (threadIdx.x == 0) {
        unsigned* bar = b.bar;
        __builtin_amdgcn_s_waitcnt(0);
        unsigned nloc = b.st[0], nx = b.st[1];
        if (nloc == 0u) { xcd_barrier_complete(bar, b.x, nloc, nx); b.st[0] = nloc; b.st[1] = nx; }
        const unsigned old = xb_add(&bar[XB_XSUB(b.x)], 1u);
        const unsigned gen = old / nloc;
        if (old + 1u == (gen + 1u) * nloc) {
            __builtin_amdgcn_fence(__ATOMIC_RELEASE, "agent");
            asm volatile("s_waitcnt vmcnt(0)" ::: "memory");
            const unsigned og = xb_add(&bar[XB_TOP], 1u);
            const unsigned tg = og / nx;
            if (og + 1u == (tg + 1u) * nx) xb_add(&bar[XB_TOPGEN], 1u);
            else XB_SPIN(xb_ld(&bar[XB_TOPGEN]) == tg, bar);
            __builtin_amdgcn_fence(__ATOMIC_ACQUIRE, "agent");
            xb_add(&bar[XB_XGEN(b.x)], 1u);
            asm volatile("s_waitcnt vmcnt(0)" ::: "memory");
        } else {
            XB_SPIN(xb_ld(&bar[XB_XGEN(b.x)]) == gen, bar);
            __builtin_amdgcn_fence(__ATOMIC_ACQUIRE, "agent");
            asm volatile("s_waitcnt vmcnt(0)" ::: "memory");
        }
    }
    __syncthreads();
}

constexpr int NTHREADS = 512;
constexpr int LDS_BYTES = 131072;
constexpr int GT = 128, GK = 16, GLD = GT + 4;

struct DevRT {
    XcdBarrier bar; float* lds;
    template <class F> __device__ __forceinline__ void items(int n, F f) {
        for (int i = blockIdx.x * NTHREADS + threadIdx.x; i < n; i += gridDim.x * NTHREADS) f(i);
    }
    __device__ __forceinline__ void sync() { xcd_barrier(bar); }

    __device__ void gemm_tile(const GemmDesc& g, int tm, int tn) {
        float* As = lds; float* Bs = lds + GK * GLD; float* B2s = lds + 2 * GK * GLD;
        const int tid = threadIdx.x, ty = tid >> 5, tx = tid & 31;
        const bool dual = g.B2 != nullptr;
        float acc[8][4], acc2[8][4];
#pragma unroll
        for (int i = 0; i < 8; ++i)
#pragma unroll
            for (int j = 0; j < 4; ++j) { acc[i][j] = 0.f; acc2[i][j] = 0.f; }
        const int arow_l = tid >> 2, akq = (tid & 3) * 4;
        const int am = tm * GT + arow_l; const bool avalid = am < g.M;
        const int arow = avalid ? (g.aidx ? g.aidx[am] : am) : 0;
        const float* ap = g.A + (size_t)arow * g.lda + akq;
        const int bk = tid >> 5, bn = (tid & 31) * 4; const int bcol = tn * GT + bn; const bool bvalid = bcol < g.N;
        const float* bp = g.B + (size_t)bk * g.ldb + bcol; const float* bp2 = dual ? g.B2 + (size_t)bk * g.ldb + bcol : nullptr;
        for (int k0 = 0; k0 < g.K; k0 += GK) {
            float4 av = avalid ? *(const float4*)(ap + k0) : make_float4(0.f, 0.f, 0.f, 0.f);
            float4 bv = bvalid ? *(const float4*)(bp + (size_t)k0 * g.ldb) : make_float4(0.f, 0.f, 0.f, 0.f);
            float4 bv2 = make_float4(0.f, 0.f, 0.f, 0.f);
            if (dual && bvalid) bv2 = *(const float4*)(bp2 + (size_t)k0 * g.ldb);
            __syncthreads();
            As[(akq + 0) * GLD + arow_l] = av.x; As[(akq + 1) * GLD + arow_l] = av.y; As[(akq + 2) * GLD + arow_l] = av.z; As[(akq + 3) * GLD + arow_l] = av.w;
            *(float4*)&Bs[bk * GLD + bn] = bv;
            if (dual) *(float4*)&B2s[bk * GLD + bn] = bv2;
            __syncthreads();
#pragma unroll 2
            for (int kk = 0; kk < GK; ++kk) {
                const float4 a0 = *(const float4*)&As[kk * GLD + ty * 8], a1 = *(const float4*)&As[kk * GLD + ty * 8 + 4];
                const float4 b0 = *(const float4*)&Bs[kk * GLD + tx * 4];
                const float a[8] = {a0.x, a0.y, a0.z, a0.w, a1.x, a1.y, a1.z, a1.w}; const float b[4] = {b0.x, b0.y, b0.z, b0.w};
#pragma unroll
                for (int i = 0; i < 8; ++i)
#pragma unroll
                    for (int j = 0; j < 4; ++j) acc[i][j] += a[i] * b[j];
                if (dual) {
                    const float4 c0 = *(const float4*)&B2s[kk * GLD + tx * 4]; const float c[4] = {c0.x, c0.y, c0.z, c0.w};
#pragma unroll
                    for (int i = 0; i < 8; ++i)
#pragma unroll
                        for (int j = 0; j < 4; ++j) acc2[i][j] += a[i] * c[j];
                }
            }
        }
        const int col = tn * GT + tx * 4;
        if (col < g.N) {
#pragma unroll
            for (int i = 0; i < 8; ++i) {
                const int m = tm * GT + ty * 8 + i;
                if (m < g.M) {
                    float4 o;
                    if (g.mode == EPI_SWIGLU) { o.x = siluf(acc[i][0]) * acc2[i][0]; o.y = siluf(acc[i][1]) * acc2[i][1]; o.z = siluf(acc[i][2]) * acc2[i][2]; o.w = siluf(acc[i][3]) * acc2[i][3]; }
                    else { const float sc = g.mode == EPI_ROWSCALE ? g.rowscale[m] : 1.0f; o.x = acc[i][0] * sc; o.y = acc[i][1] * sc; o.z = acc[i][2] * sc; o.w = acc[i][3] * sc; }
                    *(float4*)(g.C + (size_t)m * g.ldc + col) = o;
                }
            }
        }
    }
    template <class DF> __device__ __forceinline__ void gemm_batch(int nb, DF df) {
        const GemmDesc g0 = df(0);
        const int mt = (g0.M + GT - 1) / GT, nt = (g0.N + GT - 1) / GT; const int per = mt * nt;
        int ntmax = nt, mtmax = mt;
        for (int e = 1; e < nb; ++e) { const GemmDesc ge = df(e); const int n2 = (ge.N + GT - 1) / GT; ntmax = n2 > ntmax ? n2 : ntmax; }
        const int per2 = mtmax * ntmax; (void)per;
        for (int id = blockIdx.x; id < nb * per2; id += gridDim.x) {
            const int e = id / per2, rem = id % per2; const int tn = rem % ntmax, tm = rem / ntmax;
            const GemmDesc g = df(e);
#ifndef ABL_GEMM
            if (tn * GT < g.N) gemm_tile(g, tm, tn);
#endif
            __syncthreads();
        }
    }
};

__global__ void __launch_bounds__(NTHREADS) mk_forward(Prm p) {
    extern __shared__ __attribute__((aligned(16))) unsigned char lds_raw[];
    volatile LAS unsigned* st = (volatile LAS unsigned*)(LAS unsigned char*)lds_raw + (LDS_BYTES - 64) / 4;
    if (threadIdx.x < 16) st[threadIdx.x] = 0u;
    __syncthreads();
    DevRT rt;
    rt.bar = xcd_barrier_post((unsigned*)(p.ws + WS_CTL), st);
    rt.lds = (float*)lds_raw;
    forward(rt, p);
}

extern "C" void kernel_launch(void* const* d_in, const int* in_sizes, int n_in, void* d_out, int out_size, void* d_ws, size_t ws_size, hipStream_t stream) {
    static int grid = 0;
    if (grid == 0) {
        if (n_in != N_IN || out_size != NLAT * D || ws_size < WS_END) { fprintf(stderr, "kernel_launch: unexpected shapes: n_in %d out %d ws %zu (need %zu)\n", n_in, out_size, ws_size, (size_t)WS_END); grid = -1; return; }
        int dev = 0, cus = 0, per_cu = 0;
        hipGetDevice(&dev);
        hipDeviceGetAttribute(&cus, hipDeviceAttributeMultiprocessorCount, dev);
        hipFuncSetAttribute((const void*)mk_forward, hipFuncAttributeMaxDynamicSharedMemorySize, LDS_BYTES);
        hipOccupancyMaxActiveBlocksPerMultiprocessor(&per_cu, (const void*)mk_forward, NTHREADS, LDS_BYTES);
        (void)hipGetLastError();
        if (per_cu < 1) { fprintf(stderr, "kernel_launch: occupancy query says %d blocks/CU\n", per_cu); grid = -1; return; }
        grid = cus;
    }
    if (grid < 0) return;
    hipMemsetAsync((char*)d_ws + WS_CTL, 0, CTL_BYTES, stream);
    Prm p{};
    for (int i = 0; i < N_IN; ++i) p.in[i] = (const float*)d_in[i];
    p.out = (float*)d_out; p.ws = (char*)d_ws;
    void* args[] = {&p};
    hipError_t e = hipLaunchCooperativeKernel((const void*)mk_forward, dim3(grid), dim3(NTHREADS), args, LDS_BYTES, stream);
    if (e != hipSuccess) fprintf(stderr, "kernel_launch: cooperative launch failed: %s (grid %d)\n", hipGetErrorString(e), grid);
}
#endif
```

```cpp
#include <hip/hip_runtime.h>
#include <cstdio>
#include <cstdint>

constexpr int D = 1024, NB = 4, S = 4096, CTX = 256, FF = 1024;
constexpr int DEPTH = 2, GRID_W = 64, NMOD = 6, NE = 16;
constexpr int NLAT = NB * S, NCTX = NB * CTX, NTOK = NLAT + NCTX;
constexpr int IN_COLS = 2416, IN_PAD = 2560;
constexpr int C_Z = 0, C_XBC = 512, C_DT = 1280, C_DQ = 1296, C_DK = 1552, C_DV = 1808, C_CQ = 2064, C_CKV = 2256, C_KR = 2384;
constexpr int MIXW = 1024;
constexpr int CAP_L = 2 * S / NE, CAP_C = 2 * CTX / NE;
constexpr int ER_MAX = 2304;
constexpr float EPS = 1e-6f;
static_assert(NB * CAP_L == 2048 && NB * CAP_C == 128, "expert row layout");

enum { I_X = 0, I_C, I_CTX, I_CCTX, I_ADAW, I_ADAB, I_NMPRE, I_NMPOST, I_NFPRE, I_NFPOST, I_WIN, I_CONVW, I_CONVB, I_ALOG, I_DTB, I_SSDD, I_SSDN,
       I_LQ1, I_LK1, I_LQ2, I_LK2, I_SUBLN, I_QNORM, I_WQUP, I_KVNORM, I_WKVUP, I_WOUT, I_RW, I_RB, I_WG, I_WU, I_WD, N_IN };
struct Prm { const float* in[N_IN]; float* out; char* ws; };

typedef unsigned short bf16_t;
constexpr size_t al256(size_t x) { return (x + 255) & ~(size_t)255; }
constexpr size_t WS_CTL = 0, CTL_BYTES = 65536;
constexpr size_t WS_MOD = WS_CTL + CTL_BYTES;
constexpr size_t WS_CTXC = al256(WS_MOD + (size_t)DEPTH * (NB + 1) * NMOD * D * 4);
constexpr size_t WS_AFF = al256(WS_CTXC + (size_t)NCTX * D * 4);
constexpr size_t WS_TOKSLOT = al256(WS_AFF + (size_t)NTOK * NE * 4);
constexpr size_t WS_SELIDX = al256(WS_TOKSLOT + (size_t)NTOK * NE * 4);
constexpr size_t WS_SELGATE = al256(WS_SELIDX + (size_t)NE * ER_MAX * 4);
constexpr size_t WS_DT = al256(WS_SELGATE + (size_t)NE * ER_MAX * 4);
constexpr size_t WS_HB = al256(WS_DT + (size_t)NTOK * 16 * 4);
constexpr size_t WS_P = al256(WS_HB + (size_t)NTOK * D * 2);
constexpr size_t WS_G2 = al256(WS_P + (size_t)NTOK * IN_COLS * 4);
constexpr size_t WS_XBC = WS_G2;
constexpr size_t WS_MQ = al256(WS_XBC + (size_t)NTOK * 768 * 4);
constexpr size_t WS_MKV = al256(WS_MQ + (size_t)NTOK * 384 * 4);
constexpr size_t WS_CQB = al256(WS_MKV + (size_t)NTOK * 512 * 4);
constexpr size_t WS_CKVB = al256(WS_CQB + (size_t)NTOK * 256 * 2);
constexpr size_t WS_MIXB = al256(WS_CKVB + (size_t)NTOK * 128 * 2);
constexpr size_t WS_G2END = al256(WS_MIXB + (size_t)NTOK * MIXW * 2);
constexpr size_t WS_YS = WS_HB;
constexpr size_t WS_MOUT = WS_P;
constexpr size_t WS_XG = WS_P;
constexpr size_t WS_HID = al256(WS_XG + (size_t)NE * ER_MAX * D * 2);
constexpr size_t WS_Y = WS_G2;
constexpr size_t WS_WIN = WS_G2END;
constexpr size_t WS_WQ = al256(WS_WIN + (size_t)IN_PAD * D * 2);
constexpr size_t WS_WKV = al256(WS_WQ + (size_t)512 * 256 * 2);
constexpr size_t WS_WOUT = al256(WS_WKV + (size_t)512 * 128 * 2);
constexpr size_t WS_WGU = al256(WS_WOUT + (size_t)D * MIXW * 2);
constexpr size_t WS_WD = al256(WS_WGU + (size_t)NE * 2 * FF * D * 2);
constexpr size_t WS_END = al256(WS_WD + (size_t)NE * D * FF * 2);
constexpr int SK = CTX + S;
constexpr size_t WS_QD = WS_WGU;
constexpr size_t WS_QDC = al256(WS_QD + (size_t)NB * 8 * S * 32 * 2);
constexpr size_t WS_KD = al256(WS_QDC + (size_t)NB * 8 * CTX * 32 * 2);
constexpr size_t WS_VDT = al256(WS_KD + (size_t)NB * 8 * SK * 32 * 2);
constexpr size_t WS_QM = al256(WS_VDT + (size_t)NB * 4 * 64 * SK * 2);
constexpr size_t WS_QMC = al256(WS_QM + (size_t)NB * 4 * S * 96 * 2);
constexpr size_t WS_KM = al256(WS_QMC + (size_t)NB * 4 * CTX * 96 * 2);
constexpr size_t WS_VMT = al256(WS_KM + (size_t)NB * 4 * SK * 96 * 2);
constexpr size_t WS_ATTEND = al256(WS_VMT + (size_t)NB * 4 * 64 * SK * 2);
static_assert(WS_ATTEND <= WS_END, "attention operands fit in the MoE weight region");
static_assert(WS_HID + (size_t)NE * ER_MAX * FF * 2 <= WS_G2, "XG+HID fit in the P region");
static_assert((size_t)NE * ER_MAX * D * 4 <= WS_G2END - WS_G2, "Y fits in the G2 region");
static_assert((size_t)NTOK * 512 * 4 <= (size_t)NTOK * D * 2, "YS fits in HB");

#define LAS __attribute__((address_space(3)))
constexpr int NTHREADS = 512;
constexpr int LDS_BYTES = 147456;
#define ITEMS(i, n) for (int i = blockIdx.x * NTHREADS + tid; i < (n); i += gridDim.x * NTHREADS)

__device__ __forceinline__ float siluf(float x) { return x / (1.0f + expf(-x)); }
__device__ __forceinline__ float softplusf(float x) { return x > 20.f ? x : log1pf(expf(x)); }
__device__ __forceinline__ unsigned f2bf(float f) { unsigned u = __builtin_bit_cast(unsigned, f); return (u + 0x7fffu + ((u >> 16) & 1u)) >> 16; }
__device__ __forceinline__ unsigned pk2(float lo, float hi) { return f2bf(lo) | (f2bf(hi) << 16); }
__device__ __forceinline__ float bf2f(bf16_t h) { return __builtin_bit_cast(float, (unsigned)h << 16); }
#define SCHED_FENCE() __builtin_amdgcn_sched_barrier(0)

__device__ __forceinline__ void rope32(float* v, int t) {
    const float prow = (float)(t / GRID_W), pcol = (float)(t % GRID_W);
#pragma unroll
    for (int i = 0; i < 8; ++i) {
        const float inv = powf(10000.0f, -(float)i / 8.0f);
        { const float ang = prow * inv, c = cosf(ang), s = sinf(ang); const float x1 = v[i], x2 = v[8 + i]; v[i] = x1 * c - x2 * s; v[8 + i] = x1 * s + x2 * c; }
        { const float ang = pcol * inv, c = cosf(ang), s = sinf(ang); const float x1 = v[16 + i], x2 = v[24 + i]; v[16 + i] = x1 * c - x2 * s; v[24 + i] = x1 * s + x2 * c; }
    }
}
__device__ __forceinline__ int tok_row(bool lat, int b, int t) { return lat ? b * S + t : NLAT + b * CTX + t; }

namespace pg8 {
#define PG8_LAS __attribute__((address_space(3)))
typedef short bf16x8 __attribute__((ext_vector_type(8)));
typedef float f32x4 __attribute__((ext_vector_type(4)));
typedef unsigned u32x4 __attribute__((ext_vector_type(4)));
constexpr int BM = 256, BK = 64, HALF = 128, HTB = HALF * BK * 2  , STAGE_BYTES = 8 * HTB, NXCD = 8, WGM = 8;

__host__ __device__ __forceinline__ int lds_byte(int r, int c) { const int st = (r >> 4) * 2 + (c >> 5), rr = r & 15, cc = c & 31, ob = rr * 64 + cc * 2; return st * 1024 + (ob ^ (((ob >> 9) & 1) << 5)); }
__host__ __device__ __forceinline__ void stage_rc(int b, int& R, int& C) { const int st = b / 1024, sb = b % 1024, swz = sb ^ (((sb >> 9) & 1) << 5); R = (st >> 1) * 16 + swz / 64; C = (st & 1) * 32 + (swz % 64) / 2; }
__host__ __device__ __forceinline__ int perm32(int rho) { const int n = rho >> 4, i = rho & 15; return 8 * (i >> 2) + 4 * n + (i & 3); }

struct Unit { int pm, pn; };
struct Gemm { const bf16_t* A; const bf16_t* Bt; int M, N, K; int grp_tiles; size_t grp_stride; };

struct StaticOrder {
    int nM, nN, nwg, G, c;
    __host__ __device__ void init(int M, int N, int G_, int c_) { nM = M / BM; nN = N / BM; nwg = nM * nN; G = G_; c = c_; }
    __host__ __device__ bool next(int i, Unit& u) const {
        const long L = (long)i * G + c; if (L >= nwg) return false;
        int wgid = (int)L; { const int q = nwg / NXCD, r = nwg % NXCD, xcd = wgid % NXCD, off = wgid / NXCD; wgid = (xcd < r ? xcd * (q + 1) : r * (q + 1) + (xcd - r) * q) + off; }
        const int nig = WGM * nN, gid = wgid / nig, fm = gid * WGM, gsz = (nM - fm) < WGM ? (nM - fm) : WGM;
        u.pm = fm + ((wgid % nig) % gsz); u.pn = (wgid % nig) / gsz; return true;
    }
    __device__ __forceinline__ void a_ready(const Unit&) const {}
    __device__ __forceinline__ void done(const Unit&) const {}
};

__device__ __forceinline__ unsigned cvt_pk_bf16(float lo, float hi) { unsigned r; asm volatile("v_cvt_pk_bf16_f32 %0, %1, %2" : "=v"(r) : "v"(lo), "v"(hi)); return r; }

typedef unsigned u32x2 __attribute__((ext_vector_type(2)));
struct EpiF32 {
    static constexpr bool PERM = false, AFTER_DRAIN = false;
    float* C; int ldc; int ncols;
    __device__ __forceinline__ void operator()(const f32x4 (&acc)[2][2][4][2], const Unit& u, int wr, int wc, int fr, int fq) const {
        const int row0 = u.pm * BM + wr * 64 + fr, col0 = u.pn * BM + wc * 32 + 4 * fq;
#pragma unroll
        for (int ai = 0; ai < 2; ++ai)
#pragma unroll
            for (int m = 0; m < 4; ++m) { float* rowp = C + (size_t)(row0 + ai * HALF + m * 16) * ldc;
#pragma unroll
                for (int bj = 0; bj < 2; ++bj)
#pragma unroll
                    for (int n = 0; n < 2; ++n) { const int col = col0 + bj * HALF + n * 16; if (col < ncols) *(f32x4*)(rowp + col) = acc[ai][bj][m][n]; } }
    }
};
struct EpiRowScaleF32 {
    static constexpr bool PERM = false, AFTER_DRAIN = false;
    float* C; int ldc; const float* gate; int er;
    __device__ __forceinline__ void operator()(const f32x4 (&acc)[2][2][4][2], const Unit& u, int wr, int wc, int fr, int fq) const {
        const int row0 = u.pm * BM + wr * 64 + fr, col0 = u.pn * BM + wc * 32 + 4 * fq;
#pragma unroll
        for (int ai = 0; ai < 2; ++ai)
#pragma unroll
            for (int m = 0; m < 4; ++m) { const int row = row0 + ai * HALF + m * 16; float* rowp = C + (size_t)row * ldc; const float sc = gate[(row / er) * ER_MAX + row % er];
#pragma unroll
                for (int bj = 0; bj < 2; ++bj)
#pragma unroll
                    for (int n = 0; n < 2; ++n) *(f32x4*)(rowp + col0 + bj * HALF + n * 16) = acc[ai][bj][m][n] * sc; }
    }
};
struct EpiSwiGLU {
    static constexpr bool PERM = true, AFTER_DRAIN = false;
    bf16_t* O; int ldo;
    __device__ __forceinline__ void operator()(const f32x4 (&acc)[2][2][4][2], const Unit& u, int wr, int wc, int fr, int fq) const {
        const int row0 = u.pm * BM + wr * 64 + fr, col0 = u.pn * BM + wc * 32 + 8 * fq;
#pragma unroll
        for (int ai = 0; ai < 2; ++ai)
#pragma unroll
            for (int m = 0; m < 4; ++m) { bf16_t* rowp = O + (size_t)(row0 + ai * HALF + m * 16) * ldo;
#pragma unroll
                for (int bj = 0; bj < 2; ++bj) { const f32x4 gt = acc[ai][bj][m][0], up = acc[ai][bj][m][1]; f32x4 h;
#pragma unroll
                    for (int i = 0; i < 4; ++i) h[i] = gt[i] / (1.0f + __expf(-gt[i])) * up[i];
                    u32x2 w; w.x = cvt_pk_bf16(h[0], h[1]); w.y = cvt_pk_bf16(h[2], h[3]);
                    *(u32x2*)(rowp + (col0 + bj * HALF) / 2) = w; } }
    }
};
template <class Epi, class Sched, bool ALIGN_EPI = false, bool SP2 = false>
__device__ __forceinline__ void gemm_phase(PG8_LAS unsigned char* lds, const Gemm g, const Sched& S, const Epi& E) {
    int tid_ = threadIdx.x; asm volatile("" : "+v"(tid_));
    const int tid = tid_, wid = __builtin_amdgcn_readfirstlane(tid >> 6), lane = tid & 63, wr = wid >> 2, wc = wid & 3, fr = lane & 15, fq = lane >> 4;
    int K_ = g.K; asm volatile("" : "+s"(K_));
    const int K = K_, nt = K / BK;
    unsigned voffA[2], voffB[2];
#pragma unroll
    for (int i = 0; i < 2; ++i) { int R, C; stage_rc(tid * 16 + i * 8192, R, C); const int Rb = Epi::PERM ? ((R & ~31) + perm32(R & 31)) : R;
        voffA[i] = (unsigned)(R * K + C) * 2u; voffB[i] = (unsigned)(Rb * K + C) * 2u; }
    const size_t kstep = (size_t)(BK * 2);
    const size_t hstep = (size_t)HALF * K * 2;
    const size_t tstep = 2 * hstep;
    const unsigned ldsw = (unsigned)wid * 1024u;
    const int aoff = lds_byte(wr * 64 + fr, fq * 8), boff = lds_byte(wc * 32 + fr, fq * 8);
#define PG8_SA(b, h) (((b) * 2 + (h)) * HTB)
#define PG8_SB(b, h) ((4 + (b) * 2 + (h)) * HTB)
#define PG8_STAGE(bufoff, gbase, voff) do { _Pragma("unroll") for (int _i = 0; _i < 2; ++_i) \
        __builtin_amdgcn_global_load_lds((const unsigned*)((const char*)(gbase) + (voff)[_i]), (PG8_LAS unsigned*)(lds + (bufoff) + ldsw + _i * 8192), 16, 0, 0); } while (0)
#define PG8_LDA(dst, b, h) do { _Pragma("unroll") for (int m = 0; m < 4; ++m) _Pragma("unroll") for (int k = 0; k < 2; ++k) dst[m][k] = *(const PG8_LAS bf16x8*)(lds + PG8_SA(b, h) + aoff + m * 2048 + k * 1024); } while (0)
#define PG8_LDB(dst, b, h) do { _Pragma("unroll") for (int n = 0; n < 2; ++n) _Pragma("unroll") for (int k = 0; k < 2; ++k) dst[n][k] = *(const PG8_LAS bf16x8*)(lds + PG8_SB(b, h) + boff + n * 2048 + k * 1024); } while (0)
#define PG8_MMA(ai, bj, At, Bt) do { __builtin_amdgcn_s_setprio(1); _Pragma("unroll") for (int m = 0; m < 4; ++m) _Pragma("unroll") for (int n = 0; n < 2; ++n) _Pragma("unroll") for (int k = 0; k < 2; ++k) \
        acc[ai][bj][m][n] = __builtin_amdgcn_mfma_f32_16x16x32_bf16(Bt[n][k], At[m][k], acc[ai][bj][m][n], 0, 0, 0); __builtin_amdgcn_s_setprio(0); } while (0)
#define PG8_WAIT_V(n) asm volatile("s_waitcnt vmcnt(" #n ")" ::: "memory")
#define PG8_WAIT_L(n) asm volatile("s_waitcnt lgkmcnt(" #n ")" ::: "memory")
#define PG8_BAR __builtin_amdgcn_s_barrier()
#define PG8_SCHED __builtin_amdgcn_sched_barrier(0)
    Unit cur, nxt; int ui = 0;
    if (!S.next(0, cur)) return;
    f32x4 acc[2][2][4][2];
#pragma unroll
    for (int a = 0; a < 2; ++a)
#pragma unroll
        for (int b = 0; b < 2; ++b)
#pragma unroll
            for (int m = 0; m < 4; ++m)
#pragma unroll
                for (int n = 0; n < 2; ++n) acc[a][b][m][n] = (f32x4){0.f, 0.f, 0.f, 0.f};
    bf16x8 At[4][2], B0[2][2], B1[2][2];
    const char* cA = (const char*)g.A + (size_t)cur.pm * tstep; const char* cB = (const char*)g.Bt + (size_t)cur.pn * tstep + (g.grp_tiles ? (size_t)(cur.pm / g.grp_tiles) * g.grp_stride : (size_t)0);
    S.a_ready(cur);
    if constexpr (SP2) {
        PG8_STAGE(PG8_SB(0, 0), cB, voffB); PG8_STAGE(PG8_SB(0, 1), cB + hstep, voffB); PG8_STAGE(PG8_SA(0, 0), cA, voffA); PG8_STAGE(PG8_SA(0, 1), cA + hstep, voffA);
        if (wr == 1) PG8_BAR;
        PG8_WAIT_V(2); PG8_BAR;
        PG8_STAGE(PG8_SB(1, 0), cB + kstep, voffB); PG8_STAGE(PG8_SA(1, 0), cA + kstep, voffA); PG8_STAGE(PG8_SB(1, 1), cB + hstep + kstep, voffB);
        PG8_WAIT_V(6); PG8_BAR;
    } else {
        PG8_STAGE(PG8_SB(0, 0), cB, voffB); PG8_STAGE(PG8_SA(0, 0), cA, voffA); PG8_STAGE(PG8_SB(0, 1), cB + hstep, voffB); PG8_STAGE(PG8_SA(0, 1), cA + hstep, voffA);
        if (wr == 1) PG8_BAR;
        PG8_WAIT_V(4); PG8_BAR;
        PG8_STAGE(PG8_SB(1, 0), cB + kstep, voffB); PG8_STAGE(PG8_SA(1, 0), cA + kstep, voffA); PG8_STAGE(PG8_SB(1, 1), cB + hstep + kstep, voffB);
        PG8_WAIT_V(6); PG8_BAR;
    }
    for (;;) {
        const bool has_next = S.next(ui + 1, nxt);
        const char* nA = has_next ? (const char*)g.A + (size_t)nxt.pm * tstep : cA; const char* nB = has_next ? (const char*)g.Bt + (size_t)nxt.pn * tstep + (g.grp_tiles ? (size_t)(nxt.pm / g.grp_tiles) * g.grp_stride : (size_t)0) : cB;
        for (int t = 0; t < nt; t += 2) {
            const bool last = (t == nt - 2);
            const char* a1 = cA + (size_t)(t + 1) * kstep;
            const char* a2 = last ? nA : cA + (size_t)(t + 2) * kstep; const char* b2 = last ? nB : cB + (size_t)(t + 2) * kstep;
            const char* a3 = a2 + kstep; const char* b3 = b2 + kstep;
            if (last && has_next) S.a_ready(nxt);
            if constexpr (SP2) {
            PG8_LDB(B0, 0, 0); PG8_LDB(B1, 0, 1); PG8_SCHED; PG8_LDA(At, 0, 0); PG8_STAGE(PG8_SA(1, 1), a1 + hstep, voffA);
            PG8_WAIT_V(8); PG8_WAIT_L(0); PG8_BAR; PG8_MMA(0, 0, At, B0); PG8_MMA(0, 1, At, B1); PG8_BAR; PG8_SCHED;
            PG8_LDA(At, 0, 1); PG8_STAGE(PG8_SB(0, 0), b2, voffB); PG8_STAGE(PG8_SB(0, 1), b2 + hstep, voffB); PG8_STAGE(PG8_SA(0, 0), a2, voffA);
            PG8_WAIT_V(8); PG8_WAIT_L(0); PG8_BAR; PG8_MMA(1, 0, At, B0); PG8_MMA(1, 1, At, B1); PG8_BAR; PG8_SCHED;
            PG8_LDB(B0, 1, 0); PG8_LDB(B1, 1, 1); PG8_SCHED; PG8_LDA(At, 1, 0); PG8_STAGE(PG8_SA(0, 1), a2 + hstep, voffA);
            PG8_WAIT_V(8); PG8_WAIT_L(0); PG8_BAR; PG8_MMA(0, 0, At, B0); PG8_MMA(0, 1, At, B1); PG8_BAR; PG8_SCHED;
            PG8_LDA(At, 1, 1); PG8_STAGE(PG8_SB(1, 0), b3, voffB); PG8_STAGE(PG8_SB(1, 1), b3 + hstep, voffB); PG8_STAGE(PG8_SA(1, 0), a3, voffA);
            PG8_WAIT_V(8); PG8_WAIT_L(0); PG8_BAR; PG8_MMA(1, 0, At, B0); PG8_MMA(1, 1, At, B1); PG8_BAR; PG8_SCHED;
            } else {
            PG8_LDB(B0, 0, 0); PG8_SCHED; PG8_LDA(At, 0, 0); PG8_STAGE(PG8_SA(1, 1), a1 + hstep, voffA);
            PG8_WAIT_L(8); PG8_BAR; PG8_WAIT_L(0); PG8_MMA(0, 0, At, B0); PG8_BAR; PG8_SCHED;
            PG8_LDB(B1, 0, 1); PG8_STAGE(PG8_SB(0, 0), b2, voffB);
            PG8_BAR; PG8_WAIT_L(0); PG8_MMA(0, 1, At, B1); PG8_BAR;
            PG8_LDA(At, 0, 1); PG8_STAGE(PG8_SA(0, 0), a2, voffA);
            PG8_BAR; PG8_WAIT_L(0); PG8_MMA(1, 0, At, B0); PG8_BAR; PG8_SCHED;
            PG8_STAGE(PG8_SB(0, 1), b2 + hstep, voffB);
            PG8_WAIT_V(6); PG8_BAR; PG8_MMA(1, 1, At, B1); PG8_BAR;
            PG8_LDB(B0, 1, 0); PG8_SCHED; PG8_LDA(At, 1, 0); PG8_STAGE(PG8_SA(0, 1), a2 + hstep, voffA);
            PG8_WAIT_L(8); PG8_BAR; PG8_WAIT_L(0); PG8_MMA(0, 0, At, B0); PG8_BAR; PG8_SCHED;
            PG8_LDB(B1, 1, 1); PG8_STAGE(PG8_SB(1, 0), b3, voffB);
            PG8_BAR; PG8_WAIT_L(0); PG8_MMA(0, 1, At, B1); PG8_BAR;
            PG8_LDA(At, 1, 1); PG8_STAGE(PG8_SA(1, 0), a3, voffA);
            PG8_BAR; PG8_WAIT_L(0); PG8_MMA(1, 0, At, B0); PG8_BAR; PG8_SCHED;
            PG8_STAGE(PG8_SB(1, 1), b3 + hstep, voffB);
            PG8_WAIT_V(6); PG8_BAR; PG8_MMA(1, 1, At, B1); PG8_BAR;
            }
        }
        if constexpr (ALIGN_EPI) { if (wr == 0) PG8_BAR; }
        if constexpr (!Epi::AFTER_DRAIN) { E(acc, cur, wr, wc, fr, fq); S.done(cur); }
        if (!has_next) break;
#pragma unroll
        for (int a = 0; a < 2; ++a)
#pragma unroll
            for (int b = 0; b < 2; ++b)
#pragma unroll
                for (int m = 0; m < 4; ++m)
#pragma unroll
                    for (int n = 0; n < 2; ++n) acc[a][b][m][n] = (f32x4){0.f, 0.f, 0.f, 0.f};
        cur = nxt; cA = nA; cB = nB; ++ui;
        if constexpr (ALIGN_EPI) { if (wr == 1) PG8_BAR; }
    }
    PG8_WAIT_V(0);
    if constexpr (!ALIGN_EPI) { if (wr == 0) PG8_BAR; }
    PG8_BAR;
    if constexpr (Epi::AFTER_DRAIN) { E.fused(acc, cur, wr, wc, fr, fq, lds, wid, lane); S.done(cur); }
#undef PG8_SA
#undef PG8_SB
#undef PG8_STAGE
#undef PG8_LDA
#undef PG8_LDB
#undef PG8_MMA
#undef PG8_WAIT_V
#undef PG8_WAIT_L
#undef PG8_BAR
#undef PG8_SCHED
}
}


#define XB_TMO      128
#define XB_XCNT(j)  (256  + 64 * (j))
#define XB_XSUB(j)  (1280 + 64 * (j))
#define XB_XGEN(j)  (2304 + 64 * (j))
#define XB_TOP      3328
#define XB_TOPGEN   3392
#define XCD_BAR_WORDS 3456
#define XB_SPIN_CAP (1u << 22)
__device__ __forceinline__ unsigned xb_ld(unsigned* p)              { return __hip_atomic_load(p, __ATOMIC_RELAXED, __HIP_MEMORY_SCOPE_AGENT); }
__device__ __forceinline__ unsigned xb_add(unsigned* p, unsigned v) { return __hip_atomic_fetch_add(p, v, __ATOMIC_RELAXED, __HIP_MEMORY_SCOPE_AGENT); }
__device__ __forceinline__ unsigned xb_xcc_id() { return (unsigned)__builtin_amdgcn_s_getreg((3 << 11) | 20) & 0xFu; }
#define XB_SPIN(cond, bar) do { unsigned _sp = 0; while (cond) { __builtin_amdgcn_s_sleep(1); \
    if ((++_sp & 255u) == 0u) { if (xb_ld(&(bar)[XB_TMO])) break; if (_sp > XB_SPIN_CAP) { atomicAdd(&(bar)[XB_TMO], 1u); break; } } } } while (0)
struct XcdBarrier { unsigned* bar; unsigned x; volatile LAS unsigned* st; };
__device__ __forceinline__ XcdBarrier xcd_barrier_post(unsigned* bar, volatile LAS unsigned* st) {
    XcdBarrier b; b.bar = bar; b.x = xb_xcc_id(); b.st = st;
    if (threadIdx.x == 0) (void)xb_add(&bar[XB_XCNT(b.x)], 1u);
    return b;
}
__device__ __forceinline__ void xcd_barrier_complete(unsigned* bar, unsigned x, unsigned& nloc, unsigned& nx) {
    const unsigned G = gridDim.x * gridDim.y * gridDim.z;
    unsigned sum, cnt, mine, sp = 0u;
    for (;;) {
        sum = 0u; cnt = 0u; mine = 0u;
#pragma unroll
        for (unsigned j = 0; j < 16; ++j) { const unsigned c = xb_ld(&bar[XB_XCNT(j)]); sum += c; cnt += (c > 0u) ? 1u : 0u; mine = (j == x) ? c : mine; }
        if (sum == G) break;
        __builtin_amdgcn_s_sleep(1);
        if ((++sp & 255u) == 0u) { if (xb_ld(&bar[XB_TMO])) break; if (sp > XB_SPIN_CAP) { atomicAdd(&bar[XB_TMO], 1u); break; } }
    }
    nloc = mine > 0u ? mine : 1u; nx = cnt > 0u ? cnt : 1u;
}
__device__ __forceinline__ void xcd_barrier(const XcdBarrier& b) {
    asm volatile("s_waitcnt vmcnt(0)" ::: "memory");
    __syncthreads();
    if (threadIdx.x == 0) {
        unsigned* bar = b.bar;
        __builtin_amdgcn_s_waitcnt(0);
        unsigned nloc = b.st[0], nx = b.st[1];
        if (nloc == 0u) { xcd_barrier_complete(bar, b.x, nloc, nx); b.st[0] = nloc; b.st[1] = nx; }
        const unsigned old = xb_add(&bar[XB_XSUB(b.x)], 1u);
        const unsigned gen = old / nloc;
        if (old + 1u == (gen + 1u) * nloc) {
            __builtin_amdgcn_fence(__ATOMIC_RELEASE, "agent");
            asm volatile("s_waitcnt vmcnt(0)" ::: "memory");
            const unsigned og = xb_add(&bar[XB_TOP], 1u);
            const unsigned tg = og / nx;
            if (og + 1u == (tg + 1u) * nx) xb_add(&bar[XB_TOPGEN], 1u);
            else XB_SPIN(xb_ld(&bar[XB_TOPGEN]) == tg, bar);
            __builtin_amdgcn_fence(__ATOMIC_ACQUIRE, "agent");
            xb_add(&bar[XB_XGEN(b.x)], 1u);
            asm volatile("s_waitcnt vmcnt(0)" ::: "memory");
        } else {
            XB_SPIN(xb_ld(&bar[XB_XGEN(b.x)]) == gen, bar);
            __builtin_amdgcn_fence(__ATOMIC_ACQUIRE, "agent");
            asm volatile("s_waitcnt vmcnt(0)" ::: "memory");
        }
    }
    __syncthreads();
}


typedef short bf16x8 __attribute__((ext_vector_type(8)));
typedef short s16x4 __attribute__((ext_vector_type(4)));
typedef float f32x16 __attribute__((ext_vector_type(16)));
typedef unsigned v4u __attribute__((ext_vector_type(4)));
typedef unsigned v2u __attribute__((ext_vector_type(2)));
constexpr float ATT_THR = 5.0f;
template <int DK> struct AttL { static constexpr int KSTR = DK * 2 + 16, KBYTES = 64 * KSTR, VSTR = 136, VBYTES = 64 * VSTR, BUF = KBYTES + VBYTES, KCH = 64 * DK / 8, KPT = (KCH + NTHREADS - 1) / NTHREADS; };

template <int DK>
__device__ __forceinline__ void attn_pass(const bf16_t* Qrow, const bf16_t* Kp, const bf16_t* Vtp, int vt_ld, int nkt, LAS unsigned char* lds, int tid, f32x16 (&oacc)[2], float& m_run, float& l_run) {
    typedef AttL<DK> L;
    const int lane = tid & 63, r = lane & 31, h = lane >> 5;
    bf16x8 qf[DK / 16];
#pragma unroll
    for (int ks = 0; ks < DK / 16; ++ks) qf[ks] = *(const bf16x8*)(Qrow + 16 * ks + 8 * h);
    v4u kreg[L::KPT]; v4u vreg;
    const int vd = tid >> 3, vpart = tid & 7;
#define ATT_LOAD(j) do { _Pragma("unroll") for (int i_ = 0; i_ < L::KPT; ++i_) { const int c_ = tid + i_ * NTHREADS; if (c_ < L::KCH) kreg[i_] = *(const v4u*)(Kp + (size_t)(j) * 64 * DK + c_ * 8); } \
        vreg = *(const v4u*)(Vtp + (size_t)vd * vt_ld + (j) * 64 + vpart * 8); } while (0)
#define ATT_STORE(buf) do { _Pragma("unroll") for (int i_ = 0; i_ < L::KPT; ++i_) { const int c_ = tid + i_ * NTHREADS; if (c_ < L::KCH) { const int key_ = c_ / (DK / 8), part_ = c_ % (DK / 8); \
            *(LAS v4u*)(lds + (buf) * L::BUF + key_ * L::KSTR + part_ * 16) = kreg[i_]; } } \
        { LAS unsigned char* vp_ = lds + (buf) * L::BUF + L::KBYTES + vd * L::VSTR + vpart * 16; *(LAS v2u*)vp_ = (v2u){vreg.x, vreg.y}; *(LAS v2u*)(vp_ + 8) = (v2u){vreg.z, vreg.w}; } } while (0)
    __syncthreads();
    ATT_LOAD(0); ATT_STORE(0);
    __syncthreads();
    for (int j = 0; j < nkt; ++j) {
        const int buf = j & 1;
        if (j + 1 < nkt) ATT_LOAD(j + 1);
        f32x16 sacc[2];
#pragma unroll
        for (int kb = 0; kb < 2; ++kb) {
#pragma unroll
            for (int i = 0; i < 16; ++i) sacc[kb][i] = 0.f;
#pragma unroll
            for (int ks = 0; ks < DK / 16; ++ks) {
                const bf16x8 a = *(const LAS bf16x8*)(lds + buf * L::BUF + (32 * kb + r) * L::KSTR + (16 * ks + 8 * h) * 2);
                sacc[kb] = __builtin_amdgcn_mfma_f32_32x32x16_bf16(a, qf[ks], sacc[kb], 0, 0, 0);
            }
        }
        float tmax = sacc[0][0];
#pragma unroll
        for (int i = 1; i < 16; ++i) tmax = fmaxf(tmax, sacc[0][i]);
#pragma unroll
        for (int i = 0; i < 16; ++i) tmax = fmaxf(tmax, sacc[1][i]);
        tmax = fmaxf(tmax, __shfl_xor(tmax, 32));
        if (__any(tmax > m_run + ATT_THR)) {
            const float mn = fmaxf(m_run, tmax), alpha = __builtin_amdgcn_exp2f(m_run - mn);
#pragma unroll
            for (int i = 0; i < 16; ++i) { oacc[0][i] *= alpha; oacc[1][i] *= alpha; }
            l_run *= alpha; m_run = mn;
        }
        float psum = 0.f;
#pragma unroll
        for (int kb = 0; kb < 2; ++kb)
#pragma unroll
            for (int i = 0; i < 16; ++i) { const float pv = __builtin_amdgcn_exp2f(sacc[kb][i] - m_run); sacc[kb][i] = pv; psum += pv; }
        l_run += psum;
#pragma unroll
        for (int kb = 0; kb < 2; ++kb)
#pragma unroll
            for (int s2 = 0; s2 < 2; ++s2) {
                union { bf16x8 v; unsigned u[4]; } pf;
#pragma unroll
                for (int i = 0; i < 4; ++i) pf.u[i] = pg8::cvt_pk_bf16(sacc[kb][8 * s2 + 2 * i], sacc[kb][8 * s2 + 2 * i + 1]);
#pragma unroll
                for (int db = 0; db < 2; ++db) {
                    const LAS unsigned char* vp = lds + buf * L::BUF + L::KBYTES + (32 * db + r) * L::VSTR + (32 * kb + 16 * s2 + 4 * h) * 2;
                    union { bf16x8 v; v2u u[2]; } af; af.u[0] = *(const LAS v2u*)vp; af.u[1] = *(const LAS v2u*)(vp + 16);
                    oacc[db] = __builtin_amdgcn_mfma_f32_32x32x16_bf16(af.v, pf.v, oacc[db], 0, 0, 0);
                }
            }
        if (j + 1 < nkt) ATT_STORE(buf ^ 1);
        __syncthreads();
    }
#undef ATT_LOAD
#undef ATT_STORE
}

template <class RM>
__device__ __forceinline__ void cvt_transpose(const float* src, int K, int N, bf16_t* dst, int ldd, RM rowmap, float* tile  , int tile0, int& tcount, int tid) {
    const int tk = K / 64, tn = (N + 63) / 64, nt = tk * tn;
    for (int t = 0; t < nt; ++t) {
        const int gt = tile0 + t; ++tcount;
        if (gt % (int)gridDim.x != (int)blockIdx.x) continue;
        const int k0 = (t / tn) * 64, n0 = (t % tn) * 64;
        __syncthreads();
#pragma unroll
        for (int i = 0; i < 2; ++i) {
            const int kk = (tid >> 4) + 32 * i, nn = (tid & 15) * 4;
            float4 v = make_float4(0.f, 0.f, 0.f, 0.f);
            if (n0 + nn < N) v = *(const float4*)(src + (size_t)(k0 + kk) * N + n0 + nn);
            tile[kk * 65 + nn] = v.x; tile[kk * 65 + nn + 1] = v.y; tile[kk * 65 + nn + 2] = v.z; tile[kk * 65 + nn + 3] = v.w;
        }
        __syncthreads();
        const int n = tid >> 3, ks = (tid & 7) * 8;
        if (n0 + n < N) {
            uint4 o;
            o.x = pk2(tile[(ks + 0) * 65 + n], tile[(ks + 1) * 65 + n]); o.y = pk2(tile[(ks + 2) * 65 + n], tile[(ks + 3) * 65 + n]);
            o.z = pk2(tile[(ks + 4) * 65 + n], tile[(ks + 5) * 65 + n]); o.w = pk2(tile[(ks + 6) * 65 + n], tile[(ks + 7) * 65 + n]);
            *(uint4*)(dst + (size_t)rowmap(n0 + n) * ldd + k0 + ks) = o;
        }
    }
}

#define MOD ((float*)(kp_->ws + WS_MOD))
#define CTXC ((float*)(kp_->ws + WS_CTXC))
#define AFF ((float*)(kp_->ws + WS_AFF))
#define TOKSLOT ((int*)(kp_->ws + WS_TOKSLOT))
#define SELIDX ((int*)(kp_->ws + WS_SELIDX))
#define SELGATE ((float*)(kp_->ws + WS_SELGATE))
#define DT ((float*)(kp_->ws + WS_DT))
#define HB ((bf16_t*)(kp_->ws + WS_HB))
#define YS ((float*)(kp_->ws + WS_YS))
#define PB ((float*)(kp_->ws + WS_P))
#define XBC ((float*)(kp_->ws + WS_XBC))
#define MQ ((float*)(kp_->ws + WS_MQ))
#define MKV ((float*)(kp_->ws + WS_MKV))
#define CQB ((bf16_t*)(kp_->ws + WS_CQB))
#define CKVB ((bf16_t*)(kp_->ws + WS_CKVB))
#define MIXB ((bf16_t*)(kp_->ws + WS_MIXB))
#define MOUT ((float*)(kp_->ws + WS_MOUT))
#define XG ((bf16_t*)(kp_->ws + WS_XG))
#define HID ((bf16_t*)(kp_->ws + WS_HID))
#define Y ((float*)(kp_->ws + WS_Y))
#define WIN_T ((bf16_t*)(kp_->ws + WS_WIN))
#define WQ_T ((bf16_t*)(kp_->ws + WS_WQ))
#define WKV_T ((bf16_t*)(kp_->ws + WS_WKV))
#define WOUT_T ((bf16_t*)(kp_->ws + WS_WOUT))
#define WGU_T ((bf16_t*)(kp_->ws + WS_WGU))
#define WD_T ((bf16_t*)(kp_->ws + WS_WD))
#define QD ((bf16_t*)(kp_->ws + WS_QD))
#define QDC ((bf16_t*)(kp_->ws + WS_QDC))
#define KD ((bf16_t*)(kp_->ws + WS_KD))
#define VDT ((bf16_t*)(kp_->ws + WS_VDT))
#define QM ((bf16_t*)(kp_->ws + WS_QM))
#define QMC ((bf16_t*)(kp_->ws + WS_QMC))
#define KM ((bf16_t*)(kp_->ws + WS_KM))
#define VMT ((bf16_t*)(kp_->ws + WS_VMT))
#define xcur (kp_->out)
#define DTMP XBC
#define modl (MOD + (size_t)l * (NB + 1) * NMOD * D)
typedef const __attribute__((address_space(4))) Prm* KPrm;
#define PHASE_BEGIN() KPrm kp_ = (KPrm)__builtin_amdgcn_kernarg_segment_ptr(); asm volatile("" : "+s"(kp_)); int tid = threadIdx.x; asm volatile("" : "+v"(tid)); (void)tid
#define GSYNC() do { XcdBarrier b_; b_.bar = (unsigned*)(kp_->ws + WS_CTL); b_.x = xb_xcc_id(); b_.st = (volatile LAS unsigned*)(ldsb + LDS_BYTES - 64); xcd_barrier(b_); } while (0)
__global__ void __launch_bounds__(NTHREADS, 2) mk_forward(Prm p) {
    extern __shared__ __attribute__((aligned(16))) unsigned char lds_raw[];
    LAS unsigned char* const ldsb = (LAS unsigned char*)lds_raw;
    volatile LAS unsigned* st = (volatile LAS unsigned*)(ldsb + LDS_BYTES - 64);
    if (threadIdx.x < 16) st[threadIdx.x] = 0u;
    __syncthreads();
    (void)xcd_barrier_post((unsigned*)(p.ws + WS_CTL), st);
    const int G = gridDim.x, bid = blockIdx.x;

    {
        PHASE_BEGIN();
        const float* c = kp_->in[I_C]; const float* cc = kp_->in[I_CCTX]; const float* adaw = kp_->in[I_ADAW]; const float* adab = kp_->in[I_ADAB];
        ITEMS(i, DEPTH * (NB + 1) * NMOD * D) {
            const int j = i % (NMOD * D), r = (i / (NMOD * D)) % (NB + 1), l = i / ((NB + 1) * NMOD * D);
            const float* src = r < NB ? c + (size_t)r * D : cc;
            const float* w = adaw + (size_t)l * D * NMOD * D + j;
            float acc = adab[l * NMOD * D + j];
            for (int k = 0; k < D; ++k) acc += siluf(src[k]) * w[(size_t)k * NMOD * D];
            MOD[i] = acc;
        }
        const float4* x4 = (const float4*)kp_->in[I_X]; const float4* c4 = (const float4*)kp_->in[I_CTX];
        ITEMS(i, NLAT * D / 4) ((float4*)xcur)[i] = x4[i];
        ITEMS(i, NCTX * D / 4) ((float4*)CTXC)[i] = c4[i];
        GSYNC();
    }

#pragma unroll 1
    for (int l = 0; l < DEPTH; ++l) {
        const bool ctx_out = l < DEPTH - 1;
        const float lambda_init = 0.8f - 0.6f * expf(-0.3f * (float)l);
        const int nrows_out = ctx_out ? NTOK : NLAT;
        const int ER = ctx_out ? ER_MAX : NB * CAP_L;

        {
            PHASE_BEGIN();
            float* tile = (float*)lds_raw; int tc = 0;
            auto idm = [](int n) { return n; };
            cvt_transpose(kp_->in[I_WIN] + (size_t)l * D * IN_COLS, D, IN_COLS, WIN_T, D, idm, tile, tc, tc, tid);
            cvt_transpose(kp_->in[I_WQUP] + (size_t)l * 192 * 384, 192, 384, WQ_T, 256, idm, tile, tc, tc, tid);
            cvt_transpose(kp_->in[I_WKVUP] + (size_t)l * 128 * 512, 128, 512, WKV_T, 128, idm, tile, tc, tc, tid);
            cvt_transpose(kp_->in[I_WOUT] + (size_t)l * MIXW * D, MIXW, D, WOUT_T, MIXW, idm, tile, tc, tc, tid);
            __syncthreads();
            ITEMS(i, (IN_PAD - IN_COLS) * D / 8) ((uint4*)(WIN_T + (size_t)IN_COLS * D))[i] = make_uint4(0, 0, 0, 0);
            ITEMS(i, 128 * 256 / 8) ((uint4*)(WQ_T + (size_t)384 * 256))[i] = make_uint4(0, 0, 0, 0);
            ITEMS(i, 384 * 8) { const int r = i >> 3, c8 = i & 7; *(uint4*)(WQ_T + (size_t)r * 256 + 192 + c8 * 8) = make_uint4(0, 0, 0, 0); }

            const float* w = kp_->in[I_NMPRE] + l * D;
            ITEMS(r, NTOK) {
                const float* src = r < NLAT ? xcur + (size_t)r * D : CTXC + (size_t)(r - NLAT) * D;
                const float* md = modl + (size_t)(r < NLAT ? r / S : NB) * NMOD * D;
                float ss = 0.f;
                for (int k = 0; k < D; ++k) ss += src[k] * src[k];
                const float rs = 1.0f / sqrtf(ss / D + EPS);
                bf16_t* dst = HB + (size_t)r * D;
                for (int k = 0; k < D; k += 2) *(unsigned*)(dst + k) = pk2(src[k] * rs * w[k] * (1.0f + md[D + k]) + md[k], src[k + 1] * rs * w[k + 1] * (1.0f + md[D + k + 1]) + md[k + 1]);
            }
            GSYNC();
        }
        {
            PHASE_BEGIN();
            pg8::Gemm g{HB, WIN_T, NTOK, IN_PAD, D, 0, 0}; pg8::StaticOrder so; so.init(NTOK, IN_PAD, G, bid);
            pg8::EpiF32 E{PB, IN_COLS, IN_COLS};
            pg8::gemm_phase<pg8::EpiF32, pg8::StaticOrder, true, true>(ldsb, g, so, E);
            GSYNC();
        }
        {
            PHASE_BEGIN();
            const float* cw = kp_->in[I_CONVW] + (size_t)l * 3 * 768; const float* cb = kp_->in[I_CONVB] + (size_t)l * 768;
            ITEMS(i, NTOK * 768) {
                const int c = i % 768, r = i / 768;
                const bool lat = r < NLAT; const int L = lat ? S : CTX; const int t = lat ? r % S : (r - NLAT) % CTX;
                const float* u = PB + (size_t)r * IN_COLS + C_XBC + c;
                float acc = cb[c] + cw[768 + c] * u[0];
                if (t > 0) acc += cw[c] * u[-IN_COLS];
                if (t < L - 1) acc += cw[2 * 768 + c] * u[IN_COLS];
                XBC[i] = siluf(acc);
            }
            const float* dtb = kp_->in[I_DTB] + l * 16;
            ITEMS(i, NTOK * 16) { const int j = i % 16, r = i / 16; DT[i] = softplusf(PB[(size_t)r * IN_COLS + C_DT + j] + dtb[j]); }
            ITEMS(i, NTOK * 16) {
                const int g = i & 15, r = i >> 4; const int hm = g & 7, isk = g >> 3;
                const bool lat = r < NLAT; const int b = lat ? r / S : (r - NLAT) / CTX, t = lat ? r % S : (r - NLAT) % CTX;
                if (!isk && !lat && !ctx_out) continue;
                const float* vp = PB + (size_t)r * IN_COLS + (isk ? C_DK : C_DQ) + hm * 32;
                float v[32];
#pragma unroll
                for (int k = 0; k < 32; ++k) v[k] = vp[k];
                if (lat) rope32(v, t);
                const float sc = isk ? 1.0f : 0.17677669529663687f * 1.4426950408889634f;
                bf16_t* dst = isk ? KD + ((size_t)(b * 8 + hm) * SK + (lat ? CTX + t : t)) * 32 : (lat ? QD + ((size_t)(b * 8 + hm) * S + t) * 32 : QDC + ((size_t)(b * 8 + hm) * CTX + t) * 32);
#pragma unroll
                for (int k = 0; k < 32; k += 8) *(uint4*)(dst + k) = make_uint4(pk2(v[k] * sc, v[k + 1] * sc), pk2(v[k + 2] * sc, v[k + 3] * sc), pk2(v[k + 4] * sc, v[k + 5] * sc), pk2(v[k + 6] * sc, v[k + 7] * sc));
            }
            ITEMS(i, NB * 4 * 64 * SK) {
                const int j = i % SK, d = (i / SK) % 64, hh = (i / (SK * 64)) % 4, b = i / (SK * 256);
                const int r = j < CTX ? tok_row(false, b, j) : tok_row(true, b, j - CTX);
                VDT[i] = (bf16_t)f2bf(PB[(size_t)r * IN_COLS + C_DV + hh * 64 + d]);
            }
            const float* qn = kp_->in[I_QNORM] + l * 192; const float* kvn = kp_->in[I_KVNORM] + l * 128;
            ITEMS(i, NTOK * 2) {
                const int which = i & 1, r = i >> 1; const int n = which ? 128 : 192;
                const float* v = PB + (size_t)r * IN_COLS + (which ? C_CKV : C_CQ); const float* w = which ? kvn : qn;
                float ss = 0.f; for (int k = 0; k < n; ++k) ss += v[k] * v[k];
                const float rs = 1.0f / sqrtf(ss / n + EPS);
                bf16_t* dst = which ? CKVB + (size_t)r * 128 : CQB + (size_t)r * 256;
                for (int k = 0; k < n; k += 2) *(unsigned*)(dst + k) = pk2(v[k] * rs * w[k], v[k + 1] * rs * w[k + 1]);
                if (!which) for (int k = 192; k < 256; k += 2) *(unsigned*)(dst + k) = 0u;
            }
            GSYNC();
        }
        {
            PHASE_BEGIN();
            const int half = G / 2;
            if (bid < half) {
                pg8::Gemm g{CQB, WQ_T, NTOK, 512, 256, 0, 0}; pg8::StaticOrder so; so.init(NTOK, 512, half, bid);
                pg8::EpiF32 E{MQ, 384, 384};
                pg8::gemm_phase<pg8::EpiF32, pg8::StaticOrder, true, true>(ldsb, g, so, E);
            } else {
                pg8::Gemm g{CKVB, WKV_T, NTOK, 512, 128, 0, 0}; pg8::StaticOrder so; so.init(NTOK, 512, G - half, bid - half);
                pg8::EpiF32 E{MKV, 512, 512};
                pg8::gemm_phase<pg8::EpiF32, pg8::StaticOrder, true, true>(ldsb, g, so, E);
            }
            const float* alog = kp_->in[I_ALOG] + l * 16; const float* dsk = kp_->in[I_SSDD] + l * 8;
            ITEMS(i, NB * 8 * 64) {
                const int pp = i % 64, hh = (i / 64) % 8, b = i / 512, g = hh / 4;
                float hst[64];
                const float ds = dsk[hh];
                for (int dir = 0; dir < 2; ++dir) {
                    const float a = -expf(alog[dir * 8 + hh]);
#pragma unroll
                    for (int n = 0; n < 64; ++n) hst[n] = 0.f;
                    for (int seg = 0; seg < 2; ++seg) {
                        const bool lat = seg == 1; const int L = lat ? S : CTX; const bool wr = lat || ctx_out;
                        for (int tt = 0; tt < L; ++tt) {
                            const int t = dir ? L - 1 - tt : tt; const int r = tok_row(lat, b, t);
                            const float dt = DT[r * 16 + dir * 8 + hh], dec = expf(dt * a);
                            const float xv = XBC[(size_t)r * 768 + hh * 64 + pp], xdt = xv * dt;
                            const float* Bv = XBC + (size_t)r * 768 + 512 + g * 64; const float* Cv = Bv + 128;
                            float y = 0.f;
#pragma unroll
                            for (int n = 0; n < 64; ++n) { hst[n] = dec * hst[n] + xdt * Bv[n]; y += hst[n] * Cv[n]; }
                            if (wr) { float* o = YS + (size_t)r * 512 + hh * 64 + pp; if (dir == 0) *o = ds * xv + y; else *o += y; }
                        }
                    }
                }
            }
            GSYNC();
        }
        {
            PHASE_BEGIN();
            ITEMS(i, NTOK * 8) {
                const int g = i & 7, r = i >> 3; const int hh = g & 3, isk = g >> 2;
                const bool lat = r < NLAT; const int b = lat ? r / S : (r - NLAT) / CTX, t = lat ? r % S : (r - NLAT) % CTX;
                if (!isk && !lat && !ctx_out) continue;
                const float* np = isk ? MKV + (size_t)r * 512 + hh * 128 : MQ + (size_t)r * 384 + hh * 96;
                const float* rp = isk ? PB + (size_t)r * IN_COLS + C_KR : np + 64;
                float v[32];
#pragma unroll
                for (int k = 0; k < 32; ++k) v[k] = rp[k];
                if (lat) rope32(v, t);
                const float sc = isk ? 1.0f : 0.10206207261596575f * 1.4426950408889634f;
                bf16_t* dst = isk ? KM + ((size_t)(b * 4 + hh) * SK + (lat ? CTX + t : t)) * 96 : (lat ? QM + ((size_t)(b * 4 + hh) * S + t) * 96 : QMC + ((size_t)(b * 4 + hh) * CTX + t) * 96);
#pragma unroll
                for (int k = 0; k < 64; k += 8) *(uint4*)(dst + k) = make_uint4(pk2(np[k] * sc, np[k + 1] * sc), pk2(np[k + 2] * sc, np[k + 3] * sc), pk2(np[k + 4] * sc, np[k + 5] * sc), pk2(np[k + 6] * sc, np[k + 7] * sc));
#pragma unroll
                for (int k = 0; k < 32; k += 8) *(uint4*)(dst + 64 + k) = make_uint4(pk2(v[k] * sc, v[k + 1] * sc), pk2(v[k + 2] * sc, v[k + 3] * sc), pk2(v[k + 4] * sc, v[k + 5] * sc), pk2(v[k + 6] * sc, v[k + 7] * sc));
            }
            ITEMS(i, NB * 4 * 64 * SK) {
                const int j = i % SK, d = (i / SK) % 64, hh = (i / (SK * 64)) % 4, b = i / (SK * 256);
                const int r = j < CTX ? tok_row(false, b, j) : tok_row(true, b, j - CTX);
                VMT[i] = (bf16_t)f2bf(MKV[(size_t)r * 512 + hh * 128 + 64 + d]);
            }
            GSYNC();
        }
        {
            PHASE_BEGIN();
            const float* nw = kp_->in[I_SSDN] + l * 512;
            ITEMS(i, nrows_out * 2) {
                const int g = i & 1, r = i >> 1;
                const float* y = YS + (size_t)r * 512 + g * 256; const float* z = PB + (size_t)r * IN_COLS + C_Z + g * 256;
                float ss = 0.f; for (int k = 0; k < 256; ++k) { const float v = y[k] * siluf(z[k]); ss += v * v; }
                const float rs = 1.0f / sqrtf(ss / 256 + EPS);
                bf16_t* o = MIXB + (size_t)r * MIXW + g * 256;
                for (int k = 0; k < 256; k += 2) *(unsigned*)(o + k) = pk2(y[k] * siluf(z[k]) * rs * nw[g * 256 + k], y[k + 1] * siluf(z[k + 1]) * rs * nw[g * 256 + k + 1]);
            }
            const int lane = tid & 63, wave = tid >> 6, qr = lane & 31, hf = lane >> 5;
            {
                const float* lq1 = kp_->in[I_LQ1] + l * 32; const float* lk1 = kp_->in[I_LK1] + l * 32; const float* lq2 = kp_->in[I_LQ2] + l * 32; const float* lk2 = kp_->in[I_LK2] + l * 32;
                float d1 = 0.f, d2 = 0.f; for (int k = 0; k < 32; ++k) { d1 += lq1[k] * lk1[k]; d2 += lq2[k] * lk2[k]; }
                const float lam = expf(d1) - expf(d2) + lambda_init;
                const float* subw = kp_->in[I_SUBLN] + l * 64;
                const int nlat = NB * 4 * (S / 256), nit = nlat + (ctx_out ? NB * 4 : 0);
                for (int it = bid; it < nit; it += G) {
                    const bool lat = it < nlat; const int u = lat ? it : it - nlat;
                    const int qb = lat ? u % (S / 256) : 0, hh = lat ? (u / (S / 256)) % 4 : u % 4, b = lat ? u / (4 * (S / 256)) : u / 4;
                    const int t = qb * 256 + wave * 32 + qr; const int row = tok_row(lat, b, t); const int nkt = lat ? SK / 64 : CTX / 64;
                    f32x16 o1[2], oacc[2]; float lsum1 = 0.f;
#pragma unroll
                    for (int mp = 0; mp < 2; ++mp) {
                        const int hm = hh * 2 + mp;
                        const bf16_t* qrow = lat ? QD + ((size_t)(b * 8 + hm) * S + t) * 32 : QDC + ((size_t)(b * 8 + hm) * CTX + t) * 32;
                        float m_run = -1e30f, l_run = 0.f;
#pragma unroll
                        for (int i = 0; i < 16; ++i) { oacc[0][i] = 0.f; oacc[1][i] = 0.f; }
                        attn_pass<32>(qrow, KD + (size_t)(b * 8 + hm) * SK * 32, VDT + (size_t)(b * 4 + hh) * 64 * SK, SK, nkt, ldsb, tid, oacc, m_run, l_run);
                        l_run += __shfl_xor(l_run, 32);
                        if (mp == 0) { o1[0] = oacc[0]; o1[1] = oacc[1]; lsum1 = l_run; }
                        else {
                            const float i1 = 1.0f / lsum1, i2 = lam / l_run; float ss = 0.f;
#pragma unroll
                            for (int db = 0; db < 2; ++db)
#pragma unroll
                                for (int i = 0; i < 16; ++i) { const float v = o1[db][i] * i1 - oacc[db][i] * i2; o1[db][i] = v; ss += v * v; }
                            ss += __shfl_xor(ss, 32);
                            const float rs = (1.0f - lambda_init) / sqrtf(ss / 64 + EPS);
                            bf16_t* orow = MIXB + (size_t)row * MIXW + 512 + hh * 64;
#pragma unroll
                            for (int db = 0; db < 2; ++db)
#pragma unroll
                                for (int gq = 0; gq < 4; ++gq) { const int d0 = 32 * db + 8 * gq + 4 * hf; const float4 w4 = *(const float4*)(subw + d0);
                                    *(uint2*)(orow + d0) = make_uint2(pk2(o1[db][4 * gq] * rs * w4.x, o1[db][4 * gq + 1] * rs * w4.y), pk2(o1[db][4 * gq + 2] * rs * w4.z, o1[db][4 * gq + 3] * rs * w4.w)); }
                        }
                    }
                }
            }
            {
                const int nlat = NB * 4 * (S / 256), nit = nlat + (ctx_out ? NB * 4 : 0);
                for (int it = bid; it < nit; it += G) {
                    const bool lat = it < nlat; const int u = lat ? it : it - nlat;
                    const int qb = lat ? u % (S / 256) : 0, hh = lat ? (u / (S / 256)) % 4 : u % 4, b = lat ? u / (4 * (S / 256)) : u / 4;
                    const int t = qb * 256 + wave * 32 + qr; const int row = tok_row(lat, b, t); const int nkt = lat ? SK / 64 : CTX / 64;
                    const bf16_t* qrow = lat ? QM + ((size_t)(b * 4 + hh) * S + t) * 96 : QMC + ((size_t)(b * 4 + hh) * CTX + t) * 96;
                    f32x16 oacc[2]; float m_run = -1e30f, l_run = 0.f;
#pragma unroll
                    for (int i = 0; i < 16; ++i) { oacc[0][i] = 0.f; oacc[1][i] = 0.f; }
                    attn_pass<96>(qrow, KM + (size_t)(b * 4 + hh) * SK * 96, VMT + (size_t)(b * 4 + hh) * 64 * SK, SK, nkt, ldsb, tid, oacc, m_run, l_run);
                    l_run += __shfl_xor(l_run, 32);
                    const float inv = 1.0f / l_run;
                    bf16_t* orow = MIXB + (size_t)row * MIXW + 768 + hh * 64;
#pragma unroll
                    for (int db = 0; db < 2; ++db)
#pragma unroll
                        for (int gq = 0; gq < 4; ++gq) { const int d0 = 32 * db + 8 * gq + 4 * hf;
                            *(uint2*)(orow + d0) = make_uint2(pk2(oacc[db][4 * gq] * inv, oacc[db][4 * gq + 1] * inv), pk2(oacc[db][4 * gq + 2] * inv, oacc[db][4 * gq + 3] * inv)); }
                }
            }
            GSYNC();
        }
        {
            PHASE_BEGIN();
            pg8::Gemm g{MIXB, WOUT_T, nrows_out, D, MIXW, 0, 0}; pg8::StaticOrder so; so.init(nrows_out, D, G, bid);
            pg8::EpiF32 E{MOUT, D, D};
            pg8::gemm_phase<pg8::EpiF32, pg8::StaticOrder, true, true>(ldsb, g, so, E);
            GSYNC();
        }
        {
            PHASE_BEGIN();
            const float* wpost = kp_->in[I_NMPOST] + l * D; const float* wpre = kp_->in[I_NFPRE] + l * D;
            const float* rw = kp_->in[I_RW] + (size_t)l * D * NE; const float* rb = kp_->in[I_RB] + l * NE;
            ITEMS(r, nrows_out) {
                float* xr = r < NLAT ? xcur + (size_t)r * D : CTXC + (size_t)(r - NLAT) * D;
                const float* md = modl + (size_t)(r < NLAT ? r / S : NB) * NMOD * D;
                const float* m = MOUT + (size_t)r * D;
                float ss = 0.f; for (int k = 0; k < D; ++k) ss += m[k] * m[k];
                const float rs = 1.0f / sqrtf(ss / D + EPS);
                float s2 = 0.f;
                for (int k = 0; k < D; ++k) { const float v = xr[k] + md[2 * D + k] * (m[k] * rs * wpost[k]); xr[k] = v; s2 += v * v; }
                const float r2 = 1.0f / sqrtf(s2 / D + EPS);
                float lg[NE];
#pragma unroll
                for (int e = 0; e < NE; ++e) lg[e] = rb[e];
                bf16_t* hr = HB + (size_t)r * D;
                for (int k = 0; k < D; ++k) {
                    const float hv = xr[k] * r2 * wpre[k] * (1.0f + md[4 * D + k]) + md[3 * D + k]; hr[k] = (bf16_t)f2bf(hv);
#pragma unroll
                    for (int e = 0; e < NE; ++e) lg[e] += hv * rw[k * NE + e];
                }
                float mx = lg[0];
#pragma unroll
                for (int e = 1; e < NE; ++e) mx = fmaxf(mx, lg[e]);
                float sum = 0.f;
#pragma unroll
                for (int e = 0; e < NE; ++e) { lg[e] = expf(lg[e] - mx); sum += lg[e]; }
                const float is = 1.0f / sum;
#pragma unroll
                for (int e = 0; e < NE; ++e) AFF[(size_t)r * NE + e] = lg[e] * is;
            }
            GSYNC();
        }
        {
            PHASE_BEGIN();
            {
                float* tile = (float*)lds_raw; int tc = 0;
                auto idm = [](int n) { return n; };
                for (int e = 0; e < NE; ++e) {
                    cvt_transpose(kp_->in[I_WG] + ((size_t)l * NE + e) * D * FF, D, FF, WGU_T + (size_t)e * 2 * FF * D, D, [](int n) { return (n >> 2) * 8 + (n & 3); }, tile, tc, tc, tid);
                    cvt_transpose(kp_->in[I_WU] + ((size_t)l * NE + e) * D * FF, D, FF, WGU_T + (size_t)e * 2 * FF * D, D, [](int n) { return (n >> 2) * 8 + 4 + (n & 3); }, tile, tc, tc, tid);
                    cvt_transpose(kp_->in[I_WD] + ((size_t)l * NE + e) * FF * D, FF, D, WD_T + (size_t)e * D * FF, FF, idm, tile, tc, tc, tid);
                }
                __syncthreads();
            }
            for (int set = 0; set < (ctx_out ? 2 : 1); ++set) {
                const bool lat = set == 0; const int L = lat ? S : CTX; const int cap = lat ? CAP_L : CAP_C;
                ITEMS(i, NB * NE * L) {
                    const int t = i % L, e = (i / L) % NE, b = i / (NE * L);
                    const int base = tok_row(lat, b, 0);
                    const float a = AFF[(size_t)(base + t) * NE + e];
                    int rank = 0;
                    for (int j = 0; j < L; ++j) { const float aj = AFF[(size_t)(base + j) * NE + e]; rank += (aj > a || (aj == a && j < t)) ? 1 : 0; }
                    int slot = -1;
                    if (rank < cap) { slot = lat ? b * CAP_L + rank : NB * CAP_L + b * CAP_C + rank; SELIDX[e * ER_MAX + slot] = base + t; SELGATE[e * ER_MAX + slot] = a; }
                    TOKSLOT[(size_t)(base + t) * NE + e] = slot;
                }
            }
            GSYNC();
        }
        {
            PHASE_BEGIN();
            const int used = ctx_out ? NB * (CAP_L + CAP_C) : NB * CAP_L;
            ITEMS(i, NE * ER * (D / 8)) {
                const int c8 = i % (D / 8), slot = (i / (D / 8)) % ER, e = i / ((D / 8) * ER);
                uint4 v = make_uint4(0, 0, 0, 0);
                if (slot < used) v = *(const uint4*)(HB + (size_t)SELIDX[e * ER_MAX + slot] * D + c8 * 8);
                *(uint4*)(XG + ((size_t)e * ER + slot) * D + c8 * 8) = v;
            }
            GSYNC();
        }
        {
            PHASE_BEGIN();
            pg8::Gemm g{XG, WGU_T, NE * ER, 2 * FF, D, ER / 256, (size_t)2 * FF * D * 2}; pg8::StaticOrder so; so.init(NE * ER, 2 * FF, G, bid);
            pg8::EpiSwiGLU E{HID, FF};
            pg8::gemm_phase<pg8::EpiSwiGLU, pg8::StaticOrder, true, true>(ldsb, g, so, E);
            GSYNC();
        }
        {
            PHASE_BEGIN();
            pg8::Gemm g{HID, WD_T, NE * ER, D, FF, ER / 256, (size_t)D * FF * 2}; pg8::StaticOrder so; so.init(NE * ER, D, G, bid);
            pg8::EpiRowScaleF32 E{Y, D, SELGATE, ER};
            pg8::gemm_phase<pg8::EpiRowScaleF32, pg8::StaticOrder, true, true>(ldsb, g, so, E);
            GSYNC();
        }
        {
            PHASE_BEGIN();
            const float* wpost = kp_->in[I_NFPOST] + l * D;
            ITEMS(r, nrows_out) {
                float* xr = r < NLAT ? xcur + (size_t)r * D : CTXC + (size_t)(r - NLAT) * D;
                const float* md = modl + (size_t)(r < NLAT ? r / S : NB) * NMOD * D;
                int sl[NE];
#pragma unroll
                for (int e = 0; e < NE; ++e) sl[e] = TOKSLOT[(size_t)r * NE + e];
                float ss = 0.f;
                for (int k = 0; k < D; ++k) {
                    float f = 0.f;
#pragma unroll
                    for (int e = 0; e < NE; ++e) if (sl[e] >= 0) f += Y[((size_t)e * ER + sl[e]) * D + k];
                    ss += f * f;
                }
                const float rs = 1.0f / sqrtf(ss / D + EPS);
                for (int k = 0; k < D; ++k) {
                    float f = 0.f;
#pragma unroll
                    for (int e = 0; e < NE; ++e) if (sl[e] >= 0) f += Y[((size_t)e * ER + sl[e]) * D + k];
                    xr[k] += md[5 * D + k] * (f * rs * wpost[k]);
                }
            }
            GSYNC();
        }
    }
}

extern "C" void kernel_launch(void* const* d_in, const int* in_sizes, int n_in, void* d_out, int out_size, void* d_ws, size_t ws_size, hipStream_t stream) {
    static int grid = 0;
    if (grid == 0) {
        if (n_in != N_IN || out_size != NLAT * D || ws_size < WS_END) { fprintf(stderr, "kernel_launch: unexpected shapes: n_in %d out %d ws %zu (need %zu)\n", n_in, out_size, ws_size, (size_t)WS_END); grid = -1; return; }
        int dev = 0, cus = 0, per_cu = 0;
        (void)hipGetDevice(&dev);
        (void)hipDeviceGetAttribute(&cus, hipDeviceAttributeMultiprocessorCount, dev);
        (void)hipFuncSetAttribute((const void*)mk_forward, hipFuncAttributeMaxDynamicSharedMemorySize, LDS_BYTES);
        (void)hipOccupancyMaxActiveBlocksPerMultiprocessor(&per_cu, (const void*)mk_forward, NTHREADS, LDS_BYTES);
        (void)hipGetLastError();
        if (per_cu < 1) { fprintf(stderr, "kernel_launch: occupancy query says %d blocks/CU\n", per_cu); grid = -1; return; }
        grid = cus;
    }
    if (grid < 0) return;
    (void)hipMemsetAsync((char*)d_ws + WS_CTL, 0, CTL_BYTES, stream);
    Prm p{};
    for (int i = 0; i < N_IN; ++i) p.in[i] = (const float*)d_in[i];
    p.out = (float*)d_out; p.ws = (char*)d_ws;
    void* args[] = {&p};
    hipError_t e = hipLaunchCooperativeKernel((const void*)mk_forward, dim3(grid), dim3(NTHREADS), args, LDS_BYTES, stream);
    if (e != hipSuccess) fprintf(stderr, "kernel_launch: cooperative launch failed: %s (grid %d)\n", hipGetErrorString(e), grid);
}
```

```cpp
#include <hip/hip_runtime.h>
#include <cstdio>
#include <cstdint>

constexpr int D = 1024, NB = 4, S = 4096, CTX = 256, FF = 1024;
constexpr int DEPTH = 2, GRID_W = 64, NMOD = 6, NE = 16;
constexpr int NLAT = NB * S, NCTX = NB * CTX, NTOK = NLAT + NCTX;
constexpr int IN_COLS = 2416, IN_PAD = 2560;
constexpr int C_Z = 0, C_XBC = 512, C_DT = 1280, C_DQ = 1296, C_DK = 1552, C_DV = 1808, C_CQ = 2064, C_CKV = 2256, C_KR = 2384;
constexpr int MIXW = 1024;
constexpr int CAP_L = 2 * S / NE, CAP_C = 2 * CTX / NE;
constexpr int ER_MAX = 2304;
constexpr float EPS = 1e-6f;
static_assert(NB * CAP_L == 2048 && NB * CAP_C == 128, "expert row layout");

enum { I_X = 0, I_C, I_CTX, I_CCTX, I_ADAW, I_ADAB, I_NMPRE, I_NMPOST, I_NFPRE, I_NFPOST, I_WIN, I_CONVW, I_CONVB, I_ALOG, I_DTB, I_SSDD, I_SSDN,
       I_LQ1, I_LK1, I_LQ2, I_LK2, I_SUBLN, I_QNORM, I_WQUP, I_KVNORM, I_WKVUP, I_WOUT, I_RW, I_RB, I_WG, I_WU, I_WD, N_IN };
struct Prm { const float* in[N_IN]; float* out; char* ws; };

typedef unsigned short bf16_t;
constexpr size_t al256(size_t x) { return (x + 255) & ~(size_t)255; }
constexpr size_t WS_CTL = 0, CTL_BYTES = 65536;
constexpr size_t WS_MOD = WS_CTL + CTL_BYTES;
constexpr size_t WS_CTXC = al256(WS_MOD + (size_t)DEPTH * (NB + 1) * NMOD * D * 4);
constexpr size_t WS_AFF = al256(WS_CTXC + (size_t)NCTX * D * 4);
constexpr size_t WS_TOKSLOT = al256(WS_AFF + (size_t)NTOK * NE * 4);
constexpr size_t WS_SELIDX = al256(WS_TOKSLOT + (size_t)NTOK * NE * 4);
constexpr size_t WS_SELGATE = al256(WS_SELIDX + (size_t)NE * ER_MAX * 4);
constexpr size_t WS_DT = al256(WS_SELGATE + (size_t)NE * ER_MAX * 4);
constexpr int NCH = 34;
constexpr size_t WS_ALAST = al256(WS_DT + (size_t)NTOK * 16 * 4);
constexpr size_t WS_HB = al256(WS_ALAST + (size_t)NB * 2 * NCH * 8 * 4);
constexpr size_t WS_P = al256(WS_HB + (size_t)NTOK * D * 2);
constexpr size_t WS_G2 = al256(WS_P + (size_t)NTOK * IN_COLS * 4);
constexpr size_t WS_XBC = WS_G2;
constexpr size_t WS_MQ = al256(WS_XBC + (size_t)NTOK * 768 * 4);
constexpr size_t WS_MKV = al256(WS_MQ + (size_t)NTOK * 384 * 4);
constexpr size_t WS_CQB = al256(WS_MKV + (size_t)NTOK * 512 * 4);
constexpr size_t WS_CKVB = al256(WS_CQB + (size_t)NTOK * 256 * 2);
constexpr size_t WS_MIXB = al256(WS_CKVB + (size_t)NTOK * 128 * 2);
constexpr size_t WS_G2END = al256(WS_MIXB + (size_t)NTOK * MIXW * 2);
constexpr size_t WS_HS = WS_HB;
constexpr size_t WS_YD = WS_MQ;
constexpr size_t WS_MOUT = WS_P;
constexpr size_t WS_XG = WS_P;
constexpr size_t WS_HID = al256(WS_XG + (size_t)NE * ER_MAX * D * 2);
constexpr size_t WS_Y = WS_G2;
constexpr size_t WS_WIN = WS_G2END;
constexpr size_t WS_WQ = al256(WS_WIN + (size_t)IN_PAD * D * 2);
constexpr size_t WS_WKV = al256(WS_WQ + (size_t)512 * 256 * 2);
constexpr size_t WS_WOUT = al256(WS_WKV + (size_t)512 * 128 * 2);
constexpr size_t WS_WGU = al256(WS_WOUT + (size_t)D * MIXW * 2);
constexpr size_t WS_WD = al256(WS_WGU + (size_t)NE * 2 * FF * D * 2);
constexpr size_t WS_END = al256(WS_WD + (size_t)NE * D * FF * 2);
constexpr int SK = CTX + S;
constexpr size_t WS_QD = WS_WGU;
constexpr size_t WS_QDC = al256(WS_QD + (size_t)NB * 8 * S * 32 * 2);
constexpr size_t WS_KD = al256(WS_QDC + (size_t)NB * 8 * CTX * 32 * 2);
constexpr size_t WS_VDT = al256(WS_KD + (size_t)NB * 8 * SK * 32 * 2);
constexpr size_t WS_QM = al256(WS_VDT + (size_t)NB * 4 * 64 * SK * 2);
constexpr size_t WS_QMC = al256(WS_QM + (size_t)NB * 4 * S * 96 * 2);
constexpr size_t WS_KM = al256(WS_QMC + (size_t)NB * 4 * CTX * 96 * 2);
constexpr size_t WS_VMT = al256(WS_KM + (size_t)NB * 4 * SK * 96 * 2);
constexpr size_t WS_ATTEND = al256(WS_VMT + (size_t)NB * 4 * 64 * SK * 2);
static_assert(WS_ATTEND <= WS_END, "attention operands fit in the MoE weight region");
static_assert(WS_HID + (size_t)NE * ER_MAX * FF * 2 <= WS_G2, "XG+HID fit in the P region");
static_assert((size_t)NE * ER_MAX * D * 4 <= WS_G2END - WS_G2, "Y fits in the G2 region");
static_assert((size_t)NB * 2 * NCH * 8 * 4096 * 4 <= (size_t)NTOK * D * 2, "HS fits in HB");
static_assert(WS_YD + (size_t)2 * NTOK * 512 * 4 <= WS_MIXB, "YD ends below MIXB");

#define LAS __attribute__((address_space(3)))
constexpr int NTHREADS = 512;
constexpr int LDS_BYTES = 147456;
#define ITEMS(i, n) for (int i = blockIdx.x * NTHREADS + tid; i < (n); i += gridDim.x * NTHREADS)

__device__ __forceinline__ float siluf(float x) { return x / (1.0f + expf(-x)); }
__device__ __forceinline__ float softplusf(float x) { return x > 20.f ? x : log1pf(expf(x)); }
__device__ __forceinline__ unsigned f2bf(float f) { unsigned u = __builtin_bit_cast(unsigned, f); return (u + 0x7fffu + ((u >> 16) & 1u)) >> 16; }
__device__ __forceinline__ unsigned pk2(float lo, float hi) { return f2bf(lo) | (f2bf(hi) << 16); }
__device__ __forceinline__ float bf2f(bf16_t h) { return __builtin_bit_cast(float, (unsigned)h << 16); }
#define SCHED_FENCE() __builtin_amdgcn_sched_barrier(0)
__device__ __forceinline__ float wave_sum(float v) {
#pragma unroll
    for (int o = 32; o > 0; o >>= 1) v += __shfl_xor(v, o);
    return v; }
#define WITEMS(i, n) for (int i = blockIdx.x * 8 + (tid >> 6); i < (n); i += gridDim.x * 8)
__device__ __forceinline__ float4 f4mul(float4 a, float4 b) { return make_float4(a.x * b.x, a.y * b.y, a.z * b.z, a.w * b.w); }
__device__ __forceinline__ float4 f4add(float4 a, float4 b) { return make_float4(a.x + b.x, a.y + b.y, a.z + b.z, a.w + b.w); }
__device__ __forceinline__ float4 f4scale(float4 a, float s) { return make_float4(a.x * s, a.y * s, a.z * s, a.w * s); }
__device__ __forceinline__ float f4dot(float4 a, float4 b) { return a.x * b.x + a.y * b.y + a.z * b.z + a.w * b.w; }
__device__ __forceinline__ uint2 pk4(float4 v) { return make_uint2(pk2(v.x, v.y), pk2(v.z, v.w)); }

__device__ __forceinline__ void rope32(float* v, int t) {
    const float prow = (float)(t / GRID_W), pcol = (float)(t % GRID_W);
#pragma unroll
    for (int i = 0; i < 8; ++i) {
        const float inv = powf(10000.0f, -(float)i / 8.0f);
        { const float ang = prow * inv, c = cosf(ang), s = sinf(ang); const float x1 = v[i], x2 = v[8 + i]; v[i] = x1 * c - x2 * s; v[8 + i] = x1 * s + x2 * c; }
        { const float ang = pcol * inv, c = cosf(ang), s = sinf(ang); const float x1 = v[16 + i], x2 = v[24 + i]; v[16 + i] = x1 * c - x2 * s; v[24 + i] = x1 * s + x2 * c; }
    }
}
__device__ __forceinline__ int tok_row(bool lat, int b, int t) { return lat ? b * S + t : NLAT + b * CTX + t; }

namespace pg8 {
#define PG8_LAS __attribute__((address_space(3)))
typedef short bf16x8 __attribute__((ext_vector_type(8)));
typedef float f32x4 __attribute__((ext_vector_type(4)));
typedef unsigned u32x4 __attribute__((ext_vector_type(4)));
constexpr int BM = 256, BK = 64, HALF = 128, HTB = HALF * BK * 2  , STAGE_BYTES = 8 * HTB, NXCD = 8, WGM = 8;

__host__ __device__ __forceinline__ int lds_byte(int r, int c) { const int st = (r >> 4) * 2 + (c >> 5), rr = r & 15, cc = c & 31, ob = rr * 64 + cc * 2; return st * 1024 + (ob ^ (((ob >> 9) & 1) << 5)); }
__host__ __device__ __forceinline__ void stage_rc(int b, int& R, int& C) { const int st = b / 1024, sb = b % 1024, swz = sb ^ (((sb >> 9) & 1) << 5); R = (st >> 1) * 16 + swz / 64; C = (st & 1) * 32 + (swz % 64) / 2; }
__host__ __device__ __forceinline__ int perm32(int rho) { const int n = rho >> 4, i = rho & 15; return 8 * (i >> 2) + 4 * n + (i & 3); }

struct Unit { int pm, pn; };
struct Gemm { const bf16_t* A; const bf16_t* Bt; int M, N, K; int grp_tiles; size_t grp_stride; };

struct StaticOrder {
    int nM, nN, nwg, G, c;
    __host__ __device__ void init(int M, int N, int G_, int c_) { nM = M / BM; nN = N / BM; nwg = nM * nN; G = G_; c = c_; }
    __host__ __device__ bool next(int i, Unit& u) const {
        const long L = (long)i * G + c; if (L >= nwg) return false;
        int wgid = (int)L; { const int q = nwg / NXCD, r = nwg % NXCD, xcd = wgid % NXCD, off = wgid / NXCD; wgid = (xcd < r ? xcd * (q + 1) : r * (q + 1) + (xcd - r) * q) + off; }
        const int nig = WGM * nN, gid = wgid / nig, fm = gid * WGM, gsz = (nM - fm) < WGM ? (nM - fm) : WGM;
        u.pm = fm + ((wgid % nig) % gsz); u.pn = (wgid % nig) / gsz; return true;
    }
    __device__ __forceinline__ void a_ready(const Unit&) const {}
    __device__ __forceinline__ void done(const Unit&) const {}
};

__device__ __forceinline__ unsigned cvt_pk_bf16(float lo, float hi) { unsigned r; asm volatile("v_cvt_pk_bf16_f32 %0, %1, %2" : "=v"(r) : "v"(lo), "v"(hi)); return r; }

typedef unsigned u32x2 __attribute__((ext_vector_type(2)));
struct EpiF32 {
    static constexpr bool PERM = false, AFTER_DRAIN = false;
    float* C; int ldc; int ncols;
    __device__ __forceinline__ void operator()(const f32x4 (&acc)[2][2][4][2], const Unit& u, int wr, int wc, int fr, int fq) const {
        const int row0 = u.pm * BM + wr * 64 + fr, col0 = u.pn * BM + wc * 32 + 4 * fq;
#pragma unroll
        for (int ai = 0; ai < 2; ++ai)
#pragma unroll
            for (int m = 0; m < 4; ++m) { float* rowp = C + (size_t)(row0 + ai * HALF + m * 16) * ldc;
#pragma unroll
                for (int bj = 0; bj < 2; ++bj)
#pragma unroll
                    for (int n = 0; n < 2; ++n) { const int col = col0 + bj * HALF + n * 16; if (col < ncols) *(f32x4*)(rowp + col) = acc[ai][bj][m][n]; } }
    }
};
struct EpiRowScaleF32 {
    static constexpr bool PERM = false, AFTER_DRAIN = false;
    float* C; int ldc; const float* gate; int er;
    __device__ __forceinline__ void operator()(const f32x4 (&acc)[2][2][4][2], const Unit& u, int wr, int wc, int fr, int fq) const {
        const int row0 = u.pm * BM + wr * 64 + fr, col0 = u.pn * BM + wc * 32 + 4 * fq;
#pragma unroll
        for (int ai = 0; ai < 2; ++ai)
#pragma unroll
            for (int m = 0; m < 4; ++m) { const int row = row0 + ai * HALF + m * 16; float* rowp = C + (size_t)row * ldc; const float sc = gate[(row / er) * ER_MAX + row % er];
#pragma unroll
                for (int bj = 0; bj < 2; ++bj)
#pragma unroll
                    for (int n = 0; n < 2; ++n) *(f32x4*)(rowp + col0 + bj * HALF + n * 16) = acc[ai][bj][m][n] * sc; }
    }
};
struct EpiSwiGLU {
    static constexpr bool PERM = true, AFTER_DRAIN = false;
    bf16_t* O; int ldo;
    __device__ __forceinline__ void operator()(const f32x4 (&acc)[2][2][4][2], const Unit& u, int wr, int wc, int fr, int fq) const {
        const int row0 = u.pm * BM + wr * 64 + fr, col0 = u.pn * BM + wc * 32 + 8 * fq;
#pragma unroll
        for (int ai = 0; ai < 2; ++ai)
#pragma unroll
            for (int m = 0; m < 4; ++m) { bf16_t* rowp = O + (size_t)(row0 + ai * HALF + m * 16) * ldo;
#pragma unroll
                for (int bj = 0; bj < 2; ++bj) { const f32x4 gt = acc[ai][bj][m][0], up = acc[ai][bj][m][1]; f32x4 h;
#pragma unroll
                    for (int i = 0; i < 4; ++i) h[i] = gt[i] / (1.0f + __expf(-gt[i])) * up[i];
                    u32x2 w; w.x = cvt_pk_bf16(h[0], h[1]); w.y = cvt_pk_bf16(h[2], h[3]);
                    *(u32x2*)(rowp + (col0 + bj * HALF) / 2) = w; } }
    }
};
template <class Epi, class Sched, bool ALIGN_EPI = false, bool SP2 = false>
__device__ __forceinline__ void gemm_phase(PG8_LAS unsigned char* lds, const Gemm g, const Sched& S, const Epi& E) {
    int tid_ = threadIdx.x; asm volatile("" : "+v"(tid_));
    const int tid = tid_, wid = __builtin_amdgcn_readfirstlane(tid >> 6), lane = tid & 63, wr = wid >> 2, wc = wid & 3, fr = lane & 15, fq = lane >> 4;
    int K_ = g.K; asm volatile("" : "+s"(K_));
    const int K = K_, nt = K / BK;
    unsigned voffA[2], voffB[2];
#pragma unroll
    for (int i = 0; i < 2; ++i) { int R, C; stage_rc(tid * 16 + i * 8192, R, C); const int Rb = Epi::PERM ? ((R & ~31) + perm32(R & 31)) : R;
        voffA[i] = (unsigned)(R * K + C) * 2u; voffB[i] = (unsigned)(Rb * K + C) * 2u; }
    const size_t kstep = (size_t)(BK * 2);
    const size_t hstep = (size_t)HALF * K * 2;
    const size_t tstep = 2 * hstep;
    const unsigned ldsw = (unsigned)wid * 1024u;
    const int aoff = lds_byte(wr * 64 + fr, fq * 8), boff = lds_byte(wc * 32 + fr, fq * 8);
#define PG8_SA(b, h) (((b) * 2 + (h)) * HTB)
#define PG8_SB(b, h) ((4 + (b) * 2 + (h)) * HTB)
#define PG8_STAGE(bufoff, gbase, voff) do { _Pragma("unroll") for (int _i = 0; _i < 2; ++_i) \
        __builtin_amdgcn_global_load_lds((const unsigned*)((const char*)(gbase) + (voff)[_i]), (PG8_LAS unsigned*)(lds + (bufoff) + ldsw + _i * 8192), 16, 0, 0); } while (0)
#define PG8_LDA(dst, b, h) do { _Pragma("unroll") for (int m = 0; m < 4; ++m) _Pragma("unroll") for (int k = 0; k < 2; ++k) dst[m][k] = *(const PG8_LAS bf16x8*)(lds + PG8_SA(b, h) + aoff + m * 2048 + k * 1024); } while (0)
#define PG8_LDB(dst, b, h) do { _Pragma("unroll") for (int n = 0; n < 2; ++n) _Pragma("unroll") for (int k = 0; k < 2; ++k) dst[n][k] = *(const PG8_LAS bf16x8*)(lds + PG8_SB(b, h) + boff + n * 2048 + k * 1024); } while (0)
#define PG8_MMA(ai, bj, At, Bt) do { __builtin_amdgcn_s_setprio(1); _Pragma("unroll") for (int m = 0; m < 4; ++m) _Pragma("unroll") for (int n = 0; n < 2; ++n) _Pragma("unroll") for (int k = 0; k < 2; ++k) \
        acc[ai][bj][m][n] = __builtin_amdgcn_mfma_f32_16x16x32_bf16(Bt[n][k], At[m][k], acc[ai][bj][m][n], 0, 0, 0); __builtin_amdgcn_s_setprio(0); } while (0)
#define PG8_WAIT_V(n) asm volatile("s_waitcnt vmcnt(" #n ")" ::: "memory")
#define PG8_WAIT_L(n) asm volatile("s_waitcnt lgkmcnt(" #n ")" ::: "memory")
#define PG8_BAR __builtin_amdgcn_s_barrier()
#define PG8_SCHED __builtin_amdgcn_sched_barrier(0)
    Unit cur, nxt; int ui = 0;
    if (!S.next(0, cur)) return;
    f32x4 acc[2][2][4][2];
#pragma unroll
    for (int a = 0; a < 2; ++a)
#pragma unroll
        for (int b = 0; b < 2; ++b)
#pragma unroll
            for (int m = 0; m < 4; ++m)
#pragma unroll
                for (int n = 0; n < 2; ++n) acc[a][b][m][n] = (f32x4){0.f, 0.f, 0.f, 0.f};
    bf16x8 At[4][2], B0[2][2], B1[2][2];
    const char* cA = (const char*)g.A + (size_t)cur.pm * tstep; const char* cB = (const char*)g.Bt + (size_t)cur.pn * tstep + (g.grp_tiles ? (size_t)(cur.pm / g.grp_tiles) * g.grp_stride : (size_t)0);
    S.a_ready(cur);
    if constexpr (SP2) {
        PG8_STAGE(PG8_SB(0, 0), cB, voffB); PG8_STAGE(PG8_SB(0, 1), cB + hstep, voffB); PG8_STAGE(PG8_SA(0, 0), cA, voffA); PG8_STAGE(PG8_SA(0, 1), cA + hstep, voffA);
        if (wr == 1) PG8_BAR;
        PG8_WAIT_V(2); PG8_BAR;
        PG8_STAGE(PG8_SB(1, 0), cB + kstep, voffB); PG8_STAGE(PG8_SA(1, 0), cA + kstep, voffA); PG8_STAGE(PG8_SB(1, 1), cB + hstep + kstep, voffB);
        PG8_WAIT_V(6); PG8_BAR;
    } else {
        PG8_STAGE(PG8_SB(0, 0), cB, voffB); PG8_STAGE(PG8_SA(0, 0), cA, voffA); PG8_STAGE(PG8_SB(0, 1), cB + hstep, voffB); PG8_STAGE(PG8_SA(0, 1), cA + hstep, voffA);
        if (wr == 1) PG8_BAR;
        PG8_WAIT_V(4); PG8_BAR;
        PG8_STAGE(PG8_SB(1, 0), cB + kstep, voffB); PG8_STAGE(PG8_SA(1, 0), cA + kstep, voffA); PG8_STAGE(PG8_SB(1, 1), cB + hstep + kstep, voffB);
        PG8_WAIT_V(6); PG8_BAR;
    }
    for (;;) {
        const bool has_next = S.next(ui + 1, nxt);
        const char* nA = has_next ? (const char*)g.A + (size_t)nxt.pm * tstep : cA; const char* nB = has_next ? (const char*)g.Bt + (size_t)nxt.pn * tstep + (g.grp_tiles ? (size_t)(nxt.pm / g.grp_tiles) * g.grp_stride : (size_t)0) : cB;
        for (int t = 0; t < nt; t += 2) {
            const bool last = (t == nt - 2);
            const char* a1 = cA + (size_t)(t + 1) * kstep;
            const char* a2 = last ? nA : cA + (size_t)(t + 2) * kstep; const char* b2 = last ? nB : cB + (size_t)(t + 2) * kstep;
            const char* a3 = a2 + kstep; const char* b3 = b2 + kstep;
            if (last && has_next) S.a_ready(nxt);
            if constexpr (SP2) {
            PG8_LDB(B0, 0, 0); PG8_LDB(B1, 0, 1); PG8_SCHED; PG8_LDA(At, 0, 0); PG8_STAGE(PG8_SA(1, 1), a1 + hstep, voffA);
            PG8_WAIT_V(8); PG8_WAIT_L(0); PG8_BAR; PG8_MMA(0, 0, At, B0); PG8_MMA(0, 1, At, B1); PG8_BAR; PG8_SCHED;
            PG8_LDA(At, 0, 1); PG8_STAGE(PG8_SB(0, 0), b2, voffB); PG8_STAGE(PG8_SB(0, 1), b2 + hstep, voffB); PG8_STAGE(PG8_SA(0, 0), a2, voffA);
            PG8_WAIT_V(8); PG8_WAIT_L(0); PG8_BAR; PG8_MMA(1, 0, At, B0); PG8_MMA(1, 1, At, B1); PG8_BAR; PG8_SCHED;
            PG8_LDB(B0, 1, 0); PG8_LDB(B1, 1, 1); PG8_SCHED; PG8_LDA(At, 1, 0); PG8_STAGE(PG8_SA(0, 1), a2 + hstep, voffA);
            PG8_WAIT_V(8); PG8_WAIT_L(0); PG8_BAR; PG8_MMA(0, 0, At, B0); PG8_MMA(0, 1, At, B1); PG8_BAR; PG8_SCHED;
            PG8_LDA(At, 1, 1); PG8_STAGE(PG8_SB(1, 0), b3, voffB); PG8_STAGE(PG8_SB(1, 1), b3 + hstep, voffB); PG8_STAGE(PG8_SA(1, 0), a3, voffA);
            PG8_WAIT_V(8); PG8_WAIT_L(0); PG8_BAR; PG8_MMA(1, 0, At, B0); PG8_MMA(1, 1, At, B1); PG8_BAR; PG8_SCHED;
            } else {
            PG8_LDB(B0, 0, 0); PG8_SCHED; PG8_LDA(At, 0, 0); PG8_STAGE(PG8_SA(1, 1), a1 + hstep, voffA);
            PG8_WAIT_L(8); PG8_BAR; PG8_WAIT_L(0); PG8_MMA(0, 0, At, B0); PG8_BAR; PG8_SCHED;
            PG8_LDB(B1, 0, 1); PG8_STAGE(PG8_SB(0, 0), b2, voffB);
            PG8_BAR; PG8_WAIT_L(0); PG8_MMA(0, 1, At, B1); PG8_BAR;
            PG8_LDA(At, 0, 1); PG8_STAGE(PG8_SA(0, 0), a2, voffA);
            PG8_BAR; PG8_WAIT_L(0); PG8_MMA(1, 0, At, B0); PG8_BAR; PG8_SCHED;
            PG8_STAGE(PG8_SB(0, 1), b2 + hstep, voffB);
            PG8_WAIT_V(6); PG8_BAR; PG8_MMA(1, 1, At, B1); PG8_BAR;
            PG8_LDB(B0, 1, 0); PG8_SCHED; PG8_LDA(At, 1, 0); PG8_STAGE(PG8_SA(0, 1), a2 + hstep, voffA);
            PG8_WAIT_L(8); PG8_BAR; PG8_WAIT_L(0); PG8_MMA(0, 0, At, B0); PG8_BAR; PG8_SCHED;
            PG8_LDB(B1, 1, 1); PG8_STAGE(PG8_SB(1, 0), b3, voffB);
            PG8_BAR; PG8_WAIT_L(0); PG8_MMA(0, 1, At, B1); PG8_BAR;
            PG8_LDA(At, 1, 1); PG8_STAGE(PG8_SA(1, 0), a3, voffA);
            PG8_BAR; PG8_WAIT_L(0); PG8_MMA(1, 0, At, B0); PG8_BAR; PG8_SCHED;
            PG8_STAGE(PG8_SB(1, 1), b3 + hstep, voffB);
            PG8_WAIT_V(6); PG8_BAR; PG8_MMA(1, 1, At, B1); PG8_BAR;
            }
        }
        if constexpr (ALIGN_EPI) { if (wr == 0) PG8_BAR; }
        if constexpr (!Epi::AFTER_DRAIN) { E(acc, cur, wr, wc, fr, fq); S.done(cur); }
        if (!has_next) break;
#pragma unroll
        for (int a = 0; a < 2; ++a)
#pragma unroll
            for (int b = 0; b < 2; ++b)
#pragma unroll
                for (int m = 0; m < 4; ++m)
#pragma unroll
                    for (int n = 0; n < 2; ++n) acc[a][b][m][n] = (f32x4){0.f, 0.f, 0.f, 0.f};
        cur = nxt; cA = nA; cB = nB; ++ui;
        if constexpr (ALIGN_EPI) { if (wr == 1) PG8_BAR; }
    }
    PG8_WAIT_V(0);
    if constexpr (!ALIGN_EPI) { if (wr == 0) PG8_BAR; }
    PG8_BAR;
    if constexpr (Epi::AFTER_DRAIN) { E.fused(acc, cur, wr, wc, fr, fq, lds, wid, lane); S.done(cur); }
#undef PG8_SA
#undef PG8_SB
#undef PG8_STAGE
#undef PG8_LDA
#undef PG8_LDB
#undef PG8_MMA
#undef PG8_WAIT_V
#undef PG8_WAIT_L
#undef PG8_BAR
#undef PG8_SCHED
}
}


#define XB_TMO      128
#define XB_XCNT(j)  (256  + 64 * (j))
#define XB_XSUB(j)  (1280 + 64 * (j))
#define XB_XGEN(j)  (2304 + 64 * (j))
#define XB_TOP      3328
#define XB_TOPGEN   3392
#define XCD_BAR_WORDS 3456
#define XB_SPIN_CAP (1u << 22)
__device__ __forceinline__ unsigned xb_ld(unsigned* p)              { return __hip_atomic_load(p, __ATOMIC_RELAXED, __HIP_MEMORY_SCOPE_AGENT); }
__device__ __forceinline__ unsigned xb_add(unsigned* p, unsigned v) { return __hip_atomic_fetch_add(p, v, __ATOMIC_RELAXED, __HIP_MEMORY_SCOPE_AGENT); }
__device__ __forceinline__ unsigned xb_xcc_id() { return (unsigned)__builtin_amdgcn_s_getreg((3 << 11) | 20) & 0xFu; }
#define XB_SPIN(cond, bar) do { unsigned _sp = 0; while (cond) { __builtin_amdgcn_s_sleep(1); \
    if ((++_sp & 255u) == 0u) { if (xb_ld(&(bar)[XB_TMO])) break; if (_sp > XB_SPIN_CAP) { atomicAdd(&(bar)[XB_TMO], 1u); break; } } } } while (0)
struct XcdBarrier { unsigned* bar; unsigned x; volatile LAS unsigned* st; };
__device__ __forceinline__ XcdBarrier xcd_barrier_post(unsigned* bar, volatile LAS unsigned* st) {
    XcdBarrier b; b.bar = bar; b.x = xb_xcc_id(); b.st = st;
    if (threadIdx.x == 0) (void)xb_add(&bar[XB_XCNT(b.x)], 1u);
    return b;
}
__device__ __forceinline__ void xcd_barrier_complete(unsigned* bar, unsigned x, unsigned& nloc, unsigned& nx) {
    const unsigned G = gridDim.x * gridDim.y * gridDim.z;
    unsigned sum, cnt, mine, sp = 0u;
    for (;;) {
        sum = 0u; cnt = 0u; mine = 0u;
#pragma unroll
        for (unsigned j = 0; j < 16; ++j) { const unsigned c = xb_ld(&bar[XB_XCNT(j)]); sum += c; cnt += (c > 0u) ? 1u : 0u; mine = (j == x) ? c : mine; }
        if (sum == G) break;
        __builtin_amdgcn_s_sleep(1);
        if ((++sp & 255u) == 0u) { if (xb_ld(&bar[XB_TMO])) break; if (sp > XB_SPIN_CAP) { atomicAdd(&bar[XB_TMO], 1u); break; } }
    }
    nloc = mine > 0u ? mine : 1u; nx = cnt > 0u ? cnt : 1u;
}
__device__ __forceinline__ void xcd_barrier(const XcdBarrier& b) {
    asm volatile("s_waitcnt vmcnt(0)" ::: "memory");
    __syncthreads();
    if (threadIdx.x == 0) {
        unsigned* bar = b.bar;
        __builtin_amdgcn_s_waitcnt(0);
        unsigned nloc = b.st[0], nx = b.st[1];
        if (nloc == 0u) { xcd_barrier_complete(bar, b.x, nloc, nx); b.st[0] = nloc; b.st[1] = nx; }
        const unsigned old = xb_add(&bar[XB_XSUB(b.x)], 1u);
        const unsigned gen = old / nloc;
        if (old + 1u == (gen + 1u) * nloc) {
            __builtin_amdgcn_fence(__ATOMIC_RELEASE, "agent");
            asm volatile("s_waitcnt vmcnt(0)" ::: "memory");
            const unsigned og = xb_add(&bar[XB_TOP], 1u);
            const unsigned tg = og / nx;
            if (og + 1u == (tg + 1u) * nx) xb_add(&bar[XB_TOPGEN], 1u);
            else XB_SPIN(xb_ld(&bar[XB_TOPGEN]) == tg, bar);
            __builtin_amdgcn_fence(__ATOMIC_ACQUIRE, "agent");
            xb_add(&bar[XB_XGEN(b.x)], 1u);
            asm volatile("s_waitcnt vmcnt(0)" ::: "memory");
        } else {
            XB_SPIN(xb_ld(&bar[XB_XGEN(b.x)]) == gen, bar);
            __builtin_amdgcn_fence(__ATOMIC_ACQUIRE, "agent");
            asm volatile("s_waitcnt vmcnt(0)" ::: "memory");
        }
    }
    __syncthreads();
}


typedef short bf16x8 __attribute__((ext_vector_type(8)));
typedef short s16x4 __attribute__((ext_vector_type(4)));
typedef float f32x16 __attribute__((ext_vector_type(16)));
typedef unsigned v4u __attribute__((ext_vector_type(4)));
typedef unsigned v2u __attribute__((ext_vector_type(2)));
constexpr float ATT_THR = 5.0f;
template <int DK> struct AttL { static constexpr int KSTR = DK * 2 + 16, KBYTES = 64 * KSTR, VSTR = 136, VBYTES = 64 * VSTR, BUF = KBYTES + VBYTES, KCH = 64 * DK / 8, KPT = (KCH + NTHREADS - 1) / NTHREADS; };

template <int DK>
__device__ __forceinline__ void attn_pass(const bf16_t* Qrow, const bf16_t* Kp, const bf16_t* Vtp, int vt_ld, int nkt, LAS unsigned char* lds, int tid, f32x16 (&oacc)[2], float& m_run, float& l_run) {
    typedef AttL<DK> L;
    const int lane = tid & 63, r = lane & 31, h = lane >> 5;
    bf16x8 qf[DK / 16];
#pragma unroll
    for (int ks = 0; ks < DK / 16; ++ks) qf[ks] = *(const bf16x8*)(Qrow + 16 * ks + 8 * h);
    v4u kreg[L::KPT]; v4u vreg;
    const int vd = tid >> 3, vpart = tid & 7;
#define ATT_LOAD(j) do { _Pragma("unroll") for (int i_ = 0; i_ < L::KPT; ++i_) { const int c_ = tid + i_ * NTHREADS; if (c_ < L::KCH) kreg[i_] = *(const v4u*)(Kp + (size_t)(j) * 64 * DK + c_ * 8); } \
        vreg = *(const v4u*)(Vtp + (size_t)vd * vt_ld + (j) * 64 + vpart * 8); } while (0)
#define ATT_STORE(buf) do { _Pragma("unroll") for (int i_ = 0; i_ < L::KPT; ++i_) { const int c_ = tid + i_ * NTHREADS; if (c_ < L::KCH) { const int key_ = c_ / (DK / 8), part_ = c_ % (DK / 8); \
            *(LAS v4u*)(lds + (buf) * L::BUF + key_ * L::KSTR + part_ * 16) = kreg[i_]; } } \
        { LAS unsigned char* vp_ = lds + (buf) * L::BUF + L::KBYTES + vd * L::VSTR + vpart * 16; *(LAS v2u*)vp_ = (v2u){vreg.x, vreg.y}; *(LAS v2u*)(vp_ + 8) = (v2u){vreg.z, vreg.w}; } } while (0)
    __syncthreads();
    ATT_LOAD(0); ATT_STORE(0);
    __syncthreads();
    for (int j = 0; j < nkt; ++j) {
        const int buf = j & 1;
        if (j + 1 < nkt) ATT_LOAD(j + 1);
        f32x16 sacc[2];
#pragma unroll
        for (int kb = 0; kb < 2; ++kb) {
#pragma unroll
            for (int i = 0; i < 16; ++i) sacc[kb][i] = 0.f;
#pragma unroll
            for (int ks = 0; ks < DK / 16; ++ks) {
                const bf16x8 a = *(const LAS bf16x8*)(lds + buf * L::BUF + (32 * kb + r) * L::KSTR + (16 * ks + 8 * h) * 2);
                sacc[kb] = __builtin_amdgcn_mfma_f32_32x32x16_bf16(a, qf[ks], sacc[kb], 0, 0, 0);
            }
        }
        float tmax = sacc[0][0];
#pragma unroll
        for (int i = 1; i < 16; ++i) tmax = fmaxf(tmax, sacc[0][i]);
#pragma unroll
        for (int i = 0; i < 16; ++i) tmax = fmaxf(tmax, sacc[1][i]);
        tmax = fmaxf(tmax, __shfl_xor(tmax, 32));
        if (__any(tmax > m_run + ATT_THR)) {
            const float mn = fmaxf(m_run, tmax), alpha = __builtin_amdgcn_exp2f(m_run - mn);
#pragma unroll
            for (int i = 0; i < 16; ++i) { oacc[0][i] *= alpha; oacc[1][i] *= alpha; }
            l_run *= alpha; m_run = mn;
        }
        float psum = 0.f;
#pragma unroll
        for (int kb = 0; kb < 2; ++kb)
#pragma unroll
            for (int i = 0; i < 16; ++i) { const float pv = __builtin_amdgcn_exp2f(sacc[kb][i] - m_run); sacc[kb][i] = pv; psum += pv; }
        l_run += psum;
#pragma unroll
        for (int kb = 0; kb < 2; ++kb)
#pragma unroll
            for (int s2 = 0; s2 < 2; ++s2) {
                union { bf16x8 v; unsigned u[4]; } pf;
#pragma unroll
                for (int i = 0; i < 4; ++i) pf.u[i] = pg8::cvt_pk_bf16(sacc[kb][8 * s2 + 2 * i], sacc[kb][8 * s2 + 2 * i + 1]);
#pragma unroll
                for (int db = 0; db < 2; ++db) {
                    const LAS unsigned char* vp = lds + buf * L::BUF + L::KBYTES + (32 * db + r) * L::VSTR + (32 * kb + 16 * s2 + 4 * h) * 2;
                    union { bf16x8 v; v2u u[2]; } af; af.u[0] = *(const LAS v2u*)vp; af.u[1] = *(const LAS v2u*)(vp + 16);
                    oacc[db] = __builtin_amdgcn_mfma_f32_32x32x16_bf16(af.v, pf.v, oacc[db], 0, 0, 0);
                }
            }
        if (j + 1 < nkt) ATT_STORE(buf ^ 1);
        __syncthreads();
    }
#undef ATT_LOAD
#undef ATT_STORE
}


template <bool WITH_Y>
__device__ __forceinline__ void ssd_block(int b, int dir, int k, int hp, bool ctx_out, const float* xbc, const float* dtp, const float* alog, float* hs, float* alast, float* yd, float* lds, int tid) {
    const bool lat = k >= 2; const int c = lat ? (dir ? 33 - k : k - 2) : (dir ? 1 - k : k);
    const int row0 = tok_row(lat, b, c * 128), g = hp >> 1;
    float* sBC = lds; float* sX = lds + 128 * 128; float* sDT = sX + 128 * 128; float* sW = sDT + 256; float* sSc = sW + 256;
    __syncthreads();
    for (int i = tid; i < 128 * 32; i += NTHREADS) { const int t = i >> 5, c4 = i & 31;
        const float4 v = *(const float4*)(xbc + (size_t)(row0 + t) * 768 + 512 + (c4 >> 4) * 128 + g * 64 + (c4 & 15) * 4); *(float4*)(sBC + t * 128 + c4 * 4) = v; }
    for (int i = tid; i < 128 * 32; i += NTHREADS) { const int t = i >> 5, c4 = i & 31;
        const float4 v = *(const float4*)(xbc + (size_t)(row0 + t) * 768 + hp * 128 + c4 * 4); *(float4*)(sX + t * 128 + c4 * 4) = v; }
    if (tid < 256) { const int hl = tid >> 7, t = tid & 127, h = 2 * hp + hl; const float dt = dtp[(size_t)(row0 + t) * 16 + dir * 8 + h]; const float da = dt * -expf(alog[dir * 8 + h]);
        sDT[hl * 128 + t] = dt; if (WITH_Y) sW[hl * 128 + t] = expf(da); else sSc[hl * 128 + (dir ? 127 - t : t)] = da; }
    __syncthreads();
    if (!WITH_Y) {
        for (int off = 1; off < 128; off <<= 1) { float v = 0.f; const int sI = tid & 127;
            if (tid < 256) { v = sSc[tid]; if (sI + off < 128) v += sSc[tid + off]; }
            __syncthreads(); if (tid < 256) sSc[tid] = v; __syncthreads(); }
        if (tid < 256) { const int hl = tid >> 7, sI = tid & 127, t = dir ? 127 - sI : sI; sW[hl * 128 + t] = (sI < 127 ? expf(sSc[tid + 1]) : 1.0f) * sDT[hl * 128 + t]; }
        if (tid < 2) alast[((size_t)(b * 2 + dir) * NCH + k) * 8 + 2 * hp + tid] = sSc[tid * 128];
        __syncthreads();
    }
    const int wave = tid >> 6, lane = tid & 63, hl = wave >> 2, h = 2 * hp + hl, p = 16 * (wave & 3) + (lane >> 2), q = lane & 3;
    float* hsp = hs + (((size_t)(b * 2 + dir) * NCH + k) * 8 + h) * 4096 + p * 64 + q * 16;
    float hst[16];
    if (WITH_Y) {
#pragma unroll
        for (int i = 0; i < 4; ++i) { const float4 v = ((const float4*)hsp)[i]; hst[4 * i] = v.x; hst[4 * i + 1] = v.y; hst[4 * i + 2] = v.z; hst[4 * i + 3] = v.w; }
        float* yrow = yd + ((size_t)dir * NTOK + row0) * 512 + h * 64 + p;
        for (int sI = 0; sI < 128; ++sI) {
            const int t = dir ? 127 - sI : sI;
            const float dec = sW[hl * 128 + t], xdt = sX[t * 128 + hl * 64 + p] * sDT[hl * 128 + t];
            const float4* bp = (const float4*)(sBC + t * 128 + q * 16); const float4* cp = (const float4*)(sBC + t * 128 + 64 + q * 16);
            float y = 0.f;
#pragma unroll
            for (int i = 0; i < 4; ++i) { const float4 bv = bp[i], cv = cp[i];
                hst[4 * i] = dec * hst[4 * i] + xdt * bv.x; y += hst[4 * i] * cv.x;
                hst[4 * i + 1] = dec * hst[4 * i + 1] + xdt * bv.y; y += hst[4 * i + 1] * cv.y;
                hst[4 * i + 2] = dec * hst[4 * i + 2] + xdt * bv.z; y += hst[4 * i + 2] * cv.z;
                hst[4 * i + 3] = dec * hst[4 * i + 3] + xdt * bv.w; y += hst[4 * i + 3] * cv.w; }
            y += __shfl_xor(y, 1); y += __shfl_xor(y, 2);
            if (q == 0) yrow[(size_t)t * 512] = y;
        }
    } else {
#pragma unroll
        for (int i = 0; i < 16; ++i) hst[i] = 0.f;
        for (int t = 0; t < 128; ++t) {
            const float xw = sX[t * 128 + hl * 64 + p] * sW[hl * 128 + t];
            const float4* bp = (const float4*)(sBC + t * 128 + q * 16);
#pragma unroll
            for (int i = 0; i < 4; ++i) { const float4 bv = bp[i]; hst[4 * i] += xw * bv.x; hst[4 * i + 1] += xw * bv.y; hst[4 * i + 2] += xw * bv.z; hst[4 * i + 3] += xw * bv.w; }
        }
#pragma unroll
        for (int i = 0; i < 4; ++i) ((float4*)hsp)[i] = make_float4(hst[4 * i], hst[4 * i + 1], hst[4 * i + 2], hst[4 * i + 3]);
    }
}

template <class RM>
__device__ __forceinline__ void cvt_transpose(const float* src, int K, int N, bf16_t* dst, int ldd, RM rowmap, float* tile  , int tile0, int& tcount, int tid) {
    const int tk = K / 64, tn = (N + 63) / 64, nt = tk * tn;
    for (int t = 0; t < nt; ++t) {
        const int gt = tile0 + t; ++tcount;
        if (gt % (int)gridDim.x != (int)blockIdx.x) continue;
        const int k0 = (t / tn) * 64, n0 = (t % tn) * 64;
        __syncthreads();
#pragma unroll
        for (int i = 0; i < 2; ++i) {
            const int kk = (tid >> 4) + 32 * i, nn = (tid & 15) * 4;
            float4 v = make_float4(0.f, 0.f, 0.f, 0.f);
            if (n0 + nn < N) v = *(const float4*)(src + (size_t)(k0 + kk) * N + n0 + nn);
            tile[kk * 65 + nn] = v.x; tile[kk * 65 + nn + 1] = v.y; tile[kk * 65 + nn + 2] = v.z; tile[kk * 65 + nn + 3] = v.w;
        }
        __syncthreads();
        const int n = tid >> 3, ks = (tid & 7) * 8;
        if (n0 + n < N) {
            uint4 o;
            o.x = pk2(tile[(ks + 0) * 65 + n], tile[(ks + 1) * 65 + n]); o.y = pk2(tile[(ks + 2) * 65 + n], tile[(ks + 3) * 65 + n]);
            o.z = pk2(tile[(ks + 4) * 65 + n], tile[(ks + 5) * 65 + n]); o.w = pk2(tile[(ks + 6) * 65 + n], tile[(ks + 7) * 65 + n]);
            *(uint4*)(dst + (size_t)rowmap(n0 + n) * ldd + k0 + ks) = o;
        }
    }
}

#define MOD ((float*)(kp_->ws + WS_MOD))
#define CTXC ((float*)(kp_->ws + WS_CTXC))
#define AFF ((float*)(kp_->ws + WS_AFF))
#define TOKSLOT ((int*)(kp_->ws + WS_TOKSLOT))
#define SELIDX ((int*)(kp_->ws + WS_SELIDX))
#define SELGATE ((float*)(kp_->ws + WS_SELGATE))
#define DT ((float*)(kp_->ws + WS_DT))
#define HB ((bf16_t*)(kp_->ws + WS_HB))
#define HS ((float*)(kp_->ws + WS_HS))
#define YD ((float*)(kp_->ws + WS_YD))
#define ALAST ((float*)(kp_->ws + WS_ALAST))
#define PB ((float*)(kp_->ws + WS_P))
#define XBC ((float*)(kp_->ws + WS_XBC))
#define MQ ((float*)(kp_->ws + WS_MQ))
#define MKV ((float*)(kp_->ws + WS_MKV))
#define CQB ((bf16_t*)(kp_->ws + WS_CQB))
#define CKVB ((bf16_t*)(kp_->ws + WS_CKVB))
#define MIXB ((bf16_t*)(kp_->ws + WS_MIXB))
#define MOUT ((float*)(kp_->ws + WS_MOUT))
#define XG ((bf16_t*)(kp_->ws + WS_XG))
#define HID ((bf16_t*)(kp_->ws + WS_HID))
#define Y ((float*)(kp_->ws + WS_Y))
#define WIN_T ((bf16_t*)(kp_->ws + WS_WIN))
#define WQ_T ((bf16_t*)(kp_->ws + WS_WQ))
#define WKV_T ((bf16_t*)(kp_->ws + WS_WKV))
#define WOUT_T ((bf16_t*)(kp_->ws + WS_WOUT))
#define WGU_T ((bf16_t*)(kp_->ws + WS_WGU))
#define WD_T ((bf16_t*)(kp_->ws + WS_WD))
#define QD ((bf16_t*)(kp_->ws + WS_QD))
#define QDC ((bf16_t*)(kp_->ws + WS_QDC))
#define KD ((bf16_t*)(kp_->ws + WS_KD))
#define VDT ((bf16_t*)(kp_->ws + WS_VDT))
#define QM ((bf16_t*)(kp_->ws + WS_QM))
#define QMC ((bf16_t*)(kp_->ws + WS_QMC))
#define KM ((bf16_t*)(kp_->ws + WS_KM))
#define VMT ((bf16_t*)(kp_->ws + WS_VMT))
#define xcur (kp_->out)
#define DTMP XBC
#define modl (MOD + (size_t)l * (NB + 1) * NMOD * D)
typedef const __attribute__((address_space(4))) Prm* KPrm;
#define PHASE_BEGIN() KPrm kp_ = (KPrm)__builtin_amdgcn_kernarg_segment_ptr(); asm volatile("" : "+s"(kp_)); int tid = threadIdx.x; asm volatile("" : "+v"(tid)); (void)tid
#define GSYNC() do { XcdBarrier b_; b_.bar = (unsigned*)(kp_->ws + WS_CTL); b_.x = xb_xcc_id(); b_.st = (volatile LAS unsigned*)(ldsb + LDS_BYTES - 64); xcd_barrier(b_); } while (0)
__global__ void __launch_bounds__(NTHREADS, 2) mk_forward(Prm p) {
    extern __shared__ __attribute__((aligned(16))) unsigned char lds_raw[];
    LAS unsigned char* const ldsb = (LAS unsigned char*)lds_raw;
    volatile LAS unsigned* st = (volatile LAS unsigned*)(ldsb + LDS_BYTES - 64);
    if (threadIdx.x < 16) st[threadIdx.x] = 0u;
    __syncthreads();
    (void)xcd_barrier_post((unsigned*)(p.ws + WS_CTL), st);
    const int G = gridDim.x, bid = blockIdx.x;

    {
        PHASE_BEGIN();
        const float* c = kp_->in[I_C]; const float* cc = kp_->in[I_CCTX]; const float* adaw = kp_->in[I_ADAW]; const float* adab = kp_->in[I_ADAB];
        float* sc_l = (float*)lds_raw;
        for (int i = tid; i < (NB + 1) * D; i += NTHREADS) { const int r = i / D, k = i % D; sc_l[i] = siluf(r < NB ? c[(size_t)r * D + k] : cc[k]); }
        __syncthreads();
        ITEMS(i, DEPTH * (NB + 1) * NMOD * D) {
            const int j = i % (NMOD * D), r = (i / (NMOD * D)) % (NB + 1), l = i / ((NB + 1) * NMOD * D);
            const float* src = sc_l + r * D;
            const float* w = adaw + (size_t)l * D * NMOD * D + j;
            float acc = adab[l * NMOD * D + j];
#pragma unroll 8
            for (int k = 0; k < D; ++k) acc += src[k] * w[(size_t)k * NMOD * D];
            MOD[i] = acc;
        }
        const float4* x4 = (const float4*)kp_->in[I_X]; const float4* c4 = (const float4*)kp_->in[I_CTX];
        ITEMS(i, NLAT * D / 4) ((float4*)xcur)[i] = x4[i];
        ITEMS(i, NCTX * D / 4) ((float4*)CTXC)[i] = c4[i];
        GSYNC();
    }

#pragma unroll 1
    for (int l = 0; l < DEPTH; ++l) {
        const bool ctx_out = l < DEPTH - 1;
        const float lambda_init = 0.8f - 0.6f * expf(-0.3f * (float)l);
        const int nrows_out = ctx_out ? NTOK : NLAT;
        const int ER = ctx_out ? ER_MAX : NB * CAP_L;

        {
            PHASE_BEGIN();
            float* tile = (float*)lds_raw; int tc = 0;
            auto idm = [](int n) { return n; };
            cvt_transpose(kp_->in[I_WIN] + (size_t)l * D * IN_COLS, D, IN_COLS, WIN_T, D, idm, tile, tc, tc, tid);
            cvt_transpose(kp_->in[I_WQUP] + (size_t)l * 192 * 384, 192, 384, WQ_T, 256, idm, tile, tc, tc, tid);
            cvt_transpose(kp_->in[I_WKVUP] + (size_t)l * 128 * 512, 128, 512, WKV_T, 128, idm, tile, tc, tc, tid);
            cvt_transpose(kp_->in[I_WOUT] + (size_t)l * MIXW * D, MIXW, D, WOUT_T, MIXW, idm, tile, tc, tc, tid);
            __syncthreads();
            ITEMS(i, (IN_PAD - IN_COLS) * D / 8) ((uint4*)(WIN_T + (size_t)IN_COLS * D))[i] = make_uint4(0, 0, 0, 0);
            ITEMS(i, 128 * 256 / 8) ((uint4*)(WQ_T + (size_t)384 * 256))[i] = make_uint4(0, 0, 0, 0);
            ITEMS(i, 384 * 8) { const int r = i >> 3, c8 = i & 7; *(uint4*)(WQ_T + (size_t)r * 256 + 192 + c8 * 8) = make_uint4(0, 0, 0, 0); }

            const float* w = kp_->in[I_NMPRE] + l * D;
            const int lane = tid & 63;
            WITEMS(r, NTOK) {
                const float4* src = (const float4*)(r < NLAT ? xcur + (size_t)r * D : CTXC + (size_t)(r - NLAT) * D);
                const float* md = modl + (size_t)(r < NLAT ? r / S : NB) * NMOD * D;
                float4 v[4]; float ss = 0.f;
#pragma unroll
                for (int i = 0; i < 4; ++i) { v[i] = src[i * 64 + lane]; ss += f4dot(v[i], v[i]); }
                ss = wave_sum(ss);
                const float rs = 1.0f / sqrtf(ss / D + EPS);
#pragma unroll
                for (int i = 0; i < 4; ++i) { const int k4 = i * 64 + lane; const float4 w4 = ((const float4*)w)[k4], sc = ((const float4*)(md + D))[k4], sh = ((const float4*)md)[k4];
                    const float4 o = make_float4(v[i].x * rs * w4.x * (1.0f + sc.x) + sh.x, v[i].y * rs * w4.y * (1.0f + sc.y) + sh.y, v[i].z * rs * w4.z * (1.0f + sc.z) + sh.z, v[i].w * rs * w4.w * (1.0f + sc.w) + sh.w);
                    *(uint2*)(HB + (size_t)r * D + k4 * 4) = pk4(o); }
            }
            GSYNC();
        }
        {
            PHASE_BEGIN();
            pg8::Gemm g{HB, WIN_T, NTOK, IN_PAD, D, 0, 0}; pg8::StaticOrder so; so.init(NTOK, IN_PAD, G, bid);
            pg8::EpiF32 E{PB, IN_COLS, IN_COLS};
            pg8::gemm_phase<pg8::EpiF32, pg8::StaticOrder, true, true>(ldsb, g, so, E);
            GSYNC();
        }
        {
            PHASE_BEGIN();
            const float* cw = kp_->in[I_CONVW] + (size_t)l * 3 * 768; const float* cb = kp_->in[I_CONVB] + (size_t)l * 768;
            ITEMS(i, NTOK * 768) {
                const int c = i % 768, r = i / 768;
                const bool lat = r < NLAT; const int L = lat ? S : CTX; const int t = lat ? r % S : (r - NLAT) % CTX;
                const float* u = PB + (size_t)r * IN_COLS + C_XBC + c;
                float acc = cb[c] + cw[768 + c] * u[0];
                if (t > 0) acc += cw[c] * u[-IN_COLS];
                if (t < L - 1) acc += cw[2 * 768 + c] * u[IN_COLS];
                XBC[i] = siluf(acc);
            }
            const float* dtb = kp_->in[I_DTB] + l * 16;
            ITEMS(i, NTOK * 16) { const int j = i % 16, r = i / 16; DT[i] = softplusf(PB[(size_t)r * IN_COLS + C_DT + j] + dtb[j]); }
            ITEMS(i, NTOK * 16) {
                const int g = i & 15, r = i >> 4; const int hm = g & 7, isk = g >> 3;
                const bool lat = r < NLAT; const int b = lat ? r / S : (r - NLAT) / CTX, t = lat ? r % S : (r - NLAT) % CTX;
                if (!isk && !lat && !ctx_out) continue;
                const float* vp = PB + (size_t)r * IN_COLS + (isk ? C_DK : C_DQ) + hm * 32;
                float v[32];
#pragma unroll
                for (int k = 0; k < 32; ++k) v[k] = vp[k];
                if (lat) rope32(v, t);
                const float sc = isk ? 1.0f : 0.17677669529663687f * 1.4426950408889634f;
                bf16_t* dst = isk ? KD + ((size_t)(b * 8 + hm) * SK + (lat ? CTX + t : t)) * 32 : (lat ? QD + ((size_t)(b * 8 + hm) * S + t) * 32 : QDC + ((size_t)(b * 8 + hm) * CTX + t) * 32);
#pragma unroll
                for (int k = 0; k < 32; k += 8) *(uint4*)(dst + k) = make_uint4(pk2(v[k] * sc, v[k + 1] * sc), pk2(v[k + 2] * sc, v[k + 3] * sc), pk2(v[k + 4] * sc, v[k + 5] * sc), pk2(v[k + 6] * sc, v[k + 7] * sc));
            }
            ITEMS(i, NB * 4 * 64 * SK) {
                const int j = i % SK, d = (i / SK) % 64, hh = (i / (SK * 64)) % 4, b = i / (SK * 256);
                const int r = j < CTX ? tok_row(false, b, j) : tok_row(true, b, j - CTX);
                VDT[i] = (bf16_t)f2bf(PB[(size_t)r * IN_COLS + C_DV + hh * 64 + d]);
            }
            const float* qn = kp_->in[I_QNORM] + l * 192; const float* kvn = kp_->in[I_KVNORM] + l * 128;
            { const int lane = tid & 63;
            WITEMS(i, NTOK * 2) {
                const int which = i & 1, r = i >> 1; const int n4 = which ? 32 : 48;
                const float4* v = (const float4*)(PB + (size_t)r * IN_COLS + (which ? C_CKV : C_CQ)); const float4* w = (const float4*)(which ? kvn : qn);
                float4 x = make_float4(0.f, 0.f, 0.f, 0.f); if (lane < n4) x = v[lane];
                const float ss = wave_sum(f4dot(x, x));
                const float rs = 1.0f / sqrtf(ss / (n4 * 4) + EPS);
                bf16_t* dst = which ? CKVB + (size_t)r * 128 : CQB + (size_t)r * 256;
                if (lane < n4) *(uint2*)(dst + lane * 4) = pk4(f4scale(f4mul(x, w[lane]), rs));
                else if (!which) *(uint2*)(dst + lane * 4) = make_uint2(0u, 0u);
            } }
            GSYNC();
        }
        {
            PHASE_BEGIN();
            const int half = G / 2;
            if (bid < half) {
                pg8::Gemm g{CQB, WQ_T, NTOK, 512, 256, 0, 0}; pg8::StaticOrder so; so.init(NTOK, 512, half, bid);
                pg8::EpiF32 E{MQ, 384, 384};
                pg8::gemm_phase<pg8::EpiF32, pg8::StaticOrder, true, true>(ldsb, g, so, E);
            } else {
                pg8::Gemm g{CKVB, WKV_T, NTOK, 512, 128, 0, 0}; pg8::StaticOrder so; so.init(NTOK, 512, G - half, bid - half);
                pg8::EpiF32 E{MKV, 512, 512};
                pg8::gemm_phase<pg8::EpiF32, pg8::StaticOrder, true, true>(ldsb, g, so, E);
            }
            for (int it = bid; it < NB * 2 * (NCH - 1) * 4; it += G) {
                const int hp = it & 3, k = (it >> 2) % (NCH - 1), dir = (it / (4 * (NCH - 1))) & 1, b = it / (8 * (NCH - 1));
                ssd_block<false>(b, dir, k, hp, ctx_out, XBC, DT, kp_->in[I_ALOG] + l * 16, HS, ALAST, nullptr, (float*)lds_raw, tid);
            }
            GSYNC();
        }
        {
            PHASE_BEGIN();
            ITEMS(i, NTOK * 8) {
                const int g = i & 7, r = i >> 3; const int hh = g & 3, isk = g >> 2;
                const bool lat = r < NLAT; const int b = lat ? r / S : (r - NLAT) / CTX, t = lat ? r % S : (r - NLAT) % CTX;
                if (!isk && !lat && !ctx_out) continue;
                const float* np = isk ? MKV + (size_t)r * 512 + hh * 128 : MQ + (size_t)r * 384 + hh * 96;
                const float* rp = isk ? PB + (size_t)r * IN_COLS + C_KR : np + 64;
                float v[32];
#pragma unroll
                for (int k = 0; k < 32; ++k) v[k] = rp[k];
                if (lat) rope32(v, t);
                const float sc = isk ? 1.0f : 0.10206207261596575f * 1.4426950408889634f;
                bf16_t* dst = isk ? KM + ((size_t)(b * 4 + hh) * SK + (lat ? CTX + t : t)) * 96 : (lat ? QM + ((size_t)(b * 4 + hh) * S + t) * 96 : QMC + ((size_t)(b * 4 + hh) * CTX + t) * 96);
#pragma unroll
                for (int k = 0; k < 64; k += 8) *(uint4*)(dst + k) = make_uint4(pk2(np[k] * sc, np[k + 1] * sc), pk2(np[k + 2] * sc, np[k + 3] * sc), pk2(np[k + 4] * sc, np[k + 5] * sc), pk2(np[k + 6] * sc, np[k + 7] * sc));
#pragma unroll
                for (int k = 0; k < 32; k += 8) *(uint4*)(dst + 64 + k) = make_uint4(pk2(v[k] * sc, v[k + 1] * sc), pk2(v[k + 2] * sc, v[k + 3] * sc), pk2(v[k + 4] * sc, v[k + 5] * sc), pk2(v[k + 6] * sc, v[k + 7] * sc));
            }
            ITEMS(i, NB * 4 * 64 * SK) {
                const int j = i % SK, d = (i / SK) % 64, hh = (i / (SK * 64)) % 4, b = i / (SK * 256);
                const int r = j < CTX ? tok_row(false, b, j) : tok_row(true, b, j - CTX);
                VMT[i] = (bf16_t)f2bf(MKV[(size_t)r * 512 + hh * 128 + 64 + d]);
            }
            ITEMS(i, NB * 2 * 8 * 1024) {
                const int e4 = i & 1023, h = (i >> 10) & 7, bd = i >> 13;
                float4 Hc = make_float4(0.f, 0.f, 0.f, 0.f);
                for (int k = 0; k < NCH; ++k) {
                    float4* sp = (float4*)(HS + (((size_t)bd * NCH + k) * 8 + h) * 4096) + e4;
                    if (k < NCH - 1) { const float4 sv = *sp; const float dk = expf(ALAST[((size_t)bd * NCH + k) * 8 + h]); *sp = Hc; Hc = f4add(f4scale(Hc, dk), sv); }
                    else *sp = Hc;
                }
            }
            GSYNC();
        }
        {
            PHASE_BEGIN();
            for (int it = bid; it < NB * 2 * NCH * 4; it += G) {
                const int hp = it & 3, k = (it >> 2) % NCH, dir = (it / (4 * NCH)) & 1, b = it / (8 * NCH);
                if (k < 2 && !ctx_out) continue;
                ssd_block<true>(b, dir, k, hp, ctx_out, XBC, DT, kp_->in[I_ALOG] + l * 16, HS, ALAST, YD, (float*)lds_raw, tid);
            }
            const int lane = tid & 63, wave = tid >> 6, qr = lane & 31, hf = lane >> 5;
            {
                const float* lq1 = kp_->in[I_LQ1] + l * 32; const float* lk1 = kp_->in[I_LK1] + l * 32; const float* lq2 = kp_->in[I_LQ2] + l * 32; const float* lk2 = kp_->in[I_LK2] + l * 32;
                float d1 = 0.f, d2 = 0.f; for (int k = 0; k < 32; ++k) { d1 += lq1[k] * lk1[k]; d2 += lq2[k] * lk2[k]; }
                const float lam = expf(d1) - expf(d2) + lambda_init;
                const float* subw = kp_->in[I_SUBLN] + l * 64;
                const int nlat = NB * 4 * (S / 256), nit = nlat + (ctx_out ? NB * 4 : 0);
                for (int it = bid; it < nit; it += G) {
                    const bool lat = it < nlat; const int u = lat ? it : it - nlat;
                    const int qb = lat ? u % (S / 256) : 0, hh = lat ? (u / (S / 256)) % 4 : u % 4, b = lat ? u / (4 * (S / 256)) : u / 4;
                    const int t = qb * 256 + wave * 32 + qr; const int row = tok_row(lat, b, t); const int nkt = lat ? SK / 64 : CTX / 64;
                    f32x16 o1[2], oacc[2]; float lsum1 = 0.f;
#pragma unroll
                    for (int mp = 0; mp < 2; ++mp) {
                        const int hm = hh * 2 + mp;
                        const bf16_t* qrow = lat ? QD + ((size_t)(b * 8 + hm) * S + t) * 32 : QDC + ((size_t)(b * 8 + hm) * CTX + t) * 32;
                        float m_run = -1e30f, l_run = 0.f;
#pragma unroll
                        for (int i = 0; i < 16; ++i) { oacc[0][i] = 0.f; oacc[1][i] = 0.f; }
                        attn_pass<32>(qrow, KD + (size_t)(b * 8 + hm) * SK * 32, VDT + (size_t)(b * 4 + hh) * 64 * SK, SK, nkt, ldsb, tid, oacc, m_run, l_run);
                        l_run += __shfl_xor(l_run, 32);
                        if (mp == 0) { o1[0] = oacc[0]; o1[1] = oacc[1]; lsum1 = l_run; }
                        else {
                            const float i1 = 1.0f / lsum1, i2 = lam / l_run; float ss = 0.f;
#pragma unroll
                            for (int db = 0; db < 2; ++db)
#pragma unroll
                                for (int i = 0; i < 16; ++i) { const float v = o1[db][i] * i1 - oacc[db][i] * i2; o1[db][i] = v; ss += v * v; }
                            ss += __shfl_xor(ss, 32);
                            const float rs = (1.0f - lambda_init) / sqrtf(ss / 64 + EPS);
                            bf16_t* orow = MIXB + (size_t)row * MIXW + 512 + hh * 64;
#pragma unroll
                            for (int db = 0; db < 2; ++db)
#pragma unroll
                                for (int gq = 0; gq < 4; ++gq) { const int d0 = 32 * db + 8 * gq + 4 * hf; const float4 w4 = *(const float4*)(subw + d0);
                                    *(uint2*)(orow + d0) = make_uint2(pk2(o1[db][4 * gq] * rs * w4.x, o1[db][4 * gq + 1] * rs * w4.y), pk2(o1[db][4 * gq + 2] * rs * w4.z, o1[db][4 * gq + 3] * rs * w4.w)); }
                        }
                    }
                }
            }
            {
                const int nlat = NB * 4 * (S / 256), nit = nlat + (ctx_out ? NB * 4 : 0);
                for (int it = bid; it < nit; it += G) {
                    const bool lat = it < nlat; const int u = lat ? it : it - nlat;
                    const int qb = lat ? u % (S / 256) : 0, hh = lat ? (u / (S / 256)) % 4 : u % 4, b = lat ? u / (4 * (S / 256)) : u / 4;
                    const int t = qb * 256 + wave * 32 + qr; const int row = tok_row(lat, b, t); const int nkt = lat ? SK / 64 : CTX / 64;
                    const bf16_t* qrow = lat ? QM + ((size_t)(b * 4 + hh) * S + t) * 96 : QMC + ((size_t)(b * 4 + hh) * CTX + t) * 96;
                    f32x16 oacc[2]; float m_run = -1e30f, l_run = 0.f;
#pragma unroll
                    for (int i = 0; i < 16; ++i) { oacc[0][i] = 0.f; oacc[1][i] = 0.f; }
                    attn_pass<96>(qrow, KM + (size_t)(b * 4 + hh) * SK * 96, VMT + (size_t)(b * 4 + hh) * 64 * SK, SK, nkt, ldsb, tid, oacc, m_run, l_run);
                    l_run += __shfl_xor(l_run, 32);
                    const float inv = 1.0f / l_run;
                    bf16_t* orow = MIXB + (size_t)row * MIXW + 768 + hh * 64;
#pragma unroll
                    for (int db = 0; db < 2; ++db)
#pragma unroll
                        for (int gq = 0; gq < 4; ++gq) { const int d0 = 32 * db + 8 * gq + 4 * hf;
                            *(uint2*)(orow + d0) = make_uint2(pk2(oacc[db][4 * gq] * inv, oacc[db][4 * gq + 1] * inv), pk2(oacc[db][4 * gq + 2] * inv, oacc[db][4 * gq + 3] * inv)); }
                }
            }
            GSYNC();
        }
        {
            PHASE_BEGIN();
            const float* nw = kp_->in[I_SSDN] + l * 512; const float* dsk = kp_->in[I_SSDD] + l * 8;
            const int lane = tid & 63;
            WITEMS(i, nrows_out * 2) {
                const int g = i & 1, r = i >> 1, c = g * 256 + lane * 4;
                const float4 x = *(const float4*)(XBC + (size_t)r * 768 + c), y0 = *(const float4*)(YD + (size_t)r * 512 + c), y1 = *(const float4*)(YD + ((size_t)NTOK + r) * 512 + c);
                const float4 z = *(const float4*)(PB + (size_t)r * IN_COLS + C_Z + c);
                const float ds = dsk[c >> 6];
                float4 v = make_float4((ds * x.x + y0.x + y1.x) * siluf(z.x), (ds * x.y + y0.y + y1.y) * siluf(z.y), (ds * x.z + y0.z + y1.z) * siluf(z.z), (ds * x.w + y0.w + y1.w) * siluf(z.w));
                const float ss = wave_sum(f4dot(v, v));
                const float rs = 1.0f / sqrtf(ss / 256 + EPS);
                *(uint2*)(MIXB + (size_t)r * MIXW + c) = pk4(f4scale(f4mul(v, *(const float4*)(nw + c)), rs));
            }
            GSYNC();
        }
        {
            PHASE_BEGIN();
            pg8::Gemm g{MIXB, WOUT_T, nrows_out, D, MIXW, 0, 0}; pg8::StaticOrder so; so.init(nrows_out, D, G, bid);
            pg8::EpiF32 E{MOUT, D, D};
            pg8::gemm_phase<pg8::EpiF32, pg8::StaticOrder, true, true>(ldsb, g, so, E);
            GSYNC();
        }
        {
            PHASE_BEGIN();
            const float* wpost = kp_->in[I_NMPOST] + l * D; const float* wpre = kp_->in[I_NFPRE] + l * D;
            const float* rw = kp_->in[I_RW] + (size_t)l * D * NE; const float* rb = kp_->in[I_RB] + l * NE;
            const int lane = tid & 63;
            WITEMS(r, nrows_out) {
                float4* xr = (float4*)(r < NLAT ? xcur + (size_t)r * D : CTXC + (size_t)(r - NLAT) * D);
                const float* md = modl + (size_t)(r < NLAT ? r / S : NB) * NMOD * D;
                const float4* m = (const float4*)(MOUT + (size_t)r * D);
                float4 mv[4], xv[4]; float ss = 0.f;
#pragma unroll
                for (int i = 0; i < 4; ++i) { mv[i] = m[i * 64 + lane]; xv[i] = xr[i * 64 + lane]; ss += f4dot(mv[i], mv[i]); }
                ss = wave_sum(ss);
                const float rs = 1.0f / sqrtf(ss / D + EPS);
                float s2 = 0.f;
#pragma unroll
                for (int i = 0; i < 4; ++i) { const int k4 = i * 64 + lane; const float4 g2 = ((const float4*)(md + 2 * D))[k4], wp = ((const float4*)wpost)[k4];
                    xv[i] = f4add(xv[i], f4mul(g2, f4scale(f4mul(mv[i], wp), rs))); xr[k4] = xv[i]; s2 += f4dot(xv[i], xv[i]); }
                s2 = wave_sum(s2);
                const float r2 = 1.0f / sqrtf(s2 / D + EPS);
                float lg[NE];
#pragma unroll
                for (int e = 0; e < NE; ++e) lg[e] = 0.f;
#pragma unroll
                for (int i = 0; i < 4; ++i) { const int k4 = i * 64 + lane; const float4 w4 = ((const float4*)wpre)[k4], sc = ((const float4*)(md + 4 * D))[k4], sh = ((const float4*)(md + 3 * D))[k4];
                    const float hv[4] = {xv[i].x * r2 * w4.x * (1.0f + sc.x) + sh.x, xv[i].y * r2 * w4.y * (1.0f + sc.y) + sh.y, xv[i].z * r2 * w4.z * (1.0f + sc.z) + sh.z, xv[i].w * r2 * w4.w * (1.0f + sc.w) + sh.w};
                    *(uint2*)(HB + (size_t)r * D + k4 * 4) = make_uint2(pk2(hv[0], hv[1]), pk2(hv[2], hv[3]));
#pragma unroll
                    for (int c = 0; c < 4; ++c) { const float4* rwp = (const float4*)(rw + (size_t)(k4 * 4 + c) * NE);
#pragma unroll
                        for (int e4 = 0; e4 < 4; ++e4) { const float4 w = rwp[e4]; lg[4 * e4] += hv[c] * w.x; lg[4 * e4 + 1] += hv[c] * w.y; lg[4 * e4 + 2] += hv[c] * w.z; lg[4 * e4 + 3] += hv[c] * w.w; } }
                }
#pragma unroll
                for (int e = 0; e < NE; ++e) lg[e] = wave_sum(lg[e]) + rb[e];
                float mx = lg[0];
#pragma unroll
                for (int e = 1; e < NE; ++e) mx = fmaxf(mx, lg[e]);
                float sum = 0.f;
#pragma unroll
                for (int e = 0; e < NE; ++e) { lg[e] = expf(lg[e] - mx); sum += lg[e]; }
                const float is = 1.0f / sum;
                float mine = lg[0];
#pragma unroll
                for (int e = 1; e < NE; ++e) mine = lane == e ? lg[e] : mine;
                if (lane < NE) AFF[(size_t)r * NE + lane] = mine * is;
            }
            GSYNC();
        }
        {
            PHASE_BEGIN();
            {
                float* tile = (float*)lds_raw; int tc = 0;
                auto idm = [](int n) { return n; };
                for (int e = 0; e < NE; ++e) {
                    cvt_transpose(kp_->in[I_WG] + ((size_t)l * NE + e) * D * FF, D, FF, WGU_T + (size_t)e * 2 * FF * D, D, [](int n) { return (n >> 2) * 8 + (n & 3); }, tile, tc, tc, tid);
                    cvt_transpose(kp_->in[I_WU] + ((size_t)l * NE + e) * D * FF, D, FF, WGU_T + (size_t)e * 2 * FF * D, D, [](int n) { return (n >> 2) * 8 + 4 + (n & 3); }, tile, tc, tc, tid);
                    cvt_transpose(kp_->in[I_WD] + ((size_t)l * NE + e) * FF * D, FF, D, WD_T + (size_t)e * D * FF, FF, idm, tile, tc, tc, tid);
                }
                __syncthreads();
            }
            for (int set = 0; set < (ctx_out ? 2 : 1); ++set) {
                const bool lat = set == 0; const int L = lat ? S : CTX; const int cap = lat ? CAP_L : CAP_C;
                ITEMS(i, NB * NE * L) {
                    const int t = i % L, e = (i / L) % NE, b = i / (NE * L);
                    const int base = tok_row(lat, b, 0);
                    const float a = AFF[(size_t)(base + t) * NE + e];
                    int rank = 0;
                    for (int j = 0; j < L; ++j) { const float aj = AFF[(size_t)(base + j) * NE + e]; rank += (aj > a || (aj == a && j < t)) ? 1 : 0; }
                    int slot = -1;
                    if (rank < cap) { slot = lat ? b * CAP_L + rank : NB * CAP_L + b * CAP_C + rank; SELIDX[e * ER_MAX + slot] = base + t; SELGATE[e * ER_MAX + slot] = a; }
                    TOKSLOT[(size_t)(base + t) * NE + e] = slot;
                }
            }
            GSYNC();
        }
        {
            PHASE_BEGIN();
            const int used = ctx_out ? NB * (CAP_L + CAP_C) : NB * CAP_L;
            ITEMS(i, NE * ER * (D / 8)) {
                const int c8 = i % (D / 8), slot = (i / (D / 8)) % ER, e = i / ((D / 8) * ER);
                uint4 v = make_uint4(0, 0, 0, 0);
                if (slot < used) v = *(const uint4*)(HB + (size_t)SELIDX[e * ER_MAX + slot] * D + c8 * 8);
                *(uint4*)(XG + ((size_t)e * ER + slot) * D + c8 * 8) = v;
            }
            GSYNC();
        }
        {
            PHASE_BEGIN();
            pg8::Gemm g{XG, WGU_T, NE * ER, 2 * FF, D, ER / 256, (size_t)2 * FF * D * 2}; pg8::StaticOrder so; so.init(NE * ER, 2 * FF, G, bid);
            pg8::EpiSwiGLU E{HID, FF};
            pg8::gemm_phase<pg8::EpiSwiGLU, pg8::StaticOrder, true, true>(ldsb, g, so, E);
            GSYNC();
        }
        {
            PHASE_BEGIN();
            pg8::Gemm g{HID, WD_T, NE * ER, D, FF, ER / 256, (size_t)D * FF * 2}; pg8::StaticOrder so; so.init(NE * ER, D, G, bid);
            pg8::EpiRowScaleF32 E{Y, D, SELGATE, ER};
            pg8::gemm_phase<pg8::EpiRowScaleF32, pg8::StaticOrder, true, true>(ldsb, g, so, E);
            GSYNC();
        }
        {
            PHASE_BEGIN();
            const float* wpost = kp_->in[I_NFPOST] + l * D;
            const int lane = tid & 63;
            WITEMS(r, nrows_out) {
                float4* xr = (float4*)(r < NLAT ? xcur + (size_t)r * D : CTXC + (size_t)(r - NLAT) * D);
                const float* md = modl + (size_t)(r < NLAT ? r / S : NB) * NMOD * D;
                const int myslot = lane < NE ? TOKSLOT[(size_t)r * NE + lane] : -1;
                float4 f[4];
#pragma unroll
                for (int i = 0; i < 4; ++i) f[i] = make_float4(0.f, 0.f, 0.f, 0.f);
#pragma unroll 1
                for (int e = 0; e < NE; ++e) {
                    const int sl = __shfl(myslot, e);
                    if (sl >= 0) { const float4* yp = (const float4*)(Y + ((size_t)e * ER + sl) * D);
#pragma unroll
                        for (int i = 0; i < 4; ++i) f[i] = f4add(f[i], yp[i * 64 + lane]); }
                }
                float ss = 0.f;
#pragma unroll
                for (int i = 0; i < 4; ++i) ss += f4dot(f[i], f[i]);
                ss = wave_sum(ss);
                const float rs = 1.0f / sqrtf(ss / D + EPS);
#pragma unroll
                for (int i = 0; i < 4; ++i) { const int k4 = i * 64 + lane; const float4 g5 = ((const float4*)(md + 5 * D))[k4], wp = ((const float4*)wpost)[k4];
                    xr[k4] = f4add(xr[k4], f4mul(g5, f4scale(f4mul(f[i], wp), rs))); }
            }
            GSYNC();
        }
    }
}

extern "C" void kernel_launch(void* const* d_in, const int* in_sizes, int n_in, void* d_out, int out_size, void* d_ws, size_t ws_size, hipStream_t stream) {
    static int grid = 0;
    if (grid == 0) {
        if (n_in != N_IN || out_size != NLAT * D || ws_size < WS_END) { fprintf(stderr, "kernel_launch: unexpected shapes: n_in %d out %d ws %zu (need %zu)\n", n_in, out_size, ws_size, (size_t)WS_END); grid = -1; return; }
        int dev = 0, cus = 0, per_cu = 0;
        (void)hipGetDevice(&dev);
        (void)hipDeviceGetAttribute(&cus, hipDeviceAttributeMultiprocessorCount, dev);
        (void)hipFuncSetAttribute((const void*)mk_forward, hipFuncAttributeMaxDynamicSharedMemorySize, LDS_BYTES);
        (void)hipOccupancyMaxActiveBlocksPerMultiprocessor(&per_cu, (const void*)mk_forward, NTHREADS, LDS_BYTES);
        (void)hipGetLastError();
        if (per_cu < 1) { fprintf(stderr, "kernel_launch: occupancy query says %d blocks/CU\n", per_cu); grid = -1; return; }
        grid = cus;
    }
    if (grid < 0) return;
    (void)hipMemsetAsync((char*)d_ws + WS_CTL, 0, CTL_BYTES, stream);
    Prm p{};
    for (int i = 0; i < N_IN; ++i) p.in[i] = (const float*)d_in[i];
    p.out = (float*)d_out; p.ws = (char*)d_ws;
    void* args[] = {&p};
    hipError_t e = hipLaunchCooperativeKernel((const void*)mk_forward, dim3(grid), dim3(NTHREADS), args, LDS_BYTES, stream);
    if (e != hipSuccess) fprintf(stderr, "kernel_launch: cooperative launch failed: %s (grid %d)\n", hipGetErrorString(e), grid);
}
```

```cpp
#include <hip/hip_runtime.h>
#include <cstdio>
#include <cstdint>

constexpr int D = 1024, NB = 4, S = 4096, CTX = 256, FF = 1024;
constexpr int DEPTH = 2, GRID_W = 64, NMOD = 6, NE = 16;
constexpr int NLAT = NB * S, NCTX = NB * CTX, NTOK = NLAT + NCTX;
constexpr int IN_COLS = 2416, IN_PAD = 2560;
constexpr int C_Z = 0, C_XBC = 512, C_DT = 1280, C_DQ = 1296, C_DK = 1552, C_DV = 1808, C_CQ = 2064, C_CKV = 2256, C_KR = 2384;
constexpr int MIXW = 1024;
constexpr int CAP_L = 2 * S / NE, CAP_C = 2 * CTX / NE;
constexpr int ER_MAX = 2304;
constexpr float EPS = 1e-6f;
static_assert(NB * CAP_L == 2048 && NB * CAP_C == 128, "expert row layout");

enum { I_X = 0, I_C, I_CTX, I_CCTX, I_ADAW, I_ADAB, I_NMPRE, I_NMPOST, I_NFPRE, I_NFPOST, I_WIN, I_CONVW, I_CONVB, I_ALOG, I_DTB, I_SSDD, I_SSDN,
       I_LQ1, I_LK1, I_LQ2, I_LK2, I_SUBLN, I_QNORM, I_WQUP, I_KVNORM, I_WKVUP, I_WOUT, I_RW, I_RB, I_WG, I_WU, I_WD, N_IN };
struct Prm { const float* in[N_IN]; float* out; char* ws; };

typedef unsigned short bf16_t;
constexpr size_t al256(size_t x) { return (x + 255) & ~(size_t)255; }
constexpr size_t WS_CTL = 0, CTL_BYTES = 65536;
constexpr size_t WS_MOD = WS_CTL + CTL_BYTES;
constexpr size_t WS_CTXC = al256(WS_MOD + (size_t)DEPTH * (NB + 1) * NMOD * D * 4);
constexpr size_t WS_AFF = al256(WS_CTXC + (size_t)NCTX * D * 4);
constexpr size_t WS_TOKSLOT = al256(WS_AFF + (size_t)NTOK * NE * 4);
constexpr size_t WS_SELIDX = al256(WS_TOKSLOT + (size_t)NTOK * NE * 4);
constexpr size_t WS_SELGATE = al256(WS_SELIDX + (size_t)NE * ER_MAX * 4);
constexpr size_t WS_DT = al256(WS_SELGATE + (size_t)NE * ER_MAX * 4);
constexpr int NCH = 34;
constexpr size_t WS_ROPE = al256(WS_DT + (size_t)NTOK * 16 * 4);
constexpr size_t WS_ALAST = al256(WS_ROPE + (size_t)S * 32 * 4);
constexpr size_t WS_HB = al256(WS_ALAST + (size_t)NB * 2 * NCH * 8 * 4);
constexpr size_t WS_P = al256(WS_HB + (size_t)NTOK * D * 2);
constexpr size_t WS_G2 = al256(WS_P + (size_t)NTOK * IN_COLS * 4);
constexpr size_t WS_XBC = WS_G2;
constexpr size_t WS_MQ = al256(WS_XBC + (size_t)NTOK * 768 * 4);
constexpr size_t WS_MKV = al256(WS_MQ + (size_t)NTOK * 384 * 4);
constexpr size_t WS_CQB = al256(WS_MKV + (size_t)NTOK * 512 * 4);
constexpr size_t WS_CKVB = al256(WS_CQB + (size_t)NTOK * 256 * 2);
constexpr size_t WS_MIXB = al256(WS_CKVB + (size_t)NTOK * 128 * 2);
constexpr size_t WS_G2END = al256(WS_MIXB + (size_t)NTOK * MIXW * 2);
constexpr size_t WS_HS = WS_HB;
constexpr size_t WS_YD = WS_MQ;
constexpr size_t WS_MOUT = WS_P;
constexpr size_t WS_XG = WS_P;
constexpr size_t WS_HID = al256(WS_XG + (size_t)NE * ER_MAX * D * 2);
constexpr size_t WS_Y = WS_G2;
constexpr size_t WS_WIN = WS_G2END;
constexpr size_t WS_WQ = al256(WS_WIN + (size_t)IN_PAD * D * 2);
constexpr size_t WS_WKV = al256(WS_WQ + (size_t)512 * 256 * 2);
constexpr size_t WS_WOUT = al256(WS_WKV + (size_t)512 * 128 * 2);
constexpr size_t WS_WGU = al256(WS_WOUT + (size_t)D * MIXW * 2);
constexpr size_t WS_WD = al256(WS_WGU + (size_t)NE * 2 * FF * D * 2);
constexpr size_t WS_END = al256(WS_WD + (size_t)NE * D * FF * 2);
constexpr int SK = CTX + S;
constexpr size_t WS_QD = WS_WGU;
constexpr size_t WS_QDC = al256(WS_QD + (size_t)NB * 8 * S * 32 * 2);
constexpr size_t WS_KD = al256(WS_QDC + (size_t)NB * 8 * CTX * 32 * 2);
constexpr size_t WS_VDT = al256(WS_KD + (size_t)NB * 8 * SK * 32 * 2);
constexpr size_t WS_QM = al256(WS_VDT + (size_t)NB * 4 * 64 * SK * 2);
constexpr size_t WS_QMC = al256(WS_QM + (size_t)NB * 4 * S * 96 * 2);
constexpr size_t WS_KM = al256(WS_QMC + (size_t)NB * 4 * CTX * 96 * 2);
constexpr size_t WS_VMT = al256(WS_KM + (size_t)NB * 4 * SK * 96 * 2);
constexpr size_t WS_ATTEND = al256(WS_VMT + (size_t)NB * 4 * 64 * SK * 2);
static_assert(WS_ATTEND <= WS_END, "attention operands fit in the MoE weight region");
static_assert(WS_HID + (size_t)NE * ER_MAX * FF * 2 <= WS_G2, "XG+HID fit in the P region");
static_assert((size_t)NE * ER_MAX * D * 4 <= WS_G2END - WS_G2, "Y fits in the G2 region");
static_assert((size_t)NB * 2 * NCH * 8 * 4096 * 4 <= (size_t)NTOK * D * 2, "HS fits in HB");
static_assert(WS_YD + (size_t)2 * NTOK * 512 * 4 <= WS_MIXB, "YD ends below MIXB");

#define LAS __attribute__((address_space(3)))
constexpr int NTHREADS = 512;
constexpr int LDS_BYTES = 147456;
#define ITEMS(i, n) for (int i = blockIdx.x * NTHREADS + tid; i < (n); i += gridDim.x * NTHREADS)

__device__ __forceinline__ float siluf(float x) { return x / (1.0f + expf(-x)); }
__device__ __forceinline__ float softplusf(float x) { return x > 20.f ? x : log1pf(expf(x)); }
__device__ __forceinline__ unsigned f2bf(float f) { unsigned u = __builtin_bit_cast(unsigned, f); return (u + 0x7fffu + ((u >> 16) & 1u)) >> 16; }
__device__ __forceinline__ unsigned pk2(float lo, float hi) { return f2bf(lo) | (f2bf(hi) << 16); }
__device__ __forceinline__ float bf2f(bf16_t h) { return __builtin_bit_cast(float, (unsigned)h << 16); }
#define SCHED_FENCE() __builtin_amdgcn_sched_barrier(0)
__device__ __forceinline__ float dpp_row_shr(float v, int n) {
    const int iv = __builtin_bit_cast(int, v); int r;
    switch (n) { case 1: r = __builtin_amdgcn_update_dpp(0, iv, 0x111, 0xf, 0xf, true); break; case 2: r = __builtin_amdgcn_update_dpp(0, iv, 0x112, 0xf, 0xf, true); break;
                 case 4: r = __builtin_amdgcn_update_dpp(0, iv, 0x114, 0xf, 0xf, true); break; default: r = __builtin_amdgcn_update_dpp(0, iv, 0x118, 0xf, 0xf, true); break; }
    return __builtin_bit_cast(float, r);
}
__device__ __forceinline__ float wave_sum(float v) {
    v += dpp_row_shr(v, 1); v += dpp_row_shr(v, 2); v += dpp_row_shr(v, 4); v += dpp_row_shr(v, 8);
    v += __builtin_bit_cast(float, __builtin_amdgcn_update_dpp(0, __builtin_bit_cast(int, v), 0x142, 0xa, 0xf, false));
    v += __builtin_bit_cast(float, __builtin_amdgcn_update_dpp(0, __builtin_bit_cast(int, v), 0x143, 0xc, 0xf, false));
    return __builtin_bit_cast(float, __builtin_amdgcn_readlane(__builtin_bit_cast(int, v), 63)); }
__device__ __forceinline__ float xor32_max(float x) { auto t = __builtin_amdgcn_permlane32_swap(__float_as_uint(x), __float_as_uint(x), false, false); return fmaxf(__uint_as_float(t[0]), __uint_as_float(t[1])); }
__device__ __forceinline__ float xor32_sum(float x) { auto t = __builtin_amdgcn_permlane32_swap(__float_as_uint(x), __float_as_uint(x), false, false); return __uint_as_float(t[0]) + __uint_as_float(t[1]); }
#define WITEMS(i, n) for (int i = blockIdx.x * 8 + (tid >> 6); i < (n); i += gridDim.x * 8)
__device__ __forceinline__ float4 f4mul(float4 a, float4 b) { return make_float4(a.x * b.x, a.y * b.y, a.z * b.z, a.w * b.w); }
__device__ __forceinline__ float4 f4add(float4 a, float4 b) { return make_float4(a.x + b.x, a.y + b.y, a.z + b.z, a.w + b.w); }
__device__ __forceinline__ float4 f4scale(float4 a, float s) { return make_float4(a.x * s, a.y * s, a.z * s, a.w * s); }
__device__ __forceinline__ float f4dot(float4 a, float4 b) { return a.x * b.x + a.y * b.y + a.z * b.z + a.w * b.w; }
__device__ __forceinline__ uint2 pk4(float4 v) { return make_uint2(pk2(v.x, v.y), pk2(v.z, v.w)); }

__device__ __forceinline__ void rope32(float* v, int t, const float* tab) {
    const float4* tp = (const float4*)(tab + (size_t)t * 32);
    float cs[32];
#pragma unroll
    for (int i = 0; i < 8; ++i) { const float4 x = tp[i]; cs[4 * i] = x.x; cs[4 * i + 1] = x.y; cs[4 * i + 2] = x.z; cs[4 * i + 3] = x.w; }
#pragma unroll
    for (int i = 0; i < 8; ++i) {
        { const float c = cs[i], sn = cs[8 + i]; const float x1 = v[i], x2 = v[8 + i]; v[i] = x1 * c - x2 * sn; v[8 + i] = x1 * sn + x2 * c; }
        { const float c = cs[16 + i], sn = cs[24 + i]; const float x1 = v[16 + i], x2 = v[24 + i]; v[16 + i] = x1 * c - x2 * sn; v[24 + i] = x1 * sn + x2 * c; }
    }
}
__device__ __forceinline__ int tok_row(bool lat, int b, int t) { return lat ? b * S + t : NLAT + b * CTX + t; }

namespace pg8 {
#define PG8_LAS __attribute__((address_space(3)))
typedef short bf16x8 __attribute__((ext_vector_type(8)));
typedef float f32x4 __attribute__((ext_vector_type(4)));
typedef unsigned u32x4 __attribute__((ext_vector_type(4)));
constexpr int BM = 256, BK = 64, HALF = 128, HTB = HALF * BK * 2  , STAGE_BYTES = 8 * HTB, NXCD = 8, WGM = 8;

__host__ __device__ __forceinline__ int lds_byte(int r, int c) { const int st = (r >> 4) * 2 + (c >> 5), rr = r & 15, cc = c & 31, ob = rr * 64 + cc * 2; return st * 1024 + (ob ^ (((ob >> 9) & 1) << 5)); }
__host__ __device__ __forceinline__ void stage_rc(int b, int& R, int& C) { const int st = b / 1024, sb = b % 1024, swz = sb ^ (((sb >> 9) & 1) << 5); R = (st >> 1) * 16 + swz / 64; C = (st & 1) * 32 + (swz % 64) / 2; }
__host__ __device__ __forceinline__ int perm32(int rho) { const int n = rho >> 4, i = rho & 15; return 8 * (i >> 2) + 4 * n + (i & 3); }

struct Unit { int pm, pn; };
struct Gemm { const bf16_t* A; const bf16_t* Bt; int M, N, K; int grp_tiles; size_t grp_stride; };

struct StaticOrder {
    int nM, nN, nwg, G, c;
    __host__ __device__ void init(int M, int N, int G_, int c_) { nM = M / BM; nN = N / BM; nwg = nM * nN; G = G_; c = c_; }
    __host__ __device__ bool next(int i, Unit& u) const {
        const long L = (long)i * G + c; if (L >= nwg) return false;
        int wgid = (int)L; { const int q = nwg / NXCD, r = nwg % NXCD, xcd = wgid % NXCD, off = wgid / NXCD; wgid = (xcd < r ? xcd * (q + 1) : r * (q + 1) + (xcd - r) * q) + off; }
        const int nig = WGM * nN, gid = wgid / nig, fm = gid * WGM, gsz = (nM - fm) < WGM ? (nM - fm) : WGM;
        u.pm = fm + ((wgid % nig) % gsz); u.pn = (wgid % nig) / gsz; return true;
    }
    __device__ __forceinline__ void a_ready(const Unit&) const {}
    __device__ __forceinline__ void done(const Unit&) const {}
};

__device__ __forceinline__ unsigned cvt_pk_bf16(float lo, float hi) { unsigned r; asm volatile("v_cvt_pk_bf16_f32 %0, %1, %2" : "=v"(r) : "v"(lo), "v"(hi)); return r; }

typedef unsigned u32x2 __attribute__((ext_vector_type(2)));
struct EpiF32 {
    static constexpr bool PERM = false, AFTER_DRAIN = false;
    float* C; int ldc; int ncols;
    __device__ __forceinline__ void operator()(const f32x4 (&acc)[2][2][4][2], const Unit& u, int wr, int wc, int fr, int fq) const {
        const int row0 = u.pm * BM + wr * 64 + fr, col0 = u.pn * BM + wc * 32 + 4 * fq;
#pragma unroll
        for (int ai = 0; ai < 2; ++ai)
#pragma unroll
            for (int m = 0; m < 4; ++m) { float* rowp = C + (size_t)(row0 + ai * HALF + m * 16) * ldc;
#pragma unroll
                for (int bj = 0; bj < 2; ++bj)
#pragma unroll
                    for (int n = 0; n < 2; ++n) { const int col = col0 + bj * HALF + n * 16; if (col < ncols) *(f32x4*)(rowp + col) = acc[ai][bj][m][n]; } }
    }
};
struct EpiRowScaleF32 {
    static constexpr bool PERM = false, AFTER_DRAIN = false;
    float* C; int ldc; const float* gate; int er;
    __device__ __forceinline__ void operator()(const f32x4 (&acc)[2][2][4][2], const Unit& u, int wr, int wc, int fr, int fq) const {
        const int row0 = u.pm * BM + wr * 64 + fr, col0 = u.pn * BM + wc * 32 + 4 * fq;
#pragma unroll
        for (int ai = 0; ai < 2; ++ai)
#pragma unroll
            for (int m = 0; m < 4; ++m) { const int row = row0 + ai * HALF + m * 16; float* rowp = C + (size_t)row * ldc; const float sc = gate[(row / er) * ER_MAX + row % er];
#pragma unroll
                for (int bj = 0; bj < 2; ++bj)
#pragma unroll
                    for (int n = 0; n < 2; ++n) *(f32x4*)(rowp + col0 + bj * HALF + n * 16) = acc[ai][bj][m][n] * sc; }
    }
};
struct EpiSwiGLU {
    static constexpr bool PERM = true, AFTER_DRAIN = false;
    bf16_t* O; int ldo;
    __device__ __forceinline__ void operator()(const f32x4 (&acc)[2][2][4][2], const Unit& u, int wr, int wc, int fr, int fq) const {
        const int row0 = u.pm * BM + wr * 64 + fr, col0 = u.pn * BM + wc * 32 + 8 * fq;
#pragma unroll
        for (int ai = 0; ai < 2; ++ai)
#pragma unroll
            for (int m = 0; m < 4; ++m) { bf16_t* rowp = O + (size_t)(row0 + ai * HALF + m * 16) * ldo;
#pragma unroll
                for (int bj = 0; bj < 2; ++bj) { const f32x4 gt = acc[ai][bj][m][0], up = acc[ai][bj][m][1]; f32x4 h;
#pragma unroll
                    for (int i = 0; i < 4; ++i) h[i] = gt[i] / (1.0f + __expf(-gt[i])) * up[i];
                    u32x2 w; w.x = cvt_pk_bf16(h[0], h[1]); w.y = cvt_pk_bf16(h[2], h[3]);
                    *(u32x2*)(rowp + (col0 + bj * HALF) / 2) = w; } }
    }
};
template <class Epi, class Sched, bool ALIGN_EPI = false, bool SP2 = false>
__device__ __forceinline__ void gemm_phase(PG8_LAS unsigned char* lds, const Gemm g, const Sched& S, const Epi& E) {
    int tid_ = threadIdx.x; asm volatile("" : "+v"(tid_));
    const int tid = tid_, wid = __builtin_amdgcn_readfirstlane(tid >> 6), lane = tid & 63, wr = wid >> 2, wc = wid & 3, fr = lane & 15, fq = lane >> 4;
    int K_ = g.K; asm volatile("" : "+s"(K_));
    const int K = K_, nt = K / BK;
    unsigned voffA[2], voffB[2];
#pragma unroll
    for (int i = 0; i < 2; ++i) { int R, C; stage_rc(tid * 16 + i * 8192, R, C); const int Rb = Epi::PERM ? ((R & ~31) + perm32(R & 31)) : R;
        voffA[i] = (unsigned)(R * K + C) * 2u; voffB[i] = (unsigned)(Rb * K + C) * 2u; }
    const size_t kstep = (size_t)(BK * 2);
    const size_t hstep = (size_t)HALF * K * 2;
    const size_t tstep = 2 * hstep;
    const unsigned ldsw = (unsigned)wid * 1024u;
    const int aoff = lds_byte(wr * 64 + fr, fq * 8), boff = lds_byte(wc * 32 + fr, fq * 8);
#define PG8_SA(b, h) (((b) * 2 + (h)) * HTB)
#define PG8_SB(b, h) ((4 + (b) * 2 + (h)) * HTB)
#define PG8_STAGE(bufoff, gbase, voff) do { _Pragma("unroll") for (int _i = 0; _i < 2; ++_i) \
        __builtin_amdgcn_global_load_lds((const unsigned*)((const char*)(gbase) + (voff)[_i]), (PG8_LAS unsigned*)(lds + (bufoff) + ldsw + _i * 8192), 16, 0, 0); } while (0)
#define PG8_LDA(dst, b, h) do { _Pragma("unroll") for (int m = 0; m < 4; ++m) _Pragma("unroll") for (int k = 0; k < 2; ++k) dst[m][k] = *(const PG8_LAS bf16x8*)(lds + PG8_SA(b, h) + aoff + m * 2048 + k * 1024); } while (0)
#define PG8_LDB(dst, b, h) do { _Pragma("unroll") for (int n = 0; n < 2; ++n) _Pragma("unroll") for (int k = 0; k < 2; ++k) dst[n][k] = *(const PG8_LAS bf16x8*)(lds + PG8_SB(b, h) + boff + n * 2048 + k * 1024); } while (0)
#define PG8_MMA(ai, bj, At, Bt) do { __builtin_amdgcn_s_setprio(1); _Pragma("unroll") for (int m = 0; m < 4; ++m) _Pragma("unroll") for (int n = 0; n < 2; ++n) _Pragma("unroll") for (int k = 0; k < 2; ++k) \
        acc[ai][bj][m][n] = __builtin_amdgcn_mfma_f32_16x16x32_bf16(Bt[n][k], At[m][k], acc[ai][bj][m][n], 0, 0, 0); __builtin_amdgcn_s_setprio(0); } while (0)
#define PG8_WAIT_V(n) asm volatile("s_waitcnt vmcnt(" #n ")" ::: "memory")
#define PG8_WAIT_L(n) asm volatile("s_waitcnt lgkmcnt(" #n ")" ::: "memory")
#define PG8_BAR __builtin_amdgcn_s_barrier()
#define PG8_SCHED __builtin_amdgcn_sched_barrier(0)
    Unit cur, nxt; int ui = 0;
    if (!S.next(0, cur)) return;
    f32x4 acc[2][2][4][2];
#pragma unroll
    for (int a = 0; a < 2; ++a)
#pragma unroll
        for (int b = 0; b < 2; ++b)
#pragma unroll
            for (int m = 0; m < 4; ++m)
#pragma unroll
                for (int n = 0; n < 2; ++n) acc[a][b][m][n] = (f32x4){0.f, 0.f, 0.f, 0.f};
    bf16x8 At[4][2], B0[2][2], B1[2][2];
    const char* cA = (const char*)g.A + (size_t)cur.pm * tstep; const char* cB = (const char*)g.Bt + (size_t)cur.pn * tstep + (g.grp_tiles ? (size_t)(cur.pm / g.grp_tiles) * g.grp_stride : (size_t)0);
    S.a_ready(cur);
    if constexpr (SP2) {
        PG8_STAGE(PG8_SB(0, 0), cB, voffB); PG8_STAGE(PG8_SB(0, 1), cB + hstep, voffB); PG8_STAGE(PG8_SA(0, 0), cA, voffA); PG8_STAGE(PG8_SA(0, 1), cA + hstep, voffA);
        if (wr == 1) PG8_BAR;
        PG8_WAIT_V(2); PG8_BAR;
        PG8_STAGE(PG8_SB(1, 0), cB + kstep, voffB); PG8_STAGE(PG8_SA(1, 0), cA + kstep, voffA); PG8_STAGE(PG8_SB(1, 1), cB + hstep + kstep, voffB);
        PG8_WAIT_V(6); PG8_BAR;
    } else {
        PG8_STAGE(PG8_SB(0, 0), cB, voffB); PG8_STAGE(PG8_SA(0, 0), cA, voffA); PG8_STAGE(PG8_SB(0, 1), cB + hstep, voffB); PG8_STAGE(PG8_SA(0, 1), cA + hstep, voffA);
        if (wr == 1) PG8_BAR;
        PG8_WAIT_V(4); PG8_BAR;
        PG8_STAGE(PG8_SB(1, 0), cB + kstep, voffB); PG8_STAGE(PG8_SA(1, 0), cA + kstep, voffA); PG8_STAGE(PG8_SB(1, 1), cB + hstep + kstep, voffB);
        PG8_WAIT_V(6); PG8_BAR;
    }
    for (;;) {
        const bool has_next = S.next(ui + 1, nxt);
        const char* nA = has_next ? (const char*)g.A + (size_t)nxt.pm * tstep : cA; const char* nB = has_next ? (const char*)g.Bt + (size_t)nxt.pn * tstep + (g.grp_tiles ? (size_t)(nxt.pm / g.grp_tiles) * g.grp_stride : (size_t)0) : cB;
        for (int t = 0; t < nt; t += 2) {
            const bool last = (t == nt - 2);
            const char* a1 = cA + (size_t)(t + 1) * kstep;
            const char* a2 = last ? nA : cA + (size_t)(t + 2) * kstep; const char* b2 = last ? nB : cB + (size_t)(t + 2) * kstep;
            const char* a3 = a2 + kstep; const char* b3 = b2 + kstep;
            if (last && has_next) S.a_ready(nxt);
            if constexpr (SP2) {
            PG8_LDB(B0, 0, 0); PG8_LDB(B1, 0, 1); PG8_SCHED; PG8_LDA(At, 0, 0); PG8_STAGE(PG8_SA(1, 1), a1 + hstep, voffA);
            PG8_WAIT_V(8); PG8_WAIT_L(0); PG8_BAR; PG8_MMA(0, 0, At, B0); PG8_MMA(0, 1, At, B1); PG8_BAR; PG8_SCHED;
            PG8_LDA(At, 0, 1); PG8_STAGE(PG8_SB(0, 0), b2, voffB); PG8_STAGE(PG8_SB(0, 1), b2 + hstep, voffB); PG8_STAGE(PG8_SA(0, 0), a2, voffA);
            PG8_WAIT_V(8); PG8_WAIT_L(0); PG8_BAR; PG8_MMA(1, 0, At, B0); PG8_MMA(1, 1, At, B1); PG8_BAR; PG8_SCHED;
            PG8_LDB(B0, 1, 0); PG8_LDB(B1, 1, 1); PG8_SCHED; PG8_LDA(At, 1, 0); PG8_STAGE(PG8_SA(0, 1), a2 + hstep, voffA);
            PG8_WAIT_V(8); PG8_WAIT_L(0); PG8_BAR; PG8_MMA(0, 0, At, B0); PG8_MMA(0, 1, At, B1); PG8_BAR; PG8_SCHED;
            PG8_LDA(At, 1, 1); PG8_STAGE(PG8_SB(1, 0), b3, voffB); PG8_STAGE(PG8_SB(1, 1), b3 + hstep, voffB); PG8_STAGE(PG8_SA(1, 0), a3, voffA);
            PG8_WAIT_V(8); PG8_WAIT_L(0); PG8_BAR; PG8_MMA(1, 0, At, B0); PG8_MMA(1, 1, At, B1); PG8_BAR; PG8_SCHED;
            } else {
            PG8_LDB(B0, 0, 0); PG8_SCHED; PG8_LDA(At, 0, 0); PG8_STAGE(PG8_SA(1, 1), a1 + hstep, voffA);
            PG8_WAIT_L(8); PG8_BAR; PG8_WAIT_L(0); PG8_MMA(0, 0, At, B0); PG8_BAR; PG8_SCHED;
            PG8_LDB(B1, 0, 1); PG8_STAGE(PG8_SB(0, 0), b2, voffB);
            PG8_BAR; PG8_WAIT_L(0); PG8_MMA(0, 1, At, B1); PG8_BAR;
            PG8_LDA(At, 0, 1); PG8_STAGE(PG8_SA(0, 0), a2, voffA);
            PG8_BAR; PG8_WAIT_L(0); PG8_MMA(1, 0, At, B0); PG8_BAR; PG8_SCHED;
            PG8_STAGE(PG8_SB(0, 1), b2 + hstep, voffB);
            PG8_WAIT_V(6); PG8_BAR; PG8_MMA(1, 1, At, B1); PG8_BAR;
            PG8_LDB(B0, 1, 0); PG8_SCHED; PG8_LDA(At, 1, 0); PG8_STAGE(PG8_SA(0, 1), a2 + hstep, voffA);
            PG8_WAIT_L(8); PG8_BAR; PG8_WAIT_L(0); PG8_MMA(0, 0, At, B0); PG8_BAR; PG8_SCHED;
            PG8_LDB(B1, 1, 1); PG8_STAGE(PG8_SB(1, 0), b3, voffB);
            PG8_BAR; PG8_WAIT_L(0); PG8_MMA(0, 1, At, B1); PG8_BAR;
            PG8_LDA(At, 1, 1); PG8_STAGE(PG8_SA(1, 0), a3, voffA);
            PG8_BAR; PG8_WAIT_L(0); PG8_MMA(1, 0, At, B0); PG8_BAR; PG8_SCHED;
            PG8_STAGE(PG8_SB(1, 1), b3 + hstep, voffB);
            PG8_WAIT_V(6); PG8_BAR; PG8_MMA(1, 1, At, B1); PG8_BAR;
            }
        }
        if constexpr (ALIGN_EPI) { if (wr == 0) PG8_BAR; }
        if constexpr (!Epi::AFTER_DRAIN) { E(acc, cur, wr, wc, fr, fq); S.done(cur); }
        if (!has_next) break;
#pragma unroll
        for (int a = 0; a < 2; ++a)
#pragma unroll
            for (int b = 0; b < 2; ++b)
#pragma unroll
                for (int m = 0; m < 4; ++m)
#pragma unroll
                    for (int n = 0; n < 2; ++n) acc[a][b][m][n] = (f32x4){0.f, 0.f, 0.f, 0.f};
        cur = nxt; cA = nA; cB = nB; ++ui;
        if constexpr (ALIGN_EPI) { if (wr == 1) PG8_BAR; }
    }
    PG8_WAIT_V(0);
    if constexpr (!ALIGN_EPI) { if (wr == 0) PG8_BAR; }
    PG8_BAR;
    if constexpr (Epi::AFTER_DRAIN) { E.fused(acc, cur, wr, wc, fr, fq, lds, wid, lane); S.done(cur); }
#undef PG8_SA
#undef PG8_SB
#undef PG8_STAGE
#undef PG8_LDA
#undef PG8_LDB
#undef PG8_MMA
#undef PG8_WAIT_V
#undef PG8_WAIT_L
#undef PG8_BAR
#undef PG8_SCHED
}
}


#define XB_TMO      128
#define XB_XCNT(j)  (256  + 64 * (j))
#define XB_XSUB(j)  (1280 + 64 * (j))
#define XB_XGEN(j)  (2304 + 64 * (j))
#define XB_TOP      3328
#define XB_TOPGEN   3392
#define XCD_BAR_WORDS 3456
#define XB_SPIN_CAP (1u << 22)
__device__ __forceinline__ unsigned xb_ld(unsigned* p)              { return __hip_atomic_load(p, __ATOMIC_RELAXED, __HIP_MEMORY_SCOPE_AGENT); }
__device__ __forceinline__ unsigned xb_add(unsigned* p, unsigned v) { return __hip_atomic_fetch_add(p, v, __ATOMIC_RELAXED, __HIP_MEMORY_SCOPE_AGENT); }
__device__ __forceinline__ unsigned xb_xcc_id() { return (unsigned)__builtin_amdgcn_s_getreg((3 << 11) | 20) & 0xFu; }
#define XB_SPIN(cond, bar) do { unsigned _sp = 0; while (cond) { __builtin_amdgcn_s_sleep(1); \
    if ((++_sp & 255u) == 0u) { if (xb_ld(&(bar)[XB_TMO])) break; if (_sp > XB_SPIN_CAP) { atomicAdd(&(bar)[XB_TMO], 1u); break; } } } } while (0)
struct XcdBarrier { unsigned* bar; unsigned x; volatile LAS unsigned* st; };
__device__ __forceinline__ XcdBarrier xcd_barrier_post(unsigned* bar, volatile LAS unsigned* st) {
    XcdBarrier b; b.bar = bar; b.x = xb_xcc_id(); b.st = st;
    if (threadIdx.x == 0) (void)xb_add(&bar[XB_XCNT(b.x)], 1u);
    return b;
}
__device__ __forceinline__ void xcd_barrier_complete(unsigned* bar, unsigned x, unsigned& nloc, unsigned& nx) {
    const unsigned G = gridDim.x * gridDim.y * gridDim.z;
    unsigned sum, cnt, mine, sp = 0u;
    for (;;) {
        sum = 0u; cnt = 0u; mine = 0u;
#pragma unroll
        for (unsigned j = 0; j < 16; ++j) { const unsigned c = xb_ld(&bar[XB_XCNT(j)]); sum += c; cnt += (c > 0u) ? 1u : 0u; mine = (j == x) ? c : mine; }
        if (sum == G) break;
        __builtin_amdgcn_s_sleep(1);
        if ((++sp & 255u) == 0u) { if (xb_ld(&bar[XB_TMO])) break; if (sp > XB_SPIN_CAP) { atomicAdd(&bar[XB_TMO], 1u); break; } }
    }
    nloc = mine > 0u ? mine : 1u; nx = cnt > 0u ? cnt : 1u;
}
__device__ __forceinline__ void xcd_barrier(const XcdBarrier& b) {
    asm volatile("s_waitcnt vmcnt(0)" ::: "memory");
    __syncthreads();
    if (threadIdx.x == 0) {
        unsigned* bar = b.bar;
        __builtin_amdgcn_s_waitcnt(0);
        unsigned nloc = b.st[0], nx = b.st[1];
        if (nloc == 0u) { xcd_barrier_complete(bar, b.x, nloc, nx); b.st[0] = nloc; b.st[1] = nx; }
        const unsigned old = xb_add(&bar[XB_XSUB(b.x)], 1u);
        const unsigned gen = old / nloc;
        if (old + 1u == (gen + 1u) * nloc) {
            __builtin_amdgcn_fence(__ATOMIC_RELEASE, "agent");
            asm volatile("s_waitcnt vmcnt(0)" ::: "memory");
            const unsigned og = xb_add(&bar[XB_TOP], 1u);
            const unsigned tg = og / nx;
            if (og + 1u == (tg + 1u) * nx) xb_add(&bar[XB_TOPGEN], 1u);
            else XB_SPIN(xb_ld(&bar[XB_TOPGEN]) == tg, bar);
            __builtin_amdgcn_fence(__ATOMIC_ACQUIRE, "agent");
            xb_add(&bar[XB_XGEN(b.x)], 1u);
            asm volatile("s_waitcnt vmcnt(0)" ::: "memory");
        } else {
            XB_SPIN(xb_ld(&bar[XB_XGEN(b.x)]) == gen, bar);
            __builtin_amdgcn_fence(__ATOMIC_ACQUIRE, "agent");
            asm volatile("s_waitcnt vmcnt(0)" ::: "memory");
        }
    }
    __syncthreads();
}


typedef short bf16x8 __attribute__((ext_vector_type(8)));
typedef short s16x4 __attribute__((ext_vector_type(4)));
typedef float f32x16 __attribute__((ext_vector_type(16)));
typedef unsigned v4u __attribute__((ext_vector_type(4)));
typedef unsigned v2u __attribute__((ext_vector_type(2)));
constexpr float ATT_THR = 5.0f;
template <int DK> struct AttL { static constexpr int KSTR = DK * 2 + 16, KBYTES = 64 * KSTR, VSTR = 136, VBYTES = 64 * VSTR, BUF = KBYTES + VBYTES, KCH = 64 * DK / 8, KPT = (KCH + NTHREADS - 1) / NTHREADS; };

template <int DK>
__device__ __forceinline__ void attn_pass(const bf16_t* Qrow, const bf16_t* Kp, const bf16_t* Vtp, int vt_ld, int nkt, LAS unsigned char* lds, int tid, f32x16 (&oacc)[2], float& m_run, float& l_run) {
    typedef AttL<DK> L;
    const int lane = tid & 63, r = lane & 31, h = lane >> 5;
    bf16x8 qf[DK / 16];
#pragma unroll
    for (int ks = 0; ks < DK / 16; ++ks) qf[ks] = *(const bf16x8*)(Qrow + 16 * ks + 8 * h);
    v4u kreg[L::KPT]; v4u vreg;
    const int vd = tid >> 3, vpart = tid & 7;
#define ATT_LOAD(j) do { _Pragma("unroll") for (int i_ = 0; i_ < L::KPT; ++i_) { const int c_ = tid + i_ * NTHREADS; if (c_ < L::KCH) kreg[i_] = *(const v4u*)(Kp + (size_t)(j) * 64 * DK + c_ * 8); } \
        vreg = *(const v4u*)(Vtp + (size_t)vd * vt_ld + (j) * 64 + vpart * 8); } while (0)
#define ATT_STORE(buf) do { _Pragma("unroll") for (int i_ = 0; i_ < L::KPT; ++i_) { const int c_ = tid + i_ * NTHREADS; if (c_ < L::KCH) { const int key_ = c_ / (DK / 8), part_ = c_ % (DK / 8); \
            *(LAS v4u*)(lds + (buf) * L::BUF + key_ * L::KSTR + part_ * 16) = kreg[i_]; } } \
        { LAS unsigned char* vp_ = lds + (buf) * L::BUF + L::KBYTES + vd * L::VSTR + vpart * 16; *(LAS v2u*)vp_ = (v2u){vreg.x, vreg.y}; *(LAS v2u*)(vp_ + 8) = (v2u){vreg.z, vreg.w}; } } while (0)
    __syncthreads();
    ATT_LOAD(0); ATT_STORE(0);
    __syncthreads();
    for (int j = 0; j < nkt; ++j) {
        const int buf = j & 1;
        if (j + 1 < nkt) ATT_LOAD(j + 1);
        f32x16 sacc[2];
#pragma unroll
        for (int kb = 0; kb < 2; ++kb) {
#pragma unroll
            for (int i = 0; i < 16; ++i) sacc[kb][i] = 0.f;
#pragma unroll
            for (int ks = 0; ks < DK / 16; ++ks) {
                const bf16x8 a = *(const LAS bf16x8*)(lds + buf * L::BUF + (32 * kb + r) * L::KSTR + (16 * ks + 8 * h) * 2);
                sacc[kb] = __builtin_amdgcn_mfma_f32_32x32x16_bf16(a, qf[ks], sacc[kb], 0, 0, 0);
            }
        }
        float tmax = sacc[0][0];
#pragma unroll
        for (int i = 1; i < 16; ++i) tmax = fmaxf(tmax, sacc[0][i]);
#pragma unroll
        for (int i = 0; i < 16; ++i) tmax = fmaxf(tmax, sacc[1][i]);
        tmax = xor32_max(tmax);
        if (__any(tmax > m_run + ATT_THR)) {
            const float mn = fmaxf(m_run, tmax), alpha = __builtin_amdgcn_exp2f(m_run - mn);
#pragma unroll
            for (int i = 0; i < 16; ++i) { oacc[0][i] *= alpha; oacc[1][i] *= alpha; }
            l_run *= alpha; m_run = mn;
        }
        float psum = 0.f;
#pragma unroll
        for (int kb = 0; kb < 2; ++kb)
#pragma unroll
            for (int i = 0; i < 16; ++i) { const float pv = __builtin_amdgcn_exp2f(sacc[kb][i] - m_run); sacc[kb][i] = pv; psum += pv; }
        l_run += psum;
#pragma unroll
        for (int kb = 0; kb < 2; ++kb)
#pragma unroll
            for (int s2 = 0; s2 < 2; ++s2) {
                union { bf16x8 v; unsigned u[4]; } pf;
#pragma unroll
                for (int i = 0; i < 4; ++i) pf.u[i] = pg8::cvt_pk_bf16(sacc[kb][8 * s2 + 2 * i], sacc[kb][8 * s2 + 2 * i + 1]);
#pragma unroll
                for (int db = 0; db < 2; ++db) {
                    const LAS unsigned char* vp = lds + buf * L::BUF + L::KBYTES + (32 * db + r) * L::VSTR + (32 * kb + 16 * s2 + 4 * h) * 2;
                    union { bf16x8 v; v2u u[2]; } af; af.u[0] = *(const LAS v2u*)vp; af.u[1] = *(const LAS v2u*)(vp + 16);
                    oacc[db] = __builtin_amdgcn_mfma_f32_32x32x16_bf16(af.v, pf.v, oacc[db], 0, 0, 0);
                }
            }
        if (j + 1 < nkt) ATT_STORE(buf ^ 1);
        __syncthreads();
    }
#undef ATT_LOAD
#undef ATT_STORE
}


constexpr int SLD = 65;
__device__ __forceinline__ int rm32(int t, int h) { return (t & 3) + 8 * (t >> 2) + 4 * h; }
template <bool WITH_Y>
__device__ __forceinline__ void ssd_block(int b, int dir, int k, int hp, const float* xbc, const float* dtp, const float* alog, float* hs, float* alast, float* yd, float* lds, int tid) {
    const bool lat = k >= 2; const int c = lat ? (dir ? 33 - k : k - 2) : (dir ? 1 - k : k);
    const int row0 = tok_row(lat, b, c * 128), g = hp >> 1;
    float* sB = lds; float* sC = sB + 128 * SLD; float* sX = sC + 128 * SLD; float* sDT = sX + 128 * 128; float* sCum = sDT + 256; float* sW = sCum + 256; float* sSc = sW + 256;
    const int wave = tid >> 6, lane = tid & 63, r = lane & 31, h = lane >> 5, hl = wave >> 2, head = 2 * hp + hl;
    float* hsp = hs + (((size_t)(b * 2 + dir) * NCH + k) * 8 + head) * 4096;
    float hreg[WITH_Y ? 64 : 1];
    if (WITH_Y) {
#pragma unroll
        for (int Pb = 0; Pb < 2; ++Pb)
#pragma unroll
            for (int ks = 0; ks < 32; ++ks) hreg[Pb * 32 + ks] = hsp[(2 * ks + h) * 64 + 32 * Pb + r];
    }
    float4 vb[8], vx[8]; float dx[8]; float dtv = 0.f, dav = 0.f;
#pragma unroll
    for (int u = 0; u < 8; ++u) { const int i = tid + u * NTHREADS, t = i >> 5, c4 = i & 31;
        vb[u] = *(const float4*)(xbc + (size_t)(row0 + t) * 768 + 512 + (c4 >> 4) * 128 + g * 64 + (c4 & 15) * 4);
        vx[u] = *(const float4*)(xbc + (size_t)(row0 + t) * 768 + hp * 128 + c4 * 4);
        dx[u] = dtp[(size_t)(row0 + t) * 16 + dir * 8 + 2 * hp + (c4 >> 4)]; }
    if (tid < 256) { const int hl = tid >> 7, t = tid & 127, h = 2 * hp + hl; dtv = dtp[(size_t)(row0 + t) * 16 + dir * 8 + h]; dav = dtv * -expf(alog[dir * 8 + h]); }
    __syncthreads();
#pragma unroll
    for (int u = 0; u < 8; ++u) { const int i = tid + u * NTHREADS, t = i >> 5, c4 = i & 31;
        float* d = (c4 >> 4 ? sC : sB) + t * SLD + (c4 & 15) * 4; d[0] = vb[u].x; d[1] = vb[u].y; d[2] = vb[u].z; d[3] = vb[u].w;
        *(float4*)(sX + t * 128 + c4 * 4) = f4scale(vx[u], dx[u]); }
    if (tid < 256) { const int t = tid & 127; sSc[(tid & 128) + (dir ? 127 - t : t)] = dav; }
    __syncthreads();
    for (int off = 1; off < 128; off <<= 1) { float v = 0.f; const int sI = tid & 127;
        if (tid < 256) { v = sSc[tid]; if (sI >= off) v += sSc[tid - off]; }
        __syncthreads(); if (tid < 256) sSc[tid] = v; __syncthreads(); }
    if (tid < 256) { const int hl = tid >> 7, sI = tid & 127, t = dir ? 127 - sI : sI; const float cu = sSc[tid], tot = sSc[hl * 128 + 127];
        sCum[hl * 128 + t] = cu; sW[hl * 128 + t] = expf(tot - cu);
        if (!WITH_Y && sI == 127) alast[((size_t)(b * 2 + dir) * NCH + k) * 8 + 2 * hp + hl] = tot; }
    __syncthreads();
    if (WITH_Y) {
        const int I = hl ? 3 - (wave & 3) : (wave & 3), ti = 32 * I + r;
        const float cum_i = sCum[hl * 128 + ti];
        f32x16 Y[2], Yo[2];
#pragma unroll
        for (int i = 0; i < 16; ++i) { Y[0][i] = 0.f; Y[1][i] = 0.f; Yo[0][i] = 0.f; Yo[1][i] = 0.f; }
#pragma unroll
        for (int Pb = 0; Pb < 2; ++Pb)
#pragma unroll
            for (int ks = 0; ks < 32; ++ks) Yo[Pb] = __builtin_amdgcn_mfma_f32_32x32x2f32(hreg[Pb * 32 + ks], sC[(32 * I + r) * SLD + 2 * ks + h], Yo[Pb], 0, 0, 0);
        const int J0 = dir ? I : 0, J1 = dir ? 3 : I;
        for (int J = J0; J <= J1; ++J) {
            f32x16 Gt;
#pragma unroll
            for (int i = 0; i < 16; ++i) Gt[i] = 0.f;
#pragma unroll 8
            for (int ks = 0; ks < 32; ++ks) Gt = __builtin_amdgcn_mfma_f32_32x32x2f32(sB[(32 * J + r) * SLD + 2 * ks + h], sC[(32 * I + r) * SLD + 2 * ks + h], Gt, 0, 0, 0);
#pragma unroll
            for (int t = 0; t < 16; ++t) { const int tj = 32 * J + rm32(t, h); const bool valid = (J != I) || (dir ? tj >= ti : tj <= ti);
                Gt[t] *= valid ? __expf(cum_i - sCum[hl * 128 + tj]) : 0.f; }
#pragma unroll
            for (int Pb = 0; Pb < 2; ++Pb)
#pragma unroll
                for (int t = 0; t < 16; ++t) Y[Pb] = __builtin_amdgcn_mfma_f32_32x32x2f32(sX[(32 * J + rm32(t, h)) * 128 + hl * 64 + 32 * Pb + r], Gt[t], Y[Pb], 0, 0, 0);
        }
        const float ei = __expf(cum_i);
        float* yrow = yd + ((size_t)dir * NTOK + row0 + ti) * 512 + head * 64;
#pragma unroll
        for (int Pb = 0; Pb < 2; ++Pb)
#pragma unroll
            for (int tq = 0; tq < 4; ++tq)
                *(float4*)(yrow + 32 * Pb + 8 * tq + 4 * h) = make_float4(Y[Pb][4 * tq] + ei * Yo[Pb][4 * tq], Y[Pb][4 * tq + 1] + ei * Yo[Pb][4 * tq + 1], Y[Pb][4 * tq + 2] + ei * Yo[Pb][4 * tq + 2], Y[Pb][4 * tq + 3] + ei * Yo[Pb][4 * tq + 3]);
    } else {
        const int Nb = (wave >> 1) & 1, Pb = wave & 1;
        f32x16 acc;
#pragma unroll
        for (int i = 0; i < 16; ++i) acc[i] = 0.f;
#pragma unroll 8
        for (int ks = 0; ks < 64; ++ks) { const int j = 2 * ks + h;
            acc = __builtin_amdgcn_mfma_f32_32x32x2f32(sB[j * SLD + 32 * Nb + r] * sW[hl * 128 + j], sX[j * 128 + hl * 64 + 32 * Pb + r], acc, 0, 0, 0); }
#pragma unroll
        for (int t = 0; t < 16; ++t) hsp[(32 * Nb + rm32(t, h)) * 64 + 32 * Pb + r] = acc[t];
    }
}

template <class RM>
__device__ __forceinline__ void cvt_tile(const float* src, int N, bf16_t* dst, int ldd, RM rowmap, int k0, int n0, int lane) {
    const int n = n0 + lane;
    if (n < N) {
        const float* sp = src + (size_t)k0 * N + n;
        float v[32];
#pragma unroll
        for (int kk = 0; kk < 32; ++kk) v[kk] = sp[(size_t)kk * N];
        uint4* dp = (uint4*)(dst + (size_t)rowmap(n) * ldd + k0);
#pragma unroll
        for (int i = 0; i < 4; ++i) dp[i] = make_uint4(pk2(v[8 * i], v[8 * i + 1]), pk2(v[8 * i + 2], v[8 * i + 3]), pk2(v[8 * i + 4], v[8 * i + 5]), pk2(v[8 * i + 6], v[8 * i + 7]));
    }
}
__device__ __forceinline__ int block_excl_scan(int v, int tid, volatile int* sh, int& total) {
    const int lane = tid & 63, wave = tid >> 6; int x = v;
#pragma unroll
    for (int o = 1; o < 64; o <<= 1) { const int y = __shfl_up(x, o); if (lane >= o) x += y; }
    __syncthreads();
    if (lane == 63) sh[wave] = x;
    __syncthreads();
    int off = 0, tot = 0;
#pragma unroll
    for (int w = 0; w < 8; ++w) { const int c = sh[w]; tot += c; if (w < wave) off += c; }
    total = tot;
    return off + x - v;
}
__device__ __forceinline__ int block_sum(int v, int tid, volatile int* sh, int parity) {
    const int lane = tid & 63, wave = tid >> 6;
#pragma unroll
    for (int o = 32; o > 0; o >>= 1) v += __shfl_xor(v, o);
    if (lane == 0) sh[parity * 8 + wave] = v;
    __syncthreads();
    int tot = 0;
#pragma unroll
    for (int w = 0; w < 8; ++w) tot += sh[parity * 8 + w];
    return tot;
}

#define MOD ((float*)(kp_->ws + WS_MOD))
#define CTXC ((float*)(kp_->ws + WS_CTXC))
#define AFF ((float*)(kp_->ws + WS_AFF))
#define TOKSLOT ((int*)(kp_->ws + WS_TOKSLOT))
#define SELIDX ((int*)(kp_->ws + WS_SELIDX))
#define SELGATE ((float*)(kp_->ws + WS_SELGATE))
#define DT ((float*)(kp_->ws + WS_DT))
#define HB ((bf16_t*)(kp_->ws + WS_HB))
#define HS ((float*)(kp_->ws + WS_HS))
#define YD ((float*)(kp_->ws + WS_YD))
#define ALAST ((float*)(kp_->ws + WS_ALAST))
#define ROPE ((float*)(kp_->ws + WS_ROPE))
#define PB ((float*)(kp_->ws + WS_P))
#define XBC ((float*)(kp_->ws + WS_XBC))
#define MQ ((float*)(kp_->ws + WS_MQ))
#define MKV ((float*)(kp_->ws + WS_MKV))
#define CQB ((bf16_t*)(kp_->ws + WS_CQB))
#define CKVB ((bf16_t*)(kp_->ws + WS_CKVB))
#define MIXB ((bf16_t*)(kp_->ws + WS_MIXB))
#define MOUT ((float*)(kp_->ws + WS_MOUT))
#define XG ((bf16_t*)(kp_->ws + WS_XG))
#define HID ((bf16_t*)(kp_->ws + WS_HID))
#define Y ((float*)(kp_->ws + WS_Y))
#define WIN_T ((bf16_t*)(kp_->ws + WS_WIN))
#define WQ_T ((bf16_t*)(kp_->ws + WS_WQ))
#define WKV_T ((bf16_t*)(kp_->ws + WS_WKV))
#define WOUT_T ((bf16_t*)(kp_->ws + WS_WOUT))
#define WGU_T ((bf16_t*)(kp_->ws + WS_WGU))
#define WD_T ((bf16_t*)(kp_->ws + WS_WD))
#define QD ((bf16_t*)(kp_->ws + WS_QD))
#define QDC ((bf16_t*)(kp_->ws + WS_QDC))
#define KD ((bf16_t*)(kp_->ws + WS_KD))
#define VDT ((bf16_t*)(kp_->ws + WS_VDT))
#define QM ((bf16_t*)(kp_->ws + WS_QM))
#define QMC ((bf16_t*)(kp_->ws + WS_QMC))
#define KM ((bf16_t*)(kp_->ws + WS_KM))
#define VMT ((bf16_t*)(kp_->ws + WS_VMT))
#define xcur (kp_->out)
#define DTMP XBC
#define modl (MOD + (size_t)l * (NB + 1) * NMOD * D)
typedef const __attribute__((address_space(4))) Prm* KPrm;
#define PHASE_BEGIN() KPrm kp_ = (KPrm)__builtin_amdgcn_kernarg_segment_ptr(); asm volatile("" : "+s"(kp_)); int tid = threadIdx.x; asm volatile("" : "+v"(tid)); (void)tid
#define GSYNC() do { XcdBarrier b_; b_.bar = (unsigned*)(kp_->ws + WS_CTL); b_.x = xb_xcc_id(); b_.st = (volatile LAS unsigned*)(ldsb + LDS_BYTES - 64); xcd_barrier(b_); } while (0)
__global__ void __launch_bounds__(NTHREADS, 2) mk_forward(Prm p) {
    extern __shared__ __attribute__((aligned(16))) unsigned char lds_raw[];
    LAS unsigned char* const ldsb = (LAS unsigned char*)lds_raw;
    volatile LAS unsigned* st = (volatile LAS unsigned*)(ldsb + LDS_BYTES - 64);
    if (threadIdx.x < 16) st[threadIdx.x] = 0u;
    __syncthreads();
    (void)xcd_barrier_post((unsigned*)(p.ws + WS_CTL), st);
    const int G = gridDim.x, bid = blockIdx.x;
    const int vcu = (G % 8 == 0) ? (bid % 8) * (G / 8) + bid / 8 : bid;

    {
        PHASE_BEGIN();
        const float* c = kp_->in[I_C]; const float* cc = kp_->in[I_CCTX]; const float* adaw = kp_->in[I_ADAW]; const float* adab = kp_->in[I_ADAB];
        float* sc_l = (float*)lds_raw;
        for (int i = tid; i < (NB + 1) * D; i += NTHREADS) { const int r = i / D, k = i % D; sc_l[i] = siluf(r < NB ? c[(size_t)r * D + k] : cc[k]); }
        __syncthreads();
        ITEMS(i, DEPTH * (NB + 1) * NMOD * D) {
            const int j = i % (NMOD * D), r = (i / (NMOD * D)) % (NB + 1), l = i / ((NB + 1) * NMOD * D);
            const float* src = sc_l + r * D;
            const float* w = adaw + (size_t)l * D * NMOD * D + j;
            float acc = adab[l * NMOD * D + j];
#pragma unroll 8
            for (int k = 0; k < D; ++k) acc += src[k] * w[(size_t)k * NMOD * D];
            MOD[i] = acc;
        }
        ITEMS(i, S * 16) {
            const int t = i >> 4, w = i & 15, ii = w & 7; const float pos = (float)(w < 8 ? t / GRID_W : t % GRID_W);
            const float ang = pos * powf(10000.0f, -(float)ii / 8.0f);
            ROPE[(size_t)t * 32 + (w < 8 ? 0 : 16) + ii] = cosf(ang); ROPE[(size_t)t * 32 + (w < 8 ? 8 : 24) + ii] = sinf(ang);
        }
        const float4* x4 = (const float4*)kp_->in[I_X]; const float4* c4 = (const float4*)kp_->in[I_CTX];
        ITEMS(i, NLAT * D / 4) ((float4*)xcur)[i] = x4[i];
        ITEMS(i, NCTX * D / 4) ((float4*)CTXC)[i] = c4[i];
        GSYNC();
    }

#pragma unroll 1
    for (int l = 0; l < DEPTH; ++l) {
        const bool ctx_out = l < DEPTH - 1;
        const float lambda_init = 0.8f - 0.6f * expf(-0.3f * (float)l);
        const int nrows_out = ctx_out ? NTOK : NLAT;
        const int ER = ctx_out ? ER_MAX : NB * CAP_L;

        {
            PHASE_BEGIN();
            {
                const int lane = tid & 63; auto idm = [](int n) { return n; };
                constexpr int T_WIN = (D / 32) * ((IN_COLS + 63) / 64), T_WQ = (192 / 32) * (384 / 64), T_WKV = (128 / 32) * (512 / 64), T_WOUT = (MIXW / 32) * (D / 64);
                WITEMS(id, T_WIN + T_WQ + T_WKV + T_WOUT) {
                    if (id < T_WIN) { const int nt = (IN_COLS + 63) / 64; cvt_tile(kp_->in[I_WIN] + (size_t)l * D * IN_COLS, IN_COLS, WIN_T, D, idm, (id / nt) * 32, (id % nt) * 64, lane); }
                    else if (id < T_WIN + T_WQ) { const int u = id - T_WIN; cvt_tile(kp_->in[I_WQUP] + (size_t)l * 192 * 384, 384, WQ_T, 256, idm, (u / 6) * 32, (u % 6) * 64, lane); }
                    else if (id < T_WIN + T_WQ + T_WKV) { const int u = id - T_WIN - T_WQ; cvt_tile(kp_->in[I_WKVUP] + (size_t)l * 128 * 512, 512, WKV_T, 128, idm, (u / 8) * 32, (u % 8) * 64, lane); }
                    else { const int u = id - T_WIN - T_WQ - T_WKV; cvt_tile(kp_->in[I_WOUT] + (size_t)l * MIXW * D, D, WOUT_T, MIXW, idm, (u / 16) * 32, (u % 16) * 64, lane); }
                }
            }
            ITEMS(i, (IN_PAD - IN_COLS) * D / 8) ((uint4*)(WIN_T + (size_t)IN_COLS * D))[i] = make_uint4(0, 0, 0, 0);
            ITEMS(i, 128 * 256 / 8) ((uint4*)(WQ_T + (size_t)384 * 256))[i] = make_uint4(0, 0, 0, 0);
            ITEMS(i, 384 * 8) { const int r = i >> 3, c8 = i & 7; *(uint4*)(WQ_T + (size_t)r * 256 + 192 + c8 * 8) = make_uint4(0, 0, 0, 0); }

            const float* w = kp_->in[I_NMPRE] + l * D;
            const int lane = tid & 63;
            WITEMS(r, NTOK) {
                const float4* src = (const float4*)(r < NLAT ? xcur + (size_t)r * D : CTXC + (size_t)(r - NLAT) * D);
                const float* md = modl + (size_t)(r < NLAT ? r / S : NB) * NMOD * D;
                float4 v[4]; float ss = 0.f;
#pragma unroll
                for (int i = 0; i < 4; ++i) { v[i] = src[i * 64 + lane]; ss += f4dot(v[i], v[i]); }
                ss = wave_sum(ss);
                const float rs = 1.0f / sqrtf(ss / D + EPS);
#pragma unroll
                for (int i = 0; i < 4; ++i) { const int k4 = i * 64 + lane; const float4 w4 = ((const float4*)w)[k4], sc = ((const float4*)(md + D))[k4], sh = ((const float4*)md)[k4];
                    const float4 o = make_float4(v[i].x * rs * w4.x * (1.0f + sc.x) + sh.x, v[i].y * rs * w4.y * (1.0f + sc.y) + sh.y, v[i].z * rs * w4.z * (1.0f + sc.z) + sh.z, v[i].w * rs * w4.w * (1.0f + sc.w) + sh.w);
                    *(uint2*)(HB + (size_t)r * D + k4 * 4) = pk4(o); }
            }
            GSYNC();
        }
        {
            PHASE_BEGIN();
            pg8::Gemm g{HB, WIN_T, NTOK, IN_PAD, D, 0, 0}; pg8::StaticOrder so; so.init(NTOK, IN_PAD, G, bid);
            pg8::EpiF32 E{PB, IN_COLS, IN_COLS};
            pg8::gemm_phase<pg8::EpiF32, pg8::StaticOrder, true, true>(ldsb, g, so, E);
            GSYNC();
        }
        {
            PHASE_BEGIN();
            const float* cw = kp_->in[I_CONVW] + (size_t)l * 3 * 768; const float* cb = kp_->in[I_CONVB] + (size_t)l * 768;
            ITEMS(i, NTOK * 768) {
                const int c = i % 768, r = i / 768;
                const bool lat = r < NLAT; const int L = lat ? S : CTX; const int t = lat ? r % S : (r - NLAT) % CTX;
                const float* u = PB + (size_t)r * IN_COLS + C_XBC + c;
                float acc = cb[c] + cw[768 + c] * u[0];
                if (t > 0) acc += cw[c] * u[-IN_COLS];
                if (t < L - 1) acc += cw[2 * 768 + c] * u[IN_COLS];
                XBC[i] = siluf(acc);
            }
            const float* dtb = kp_->in[I_DTB] + l * 16;
            ITEMS(i, NTOK * 16) { const int j = i % 16, r = i / 16; DT[i] = softplusf(PB[(size_t)r * IN_COLS + C_DT + j] + dtb[j]); }
            ITEMS(i, NTOK * 16) {
                const int g = i & 15, r = i >> 4; const int hm = g & 7, isk = g >> 3;
                const bool lat = r < NLAT; const int b = lat ? r / S : (r - NLAT) / CTX, t = lat ? r % S : (r - NLAT) % CTX;
                if (!isk && !lat && !ctx_out) continue;
                const float* vp = PB + (size_t)r * IN_COLS + (isk ? C_DK : C_DQ) + hm * 32;
                float v[32];
#pragma unroll
                for (int k = 0; k < 32; ++k) v[k] = vp[k];
                if (lat) rope32(v, t, ROPE);
                const float sc = isk ? 1.0f : 0.17677669529663687f * 1.4426950408889634f;
                bf16_t* dst = isk ? KD + ((size_t)(b * 8 + hm) * SK + (lat ? CTX + t : t)) * 32 : (lat ? QD + ((size_t)(b * 8 + hm) * S + t) * 32 : QDC + ((size_t)(b * 8 + hm) * CTX + t) * 32);
#pragma unroll
                for (int k = 0; k < 32; k += 8) *(uint4*)(dst + k) = make_uint4(pk2(v[k] * sc, v[k + 1] * sc), pk2(v[k + 2] * sc, v[k + 3] * sc), pk2(v[k + 4] * sc, v[k + 5] * sc), pk2(v[k + 6] * sc, v[k + 7] * sc));
            }
            ITEMS(i, NB * 4 * (SK / 8) * 64) {
                const int d = i & 63, j8 = (i >> 6) % (SK / 8), hh = (i / (64 * (SK / 8))) & 3, b = i / (256 * (SK / 8));
                const int r0 = j8 * 8 < CTX ? tok_row(false, b, j8 * 8) : tok_row(true, b, j8 * 8 - CTX);
                const float* sp = PB + (size_t)r0 * IN_COLS + C_DV + hh * 64 + d;
                float v[8];
#pragma unroll
                for (int jj = 0; jj < 8; ++jj) v[jj] = sp[(size_t)jj * IN_COLS];
                *(uint4*)(VDT + ((size_t)(b * 4 + hh) * 64 + d) * SK + j8 * 8) = make_uint4(pk2(v[0], v[1]), pk2(v[2], v[3]), pk2(v[4], v[5]), pk2(v[6], v[7]));
            }
            const float* qn = kp_->in[I_QNORM] + l * 192; const float* kvn = kp_->in[I_KVNORM] + l * 128;
            { const int lane = tid & 63;
            WITEMS(i, NTOK * 2) {
                const int which = i & 1, r = i >> 1; const int n4 = which ? 32 : 48;
                const float4* v = (const float4*)(PB + (size_t)r * IN_COLS + (which ? C_CKV : C_CQ)); const float4* w = (const float4*)(which ? kvn : qn);
                float4 x = make_float4(0.f, 0.f, 0.f, 0.f); if (lane < n4) x = v[lane];
                const float ss = wave_sum(f4dot(x, x));
                const float rs = 1.0f / sqrtf(ss / (n4 * 4) + EPS);
                bf16_t* dst = which ? CKVB + (size_t)r * 128 : CQB + (size_t)r * 256;
                if (lane < n4) *(uint2*)(dst + lane * 4) = pk4(f4scale(f4mul(x, w[lane]), rs));
                else if (!which) *(uint2*)(dst + lane * 4) = make_uint2(0u, 0u);
            } }
            GSYNC();
        }
        {
            PHASE_BEGIN();
            const int half = G / 2;
            if (bid < half) {
                pg8::Gemm g{CQB, WQ_T, NTOK, 512, 256, 0, 0}; pg8::StaticOrder so; so.init(NTOK, 512, half, bid);
                pg8::EpiF32 E{MQ, 384, 384};
                pg8::gemm_phase<pg8::EpiF32, pg8::StaticOrder, true, true>(ldsb, g, so, E);
            } else {
                pg8::Gemm g{CKVB, WKV_T, NTOK, 512, 128, 0, 0}; pg8::StaticOrder so; so.init(NTOK, 512, G - half, bid - half);
                pg8::EpiF32 E{MKV, 512, 512};
                pg8::gemm_phase<pg8::EpiF32, pg8::StaticOrder, true, true>(ldsb, g, so, E);
            }
            for (int it = vcu; it < NB * NCH * 8; it += G) {
                const int hp = it & 3, dir = (it >> 2) & 1, cp = (it >> 3) % NCH, b = it / (8 * NCH);
                const int k = dir ? (cp < 2 ? 1 - cp : 35 - cp) : cp;
                if (k == NCH - 1) continue;
                ssd_block<false>(b, dir, k, hp, XBC, DT, kp_->in[I_ALOG] + l * 16, HS, ALAST, nullptr, (float*)lds_raw, tid);
            }
            GSYNC();
        }
        {
            PHASE_BEGIN();
            ITEMS(i, NTOK * 8) {
                const int g = i & 7, r = i >> 3; const int hh = g & 3, isk = g >> 2;
                const bool lat = r < NLAT; const int b = lat ? r / S : (r - NLAT) / CTX, t = lat ? r % S : (r - NLAT) % CTX;
                if (!isk && !lat && !ctx_out) continue;
                const float* np = isk ? MKV + (size_t)r * 512 + hh * 128 : MQ + (size_t)r * 384 + hh * 96;
                const float* rp = isk ? PB + (size_t)r * IN_COLS + C_KR : np + 64;
                float v[32];
#pragma unroll
                for (int k = 0; k < 32; ++k) v[k] = rp[k];
                if (lat) rope32(v, t, ROPE);
                const float sc = isk ? 1.0f : 0.10206207261596575f * 1.4426950408889634f;
                bf16_t* dst = isk ? KM + ((size_t)(b * 4 + hh) * SK + (lat ? CTX + t : t)) * 96 : (lat ? QM + ((size_t)(b * 4 + hh) * S + t) * 96 : QMC + ((size_t)(b * 4 + hh) * CTX + t) * 96);
#pragma unroll
                for (int k = 0; k < 64; k += 8) *(uint4*)(dst + k) = make_uint4(pk2(np[k] * sc, np[k + 1] * sc), pk2(np[k + 2] * sc, np[k + 3] * sc), pk2(np[k + 4] * sc, np[k + 5] * sc), pk2(np[k + 6] * sc, np[k + 7] * sc));
#pragma unroll
                for (int k = 0; k < 32; k += 8) *(uint4*)(dst + 64 + k) = make_uint4(pk2(v[k] * sc, v[k + 1] * sc), pk2(v[k + 2] * sc, v[k + 3] * sc), pk2(v[k + 4] * sc, v[k + 5] * sc), pk2(v[k + 6] * sc, v[k + 7] * sc));
            }
            ITEMS(i, NB * 4 * (SK / 8) * 64) {
                const int d = i & 63, j8 = (i >> 6) % (SK / 8), hh = (i / (64 * (SK / 8))) & 3, b = i / (256 * (SK / 8));
                const int r0 = j8 * 8 < CTX ? tok_row(false, b, j8 * 8) : tok_row(true, b, j8 * 8 - CTX);
                const float* sp = MKV + (size_t)r0 * 512 + hh * 128 + 64 + d;
                float v[8];
#pragma unroll
                for (int jj = 0; jj < 8; ++jj) v[jj] = sp[(size_t)jj * 512];
                *(uint4*)(VMT + ((size_t)(b * 4 + hh) * 64 + d) * SK + j8 * 8) = make_uint4(pk2(v[0], v[1]), pk2(v[2], v[3]), pk2(v[4], v[5]), pk2(v[6], v[7]));
            }
            ITEMS(i, NB * 2 * 8 * 4096) {
                const int e = i & 4095, h = (i >> 12) & 7, bd = i >> 15;
                float* hp0 = HS + ((size_t)bd * NCH * 8 + h) * 4096 + e; const float* al0 = ALAST + (size_t)bd * NCH * 8 + h;
                float sv[NCH - 1], dk[NCH - 1];
#pragma unroll
                for (int k = 0; k < NCH - 1; ++k) { sv[k] = hp0[(size_t)k * 8 * 4096]; dk[k] = al0[k * 8]; }
                float Hc = 0.f;
#pragma unroll
                for (int k = 0; k < NCH; ++k) { hp0[(size_t)k * 8 * 4096] = Hc; if (k < NCH - 1) Hc = Hc * __expf(dk[k]) + sv[k]; }
            }
            GSYNC();
        }
        {
            PHASE_BEGIN();
            for (int it = vcu; it < NB * 2 * NCH * 4; it += G) {
                const int hp = it & 3, dir = (it >> 2) & 1, cp = (it >> 3) % NCH, b = it / (8 * NCH);
                const int k = dir ? (cp < 2 ? 1 - cp : 35 - cp) : cp;
                if (k < 2 && !ctx_out) continue;
                ssd_block<true>(b, dir, k, hp, XBC, DT, kp_->in[I_ALOG] + l * 16, HS, ALAST, YD, (float*)lds_raw, tid);
            }
            const int lane = tid & 63, wave = tid >> 6, qr = lane & 31, hf = lane >> 5;
            {
                const float* lq1 = kp_->in[I_LQ1] + l * 32; const float* lk1 = kp_->in[I_LK1] + l * 32; const float* lq2 = kp_->in[I_LQ2] + l * 32; const float* lk2 = kp_->in[I_LK2] + l * 32;
                float d1 = 0.f, d2 = 0.f; for (int k = 0; k < 32; ++k) { d1 += lq1[k] * lk1[k]; d2 += lq2[k] * lk2[k]; }
                const float lam = expf(d1) - expf(d2) + lambda_init;
                const float* subw = kp_->in[I_SUBLN] + l * 64;
                const int nlat = NB * 4 * (S / 256), nit = nlat + (ctx_out ? NB * 4 : 0);
                for (int it = vcu; it < nit; it += G) {
                    const bool lat = it < nlat; const int u = lat ? it : it - nlat;
                    const int qb = lat ? u % (S / 256) : 0, hh = lat ? (u / (S / 256)) % 4 : u % 4, b = lat ? u / (4 * (S / 256)) : u / 4;
                    const int t = qb * 256 + wave * 32 + qr; const int row = tok_row(lat, b, t); const int nkt = lat ? SK / 64 : CTX / 64;
                    f32x16 o1[2], oacc[2]; float lsum1 = 0.f;
#pragma unroll
                    for (int mp = 0; mp < 2; ++mp) {
                        const int hm = hh * 2 + mp;
                        const bf16_t* qrow = lat ? QD + ((size_t)(b * 8 + hm) * S + t) * 32 : QDC + ((size_t)(b * 8 + hm) * CTX + t) * 32;
                        float m_run = -1e30f, l_run = 0.f;
#pragma unroll
                        for (int i = 0; i < 16; ++i) { oacc[0][i] = 0.f; oacc[1][i] = 0.f; }
                        attn_pass<32>(qrow, KD + (size_t)(b * 8 + hm) * SK * 32, VDT + (size_t)(b * 4 + hh) * 64 * SK, SK, nkt, ldsb, tid, oacc, m_run, l_run);
                        l_run = xor32_sum(l_run);
                        if (mp == 0) { o1[0] = oacc[0]; o1[1] = oacc[1]; lsum1 = l_run; }
                        else {
                            const float i1 = 1.0f / lsum1, i2 = lam / l_run; float ss = 0.f;
#pragma unroll
                            for (int db = 0; db < 2; ++db)
#pragma unroll
                                for (int i = 0; i < 16; ++i) { const float v = o1[db][i] * i1 - oacc[db][i] * i2; o1[db][i] = v; ss += v * v; }
                            ss = xor32_sum(ss);
                            const float rs = (1.0f - lambda_init) / sqrtf(ss / 64 + EPS);
                            bf16_t* orow = MIXB + (size_t)row * MIXW + 512 + hh * 64;
#pragma unroll
                            for (int db = 0; db < 2; ++db)
#pragma unroll
                                for (int gq = 0; gq < 4; ++gq) { const int d0 = 32 * db + 8 * gq + 4 * hf; const float4 w4 = *(const float4*)(subw + d0);
                                    *(uint2*)(orow + d0) = make_uint2(pk2(o1[db][4 * gq] * rs * w4.x, o1[db][4 * gq + 1] * rs * w4.y), pk2(o1[db][4 * gq + 2] * rs * w4.z, o1[db][4 * gq + 3] * rs * w4.w)); }
                        }
                    }
                }
            }
            {
                const int nlat = NB * 4 * (S / 256), nit = nlat + (ctx_out ? NB * 4 : 0);
                for (int it = vcu; it < nit; it += G) {
                    const bool lat = it < nlat; const int u = lat ? it : it - nlat;
                    const int qb = lat ? u % (S / 256) : 0, hh = lat ? (u / (S / 256)) % 4 : u % 4, b = lat ? u / (4 * (S / 256)) : u / 4;
                    const int t = qb * 256 + wave * 32 + qr; const int row = tok_row(lat, b, t); const int nkt = lat ? SK / 64 : CTX / 64;
                    const bf16_t* qrow = lat ? QM + ((size_t)(b * 4 + hh) * S + t) * 96 : QMC + ((size_t)(b * 4 + hh) * CTX + t) * 96;
                    f32x16 oacc[2]; float m_run = -1e30f, l_run = 0.f;
#pragma unroll
                    for (int i = 0; i < 16; ++i) { oacc[0][i] = 0.f; oacc[1][i] = 0.f; }
                    attn_pass<96>(qrow, KM + (size_t)(b * 4 + hh) * SK * 96, VMT + (size_t)(b * 4 + hh) * 64 * SK, SK, nkt, ldsb, tid, oacc, m_run, l_run);
                    l_run = xor32_sum(l_run);
                    const float inv = 1.0f / l_run;
                    bf16_t* orow = MIXB + (size_t)row * MIXW + 768 + hh * 64;
#pragma unroll
                    for (int db = 0; db < 2; ++db)
#pragma unroll
                        for (int gq = 0; gq < 4; ++gq) { const int d0 = 32 * db + 8 * gq + 4 * hf;
                            *(uint2*)(orow + d0) = make_uint2(pk2(oacc[db][4 * gq] * inv, oacc[db][4 * gq + 1] * inv), pk2(oacc[db][4 * gq + 2] * inv, oacc[db][4 * gq + 3] * inv)); }
                }
            }
            GSYNC();
        }
        {
            PHASE_BEGIN();
            const float* nw = kp_->in[I_SSDN] + l * 512; const float* dsk = kp_->in[I_SSDD] + l * 8;
            const int lane = tid & 63;
            WITEMS(i, nrows_out * 2) {
                const int g = i & 1, r = i >> 1, c = g * 256 + lane * 4;
                const float4 x = *(const float4*)(XBC + (size_t)r * 768 + c), y0 = *(const float4*)(YD + (size_t)r * 512 + c), y1 = *(const float4*)(YD + ((size_t)NTOK + r) * 512 + c);
                const float4 z = *(const float4*)(PB + (size_t)r * IN_COLS + C_Z + c);
                const float ds = dsk[c >> 6];
                float4 v = make_float4((ds * x.x + y0.x + y1.x) * siluf(z.x), (ds * x.y + y0.y + y1.y) * siluf(z.y), (ds * x.z + y0.z + y1.z) * siluf(z.z), (ds * x.w + y0.w + y1.w) * siluf(z.w));
                const float ss = wave_sum(f4dot(v, v));
                const float rs = 1.0f / sqrtf(ss / 256 + EPS);
                *(uint2*)(MIXB + (size_t)r * MIXW + c) = pk4(f4scale(f4mul(v, *(const float4*)(nw + c)), rs));
            }
            GSYNC();
        }
        {
            PHASE_BEGIN();
            pg8::Gemm g{MIXB, WOUT_T, nrows_out, D, MIXW, 0, 0}; pg8::StaticOrder so; so.init(nrows_out, D, G, bid);
            pg8::EpiF32 E{MOUT, D, D};
            pg8::gemm_phase<pg8::EpiF32, pg8::StaticOrder, true, true>(ldsb, g, so, E);
            GSYNC();
        }
        {
            PHASE_BEGIN();
            const float* wpost = kp_->in[I_NMPOST] + l * D; const float* wpre = kp_->in[I_NFPRE] + l * D;
            const float* rw = kp_->in[I_RW] + (size_t)l * D * NE; const float* rb = kp_->in[I_RB] + l * NE;
            const int lane = tid & 63;
            float* rwl = (float*)lds_raw;
            for (int i = tid; i < D * NE / 4; i += NTHREADS) ((float4*)rwl)[i] = ((const float4*)rw)[i];
            __syncthreads();
            WITEMS(r, nrows_out) {
                float4* xr = (float4*)(r < NLAT ? xcur + (size_t)r * D : CTXC + (size_t)(r - NLAT) * D);
                const float* md = modl + (size_t)(r < NLAT ? r / S : NB) * NMOD * D;
                const float4* m = (const float4*)(MOUT + (size_t)r * D);
                float4 mv[4], xv[4]; float ss = 0.f;
#pragma unroll
                for (int i = 0; i < 4; ++i) { mv[i] = m[i * 64 + lane]; xv[i] = xr[i * 64 + lane]; ss += f4dot(mv[i], mv[i]); }
                ss = wave_sum(ss);
                const float rs = 1.0f / sqrtf(ss / D + EPS);
                float s2 = 0.f;
#pragma unroll
                for (int i = 0; i < 4; ++i) { const int k4 = i * 64 + lane; const float4 g2 = ((const float4*)(md + 2 * D))[k4], wp = ((const float4*)wpost)[k4];
                    xv[i] = f4add(xv[i], f4mul(g2, f4scale(f4mul(mv[i], wp), rs))); xr[k4] = xv[i]; s2 += f4dot(xv[i], xv[i]); }
                s2 = wave_sum(s2);
                const float r2 = 1.0f / sqrtf(s2 / D + EPS);
                float lg[NE];
#pragma unroll
                for (int e = 0; e < NE; ++e) lg[e] = 0.f;
#pragma unroll
                for (int i = 0; i < 4; ++i) { const int k4 = i * 64 + lane; const float4 w4 = ((const float4*)wpre)[k4], sc = ((const float4*)(md + 4 * D))[k4], sh = ((const float4*)(md + 3 * D))[k4];
                    const float hv[4] = {xv[i].x * r2 * w4.x * (1.0f + sc.x) + sh.x, xv[i].y * r2 * w4.y * (1.0f + sc.y) + sh.y, xv[i].z * r2 * w4.z * (1.0f + sc.z) + sh.z, xv[i].w * r2 * w4.w * (1.0f + sc.w) + sh.w};
                    *(uint2*)(HB + (size_t)r * D + k4 * 4) = make_uint2(pk2(hv[0], hv[1]), pk2(hv[2], hv[3]));
#pragma unroll
                    for (int c = 0; c < 4; ++c) { const float4* rwp = (const float4*)(rwl + (size_t)(k4 * 4 + c) * NE);
#pragma unroll
                        for (int e4 = 0; e4 < 4; ++e4) { const float4 w = rwp[e4]; lg[4 * e4] += hv[c] * w.x; lg[4 * e4 + 1] += hv[c] * w.y; lg[4 * e4 + 2] += hv[c] * w.z; lg[4 * e4 + 3] += hv[c] * w.w; }
                        SCHED_FENCE(); }
                }
#pragma unroll
                for (int e = 0; e < NE; ++e) lg[e] = wave_sum(lg[e]) + rb[e];
                float mx = lg[0];
#pragma unroll
                for (int e = 1; e < NE; ++e) mx = fmaxf(mx, lg[e]);
                float sum = 0.f;
#pragma unroll
                for (int e = 0; e < NE; ++e) { lg[e] = expf(lg[e] - mx); sum += lg[e]; }
                const float is = 1.0f / sum;
                float mine = lg[0];
#pragma unroll
                for (int e = 1; e < NE; ++e) mine = lane == e ? lg[e] : mine;
                if (lane < NE) AFF[(size_t)r * NE + lane] = mine * is;
            }
            GSYNC();
        }
        {
            PHASE_BEGIN();
            {
                const int lane = tid & 63;
                WITEMS(id, NE * 3 * 512) {
                    const int mat = id >> 9, tl = id & 511, e = mat / 3, which = mat % 3, k0 = (tl >> 4) * 32, n0 = (tl & 15) * 64;
                    if (which == 0) cvt_tile(kp_->in[I_WG] + ((size_t)l * NE + e) * D * FF, FF, WGU_T + (size_t)e * 2 * FF * D, D, [](int n) { return (n >> 2) * 8 + (n & 3); }, k0, n0, lane);
                    else if (which == 1) cvt_tile(kp_->in[I_WU] + ((size_t)l * NE + e) * D * FF, FF, WGU_T + (size_t)e * 2 * FF * D, D, [](int n) { return (n >> 2) * 8 + 4 + (n & 3); }, k0, n0, lane);
                    else cvt_tile(kp_->in[I_WD] + ((size_t)l * NE + e) * FF * D, D, WD_T + (size_t)e * D * FF, FF, [](int n) { return n; }, k0, n0, lane);
                }
            }
            {
                volatile int* sh = (volatile int*)lds_raw;
                const int nsel = (ctx_out ? 2 : 1) * NB * NE;
                for (int it = bid; it < nsel; it += G) {
                    const bool lat = it < NB * NE; const int u = lat ? it : it - NB * NE; const int e = u % NE, b = u / NE;
                    const int L = lat ? S : CTX, cap = lat ? CAP_L : CAP_C, npt = lat ? S / NTHREADS : 1, base = tok_row(lat, b, 0);
                    const bool act = lat || tid < CTX;
                    unsigned key[S / NTHREADS];
#pragma unroll
                    for (int i = 0; i < S / NTHREADS; ++i) key[i] = (act && i < npt) ? __float_as_uint(AFF[(size_t)(base + tid * npt + i) * NE + e]) : 0u;
                    __syncthreads();
                    unsigned T = 0u;
                    for (int bit = 30; bit >= 0; --bit) {
                        const unsigned cand = T | (1u << bit); int c = 0;
#pragma unroll
                        for (int i = 0; i < S / NTHREADS; ++i) c += (key[i] >= cand) ? 1 : 0;
                        if (block_sum(c, tid, sh, bit & 1) >= cap) T = cand;
                    }
                    int cg = 0, ct = 0;
#pragma unroll
                    for (int i = 0; i < S / NTHREADS; ++i) { cg += (key[i] > T) ? 1 : 0; ct += (key[i] == T && key[i] != 0u) ? 1 : 0; }
                    int tot_g, tot_t;
                    (void)block_excl_scan(cg, tid, sh, tot_g);
                    int tie_rank = block_excl_scan(ct, tid, sh, tot_t);
                    const int need = cap - tot_g;
                    int sel[S / NTHREADS], cs = 0;
#pragma unroll
                    for (int i = 0; i < S / NTHREADS; ++i) { const bool tie = key[i] == T && key[i] != 0u; sel[i] = (key[i] > T || (tie && tie_rank < need)) ? 1 : 0; tie_rank += tie ? 1 : 0; cs += sel[i]; }
                    int tot_s; int slot = block_excl_scan(cs, tid, sh, tot_s);
#pragma unroll
                    for (int i = 0; i < S / NTHREADS; ++i) if (act && i < npt) {
                        const int row = base + tid * npt + i; int sa = -1;
                        if (sel[i]) { sa = (lat ? b * CAP_L : NB * CAP_L + b * CAP_C) + slot; ++slot; SELIDX[e * ER_MAX + sa] = row; SELGATE[e * ER_MAX + sa] = __uint_as_float(key[i]); }
                        TOKSLOT[(size_t)row * NE + e] = sa;
                    }
                }
            }
            GSYNC();
        }
        {
            PHASE_BEGIN();
            const int used = ctx_out ? NB * (CAP_L + CAP_C) : NB * CAP_L;
            ITEMS(i, NE * ER * (D / 8)) {
                const int c8 = i % (D / 8), slot = (i / (D / 8)) % ER, e = i / ((D / 8) * ER);
                uint4 v = make_uint4(0, 0, 0, 0);
                if (slot < used) v = *(const uint4*)(HB + (size_t)SELIDX[e * ER_MAX + slot] * D + c8 * 8);
                *(uint4*)(XG + ((size_t)e * ER + slot) * D + c8 * 8) = v;
            }
            GSYNC();
        }
        {
            PHASE_BEGIN();
            pg8::Gemm g{XG, WGU_T, NE * ER, 2 * FF, D, ER / 256, (size_t)2 * FF * D * 2}; pg8::StaticOrder so; so.init(NE * ER, 2 * FF, G, bid);
            pg8::EpiSwiGLU E{HID, FF};
            pg8::gemm_phase<pg8::EpiSwiGLU, pg8::StaticOrder, true, true>(ldsb, g, so, E);
            GSYNC();
        }
        {
            PHASE_BEGIN();
            pg8::Gemm g{HID, WD_T, NE * ER, D, FF, ER / 256, (size_t)D * FF * 2}; pg8::StaticOrder so; so.init(NE * ER, D, G, bid);
            pg8::EpiRowScaleF32 E{Y, D, SELGATE, ER};
            pg8::gemm_phase<pg8::EpiRowScaleF32, pg8::StaticOrder, true, true>(ldsb, g, so, E);
            GSYNC();
        }
        {
            PHASE_BEGIN();
            const float* wpost = kp_->in[I_NFPOST] + l * D;
            const int lane = tid & 63;
            WITEMS(r, nrows_out) {
                float4* xr = (float4*)(r < NLAT ? xcur + (size_t)r * D : CTXC + (size_t)(r - NLAT) * D);
                const float* md = modl + (size_t)(r < NLAT ? r / S : NB) * NMOD * D;
                const int myslot = lane < NE ? TOKSLOT[(size_t)r * NE + lane] : -1;
                float4 f[4];
#pragma unroll
                for (int i = 0; i < 4; ++i) f[i] = make_float4(0.f, 0.f, 0.f, 0.f);
#pragma unroll
                for (int e = 0; e < NE; ++e) {
                    const int sl = __builtin_amdgcn_readlane(myslot, e);
                    if (sl >= 0) { const float4* yp = (const float4*)(Y + ((size_t)e * ER + sl) * D);
#pragma unroll
                        for (int i = 0; i < 4; ++i) f[i] = f4add(f[i], yp[i * 64 + lane]); }
                }
                float ss = 0.f;
#pragma unroll
                for (int i = 0; i < 4; ++i) ss += f4dot(f[i], f[i]);
                ss = wave_sum(ss);
                const float rs = 1.0f / sqrtf(ss / D + EPS);
#pragma unroll
                for (int i = 0; i < 4; ++i) { const int k4 = i * 64 + lane; const float4 g5 = ((const float4*)(md + 5 * D))[k4], wp = ((const float4*)wpost)[k4];
                    xr[k4] = f4add(xr[k4], f4mul(g5, f4scale(f4mul(f[i], wp), rs))); }
            }
            GSYNC();
        }
    }
}

extern "C" void kernel_launch(void* const* d_in, const int* in_sizes, int n_in, void* d_out, int out_size, void* d_ws, size_t ws_size, hipStream_t stream) {
    static int grid = 0;
    if (grid == 0) {
        if (n_in != N_IN || out_size != NLAT * D || ws_size < WS_END) { fprintf(stderr, "kernel_launch: unexpected shapes: n_in %d out %d ws %zu (need %zu)\n", n_in, out_size, ws_size, (size_t)WS_END); grid = -1; return; }
        int dev = 0, cus = 0, per_cu = 0;
        (void)hipGetDevice(&dev);
        (void)hipDeviceGetAttribute(&cus, hipDeviceAttributeMultiprocessorCount, dev);
        (void)hipFuncSetAttribute((const void*)mk_forward, hipFuncAttributeMaxDynamicSharedMemorySize, LDS_BYTES);
        (void)hipOccupancyMaxActiveBlocksPerMultiprocessor(&per_cu, (const void*)mk_forward, NTHREADS, LDS_BYTES);
        (void)hipGetLastError();
        if (per_cu < 1) { fprintf(stderr, "kernel_launch: occupancy query says %d blocks/CU\n", per_cu); grid = -1; return; }
        grid = cus;
    }
    if (grid < 0) return;
    (void)hipMemsetAsync((char*)d_ws + WS_CTL, 0, CTL_BYTES, stream);
    Prm p{};
    for (int i = 0; i < N_IN; ++i) p.in[i] = (const float*)d_in[i];
    p.out = (float*)d_out; p.ws = (char*)d_ws;
    void* args[] = {&p};
    hipError_t e = hipLaunchCooperativeKernel((const void*)mk_forward, dim3(grid), dim3(NTHREADS), args, LDS_BYTES, stream);
    if (e != hipSuccess) fprintf(stderr, "kernel_launch: cooperative launch failed: %s (grid %d)\n", hipGetErrorString(e), grid);
}
```

```cpp
#include <hip/hip_runtime.h>
#include <cstdio>
#include <cstdint>

constexpr int D = 1024, NB = 4, S = 4096, CTX = 256, FF = 1024;
constexpr int DEPTH = 2, GRID_W = 64, NMOD = 6, NE = 16;
constexpr int NLAT = NB * S, NCTX = NB * CTX, NTOK = NLAT + NCTX;
constexpr int IN_COLS = 2416, IN_PAD = 2560;
constexpr int C_Z = 0, C_XBC = 512, C_DT = 1280, C_DQ = 1296, C_DK = 1552, C_DV = 1808, C_CQ = 2064, C_CKV = 2256, C_KR = 2384;
constexpr int MIXW = 1024;
constexpr int CAP_L = 2 * S / NE, CAP_C = 2 * CTX / NE;
constexpr int ER_MAX = 2304;
constexpr float EPS = 1e-6f;
static_assert(NB * CAP_L == 2048 && NB * CAP_C == 128, "expert row layout");

enum { I_X = 0, I_C, I_CTX, I_CCTX, I_ADAW, I_ADAB, I_NMPRE, I_NMPOST, I_NFPRE, I_NFPOST, I_WIN, I_CONVW, I_CONVB, I_ALOG, I_DTB, I_SSDD, I_SSDN,
       I_LQ1, I_LK1, I_LQ2, I_LK2, I_SUBLN, I_QNORM, I_WQUP, I_KVNORM, I_WKVUP, I_WOUT, I_RW, I_RB, I_WG, I_WU, I_WD, N_IN };
struct Prm { const float* in[N_IN]; float* out; char* ws; };

typedef unsigned short bf16_t;
constexpr size_t al256(size_t x) { return (x + 255) & ~(size_t)255; }
constexpr size_t WS_CTL = 0, CTL_BYTES = 65536;
constexpr size_t WS_MOD = WS_CTL + CTL_BYTES;
constexpr size_t WS_CTXC = al256(WS_MOD + (size_t)DEPTH * (NB + 1) * NMOD * D * 4);
constexpr size_t WS_AFF = al256(WS_CTXC + (size_t)NCTX * D * 4);
constexpr size_t WS_TOKSLOT = al256(WS_AFF + (size_t)NTOK * NE * 4);
constexpr size_t WS_SELIDX = al256(WS_TOKSLOT + (size_t)NTOK * NE * 4);
constexpr size_t WS_SELGATE = al256(WS_SELIDX + (size_t)NE * ER_MAX * 4);
constexpr size_t WS_DT = al256(WS_SELGATE + (size_t)NE * ER_MAX * 4);
constexpr int NCH = 34;
constexpr size_t WS_ROPE = al256(WS_DT + (size_t)NTOK * 16 * 4);
constexpr size_t WS_ALAST = al256(WS_ROPE + (size_t)S * 32 * 4);
constexpr size_t WS_HB = al256(WS_ALAST + (size_t)NB * 2 * NCH * 8 * 4);
constexpr size_t WS_P = al256(WS_HB + (size_t)NTOK * D * 2);
constexpr size_t WS_G2 = al256(WS_P + (size_t)NTOK * IN_COLS * 4);
constexpr size_t WS_XBC = WS_G2;
constexpr size_t WS_MQ = al256(WS_XBC + (size_t)NTOK * 768 * 4);
constexpr size_t WS_MKV = al256(WS_MQ + (size_t)NTOK * 384 * 4);
constexpr size_t WS_CQB = al256(WS_MKV + (size_t)NTOK * 512 * 4);
constexpr size_t WS_CKVB = al256(WS_CQB + (size_t)NTOK * 256 * 2);
constexpr size_t WS_MIXB = al256(WS_CKVB + (size_t)NTOK * 128 * 2);
constexpr size_t WS_G2END = al256(WS_MIXB + (size_t)NTOK * MIXW * 2);
constexpr size_t WS_HS = WS_HB;
constexpr size_t WS_YD = WS_MQ;
constexpr size_t WS_MOUT = WS_P;
constexpr size_t WS_XG = WS_P;
constexpr size_t WS_HID = al256(WS_XG + (size_t)NE * ER_MAX * D * 2);
constexpr size_t WS_Y = WS_G2;
constexpr size_t WS_WIN = WS_G2END;
constexpr size_t WS_WQ = al256(WS_WIN + (size_t)IN_PAD * D * 2);
constexpr size_t WS_WKV = al256(WS_WQ + (size_t)512 * 256 * 2);
constexpr size_t WS_WOUT = al256(WS_WKV + (size_t)512 * 128 * 2);
constexpr size_t WS_WGU = al256(WS_WOUT + (size_t)D * MIXW * 2);
constexpr size_t WS_WD = al256(WS_WGU + (size_t)NE * 2 * FF * D * 2);
constexpr size_t WS_END = al256(WS_WD + (size_t)NE * D * FF * 2);
constexpr int SK = CTX + S;
constexpr size_t WS_QD = WS_WGU;
constexpr size_t WS_QDC = al256(WS_QD + (size_t)NB * 8 * S * 32 * 2);
constexpr size_t WS_KD = al256(WS_QDC + (size_t)NB * 8 * CTX * 32 * 2);
constexpr size_t WS_VDT = al256(WS_KD + (size_t)NB * 8 * SK * 32 * 2);
constexpr size_t WS_QM = al256(WS_VDT + (size_t)NB * 4 * 64 * SK * 2);
constexpr size_t WS_QMC = al256(WS_QM + (size_t)NB * 4 * S * 96 * 2);
constexpr size_t WS_KM = al256(WS_QMC + (size_t)NB * 4 * CTX * 96 * 2);
constexpr size_t WS_VMT = al256(WS_KM + (size_t)NB * 4 * SK * 96 * 2);
constexpr size_t WS_ATTEND = al256(WS_VMT + (size_t)NB * 4 * 64 * SK * 2);
static_assert(WS_ATTEND <= WS_END, "attention operands fit in the MoE weight region");
static_assert(WS_HID + (size_t)NE * ER_MAX * FF * 2 <= WS_G2, "XG+HID fit in the P region");
static_assert((size_t)NE * ER_MAX * D * 4 <= WS_G2END - WS_G2, "Y fits in the G2 region");
static_assert((size_t)NB * 2 * NCH * 8 * 4096 * 4 <= (size_t)NTOK * D * 2, "HS fits in HB");
static_assert(WS_YD + (size_t)2 * NTOK * 512 * 4 <= WS_MIXB, "YD ends below MIXB");

#define LAS __attribute__((address_space(3)))
constexpr int NTHREADS = 512;
constexpr int LDS_BYTES = 147456;
#define ITEMS(i, n) for (int i = blockIdx.x * NTHREADS + tid; i < (n); i += gridDim.x * NTHREADS)

__device__ __forceinline__ float siluf(float x) { return x / (1.0f + expf(-x)); }
__device__ __forceinline__ float softplusf(float x) { return x > 20.f ? x : log1pf(expf(x)); }
__device__ __forceinline__ unsigned f2bf(float f) { unsigned u = __builtin_bit_cast(unsigned, f); return (u + 0x7fffu + ((u >> 16) & 1u)) >> 16; }
__device__ __forceinline__ unsigned pk2(float lo, float hi) { return f2bf(lo) | (f2bf(hi) << 16); }
__device__ __forceinline__ float bf2f(bf16_t h) { return __builtin_bit_cast(float, (unsigned)h << 16); }
#define SCHED_FENCE() __builtin_amdgcn_sched_barrier(0)
__device__ __forceinline__ float dpp_row_shr(float v, int n) {
    const int iv = __builtin_bit_cast(int, v); int r;
    switch (n) { case 1: r = __builtin_amdgcn_update_dpp(0, iv, 0x111, 0xf, 0xf, true); break; case 2: r = __builtin_amdgcn_update_dpp(0, iv, 0x112, 0xf, 0xf, true); break;
                 case 4: r = __builtin_amdgcn_update_dpp(0, iv, 0x114, 0xf, 0xf, true); break; default: r = __builtin_amdgcn_update_dpp(0, iv, 0x118, 0xf, 0xf, true); break; }
    return __builtin_bit_cast(float, r);
}
__device__ __forceinline__ float wave_sum(float v) {
    v += dpp_row_shr(v, 1); v += dpp_row_shr(v, 2); v += dpp_row_shr(v, 4); v += dpp_row_shr(v, 8);
    v += __builtin_bit_cast(float, __builtin_amdgcn_update_dpp(0, __builtin_bit_cast(int, v), 0x142, 0xa, 0xf, false));
    v += __builtin_bit_cast(float, __builtin_amdgcn_update_dpp(0, __builtin_bit_cast(int, v), 0x143, 0xc, 0xf, false));
    return __builtin_bit_cast(float, __builtin_amdgcn_readlane(__builtin_bit_cast(int, v), 63)); }
__device__ __forceinline__ float xor32_max(float x) { auto t = __builtin_amdgcn_permlane32_swap(__float_as_uint(x), __float_as_uint(x), false, false); return fmaxf(__uint_as_float(t[0]), __uint_as_float(t[1])); }
__device__ __forceinline__ float xor32_sum(float x) { auto t = __builtin_amdgcn_permlane32_swap(__float_as_uint(x), __float_as_uint(x), false, false); return __uint_as_float(t[0]) + __uint_as_float(t[1]); }
#define WITEMS(i, n) for (int i = blockIdx.x * 8 + (tid >> 6); i < (n); i += gridDim.x * 8)
__device__ __forceinline__ float4 f4mul(float4 a, float4 b) { return make_float4(a.x * b.x, a.y * b.y, a.z * b.z, a.w * b.w); }
__device__ __forceinline__ float4 f4add(float4 a, float4 b) { return make_float4(a.x + b.x, a.y + b.y, a.z + b.z, a.w + b.w); }
__device__ __forceinline__ float4 f4scale(float4 a, float s) { return make_float4(a.x * s, a.y * s, a.z * s, a.w * s); }
__device__ __forceinline__ float f4dot(float4 a, float4 b) { return a.x * b.x + a.y * b.y + a.z * b.z + a.w * b.w; }
__device__ __forceinline__ uint2 pk4(float4 v) { return make_uint2(pk2(v.x, v.y), pk2(v.z, v.w)); }
__device__ __forceinline__ float4 up4(uint2 u) { return make_float4(__uint_as_float(u.x << 16), __uint_as_float(u.x & 0xffff0000u), __uint_as_float(u.y << 16), __uint_as_float(u.y & 0xffff0000u)); }
__device__ __forceinline__ float4 ld4h(const bf16_t* p) { return up4(*(const uint2*)p); }

__device__ __forceinline__ void rope32(float* v, int t, const float* tab) {
    const float4* tp = (const float4*)(tab + (size_t)t * 32);
    float cs[32];
#pragma unroll
    for (int i = 0; i < 8; ++i) { const float4 x = tp[i]; cs[4 * i] = x.x; cs[4 * i + 1] = x.y; cs[4 * i + 2] = x.z; cs[4 * i + 3] = x.w; }
#pragma unroll
    for (int i = 0; i < 8; ++i) {
        { const float c = cs[i], sn = cs[8 + i]; const float x1 = v[i], x2 = v[8 + i]; v[i] = x1 * c - x2 * sn; v[8 + i] = x1 * sn + x2 * c; }
        { const float c = cs[16 + i], sn = cs[24 + i]; const float x1 = v[16 + i], x2 = v[24 + i]; v[16 + i] = x1 * c - x2 * sn; v[24 + i] = x1 * sn + x2 * c; }
    }
}
__device__ __forceinline__ int tok_row(bool lat, int b, int t) { return lat ? b * S + t : NLAT + b * CTX + t; }

namespace pg8 {
#define PG8_LAS __attribute__((address_space(3)))
typedef short bf16x8 __attribute__((ext_vector_type(8)));
typedef float f32x4 __attribute__((ext_vector_type(4)));
typedef unsigned u32x4 __attribute__((ext_vector_type(4)));
constexpr int BM = 256, BK = 64, HALF = 128, HTB = HALF * BK * 2  , STAGE_BYTES = 8 * HTB, NXCD = 8, WGM = 8;

__host__ __device__ __forceinline__ int lds_byte(int r, int c) { const int st = (r >> 4) * 2 + (c >> 5), rr = r & 15, cc = c & 31, ob = rr * 64 + cc * 2; return st * 1024 + (ob ^ (((ob >> 9) & 1) << 5)); }
__host__ __device__ __forceinline__ void stage_rc(int b, int& R, int& C) { const int st = b / 1024, sb = b % 1024, swz = sb ^ (((sb >> 9) & 1) << 5); R = (st >> 1) * 16 + swz / 64; C = (st & 1) * 32 + (swz % 64) / 2; }
__host__ __device__ __forceinline__ int perm32(int rho) { const int n = rho >> 4, i = rho & 15; return 8 * (i >> 2) + 4 * n + (i & 3); }

struct Unit { int pm, pn; };
struct Gemm { const bf16_t* A; const bf16_t* Bt; int M, N, K; int grp_tiles; size_t grp_stride; };

struct StaticOrder {
    int nM, nN, nwg, G, c;
    __host__ __device__ void init(int M, int N, int G_, int c_) { nM = M / BM; nN = N / BM; nwg = nM * nN; G = G_; c = c_; }
    __host__ __device__ bool next(int i, Unit& u) const {
        const long L = (long)i * G + c; if (L >= nwg) return false;
        int wgid = (int)L; { const int q = nwg / NXCD, r = nwg % NXCD, xcd = wgid % NXCD, off = wgid / NXCD; wgid = (xcd < r ? xcd * (q + 1) : r * (q + 1) + (xcd - r) * q) + off; }
        const int nig = WGM * nN, gid = wgid / nig, fm = gid * WGM, gsz = (nM - fm) < WGM ? (nM - fm) : WGM;
        u.pm = fm + ((wgid % nig) % gsz); u.pn = (wgid % nig) / gsz; return true;
    }
    __device__ __forceinline__ void a_ready(const Unit&) const {}
    __device__ __forceinline__ void done(const Unit&) const {}
};

__device__ __forceinline__ unsigned cvt_pk_bf16(float lo, float hi) { unsigned r; asm volatile("v_cvt_pk_bf16_f32 %0, %1, %2" : "=v"(r) : "v"(lo), "v"(hi)); return r; }

typedef unsigned u32x2 __attribute__((ext_vector_type(2)));
struct EpiF32 {
    static constexpr bool PERM = false, AFTER_DRAIN = false;
    float* C; int ldc; int ncols;
    __device__ __forceinline__ void operator()(const f32x4 (&acc)[2][2][4][2], const Unit& u, int wr, int wc, int fr, int fq) const {
        const int row0 = u.pm * BM + wr * 64 + fr, col0 = u.pn * BM + wc * 32 + 4 * fq;
#pragma unroll
        for (int ai = 0; ai < 2; ++ai)
#pragma unroll
            for (int m = 0; m < 4; ++m) { float* rowp = C + (size_t)(row0 + ai * HALF + m * 16) * ldc;
#pragma unroll
                for (int bj = 0; bj < 2; ++bj)
#pragma unroll
                    for (int n = 0; n < 2; ++n) { const int col = col0 + bj * HALF + n * 16; if (col < ncols) *(f32x4*)(rowp + col) = acc[ai][bj][m][n]; } }
    }
};
struct EpiRowScaleF32 {
    static constexpr bool PERM = false, AFTER_DRAIN = false;
    float* C; int ldc; const float* gate; int er;
    __device__ __forceinline__ void operator()(const f32x4 (&acc)[2][2][4][2], const Unit& u, int wr, int wc, int fr, int fq) const {
        const int row0 = u.pm * BM + wr * 64 + fr, col0 = u.pn * BM + wc * 32 + 4 * fq;
#pragma unroll
        for (int ai = 0; ai < 2; ++ai)
#pragma unroll
            for (int m = 0; m < 4; ++m) { const int row = row0 + ai * HALF + m * 16; float* rowp = C + (size_t)row * ldc; const float sc = gate[(row / er) * ER_MAX + row % er];
#pragma unroll
                for (int bj = 0; bj < 2; ++bj)
#pragma unroll
                    for (int n = 0; n < 2; ++n) *(f32x4*)(rowp + col0 + bj * HALF + n * 16) = acc[ai][bj][m][n] * sc; }
    }
};
struct EpiSwiGLU {
    static constexpr bool PERM = true, AFTER_DRAIN = false;
    bf16_t* O; int ldo;
    __device__ __forceinline__ void operator()(const f32x4 (&acc)[2][2][4][2], const Unit& u, int wr, int wc, int fr, int fq) const {
        const int row0 = u.pm * BM + wr * 64 + fr, col0 = u.pn * BM + wc * 32 + 8 * fq;
#pragma unroll
        for (int ai = 0; ai < 2; ++ai)
#pragma unroll
            for (int m = 0; m < 4; ++m) { bf16_t* rowp = O + (size_t)(row0 + ai * HALF + m * 16) * ldo;
#pragma unroll
                for (int bj = 0; bj < 2; ++bj) { const f32x4 gt = acc[ai][bj][m][0], up = acc[ai][bj][m][1]; f32x4 h;
#pragma unroll
                    for (int i = 0; i < 4; ++i) h[i] = gt[i] / (1.0f + __expf(-gt[i])) * up[i];
                    u32x2 w; w.x = cvt_pk_bf16(h[0], h[1]); w.y = cvt_pk_bf16(h[2], h[3]);
                    *(u32x2*)(rowp + (col0 + bj * HALF) / 2) = w; } }
    }
};

struct EpiBf16 {
    static constexpr bool PERM = true, AFTER_DRAIN = false;
    bf16_t* O; int ldo; int ncols;
    __device__ __forceinline__ void operator()(const f32x4 (&acc)[2][2][4][2], const Unit& u, int wr, int wc, int fr, int fq) const {
        const int row0 = u.pm * BM + wr * 64 + fr, col0 = u.pn * BM + wc * 32 + 8 * fq;
#pragma unroll
        for (int ai = 0; ai < 2; ++ai)
#pragma unroll
            for (int m = 0; m < 4; ++m) { bf16_t* rowp = O + (size_t)(row0 + ai * HALF + m * 16) * ldo;
#pragma unroll
                for (int bj = 0; bj < 2; ++bj) { const int col = col0 + bj * HALF; const f32x4 v0 = acc[ai][bj][m][0], v1 = acc[ai][bj][m][1];
                    u32x4 w; w.x = cvt_pk_bf16(v0[0], v0[1]); w.y = cvt_pk_bf16(v0[2], v0[3]); w.z = cvt_pk_bf16(v1[0], v1[1]); w.w = cvt_pk_bf16(v1[2], v1[3]);
                    if (col < ncols) *(u32x4*)(rowp + col) = w; } }
    }
};
struct EpiRowScaleBf16 {
    static constexpr bool PERM = true, AFTER_DRAIN = false;
    bf16_t* O; int ldo; const float* gate; int er;
    __device__ __forceinline__ void operator()(const f32x4 (&acc)[2][2][4][2], const Unit& u, int wr, int wc, int fr, int fq) const {
        const int row0 = u.pm * BM + wr * 64 + fr, col0 = u.pn * BM + wc * 32 + 8 * fq;
#pragma unroll
        for (int ai = 0; ai < 2; ++ai)
#pragma unroll
            for (int m = 0; m < 4; ++m) { const int row = row0 + ai * HALF + m * 16; bf16_t* rowp = O + (size_t)row * ldo; const float sc = gate[(row / er) * ER_MAX + row % er];
#pragma unroll
                for (int bj = 0; bj < 2; ++bj) { const f32x4 v0 = acc[ai][bj][m][0] * sc, v1 = acc[ai][bj][m][1] * sc;
                    u32x4 w; w.x = cvt_pk_bf16(v0[0], v0[1]); w.y = cvt_pk_bf16(v0[2], v0[3]); w.z = cvt_pk_bf16(v1[0], v1[1]); w.w = cvt_pk_bf16(v1[2], v1[3]);
                    *(u32x4*)(rowp + col0 + bj * HALF) = w; } }
    }
};
template <class Epi, class Sched, bool ALIGN_EPI = false, bool SP2 = false>
__device__ __forceinline__ void gemm_phase(PG8_LAS unsigned char* lds, const Gemm g, const Sched& S, const Epi& E) {
    int tid_ = threadIdx.x; asm volatile("" : "+v"(tid_));
    const int tid = tid_, wid = __builtin_amdgcn_readfirstlane(tid >> 6), lane = tid & 63, wr = wid >> 2, wc = wid & 3, fr = lane & 15, fq = lane >> 4;
    int K_ = g.K; asm volatile("" : "+s"(K_));
    const int K = K_, nt = K / BK;
    unsigned voffA[2], voffB[2];
#pragma unroll
    for (int i = 0; i < 2; ++i) { int R, C; stage_rc(tid * 16 + i * 8192, R, C); const int Rb = Epi::PERM ? ((R & ~31) + perm32(R & 31)) : R;
        voffA[i] = (unsigned)(R * K + C) * 2u; voffB[i] = (unsigned)(Rb * K + C) * 2u; }
    const size_t kstep = (size_t)(BK * 2);
    const size_t hstep = (size_t)HALF * K * 2;
    const size_t tstep = 2 * hstep;
    const unsigned ldsw = (unsigned)wid * 1024u;
    const int aoff = lds_byte(wr * 64 + fr, fq * 8), boff = lds_byte(wc * 32 + fr, fq * 8);
#define PG8_SA(b, h) (((b) * 2 + (h)) * HTB)
#define PG8_SB(b, h) ((4 + (b) * 2 + (h)) * HTB)
#define PG8_STAGE(bufoff, gbase, voff) do { _Pragma("unroll") for (int _i = 0; _i < 2; ++_i) \
        __builtin_amdgcn_global_load_lds((const unsigned*)((const char*)(gbase) + (voff)[_i]), (PG8_LAS unsigned*)(lds + (bufoff) + ldsw + _i * 8192), 16, 0, 0); } while (0)
#define PG8_LDA(dst, b, h) do { _Pragma("unroll") for (int m = 0; m < 4; ++m) _Pragma("unroll") for (int k = 0; k < 2; ++k) dst[m][k] = *(const PG8_LAS bf16x8*)(lds + PG8_SA(b, h) + aoff + m * 2048 + k * 1024); } while (0)
#define PG8_LDB(dst, b, h) do { _Pragma("unroll") for (int n = 0; n < 2; ++n) _Pragma("unroll") for (int k = 0; k < 2; ++k) dst[n][k] = *(const PG8_LAS bf16x8*)(lds + PG8_SB(b, h) + boff + n * 2048 + k * 1024); } while (0)
#define PG8_MMA(ai, bj, At, Bt) do { __builtin_amdgcn_s_setprio(1); _Pragma("unroll") for (int m = 0; m < 4; ++m) _Pragma("unroll") for (int n = 0; n < 2; ++n) _Pragma("unroll") for (int k = 0; k < 2; ++k) \
        acc[ai][bj][m][n] = __builtin_amdgcn_mfma_f32_16x16x32_bf16(Bt[n][k], At[m][k], acc[ai][bj][m][n], 0, 0, 0); __builtin_amdgcn_s_setprio(0); } while (0)
#define PG8_WAIT_V(n) asm volatile("s_waitcnt vmcnt(" #n ")" ::: "memory")
#define PG8_WAIT_L(n) asm volatile("s_waitcnt lgkmcnt(" #n ")" ::: "memory")
#define PG8_BAR __builtin_amdgcn_s_barrier()
#define PG8_SCHED __builtin_amdgcn_sched_barrier(0)
    Unit cur, nxt; int ui = 0;
    if (!S.next(0, cur)) return;
    f32x4 acc[2][2][4][2];
#pragma unroll
    for (int a = 0; a < 2; ++a)
#pragma unroll
        for (int b = 0; b < 2; ++b)
#pragma unroll
            for (int m = 0; m < 4; ++m)
#pragma unroll
                for (int n = 0; n < 2; ++n) acc[a][b][m][n] = (f32x4){0.f, 0.f, 0.f, 0.f};
    bf16x8 At[4][2], B0[2][2], B1[2][2];
    const char* cA = (const char*)g.A + (size_t)cur.pm * tstep; const char* cB = (const char*)g.Bt + (size_t)cur.pn * tstep + (g.grp_tiles ? (size_t)(cur.pm / g.grp_tiles) * g.grp_stride : (size_t)0);
    S.a_ready(cur);
    if constexpr (SP2) {
        PG8_STAGE(PG8_SB(0, 0), cB, voffB); PG8_STAGE(PG8_SB(0, 1), cB + hstep, voffB); PG8_STAGE(PG8_SA(0, 0), cA, voffA); PG8_STAGE(PG8_SA(0, 1), cA + hstep, voffA);
        if (wr == 1) PG8_BAR;
        PG8_WAIT_V(2); PG8_BAR;
        PG8_STAGE(PG8_SB(1, 0), cB + kstep, voffB); PG8_STAGE(PG8_SA(1, 0), cA + kstep, voffA); PG8_STAGE(PG8_SB(1, 1), cB + hstep + kstep, voffB);
        PG8_WAIT_V(6); PG8_BAR;
    } else {
        PG8_STAGE(PG8_SB(0, 0), cB, voffB); PG8_STAGE(PG8_SA(0, 0), cA, voffA); PG8_STAGE(PG8_SB(0, 1), cB + hstep, voffB); PG8_STAGE(PG8_SA(0, 1), cA + hstep, voffA);
        if (wr == 1) PG8_BAR;
        PG8_WAIT_V(4); PG8_BAR;
        PG8_STAGE(PG8_SB(1, 0), cB + kstep, voffB); PG8_STAGE(PG8_SA(1, 0), cA + kstep, voffA); PG8_STAGE(PG8_SB(1, 1), cB + hstep + kstep, voffB);
        PG8_WAIT_V(6); PG8_BAR;
    }
    for (;;) {
        const bool has_next = S.next(ui + 1, nxt);
        const char* nA = has_next ? (const char*)g.A + (size_t)nxt.pm * tstep : cA; const char* nB = has_next ? (const char*)g.Bt + (size_t)nxt.pn * tstep + (g.grp_tiles ? (size_t)(nxt.pm / g.grp_tiles) * g.grp_stride : (size_t)0) : cB;
        for (int t = 0; t < nt; t += 2) {
            const bool last = (t == nt - 2);
            const char* a1 = cA + (size_t)(t + 1) * kstep;
            const char* a2 = last ? nA : cA + (size_t)(t + 2) * kstep; const char* b2 = last ? nB : cB + (size_t)(t + 2) * kstep;
            const char* a3 = a2 + kstep; const char* b3 = b2 + kstep;
            if (last && has_next) S.a_ready(nxt);
            if constexpr (SP2) {
            PG8_LDB(B0, 0, 0); PG8_LDB(B1, 0, 1); PG8_SCHED; PG8_LDA(At, 0, 0); PG8_STAGE(PG8_SA(1, 1), a1 + hstep, voffA);
            PG8_WAIT_V(8); PG8_WAIT_L(0); PG8_BAR; PG8_MMA(0, 0, At, B0); PG8_MMA(0, 1, At, B1); PG8_BAR; PG8_SCHED;
            PG8_LDA(At, 0, 1); PG8_STAGE(PG8_SB(0, 0), b2, voffB); PG8_STAGE(PG8_SB(0, 1), b2 + hstep, voffB); PG8_STAGE(PG8_SA(0, 0), a2, voffA);
            PG8_WAIT_V(8); PG8_WAIT_L(0); PG8_BAR; PG8_MMA(1, 0, At, B0); PG8_MMA(1, 1, At, B1); PG8_BAR; PG8_SCHED;
            PG8_LDB(B0, 1, 0); PG8_LDB(B1, 1, 1); PG8_SCHED; PG8_LDA(At, 1, 0); PG8_STAGE(PG8_SA(0, 1), a2 + hstep, voffA);
            PG8_WAIT_V(8); PG8_WAIT_L(0); PG8_BAR; PG8_MMA(0, 0, At, B0); PG8_MMA(0, 1, At, B1); PG8_BAR; PG8_SCHED;
            PG8_LDA(At, 1, 1); PG8_STAGE(PG8_SB(1, 0), b3, voffB); PG8_STAGE(PG8_SB(1, 1), b3 + hstep, voffB); PG8_STAGE(PG8_SA(1, 0), a3, voffA);
            PG8_WAIT_V(8); PG8_WAIT_L(0); PG8_BAR; PG8_MMA(1, 0, At, B0); PG8_MMA(1, 1, At, B1); PG8_BAR; PG8_SCHED;
            } else {
            PG8_LDB(B0, 0, 0); PG8_SCHED; PG8_LDA(At, 0, 0); PG8_STAGE(PG8_SA(1, 1), a1 + hstep, voffA);
            PG8_WAIT_L(8); PG8_BAR; PG8_WAIT_L(0); PG8_MMA(0, 0, At, B0); PG8_BAR; PG8_SCHED;
            PG8_LDB(B1, 0, 1); PG8_STAGE(PG8_SB(0, 0), b2, voffB);
            PG8_BAR; PG8_WAIT_L(0); PG8_MMA(0, 1, At, B1); PG8_BAR;
            PG8_LDA(At, 0, 1); PG8_STAGE(PG8_SA(0, 0), a2, voffA);
            PG8_BAR; PG8_WAIT_L(0); PG8_MMA(1, 0, At, B0); PG8_BAR; PG8_SCHED;
            PG8_STAGE(PG8_SB(0, 1), b2 + hstep, voffB);
            PG8_WAIT_V(6); PG8_BAR; PG8_MMA(1, 1, At, B1); PG8_BAR;
            PG8_LDB(B0, 1, 0); PG8_SCHED; PG8_LDA(At, 1, 0); PG8_STAGE(PG8_SA(0, 1), a2 + hstep, voffA);
            PG8_WAIT_L(8); PG8_BAR; PG8_WAIT_L(0); PG8_MMA(0, 0, At, B0); PG8_BAR; PG8_SCHED;
            PG8_LDB(B1, 1, 1); PG8_STAGE(PG8_SB(1, 0), b3, voffB);
            PG8_BAR; PG8_WAIT_L(0); PG8_MMA(0, 1, At, B1); PG8_BAR;
            PG8_LDA(At, 1, 1); PG8_STAGE(PG8_SA(1, 0), a3, voffA);
            PG8_BAR; PG8_WAIT_L(0); PG8_MMA(1, 0, At, B0); PG8_BAR; PG8_SCHED;
            PG8_STAGE(PG8_SB(1, 1), b3 + hstep, voffB);
            PG8_WAIT_V(6); PG8_BAR; PG8_MMA(1, 1, At, B1); PG8_BAR;
            }
        }
        if constexpr (ALIGN_EPI) { if (wr == 0) PG8_BAR; }
        if constexpr (!Epi::AFTER_DRAIN) { E(acc, cur, wr, wc, fr, fq); S.done(cur); }
        if (!has_next) break;
#pragma unroll
        for (int a = 0; a < 2; ++a)
#pragma unroll
            for (int b = 0; b < 2; ++b)
#pragma unroll
                for (int m = 0; m < 4; ++m)
#pragma unroll
                    for (int n = 0; n < 2; ++n) acc[a][b][m][n] = (f32x4){0.f, 0.f, 0.f, 0.f};
        cur = nxt; cA = nA; cB = nB; ++ui;
        if constexpr (ALIGN_EPI) { if (wr == 1) PG8_BAR; }
    }
    PG8_WAIT_V(0);
    if constexpr (!ALIGN_EPI) { if (wr == 0) PG8_BAR; }
    PG8_BAR;
    if constexpr (Epi::AFTER_DRAIN) { E.fused(acc, cur, wr, wc, fr, fq, lds, wid, lane); S.done(cur); }
#undef PG8_SA
#undef PG8_SB
#undef PG8_STAGE
#undef PG8_LDA
#undef PG8_LDB
#undef PG8_MMA
#undef PG8_WAIT_V
#undef PG8_WAIT_L
#undef PG8_BAR
#undef PG8_SCHED
}
}


#define XB_TMO      128
#define XB_XCNT(j)  (256  + 64 * (j))
#define XB_XSUB(j)  (1280 + 64 * (j))
#define XB_XGEN(j)  (2304 + 64 * (j))
#define XB_TOP      3328
#define XB_TOPGEN   3392
#define XCD_BAR_WORDS 3456
#define XB_SPIN_CAP (1u << 22)
__device__ __forceinline__ unsigned xb_ld(unsigned* p)              { return __hip_atomic_load(p, __ATOMIC_RELAXED, __HIP_MEMORY_SCOPE_AGENT); }
__device__ __forceinline__ unsigned xb_add(unsigned* p, unsigned v) { return __hip_atomic_fetch_add(p, v, __ATOMIC_RELAXED, __HIP_MEMORY_SCOPE_AGENT); }
__device__ __forceinline__ unsigned xb_xcc_id() { return (unsigned)__builtin_amdgcn_s_getreg((3 << 11) | 20) & 0xFu; }
#define XB_SPIN(cond, bar) do { unsigned _sp = 0; while (cond) { __builtin_amdgcn_s_sleep(1); \
    if ((++_sp & 255u) == 0u) { if (xb_ld(&(bar)[XB_TMO])) break; if (_sp > XB_SPIN_CAP) { atomicAdd(&(bar)[XB_TMO], 1u); break; } } } } while (0)
struct XcdBarrier { unsigned* bar; unsigned x; volatile LAS unsigned* st; };
__device__ __forceinline__ XcdBarrier xcd_barrier_post(unsigned* bar, volatile LAS unsigned* st) {
    XcdBarrier b; b.bar = bar; b.x = xb_xcc_id(); b.st = st;
    if (threadIdx.x == 0) (void)xb_add(&bar[XB_XCNT(b.x)], 1u);
    return b;
}
__device__ __forceinline__ void xcd_barrier_complete(unsigned* bar, unsigned x, unsigned& nloc, unsigned& nx) {
    const unsigned G = gridDim.x * gridDim.y * gridDim.z;
    unsigned sum, cnt, mine, sp = 0u;
    for (;;) {
        sum = 0u; cnt = 0u; mine = 0u;
#pragma unroll
        for (unsigned j = 0; j < 16; ++j) { const unsigned c = xb_ld(&bar[XB_XCNT(j)]); sum += c; cnt += (c > 0u) ? 1u : 0u; mine = (j == x) ? c : mine; }
        if (sum == G) break;
        __builtin_amdgcn_s_sleep(1);
        if ((++sp & 255u) == 0u) { if (xb_ld(&bar[XB_TMO])) break; if (sp > XB_SPIN_CAP) { atomicAdd(&bar[XB_TMO], 1u); break; } }
    }
    nloc = mine > 0u ? mine : 1u; nx = cnt > 0u ? cnt : 1u;
}
__device__ __forceinline__ void xcd_barrier(const XcdBarrier& b) {
    asm volatile("s_waitcnt vmcnt(0)" ::: "memory");
    __syncthreads();
    if (threadIdx.x == 0) {
        unsigned* bar = b.bar;
        __builtin_amdgcn_s_waitcnt(0);
        unsigned nloc = b.st[0], nx = b.st[1];
        if (nloc == 0u) { xcd_barrier_complete(bar, b.x, nloc, nx); b.st[0] = nloc; b.st[1] = nx; }
        const unsigned old = xb_add(&bar[XB_XSUB(b.x)], 1u);
        const unsigned gen = old / nloc;
        if (old + 1u == (gen + 1u) * nloc) {
            __builtin_amdgcn_fence(__ATOMIC_RELEASE, "agent");
            asm volatile("s_waitcnt vmcnt(0)" ::: "memory");
            const unsigned og = xb_add(&bar[XB_TOP], 1u);
            const unsigned tg = og / nx;
            if (og + 1u == (tg + 1u) * nx) xb_add(&bar[XB_TOPGEN], 1u);
            else XB_SPIN(xb_ld(&bar[XB_TOPGEN]) == tg, bar);
            __builtin_amdgcn_fence(__ATOMIC_ACQUIRE, "agent");
            xb_add(&bar[XB_XGEN(b.x)], 1u);
            asm volatile("s_waitcnt vmcnt(0)" ::: "memory");
        } else {
            XB_SPIN(xb_ld(&bar[XB_XGEN(b.x)]) == gen, bar);
            __builtin_amdgcn_fence(__ATOMIC_ACQUIRE, "agent");
            asm volatile("s_waitcnt vmcnt(0)" ::: "memory");
        }
    }
    __syncthreads();
}


typedef short bf16x8 __attribute__((ext_vector_type(8)));
typedef short s16x4 __attribute__((ext_vector_type(4)));
typedef float f32x16 __attribute__((ext_vector_type(16)));
typedef unsigned v4u __attribute__((ext_vector_type(4)));
typedef unsigned v2u __attribute__((ext_vector_type(2)));
constexpr float ATT_THR = 5.0f;
template <int DK> struct AttL { static constexpr int KSTR = DK * 2 + 16, KBYTES = 64 * KSTR, VSTR = 136, VBYTES = 64 * VSTR, BUF = KBYTES + VBYTES, KCH = 64 * DK / 8, KPT = (KCH + NTHREADS - 1) / NTHREADS; };

template <int DK>
__device__ __forceinline__ void attn_pass(const bf16_t* Qrow, const bf16_t* Kp, const bf16_t* Vtp, int vt_ld, int nkt, LAS unsigned char* lds, int tid, f32x16 (&oacc)[2], float& m_run, float& l_run) {
    typedef AttL<DK> L;
    const int lane = tid & 63, r = lane & 31, h = lane >> 5;
    bf16x8 qf[DK / 16];
#pragma unroll
    for (int ks = 0; ks < DK / 16; ++ks) qf[ks] = *(const bf16x8*)(Qrow + 16 * ks + 8 * h);
    v4u kreg[L::KPT]; v4u vreg;
    const int vd = tid >> 3, vpart = tid & 7;
#define ATT_LOAD(j) do { _Pragma("unroll") for (int i_ = 0; i_ < L::KPT; ++i_) { const int c_ = tid + i_ * NTHREADS; if (c_ < L::KCH) kreg[i_] = *(const v4u*)(Kp + (size_t)(j) * 64 * DK + c_ * 8); } \
        vreg = *(const v4u*)(Vtp + (size_t)vd * vt_ld + (j) * 64 + vpart * 8); } while (0)
#define ATT_STORE(buf) do { _Pragma("unroll") for (int i_ = 0; i_ < L::KPT; ++i_) { const int c_ = tid + i_ * NTHREADS; if (c_ < L::KCH) { const int key_ = c_ / (DK / 8), part_ = c_ % (DK / 8); \
            *(LAS v4u*)(lds + (buf) * L::BUF + key_ * L::KSTR + part_ * 16) = kreg[i_]; } } \
        { LAS unsigned char* vp_ = lds + (buf) * L::BUF + L::KBYTES + vd * L::VSTR + vpart * 16; *(LAS v2u*)vp_ = (v2u){vreg.x, vreg.y}; *(LAS v2u*)(vp_ + 8) = (v2u){vreg.z, vreg.w}; } } while (0)
    __syncthreads();
    ATT_LOAD(0); ATT_STORE(0);
    __syncthreads();
    for (int j = 0; j < nkt; ++j) {
        const int buf = j & 1;
        if (j + 1 < nkt) ATT_LOAD(j + 1);
        f32x16 sacc[2];
#pragma unroll
        for (int kb = 0; kb < 2; ++kb) {
#pragma unroll
            for (int i = 0; i < 16; ++i) sacc[kb][i] = 0.f;
#pragma unroll
            for (int ks = 0; ks < DK / 16; ++ks) {
                const bf16x8 a = *(const LAS bf16x8*)(lds + buf * L::BUF + (32 * kb + r) * L::KSTR + (16 * ks + 8 * h) * 2);
                sacc[kb] = __builtin_amdgcn_mfma_f32_32x32x16_bf16(a, qf[ks], sacc[kb], 0, 0, 0);
            }
        }
        float tmax = sacc[0][0];
#pragma unroll
        for (int i = 1; i < 16; ++i) tmax = fmaxf(tmax, sacc[0][i]);
#pragma unroll
        for (int i = 0; i < 16; ++i) tmax = fmaxf(tmax, sacc[1][i]);
        tmax = xor32_max(tmax);
        if (__any(tmax > m_run + ATT_THR)) {
            const float mn = fmaxf(m_run, tmax), alpha = __builtin_amdgcn_exp2f(m_run - mn);
#pragma unroll
            for (int i = 0; i < 16; ++i) { oacc[0][i] *= alpha; oacc[1][i] *= alpha; }
            l_run *= alpha; m_run = mn;
        }
        float psum = 0.f;
#pragma unroll
        for (int kb = 0; kb < 2; ++kb)
#pragma unroll
            for (int i = 0; i < 16; ++i) { const float pv = __builtin_amdgcn_exp2f(sacc[kb][i] - m_run); sacc[kb][i] = pv; psum += pv; }
        l_run += psum;
#pragma unroll
        for (int kb = 0; kb < 2; ++kb)
#pragma unroll
            for (int s2 = 0; s2 < 2; ++s2) {
                union { bf16x8 v; unsigned u[4]; } pf;
#pragma unroll
                for (int i = 0; i < 4; ++i) pf.u[i] = pg8::cvt_pk_bf16(sacc[kb][8 * s2 + 2 * i], sacc[kb][8 * s2 + 2 * i + 1]);
#pragma unroll
                for (int db = 0; db < 2; ++db) {
                    const LAS unsigned char* vp = lds + buf * L::BUF + L::KBYTES + (32 * db + r) * L::VSTR + (32 * kb + 16 * s2 + 4 * h) * 2;
                    union { bf16x8 v; v2u u[2]; } af; af.u[0] = *(const LAS v2u*)vp; af.u[1] = *(const LAS v2u*)(vp + 16);
                    oacc[db] = __builtin_amdgcn_mfma_f32_32x32x16_bf16(af.v, pf.v, oacc[db], 0, 0, 0);
                }
            }
        if (j + 1 < nkt) ATT_STORE(buf ^ 1);
        __syncthreads();
    }
#undef ATT_LOAD
#undef ATT_STORE
}


constexpr int SLD = 65;
__device__ __forceinline__ int rm32(int t, int h) { return (t & 3) + 8 * (t >> 2) + 4 * h; }
template <bool WITH_Y>
__device__ __forceinline__ void ssd_block(int b, int dir, int k, int hp, const bf16_t* xbc, const float* dtp, const float* alog, float* hs, float* alast, bf16_t* yd, float* lds, int tid) {
    const bool lat = k >= 2; const int c = lat ? (dir ? 33 - k : k - 2) : (dir ? 1 - k : k);
    const int row0 = tok_row(lat, b, c * 128), g = hp >> 1;
    float* sB = lds; float* sC = sB + 128 * SLD; float* sX = sC + 128 * SLD; float* sDT = sX + 128 * 128; float* sCum = sDT + 256; float* sW = sCum + 256; float* sSc = sW + 256;
    const int wave = tid >> 6, lane = tid & 63, r = lane & 31, h = lane >> 5, hl = wave >> 2, head = 2 * hp + hl;
    float* hsp = hs + (((size_t)(b * 2 + dir) * NCH + k) * 8 + head) * 4096;
    float hreg[WITH_Y ? 64 : 1];
    if (WITH_Y) {
#pragma unroll
        for (int Pb = 0; Pb < 2; ++Pb)
#pragma unroll
            for (int ks = 0; ks < 32; ++ks) hreg[Pb * 32 + ks] = hsp[(2 * ks + h) * 64 + 32 * Pb + r];
    }
    float4 vb[8], vx[8]; float dx[8]; float dtv = 0.f, dav = 0.f;
#pragma unroll
    for (int u = 0; u < 8; ++u) { const int i = tid + u * NTHREADS, t = i >> 5, c4 = i & 31;
        vb[u] = ld4h(xbc + (size_t)(row0 + t) * 768 + 512 + (c4 >> 4) * 128 + g * 64 + (c4 & 15) * 4);
        vx[u] = ld4h(xbc + (size_t)(row0 + t) * 768 + hp * 128 + c4 * 4);
        dx[u] = dtp[(size_t)(row0 + t) * 16 + dir * 8 + 2 * hp + (c4 >> 4)]; }
    if (tid < 256) { const int hl = tid >> 7, t = tid & 127, h = 2 * hp + hl; dtv = dtp[(size_t)(row0 + t) * 16 + dir * 8 + h]; dav = dtv * -expf(alog[dir * 8 + h]); }
    __syncthreads();
#pragma unroll
    for (int u = 0; u < 8; ++u) { const int i = tid + u * NTHREADS, t = i >> 5, c4 = i & 31;
        float* d = (c4 >> 4 ? sC : sB) + t * SLD + (c4 & 15) * 4; d[0] = vb[u].x; d[1] = vb[u].y; d[2] = vb[u].z; d[3] = vb[u].w;
        *(float4*)(sX + t * 128 + c4 * 4) = f4scale(vx[u], dx[u]); }
    if (tid < 256) { const int t = tid & 127; sSc[(tid & 128) + (dir ? 127 - t : t)] = dav; }
    __syncthreads();
    for (int off = 1; off < 128; off <<= 1) { float v = 0.f; const int sI = tid & 127;
        if (tid < 256) { v = sSc[tid]; if (sI >= off) v += sSc[tid - off]; }
        __syncthreads(); if (tid < 256) sSc[tid] = v; __syncthreads(); }
    if (tid < 256) { const int hl = tid >> 7, sI = tid & 127, t = dir ? 127 - sI : sI; const float cu = sSc[tid], tot = sSc[hl * 128 + 127];
        sCum[hl * 128 + t] = cu; sW[hl * 128 + t] = expf(tot - cu);
        if (!WITH_Y && sI == 127) alast[((size_t)(b * 2 + dir) * NCH + k) * 8 + 2 * hp + hl] = tot; }
    __syncthreads();
    if (WITH_Y) {
        const int I = hl ? 3 - (wave & 3) : (wave & 3), ti = 32 * I + r;
        const float cum_i = sCum[hl * 128 + ti];
        f32x16 Y[2], Yo[2];
#pragma unroll
        for (int i = 0; i < 16; ++i) { Y[0][i] = 0.f; Y[1][i] = 0.f; Yo[0][i] = 0.f; Yo[1][i] = 0.f; }
#pragma unroll
        for (int Pb = 0; Pb < 2; ++Pb)
#pragma unroll
            for (int ks = 0; ks < 32; ++ks) Yo[Pb] = __builtin_amdgcn_mfma_f32_32x32x2f32(hreg[Pb * 32 + ks], sC[(32 * I + r) * SLD + 2 * ks + h], Yo[Pb], 0, 0, 0);
        const int J0 = dir ? I : 0, J1 = dir ? 3 : I;
        for (int J = J0; J <= J1; ++J) {
            f32x16 Gt;
#pragma unroll
            for (int i = 0; i < 16; ++i) Gt[i] = 0.f;
#pragma unroll 8
            for (int ks = 0; ks < 32; ++ks) Gt = __builtin_amdgcn_mfma_f32_32x32x2f32(sB[(32 * J + r) * SLD + 2 * ks + h], sC[(32 * I + r) * SLD + 2 * ks + h], Gt, 0, 0, 0);
#pragma unroll
            for (int t = 0; t < 16; ++t) { const int tj = 32 * J + rm32(t, h); const bool valid = (J != I) || (dir ? tj >= ti : tj <= ti);
                Gt[t] *= valid ? __expf(cum_i - sCum[hl * 128 + tj]) : 0.f; }
#pragma unroll
            for (int Pb = 0; Pb < 2; ++Pb)
#pragma unroll
                for (int t = 0; t < 16; ++t) Y[Pb] = __builtin_amdgcn_mfma_f32_32x32x2f32(sX[(32 * J + rm32(t, h)) * 128 + hl * 64 + 32 * Pb + r], Gt[t], Y[Pb], 0, 0, 0);
        }
        const float ei = __expf(cum_i);
        bf16_t* yrow = yd + ((size_t)dir * NTOK + row0 + ti) * 512 + head * 64;
#pragma unroll
        for (int Pb = 0; Pb < 2; ++Pb)
#pragma unroll
            for (int tq = 0; tq < 4; ++tq)
                *(uint2*)(yrow + 32 * Pb + 8 * tq + 4 * h) = pk4(make_float4(Y[Pb][4 * tq] + ei * Yo[Pb][4 * tq], Y[Pb][4 * tq + 1] + ei * Yo[Pb][4 * tq + 1], Y[Pb][4 * tq + 2] + ei * Yo[Pb][4 * tq + 2], Y[Pb][4 * tq + 3] + ei * Yo[Pb][4 * tq + 3]));
    } else {
        const int Nb = (wave >> 1) & 1, Pb = wave & 1;
        f32x16 acc;
#pragma unroll
        for (int i = 0; i < 16; ++i) acc[i] = 0.f;
#pragma unroll 8
        for (int ks = 0; ks < 64; ++ks) { const int j = 2 * ks + h;
            acc = __builtin_amdgcn_mfma_f32_32x32x2f32(sB[j * SLD + 32 * Nb + r] * sW[hl * 128 + j], sX[j * 128 + hl * 64 + 32 * Pb + r], acc, 0, 0, 0); }
#pragma unroll
        for (int t = 0; t < 16; ++t) hsp[(32 * Nb + rm32(t, h)) * 64 + 32 * Pb + r] = acc[t];
    }
}

template <class RM>
__device__ __forceinline__ void cvt_tile(const float* src, int N, bf16_t* dst, int ldd, RM rowmap, int k0, int n0, int lane) {
    const int n = n0 + lane;
    if (n < N) {
        const float* sp = src + (size_t)k0 * N + n;
        float v[32];
#pragma unroll
        for (int kk = 0; kk < 32; ++kk) v[kk] = sp[(size_t)kk * N];
        uint4* dp = (uint4*)(dst + (size_t)rowmap(n) * ldd + k0);
#pragma unroll
        for (int i = 0; i < 4; ++i) dp[i] = make_uint4(pk2(v[8 * i], v[8 * i + 1]), pk2(v[8 * i + 2], v[8 * i + 3]), pk2(v[8 * i + 4], v[8 * i + 5]), pk2(v[8 * i + 6], v[8 * i + 7]));
    }
}
__device__ __forceinline__ int block_excl_scan(int v, int tid, volatile int* sh, int& total) {
    const int lane = tid & 63, wave = tid >> 6; int x = v;
#pragma unroll
    for (int o = 1; o < 64; o <<= 1) { const int y = __shfl_up(x, o); if (lane >= o) x += y; }
    __syncthreads();
    if (lane == 63) sh[wave] = x;
    __syncthreads();
    int off = 0, tot = 0;
#pragma unroll
    for (int w = 0; w < 8; ++w) { const int c = sh[w]; tot += c; if (w < wave) off += c; }
    total = tot;
    return off + x - v;
}
__device__ __forceinline__ int block_sum(int v, int tid, volatile int* sh, int parity) {
    const int lane = tid & 63, wave = tid >> 6;
#pragma unroll
    for (int o = 32; o > 0; o >>= 1) v += __shfl_xor(v, o);
    if (lane == 0) sh[parity * 8 + wave] = v;
    __syncthreads();
    int tot = 0;
#pragma unroll
    for (int w = 0; w < 8; ++w) tot += sh[parity * 8 + w];
    return tot;
}

#define MOD ((float*)(kp_->ws + WS_MOD))
#define CTXC ((float*)(kp_->ws + WS_CTXC))
#define AFF ((float*)(kp_->ws + WS_AFF))
#define TOKSLOT ((int*)(kp_->ws + WS_TOKSLOT))
#define SELIDX ((int*)(kp_->ws + WS_SELIDX))
#define SELGATE ((float*)(kp_->ws + WS_SELGATE))
#define DT ((float*)(kp_->ws + WS_DT))
#define HB ((bf16_t*)(kp_->ws + WS_HB))
#define HS ((float*)(kp_->ws + WS_HS))
#define YD ((bf16_t*)(kp_->ws + WS_YD))
#define ALAST ((float*)(kp_->ws + WS_ALAST))
#define ROPE ((float*)(kp_->ws + WS_ROPE))
#define PB ((bf16_t*)(kp_->ws + WS_P))
#define XBC ((bf16_t*)(kp_->ws + WS_XBC))
#define MQ ((bf16_t*)(kp_->ws + WS_MQ))
#define MKV ((bf16_t*)(kp_->ws + WS_MKV))
#define CQB ((bf16_t*)(kp_->ws + WS_CQB))
#define CKVB ((bf16_t*)(kp_->ws + WS_CKVB))
#define MIXB ((bf16_t*)(kp_->ws + WS_MIXB))
#define MOUT ((bf16_t*)(kp_->ws + WS_MOUT))
#define XG ((bf16_t*)(kp_->ws + WS_XG))
#define HID ((bf16_t*)(kp_->ws + WS_HID))
#define Y ((bf16_t*)(kp_->ws + WS_Y))
#define WIN_T ((bf16_t*)(kp_->ws + WS_WIN))
#define WQ_T ((bf16_t*)(kp_->ws + WS_WQ))
#define WKV_T ((bf16_t*)(kp_->ws + WS_WKV))
#define WOUT_T ((bf16_t*)(kp_->ws + WS_WOUT))
#define WGU_T ((bf16_t*)(kp_->ws + WS_WGU))
#define WD_T ((bf16_t*)(kp_->ws + WS_WD))
#define QD ((bf16_t*)(kp_->ws + WS_QD))
#define QDC ((bf16_t*)(kp_->ws + WS_QDC))
#define KD ((bf16_t*)(kp_->ws + WS_KD))
#define VDT ((bf16_t*)(kp_->ws + WS_VDT))
#define QM ((bf16_t*)(kp_->ws + WS_QM))
#define QMC ((bf16_t*)(kp_->ws + WS_QMC))
#define KM ((bf16_t*)(kp_->ws + WS_KM))
#define VMT ((bf16_t*)(kp_->ws + WS_VMT))
#define xcur (kp_->out)
#define DTMP XBC
#define modl (MOD + (size_t)l * (NB + 1) * NMOD * D)
typedef const __attribute__((address_space(4))) Prm* KPrm;
#define PHASE_BEGIN() KPrm kp_ = (KPrm)__builtin_amdgcn_kernarg_segment_ptr(); asm volatile("" : "+s"(kp_)); int tid = threadIdx.x; asm volatile("" : "+v"(tid)); (void)tid
#define GSYNC() do { XcdBarrier b_; b_.bar = (unsigned*)(kp_->ws + WS_CTL); b_.x = xb_xcc_id(); b_.st = (volatile LAS unsigned*)(ldsb + LDS_BYTES - 64); xcd_barrier(b_); } while (0)
__global__ void __launch_bounds__(NTHREADS, 2) mk_forward(Prm p) {
    extern __shared__ __attribute__((aligned(16))) unsigned char lds_raw[];
    LAS unsigned char* const ldsb = (LAS unsigned char*)lds_raw;
    volatile LAS unsigned* st = (volatile LAS unsigned*)(ldsb + LDS_BYTES - 64);
    if (threadIdx.x < 16) st[threadIdx.x] = 0u;
    __syncthreads();
    (void)xcd_barrier_post((unsigned*)(p.ws + WS_CTL), st);
    const int G = gridDim.x, bid = blockIdx.x;
    const int vcu = (G % 8 == 0) ? (bid % 8) * (G / 8) + bid / 8 : bid;

    {
        PHASE_BEGIN();
        const float* c = kp_->in[I_C]; const float* cc = kp_->in[I_CCTX]; const float* adaw = kp_->in[I_ADAW]; const float* adab = kp_->in[I_ADAB];
        float* sc_l = (float*)lds_raw;
        for (int i = tid; i < (NB + 1) * D; i += NTHREADS) { const int r = i / D, k = i % D; sc_l[i] = siluf(r < NB ? c[(size_t)r * D + k] : cc[k]); }
        __syncthreads();
        ITEMS(i, DEPTH * (NB + 1) * NMOD * D) {
            const int j = i % (NMOD * D), r = (i / (NMOD * D)) % (NB + 1), l = i / ((NB + 1) * NMOD * D);
            const float* src = sc_l + r * D;
            const float* w = adaw + (size_t)l * D * NMOD * D + j;
            float acc = adab[l * NMOD * D + j];
#pragma unroll 8
            for (int k = 0; k < D; ++k) acc += src[k] * w[(size_t)k * NMOD * D];
            MOD[i] = acc;
        }
        ITEMS(i, S * 16) {
            const int t = i >> 4, w = i & 15, ii = w & 7; const float pos = (float)(w < 8 ? t / GRID_W : t % GRID_W);
            const float ang = pos * powf(10000.0f, -(float)ii / 8.0f);
            ROPE[(size_t)t * 32 + (w < 8 ? 0 : 16) + ii] = cosf(ang); ROPE[(size_t)t * 32 + (w < 8 ? 8 : 24) + ii] = sinf(ang);
        }
        const float4* x4 = (const float4*)kp_->in[I_X]; const float4* c4 = (const float4*)kp_->in[I_CTX];
        ITEMS(i, NLAT * D / 4) ((float4*)xcur)[i] = x4[i];
        ITEMS(i, NCTX * D / 4) ((float4*)CTXC)[i] = c4[i];
        GSYNC();
    }

#pragma unroll 1
    for (int l = 0; l < DEPTH; ++l) {
        const bool ctx_out = l < DEPTH - 1;
        const float lambda_init = 0.8f - 0.6f * expf(-0.3f * (float)l);
        const int nrows_out = ctx_out ? NTOK : NLAT;
        const int ER = ctx_out ? ER_MAX : NB * CAP_L;

        {
            PHASE_BEGIN();
            {
                const int lane = tid & 63; auto idm = [](int n) { return n; };
                constexpr int T_WIN = (D / 32) * ((IN_COLS + 63) / 64), T_WQ = (192 / 32) * (384 / 64), T_WKV = (128 / 32) * (512 / 64), T_WOUT = (MIXW / 32) * (D / 64);
                WITEMS(id, T_WIN + T_WQ + T_WKV + T_WOUT) {
                    if (id < T_WIN) { const int nt = (IN_COLS + 63) / 64; cvt_tile(kp_->in[I_WIN] + (size_t)l * D * IN_COLS, IN_COLS, WIN_T, D, idm, (id / nt) * 32, (id % nt) * 64, lane); }
                    else if (id < T_WIN + T_WQ) { const int u = id - T_WIN; cvt_tile(kp_->in[I_WQUP] + (size_t)l * 192 * 384, 384, WQ_T, 256, idm, (u / 6) * 32, (u % 6) * 64, lane); }
                    else if (id < T_WIN + T_WQ + T_WKV) { const int u = id - T_WIN - T_WQ; cvt_tile(kp_->in[I_WKVUP] + (size_t)l * 128 * 512, 512, WKV_T, 128, idm, (u / 8) * 32, (u % 8) * 64, lane); }
                    else { const int u = id - T_WIN - T_WQ - T_WKV; cvt_tile(kp_->in[I_WOUT] + (size_t)l * MIXW * D, D, WOUT_T, MIXW, idm, (u / 16) * 32, (u % 16) * 64, lane); }
                }
            }
            ITEMS(i, (IN_PAD - IN_COLS) * D / 8) ((uint4*)(WIN_T + (size_t)IN_COLS * D))[i] = make_uint4(0, 0, 0, 0);
            ITEMS(i, 128 * 256 / 8) ((uint4*)(WQ_T + (size_t)384 * 256))[i] = make_uint4(0, 0, 0, 0);
            ITEMS(i, 384 * 8) { const int r = i >> 3, c8 = i & 7; *(uint4*)(WQ_T + (size_t)r * 256 + 192 + c8 * 8) = make_uint4(0, 0, 0, 0); }

            const float* w = kp_->in[I_NMPRE] + l * D;
            const int lane = tid & 63;
            WITEMS(r, NTOK) {
                const float4* src = (const float4*)(r < NLAT ? xcur + (size_t)r * D : CTXC + (size_t)(r - NLAT) * D);
                const float* md = modl + (size_t)(r < NLAT ? r / S : NB) * NMOD * D;
                float4 v[4]; float ss = 0.f;
#pragma unroll
                for (int i = 0; i < 4; ++i) { v[i] = src[i * 64 + lane]; ss += f4dot(v[i], v[i]); }
                ss = wave_sum(ss);
                const float rs = 1.0f / sqrtf(ss / D + EPS);
#pragma unroll
                for (int i = 0; i < 4; ++i) { const int k4 = i * 64 + lane; const float4 w4 = ((const float4*)w)[k4], sc = ((const float4*)(md + D))[k4], sh = ((const float4*)md)[k4];
                    const float4 o = make_float4(v[i].x * rs * w4.x * (1.0f + sc.x) + sh.x, v[i].y * rs * w4.y * (1.0f + sc.y) + sh.y, v[i].z * rs * w4.z * (1.0f + sc.z) + sh.z, v[i].w * rs * w4.w * (1.0f + sc.w) + sh.w);
                    *(uint2*)(HB + (size_t)r * D + k4 * 4) = pk4(o); }
            }
            GSYNC();
        }
        {
            PHASE_BEGIN();
            pg8::Gemm g{HB, WIN_T, NTOK, IN_PAD, D, 0, 0}; pg8::StaticOrder so; so.init(NTOK, IN_PAD, G, bid);
            pg8::EpiBf16 E{PB, IN_COLS, IN_COLS};
            pg8::gemm_phase<pg8::EpiBf16, pg8::StaticOrder, true, true>(ldsb, g, so, E);
            GSYNC();
        }
        {
            PHASE_BEGIN();
            const float* cw = kp_->in[I_CONVW] + (size_t)l * 3 * 768; const float* cb = kp_->in[I_CONVB] + (size_t)l * 768;
            ITEMS(i, NTOK * 192) {
                const int c = (i % 192) * 4, r = i / 192;
                const bool lat = r < NLAT; const int L = lat ? S : CTX; const int t = lat ? r % S : (r - NLAT) % CTX;
                const bf16_t* u = PB + (size_t)r * IN_COLS + C_XBC + c;
                float4 acc = f4add(*(const float4*)(cb + c), f4mul(*(const float4*)(cw + 768 + c), ld4h(u)));
                if (t > 0) acc = f4add(acc, f4mul(*(const float4*)(cw + c), ld4h(u - IN_COLS)));
                if (t < L - 1) acc = f4add(acc, f4mul(*(const float4*)(cw + 2 * 768 + c), ld4h(u + IN_COLS)));
                *(uint2*)(XBC + (size_t)r * 768 + c) = pk4(make_float4(siluf(acc.x), siluf(acc.y), siluf(acc.z), siluf(acc.w)));
            }
            const float* dtb = kp_->in[I_DTB] + l * 16;
            ITEMS(i, NTOK * 16) { const int j = i % 16, r = i / 16; DT[i] = softplusf(bf2f(PB[(size_t)r * IN_COLS + C_DT + j]) + dtb[j]); }
            ITEMS(i, NTOK * 16) {
                const int g = i & 15, r = i >> 4; const int hm = g & 7, isk = g >> 3;
                const bool lat = r < NLAT; const int b = lat ? r / S : (r - NLAT) / CTX, t = lat ? r % S : (r - NLAT) % CTX;
                if (!isk && !lat && !ctx_out) continue;
                const bf16_t* vp = PB + (size_t)r * IN_COLS + (isk ? C_DK : C_DQ) + hm * 32;
                float v[32];
#pragma unroll
                for (int k = 0; k < 32; k += 4) { const float4 x = ld4h(vp + k); v[k] = x.x; v[k + 1] = x.y; v[k + 2] = x.z; v[k + 3] = x.w; }
                if (lat) rope32(v, t, ROPE);
                const float sc = isk ? 1.0f : 0.17677669529663687f * 1.4426950408889634f;
                bf16_t* dst = isk ? KD + ((size_t)(b * 8 + hm) * SK + (lat ? CTX + t : t)) * 32 : (lat ? QD + ((size_t)(b * 8 + hm) * S + t) * 32 : QDC + ((size_t)(b * 8 + hm) * CTX + t) * 32);
#pragma unroll
                for (int k = 0; k < 32; k += 8) *(uint4*)(dst + k) = make_uint4(pk2(v[k] * sc, v[k + 1] * sc), pk2(v[k + 2] * sc, v[k + 3] * sc), pk2(v[k + 4] * sc, v[k + 5] * sc), pk2(v[k + 6] * sc, v[k + 7] * sc));
            }
            ITEMS(i, NB * 4 * (SK / 8) * 64) {
                const int d = i & 63, j8 = (i >> 6) % (SK / 8), hh = (i / (64 * (SK / 8))) & 3, b = i / (256 * (SK / 8));
                const int r0 = j8 * 8 < CTX ? tok_row(false, b, j8 * 8) : tok_row(true, b, j8 * 8 - CTX);
                const bf16_t* sp = PB + (size_t)r0 * IN_COLS + C_DV + hh * 64 + d;
                unsigned v[8];
#pragma unroll
                for (int jj = 0; jj < 8; ++jj) v[jj] = sp[(size_t)jj * IN_COLS];
                *(uint4*)(VDT + ((size_t)(b * 4 + hh) * 64 + d) * SK + j8 * 8) = make_uint4(v[0] | (v[1] << 16), v[2] | (v[3] << 16), v[4] | (v[5] << 16), v[6] | (v[7] << 16));
            }
            const float* qn = kp_->in[I_QNORM] + l * 192; const float* kvn = kp_->in[I_KVNORM] + l * 128;
            { const int lane = tid & 63;
            WITEMS(i, NTOK * 2) {
                const int which = i & 1, r = i >> 1; const int n4 = which ? 32 : 48;
                const bf16_t* v = PB + (size_t)r * IN_COLS + (which ? C_CKV : C_CQ); const float4* w = (const float4*)(which ? kvn : qn);
                float4 x = make_float4(0.f, 0.f, 0.f, 0.f); if (lane < n4) x = ld4h(v + lane * 4);
                const float ss = wave_sum(f4dot(x, x));
                const float rs = 1.0f / sqrtf(ss / (n4 * 4) + EPS);
                bf16_t* dst = which ? CKVB + (size_t)r * 128 : CQB + (size_t)r * 256;
                if (lane < n4) *(uint2*)(dst + lane * 4) = pk4(f4scale(f4mul(x, w[lane]), rs));
                else if (!which) *(uint2*)(dst + lane * 4) = make_uint2(0u, 0u);
            } }
            GSYNC();
        }
        {
            PHASE_BEGIN();
            const int half = G / 2;
            if (bid < half) {
                pg8::Gemm g{CQB, WQ_T, NTOK, 512, 256, 0, 0}; pg8::StaticOrder so; so.init(NTOK, 512, half, bid);
                pg8::EpiBf16 E{MQ, 384, 384};
                pg8::gemm_phase<pg8::EpiBf16, pg8::StaticOrder, true, true>(ldsb, g, so, E);
            } else {
                pg8::Gemm g{CKVB, WKV_T, NTOK, 512, 128, 0, 0}; pg8::StaticOrder so; so.init(NTOK, 512, G - half, bid - half);
                pg8::EpiBf16 E{MKV, 512, 512};
                pg8::gemm_phase<pg8::EpiBf16, pg8::StaticOrder, true, true>(ldsb, g, so, E);
            }
            for (int it = vcu; it < NB * NCH * 8; it += G) {
                const int hp = it & 3, dir = (it >> 2) & 1, cp = (it >> 3) % NCH, b = it / (8 * NCH);
                const int k = dir ? (cp < 2 ? 1 - cp : 35 - cp) : cp;
                if (k == NCH - 1) continue;
                ssd_block<false>(b, dir, k, hp, XBC, DT, kp_->in[I_ALOG] + l * 16, HS, ALAST, nullptr, (float*)lds_raw, tid);
            }
            GSYNC();
        }
        {
            PHASE_BEGIN();
            ITEMS(i, NTOK * 8) {
                const int g = i & 7, r = i >> 3; const int hh = g & 3, isk = g >> 2;
                const bool lat = r < NLAT; const int b = lat ? r / S : (r - NLAT) / CTX, t = lat ? r % S : (r - NLAT) % CTX;
                if (!isk && !lat && !ctx_out) continue;
                const bf16_t* npb = isk ? MKV + (size_t)r * 512 + hh * 128 : MQ + (size_t)r * 384 + hh * 96;
                const bf16_t* rp = isk ? PB + (size_t)r * IN_COLS + C_KR : npb + 64;
                float v[32], np[64];
#pragma unroll
                for (int k = 0; k < 32; k += 4) { const float4 x = ld4h(rp + k); v[k] = x.x; v[k + 1] = x.y; v[k + 2] = x.z; v[k + 3] = x.w; }
#pragma unroll
                for (int k = 0; k < 64; k += 4) { const float4 x = ld4h(npb + k); np[k] = x.x; np[k + 1] = x.y; np[k + 2] = x.z; np[k + 3] = x.w; }
                if (lat) rope32(v, t, ROPE);
                const float sc = isk ? 1.0f : 0.10206207261596575f * 1.4426950408889634f;
                bf16_t* dst = isk ? KM + ((size_t)(b * 4 + hh) * SK + (lat ? CTX + t : t)) * 96 : (lat ? QM + ((size_t)(b * 4 + hh) * S + t) * 96 : QMC + ((size_t)(b * 4 + hh) * CTX + t) * 96);
#pragma unroll
                for (int k = 0; k < 64; k += 8) *(uint4*)(dst + k) = make_uint4(pk2(np[k] * sc, np[k + 1] * sc), pk2(np[k + 2] * sc, np[k + 3] * sc), pk2(np[k + 4] * sc, np[k + 5] * sc), pk2(np[k + 6] * sc, np[k + 7] * sc));
#pragma unroll
                for (int k = 0; k < 32; k += 8) *(uint4*)(dst + 64 + k) = make_uint4(pk2(v[k] * sc, v[k + 1] * sc), pk2(v[k + 2] * sc, v[k + 3] * sc), pk2(v[k + 4] * sc, v[k + 5] * sc), pk2(v[k + 6] * sc, v[k + 7] * sc));
            }
            ITEMS(i, NB * 4 * (SK / 8) * 64) {
                const int d = i & 63, j8 = (i >> 6) % (SK / 8), hh = (i / (64 * (SK / 8))) & 3, b = i / (256 * (SK / 8));
                const int r0 = j8 * 8 < CTX ? tok_row(false, b, j8 * 8) : tok_row(true, b, j8 * 8 - CTX);
                const bf16_t* sp = MKV + (size_t)r0 * 512 + hh * 128 + 64 + d;
                unsigned v[8];
#pragma unroll
                for (int jj = 0; jj < 8; ++jj) v[jj] = sp[(size_t)jj * 512];
                *(uint4*)(VMT + ((size_t)(b * 4 + hh) * 64 + d) * SK + j8 * 8) = make_uint4(v[0] | (v[1] << 16), v[2] | (v[3] << 16), v[4] | (v[5] << 16), v[6] | (v[7] << 16));
            }
            ITEMS(i, NB * 2 * 8 * 4096) {
                const int e = i & 4095, h = (i >> 12) & 7, bd = i >> 15;
                float* hp0 = HS + ((size_t)bd * NCH * 8 + h) * 4096 + e; const float* al0 = ALAST + (size_t)bd * NCH * 8 + h;
                float sv[NCH - 1], dk[NCH - 1];
#pragma unroll
                for (int k = 0; k < NCH - 1; ++k) { sv[k] = hp0[(size_t)k * 8 * 4096]; dk[k] = al0[k * 8]; }
                float Hc = 0.f;
#pragma unroll
                for (int k = 0; k < NCH; ++k) { hp0[(size_t)k * 8 * 4096] = Hc; if (k < NCH - 1) Hc = Hc * __expf(dk[k]) + sv[k]; }
            }
            GSYNC();
        }
        {
            PHASE_BEGIN();
            for (int it = vcu; it < NB * 2 * NCH * 4; it += G) {
                const int hp = it & 3, dir = (it >> 2) & 1, cp = (it >> 3) % NCH, b = it / (8 * NCH);
                const int k = dir ? (cp < 2 ? 1 - cp : 35 - cp) : cp;
                if (k < 2 && !ctx_out) continue;
                ssd_block<true>(b, dir, k, hp, XBC, DT, kp_->in[I_ALOG] + l * 16, HS, ALAST, YD, (float*)lds_raw, tid);
            }
            const int lane = tid & 63, wave = tid >> 6, qr = lane & 31, hf = lane >> 5;
            {
                const float* lq1 = kp_->in[I_LQ1] + l * 32; const float* lk1 = kp_->in[I_LK1] + l * 32; const float* lq2 = kp_->in[I_LQ2] + l * 32; const float* lk2 = kp_->in[I_LK2] + l * 32;
                float d1 = 0.f, d2 = 0.f; for (int k = 0; k < 32; ++k) { d1 += lq1[k] * lk1[k]; d2 += lq2[k] * lk2[k]; }
                const float lam = expf(d1) - expf(d2) + lambda_init;
                const float* subw = kp_->in[I_SUBLN] + l * 64;
                const int nlat = NB * 4 * (S / 256), nit = nlat + (ctx_out ? NB * 4 : 0);
                for (int it = vcu; it < nit; it += G) {
                    const bool lat = it < nlat; const int u = lat ? it : it - nlat;
                    const int qb = lat ? u % (S / 256) : 0, hh = lat ? (u / (S / 256)) % 4 : u % 4, b = lat ? u / (4 * (S / 256)) : u / 4;
                    const int t = qb * 256 + wave * 32 + qr; const int row = tok_row(lat, b, t); const int nkt = lat ? SK / 64 : CTX / 64;
                    f32x16 o1[2], oacc[2]; float lsum1 = 0.f;
#pragma unroll
                    for (int mp = 0; mp < 2; ++mp) {
                        const int hm = hh * 2 + mp;
                        const bf16_t* qrow = lat ? QD + ((size_t)(b * 8 + hm) * S + t) * 32 : QDC + ((size_t)(b * 8 + hm) * CTX + t) * 32;
                        float m_run = -1e30f, l_run = 0.f;
#pragma unroll
                        for (int i = 0; i < 16; ++i) { oacc[0][i] = 0.f; oacc[1][i] = 0.f; }
                        attn_pass<32>(qrow, KD + (size_t)(b * 8 + hm) * SK * 32, VDT + (size_t)(b * 4 + hh) * 64 * SK, SK, nkt, ldsb, tid, oacc, m_run, l_run);
                        l_run = xor32_sum(l_run);
                        if (mp == 0) { o1[0] = oacc[0]; o1[1] = oacc[1]; lsum1 = l_run; }
                        else {
                            const float i1 = 1.0f / lsum1, i2 = lam / l_run; float ss = 0.f;
#pragma unroll
                            for (int db = 0; db < 2; ++db)
#pragma unroll
                                for (int i = 0; i < 16; ++i) { const float v = o1[db][i] * i1 - oacc[db][i] * i2; o1[db][i] = v; ss += v * v; }
                            ss = xor32_sum(ss);
                            const float rs = (1.0f - lambda_init) / sqrtf(ss / 64 + EPS);
                            bf16_t* orow = MIXB + (size_t)row * MIXW + 512 + hh * 64;
#pragma unroll
                            for (int db = 0; db < 2; ++db)
#pragma unroll
                                for (int gq = 0; gq < 4; ++gq) { const int d0 = 32 * db + 8 * gq + 4 * hf; const float4 w4 = *(const float4*)(subw + d0);
                                    *(uint2*)(orow + d0) = make_uint2(pk2(o1[db][4 * gq] * rs * w4.x, o1[db][4 * gq + 1] * rs * w4.y), pk2(o1[db][4 * gq + 2] * rs * w4.z, o1[db][4 * gq + 3] * rs * w4.w)); }
                        }
                    }
                }
            }
            {
                const int nlat = NB * 4 * (S / 256), nit = nlat + (ctx_out ? NB * 4 : 0);
                for (int it = vcu; it < nit; it += G) {
                    const bool lat = it < nlat; const int u = lat ? it : it - nlat;
                    const int qb = lat ? u % (S / 256) : 0, hh = lat ? (u / (S / 256)) % 4 : u % 4, b = lat ? u / (4 * (S / 256)) : u / 4;
                    const int t = qb * 256 + wave * 32 + qr; const int row = tok_row(lat, b, t); const int nkt = lat ? SK / 64 : CTX / 64;
                    const bf16_t* qrow = lat ? QM + ((size_t)(b * 4 + hh) * S + t) * 96 : QMC + ((size_t)(b * 4 + hh) * CTX + t) * 96;
                    f32x16 oacc[2]; float m_run = -1e30f, l_run = 0.f;
#pragma unroll
                    for (int i = 0; i < 16; ++i) { oacc[0][i] = 0.f; oacc[1][i] = 0.f; }
                    attn_pass<96>(qrow, KM + (size_t)(b * 4 + hh) * SK * 96, VMT + (size_t)(b * 4 + hh) * 64 * SK, SK, nkt, ldsb, tid, oacc, m_run, l_run);
                    l_run = xor32_sum(l_run);
                    const float inv = 1.0f / l_run;
                    bf16_t* orow = MIXB + (size_t)row * MIXW + 768 + hh * 64;
#pragma unroll
                    for (int db = 0; db < 2; ++db)
#pragma unroll
                        for (int gq = 0; gq < 4; ++gq) { const int d0 = 32 * db + 8 * gq + 4 * hf;
                            *(uint2*)(orow + d0) = make_uint2(pk2(oacc[db][4 * gq] * inv, oacc[db][4 * gq + 1] * inv), pk2(oacc[db][4 * gq + 2] * inv, oacc[db][4 * gq + 3] * inv)); }
                }
            }
            GSYNC();
        }
        {
            PHASE_BEGIN();
            const float* nw = kp_->in[I_SSDN] + l * 512; const float* dsk = kp_->in[I_SSDD] + l * 8;
            const int lane = tid & 63;
            WITEMS(i, nrows_out * 2) {
                const int g = i & 1, r = i >> 1, c = g * 256 + lane * 4;
                const float4 x = ld4h(XBC + (size_t)r * 768 + c), y0 = ld4h(YD + (size_t)r * 512 + c), y1 = ld4h(YD + ((size_t)NTOK + r) * 512 + c);
                const float4 z = ld4h(PB + (size_t)r * IN_COLS + C_Z + c);
                const float ds = dsk[c >> 6];
                float4 v = make_float4((ds * x.x + y0.x + y1.x) * siluf(z.x), (ds * x.y + y0.y + y1.y) * siluf(z.y), (ds * x.z + y0.z + y1.z) * siluf(z.z), (ds * x.w + y0.w + y1.w) * siluf(z.w));
                const float ss = wave_sum(f4dot(v, v));
                const float rs = 1.0f / sqrtf(ss / 256 + EPS);
                *(uint2*)(MIXB + (size_t)r * MIXW + c) = pk4(f4scale(f4mul(v, *(const float4*)(nw + c)), rs));
            }
            GSYNC();
        }
        {
            PHASE_BEGIN();
            pg8::Gemm g{MIXB, WOUT_T, nrows_out, D, MIXW, 0, 0}; pg8::StaticOrder so; so.init(nrows_out, D, G, bid);
            pg8::EpiBf16 E{MOUT, D, D};
            pg8::gemm_phase<pg8::EpiBf16, pg8::StaticOrder, true, true>(ldsb, g, so, E);
            GSYNC();
        }
        {
            PHASE_BEGIN();
            const float* wpost = kp_->in[I_NMPOST] + l * D; const float* wpre = kp_->in[I_NFPRE] + l * D;
            const float* rw = kp_->in[I_RW] + (size_t)l * D * NE; const float* rb = kp_->in[I_RB] + l * NE;
            const int lane = tid & 63;
            float* rwl = (float*)lds_raw;
            for (int i = tid; i < D * NE / 4; i += NTHREADS) ((float4*)rwl)[i] = ((const float4*)rw)[i];
            __syncthreads();
            WITEMS(r, nrows_out) {
                float4* xr = (float4*)(r < NLAT ? xcur + (size_t)r * D : CTXC + (size_t)(r - NLAT) * D);
                const float* md = modl + (size_t)(r < NLAT ? r / S : NB) * NMOD * D;
                const bf16_t* m = MOUT + (size_t)r * D;
                float4 mv[4], xv[4]; float ss = 0.f;
#pragma unroll
                for (int i = 0; i < 4; ++i) { mv[i] = ld4h(m + (i * 64 + lane) * 4); xv[i] = xr[i * 64 + lane]; ss += f4dot(mv[i], mv[i]); }
                ss = wave_sum(ss);
                const float rs = 1.0f / sqrtf(ss / D + EPS);
                float s2 = 0.f;
#pragma unroll
                for (int i = 0; i < 4; ++i) { const int k4 = i * 64 + lane; const float4 g2 = ((const float4*)(md + 2 * D))[k4], wp = ((const float4*)wpost)[k4];
                    xv[i] = f4add(xv[i], f4mul(g2, f4scale(f4mul(mv[i], wp), rs))); xr[k4] = xv[i]; s2 += f4dot(xv[i], xv[i]); }
                s2 = wave_sum(s2);
                const float r2 = 1.0f / sqrtf(s2 / D + EPS);
                float lg[NE];
#pragma unroll
                for (int e = 0; e < NE; ++e) lg[e] = 0.f;
#pragma unroll
                for (int i = 0; i < 4; ++i) { const int k4 = i * 64 + lane; const float4 w4 = ((const float4*)wpre)[k4], sc = ((const float4*)(md + 4 * D))[k4], sh = ((const float4*)(md + 3 * D))[k4];
                    const float hv[4] = {xv[i].x * r2 * w4.x * (1.0f + sc.x) + sh.x, xv[i].y * r2 * w4.y * (1.0f + sc.y) + sh.y, xv[i].z * r2 * w4.z * (1.0f + sc.z) + sh.z, xv[i].w * r2 * w4.w * (1.0f + sc.w) + sh.w};
                    *(uint2*)(HB + (size_t)r * D + k4 * 4) = make_uint2(pk2(hv[0], hv[1]), pk2(hv[2], hv[3]));
#pragma unroll
                    for (int c = 0; c < 4; ++c) { const float4* rwp = (const float4*)(rwl + (size_t)(k4 * 4 + c) * NE);
#pragma unroll
                        for (int e4 = 0; e4 < 4; ++e4) { const float4 w = rwp[e4]; lg[4 * e4] += hv[c] * w.x; lg[4 * e4 + 1] += hv[c] * w.y; lg[4 * e4 + 2] += hv[c] * w.z; lg[4 * e4 + 3] += hv[c] * w.w; }
                        SCHED_FENCE(); }
                }
#pragma unroll
                for (int e = 0; e < NE; ++e) lg[e] = wave_sum(lg[e]) + rb[e];
                float mx = lg[0];
#pragma unroll
                for (int e = 1; e < NE; ++e) mx = fmaxf(mx, lg[e]);
                float sum = 0.f;
#pragma unroll
                for (int e = 0; e < NE; ++e) { lg[e] = expf(lg[e] - mx); sum += lg[e]; }
                const float is = 1.0f / sum;
                float mine = lg[0];
#pragma unroll
                for (int e = 1; e < NE; ++e) mine = lane == e ? lg[e] : mine;
                if (lane < NE) AFF[(size_t)r * NE + lane] = mine * is;
            }
            GSYNC();
        }
        {
            PHASE_BEGIN();
            {
                const int lane = tid & 63;
                WITEMS(id, NE * 3 * 512) {
                    const int mat = id >> 9, tl = id & 511, e = mat / 3, which = mat % 3, k0 = (tl >> 4) * 32, n0 = (tl & 15) * 64;
                    if (which == 0) cvt_tile(kp_->in[I_WG] + ((size_t)l * NE + e) * D * FF, FF, WGU_T + (size_t)e * 2 * FF * D, D, [](int n) { return (n >> 2) * 8 + (n & 3); }, k0, n0, lane);
                    else if (which == 1) cvt_tile(kp_->in[I_WU] + ((size_t)l * NE + e) * D * FF, FF, WGU_T + (size_t)e * 2 * FF * D, D, [](int n) { return (n >> 2) * 8 + 4 + (n & 3); }, k0, n0, lane);
                    else cvt_tile(kp_->in[I_WD] + ((size_t)l * NE + e) * FF * D, D, WD_T + (size_t)e * D * FF, FF, [](int n) { return n; }, k0, n0, lane);
                }
            }
            {
                volatile int* sh = (volatile int*)lds_raw;
                const int nsel = (ctx_out ? 2 : 1) * NB * NE;
                for (int it = bid; it < nsel; it += G) {
                    const bool lat = it < NB * NE; const int u = lat ? it : it - NB * NE; const int e = u % NE, b = u / NE;
                    const int L = lat ? S : CTX, cap = lat ? CAP_L : CAP_C, npt = lat ? S / NTHREADS : 1, base = tok_row(lat, b, 0);
                    const bool act = lat || tid < CTX;
                    unsigned key[S / NTHREADS];
#pragma unroll
                    for (int i = 0; i < S / NTHREADS; ++i) key[i] = (act && i < npt) ? __float_as_uint(AFF[(size_t)(base + tid * npt + i) * NE + e]) : 0u;
                    __syncthreads();
                    unsigned T = 0u;
                    for (int bit = 30; bit >= 0; --bit) {
                        const unsigned cand = T | (1u << bit); int c = 0;
#pragma unroll
                        for (int i = 0; i < S / NTHREADS; ++i) c += (key[i] >= cand) ? 1 : 0;
                        if (block_sum(c, tid, sh, bit & 1) >= cap) T = cand;
                    }
                    int cg = 0, ct = 0;
#pragma unroll
                    for (int i = 0; i < S / NTHREADS; ++i) { cg += (key[i] > T) ? 1 : 0; ct += (key[i] == T && key[i] != 0u) ? 1 : 0; }
                    int tot_g, tot_t;
                    (void)block_excl_scan(cg, tid, sh, tot_g);
                    int tie_rank = block_excl_scan(ct, tid, sh, tot_t);
                    const int need = cap - tot_g;
                    int sel[S / NTHREADS], cs = 0;
#pragma unroll
                    for (int i = 0; i < S / NTHREADS; ++i) { const bool tie = key[i] == T && key[i] != 0u; sel[i] = (key[i] > T || (tie && tie_rank < need)) ? 1 : 0; tie_rank += tie ? 1 : 0; cs += sel[i]; }
                    int tot_s; int slot = block_excl_scan(cs, tid, sh, tot_s);
#pragma unroll
                    for (int i = 0; i < S / NTHREADS; ++i) if (act && i < npt) {
                        const int row = base + tid * npt + i; int sa = -1;
                        if (sel[i]) { sa = (lat ? b * CAP_L : NB * CAP_L + b * CAP_C) + slot; ++slot; SELIDX[e * ER_MAX + sa] = row; SELGATE[e * ER_MAX + sa] = __uint_as_float(key[i]); }
                        TOKSLOT[(size_t)row * NE + e] = sa;
                    }
                }
            }
            GSYNC();
        }
        {
            PHASE_BEGIN();
            const int used = ctx_out ? NB * (CAP_L + CAP_C) : NB * CAP_L;
            ITEMS(i, NE * ER * (D / 8)) {
                const int c8 = i % (D / 8), slot = (i / (D / 8)) % ER, e = i / ((D / 8) * ER);
                uint4 v = make_uint4(0, 0, 0, 0);
                if (slot < used) v = *(const uint4*)(HB + (size_t)SELIDX[e * ER_MAX + slot] * D + c8 * 8);
                *(uint4*)(XG + ((size_t)e * ER + slot) * D + c8 * 8) = v;
            }
            GSYNC();
        }
        {
            PHASE_BEGIN();
            pg8::Gemm g{XG, WGU_T, NE * ER, 2 * FF, D, ER / 256, (size_t)2 * FF * D * 2}; pg8::StaticOrder so; so.init(NE * ER, 2 * FF, G, bid);
            pg8::EpiSwiGLU E{HID, FF};
            pg8::gemm_phase<pg8::EpiSwiGLU, pg8::StaticOrder, true, true>(ldsb, g, so, E);
            GSYNC();
        }
        {
            PHASE_BEGIN();
            pg8::Gemm g{HID, WD_T, NE * ER, D, FF, ER / 256, (size_t)D * FF * 2}; pg8::StaticOrder so; so.init(NE * ER, D, G, bid);
            pg8::EpiRowScaleBf16 E{Y, D, SELGATE, ER};
            pg8::gemm_phase<pg8::EpiRowScaleBf16, pg8::StaticOrder, true, true>(ldsb, g, so, E);
            GSYNC();
        }
        {
            PHASE_BEGIN();
            const float* wpost = kp_->in[I_NFPOST] + l * D;
            const int lane = tid & 63;
            WITEMS(r, nrows_out) {
                float4* xr = (float4*)(r < NLAT ? xcur + (size_t)r * D : CTXC + (size_t)(r - NLAT) * D);
                const float* md = modl + (size_t)(r < NLAT ? r / S : NB) * NMOD * D;
                const int myslot = lane < NE ? TOKSLOT[(size_t)r * NE + lane] : -1;
                float4 f[4];
#pragma unroll
                for (int i = 0; i < 4; ++i) f[i] = make_float4(0.f, 0.f, 0.f, 0.f);
#pragma unroll
                for (int e = 0; e < NE; ++e) {
                    const int sl = __builtin_amdgcn_readlane(myslot, e);
                    if (sl >= 0) { const bf16_t* yp = Y + ((size_t)e * ER + sl) * D;
#pragma unroll
                        for (int i = 0; i < 4; ++i) f[i] = f4add(f[i], ld4h(yp + (i * 64 + lane) * 4)); }
                }
                float ss = 0.f;
#pragma unroll
                for (int i = 0; i < 4; ++i) ss += f4dot(f[i], f[i]);
                ss = wave_sum(ss);
                const float rs = 1.0f / sqrtf(ss / D + EPS);
#pragma unroll
                for (int i = 0; i < 4; ++i) { const int k4 = i * 64 + lane; const float4 g5 = ((const float4*)(md + 5 * D))[k4], wp = ((const float4*)wpost)[k4];
                    xr[k4] = f4add(xr[k4], f4mul(g5, f4scale(f4mul(f[i], wp), rs))); }
            }
            GSYNC();
        }
    }
}

extern "C" void kernel_launch(void* const* d_in, const int* in_sizes, int n_in, void* d_out, int out_size, void* d_ws, size_t ws_size, hipStream_t stream) {
    static int grid = 0;
    if (grid == 0) {
        if (n_in != N_IN || out_size != NLAT * D || ws_size < WS_END) { fprintf(stderr, "kernel_launch: unexpected shapes: n_in %d out %d ws %zu (need %zu)\n", n_in, out_size, ws_size, (size_t)WS_END); grid = -1; return; }
        int dev = 0, cus = 0, per_cu = 0;
        (void)hipGetDevice(&dev);
        (void)hipDeviceGetAttribute(&cus, hipDeviceAttributeMultiprocessorCount, dev);
        (void)hipFuncSetAttribute((const void*)mk_forward, hipFuncAttributeMaxDynamicSharedMemorySize, LDS_BYTES);
        (void)hipOccupancyMaxActiveBlocksPerMultiprocessor(&per_cu, (const void*)mk_forward, NTHREADS, LDS_BYTES);
        (void)hipGetLastError();
        if (per_cu < 1) { fprintf(stderr, "kernel_launch: occupancy query says %d blocks/CU\n", per_cu); grid = -1; return; }
        grid = cus;
    }
    if (grid < 0) return;
    (void)hipMemsetAsync((char*)d_ws + WS_CTL, 0, CTL_BYTES, stream);
    Prm p{};
    for (int i = 0; i < N_IN; ++i) p.in[i] = (const float*)d_in[i];
    p.out = (float*)d_out; p.ws = (char*)d_ws;
    void* args[] = {&p};
    hipError_t e = hipLaunchCooperativeKernel((const void*)mk_forward, dim3(grid), dim3(NTHREADS), args, LDS_BYTES, stream);
    if (e != hipSuccess) fprintf(stderr, "kernel_launch: cooperative launch failed: %s (grid %d)\n", hipGetErrorString(e), grid);
}
```

```cpp
#include <hip/hip_runtime.h>
#include <cstdio>
#include <cstdint>

constexpr int D = 1024, NB = 4, S = 4096, CTX = 256, FF = 1024;
constexpr int DEPTH = 2, GRID_W = 64, NMOD = 6, NE = 16;
constexpr int NLAT = NB * S, NCTX = NB * CTX, NTOK = NLAT + NCTX;
constexpr int IN_COLS = 2416, IN_PAD = 2560;
constexpr int C_Z = 0, C_XBC = 512, C_DT = 1280, C_DQ = 1296, C_DK = 1552, C_DV = 1808, C_CQ = 2064, C_CKV = 2256, C_KR = 2384;
constexpr int MIXW = 1024;
constexpr int CAP_L = 2 * S / NE, CAP_C = 2 * CTX / NE;
constexpr int ER_MAX = 2304;
constexpr float EPS = 1e-6f;
static_assert(NB * CAP_L == 2048 && NB * CAP_C == 128, "expert row layout");

enum { I_X = 0, I_C, I_CTX, I_CCTX, I_ADAW, I_ADAB, I_NMPRE, I_NMPOST, I_NFPRE, I_NFPOST, I_WIN, I_CONVW, I_CONVB, I_ALOG, I_DTB, I_SSDD, I_SSDN,
       I_LQ1, I_LK1, I_LQ2, I_LK2, I_SUBLN, I_QNORM, I_WQUP, I_KVNORM, I_WKVUP, I_WOUT, I_RW, I_RB, I_WG, I_WU, I_WD, N_IN };
struct Prm { const float* in[N_IN]; float* out; char* ws; };

typedef unsigned short bf16_t;
constexpr size_t al256(size_t x) { return (x + 255) & ~(size_t)255; }
constexpr size_t WS_CTL = 0, CTL_BYTES = 65536;
constexpr size_t WS_MOD = WS_CTL + CTL_BYTES;
constexpr size_t WS_CTXC = al256(WS_MOD + (size_t)DEPTH * (NB + 1) * NMOD * D * 4);
constexpr size_t WS_AFF = al256(WS_CTXC + (size_t)NCTX * D * 4);
constexpr size_t WS_TOKSLOT = al256(WS_AFF + (size_t)NTOK * NE * 4);
constexpr size_t WS_SELIDX = al256(WS_TOKSLOT + (size_t)NTOK * NE * 4);
constexpr size_t WS_SELGATE = al256(WS_SELIDX + (size_t)NE * ER_MAX * 4);
constexpr size_t WS_DT = al256(WS_SELGATE + (size_t)NE * ER_MAX * 4);
constexpr int NCH = 34;
constexpr size_t WS_ROPE = al256(WS_DT + (size_t)NTOK * 16 * 4);
constexpr size_t WS_ALAST = al256(WS_ROPE + (size_t)S * 32 * 4);
constexpr size_t WS_HB = al256(WS_ALAST + (size_t)NB * 2 * NCH * 8 * 4);
constexpr size_t WS_P = al256(WS_HB + (size_t)NTOK * D * 2);
constexpr size_t WS_G2 = al256(WS_P + (size_t)NTOK * IN_COLS * 4);
constexpr size_t WS_XBC = WS_G2;
constexpr size_t WS_MQ = al256(WS_XBC + (size_t)NTOK * 768 * 4);
constexpr size_t WS_MKV = al256(WS_MQ + (size_t)NTOK * 384 * 4);
constexpr size_t WS_CQB = al256(WS_MKV + (size_t)NTOK * 512 * 4);
constexpr size_t WS_CKVB = al256(WS_CQB + (size_t)NTOK * 256 * 2);
constexpr size_t WS_MIXB = al256(WS_CKVB + (size_t)NTOK * 128 * 2);
constexpr size_t WS_G2END = al256(WS_MIXB + (size_t)NTOK * MIXW * 2);
constexpr size_t WS_HS = WS_HB;
constexpr size_t WS_YD = WS_MQ;
constexpr size_t WS_MOUT = WS_P;
constexpr size_t WS_XG = WS_P;
constexpr size_t WS_HID = al256(WS_XG + (size_t)NE * ER_MAX * D * 2);
constexpr size_t WS_Y = WS_G2;
constexpr size_t WS_WIN = WS_G2END;
constexpr size_t WS_WQ = al256(WS_WIN + (size_t)IN_PAD * D * 2);
constexpr size_t WS_WKV = al256(WS_WQ + (size_t)512 * 256 * 2);
constexpr size_t WS_WOUT = al256(WS_WKV + (size_t)512 * 128 * 2);
constexpr size_t WS_WGU = al256(WS_WOUT + (size_t)D * MIXW * 2);
constexpr size_t WS_WD = al256(WS_WGU + (size_t)NE * 2 * FF * D * 2);
constexpr size_t WS_END = al256(WS_WD + (size_t)NE * D * FF * 2);
constexpr int SK = CTX + S;
constexpr size_t WS_QD = WS_WGU;
constexpr size_t WS_QDC = al256(WS_QD + (size_t)NB * 8 * S * 32 * 2);
constexpr size_t WS_KD = al256(WS_QDC + (size_t)NB * 8 * CTX * 32 * 2);
constexpr size_t WS_VDT = al256(WS_KD + (size_t)NB * 8 * SK * 32 * 2);
constexpr size_t WS_QM = al256(WS_VDT + (size_t)NB * 4 * 64 * SK * 2);
constexpr size_t WS_QMC = al256(WS_QM + (size_t)NB * 4 * S * 96 * 2);
constexpr size_t WS_KM = al256(WS_QMC + (size_t)NB * 4 * CTX * 96 * 2);
constexpr size_t WS_VMT = al256(WS_KM + (size_t)NB * 4 * SK * 96 * 2);
constexpr size_t WS_ATTEND = al256(WS_VMT + (size_t)NB * 4 * 64 * SK * 2);
static_assert(WS_ATTEND <= WS_END, "attention operands fit in the MoE weight region");
static_assert(WS_HID + (size_t)NE * ER_MAX * FF * 2 <= WS_G2, "XG+HID fit in the P region");
static_assert((size_t)NE * ER_MAX * D * 4 <= WS_G2END - WS_G2, "Y fits in the G2 region");
static_assert((size_t)NB * 2 * NCH * 8 * 4096 * 4 <= (size_t)NTOK * D * 2, "HS fits in HB");
static_assert(WS_YD + (size_t)2 * NTOK * 512 * 4 <= WS_MIXB, "YD ends below MIXB");

#define LAS __attribute__((address_space(3)))
constexpr int NTHREADS = 512;
constexpr int LDS_BYTES = 147456;
#define ITEMS(i, n) for (int i = blockIdx.x * NTHREADS + tid; i < (n); i += gridDim.x * NTHREADS)

__device__ __forceinline__ float siluf(float x) { return x / (1.0f + expf(-x)); }
__device__ __forceinline__ float softplusf(float x) { return x > 20.f ? x : log1pf(expf(x)); }
__device__ __forceinline__ unsigned f2bf(float f) { unsigned u = __builtin_bit_cast(unsigned, f); return (u + 0x7fffu + ((u >> 16) & 1u)) >> 16; }
typedef float f32x2_t __attribute__((ext_vector_type(2)));
typedef __bf16 bf16x2_t __attribute__((ext_vector_type(2)));
__device__ __forceinline__ unsigned pk2(float lo, float hi) { const f32x2_t v = {lo, hi}; return __builtin_bit_cast(unsigned, __builtin_convertvector(v, bf16x2_t)); }
__device__ __forceinline__ float bf2f(bf16_t h) { return __builtin_bit_cast(float, (unsigned)h << 16); }
#define SCHED_FENCE() __builtin_amdgcn_sched_barrier(0)
__device__ __forceinline__ float dpp_row_shr(float v, int n) {
    const int iv = __builtin_bit_cast(int, v); int r;
    switch (n) { case 1: r = __builtin_amdgcn_update_dpp(0, iv, 0x111, 0xf, 0xf, true); break; case 2: r = __builtin_amdgcn_update_dpp(0, iv, 0x112, 0xf, 0xf, true); break;
                 case 4: r = __builtin_amdgcn_update_dpp(0, iv, 0x114, 0xf, 0xf, true); break; default: r = __builtin_amdgcn_update_dpp(0, iv, 0x118, 0xf, 0xf, true); break; }
    return __builtin_bit_cast(float, r);
}
__device__ __forceinline__ float wave_sum(float v) {
    v += dpp_row_shr(v, 1); v += dpp_row_shr(v, 2); v += dpp_row_shr(v, 4); v += dpp_row_shr(v, 8);
    v += __builtin_bit_cast(float, __builtin_amdgcn_update_dpp(0, __builtin_bit_cast(int, v), 0x142, 0xa, 0xf, false));
    v += __builtin_bit_cast(float, __builtin_amdgcn_update_dpp(0, __builtin_bit_cast(int, v), 0x143, 0xc, 0xf, false));
    return __builtin_bit_cast(float, __builtin_amdgcn_readlane(__builtin_bit_cast(int, v), 63)); }
__device__ __forceinline__ float xor32_max(float x) { auto t = __builtin_amdgcn_permlane32_swap(__float_as_uint(x), __float_as_uint(x), false, false); return fmaxf(__uint_as_float(t[0]), __uint_as_float(t[1])); }
__device__ __forceinline__ float xor32_sum(float x) { auto t = __builtin_amdgcn_permlane32_swap(__float_as_uint(x), __float_as_uint(x), false, false); return __uint_as_float(t[0]) + __uint_as_float(t[1]); }
#define WITEMS(i, n) for (int i = blockIdx.x * 8 + (tid >> 6); i < (n); i += gridDim.x * 8)
__device__ __forceinline__ float4 f4mul(float4 a, float4 b) { return make_float4(a.x * b.x, a.y * b.y, a.z * b.z, a.w * b.w); }
__device__ __forceinline__ float4 f4add(float4 a, float4 b) { return make_float4(a.x + b.x, a.y + b.y, a.z + b.z, a.w + b.w); }
__device__ __forceinline__ float4 f4scale(float4 a, float s) { return make_float4(a.x * s, a.y * s, a.z * s, a.w * s); }
__device__ __forceinline__ float f4dot(float4 a, float4 b) { return a.x * b.x + a.y * b.y + a.z * b.z + a.w * b.w; }
__device__ __forceinline__ uint2 pk4(float4 v) { return make_uint2(pk2(v.x, v.y), pk2(v.z, v.w)); }
__device__ __forceinline__ float4 up4(uint2 u) { return make_float4(__uint_as_float(u.x << 16), __uint_as_float(u.x & 0xffff0000u), __uint_as_float(u.y << 16), __uint_as_float(u.y & 0xffff0000u)); }
__device__ __forceinline__ float4 ld4h(const bf16_t* p) { return up4(*(const uint2*)p); }

__device__ __forceinline__ void rope32(float* v, int t, const float* tab) {
    const float4* tp = (const float4*)(tab + (size_t)t * 32);
    float cs[32];
#pragma unroll
    for (int i = 0; i < 8; ++i) { const float4 x = tp[i]; cs[4 * i] = x.x; cs[4 * i + 1] = x.y; cs[4 * i + 2] = x.z; cs[4 * i + 3] = x.w; }
#pragma unroll
    for (int i = 0; i < 8; ++i) {
        { const float c = cs[i], sn = cs[8 + i]; const float x1 = v[i], x2 = v[8 + i]; v[i] = x1 * c - x2 * sn; v[8 + i] = x1 * sn + x2 * c; }
        { const float c = cs[16 + i], sn = cs[24 + i]; const float x1 = v[16 + i], x2 = v[24 + i]; v[16 + i] = x1 * c - x2 * sn; v[24 + i] = x1 * sn + x2 * c; }
    }
}
__device__ __forceinline__ int tok_row(bool lat, int b, int t) { return lat ? b * S + t : NLAT + b * CTX + t; }

namespace pg8 {
#define PG8_LAS __attribute__((address_space(3)))
typedef short bf16x8 __attribute__((ext_vector_type(8)));
typedef float f32x4 __attribute__((ext_vector_type(4)));
typedef unsigned u32x4 __attribute__((ext_vector_type(4)));
constexpr int BM = 256, BK = 64, HALF = 128, HTB = HALF * BK * 2  , STAGE_BYTES = 8 * HTB, NXCD = 8, WGM = 8;

__host__ __device__ __forceinline__ int lds_byte(int r, int c) { const int st = (r >> 4) * 2 + (c >> 5), rr = r & 15, cc = c & 31, ob = rr * 64 + cc * 2; return st * 1024 + (ob ^ (((ob >> 9) & 1) << 5)); }
__host__ __device__ __forceinline__ void stage_rc(int b, int& R, int& C) { const int st = b / 1024, sb = b % 1024, swz = sb ^ (((sb >> 9) & 1) << 5); R = (st >> 1) * 16 + swz / 64; C = (st & 1) * 32 + (swz % 64) / 2; }
__host__ __device__ __forceinline__ int perm32(int rho) { const int n = rho >> 4, i = rho & 15; return 8 * (i >> 2) + 4 * n + (i & 3); }

struct Unit { int pm, pn; };
struct Gemm { const bf16_t* A; const bf16_t* Bt; int M, N, K; int grp_tiles; size_t grp_stride; };

struct StaticOrder {
    int nM, nN, nwg, G, c;
    __host__ __device__ void init(int M, int N, int G_, int c_) { nM = M / BM; nN = N / BM; nwg = nM * nN; G = G_; c = c_; }
    __host__ __device__ bool next(int i, Unit& u) const {
        const long L = (long)i * G + c; if (L >= nwg) return false;
        int wgid = (int)L; { const int q = nwg / NXCD, r = nwg % NXCD, xcd = wgid % NXCD, off = wgid / NXCD; wgid = (xcd < r ? xcd * (q + 1) : r * (q + 1) + (xcd - r) * q) + off; }
        const int nig = WGM * nN, gid = wgid / nig, fm = gid * WGM, gsz = (nM - fm) < WGM ? (nM - fm) : WGM;
        u.pm = fm + ((wgid % nig) % gsz); u.pn = (wgid % nig) / gsz; return true;
    }
    __device__ __forceinline__ void a_ready(const Unit&) const {}
    __device__ __forceinline__ void done(const Unit&) const {}
};

__device__ __forceinline__ unsigned cvt_pk_bf16(float lo, float hi) { unsigned r; asm volatile("v_cvt_pk_bf16_f32 %0, %1, %2" : "=v"(r) : "v"(lo), "v"(hi)); return r; }

typedef unsigned u32x2 __attribute__((ext_vector_type(2)));
struct EpiF32 {
    static constexpr bool PERM = false, AFTER_DRAIN = false;
    float* C; int ldc; int ncols;
    __device__ __forceinline__ void operator()(const f32x4 (&acc)[2][2][4][2], const Unit& u, int wr, int wc, int fr, int fq) const {
        const int row0 = u.pm * BM + wr * 64 + fr, col0 = u.pn * BM + wc * 32 + 4 * fq;
#pragma unroll
        for (int ai = 0; ai < 2; ++ai)
#pragma unroll
            for (int m = 0; m < 4; ++m) { float* rowp = C + (size_t)(row0 + ai * HALF + m * 16) * ldc;
#pragma unroll
                for (int bj = 0; bj < 2; ++bj)
#pragma unroll
                    for (int n = 0; n < 2; ++n) { const int col = col0 + bj * HALF + n * 16; if (col < ncols) *(f32x4*)(rowp + col) = acc[ai][bj][m][n]; } }
    }
};
struct EpiRowScaleF32 {
    static constexpr bool PERM = false, AFTER_DRAIN = false;
    float* C; int ldc; const float* gate; int er;
    __device__ __forceinline__ void operator()(const f32x4 (&acc)[2][2][4][2], const Unit& u, int wr, int wc, int fr, int fq) const {
        const int row0 = u.pm * BM + wr * 64 + fr, col0 = u.pn * BM + wc * 32 + 4 * fq;
#pragma unroll
        for (int ai = 0; ai < 2; ++ai)
#pragma unroll
            for (int m = 0; m < 4; ++m) { const int row = row0 + ai * HALF + m * 16; float* rowp = C + (size_t)row * ldc; const float sc = gate[(row / er) * ER_MAX + row % er];
#pragma unroll
                for (int bj = 0; bj < 2; ++bj)
#pragma unroll
                    for (int n = 0; n < 2; ++n) *(f32x4*)(rowp + col0 + bj * HALF + n * 16) = acc[ai][bj][m][n] * sc; }
    }
};
struct EpiSwiGLU {
    static constexpr bool PERM = true, AFTER_DRAIN = false;
    bf16_t* O; int ldo;
    __device__ __forceinline__ void operator()(const f32x4 (&acc)[2][2][4][2], const Unit& u, int wr, int wc, int fr, int fq) const {
        const int row0 = u.pm * BM + wr * 64 + fr, col0 = u.pn * BM + wc * 32 + 8 * fq;
#pragma unroll
        for (int ai = 0; ai < 2; ++ai)
#pragma unroll
            for (int m = 0; m < 4; ++m) { bf16_t* rowp = O + (size_t)(row0 + ai * HALF + m * 16) * ldo;
#pragma unroll
                for (int bj = 0; bj < 2; ++bj) { const f32x4 gt = acc[ai][bj][m][0], up = acc[ai][bj][m][1]; f32x4 h;
#pragma unroll
                    for (int i = 0; i < 4; ++i) h[i] = gt[i] / (1.0f + __expf(-gt[i])) * up[i];
                    u32x2 w; w.x = cvt_pk_bf16(h[0], h[1]); w.y = cvt_pk_bf16(h[2], h[3]);
                    *(u32x2*)(rowp + (col0 + bj * HALF) / 2) = w; } }
    }
};

struct EpiBf16 {
    static constexpr bool PERM = true, AFTER_DRAIN = false;
    bf16_t* O; int ldo; int ncols;
    __device__ __forceinline__ void operator()(const f32x4 (&acc)[2][2][4][2], const Unit& u, int wr, int wc, int fr, int fq) const {
        const int row0 = u.pm * BM + wr * 64 + fr, col0 = u.pn * BM + wc * 32 + 8 * fq;
#pragma unroll
        for (int ai = 0; ai < 2; ++ai)
#pragma unroll
            for (int m = 0; m < 4; ++m) { bf16_t* rowp = O + (size_t)(row0 + ai * HALF + m * 16) * ldo;
#pragma unroll
                for (int bj = 0; bj < 2; ++bj) { const int col = col0 + bj * HALF; const f32x4 v0 = acc[ai][bj][m][0], v1 = acc[ai][bj][m][1];
                    u32x4 w; w.x = cvt_pk_bf16(v0[0], v0[1]); w.y = cvt_pk_bf16(v0[2], v0[3]); w.z = cvt_pk_bf16(v1[0], v1[1]); w.w = cvt_pk_bf16(v1[2], v1[3]);
                    if (col < ncols) *(u32x4*)(rowp + col) = w; } }
    }
};
struct EpiRowScaleBf16 {
    static constexpr bool PERM = true, AFTER_DRAIN = false;
    bf16_t* O; int ldo; const float* gate; int er;
    __device__ __forceinline__ void operator()(const f32x4 (&acc)[2][2][4][2], const Unit& u, int wr, int wc, int fr, int fq) const {
        const int row0 = u.pm * BM + wr * 64 + fr, col0 = u.pn * BM + wc * 32 + 8 * fq;
#pragma unroll
        for (int ai = 0; ai < 2; ++ai)
#pragma unroll
            for (int m = 0; m < 4; ++m) { const int row = row0 + ai * HALF + m * 16; bf16_t* rowp = O + (size_t)row * ldo; const float sc = gate[(row / er) * ER_MAX + row % er];
#pragma unroll
                for (int bj = 0; bj < 2; ++bj) { const f32x4 v0 = acc[ai][bj][m][0] * sc, v1 = acc[ai][bj][m][1] * sc;
                    u32x4 w; w.x = cvt_pk_bf16(v0[0], v0[1]); w.y = cvt_pk_bf16(v0[2], v0[3]); w.z = cvt_pk_bf16(v1[0], v1[1]); w.w = cvt_pk_bf16(v1[2], v1[3]);
                    *(u32x4*)(rowp + col0 + bj * HALF) = w; } }
    }
};
template <class Epi, class Sched, bool ALIGN_EPI = false, bool SP2 = false>
__device__ __forceinline__ void gemm_phase(PG8_LAS unsigned char* lds, const Gemm g, const Sched& S, const Epi& E) {
    int tid_ = threadIdx.x; asm volatile("" : "+v"(tid_));
    const int tid = tid_, wid = __builtin_amdgcn_readfirstlane(tid >> 6), lane = tid & 63, wr = wid >> 2, wc = wid & 3, fr = lane & 15, fq = lane >> 4;
    int K_ = g.K; asm volatile("" : "+s"(K_));
    const int K = K_, nt = K / BK;
    unsigned voffA[2], voffB[2];
#pragma unroll
    for (int i = 0; i < 2; ++i) { int R, C; stage_rc(tid * 16 + i * 8192, R, C); const int Rb = Epi::PERM ? ((R & ~31) + perm32(R & 31)) : R;
        voffA[i] = (unsigned)(R * K + C) * 2u; voffB[i] = (unsigned)(Rb * K + C) * 2u; }
    const size_t kstep = (size_t)(BK * 2);
    const size_t hstep = (size_t)HALF * K * 2;
    const size_t tstep = 2 * hstep;
    const unsigned ldsw = (unsigned)wid * 1024u;
    const int aoff = lds_byte(wr * 64 + fr, fq * 8), boff = lds_byte(wc * 32 + fr, fq * 8);
#define PG8_SA(b, h) (((b) * 2 + (h)) * HTB)
#define PG8_SB(b, h) ((4 + (b) * 2 + (h)) * HTB)
#define PG8_STAGE(bufoff, gbase, voff) do { _Pragma("unroll") for (int _i = 0; _i < 2; ++_i) \
        __builtin_amdgcn_global_load_lds((const unsigned*)((const char*)(gbase) + (voff)[_i]), (PG8_LAS unsigned*)(lds + (bufoff) + ldsw + _i * 8192), 16, 0, 0); } while (0)
#define PG8_LDA(dst, b, h) do { _Pragma("unroll") for (int m = 0; m < 4; ++m) _Pragma("unroll") for (int k = 0; k < 2; ++k) dst[m][k] = *(const PG8_LAS bf16x8*)(lds + PG8_SA(b, h) + aoff + m * 2048 + k * 1024); } while (0)
#define PG8_LDB(dst, b, h) do { _Pragma("unroll") for (int n = 0; n < 2; ++n) _Pragma("unroll") for (int k = 0; k < 2; ++k) dst[n][k] = *(const PG8_LAS bf16x8*)(lds + PG8_SB(b, h) + boff + n * 2048 + k * 1024); } while (0)
#define PG8_MMA(ai, bj, At, Bt) do { __builtin_amdgcn_s_setprio(1); _Pragma("unroll") for (int m = 0; m < 4; ++m) _Pragma("unroll") for (int n = 0; n < 2; ++n) _Pragma("unroll") for (int k = 0; k < 2; ++k) \
        acc[ai][bj][m][n] = __builtin_amdgcn_mfma_f32_16x16x32_bf16(Bt[n][k], At[m][k], acc[ai][bj][m][n], 0, 0, 0); __builtin_amdgcn_s_setprio(0); } while (0)
#define PG8_WAIT_V(n) asm volatile("s_waitcnt vmcnt(" #n ")" ::: "memory")
#define PG8_WAIT_L(n) asm volatile("s_waitcnt lgkmcnt(" #n ")" ::: "memory")
#define PG8_BAR __builtin_amdgcn_s_barrier()
#define PG8_SCHED __builtin_amdgcn_sched_barrier(0)
    Unit cur, nxt; int ui = 0;
    if (!S.next(0, cur)) return;
    f32x4 acc[2][2][4][2];
#pragma unroll
    for (int a = 0; a < 2; ++a)
#pragma unroll
        for (int b = 0; b < 2; ++b)
#pragma unroll
            for (int m = 0; m < 4; ++m)
#pragma unroll
                for (int n = 0; n < 2; ++n) acc[a][b][m][n] = (f32x4){0.f, 0.f, 0.f, 0.f};
    bf16x8 At[4][2], B0[2][2], B1[2][2];
    const char* cA = (const char*)g.A + (size_t)cur.pm * tstep; const char* cB = (const char*)g.Bt + (size_t)cur.pn * tstep + (g.grp_tiles ? (size_t)(cur.pm / g.grp_tiles) * g.grp_stride : (size_t)0);
    S.a_ready(cur);
    if constexpr (SP2) {
        PG8_STAGE(PG8_SB(0, 0), cB, voffB); PG8_STAGE(PG8_SB(0, 1), cB + hstep, voffB); PG8_STAGE(PG8_SA(0, 0), cA, voffA); PG8_STAGE(PG8_SA(0, 1), cA + hstep, voffA);
        if (wr == 1) PG8_BAR;
        PG8_WAIT_V(2); PG8_BAR;
        PG8_STAGE(PG8_SB(1, 0), cB + kstep, voffB); PG8_STAGE(PG8_SA(1, 0), cA + kstep, voffA); PG8_STAGE(PG8_SB(1, 1), cB + hstep + kstep, voffB);
        PG8_WAIT_V(6); PG8_BAR;
    } else {
        PG8_STAGE(PG8_SB(0, 0), cB, voffB); PG8_STAGE(PG8_SA(0, 0), cA, voffA); PG8_STAGE(PG8_SB(0, 1), cB + hstep, voffB); PG8_STAGE(PG8_SA(0, 1), cA + hstep, voffA);
        if (wr == 1) PG8_BAR;
        PG8_WAIT_V(4); PG8_BAR;
        PG8_STAGE(PG8_SB(1, 0), cB + kstep, voffB); PG8_STAGE(PG8_SA(1, 0), cA + kstep, voffA); PG8_STAGE(PG8_SB(1, 1), cB + hstep + kstep, voffB);
        PG8_WAIT_V(6); PG8_BAR;
    }
    for (;;) {
        const bool has_next = S.next(ui + 1, nxt);
        const char* nA = has_next ? (const char*)g.A + (size_t)nxt.pm * tstep : cA; const char* nB = has_next ? (const char*)g.Bt + (size_t)nxt.pn * tstep + (g.grp_tiles ? (size_t)(nxt.pm / g.grp_tiles) * g.grp_stride : (size_t)0) : cB;
        for (int t = 0; t < nt; t += 2) {
            const bool last = (t == nt - 2);
            const char* a1 = cA + (size_t)(t + 1) * kstep;
            const char* a2 = last ? nA : cA + (size_t)(t + 2) * kstep; const char* b2 = last ? nB : cB + (size_t)(t + 2) * kstep;
            const char* a3 = a2 + kstep; const char* b3 = b2 + kstep;
            if (last && has_next) S.a_ready(nxt);
            if constexpr (SP2) {
            PG8_LDB(B0, 0, 0); PG8_LDB(B1, 0, 1); PG8_SCHED; PG8_LDA(At, 0, 0); PG8_STAGE(PG8_SA(1, 1), a1 + hstep, voffA);
            PG8_WAIT_V(8); PG8_WAIT_L(0); PG8_BAR; PG8_MMA(0, 0, At, B0); PG8_MMA(0, 1, At, B1); PG8_BAR; PG8_SCHED;
            PG8_LDA(At, 0, 1); PG8_STAGE(PG8_SB(0, 0), b2, voffB); PG8_STAGE(PG8_SB(0, 1), b2 + hstep, voffB); PG8_STAGE(PG8_SA(0, 0), a2, voffA);
            PG8_WAIT_V(8); PG8_WAIT_L(0); PG8_BAR; PG8_MMA(1, 0, At, B0); PG8_MMA(1, 1, At, B1); PG8_BAR; PG8_SCHED;
            PG8_LDB(B0, 1, 0); PG8_LDB(B1, 1, 1); PG8_SCHED; PG8_LDA(At, 1, 0); PG8_STAGE(PG8_SA(0, 1), a2 + hstep, voffA);
            PG8_WAIT_V(8); PG8_WAIT_L(0); PG8_BAR; PG8_MMA(0, 0, At, B0); PG8_MMA(0, 1, At, B1); PG8_BAR; PG8_SCHED;
            PG8_LDA(At, 1, 1); PG8_STAGE(PG8_SB(1, 0), b3, voffB); PG8_STAGE(PG8_SB(1, 1), b3 + hstep, voffB); PG8_STAGE(PG8_SA(1, 0), a3, voffA);
            PG8_WAIT_V(8); PG8_WAIT_L(0); PG8_BAR; PG8_MMA(1, 0, At, B0); PG8_MMA(1, 1, At, B1); PG8_BAR; PG8_SCHED;
            } else {
            PG8_LDB(B0, 0, 0); PG8_SCHED; PG8_LDA(At, 0, 0); PG8_STAGE(PG8_SA(1, 1), a1 + hstep, voffA);
            PG8_WAIT_L(8); PG8_BAR; PG8_WAIT_L(0); PG8_MMA(0, 0, At, B0); PG8_BAR; PG8_SCHED;
            PG8_LDB(B1, 0, 1); PG8_STAGE(PG8_SB(0, 0), b2, voffB);
            PG8_BAR; PG8_WAIT_L(0); PG8_MMA(0, 1, At, B1); PG8_BAR;
            PG8_LDA(At, 0, 1); PG8_STAGE(PG8_SA(0, 0), a2, voffA);
            PG8_BAR; PG8_WAIT_L(0); PG8_MMA(1, 0, At, B0); PG8_BAR; PG8_SCHED;
            PG8_STAGE(PG8_SB(0, 1), b2 + hstep, voffB);
            PG8_WAIT_V(6); PG8_BAR; PG8_MMA(1, 1, At, B1); PG8_BAR;
            PG8_LDB(B0, 1, 0); PG8_SCHED; PG8_LDA(At, 1, 0); PG8_STAGE(PG8_SA(0, 1), a2 + hstep, voffA);
            PG8_WAIT_L(8); PG8_BAR; PG8_WAIT_L(0); PG8_MMA(0, 0, At, B0); PG8_BAR; PG8_SCHED;
            PG8_LDB(B1, 1, 1); PG8_STAGE(PG8_SB(1, 0), b3, voffB);
            PG8_BAR; PG8_WAIT_L(0); PG8_MMA(0, 1, At, B1); PG8_BAR;
            PG8_LDA(At, 1, 1); PG8_STAGE(PG8_SA(1, 0), a3, voffA);
            PG8_BAR; PG8_WAIT_L(0); PG8_MMA(1, 0, At, B0); PG8_BAR; PG8_SCHED;
            PG8_STAGE(PG8_SB(1, 1), b3 + hstep, voffB);
            PG8_WAIT_V(6); PG8_BAR; PG8_MMA(1, 1, At, B1); PG8_BAR;
            }
        }
        if constexpr (ALIGN_EPI) { if (wr == 0) PG8_BAR; }
        if constexpr (!Epi::AFTER_DRAIN) { E(acc, cur, wr, wc, fr, fq); S.done(cur); }
        if (!has_next) break;
#pragma unroll
        for (int a = 0; a < 2; ++a)
#pragma unroll
            for (int b = 0; b < 2; ++b)
#pragma unroll
                for (int m = 0; m < 4; ++m)
#pragma unroll
                    for (int n = 0; n < 2; ++n) acc[a][b][m][n] = (f32x4){0.f, 0.f, 0.f, 0.f};
        cur = nxt; cA = nA; cB = nB; ++ui;
        if constexpr (ALIGN_EPI) { if (wr == 1) PG8_BAR; }
    }
    PG8_WAIT_V(0);
    if constexpr (!ALIGN_EPI) { if (wr == 0) PG8_BAR; }
    PG8_BAR;
    if constexpr (Epi::AFTER_DRAIN) { E.fused(acc, cur, wr, wc, fr, fq, lds, wid, lane); S.done(cur); }
#undef PG8_SA
#undef PG8_SB
#undef PG8_STAGE
#undef PG8_LDA
#undef PG8_LDB
#undef PG8_MMA
#undef PG8_WAIT_V
#undef PG8_WAIT_L
#undef PG8_BAR
#undef PG8_SCHED
}
}


#define XB_TMO      128
#define XB_XCNT(j)  (256  + 64 * (j))
#define XB_XSUB(j)  (1280 + 64 * (j))
#define XB_XGEN(j)  (2304 + 64 * (j))
#define XB_TOP      3328
#define XB_TOPGEN   3392
#define XCD_BAR_WORDS 3456
#define XB_SPIN_CAP (1u << 22)
__device__ __forceinline__ unsigned xb_ld(unsigned* p)              { return __hip_atomic_load(p, __ATOMIC_RELAXED, __HIP_MEMORY_SCOPE_AGENT); }
__device__ __forceinline__ unsigned xb_add(unsigned* p, unsigned v) { return __hip_atomic_fetch_add(p, v, __ATOMIC_RELAXED, __HIP_MEMORY_SCOPE_AGENT); }
__device__ __forceinline__ unsigned xb_xcc_id() { return (unsigned)__builtin_amdgcn_s_getreg((3 << 11) | 20) & 0xFu; }
#define XB_SPIN(cond, bar) do { unsigned _sp = 0; while (cond) { __builtin_amdgcn_s_sleep(1); \
    if ((++_sp & 255u) == 0u) { if (xb_ld(&(bar)[XB_TMO])) break; if (_sp > XB_SPIN_CAP) { atomicAdd(&(bar)[XB_TMO], 1u); break; } } } } while (0)
struct XcdBarrier { unsigned* bar; unsigned x; volatile LAS unsigned* st; };
__device__ __forceinline__ XcdBarrier xcd_barrier_post(unsigned* bar, volatile LAS unsigned* st) {
    XcdBarrier b; b.bar = bar; b.x = xb_xcc_id(); b.st = st;
    if (threadIdx.x == 0) (void)xb_add(&bar[XB_XCNT(b.x)], 1u);
    return b;
}
__device__ __forceinline__ void xcd_barrier_complete(unsigned* bar, unsigned x, unsigned& nloc, unsigned& nx) {
    const unsigned G = gridDim.x * gridDim.y * gridDim.z;
    unsigned sum, cnt, mine, sp = 0u;
    for (;;) {
        sum = 0u; cnt = 0u; mine = 0u;
#pragma unroll
        for (unsigned j = 0; j < 16; ++j) { const unsigned c = xb_ld(&bar[XB_XCNT(j)]); sum += c; cnt += (c > 0u) ? 1u : 0u; mine = (j == x) ? c : mine; }
        if (sum == G) break;
        __builtin_amdgcn_s_sleep(1);
        if ((++sp & 255u) == 0u) { if (xb_ld(&bar[XB_TMO])) break; if (sp > XB_SPIN_CAP) { atomicAdd(&bar[XB_TMO], 1u); break; } }
    }
    nloc = mine > 0u ? mine : 1u; nx = cnt > 0u ? cnt : 1u;
}
__device__ __forceinline__ void xcd_barrier(const XcdBarrier& b) {
    asm volatile("s_waitcnt vmcnt(0)" ::: "memory");
    __syncthreads();
    if (threadIdx.x == 0) {
        unsigned* bar = b.bar;
        __builtin_amdgcn_s_waitcnt(0);
        unsigned nloc = b.st[0], nx = b.st[1];
        if (nloc == 0u) { xcd_barrier_complete(bar, b.x, nloc, nx); b.st[0] = nloc; b.st[1] = nx; }
        const unsigned old = xb_add(&bar[XB_XSUB(b.x)], 1u);
        const unsigned gen = old / nloc;
        if (old + 1u == (gen + 1u) * nloc) {
            __builtin_amdgcn_fence(__ATOMIC_RELEASE, "agent");
            asm volatile("s_waitcnt vmcnt(0)" ::: "memory");
            const unsigned og = xb_add(&bar[XB_TOP], 1u);
            const unsigned tg = og / nx;
            if (og + 1u == (tg + 1u) * nx) xb_add(&bar[XB_TOPGEN], 1u);
            else XB_SPIN(xb_ld(&bar[XB_TOPGEN]) == tg, bar);
            __builtin_amdgcn_fence(__ATOMIC_ACQUIRE, "agent");
            xb_add(&bar[XB_XGEN(b.x)], 1u);
            asm volatile("s_waitcnt vmcnt(0)" ::: "memory");
        } else {
            XB_SPIN(xb_ld(&bar[XB_XGEN(b.x)]) == gen, bar);
            __builtin_amdgcn_fence(__ATOMIC_ACQUIRE, "agent");
            asm volatile("s_waitcnt vmcnt(0)" ::: "memory");
        }
    }
    __syncthreads();
}


typedef short bf16x8 __attribute__((ext_vector_type(8)));
typedef short s16x4 __attribute__((ext_vector_type(4)));
typedef float f32x16 __attribute__((ext_vector_type(16)));
typedef unsigned v4u __attribute__((ext_vector_type(4)));
typedef unsigned v2u __attribute__((ext_vector_type(2)));
constexpr float ATT_THR = 5.0f;
template <int DK> struct AttL { static constexpr int KSTR = DK * 2 + 16, KBYTES = 64 * KSTR, VSTR = 136, VBYTES = 64 * VSTR, KCH = 64 * DK / 8, KPT = (KCH + NTHREADS - 1) / NTHREADS;
    static constexpr int K_OFF = 0, V_OFF = 2 * KBYTES; };

template <int DK>
__device__ __forceinline__ void attn_pass(const bf16_t* Qrow, const bf16_t* Kp, const bf16_t* Vtp, int vt_ld, int nkt, LAS unsigned char* lds, int tid, f32x16 (&oacc)[2], float& l_run) {
    typedef AttL<DK> L;
    constexpr bool AUG = DK <= 32;
    const int lane = tid & 63, r = lane & 31, h = lane >> 5;
    bf16x8 qf[DK / 16];
#pragma unroll
    for (int ks = 0; ks < DK / 16; ++ks) qf[ks] = *(const bf16x8*)(Qrow + 16 * ks + 8 * h);
    const short z_ = (short)(tid >> 20);
    bf16x8 aone = {z_, z_, z_, z_, z_, z_, z_, z_}, bneg = {z_, z_, z_, z_, z_, z_, z_, z_};
    if (h == 0) aone[0] = (short)0x3F80;
    float m_run = 0.f;
    v4u kreg[L::KPT]; v4u vreg;
    const int vd = tid >> 3, vpart = tid & 7;
#define ATT_LOADK(j) do { _Pragma("unroll") for (int i_ = 0; i_ < L::KPT; ++i_) { const int c_ = tid + i_ * NTHREADS; if (c_ < L::KCH) kreg[i_] = *(const v4u*)(Kp + (size_t)(j) * 64 * DK + c_ * 8); } } while (0)
#define ATT_LOADV(j) do { vreg = *(const v4u*)(Vtp + (size_t)vd * vt_ld + (j) * 64 + vpart * 8); } while (0)
#define ATT_STOREK(buf) do { _Pragma("unroll") for (int i_ = 0; i_ < L::KPT; ++i_) { const int c_ = tid + i_ * NTHREADS; if (c_ < L::KCH) { const int key_ = c_ / (DK / 8), part_ = c_ % (DK / 8); \
            *(LAS v4u*)(lds + L::K_OFF + (buf) * L::KBYTES + key_ * L::KSTR + part_ * 16) = kreg[i_]; } } } while (0)
#define ATT_STOREV(buf) do { LAS unsigned char* vp_ = lds + L::V_OFF + (buf) * L::VBYTES + vd * L::VSTR + vpart * 16; *(LAS v2u*)vp_ = (v2u){vreg.x, vreg.y}; *(LAS v2u*)(vp_ + 8) = (v2u){vreg.z, vreg.w}; } while (0)
#define ATT_QK(dst, buf) do { _Pragma("unroll") for (int kb = 0; kb < 2; ++kb) { _Pragma("unroll") for (int i = 0; i < 16; ++i) dst[kb][i] = 0.f; \
        if (AUG) dst[kb] = __builtin_amdgcn_mfma_f32_32x32x16_bf16(aone, bneg, dst[kb], 0, 0, 0); \
        _Pragma("unroll") for (int ks = 0; ks < DK / 16; ++ks) { const bf16x8 a_ = *(const LAS bf16x8*)(lds + L::K_OFF + (buf) * L::KBYTES + (32 * kb + r) * L::KSTR + (16 * ks + 8 * h) * 2); \
            dst[kb] = __builtin_amdgcn_mfma_f32_32x32x16_bf16(a_, qf[ks], dst[kb], 0, 0, 0); } } } while (0)
#define ATT_BODY(SC, SN, j) do { \
        if ((j) + 2 < nkt) ATT_LOADK((j) + 2); \
        if ((j) + 1 < nkt) { ATT_LOADV((j) + 1); ATT_QK(SN, ((j) + 1) & 1); } \
        if (((j) & 3) == 0) { \
            float t0 = fmaxf(fmaxf(SC[0][0], SC[0][1]), SC[0][2]), t1 = fmaxf(fmaxf(SC[0][3], SC[0][4]), SC[0][5]), t2 = fmaxf(fmaxf(SC[0][6], SC[0][7]), SC[0][8]), t3 = fmaxf(fmaxf(SC[0][9], SC[0][10]), SC[0][11]); \
            float t4 = fmaxf(fmaxf(SC[0][12], SC[0][13]), SC[0][14]), t5 = fmaxf(fmaxf(SC[0][15], SC[1][0]), SC[1][1]), t6 = fmaxf(fmaxf(SC[1][2], SC[1][3]), SC[1][4]), t7 = fmaxf(fmaxf(SC[1][5], SC[1][6]), SC[1][7]); \
            float t8 = fmaxf(fmaxf(SC[1][8], SC[1][9]), SC[1][10]), t9 = fmaxf(fmaxf(SC[1][11], SC[1][12]), SC[1][13]), t10 = fmaxf(SC[1][14], SC[1][15]); \
            float tmax = fmaxf(fmaxf(fmaxf(fmaxf(t0, t1), t2), fmaxf(fmaxf(t3, t4), t5)), fmaxf(fmaxf(fmaxf(t6, t7), t8), fmaxf(t9, t10))); \
            tmax = xor32_max(tmax); if (!AUG) tmax -= m_run;            \
            if ((j) == 0 || __any(tmax > ATT_THR)) {                   \
                const float want = (j) == 0 ? tmax : m_run + fmaxf(tmax, 0.f); \
                const float mn = __uint_as_float(pk2(want, 0.f) << 16), dlt = mn - m_run, alpha = __builtin_amdgcn_exp2f(-dlt); \
                _Pragma("unroll") for (int i = 0; i < 16; ++i) { oacc[0][i] *= alpha; oacc[1][i] *= alpha; if (AUG) { SC[0][i] -= dlt; SC[1][i] -= dlt; SN[0][i] -= dlt; SN[1][i] -= dlt; } } \
                l_run *= alpha; m_run = mn; if (AUG && h == 0) bneg[0] = (short)(__float_as_uint(-mn) >> 16); \
            } \
        } \
        float ps0 = 0.f, ps1 = 0.f, ps2 = 0.f, ps3 = 0.f; \
        _Pragma("unroll") for (int kb = 0; kb < 2; ++kb) \
            _Pragma("unroll") for (int i = 0; i < 16; i += 4) { const float mo = AUG ? 0.f : m_run; const float p0 = __builtin_amdgcn_exp2f(SC[kb][i] - mo), p1 = __builtin_amdgcn_exp2f(SC[kb][i + 1] - mo), p2 = __builtin_amdgcn_exp2f(SC[kb][i + 2] - mo), p3 = __builtin_amdgcn_exp2f(SC[kb][i + 3] - mo); \
                SC[kb][i] = p0; SC[kb][i + 1] = p1; SC[kb][i + 2] = p2; SC[kb][i + 3] = p3; ps0 += p0; ps1 += p1; ps2 += p2; ps3 += p3; } \
        l_run += (ps0 + ps1) + (ps2 + ps3); \
        _Pragma("unroll") for (int kb = 0; kb < 2; ++kb) \
            _Pragma("unroll") for (int s2 = 0; s2 < 2; ++s2) { \
                union { bf16x8 v; unsigned u[4]; } pf; \
                _Pragma("unroll") for (int i = 0; i < 4; ++i) pf.u[i] = pk2(SC[kb][8 * s2 + 2 * i], SC[kb][8 * s2 + 2 * i + 1]); \
                _Pragma("unroll") for (int db = 0; db < 2; ++db) { \
                    const LAS unsigned char* vp = lds + L::V_OFF + ((j) & 1) * L::VBYTES + (32 * db + r) * L::VSTR + (32 * kb + 16 * s2 + 4 * h) * 2; \
                    union { bf16x8 v; v2u u[2]; } af; af.u[0] = *(const LAS v2u*)vp; af.u[1] = *(const LAS v2u*)(vp + 16); \
                    oacc[db] = __builtin_amdgcn_mfma_f32_32x32x16_bf16(af.v, pf.v, oacc[db], 0, 0, 0); } } \
        if ((j) + 2 < nkt) ATT_STOREK((j) & 1);               \
        if ((j) + 1 < nkt) ATT_STOREV(((j) + 1) & 1);         \
        __syncthreads(); \
    } while (0)
    __syncthreads();
    ATT_LOADK(0); ATT_LOADV(0); ATT_STOREK(0); ATT_STOREV(0);
    if (nkt > 1) { ATT_LOADK(1); ATT_STOREK(1); }
    __syncthreads();
    f32x16 sa[2], sb[2];
#pragma unroll
    for (int i = 0; i < 16; ++i) { sb[0][i] = (float)z_; sb[1][i] = (float)z_; }
    ATT_QK(sa, 0);
    for (int j = 0; j < nkt; j += 2) {
        ATT_BODY(sa, sb, j);
        if (j + 1 < nkt) ATT_BODY(sb, sa, j + 1);
    }
#undef ATT_BODY
#undef ATT_LOADK
#undef ATT_LOADV
#undef ATT_STOREK
#undef ATT_STOREV
#undef ATT_QK
}


constexpr int SLD = 65;
__device__ __forceinline__ int rm32(int t, int h) { return (t & 3) + 8 * (t >> 2) + 4 * h; }
template <bool WITH_Y>
__device__ __forceinline__ void ssd_block(int b, int dir, int k, int hp, const bf16_t* xbc, const float* dtp, const float* alog, float* hs, float* alast, bf16_t* yd, float* lds, int tid) {
    const bool lat = k >= 2; const int c = lat ? (dir ? 33 - k : k - 2) : (dir ? 1 - k : k);
    const int row0 = tok_row(lat, b, c * 128), g = hp >> 1;
    float* sB = lds; float* sC = sB + 128 * SLD; float* sX = sC + 128 * SLD; float* sDT = sX + 128 * 128; float* sCum = sDT + 256; float* sW = sCum + 256; float* sSc = sW + 256;
    const int wave = tid >> 6, lane = tid & 63, r = lane & 31, h = lane >> 5, hl = wave >> 2, head = 2 * hp + hl;
    float* hsp = hs + (((size_t)(b * 2 + dir) * NCH + k) * 8 + head) * 4096;
    float hreg[WITH_Y ? 64 : 1];
    if (WITH_Y) {
#pragma unroll
        for (int Pb = 0; Pb < 2; ++Pb)
#pragma unroll
            for (int ks = 0; ks < 32; ++ks) hreg[Pb * 32 + ks] = hsp[(2 * ks + h) * 64 + 32 * Pb + r];
    }
    float4 vb[8], vx[8]; float dx[8]; float dtv = 0.f, dav = 0.f;
#pragma unroll
    for (int u = 0; u < 8; ++u) { const int i = tid + u * NTHREADS, t = i >> 5, c4 = i & 31;
        vb[u] = ld4h(xbc + (size_t)(row0 + t) * 768 + 512 + (c4 >> 4) * 128 + g * 64 + (c4 & 15) * 4);
        vx[u] = ld4h(xbc + (size_t)(row0 + t) * 768 + hp * 128 + c4 * 4);
        dx[u] = dtp[(size_t)(row0 + t) * 16 + dir * 8 + 2 * hp + (c4 >> 4)]; }
    if (tid < 256) { const int hl = tid >> 7, t = tid & 127, h = 2 * hp + hl; dtv = dtp[(size_t)(row0 + t) * 16 + dir * 8 + h]; dav = dtv * -expf(alog[dir * 8 + h]); }
    __syncthreads();
#pragma unroll
    for (int u = 0; u < 8; ++u) { const int i = tid + u * NTHREADS, t = i >> 5, c4 = i & 31;
        float* d = (c4 >> 4 ? sC : sB) + t * SLD + (c4 & 15) * 4; d[0] = vb[u].x; d[1] = vb[u].y; d[2] = vb[u].z; d[3] = vb[u].w;
        *(float4*)(sX + t * 128 + c4 * 4) = f4scale(vx[u], dx[u]); }
    if (tid < 256) { const int t = tid & 127; sSc[(tid & 128) + (dir ? 127 - t : t)] = dav; }
    __syncthreads();
    for (int off = 1; off < 128; off <<= 1) { float v = 0.f; const int sI = tid & 127;
        if (tid < 256) { v = sSc[tid]; if (sI >= off) v += sSc[tid - off]; }
        __syncthreads(); if (tid < 256) sSc[tid] = v; __syncthreads(); }
    if (tid < 256) { const int hl = tid >> 7, sI = tid & 127, t = dir ? 127 - sI : sI; const float cu = sSc[tid], tot = sSc[hl * 128 + 127];
        sCum[hl * 128 + t] = cu; sW[hl * 128 + t] = expf(tot - cu);
        if (!WITH_Y && sI == 127) alast[((size_t)(b * 2 + dir) * NCH + k) * 8 + 2 * hp + hl] = tot; }
    __syncthreads();
    if (WITH_Y) {
        const int I = hl ? 3 - (wave & 3) : (wave & 3), ti = 32 * I + r;
        const float cum_i = sCum[hl * 128 + ti];
        f32x16 Y[2], Yo[2];
#pragma unroll
        for (int i = 0; i < 16; ++i) { Y[0][i] = 0.f; Y[1][i] = 0.f; Yo[0][i] = 0.f; Yo[1][i] = 0.f; }
#pragma unroll
        for (int Pb = 0; Pb < 2; ++Pb)
#pragma unroll
            for (int ks = 0; ks < 32; ++ks) Yo[Pb] = __builtin_amdgcn_mfma_f32_32x32x2f32(hreg[Pb * 32 + ks], sC[(32 * I + r) * SLD + 2 * ks + h], Yo[Pb], 0, 0, 0);
        const int J0 = dir ? I : 0, J1 = dir ? 3 : I;
        for (int J = J0; J <= J1; ++J) {
            f32x16 Gt;
#pragma unroll
            for (int i = 0; i < 16; ++i) Gt[i] = 0.f;
#pragma unroll 8
            for (int ks = 0; ks < 32; ++ks) Gt = __builtin_amdgcn_mfma_f32_32x32x2f32(sB[(32 * J + r) * SLD + 2 * ks + h], sC[(32 * I + r) * SLD + 2 * ks + h], Gt, 0, 0, 0);
#pragma unroll
            for (int t = 0; t < 16; ++t) { const int tj = 32 * J + rm32(t, h); const bool valid = (J != I) || (dir ? tj >= ti : tj <= ti);
                Gt[t] *= valid ? __expf(cum_i - sCum[hl * 128 + tj]) : 0.f; }
#pragma unroll
            for (int Pb = 0; Pb < 2; ++Pb)
#pragma unroll
                for (int t = 0; t < 16; ++t) Y[Pb] = __builtin_amdgcn_mfma_f32_32x32x2f32(sX[(32 * J + rm32(t, h)) * 128 + hl * 64 + 32 * Pb + r], Gt[t], Y[Pb], 0, 0, 0);
        }
        const float ei = __expf(cum_i);
        bf16_t* yrow = yd + ((size_t)dir * NTOK + row0 + ti) * 512 + head * 64;
#pragma unroll
        for (int Pb = 0; Pb < 2; ++Pb)
#pragma unroll
            for (int tq = 0; tq < 4; ++tq)
                *(uint2*)(yrow + 32 * Pb + 8 * tq + 4 * h) = pk4(make_float4(Y[Pb][4 * tq] + ei * Yo[Pb][4 * tq], Y[Pb][4 * tq + 1] + ei * Yo[Pb][4 * tq + 1], Y[Pb][4 * tq + 2] + ei * Yo[Pb][4 * tq + 2], Y[Pb][4 * tq + 3] + ei * Yo[Pb][4 * tq + 3]));
    } else {
        const int Nb = (wave >> 1) & 1, Pb = wave & 1;
        f32x16 acc;
#pragma unroll
        for (int i = 0; i < 16; ++i) acc[i] = 0.f;
#pragma unroll 8
        for (int ks = 0; ks < 64; ++ks) { const int j = 2 * ks + h;
            acc = __builtin_amdgcn_mfma_f32_32x32x2f32(sB[j * SLD + 32 * Nb + r] * sW[hl * 128 + j], sX[j * 128 + hl * 64 + 32 * Pb + r], acc, 0, 0, 0); }
#pragma unroll
        for (int t = 0; t < 16; ++t) hsp[(32 * Nb + rm32(t, h)) * 64 + 32 * Pb + r] = acc[t];
    }
}

template <class RM>
__device__ __forceinline__ void cvt_tile(const float* src, int N, bf16_t* dst, int ldd, RM rowmap, int k0, int n0, int lane) {
    const int n = n0 + lane;
    if (n < N) {
        const float* sp = src + (size_t)k0 * N + n;
        float v[32];
#pragma unroll
        for (int kk = 0; kk < 32; ++kk) v[kk] = sp[(size_t)kk * N];
        uint4* dp = (uint4*)(dst + (size_t)rowmap(n) * ldd + k0);
#pragma unroll
        for (int i = 0; i < 4; ++i) dp[i] = make_uint4(pk2(v[8 * i], v[8 * i + 1]), pk2(v[8 * i + 2], v[8 * i + 3]), pk2(v[8 * i + 4], v[8 * i + 5]), pk2(v[8 * i + 6], v[8 * i + 7]));
    }
}
__device__ __forceinline__ int block_excl_scan(int v, int tid, volatile int* sh, int& total) {
    const int lane = tid & 63, wave = tid >> 6; int x = v;
#pragma unroll
    for (int o = 1; o < 64; o <<= 1) { const int y = __shfl_up(x, o); if (lane >= o) x += y; }
    __syncthreads();
    if (lane == 63) sh[wave] = x;
    __syncthreads();
    int off = 0, tot = 0;
#pragma unroll
    for (int w = 0; w < 8; ++w) { const int c = sh[w]; tot += c; if (w < wave) off += c; }
    total = tot;
    return off + x - v;
}
__device__ __forceinline__ int block_sum(int v, int tid, volatile int* sh, int parity) {
    const int lane = tid & 63, wave = tid >> 6;
#pragma unroll
    for (int o = 32; o > 0; o >>= 1) v += __shfl_xor(v, o);
    if (lane == 0) sh[parity * 8 + wave] = v;
    __syncthreads();
    int tot = 0;
#pragma unroll
    for (int w = 0; w < 8; ++w) tot += sh[parity * 8 + w];
    return tot;
}

#define MOD ((float*)(kp_->ws + WS_MOD))
#define CTXC ((float*)(kp_->ws + WS_CTXC))
#define AFF ((float*)(kp_->ws + WS_AFF))
#define TOKSLOT ((int*)(kp_->ws + WS_TOKSLOT))
#define SELIDX ((int*)(kp_->ws + WS_SELIDX))
#define SELGATE ((float*)(kp_->ws + WS_SELGATE))
#define DT ((float*)(kp_->ws + WS_DT))
#define HB ((bf16_t*)(kp_->ws + WS_HB))
#define HS ((float*)(kp_->ws + WS_HS))
#define YD ((bf16_t*)(kp_->ws + WS_YD))
#define ALAST ((float*)(kp_->ws + WS_ALAST))
#define ROPE ((float*)(kp_->ws + WS_ROPE))
#define PB ((bf16_t*)(kp_->ws + WS_P))
#define XBC ((bf16_t*)(kp_->ws + WS_XBC))
#define MQ ((bf16_t*)(kp_->ws + WS_MQ))
#define MKV ((bf16_t*)(kp_->ws + WS_MKV))
#define CQB ((bf16_t*)(kp_->ws + WS_CQB))
#define CKVB ((bf16_t*)(kp_->ws + WS_CKVB))
#define MIXB ((bf16_t*)(kp_->ws + WS_MIXB))
#define MOUT ((bf16_t*)(kp_->ws + WS_MOUT))
#define XG ((bf16_t*)(kp_->ws + WS_XG))
#define HID ((bf16_t*)(kp_->ws + WS_HID))
#define Y ((bf16_t*)(kp_->ws + WS_Y))
#define WIN_T ((bf16_t*)(kp_->ws + WS_WIN))
#define WQ_T ((bf16_t*)(kp_->ws + WS_WQ))
#define WKV_T ((bf16_t*)(kp_->ws + WS_WKV))
#define WOUT_T ((bf16_t*)(kp_->ws + WS_WOUT))
#define WGU_T ((bf16_t*)(kp_->ws + WS_WGU))
#define WD_T ((bf16_t*)(kp_->ws + WS_WD))
#define QD ((bf16_t*)(kp_->ws + WS_QD))
#define QDC ((bf16_t*)(kp_->ws + WS_QDC))
#define KD ((bf16_t*)(kp_->ws + WS_KD))
#define VDT ((bf16_t*)(kp_->ws + WS_VDT))
#define QM ((bf16_t*)(kp_->ws + WS_QM))
#define QMC ((bf16_t*)(kp_->ws + WS_QMC))
#define KM ((bf16_t*)(kp_->ws + WS_KM))
#define VMT ((bf16_t*)(kp_->ws + WS_VMT))
#define xcur (kp_->out)
#define XSRC (l == 0 ? kp_->in[I_X] : (const float*)kp_->out)
#define CSRC (l == 0 ? kp_->in[I_CTX] : (const float*)CTXC)
#define DTMP XBC
#define modl (MOD + (size_t)l * (NB + 1) * NMOD * D)
typedef const __attribute__((address_space(4))) Prm* KPrm;
#define PHASE_BEGIN() KPrm kp_ = (KPrm)__builtin_amdgcn_kernarg_segment_ptr(); asm volatile("" : "+s"(kp_)); int tid = threadIdx.x; asm volatile("" : "+v"(tid)); (void)tid
#define GSYNC() do { XcdBarrier b_; b_.bar = (unsigned*)(kp_->ws + WS_CTL); b_.x = xb_xcc_id(); b_.st = (volatile LAS unsigned*)(ldsb + LDS_BYTES - 64); xcd_barrier(b_); } while (0)
__global__ void __launch_bounds__(NTHREADS, 2) mk_forward(Prm p) {
    extern __shared__ __attribute__((aligned(16))) unsigned char lds_raw[];
    LAS unsigned char* const ldsb = (LAS unsigned char*)lds_raw;
    volatile LAS unsigned* st = (volatile LAS unsigned*)(ldsb + LDS_BYTES - 64);
    if (threadIdx.x < 16) st[threadIdx.x] = 0u;
    __syncthreads();
    (void)xcd_barrier_post((unsigned*)(p.ws + WS_CTL), st);
    const int G = gridDim.x, bid = blockIdx.x;
    const int vcu = (G % 8 == 0) ? (bid % 8) * (G / 8) + bid / 8 : bid;

    {
        PHASE_BEGIN();
        const float* c = kp_->in[I_C]; const float* cc = kp_->in[I_CCTX]; const float* adaw = kp_->in[I_ADAW]; const float* adab = kp_->in[I_ADAB];
        float* sc_l = (float*)lds_raw;
        for (int i = tid; i < (NB + 1) * D; i += NTHREADS) { const int r = i / D, k = i % D; sc_l[i] = siluf(r < NB ? c[(size_t)r * D + k] : cc[k]); }
        __syncthreads();
        {
            float* red = sc_l + (NB + 1) * D;
            const int lane = tid & 63, wv = tid >> 6;
            for (int it = bid; it < DEPTH * (NMOD * D / 64); it += G) {
                const int l = it / (NMOD * D / 64), j = (it % (NMOD * D / 64)) * 64 + lane;
                const float* w = adaw + ((size_t)l * D + wv * 128) * NMOD * D + j;
                float a0 = 0.f, a1 = 0.f, a2 = 0.f, a3 = 0.f, a4 = 0.f;
#pragma unroll 8
                for (int k = 0; k < 128; ++k) { const float wk = w[(size_t)k * NMOD * D]; const int kk = wv * 128 + k;
                    a0 += sc_l[kk] * wk; a1 += sc_l[D + kk] * wk; a2 += sc_l[2 * D + kk] * wk; a3 += sc_l[3 * D + kk] * wk; a4 += sc_l[4 * D + kk] * wk; }
                __syncthreads();
                red[(wv * 5 + 0) * 64 + lane] = a0; red[(wv * 5 + 1) * 64 + lane] = a1; red[(wv * 5 + 2) * 64 + lane] = a2; red[(wv * 5 + 3) * 64 + lane] = a3; red[(wv * 5 + 4) * 64 + lane] = a4;
                __syncthreads();
                if (tid < 5 * 64) { const int r = tid >> 6; float acc = adab[l * NMOD * D + j - lane + (tid & 63)];
#pragma unroll
                    for (int q = 0; q < 8; ++q) acc += red[(q * 5 + r) * 64 + (tid & 63)];
                    MOD[((size_t)l * (NB + 1) + r) * NMOD * D + (j - lane) + (tid & 63)] = acc; }
            }
        }
        ITEMS(i, S * 16) {
            const int t = i >> 4, w = i & 15, ii = w & 7; const float pos = (float)(w < 8 ? t / GRID_W : t % GRID_W);
            const float ang = pos * powf(10000.0f, -(float)ii / 8.0f);
            ROPE[(size_t)t * 32 + (w < 8 ? 0 : 16) + ii] = cosf(ang); ROPE[(size_t)t * 32 + (w < 8 ? 8 : 24) + ii] = sinf(ang);
        }
        GSYNC();
    }

#pragma unroll 1
    for (int l = 0; l < DEPTH; ++l) {
        const bool ctx_out = l < DEPTH - 1;
        const float lambda_init = 0.8f - 0.6f * expf(-0.3f * (float)l);
        const int nrows_out = ctx_out ? NTOK : NLAT;
        const int ER = ctx_out ? ER_MAX : NB * CAP_L;

        {
            PHASE_BEGIN();
            {
                const int lane = tid & 63; auto idm = [](int n) { return n; };
                constexpr int T_WIN = (D / 32) * ((IN_COLS + 63) / 64), T_WQ = (192 / 32) * (384 / 64), T_WKV = (128 / 32) * (512 / 64), T_WOUT = (MIXW / 32) * (D / 64);
                WITEMS(id, T_WIN + T_WQ + T_WKV + T_WOUT) {
                    if (id < T_WIN) { const int nt = (IN_COLS + 63) / 64; cvt_tile(kp_->in[I_WIN] + (size_t)l * D * IN_COLS, IN_COLS, WIN_T, D, idm, (id / nt) * 32, (id % nt) * 64, lane); }
                    else if (id < T_WIN + T_WQ) { const int u = id - T_WIN; cvt_tile(kp_->in[I_WQUP] + (size_t)l * 192 * 384, 384, WQ_T, 256, idm, (u / 6) * 32, (u % 6) * 64, lane); }
                    else if (id < T_WIN + T_WQ + T_WKV) { const int u = id - T_WIN - T_WQ; cvt_tile(kp_->in[I_WKVUP] + (size_t)l * 128 * 512, 512, WKV_T, 128, idm, (u / 8) * 32, (u % 8) * 64, lane); }
                    else { const int u = id - T_WIN - T_WQ - T_WKV; cvt_tile(kp_->in[I_WOUT] + (size_t)l * MIXW * D, D, WOUT_T, MIXW, idm, (u / 16) * 32, (u % 16) * 64, lane); }
                }
            }
            ITEMS(i, (IN_PAD - IN_COLS) * D / 8) ((uint4*)(WIN_T + (size_t)IN_COLS * D))[i] = make_uint4(0, 0, 0, 0);
            ITEMS(i, 128 * 256 / 8) ((uint4*)(WQ_T + (size_t)384 * 256))[i] = make_uint4(0, 0, 0, 0);
            ITEMS(i, 384 * 8) { const int r = i >> 3, c8 = i & 7; *(uint4*)(WQ_T + (size_t)r * 256 + 192 + c8 * 8) = make_uint4(0, 0, 0, 0); }

            const float* w = kp_->in[I_NMPRE] + l * D;
            const int lane = tid & 63;
            WITEMS(r, NTOK) {
                const float4* src = (const float4*)(r < NLAT ? XSRC + (size_t)r * D : CSRC + (size_t)(r - NLAT) * D);
                const float* md = modl + (size_t)(r < NLAT ? r / S : NB) * NMOD * D;
                float4 v[4]; float ss = 0.f;
#pragma unroll
                for (int i = 0; i < 4; ++i) { v[i] = src[i * 64 + lane]; ss += f4dot(v[i], v[i]); }
                ss = wave_sum(ss);
                const float rs = 1.0f / sqrtf(ss / D + EPS);
#pragma unroll
                for (int i = 0; i < 4; ++i) { const int k4 = i * 64 + lane; const float4 w4 = ((const float4*)w)[k4], sc = ((const float4*)(md + D))[k4], sh = ((const float4*)md)[k4];
                    const float4 o = make_float4(v[i].x * rs * w4.x * (1.0f + sc.x) + sh.x, v[i].y * rs * w4.y * (1.0f + sc.y) + sh.y, v[i].z * rs * w4.z * (1.0f + sc.z) + sh.z, v[i].w * rs * w4.w * (1.0f + sc.w) + sh.w);
                    *(uint2*)(HB + (size_t)r * D + k4 * 4) = pk4(o); }
            }
            GSYNC();
        }
        {
            PHASE_BEGIN();
            pg8::Gemm g{HB, WIN_T, NTOK, IN_PAD, D, 0, 0}; pg8::StaticOrder so; so.init(NTOK, IN_PAD, G, bid);
            pg8::EpiBf16 E{PB, IN_COLS, IN_COLS};
            pg8::gemm_phase<pg8::EpiBf16, pg8::StaticOrder, true, true>(ldsb, g, so, E);
            GSYNC();
        }
        {
            PHASE_BEGIN();
            const float* cw = kp_->in[I_CONVW] + (size_t)l * 3 * 768; const float* cb = kp_->in[I_CONVB] + (size_t)l * 768;
            ITEMS(i, NTOK * 192) {
                const int c = (i % 192) * 4, r = i / 192;
                const bool lat = r < NLAT; const int L = lat ? S : CTX; const int t = lat ? r % S : (r - NLAT) % CTX;
                const bf16_t* u = PB + (size_t)r * IN_COLS + C_XBC + c;
                float4 acc = f4add(*(const float4*)(cb + c), f4mul(*(const float4*)(cw + 768 + c), ld4h(u)));
                if (t > 0) acc = f4add(acc, f4mul(*(const float4*)(cw + c), ld4h(u - IN_COLS)));
                if (t < L - 1) acc = f4add(acc, f4mul(*(const float4*)(cw + 2 * 768 + c), ld4h(u + IN_COLS)));
                *(uint2*)(XBC + (size_t)r * 768 + c) = pk4(make_float4(siluf(acc.x), siluf(acc.y), siluf(acc.z), siluf(acc.w)));
            }
            const float* dtb = kp_->in[I_DTB] + l * 16;
            ITEMS(i, NTOK * 16) { const int j = i % 16, r = i / 16; DT[i] = softplusf(bf2f(PB[(size_t)r * IN_COLS + C_DT + j]) + dtb[j]); }
            ITEMS(i, NTOK * 16) {
                const int g = i & 15, r = i >> 4; const int hm = g & 7, isk = g >> 3;
                const bool lat = r < NLAT; const int b = lat ? r / S : (r - NLAT) / CTX, t = lat ? r % S : (r - NLAT) % CTX;
                if (!isk && !lat && !ctx_out) continue;
                const bf16_t* vp = PB + (size_t)r * IN_COLS + (isk ? C_DK : C_DQ) + hm * 32;
                float v[32];
#pragma unroll
                for (int k = 0; k < 32; k += 4) { const float4 x = ld4h(vp + k); v[k] = x.x; v[k + 1] = x.y; v[k + 2] = x.z; v[k + 3] = x.w; }
                if (lat) rope32(v, t, ROPE);
                const float sc = isk ? 1.0f : 0.17677669529663687f * 1.4426950408889634f;
                bf16_t* dst = isk ? KD + ((size_t)(b * 8 + hm) * SK + (lat ? CTX + t : t)) * 32 : (lat ? QD + ((size_t)(b * 8 + hm) * S + t) * 32 : QDC + ((size_t)(b * 8 + hm) * CTX + t) * 32);
#pragma unroll
                for (int k = 0; k < 32; k += 8) *(uint4*)(dst + k) = make_uint4(pk2(v[k] * sc, v[k + 1] * sc), pk2(v[k + 2] * sc, v[k + 3] * sc), pk2(v[k + 4] * sc, v[k + 5] * sc), pk2(v[k + 6] * sc, v[k + 7] * sc));
            }
            ITEMS(i, NB * 4 * (SK / 8) * 64) {
                const int d = i & 63, j8 = (i >> 6) % (SK / 8), hh = (i / (64 * (SK / 8))) & 3, b = i / (256 * (SK / 8));
                const int r0 = j8 * 8 < CTX ? tok_row(false, b, j8 * 8) : tok_row(true, b, j8 * 8 - CTX);
                const bf16_t* sp = PB + (size_t)r0 * IN_COLS + C_DV + hh * 64 + d;
                unsigned v[8];
#pragma unroll
                for (int jj = 0; jj < 8; ++jj) v[jj] = sp[(size_t)jj * IN_COLS];
                *(uint4*)(VDT + ((size_t)(b * 4 + hh) * 64 + d) * SK + j8 * 8) = make_uint4(v[0] | (v[1] << 16), v[2] | (v[3] << 16), v[4] | (v[5] << 16), v[6] | (v[7] << 16));
            }
            const float* qn = kp_->in[I_QNORM] + l * 192; const float* kvn = kp_->in[I_KVNORM] + l * 128;
            { const int lane = tid & 63;
            WITEMS(i, NTOK * 2) {
                const int which = i & 1, r = i >> 1; const int n4 = which ? 32 : 48;
                const bf16_t* v = PB + (size_t)r * IN_COLS + (which ? C_CKV : C_CQ); const float4* w = (const float4*)(which ? kvn : qn);
                float4 x = make_float4(0.f, 0.f, 0.f, 0.f); if (lane < n4) x = ld4h(v + lane * 4);
                const float ss = wave_sum(f4dot(x, x));
                const float rs = 1.0f / sqrtf(ss / (n4 * 4) + EPS);
                bf16_t* dst = which ? CKVB + (size_t)r * 128 : CQB + (size_t)r * 256;
                if (lane < n4) *(uint2*)(dst + lane * 4) = pk4(f4scale(f4mul(x, w[lane]), rs));
                else if (!which) { const unsigned z_ = (unsigned)tid >> 20; *(uint2*)(dst + lane * 4) = make_uint2(z_, z_); }
            } }
            GSYNC();
        }
        {
            PHASE_BEGIN();
            const int half = G / 2;
            if (bid < half) {
                pg8::Gemm g{CQB, WQ_T, NTOK, 512, 256, 0, 0}; pg8::StaticOrder so; so.init(NTOK, 512, half, bid);
                pg8::EpiBf16 E{MQ, 384, 384};
                pg8::gemm_phase<pg8::EpiBf16, pg8::StaticOrder, true, true>(ldsb, g, so, E);
            } else {
                pg8::Gemm g{CKVB, WKV_T, NTOK, 512, 128, 0, 0}; pg8::StaticOrder so; so.init(NTOK, 512, G - half, bid - half);
                pg8::EpiBf16 E{MKV, 512, 512};
                pg8::gemm_phase<pg8::EpiBf16, pg8::StaticOrder, true, true>(ldsb, g, so, E);
            }
            for (int it = vcu; it < NB * NCH * 8; it += G) {
                const int hp = it & 3, dir = (it >> 2) & 1, cp = (it >> 3) % NCH, b = it / (8 * NCH);
                const int k = dir ? (cp < 2 ? 1 - cp : 35 - cp) : cp;
                if (k == NCH - 1) continue;
                ssd_block<false>(b, dir, k, hp, XBC, DT, kp_->in[I_ALOG] + l * 16, HS, ALAST, nullptr, (float*)lds_raw, tid);
            }
            GSYNC();
        }
        {
            PHASE_BEGIN();
            ITEMS(i, NTOK * 8) {
                const int g = i & 7, r = i >> 3; const int hh = g & 3, isk = g >> 2;
                const bool lat = r < NLAT; const int b = lat ? r / S : (r - NLAT) / CTX, t = lat ? r % S : (r - NLAT) % CTX;
                if (!isk && !lat && !ctx_out) continue;
                const bf16_t* npb = isk ? MKV + (size_t)r * 512 + hh * 128 : MQ + (size_t)r * 384 + hh * 96;
                const bf16_t* rp = isk ? PB + (size_t)r * IN_COLS + C_KR : npb + 64;
                float v[32], np[64];
#pragma unroll
                for (int k = 0; k < 32; k += 4) { const float4 x = ld4h(rp + k); v[k] = x.x; v[k + 1] = x.y; v[k + 2] = x.z; v[k + 3] = x.w; }
#pragma unroll
                for (int k = 0; k < 64; k += 4) { const float4 x = ld4h(npb + k); np[k] = x.x; np[k + 1] = x.y; np[k + 2] = x.z; np[k + 3] = x.w; }
                if (lat) rope32(v, t, ROPE);
                const float sc = isk ? 1.0f : 0.10206207261596575f * 1.4426950408889634f;
                bf16_t* dst = isk ? KM + ((size_t)(b * 4 + hh) * SK + (lat ? CTX + t : t)) * 96 : (lat ? QM + ((size_t)(b * 4 + hh) * S + t) * 96 : QMC + ((size_t)(b * 4 + hh) * CTX + t) * 96);
#pragma unroll
                for (int k = 0; k < 64; k += 8) *(uint4*)(dst + k) = make_uint4(pk2(np[k] * sc, np[k + 1] * sc), pk2(np[k + 2] * sc, np[k + 3] * sc), pk2(np[k + 4] * sc, np[k + 5] * sc), pk2(np[k + 6] * sc, np[k + 7] * sc));
#pragma unroll
                for (int k = 0; k < 32; k += 8) *(uint4*)(dst + 64 + k) = make_uint4(pk2(v[k] * sc, v[k + 1] * sc), pk2(v[k + 2] * sc, v[k + 3] * sc), pk2(v[k + 4] * sc, v[k + 5] * sc), pk2(v[k + 6] * sc, v[k + 7] * sc));
            }
            ITEMS(i, NB * 4 * (SK / 8) * 64) {
                const int d = i & 63, j8 = (i >> 6) % (SK / 8), hh = (i / (64 * (SK / 8))) & 3, b = i / (256 * (SK / 8));
                const int r0 = j8 * 8 < CTX ? tok_row(false, b, j8 * 8) : tok_row(true, b, j8 * 8 - CTX);
                const bf16_t* sp = MKV + (size_t)r0 * 512 + hh * 128 + 64 + d;
                unsigned v[8];
#pragma unroll
                for (int jj = 0; jj < 8; ++jj) v[jj] = sp[(size_t)jj * 512];
                *(uint4*)(VMT + ((size_t)(b * 4 + hh) * 64 + d) * SK + j8 * 8) = make_uint4(v[0] | (v[1] << 16), v[2] | (v[3] << 16), v[4] | (v[5] << 16), v[6] | (v[7] << 16));
            }
            ITEMS(i, NB * 2 * 8 * 4096) {
                const int e = i & 4095, h = (i >> 12) & 7, bd = i >> 15;
                float* hp0 = HS + ((size_t)bd * NCH * 8 + h) * 4096 + e; const float* al0 = ALAST + (size_t)bd * NCH * 8 + h;
                float sv[NCH - 1], dk[NCH - 1];
#pragma unroll
                for (int k = 0; k < NCH - 1; ++k) { sv[k] = hp0[(size_t)k * 8 * 4096]; dk[k] = al0[k * 8]; }
                float Hc = 0.f;
#pragma unroll
                for (int k = 0; k < NCH; ++k) { hp0[(size_t)k * 8 * 4096] = Hc; if (k < NCH - 1) Hc = Hc * __expf(dk[k]) + sv[k]; }
            }
            GSYNC();
        }
        {
            PHASE_BEGIN();
            for (int it = vcu; it < NB * 2 * NCH * 4; it += G) {
                const int hp = it & 3, dir = (it >> 2) & 1, cp = (it >> 3) % NCH, b = it / (8 * NCH);
                const int k = dir ? (cp < 2 ? 1 - cp : 35 - cp) : cp;
                if (k < 2 && !ctx_out) continue;
                ssd_block<true>(b, dir, k, hp, XBC, DT, kp_->in[I_ALOG] + l * 16, HS, ALAST, YD, (float*)lds_raw, tid);
            }
            const int lane = tid & 63, wave = tid >> 6, qr = lane & 31, hf = lane >> 5;
            {
                const float* lq1 = kp_->in[I_LQ1] + l * 32; const float* lk1 = kp_->in[I_LK1] + l * 32; const float* lq2 = kp_->in[I_LQ2] + l * 32; const float* lk2 = kp_->in[I_LK2] + l * 32;
                const float* subw = kp_->in[I_SUBLN] + l * 64;
                const int nlat = NB * 4 * (S / 256), nit = nlat + (ctx_out ? NB * 4 : 0);
                for (int it = vcu; it < nit; it += G) {
                    const bool lat = it < nlat; const int u = lat ? it : it - nlat;
                    const int qb = lat ? u % (S / 256) : 0, hh = lat ? (u / (S / 256)) % 4 : u % 4, b = lat ? u / (4 * (S / 256)) : u / 4;
                    const int t = qb * 256 + wave * 32 + qr; const int row = tok_row(lat, b, t); const int nkt = lat ? SK / 64 : CTX / 64;
                    f32x16 oacc[2]; unsigned o1p[2][8];
#pragma unroll 1
                    for (int mp = 0; mp < 2; ++mp) {
                        const int hm = hh * 2 + mp;
                        const bf16_t* qrow = lat ? QD + ((size_t)(b * 8 + hm) * S + t) * 32 : QDC + ((size_t)(b * 8 + hm) * CTX + t) * 32;
                        float l_run = 0.f;
#pragma unroll
                        for (int i = 0; i < 16; ++i) { oacc[0][i] = 0.f; oacc[1][i] = 0.f; }
                        attn_pass<32>(qrow, KD + (size_t)(b * 8 + hm) * SK * 32, VDT + (size_t)(b * 4 + hh) * 64 * SK, SK, nkt, ldsb, tid, oacc, l_run);
                        l_run = xor32_sum(l_run);
                        if (mp == 0) { const float i1 = 1.0f / l_run;
#pragma unroll
                            for (int db = 0; db < 2; ++db)
#pragma unroll
                                for (int i = 0; i < 8; ++i) o1p[db][i] = pk2(oacc[db][2 * i] * i1, oacc[db][2 * i + 1] * i1); }
                        else {
                            float d1 = 0.f, d2 = 0.f; for (int k = 0; k < 32; ++k) { d1 += lq1[k] * lk1[k]; d2 += lq2[k] * lk2[k]; }
                            const float lam = expf(d1) - expf(d2) + lambda_init;
                            const float i2 = lam / l_run; float ss = 0.f; f32x16 o1[2];
#pragma unroll
                            for (int db = 0; db < 2; ++db)
#pragma unroll
                                for (int i = 0; i < 16; ++i) { const float a1 = __uint_as_float((i & 1) ? (o1p[db][i >> 1] & 0xffff0000u) : (o1p[db][i >> 1] << 16)); const float v = a1 - oacc[db][i] * i2; o1[db][i] = v; ss += v * v; }
                            ss = xor32_sum(ss);
                            const float rs = (1.0f - lambda_init) / sqrtf(ss / 64 + EPS);
                            bf16_t* orow = MIXB + (size_t)row * MIXW + 512 + hh * 64;
#pragma unroll
                            for (int db = 0; db < 2; ++db)
#pragma unroll
                                for (int gq = 0; gq < 4; ++gq) { const int d0 = 32 * db + 8 * gq + 4 * hf; const float4 w4 = *(const float4*)(subw + d0);
                                    *(uint2*)(orow + d0) = make_uint2(pk2(o1[db][4 * gq] * rs * w4.x, o1[db][4 * gq + 1] * rs * w4.y), pk2(o1[db][4 * gq + 2] * rs * w4.z, o1[db][4 * gq + 3] * rs * w4.w)); }
                        }
                    }
                }
            }
            {
                const int nlat = NB * 4 * (S / 256), nit = nlat + (ctx_out ? NB * 4 : 0);
                for (int it = vcu; it < nit; it += G) {
                    const bool lat = it < nlat; const int u = lat ? it : it - nlat;
                    const int qb = lat ? u % (S / 256) : 0, hh = lat ? (u / (S / 256)) % 4 : u % 4, b = lat ? u / (4 * (S / 256)) : u / 4;
                    const int t = qb * 256 + wave * 32 + qr; const int row = tok_row(lat, b, t); const int nkt = lat ? SK / 64 : CTX / 64;
                    const bf16_t* qrow = lat ? QM + ((size_t)(b * 4 + hh) * S + t) * 96 : QMC + ((size_t)(b * 4 + hh) * CTX + t) * 96;
                    f32x16 oacc[2]; float l_run = 0.f;
#pragma unroll
                    for (int i = 0; i < 16; ++i) { oacc[0][i] = 0.f; oacc[1][i] = 0.f; }
                    attn_pass<96>(qrow, KM + (size_t)(b * 4 + hh) * SK * 96, VMT + (size_t)(b * 4 + hh) * 64 * SK, SK, nkt, ldsb, tid, oacc, l_run);
                    l_run = xor32_sum(l_run);
                    const float inv = 1.0f / l_run;
                    bf16_t* orow = MIXB + (size_t)row * MIXW + 768 + hh * 64;
#pragma unroll
                    for (int db = 0; db < 2; ++db)
#pragma unroll
                        for (int gq = 0; gq < 4; ++gq) { const int d0 = 32 * db + 8 * gq + 4 * hf;
                            *(uint2*)(orow + d0) = make_uint2(pk2(oacc[db][4 * gq] * inv, oacc[db][4 * gq + 1] * inv), pk2(oacc[db][4 * gq + 2] * inv, oacc[db][4 * gq + 3] * inv)); }
                }
            }
            GSYNC();
        }
        {
            PHASE_BEGIN();
            const float* nw = kp_->in[I_SSDN] + l * 512; const float* dsk = kp_->in[I_SSDD] + l * 8;
            const int lane = tid & 63;
            WITEMS(i, nrows_out * 2) {
                const int g = i & 1, r = i >> 1, c = g * 256 + lane * 4;
                const float4 x = ld4h(XBC + (size_t)r * 768 + c), y0 = ld4h(YD + (size_t)r * 512 + c), y1 = ld4h(YD + ((size_t)NTOK + r) * 512 + c);
                const float4 z = ld4h(PB + (size_t)r * IN_COLS + C_Z + c);
                const float ds = dsk[c >> 6];
                float4 v = make_float4((ds * x.x + y0.x + y1.x) * siluf(z.x), (ds * x.y + y0.y + y1.y) * siluf(z.y), (ds * x.z + y0.z + y1.z) * siluf(z.z), (ds * x.w + y0.w + y1.w) * siluf(z.w));
                const float ss = wave_sum(f4dot(v, v));
                const float rs = 1.0f / sqrtf(ss / 256 + EPS);
                *(uint2*)(MIXB + (size_t)r * MIXW + c) = pk4(f4scale(f4mul(v, *(const float4*)(nw + c)), rs));
            }
            GSYNC();
        }
        {
            PHASE_BEGIN();
            pg8::Gemm g{MIXB, WOUT_T, nrows_out, D, MIXW, 0, 0}; pg8::StaticOrder so; so.init(nrows_out, D, G, bid);
            pg8::EpiBf16 E{MOUT, D, D};
            pg8::gemm_phase<pg8::EpiBf16, pg8::StaticOrder, true, true>(ldsb, g, so, E);
            GSYNC();
        }
        {
            PHASE_BEGIN();
            const float* wpost = kp_->in[I_NMPOST] + l * D; const float* wpre = kp_->in[I_NFPRE] + l * D;
            const float* rw = kp_->in[I_RW] + (size_t)l * D * NE; const float* rb = kp_->in[I_RB] + l * NE;
            const int lane = tid & 63;
            float* rwl = (float*)lds_raw;
            for (int i = tid; i < D * NE / 4; i += NTHREADS) { const int k = i >> 2, e4 = i & 3; ((float4*)rwl)[(((k & 3) * 256 + (k >> 2)) << 2) + e4] = ((const float4*)rw)[i]; }
            __syncthreads();
            WITEMS(r, nrows_out) {
                float4* xr = (float4*)(r < NLAT ? xcur + (size_t)r * D : CTXC + (size_t)(r - NLAT) * D);
                const float4* xin = (const float4*)(r < NLAT ? XSRC + (size_t)r * D : CSRC + (size_t)(r - NLAT) * D);
                const float* md = modl + (size_t)(r < NLAT ? r / S : NB) * NMOD * D;
                const bf16_t* m = MOUT + (size_t)r * D;
                float4 mv[4], xv[4]; float ss = 0.f;
#pragma unroll
                for (int i = 0; i < 4; ++i) { mv[i] = ld4h(m + (i * 64 + lane) * 4); xv[i] = xin[i * 64 + lane]; ss += f4dot(mv[i], mv[i]); }
                ss = wave_sum(ss);
                const float rs = 1.0f / sqrtf(ss / D + EPS);
                float s2 = 0.f;
#pragma unroll
                for (int i = 0; i < 4; ++i) { const int k4 = i * 64 + lane; const float4 g2 = ((const float4*)(md + 2 * D))[k4], wp = ((const float4*)wpost)[k4];
                    xv[i] = f4add(xv[i], f4mul(g2, f4scale(f4mul(mv[i], wp), rs))); xr[k4] = xv[i]; s2 += f4dot(xv[i], xv[i]); }
                s2 = wave_sum(s2);
                const float r2 = 1.0f / sqrtf(s2 / D + EPS);
                float lg[NE];
#pragma unroll
                for (int e = 0; e < NE; ++e) lg[e] = 0.f;
#pragma unroll
                for (int i = 0; i < 4; ++i) { const int k4 = i * 64 + lane; const float4 w4 = ((const float4*)wpre)[k4], sc = ((const float4*)(md + 4 * D))[k4], sh = ((const float4*)(md + 3 * D))[k4];
                    const float hv[4] = {xv[i].x * r2 * w4.x * (1.0f + sc.x) + sh.x, xv[i].y * r2 * w4.y * (1.0f + sc.y) + sh.y, xv[i].z * r2 * w4.z * (1.0f + sc.z) + sh.z, xv[i].w * r2 * w4.w * (1.0f + sc.w) + sh.w};
                    *(uint2*)(HB + (size_t)r * D + k4 * 4) = make_uint2(pk2(hv[0], hv[1]), pk2(hv[2], hv[3]));
#pragma unroll
                    for (int c = 0; c < 4; ++c) { const float4* rwp = (const float4*)(rwl + (size_t)(c * 256 + k4) * NE);
#pragma unroll
                        for (int e4 = 0; e4 < 4; ++e4) { const float4 w = rwp[e4]; lg[4 * e4] += hv[c] * w.x; lg[4 * e4 + 1] += hv[c] * w.y; lg[4 * e4 + 2] += hv[c] * w.z; lg[4 * e4 + 3] += hv[c] * w.w; }
                        SCHED_FENCE(); }
                }
#pragma unroll
                for (int e = 0; e < NE; ++e) lg[e] = wave_sum(lg[e]) + rb[e];
                float mx = lg[0];
#pragma unroll
                for (int e = 1; e < NE; ++e) mx = fmaxf(mx, lg[e]);
                float sum = 0.f;
#pragma unroll
                for (int e = 0; e < NE; ++e) { lg[e] = expf(lg[e] - mx); sum += lg[e]; }
                const float is = 1.0f / sum;
                float mine = lg[0];
#pragma unroll
                for (int e = 1; e < NE; ++e) mine = lane == e ? lg[e] : mine;
                if (lane < NE) AFF[(size_t)r * NE + lane] = mine * is;
            }
            GSYNC();
        }
        {
            PHASE_BEGIN();
            {
                const int lane = tid & 63;
                WITEMS(id, NE * 3 * 512) {
                    const int mat = id >> 9, tl = id & 511, e = mat / 3, which = mat % 3, k0 = (tl >> 4) * 32, n0 = (tl & 15) * 64;
                    if (which == 0) cvt_tile(kp_->in[I_WG] + ((size_t)l * NE + e) * D * FF, FF, WGU_T + (size_t)e * 2 * FF * D, D, [](int n) { return (n >> 2) * 8 + (n & 3); }, k0, n0, lane);
                    else if (which == 1) cvt_tile(kp_->in[I_WU] + ((size_t)l * NE + e) * D * FF, FF, WGU_T + (size_t)e * 2 * FF * D, D, [](int n) { return (n >> 2) * 8 + 4 + (n & 3); }, k0, n0, lane);
                    else cvt_tile(kp_->in[I_WD] + ((size_t)l * NE + e) * FF * D, D, WD_T + (size_t)e * D * FF, FF, [](int n) { return n; }, k0, n0, lane);
                }
            }
            {
                volatile int* sh = (volatile int*)lds_raw;
                const int nsel = (ctx_out ? 2 : 1) * NB * NE;
                for (int it = bid; it < nsel; it += G) {
                    const bool lat = it < NB * NE; const int u = lat ? it : it - NB * NE; const int e = u % NE, b = u / NE;
                    const int L = lat ? S : CTX, cap = lat ? CAP_L : CAP_C, npt = lat ? S / NTHREADS : 1, base = tok_row(lat, b, 0);
                    const bool act = lat || tid < CTX;
                    unsigned key[S / NTHREADS];
#pragma unroll
                    for (int i = 0; i < S / NTHREADS; ++i) key[i] = (act && i < npt) ? __float_as_uint(AFF[(size_t)(base + tid * npt + i) * NE + e]) : 0u;
                    __syncthreads();
                    unsigned T = 0u;
                    for (int bit = 30; bit >= 0; --bit) {
                        const unsigned cand = T | (1u << bit); int c = 0;
#pragma unroll
                        for (int i = 0; i < S / NTHREADS; ++i) c += (key[i] >= cand) ? 1 : 0;
                        if (block_sum(c, tid, sh, bit & 1) >= cap) T = cand;
                    }
                    int cg = 0, ct = 0;
#pragma unroll
                    for (int i = 0; i < S / NTHREADS; ++i) { cg += (key[i] > T) ? 1 : 0; ct += (key[i] == T && key[i] != 0u) ? 1 : 0; }
                    int tot_g, tot_t;
                    (void)block_excl_scan(cg, tid, sh, tot_g);
                    int tie_rank = block_excl_scan(ct, tid, sh, tot_t);
                    const int need = cap - tot_g;
                    int sel[S / NTHREADS], cs = 0;
#pragma unroll
                    for (int i = 0; i < S / NTHREADS; ++i) { const bool tie = key[i] == T && key[i] != 0u; sel[i] = (key[i] > T || (tie && tie_rank < need)) ? 1 : 0; tie_rank += tie ? 1 : 0; cs += sel[i]; }
                    int tot_s; int slot = block_excl_scan(cs, tid, sh, tot_s);
#pragma unroll
                    for (int i = 0; i < S / NTHREADS; ++i) if (act && i < npt) {
                        const int row = base + tid * npt + i; int sa = -1;
                        if (sel[i]) { sa = (lat ? b * CAP_L : NB * CAP_L + b * CAP_C) + slot; ++slot; SELIDX[e * ER_MAX + sa] = row; SELGATE[e * ER_MAX + sa] = __uint_as_float(key[i]); }
                        TOKSLOT[(size_t)row * NE + e] = sa;
                    }
                }
            }
            GSYNC();
        }
        {
            PHASE_BEGIN();
            const int used = ctx_out ? NB * (CAP_L + CAP_C) : NB * CAP_L;
            ITEMS(i, NE * ER * (D / 8)) {
                const int c8 = i % (D / 8), slot = (i / (D / 8)) % ER, e = i / ((D / 8) * ER);
                uint4 v = make_uint4(0, 0, 0, 0);
                if (slot < used) v = *(const uint4*)(HB + (size_t)SELIDX[e * ER_MAX + slot] * D + c8 * 8);
                *(uint4*)(XG + ((size_t)e * ER + slot) * D + c8 * 8) = v;
            }
            GSYNC();
        }
        {
            PHASE_BEGIN();
            pg8::Gemm g{XG, WGU_T, NE * ER, 2 * FF, D, ER / 256, (size_t)2 * FF * D * 2}; pg8::StaticOrder so; so.init(NE * ER, 2 * FF, G, bid);
            pg8::EpiSwiGLU E{HID, FF};
            pg8::gemm_phase<pg8::EpiSwiGLU, pg8::StaticOrder, true, true>(ldsb, g, so, E);
            GSYNC();
        }
        {
            PHASE_BEGIN();
            pg8::Gemm g{HID, WD_T, NE * ER, D, FF, ER / 256, (size_t)D * FF * 2}; pg8::StaticOrder so; so.init(NE * ER, D, G, bid);
            pg8::EpiRowScaleBf16 E{Y, D, SELGATE, ER};
            pg8::gemm_phase<pg8::EpiRowScaleBf16, pg8::StaticOrder, true, true>(ldsb, g, so, E);
            GSYNC();
        }
        {
            PHASE_BEGIN();
            const float* wpost = kp_->in[I_NFPOST] + l * D;
            const int lane = tid & 63;
            WITEMS(r, nrows_out) {
                float4* xr = (float4*)(r < NLAT ? xcur + (size_t)r * D : CTXC + (size_t)(r - NLAT) * D);
                const float* md = modl + (size_t)(r < NLAT ? r / S : NB) * NMOD * D;
                const int myslot = lane < NE ? TOKSLOT[(size_t)r * NE + lane] : -1;
                float4 f[4];
#pragma unroll
                for (int i = 0; i < 4; ++i) f[i] = make_float4(0.f, 0.f, 0.f, 0.f);
#pragma unroll
                for (int e = 0; e < NE; ++e) {
                    const int sl = __builtin_amdgcn_readlane(myslot, e);
                    if (sl >= 0) { const bf16_t* yp = Y + ((size_t)e * ER + sl) * D;
#pragma unroll
                        for (int i = 0; i < 4; ++i) f[i] = f4add(f[i], ld4h(yp + (i * 64 + lane) * 4)); }
                }
                float ss = 0.f;
#pragma unroll
                for (int i = 0; i < 4; ++i) ss += f4dot(f[i], f[i]);
                ss = wave_sum(ss);
                const float rs = 1.0f / sqrtf(ss / D + EPS);
#pragma unroll
                for (int i = 0; i < 4; ++i) { const int k4 = i * 64 + lane; const float4 g5 = ((const float4*)(md + 5 * D))[k4], wp = ((const float4*)wpost)[k4];
                    xr[k4] = f4add(xr[k4], f4mul(g5, f4scale(f4mul(f[i], wp), rs))); }
            }
            GSYNC();
        }
    }
}

extern "C" void kernel_launch(void* const* d_in, const int* in_sizes, int n_in, void* d_out, int out_size, void* d_ws, size_t ws_size, hipStream_t stream) {
    static int grid = 0;
    if (grid == 0) {
        if (n_in != N_IN || out_size != NLAT * D || ws_size < WS_END) { fprintf(stderr, "kernel_launch: unexpected shapes: n_in %d out %d ws %zu (need %zu)\n", n_in, out_size, ws_size, (size_t)WS_END); grid = -1; return; }
        int dev = 0, cus = 0, per_cu = 0;
        (void)hipGetDevice(&dev);
        (void)hipDeviceGetAttribute(&cus, hipDeviceAttributeMultiprocessorCount, dev);
        (void)hipFuncSetAttribute((const void*)mk_forward, hipFuncAttributeMaxDynamicSharedMemorySize, LDS_BYTES);
        (void)hipOccupancyMaxActiveBlocksPerMultiprocessor(&per_cu, (const void*)mk_forward, NTHREADS, LDS_BYTES);
        (void)hipGetLastError();
        if (per_cu < 1) { fprintf(stderr, "kernel_launch: occupancy query says %d blocks/CU\n", per_cu); grid = -1; return; }
        grid = cus;
    }
    if (grid < 0) return;
    (void)hipMemsetAsync((char*)d_ws + WS_CTL, 0, CTL_BYTES, stream);
    Prm p{};
    for (int i = 0; i < N_IN; ++i) p.in[i] = (const float*)d_in[i];
    p.out = (float*)d_out; p.ws = (char*)d_ws;
    void* args[] = {&p};
    hipError_t e = hipLaunchCooperativeKernel((const void*)mk_forward, dim3(grid), dim3(NTHREADS), args, LDS_BYTES, stream);
    if (e != hipSuccess) fprintf(stderr, "kernel_launch: cooperative launch failed: %s (grid %d)\n", hipGetErrorString(e), grid);
}
```

```cpp
#include <hip/hip_runtime.h>
#include <cstdio>
#include <cstdint>

constexpr int D = 1024, NB = 4, S = 4096, CTX = 256, FF = 1024;
constexpr int DEPTH = 2, GRID_W = 64, NMOD = 6, NE = 16;
constexpr int NLAT = NB * S, NCTX = NB * CTX, NTOK = NLAT + NCTX;
constexpr int IN_COLS = 2416, IN_PAD = 2560;
constexpr int C_Z = 0, C_XBC = 512, C_DT = 1280, C_DQ = 1296, C_DK = 1552, C_DV = 1808, C_CQ = 2064, C_CKV = 2256, C_KR = 2384;
constexpr int MIXW = 1024;
constexpr int CAP_L = 2 * S / NE, CAP_C = 2 * CTX / NE;
constexpr int ER_MAX = 2304;
constexpr float EPS = 1e-6f;
static_assert(NB * CAP_L == 2048 && NB * CAP_C == 128, "expert row layout");

enum { I_X = 0, I_C, I_CTX, I_CCTX, I_ADAW, I_ADAB, I_NMPRE, I_NMPOST, I_NFPRE, I_NFPOST, I_WIN, I_CONVW, I_CONVB, I_ALOG, I_DTB, I_SSDD, I_SSDN,
       I_LQ1, I_LK1, I_LQ2, I_LK2, I_SUBLN, I_QNORM, I_WQUP, I_KVNORM, I_WKVUP, I_WOUT, I_RW, I_RB, I_WG, I_WU, I_WD, N_IN };
struct Prm { const float* in[N_IN]; float* out; char* ws; };

typedef unsigned short bf16_t;
constexpr size_t al256(size_t x) { return (x + 255) & ~(size_t)255; }
constexpr size_t WS_CTL = 0, CTL_BYTES = 65536;
constexpr size_t WS_MOD = WS_CTL + CTL_BYTES;
constexpr size_t WS_CTXC = al256(WS_MOD + (size_t)DEPTH * (NB + 1) * NMOD * D * 4);
constexpr size_t WS_AFF = al256(WS_CTXC + (size_t)NCTX * D * 4);
constexpr size_t WS_TOKSLOT = al256(WS_AFF + (size_t)NTOK * NE * 4);
constexpr size_t WS_SELIDX = al256(WS_TOKSLOT + (size_t)NTOK * NE * 4);
constexpr size_t WS_SELGATE = al256(WS_SELIDX + (size_t)NE * ER_MAX * 4);
constexpr size_t WS_DT = al256(WS_SELGATE + (size_t)NE * ER_MAX * 4);
constexpr int NCH = 34;
constexpr size_t WS_ROPE = al256(WS_DT + (size_t)NTOK * 16 * 4);
constexpr size_t WS_ALAST = al256(WS_ROPE + (size_t)S * 32 * 4);
constexpr size_t WS_HB = al256(WS_ALAST + (size_t)NB * 2 * NCH * 8 * 4);
constexpr size_t WS_P = al256(WS_HB + (size_t)NTOK * D * 2);
constexpr size_t WS_G2 = al256(WS_P + (size_t)NTOK * IN_COLS * 4);
constexpr size_t WS_XBC = WS_G2;
constexpr size_t WS_MQ = al256(WS_XBC + (size_t)NTOK * 768 * 4);
constexpr size_t WS_MKV = al256(WS_MQ + (size_t)NTOK * 384 * 4);
constexpr size_t WS_CQB = al256(WS_MKV + (size_t)NTOK * 512 * 4);
constexpr size_t WS_CKVB = al256(WS_CQB + (size_t)NTOK * 256 * 2);
constexpr size_t WS_MIXB = al256(WS_CKVB + (size_t)NTOK * 128 * 2);
constexpr size_t WS_G2END = al256(WS_MIXB + (size_t)NTOK * MIXW * 2);
constexpr size_t WS_HS = WS_HB;
constexpr size_t WS_YD = WS_MQ;
constexpr size_t WS_MOUT = WS_P;
constexpr size_t WS_XG = WS_P;
constexpr size_t WS_HID = al256(WS_XG + (size_t)NE * ER_MAX * D * 2);
constexpr size_t WS_Y = WS_G2;
constexpr size_t WS_WIN = WS_G2END;
constexpr size_t WS_WQ = al256(WS_WIN + (size_t)IN_PAD * D * 2);
constexpr size_t WS_WKV = al256(WS_WQ + (size_t)512 * 256 * 2);
constexpr size_t WS_WOUT = al256(WS_WKV + (size_t)512 * 128 * 2);
constexpr size_t WS_WGU = al256(WS_WOUT + (size_t)D * MIXW * 2);
constexpr size_t WS_WD = al256(WS_WGU + (size_t)NE * 2 * FF * D * 2);
constexpr size_t WS_END = al256(WS_WD + (size_t)NE * D * FF * 2);
constexpr int SK = CTX + S;
constexpr size_t WS_QD = al256(WS_P + (size_t)NTOK * IN_COLS * 2);
constexpr size_t WS_QDC = al256(WS_QD + (size_t)NB * 8 * S * 32 * 2);
constexpr size_t WS_KD = al256(WS_QDC + (size_t)NB * 8 * CTX * 32 * 2);
constexpr size_t WS_VDT = al256(WS_KD + (size_t)NB * 8 * SK * 32 * 2);
constexpr size_t WS_QM = al256(WS_VDT + (size_t)NB * 4 * 64 * SK * 2);
constexpr size_t WS_QMC = al256(WS_QM + (size_t)NB * 4 * S * 96 * 2);
constexpr size_t WS_KM = al256(WS_QMC + (size_t)NB * 4 * CTX * 96 * 2);
constexpr size_t WS_VMT = al256(WS_KM + (size_t)NB * 4 * SK * 96 * 2);
constexpr size_t WS_ATTEND = al256(WS_VMT + (size_t)NB * 4 * 64 * SK * 2);
static_assert(WS_ATTEND <= WS_G2, "attention operands fit in the spare half of the P slot");
static_assert(WS_HID + (size_t)NE * ER_MAX * FF * 2 <= WS_G2, "XG+HID fit in the P region");
static_assert((size_t)NE * ER_MAX * D * 4 <= WS_G2END - WS_G2, "Y fits in the G2 region");
static_assert((size_t)NB * 2 * NCH * 8 * 4096 * 4 <= (size_t)NTOK * D * 2, "HS fits in HB");
static_assert(WS_YD + (size_t)2 * NTOK * 512 * 4 <= WS_MIXB, "YD ends below MIXB");

#define LAS __attribute__((address_space(3)))
constexpr int NTHREADS = 512;
constexpr int LDS_BYTES = 147456;
#define ITEMS(i, n) for (int i = blockIdx.x * NTHREADS + tid; i < (n); i += gridDim.x * NTHREADS)

__device__ __forceinline__ float siluf(float x) { return x / (1.0f + expf(-x)); }
__device__ __forceinline__ float softplusf(float x) { return x > 20.f ? x : log1pf(expf(x)); }
__device__ __forceinline__ unsigned f2bf(float f) { unsigned u = __builtin_bit_cast(unsigned, f); return (u + 0x7fffu + ((u >> 16) & 1u)) >> 16; }
typedef float f32x2_t __attribute__((ext_vector_type(2)));
typedef __bf16 bf16x2_t __attribute__((ext_vector_type(2)));
__device__ __forceinline__ unsigned pk2(float lo, float hi) { const f32x2_t v = {lo, hi}; return __builtin_bit_cast(unsigned, __builtin_convertvector(v, bf16x2_t)); }
__device__ __forceinline__ float bf2f(bf16_t h) { return __builtin_bit_cast(float, (unsigned)h << 16); }
#define SCHED_FENCE() __builtin_amdgcn_sched_barrier(0)
__device__ __forceinline__ float dpp_row_shr(float v, int n) {
    const int iv = __builtin_bit_cast(int, v); int r;
    switch (n) { case 1: r = __builtin_amdgcn_update_dpp(0, iv, 0x111, 0xf, 0xf, true); break; case 2: r = __builtin_amdgcn_update_dpp(0, iv, 0x112, 0xf, 0xf, true); break;
                 case 4: r = __builtin_amdgcn_update_dpp(0, iv, 0x114, 0xf, 0xf, true); break; default: r = __builtin_amdgcn_update_dpp(0, iv, 0x118, 0xf, 0xf, true); break; }
    return __builtin_bit_cast(float, r);
}
__device__ __forceinline__ float wave_sum(float v) {
    v += dpp_row_shr(v, 1); v += dpp_row_shr(v, 2); v += dpp_row_shr(v, 4); v += dpp_row_shr(v, 8);
    v += __builtin_bit_cast(float, __builtin_amdgcn_update_dpp(0, __builtin_bit_cast(int, v), 0x142, 0xa, 0xf, false));
    v += __builtin_bit_cast(float, __builtin_amdgcn_update_dpp(0, __builtin_bit_cast(int, v), 0x143, 0xc, 0xf, false));
    return __builtin_bit_cast(float, __builtin_amdgcn_readlane(__builtin_bit_cast(int, v), 63)); }
__device__ __forceinline__ float xor32_max(float x) { auto t = __builtin_amdgcn_permlane32_swap(__float_as_uint(x), __float_as_uint(x), false, false); return fmaxf(__uint_as_float(t[0]), __uint_as_float(t[1])); }
__device__ __forceinline__ float xor32_sum(float x) { auto t = __builtin_amdgcn_permlane32_swap(__float_as_uint(x), __float_as_uint(x), false, false); return __uint_as_float(t[0]) + __uint_as_float(t[1]); }
#define WITEMS(i, n) for (int i = blockIdx.x * 8 + (tid >> 6); i < (n); i += gridDim.x * 8)
__device__ __forceinline__ float4 f4mul(float4 a, float4 b) { return make_float4(a.x * b.x, a.y * b.y, a.z * b.z, a.w * b.w); }
__device__ __forceinline__ float4 f4add(float4 a, float4 b) { return make_float4(a.x + b.x, a.y + b.y, a.z + b.z, a.w + b.w); }
__device__ __forceinline__ float4 f4scale(float4 a, float s) { return make_float4(a.x * s, a.y * s, a.z * s, a.w * s); }
__device__ __forceinline__ float f4dot(float4 a, float4 b) { return a.x * b.x + a.y * b.y + a.z * b.z + a.w * b.w; }
__device__ __forceinline__ uint2 pk4(float4 v) { return make_uint2(pk2(v.x, v.y), pk2(v.z, v.w)); }
__device__ __forceinline__ float4 up4(uint2 u) { return make_float4(__uint_as_float(u.x << 16), __uint_as_float(u.x & 0xffff0000u), __uint_as_float(u.y << 16), __uint_as_float(u.y & 0xffff0000u)); }
__device__ __forceinline__ float4 ld4h(const bf16_t* p) { return up4(*(const uint2*)p); }

__device__ __forceinline__ void rope32(float* v, int t, const float* tab) {
    const float4* tp = (const float4*)(tab + (size_t)t * 32);
    float cs[32];
#pragma unroll
    for (int i = 0; i < 8; ++i) { const float4 x = tp[i]; cs[4 * i] = x.x; cs[4 * i + 1] = x.y; cs[4 * i + 2] = x.z; cs[4 * i + 3] = x.w; }
#pragma unroll
    for (int i = 0; i < 8; ++i) {
        { const float c = cs[i], sn = cs[8 + i]; const float x1 = v[i], x2 = v[8 + i]; v[i] = x1 * c - x2 * sn; v[8 + i] = x1 * sn + x2 * c; }
        { const float c = cs[16 + i], sn = cs[24 + i]; const float x1 = v[16 + i], x2 = v[24 + i]; v[16 + i] = x1 * c - x2 * sn; v[24 + i] = x1 * sn + x2 * c; }
    }
}
__device__ __forceinline__ int tok_row(bool lat, int b, int t) { return lat ? b * S + t : NLAT + b * CTX + t; }

namespace pg8 {
#define PG8_LAS __attribute__((address_space(3)))
typedef short bf16x8 __attribute__((ext_vector_type(8)));
typedef float f32x4 __attribute__((ext_vector_type(4)));
typedef unsigned u32x4 __attribute__((ext_vector_type(4)));
constexpr int BM = 256, BK = 64, HALF = 128, HTB = HALF * BK * 2  , STAGE_BYTES = 8 * HTB, NXCD = 8, WGM = 8;

__host__ __device__ __forceinline__ int lds_byte(int r, int c) { const int st = (r >> 4) * 2 + (c >> 5), rr = r & 15, cc = c & 31, ob = rr * 64 + cc * 2; return st * 1024 + (ob ^ (((ob >> 9) & 1) << 5)); }
__host__ __device__ __forceinline__ void stage_rc(int b, int& R, int& C) { const int st = b / 1024, sb = b % 1024, swz = sb ^ (((sb >> 9) & 1) << 5); R = (st >> 1) * 16 + swz / 64; C = (st & 1) * 32 + (swz % 64) / 2; }
__host__ __device__ __forceinline__ int perm32(int rho) { const int n = rho >> 4, i = rho & 15; return 8 * (i >> 2) + 4 * n + (i & 3); }

struct Unit { int pm, pn; };
struct Gemm { const bf16_t* A; const bf16_t* Bt; int M, N, K; int grp_tiles; size_t grp_stride; };

struct StaticOrder {
    int nM, nN, nwg, G, c;
    __host__ __device__ void init(int M, int N, int G_, int c_) { nM = M / BM; nN = N / BM; nwg = nM * nN; G = G_; c = c_; }
    __host__ __device__ bool next(int i, Unit& u) const {
        const long L = (long)i * G + c; if (L >= nwg) return false;
        int wgid = (int)L; { const int q = nwg / NXCD, r = nwg % NXCD, xcd = wgid % NXCD, off = wgid / NXCD; wgid = (xcd < r ? xcd * (q + 1) : r * (q + 1) + (xcd - r) * q) + off; }
        const int nig = WGM * nN, gid = wgid / nig, fm = gid * WGM, gsz = (nM - fm) < WGM ? (nM - fm) : WGM;
        u.pm = fm + ((wgid % nig) % gsz); u.pn = (wgid % nig) / gsz; return true;
    }
    __device__ __forceinline__ void a_ready(const Unit&) const {}
    __device__ __forceinline__ void done(const Unit&) const {}
};

__device__ __forceinline__ unsigned cvt_pk_bf16(float lo, float hi) { unsigned r; asm volatile("v_cvt_pk_bf16_f32 %0, %1, %2" : "=v"(r) : "v"(lo), "v"(hi)); return r; }

typedef unsigned u32x2 __attribute__((ext_vector_type(2)));
struct EpiF32 {
    static constexpr bool PERM = false, AFTER_DRAIN = false;
    float* C; int ldc; int ncols;
    __device__ __forceinline__ void operator()(const f32x4 (&acc)[2][2][4][2], const Unit& u, int wr, int wc, int fr, int fq) const {
        const int row0 = u.pm * BM + wr * 64 + fr, col0 = u.pn * BM + wc * 32 + 4 * fq;
#pragma unroll
        for (int ai = 0; ai < 2; ++ai)
#pragma unroll
            for (int m = 0; m < 4; ++m) { float* rowp = C + (size_t)(row0 + ai * HALF + m * 16) * ldc;
#pragma unroll
                for (int bj = 0; bj < 2; ++bj)
#pragma unroll
                    for (int n = 0; n < 2; ++n) { const int col = col0 + bj * HALF + n * 16; if (col < ncols) *(f32x4*)(rowp + col) = acc[ai][bj][m][n]; } }
    }
};
struct EpiRowScaleF32 {
    static constexpr bool PERM = false, AFTER_DRAIN = false;
    float* C; int ldc; const float* gate; int er;
    __device__ __forceinline__ void operator()(const f32x4 (&acc)[2][2][4][2], const Unit& u, int wr, int wc, int fr, int fq) const {
        const int row0 = u.pm * BM + wr * 64 + fr, col0 = u.pn * BM + wc * 32 + 4 * fq;
#pragma unroll
        for (int ai = 0; ai < 2; ++ai)
#pragma unroll
            for (int m = 0; m < 4; ++m) { const int row = row0 + ai * HALF + m * 16; float* rowp = C + (size_t)row * ldc; const float sc = gate[(row / er) * ER_MAX + row % er];
#pragma unroll
                for (int bj = 0; bj < 2; ++bj)
#pragma unroll
                    for (int n = 0; n < 2; ++n) *(f32x4*)(rowp + col0 + bj * HALF + n * 16) = acc[ai][bj][m][n] * sc; }
    }
};
struct EpiSwiGLU {
    static constexpr bool PERM = true, AFTER_DRAIN = false;
    bf16_t* O; int ldo;
    __device__ __forceinline__ void operator()(const f32x4 (&acc)[2][2][4][2], const Unit& u, int wr, int wc, int fr, int fq) const {
        const int row0 = u.pm * BM + wr * 64 + fr, col0 = u.pn * BM + wc * 32 + 8 * fq;
#pragma unroll
        for (int ai = 0; ai < 2; ++ai)
#pragma unroll
            for (int m = 0; m < 4; ++m) { bf16_t* rowp = O + (size_t)(row0 + ai * HALF + m * 16) * ldo;
#pragma unroll
                for (int bj = 0; bj < 2; ++bj) { const f32x4 gt = acc[ai][bj][m][0], up = acc[ai][bj][m][1]; f32x4 h;
#pragma unroll
                    for (int i = 0; i < 4; ++i) h[i] = gt[i] / (1.0f + __expf(-gt[i])) * up[i];
                    u32x2 w; w.x = cvt_pk_bf16(h[0], h[1]); w.y = cvt_pk_bf16(h[2], h[3]);
                    *(u32x2*)(rowp + (col0 + bj * HALF) / 2) = w; } }
    }
};

struct EpiBf16 {
    static constexpr bool PERM = true, AFTER_DRAIN = false;
    bf16_t* O; int ldo; int ncols;
    __device__ __forceinline__ void operator()(const f32x4 (&acc)[2][2][4][2], const Unit& u, int wr, int wc, int fr, int fq) const {
        const int row0 = u.pm * BM + wr * 64 + fr, col0 = u.pn * BM + wc * 32 + 8 * fq;
#pragma unroll
        for (int ai = 0; ai < 2; ++ai)
#pragma unroll
            for (int m = 0; m < 4; ++m) { bf16_t* rowp = O + (size_t)(row0 + ai * HALF + m * 16) * ldo;
#pragma unroll
                for (int bj = 0; bj < 2; ++bj) { const int col = col0 + bj * HALF; const f32x4 v0 = acc[ai][bj][m][0], v1 = acc[ai][bj][m][1];
                    u32x4 w; w.x = cvt_pk_bf16(v0[0], v0[1]); w.y = cvt_pk_bf16(v0[2], v0[3]); w.z = cvt_pk_bf16(v1[0], v1[1]); w.w = cvt_pk_bf16(v1[2], v1[3]);
                    if (col < ncols) *(u32x4*)(rowp + col) = w; } }
    }
};
struct EpiRowScaleBf16 {
    static constexpr bool PERM = true, AFTER_DRAIN = false;
    bf16_t* O; int ldo; const float* gate; int er;
    __device__ __forceinline__ void operator()(const f32x4 (&acc)[2][2][4][2], const Unit& u, int wr, int wc, int fr, int fq) const {
        const int row0 = u.pm * BM + wr * 64 + fr, col0 = u.pn * BM + wc * 32 + 8 * fq;
#pragma unroll
        for (int ai = 0; ai < 2; ++ai)
#pragma unroll
            for (int m = 0; m < 4; ++m) { const int row = row0 + ai * HALF + m * 16; bf16_t* rowp = O + (size_t)row * ldo; const float sc = gate[(row / er) * ER_MAX + row % er];
#pragma unroll
                for (int bj = 0; bj < 2; ++bj) { const f32x4 v0 = acc[ai][bj][m][0] * sc, v1 = acc[ai][bj][m][1] * sc;
                    u32x4 w; w.x = cvt_pk_bf16(v0[0], v0[1]); w.y = cvt_pk_bf16(v0[2], v0[3]); w.z = cvt_pk_bf16(v1[0], v1[1]); w.w = cvt_pk_bf16(v1[2], v1[3]);
                    *(u32x4*)(rowp + col0 + bj * HALF) = w; } }
    }
};
template <class Epi, class Sched, bool ALIGN_EPI = false, bool SP2 = false>
__device__ __forceinline__ void gemm_phase(PG8_LAS unsigned char* lds, const Gemm g, const Sched& S, const Epi& E) {
    int tid_ = threadIdx.x; asm volatile("" : "+v"(tid_));
    const int tid = tid_, wid = __builtin_amdgcn_readfirstlane(tid >> 6), lane = tid & 63, wr = wid >> 2, wc = wid & 3, fr = lane & 15, fq = lane >> 4;
    int K_ = g.K; asm volatile("" : "+s"(K_));
    const int K = K_, nt = K / BK;
    unsigned voffA[2], voffB[2];
#pragma unroll
    for (int i = 0; i < 2; ++i) { int R, C; stage_rc(tid * 16 + i * 8192, R, C); const int Rb = Epi::PERM ? ((R & ~31) + perm32(R & 31)) : R;
        voffA[i] = (unsigned)(R * K + C) * 2u; voffB[i] = (unsigned)(Rb * K + C) * 2u; }
    const size_t kstep = (size_t)(BK * 2);
    const size_t hstep = (size_t)HALF * K * 2;
    const size_t tstep = 2 * hstep;
    const unsigned ldsw = (unsigned)wid * 1024u;
    const int aoff = lds_byte(wr * 64 + fr, fq * 8), boff = lds_byte(wc * 32 + fr, fq * 8);
#define PG8_SA(b, h) (((b) * 2 + (h)) * HTB)
#define PG8_SB(b, h) ((4 + (b) * 2 + (h)) * HTB)
#define PG8_STAGE(bufoff, gbase, voff) do { _Pragma("unroll") for (int _i = 0; _i < 2; ++_i) \
        __builtin_amdgcn_global_load_lds((const unsigned*)((const char*)(gbase) + (voff)[_i]), (PG8_LAS unsigned*)(lds + (bufoff) + ldsw + _i * 8192), 16, 0, 0); } while (0)
#define PG8_LDA(dst, b, h) do { _Pragma("unroll") for (int m = 0; m < 4; ++m) _Pragma("unroll") for (int k = 0; k < 2; ++k) dst[m][k] = *(const PG8_LAS bf16x8*)(lds + PG8_SA(b, h) + aoff + m * 2048 + k * 1024); } while (0)
#define PG8_LDB(dst, b, h) do { _Pragma("unroll") for (int n = 0; n < 2; ++n) _Pragma("unroll") for (int k = 0; k < 2; ++k) dst[n][k] = *(const PG8_LAS bf16x8*)(lds + PG8_SB(b, h) + boff + n * 2048 + k * 1024); } while (0)
#define PG8_MMA(ai, bj, At, Bt) do { __builtin_amdgcn_s_setprio(1); _Pragma("unroll") for (int m = 0; m < 4; ++m) _Pragma("unroll") for (int n = 0; n < 2; ++n) _Pragma("unroll") for (int k = 0; k < 2; ++k) \
        acc[ai][bj][m][n] = __builtin_amdgcn_mfma_f32_16x16x32_bf16(Bt[n][k], At[m][k], acc[ai][bj][m][n], 0, 0, 0); __builtin_amdgcn_s_setprio(0); } while (0)
#define PG8_WAIT_V(n) asm volatile("s_waitcnt vmcnt(" #n ")" ::: "memory")
#define PG8_WAIT_L(n) asm volatile("s_waitcnt lgkmcnt(" #n ")" ::: "memory")
#define PG8_BAR __builtin_amdgcn_s_barrier()
#define PG8_SCHED __builtin_amdgcn_sched_barrier(0)
    Unit cur, nxt; int ui = 0;
    if (!S.next(0, cur)) return;
    f32x4 acc[2][2][4][2];
#pragma unroll
    for (int a = 0; a < 2; ++a)
#pragma unroll
        for (int b = 0; b < 2; ++b)
#pragma unroll
            for (int m = 0; m < 4; ++m)
#pragma unroll
                for (int n = 0; n < 2; ++n) acc[a][b][m][n] = (f32x4){0.f, 0.f, 0.f, 0.f};
    bf16x8 At[4][2], B0[2][2], B1[2][2];
    const char* cA = (const char*)g.A + (size_t)cur.pm * tstep; const char* cB = (const char*)g.Bt + (size_t)cur.pn * tstep + (g.grp_tiles ? (size_t)(cur.pm / g.grp_tiles) * g.grp_stride : (size_t)0);
    S.a_ready(cur);
    if constexpr (SP2) {
        PG8_STAGE(PG8_SB(0, 0), cB, voffB); PG8_STAGE(PG8_SB(0, 1), cB + hstep, voffB); PG8_STAGE(PG8_SA(0, 0), cA, voffA); PG8_STAGE(PG8_SA(0, 1), cA + hstep, voffA);
        if (wr == 1) PG8_BAR;
        PG8_WAIT_V(2); PG8_BAR;
        PG8_STAGE(PG8_SB(1, 0), cB + kstep, voffB); PG8_STAGE(PG8_SA(1, 0), cA + kstep, voffA); PG8_STAGE(PG8_SB(1, 1), cB + hstep + kstep, voffB);
        PG8_WAIT_V(6); PG8_BAR;
    } else {
        PG8_STAGE(PG8_SB(0, 0), cB, voffB); PG8_STAGE(PG8_SA(0, 0), cA, voffA); PG8_STAGE(PG8_SB(0, 1), cB + hstep, voffB); PG8_STAGE(PG8_SA(0, 1), cA + hstep, voffA);
        if (wr == 1) PG8_BAR;
        PG8_WAIT_V(4); PG8_BAR;
        PG8_STAGE(PG8_SB(1, 0), cB + kstep, voffB); PG8_STAGE(PG8_SA(1, 0), cA + kstep, voffA); PG8_STAGE(PG8_SB(1, 1), cB + hstep + kstep, voffB);
        PG8_WAIT_V(6); PG8_BAR;
    }
    for (;;) {
        const bool has_next = S.next(ui + 1, nxt);
        const char* nA = has_next ? (const char*)g.A + (size_t)nxt.pm * tstep : cA; const char* nB = has_next ? (const char*)g.Bt + (size_t)nxt.pn * tstep + (g.grp_tiles ? (size_t)(nxt.pm / g.grp_tiles) * g.grp_stride : (size_t)0) : cB;
        for (int t = 0; t < nt; t += 2) {
            const bool last = (t == nt - 2);
            const char* a1 = cA + (size_t)(t + 1) * kstep;
            const char* a2 = last ? nA : cA + (size_t)(t + 2) * kstep; const char* b2 = last ? nB : cB + (size_t)(t + 2) * kstep;
            const char* a3 = a2 + kstep; const char* b3 = b2 + kstep;
            if (last && has_next) S.a_ready(nxt);
            if constexpr (SP2) {
            PG8_LDB(B0, 0, 0); PG8_LDB(B1, 0, 1); PG8_SCHED; PG8_LDA(At, 0, 0); PG8_STAGE(PG8_SA(1, 1), a1 + hstep, voffA);
            PG8_WAIT_V(8); PG8_WAIT_L(0); PG8_BAR; PG8_MMA(0, 0, At, B0); PG8_MMA(0, 1, At, B1); PG8_BAR; PG8_SCHED;
            PG8_LDA(At, 0, 1); PG8_STAGE(PG8_SB(0, 0), b2, voffB); PG8_STAGE(PG8_SB(0, 1), b2 + hstep, voffB); PG8_STAGE(PG8_SA(0, 0), a2, voffA);
            PG8_WAIT_V(8); PG8_WAIT_L(0); PG8_BAR; PG8_MMA(1, 0, At, B0); PG8_MMA(1, 1, At, B1); PG8_BAR; PG8_SCHED;
            PG8_LDB(B0, 1, 0); PG8_LDB(B1, 1, 1); PG8_SCHED; PG8_LDA(At, 1, 0); PG8_STAGE(PG8_SA(0, 1), a2 + hstep, voffA);
            PG8_WAIT_V(8); PG8_WAIT_L(0); PG8_BAR; PG8_MMA(0, 0, At, B0); PG8_MMA(0, 1, At, B1); PG8_BAR; PG8_SCHED;
            PG8_LDA(At, 1, 1); PG8_STAGE(PG8_SB(1, 0), b3, voffB); PG8_STAGE(PG8_SB(1, 1), b3 + hstep, voffB); PG8_STAGE(PG8_SA(1, 0), a3, voffA);
            PG8_WAIT_V(8); PG8_WAIT_L(0); PG8_BAR; PG8_MMA(1, 0, At, B0); PG8_MMA(1, 1, At, B1); PG8_BAR; PG8_SCHED;
            } else {
            PG8_LDB(B0, 0, 0); PG8_SCHED; PG8_LDA(At, 0, 0); PG8_STAGE(PG8_SA(1, 1), a1 + hstep, voffA);
            PG8_WAIT_L(8); PG8_BAR; PG8_WAIT_L(0); PG8_MMA(0, 0, At, B0); PG8_BAR; PG8_SCHED;
            PG8_LDB(B1, 0, 1); PG8_STAGE(PG8_SB(0, 0), b2, voffB);
            PG8_BAR; PG8_WAIT_L(0); PG8_MMA(0, 1, At, B1); PG8_BAR;
            PG8_LDA(At, 0, 1); PG8_STAGE(PG8_SA(0, 0), a2, voffA);
            PG8_BAR; PG8_WAIT_L(0); PG8_MMA(1, 0, At, B0); PG8_BAR; PG8_SCHED;
            PG8_STAGE(PG8_SB(0, 1), b2 + hstep, voffB);
            PG8_WAIT_V(6); PG8_BAR; PG8_MMA(1, 1, At, B1); PG8_BAR;
            PG8_LDB(B0, 1, 0); PG8_SCHED; PG8_LDA(At, 1, 0); PG8_STAGE(PG8_SA(0, 1), a2 + hstep, voffA);
            PG8_WAIT_L(8); PG8_BAR; PG8_WAIT_L(0); PG8_MMA(0, 0, At, B0); PG8_BAR; PG8_SCHED;
            PG8_LDB(B1, 1, 1); PG8_STAGE(PG8_SB(1, 0), b3, voffB);
            PG8_BAR; PG8_WAIT_L(0); PG8_MMA(0, 1, At, B1); PG8_BAR;
            PG8_LDA(At, 1, 1); PG8_STAGE(PG8_SA(1, 0), a3, voffA);
            PG8_BAR; PG8_WAIT_L(0); PG8_MMA(1, 0, At, B0); PG8_BAR; PG8_SCHED;
            PG8_STAGE(PG8_SB(1, 1), b3 + hstep, voffB);
            PG8_WAIT_V(6); PG8_BAR; PG8_MMA(1, 1, At, B1); PG8_BAR;
            }
        }
        if constexpr (ALIGN_EPI) { if (wr == 0) PG8_BAR; }
        if constexpr (!Epi::AFTER_DRAIN) { E(acc, cur, wr, wc, fr, fq); S.done(cur); }
        if (!has_next) break;
#pragma unroll
        for (int a = 0; a < 2; ++a)
#pragma unroll
            for (int b = 0; b < 2; ++b)
#pragma unroll
                for (int m = 0; m < 4; ++m)
#pragma unroll
                    for (int n = 0; n < 2; ++n) acc[a][b][m][n] = (f32x4){0.f, 0.f, 0.f, 0.f};
        cur = nxt; cA = nA; cB = nB; ++ui;
        if constexpr (ALIGN_EPI) { if (wr == 1) PG8_BAR; }
    }
    PG8_WAIT_V(0);
    if constexpr (!ALIGN_EPI) { if (wr == 0) PG8_BAR; }
    PG8_BAR;
    if constexpr (Epi::AFTER_DRAIN) { E.fused(acc, cur, wr, wc, fr, fq, lds, wid, lane); S.done(cur); }
#undef PG8_SA
#undef PG8_SB
#undef PG8_STAGE
#undef PG8_LDA
#undef PG8_LDB
#undef PG8_MMA
#undef PG8_WAIT_V
#undef PG8_WAIT_L
#undef PG8_BAR
#undef PG8_SCHED
}
}


#define XB_TMO      128
#define XB_XCNT(j)  (256  + 64 * (j))
#define XB_XSUB(j)  (1280 + 64 * (j))
#define XB_XGEN(j)  (2304 + 64 * (j))
#define XB_TOP      3328
#define XB_TOPGEN   3392
#define XCD_BAR_WORDS 3456
#define XB_SPIN_CAP (1u << 22)
__device__ __forceinline__ unsigned xb_ld(unsigned* p)              { return __hip_atomic_load(p, __ATOMIC_RELAXED, __HIP_MEMORY_SCOPE_AGENT); }
__device__ __forceinline__ unsigned xb_add(unsigned* p, unsigned v) { return __hip_atomic_fetch_add(p, v, __ATOMIC_RELAXED, __HIP_MEMORY_SCOPE_AGENT); }
__device__ __forceinline__ unsigned xb_xcc_id() { return (unsigned)__builtin_amdgcn_s_getreg((3 << 11) | 20) & 0xFu; }
#define XB_SPIN(cond, bar) do { unsigned _sp = 0; while (cond) { __builtin_amdgcn_s_sleep(1); \
    if ((++_sp & 255u) == 0u) { if (xb_ld(&(bar)[XB_TMO])) break; if (_sp > XB_SPIN_CAP) { atomicAdd(&(bar)[XB_TMO], 1u); break; } } } } while (0)
struct XcdBarrier { unsigned* bar; unsigned x; volatile LAS unsigned* st; };
__device__ __forceinline__ XcdBarrier xcd_barrier_post(unsigned* bar, volatile LAS unsigned* st) {
    XcdBarrier b; b.bar = bar; b.x = xb_xcc_id(); b.st = st;
    if (threadIdx.x == 0) (void)xb_add(&bar[XB_XCNT(b.x)], 1u);
    return b;
}
__device__ __forceinline__ void xcd_barrier_complete(unsigned* bar, unsigned x, unsigned& nloc, unsigned& nx) {
    const unsigned G = gridDim.x * gridDim.y * gridDim.z;
    unsigned sum, cnt, mine, sp = 0u;
    for (;;) {
        sum = 0u; cnt = 0u; mine = 0u;
#pragma unroll
        for (unsigned j = 0; j < 16; ++j) { const unsigned c = xb_ld(&bar[XB_XCNT(j)]); sum += c; cnt += (c > 0u) ? 1u : 0u; mine = (j == x) ? c : mine; }
        if (sum == G) break;
        __builtin_amdgcn_s_sleep(1);
        if ((++sp & 255u) == 0u) { if (xb_ld(&bar[XB_TMO])) break; if (sp > XB_SPIN_CAP) { atomicAdd(&bar[XB_TMO], 1u); break; } }
    }
    nloc = mine > 0u ? mine : 1u; nx = cnt > 0u ? cnt : 1u;
}
__device__ __forceinline__ void xcd_barrier(const XcdBarrier& b) {
    asm volatile("s_waitcnt vmcnt(0)" ::: "memory");
    __syncthreads();
    if (threadIdx.x == 0) {
        unsigned* bar = b.bar;
        __builtin_amdgcn_s_waitcnt(0);
        unsigned nloc = b.st[0], nx = b.st[1];
        if (nloc == 0u) { xcd_barrier_complete(bar, b.x, nloc, nx); b.st[0] = nloc; b.st[1] = nx; }
        const unsigned old = xb_add(&bar[XB_XSUB(b.x)], 1u);
        const unsigned gen = old / nloc;
        if (old + 1u == (gen + 1u) * nloc) {
            __builtin_amdgcn_fence(__ATOMIC_RELEASE, "agent");
            asm volatile("s_waitcnt vmcnt(0)" ::: "memory");
            const unsigned og = xb_add(&bar[XB_TOP], 1u);
            const unsigned tg = og / nx;
            if (og + 1u == (tg + 1u) * nx) xb_add(&bar[XB_TOPGEN], 1u);
            else XB_SPIN(xb_ld(&bar[XB_TOPGEN]) == tg, bar);
            __builtin_amdgcn_fence(__ATOMIC_ACQUIRE, "agent");
            xb_add(&bar[XB_XGEN(b.x)], 1u);
            asm volatile("s_waitcnt vmcnt(0)" ::: "memory");
        } else {
            XB_SPIN(xb_ld(&bar[XB_XGEN(b.x)]) == gen, bar);
            __builtin_amdgcn_fence(__ATOMIC_ACQUIRE, "agent");
            asm volatile("s_waitcnt vmcnt(0)" ::: "memory");
        }
    }
    __syncthreads();
}


typedef short bf16x8 __attribute__((ext_vector_type(8)));
typedef short s16x4 __attribute__((ext_vector_type(4)));
typedef float f32x16 __attribute__((ext_vector_type(16)));
typedef unsigned v4u __attribute__((ext_vector_type(4)));
typedef unsigned v2u __attribute__((ext_vector_type(2)));
constexpr float ATT_THR = 5.0f;
template <int DK> struct AttL { static constexpr int KSTR = DK * 2 + 16, KBYTES = 64 * KSTR, VSTR = 136, VBYTES = 64 * VSTR, KCH = 64 * DK / 8, KPT = (KCH + NTHREADS - 1) / NTHREADS;
    static constexpr int K_OFF = 0, V_OFF = 2 * KBYTES; };

template <int DK>
__device__ __forceinline__ void attn_pass(const bf16_t* Qrow, const bf16_t* Kp, const bf16_t* Vtp, int vt_ld, int nkt, LAS unsigned char* lds, int tid, f32x16 (&oacc)[2], float& l_run) {
    typedef AttL<DK> L;
    constexpr bool AUG = DK <= 32;
    const int lane = tid & 63, r = lane & 31, h = lane >> 5;
    bf16x8 qf[DK / 16];
#pragma unroll
    for (int ks = 0; ks < DK / 16; ++ks) qf[ks] = *(const bf16x8*)(Qrow + 16 * ks + 8 * h);
    const short z_ = (short)(tid >> 20);
    bf16x8 aone = {z_, z_, z_, z_, z_, z_, z_, z_}, bneg = {z_, z_, z_, z_, z_, z_, z_, z_};
    if (h == 0) aone[0] = (short)0x3F80;
    float m_run = 0.f;
    v4u kreg[L::KPT]; v4u vreg;
    const int vd = tid >> 3, vpart = tid & 7;
#define ATT_LOADK(j) do { _Pragma("unroll") for (int i_ = 0; i_ < L::KPT; ++i_) { const int c_ = tid + i_ * NTHREADS; if (c_ < L::KCH) kreg[i_] = *(const v4u*)(Kp + (size_t)(j) * 64 * DK + c_ * 8); } } while (0)
#define ATT_LOADV(j) do { vreg = *(const v4u*)(Vtp + (size_t)vd * vt_ld + (j) * 64 + vpart * 8); } while (0)
#define ATT_STOREK(buf) do { _Pragma("unroll") for (int i_ = 0; i_ < L::KPT; ++i_) { const int c_ = tid + i_ * NTHREADS; if (c_ < L::KCH) { const int key_ = c_ / (DK / 8), part_ = c_ % (DK / 8); \
            *(LAS v4u*)(lds + L::K_OFF + (buf) * L::KBYTES + key_ * L::KSTR + part_ * 16) = kreg[i_]; } } } while (0)
#define ATT_STOREV(buf) do { LAS unsigned char* vp_ = lds + L::V_OFF + (buf) * L::VBYTES + vd * L::VSTR + vpart * 16; *(LAS v2u*)vp_ = (v2u){vreg.x, vreg.y}; *(LAS v2u*)(vp_ + 8) = (v2u){vreg.z, vreg.w}; } while (0)
#define ATT_QK(dst, buf) do { _Pragma("unroll") for (int kb = 0; kb < 2; ++kb) { _Pragma("unroll") for (int i = 0; i < 16; ++i) dst[kb][i] = 0.f; \
        if (AUG) dst[kb] = __builtin_amdgcn_mfma_f32_32x32x16_bf16(aone, bneg, dst[kb], 0, 0, 0); \
        _Pragma("unroll") for (int ks = 0; ks < DK / 16; ++ks) { const bf16x8 a_ = *(const LAS bf16x8*)(lds + L::K_OFF + (buf) * L::KBYTES + (32 * kb + r) * L::KSTR + (16 * ks + 8 * h) * 2); \
            dst[kb] = __builtin_amdgcn_mfma_f32_32x32x16_bf16(a_, qf[ks], dst[kb], 0, 0, 0); } } } while (0)
#define ATT_BODY(SC, SN, j) do { \
        if ((j) + 2 < nkt) ATT_LOADK((j) + 2); \
        if ((j) + 1 < nkt) { ATT_LOADV((j) + 1); ATT_QK(SN, ((j) + 1) & 1); } \
        if (((j) & 3) == 0) { \
            float t0 = fmaxf(fmaxf(SC[0][0], SC[0][1]), SC[0][2]), t1 = fmaxf(fmaxf(SC[0][3], SC[0][4]), SC[0][5]), t2 = fmaxf(fmaxf(SC[0][6], SC[0][7]), SC[0][8]), t3 = fmaxf(fmaxf(SC[0][9], SC[0][10]), SC[0][11]); \
            float t4 = fmaxf(fmaxf(SC[0][12], SC[0][13]), SC[0][14]), t5 = fmaxf(fmaxf(SC[0][15], SC[1][0]), SC[1][1]), t6 = fmaxf(fmaxf(SC[1][2], SC[1][3]), SC[1][4]), t7 = fmaxf(fmaxf(SC[1][5], SC[1][6]), SC[1][7]); \
            float t8 = fmaxf(fmaxf(SC[1][8], SC[1][9]), SC[1][10]), t9 = fmaxf(fmaxf(SC[1][11], SC[1][12]), SC[1][13]), t10 = fmaxf(SC[1][14], SC[1][15]); \
            float tmax = fmaxf(fmaxf(fmaxf(fmaxf(t0, t1), t2), fmaxf(fmaxf(t3, t4), t5)), fmaxf(fmaxf(fmaxf(t6, t7), t8), fmaxf(t9, t10))); \
            tmax = xor32_max(tmax); if (!AUG) tmax -= m_run;            \
            if ((j) == 0 || __any(tmax > ATT_THR)) {                   \
                const float want = (j) == 0 ? tmax : m_run + fmaxf(tmax, 0.f); \
                const float mn = __uint_as_float(pk2(want, 0.f) << 16), dlt = mn - m_run, alpha = __builtin_amdgcn_exp2f(-dlt); \
                _Pragma("unroll") for (int i = 0; i < 16; ++i) { oacc[0][i] *= alpha; oacc[1][i] *= alpha; if (AUG) { SC[0][i] -= dlt; SC[1][i] -= dlt; SN[0][i] -= dlt; SN[1][i] -= dlt; } } \
                l_run *= alpha; m_run = mn; if (AUG && h == 0) bneg[0] = (short)(__float_as_uint(-mn) >> 16); \
            } \
        } \
        float ps0 = 0.f, ps1 = 0.f, ps2 = 0.f, ps3 = 0.f; \
        _Pragma("unroll") for (int kb = 0; kb < 2; ++kb) \
            _Pragma("unroll") for (int i = 0; i < 16; i += 4) { const float mo = AUG ? 0.f : m_run; const float p0 = __builtin_amdgcn_exp2f(SC[kb][i] - mo), p1 = __builtin_amdgcn_exp2f(SC[kb][i + 1] - mo), p2 = __builtin_amdgcn_exp2f(SC[kb][i + 2] - mo), p3 = __builtin_amdgcn_exp2f(SC[kb][i + 3] - mo); \
                SC[kb][i] = p0; SC[kb][i + 1] = p1; SC[kb][i + 2] = p2; SC[kb][i + 3] = p3; ps0 += p0; ps1 += p1; ps2 += p2; ps3 += p3; } \
        l_run += (ps0 + ps1) + (ps2 + ps3); \
        _Pragma("unroll") for (int kb = 0; kb < 2; ++kb) \
            _Pragma("unroll") for (int s2 = 0; s2 < 2; ++s2) { \
                union { bf16x8 v; unsigned u[4]; } pf; \
                _Pragma("unroll") for (int i = 0; i < 4; ++i) pf.u[i] = pk2(SC[kb][8 * s2 + 2 * i], SC[kb][8 * s2 + 2 * i + 1]); \
                _Pragma("unroll") for (int db = 0; db < 2; ++db) { \
                    const LAS unsigned char* vp = lds + L::V_OFF + ((j) & 1) * L::VBYTES + (32 * db + r) * L::VSTR + (32 * kb + 16 * s2 + 4 * h) * 2; \
                    union { bf16x8 v; v2u u[2]; } af; af.u[0] = *(const LAS v2u*)vp; af.u[1] = *(const LAS v2u*)(vp + 16); \
                    oacc[db] = __builtin_amdgcn_mfma_f32_32x32x16_bf16(af.v, pf.v, oacc[db], 0, 0, 0); } } \
        if ((j) + 2 < nkt) ATT_STOREK((j) & 1);               \
        if ((j) + 1 < nkt) ATT_STOREV(((j) + 1) & 1);         \
        __syncthreads(); \
    } while (0)
    __syncthreads();
    ATT_LOADK(0); ATT_LOADV(0); ATT_STOREK(0); ATT_STOREV(0);
    if (nkt > 1) { ATT_LOADK(1); ATT_STOREK(1); }
    __syncthreads();
    f32x16 sa[2], sb[2];
#pragma unroll
    for (int i = 0; i < 16; ++i) { sb[0][i] = (float)z_; sb[1][i] = (float)z_; }
    ATT_QK(sa, 0);
    for (int j = 0; j < nkt; j += 2) {
        ATT_BODY(sa, sb, j);
        if (j + 1 < nkt) ATT_BODY(sb, sa, j + 1);
    }
#undef ATT_BODY
#undef ATT_LOADK
#undef ATT_LOADV
#undef ATT_STOREK
#undef ATT_STOREV
#undef ATT_QK
}


constexpr int SLD = 65, SHLD = 72, XTLD = 132;
__device__ __forceinline__ int rm32(int t, int h) { return (t & 3) + 8 * (t >> 2) + 4 * h; }
template <bool WITH_Y>
__device__ __forceinline__ void ssd_block(int b, int dir, int k, int hp, const bf16_t* xbc, const float* dtp, const float* alog, float* hs, float* alast, bf16_t* yd, float* lds, int tid) {
    const bool lat = k >= 2; const int c = lat ? (dir ? 33 - k : k - 2) : (dir ? 1 - k : k);
    const int row0 = tok_row(lat, b, c * 128), g = hp >> 1;
    float* sB = lds; bf16_t* sBh = (bf16_t*)lds; bf16_t* sCh = sBh + 128 * SHLD;
    float* sX = WITH_Y ? lds + (2 * 128 * SHLD * 2) / 4 : sB + 128 * SLD; bf16_t* sXT = (bf16_t*)sX;
    float* sDT = sX + 128 * 128; float* sCum = sDT + 256; float* sW = sCum + 256; float* sSc = sW + 256;
    const int wave = tid >> 6, lane = tid & 63, r = lane & 31, h = lane >> 5, hl = wave >> 2, head = 2 * hp + hl;
    float* hsp = hs + (((size_t)(b * 2 + dir) * NCH + k) * 8 + head) * 4096;
    union { bf16x8 v; unsigned u[4]; } hfrag[WITH_Y ? 8 : 1];
    if (WITH_Y) {
#pragma unroll
        for (int Pb = 0; Pb < 2; ++Pb)
#pragma unroll
            for (int ks = 0; ks < 4; ++ks) { const float4 x0 = *(const float4*)(hsp + (32 * Pb + r) * 64 + 16 * ks + 8 * h), x1 = *(const float4*)(hsp + (32 * Pb + r) * 64 + 16 * ks + 8 * h + 4);
                hfrag[Pb * 4 + ks].u[0] = pk2(x0.x, x0.y); hfrag[Pb * 4 + ks].u[1] = pk2(x0.z, x0.w); hfrag[Pb * 4 + ks].u[2] = pk2(x1.x, x1.y); hfrag[Pb * 4 + ks].u[3] = pk2(x1.z, x1.w); }
    }
    uint2 vb[8]; float4 vx[8]; float dx[8]; float dtv = 0.f, dav = 0.f;
#pragma unroll
    for (int u = 0; u < 8; ++u) { const int i = tid + u * NTHREADS, t = i >> 5, c4 = i & 31;
        vb[u] = *(const uint2*)(xbc + (size_t)(row0 + t) * 768 + 512 + (c4 >> 4) * 128 + g * 64 + (c4 & 15) * 4);
        vx[u] = ld4h(xbc + (size_t)(row0 + t) * 768 + hp * 128 + c4 * 4);
        dx[u] = dtp[(size_t)(row0 + t) * 16 + dir * 8 + 2 * hp + (c4 >> 4)]; }
    if (tid < 256) { const int hl = tid >> 7, t = tid & 127, h = 2 * hp + hl; dtv = dtp[(size_t)(row0 + t) * 16 + dir * 8 + h]; dav = dtv * -expf(alog[dir * 8 + h]); }
    __syncthreads();
#pragma unroll
    for (int u = 0; u < 8; ++u) { const int i = tid + u * NTHREADS, t = i >> 5, c4 = i & 31;
        if (WITH_Y) *(uint2*)((c4 >> 4 ? sCh : sBh) + t * SHLD + (c4 & 15) * 4) = vb[u];
        else if (!(c4 >> 4)) { const float4 f = up4(vb[u]); float* d = sB + t * SLD + (c4 & 15) * 4; d[0] = f.x; d[1] = f.y; d[2] = f.z; d[3] = f.w; }
        if (WITH_Y) { const float4 xs = f4scale(vx[u], dx[u]); sXT[(c4 * 4 + 0) * XTLD + t] = (bf16_t)(pk2(xs.x, 0.f)); sXT[(c4 * 4 + 1) * XTLD + t] = (bf16_t)(pk2(xs.y, 0.f)); sXT[(c4 * 4 + 2) * XTLD + t] = (bf16_t)(pk2(xs.z, 0.f)); sXT[(c4 * 4 + 3) * XTLD + t] = (bf16_t)(pk2(xs.w, 0.f)); }
        else *(float4*)(sX + t * 128 + c4 * 4) = f4scale(vx[u], dx[u]); }
    if (tid < 256) { const int t = tid & 127; sSc[(tid & 128) + (dir ? 127 - t : t)] = dav; }
    __syncthreads();
    for (int off = 1; off < 128; off <<= 1) { float v = 0.f; const int sI = tid & 127;
        if (tid < 256) { v = sSc[tid]; if (sI >= off) v += sSc[tid - off]; }
        __syncthreads(); if (tid < 256) sSc[tid] = v; __syncthreads(); }
    if (tid < 256) { const int hl = tid >> 7, sI = tid & 127, t = dir ? 127 - sI : sI; const float cu = sSc[tid], tot = sSc[hl * 128 + 127];
        sCum[hl * 128 + t] = cu; sW[hl * 128 + t] = expf(tot - cu);
        if (!WITH_Y && sI == 127) alast[((size_t)(b * 2 + dir) * NCH + k) * 8 + 2 * hp + hl] = tot; }
    __syncthreads();
    if (WITH_Y) {
        const int I = hl ? 3 - (wave & 3) : (wave & 3), ti = 32 * I + r;
        const float cum_i = sCum[hl * 128 + ti];
        f32x16 Y[2], Yo[2];
#pragma unroll
        for (int i = 0; i < 16; ++i) { Y[0][i] = 0.f; Y[1][i] = 0.f; Yo[0][i] = 0.f; Yo[1][i] = 0.f; }
        bf16x8 cfrag[4];
#pragma unroll
        for (int ks = 0; ks < 4; ++ks) cfrag[ks] = *(const bf16x8*)(sCh + (32 * I + r) * SHLD + 16 * ks + 8 * h);
#pragma unroll
        for (int Pb = 0; Pb < 2; ++Pb)
#pragma unroll
            for (int ks = 0; ks < 4; ++ks) Yo[Pb] = __builtin_amdgcn_mfma_f32_32x32x16_bf16(hfrag[Pb * 4 + ks].v, cfrag[ks], Yo[Pb], 0, 0, 0);
        const int J0 = dir ? I : 0, J1 = dir ? 3 : I;
        for (int J = J0; J <= J1; ++J) {
            f32x16 Gt;
#pragma unroll
            for (int i = 0; i < 16; ++i) Gt[i] = 0.f;
#pragma unroll
            for (int ks = 0; ks < 4; ++ks) Gt = __builtin_amdgcn_mfma_f32_32x32x16_bf16(*(const bf16x8*)(sBh + (32 * J + r) * SHLD + 16 * ks + 8 * h), cfrag[ks], Gt, 0, 0, 0);
#pragma unroll
            for (int t = 0; t < 16; ++t) { const int tj = 32 * J + rm32(t, h); const bool valid = (J != I) || (dir ? tj >= ti : tj <= ti);
                Gt[t] *= valid ? __expf(cum_i - sCum[hl * 128 + tj]) : 0.f; }
#pragma unroll
            for (int s2 = 0; s2 < 2; ++s2) {
                union { bf16x8 v; unsigned u[4]; } pf;
#pragma unroll
                for (int i = 0; i < 4; ++i) pf.u[i] = pk2(Gt[8 * s2 + 2 * i], Gt[8 * s2 + 2 * i + 1]);
#pragma unroll
                for (int Pb = 0; Pb < 2; ++Pb) {
                    const bf16_t* xp = sXT + (hl * 64 + 32 * Pb + r) * XTLD + 32 * J + 16 * s2 + 4 * h;
                    union { bf16x8 v; uint2 u[2]; } af; af.u[0] = *(const uint2*)xp; af.u[1] = *(const uint2*)(xp + 8);
                    Y[Pb] = __builtin_amdgcn_mfma_f32_32x32x16_bf16(af.v, pf.v, Y[Pb], 0, 0, 0);
                }
            }
        }
        const float ei = __expf(cum_i);
        bf16_t* yrow = yd + ((size_t)dir * NTOK + row0 + ti) * 512 + head * 64;
#pragma unroll
        for (int Pb = 0; Pb < 2; ++Pb)
#pragma unroll
            for (int tq = 0; tq < 4; ++tq)
                *(uint2*)(yrow + 32 * Pb + 8 * tq + 4 * h) = pk4(make_float4(Y[Pb][4 * tq] + ei * Yo[Pb][4 * tq], Y[Pb][4 * tq + 1] + ei * Yo[Pb][4 * tq + 1], Y[Pb][4 * tq + 2] + ei * Yo[Pb][4 * tq + 2], Y[Pb][4 * tq + 3] + ei * Yo[Pb][4 * tq + 3]));
    } else {
        const int Pb = (wave >> 1) & 1, Nb = wave & 1;
        f32x16 acc;
#pragma unroll
        for (int i = 0; i < 16; ++i) acc[i] = 0.f;
#pragma unroll 8
        for (int ks = 0; ks < 64; ++ks) { const int j = 2 * ks + h;
            acc = __builtin_amdgcn_mfma_f32_32x32x2f32(sX[j * 128 + hl * 64 + 32 * Pb + r] * sW[hl * 128 + j], sB[j * SLD + 32 * Nb + r], acc, 0, 0, 0); }
#pragma unroll
        for (int t = 0; t < 16; ++t) hsp[(32 * Pb + rm32(t, h)) * 64 + 32 * Nb + r] = acc[t];
    }
}

template <class RM>
__device__ __forceinline__ void cvt_tile(const float* src, int N, bf16_t* dst, int ldd, RM rowmap, int k0, int n0, int lane) {
    const int n = n0 + lane;
    if (n < N) {
        const float* sp = src + (size_t)k0 * N + n;
        float v[32];
#pragma unroll
        for (int kk = 0; kk < 32; ++kk) v[kk] = sp[(size_t)kk * N];
        uint4* dp = (uint4*)(dst + (size_t)rowmap(n) * ldd + k0);
#pragma unroll
        for (int i = 0; i < 4; ++i) dp[i] = make_uint4(pk2(v[8 * i], v[8 * i + 1]), pk2(v[8 * i + 2], v[8 * i + 3]), pk2(v[8 * i + 4], v[8 * i + 5]), pk2(v[8 * i + 6], v[8 * i + 7]));
    }
}
__device__ __forceinline__ int block_excl_scan(int v, int tid, volatile int* sh, int& total) {
    const int lane = tid & 63, wave = tid >> 6; int x = v;
    x += __builtin_amdgcn_update_dpp(0, x, 0x111, 0xf, 0xf, true); x += __builtin_amdgcn_update_dpp(0, x, 0x112, 0xf, 0xf, true);
    x += __builtin_amdgcn_update_dpp(0, x, 0x114, 0xf, 0xf, true); x += __builtin_amdgcn_update_dpp(0, x, 0x118, 0xf, 0xf, true);
    x += __builtin_amdgcn_update_dpp(0, x, 0x142, 0xa, 0xf, false); x += __builtin_amdgcn_update_dpp(0, x, 0x143, 0xc, 0xf, false);
    __syncthreads();
    if (lane == 63) sh[wave] = x;
    __syncthreads();
    int off = 0, tot = 0;
#pragma unroll
    for (int w = 0; w < 8; ++w) { const int c = sh[w]; tot += c; if (w < wave) off += c; }
    total = tot;
    return off + x - v;
}
__device__ __forceinline__ int block_sum(int v, int tid, volatile int* sh, int parity) {
    const int lane = tid & 63, wave = tid >> 6;
    v += __builtin_amdgcn_update_dpp(0, v, 0x111, 0xf, 0xf, true); v += __builtin_amdgcn_update_dpp(0, v, 0x112, 0xf, 0xf, true);
    v += __builtin_amdgcn_update_dpp(0, v, 0x114, 0xf, 0xf, true); v += __builtin_amdgcn_update_dpp(0, v, 0x118, 0xf, 0xf, true);
    v += __builtin_amdgcn_update_dpp(0, v, 0x142, 0xa, 0xf, false); v += __builtin_amdgcn_update_dpp(0, v, 0x143, 0xc, 0xf, false);
    if (lane == 63) sh[parity * 8 + wave] = v;
    __syncthreads();
    int tot = 0;
#pragma unroll
    for (int w = 0; w < 8; ++w) tot += sh[parity * 8 + w];
    return tot;
}

#define MOD ((float*)(kp_->ws + WS_MOD))
#define CTXC ((float*)(kp_->ws + WS_CTXC))
#define AFF ((float*)(kp_->ws + WS_AFF))
#define TOKSLOT ((int*)(kp_->ws + WS_TOKSLOT))
#define SELIDX ((int*)(kp_->ws + WS_SELIDX))
#define SELGATE ((float*)(kp_->ws + WS_SELGATE))
#define DT ((float*)(kp_->ws + WS_DT))
#define HB ((bf16_t*)(kp_->ws + WS_HB))
#define HS ((float*)(kp_->ws + WS_HS))
#define YD ((bf16_t*)(kp_->ws + WS_YD))
#define ALAST ((float*)(kp_->ws + WS_ALAST))
#define ROPE ((float*)(kp_->ws + WS_ROPE))
#define PB ((bf16_t*)(kp_->ws + WS_P))
#define XBC ((bf16_t*)(kp_->ws + WS_XBC))
#define MQ ((bf16_t*)(kp_->ws + WS_MQ))
#define MKV ((bf16_t*)(kp_->ws + WS_MKV))
#define CQB ((bf16_t*)(kp_->ws + WS_CQB))
#define CKVB ((bf16_t*)(kp_->ws + WS_CKVB))
#define MIXB ((bf16_t*)(kp_->ws + WS_MIXB))
#define MOUT ((bf16_t*)(kp_->ws + WS_MOUT))
#define XG ((bf16_t*)(kp_->ws + WS_XG))
#define HID ((bf16_t*)(kp_->ws + WS_HID))
#define Y ((bf16_t*)(kp_->ws + WS_Y))
#define WIN_T ((bf16_t*)(kp_->ws + WS_WIN))
#define WQ_T ((bf16_t*)(kp_->ws + WS_WQ))
#define WKV_T ((bf16_t*)(kp_->ws + WS_WKV))
#define WOUT_T ((bf16_t*)(kp_->ws + WS_WOUT))
#define WGU_T ((bf16_t*)(kp_->ws + WS_WGU))
#define WD_T ((bf16_t*)(kp_->ws + WS_WD))
#define QD ((bf16_t*)(kp_->ws + WS_QD))
#define QDC ((bf16_t*)(kp_->ws + WS_QDC))
#define KD ((bf16_t*)(kp_->ws + WS_KD))
#define VDT ((bf16_t*)(kp_->ws + WS_VDT))
#define QM ((bf16_t*)(kp_->ws + WS_QM))
#define QMC ((bf16_t*)(kp_->ws + WS_QMC))
#define KM ((bf16_t*)(kp_->ws + WS_KM))
#define VMT ((bf16_t*)(kp_->ws + WS_VMT))
#define xcur (kp_->out)
#define XSRC (l == 0 ? kp_->in[I_X] : (const float*)kp_->out)
#define CSRC (l == 0 ? kp_->in[I_CTX] : (const float*)CTXC)
#define DTMP XBC
#define modl (MOD + (size_t)l * (NB + 1) * NMOD * D)
typedef const __attribute__((address_space(4))) Prm* KPrm;
#define PHASE_BEGIN() KPrm kp_ = (KPrm)__builtin_amdgcn_kernarg_segment_ptr(); asm volatile("" : "+s"(kp_)); int tid = threadIdx.x; asm volatile("" : "+v"(tid)); (void)tid
#define GSYNC() do { XcdBarrier b_; b_.bar = (unsigned*)(kp_->ws + WS_CTL); b_.x = xb_xcc_id(); b_.st = (volatile LAS unsigned*)(ldsb + LDS_BYTES - 64); xcd_barrier(b_); } while (0)
#define CVT_MOE_RANGE(LW, ID0, ID1, SLOT, NSLOTS) do { const int lane_ = tid & 63; \
        for (int id = (ID0) + (SLOT); id < (ID1); id += (NSLOTS)) { \
            const int mat = id >> 9, tl = id & 511, e = mat / 3, which = mat % 3, k0 = (tl >> 4) * 32, n0 = (tl & 15) * 64; \
            if (which == 0) cvt_tile(kp_->in[I_WG] + ((size_t)(LW) * NE + e) * D * FF, FF, WGU_T + (size_t)e * 2 * FF * D, D, [](int n) { return (n >> 2) * 8 + (n & 3); }, k0, n0, lane_); \
            else if (which == 1) cvt_tile(kp_->in[I_WU] + ((size_t)(LW) * NE + e) * D * FF, FF, WGU_T + (size_t)e * 2 * FF * D, D, [](int n) { return (n >> 2) * 8 + 4 + (n & 3); }, k0, n0, lane_); \
            else cvt_tile(kp_->in[I_WD] + ((size_t)(LW) * NE + e) * FF * D, D, WD_T + (size_t)e * D * FF, FF, [](int n) { return n; }, k0, n0, lane_); } } while (0)
constexpr int MOE_TILES = NE * 3 * 512;
constexpr int CVT_PER_WAVE = 4;
__global__ void __launch_bounds__(NTHREADS, 2) mk_forward(Prm p) {
    extern __shared__ __attribute__((aligned(16))) unsigned char lds_raw[];
    LAS unsigned char* const ldsb = (LAS unsigned char*)lds_raw;
    volatile LAS unsigned* st = (volatile LAS unsigned*)(ldsb + LDS_BYTES - 64);
    if (threadIdx.x < 16) st[threadIdx.x] = 0u;
    __syncthreads();
    (void)xcd_barrier_post((unsigned*)(p.ws + WS_CTL), st);
    const int G = gridDim.x, bid = blockIdx.x;
    const int vcu = (G % 8 == 0) ? (bid % 8) * (G / 8) + bid / 8 : bid;

    {
        PHASE_BEGIN();
        const float* c = kp_->in[I_C]; const float* cc = kp_->in[I_CCTX]; const float* adaw = kp_->in[I_ADAW]; const float* adab = kp_->in[I_ADAB];
        float* sc_l = (float*)lds_raw;
        for (int i = tid; i < (NB + 1) * D; i += NTHREADS) { const int r = i / D, k = i % D; sc_l[i] = siluf(r < NB ? c[(size_t)r * D + k] : cc[k]); }
        __syncthreads();
        {
            float* red = sc_l + (NB + 1) * D;
            const int lane = tid & 63, wv = tid >> 6;
            for (int it = bid; it < DEPTH * (NMOD * D / 64); it += G) {
                const int l = it / (NMOD * D / 64), j = (it % (NMOD * D / 64)) * 64 + lane;
                const float* w = adaw + ((size_t)l * D + wv * 128) * NMOD * D + j;
                float a0 = 0.f, a1 = 0.f, a2 = 0.f, a3 = 0.f, a4 = 0.f;
#pragma unroll 8
                for (int k = 0; k < 128; ++k) { const float wk = w[(size_t)k * NMOD * D]; const int kk = wv * 128 + k;
                    a0 += sc_l[kk] * wk; a1 += sc_l[D + kk] * wk; a2 += sc_l[2 * D + kk] * wk; a3 += sc_l[3 * D + kk] * wk; a4 += sc_l[4 * D + kk] * wk; }
                __syncthreads();
                red[(wv * 5 + 0) * 64 + lane] = a0; red[(wv * 5 + 1) * 64 + lane] = a1; red[(wv * 5 + 2) * 64 + lane] = a2; red[(wv * 5 + 3) * 64 + lane] = a3; red[(wv * 5 + 4) * 64 + lane] = a4;
                __syncthreads();
                if (tid < 5 * 64) { const int r = tid >> 6; float acc = adab[l * NMOD * D + j - lane + (tid & 63)];
#pragma unroll
                    for (int q = 0; q < 8; ++q) acc += red[(q * 5 + r) * 64 + (tid & 63)];
                    MOD[((size_t)l * (NB + 1) + r) * NMOD * D + (j - lane) + (tid & 63)] = acc; }
            }
        }
        ITEMS(i, S * 16) {
            const int t = i >> 4, w = i & 15, ii = w & 7; const float pos = (float)(w < 8 ? t / GRID_W : t % GRID_W);
            const float ang = pos * powf(10000.0f, -(float)ii / 8.0f);
            ROPE[(size_t)t * 32 + (w < 8 ? 0 : 16) + ii] = cosf(ang); ROPE[(size_t)t * 32 + (w < 8 ? 8 : 24) + ii] = sinf(ang);
        }
        GSYNC();
    }

#pragma unroll 1
    for (int l = 0; l < DEPTH; ++l) {
        const bool ctx_out = l < DEPTH - 1;
        const float lambda_init = 0.8f - 0.6f * expf(-0.3f * (float)l);
        const int nrows_out = ctx_out ? NTOK : NLAT;
        const int ER = ctx_out ? ER_MAX : NB * CAP_L;
        int moe_done = 0;

        {
            PHASE_BEGIN();
            {
                const int lane = tid & 63; auto idm = [](int n) { return n; };
                constexpr int T_WIN = (D / 32) * ((IN_COLS + 63) / 64), T_WQ = (192 / 32) * (384 / 64), T_WKV = (128 / 32) * (512 / 64), T_WOUT = (MIXW / 32) * (D / 64);
                WITEMS(id, T_WIN + T_WQ + T_WKV + T_WOUT) {
                    if (id < T_WIN) { const int nt = (IN_COLS + 63) / 64; cvt_tile(kp_->in[I_WIN] + (size_t)l * D * IN_COLS, IN_COLS, WIN_T, D, idm, (id / nt) * 32, (id % nt) * 64, lane); }
                    else if (id < T_WIN + T_WQ) { const int u = id - T_WIN; cvt_tile(kp_->in[I_WQUP] + (size_t)l * 192 * 384, 384, WQ_T, 256, idm, (u / 6) * 32, (u % 6) * 64, lane); }
                    else if (id < T_WIN + T_WQ + T_WKV) { const int u = id - T_WIN - T_WQ; cvt_tile(kp_->in[I_WKVUP] + (size_t)l * 128 * 512, 512, WKV_T, 128, idm, (u / 8) * 32, (u % 8) * 64, lane); }
                    else { const int u = id - T_WIN - T_WQ - T_WKV; cvt_tile(kp_->in[I_WOUT] + (size_t)l * MIXW * D, D, WOUT_T, MIXW, idm, (u / 16) * 32, (u % 16) * 64, lane); }
                }
            }
            ITEMS(i, (IN_PAD - IN_COLS) * D / 8) ((uint4*)(WIN_T + (size_t)IN_COLS * D))[i] = make_uint4(0, 0, 0, 0);
            ITEMS(i, 128 * 256 / 8) ((uint4*)(WQ_T + (size_t)384 * 256))[i] = make_uint4(0, 0, 0, 0);
            ITEMS(i, 384 * 8) { const int r = i >> 3, c8 = i & 7; *(uint4*)(WQ_T + (size_t)r * 256 + 192 + c8 * 8) = make_uint4(0, 0, 0, 0); }

            const float* w = kp_->in[I_NMPRE] + l * D;
            const int lane = tid & 63;
            {
                float4 xq[4];
                { const float zf_ = (float)(tid >> 20);
#pragma unroll
                  for (int i = 0; i < 4; ++i) xq[i] = make_float4(zf_, zf_, zf_, zf_); }
                float4* aux = (float4*)lds_raw;
                __syncthreads();
                for (int i = tid; i < 11 * (D / 4); i += NTHREADS) { const int v = i / (D / 4), k4 = i % (D / 4);
                    const float* src = v == 0 ? w : modl + (size_t)((v - 1) % 5) * NMOD * D + ((v - 1) / 5) * D;
                    aux[i] = ((const float4*)src)[k4]; }
                __syncthreads();
                const int wstride = gridDim.x * 8; int r = blockIdx.x * 8 + (tid >> 6);
#define P1_LOAD(rr) do { const float4* src_ = (const float4*)((rr) < NLAT ? XSRC + (size_t)(rr) * D : CSRC + (size_t)((rr) - NLAT) * D); _Pragma("unroll") for (int i = 0; i < 4; ++i) xq[i] = src_[i * 64 + lane]; } while (0)
                if (r < NTOK) P1_LOAD(r);
                for (; r < NTOK; r += wstride) {
                    const int bsel = r < NLAT ? r / S : NB;
                    float4 v[4]; float ss = 0.f;
#pragma unroll
                    for (int i = 0; i < 4; ++i) { v[i] = xq[i]; ss += f4dot(v[i], v[i]); }
                    if (r + wstride < NTOK) P1_LOAD(r + wstride);
                    ss = wave_sum(ss);
                    const float rs = 1.0f / sqrtf(ss / D + EPS);
#pragma unroll
                    for (int i = 0; i < 4; ++i) { const int k4 = i * 64 + lane; const float4 w4 = aux[k4], sc = aux[(6 + bsel) * (D / 4) + k4], sh = aux[(1 + bsel) * (D / 4) + k4];
                        const float4 o = make_float4(v[i].x * rs * w4.x * (1.0f + sc.x) + sh.x, v[i].y * rs * w4.y * (1.0f + sc.y) + sh.y, v[i].z * rs * w4.z * (1.0f + sc.z) + sh.z, v[i].w * rs * w4.w * (1.0f + sc.w) + sh.w);
                        *(uint2*)(HB + (size_t)r * D + k4 * 4) = pk4(o); }
                }
#undef P1_LOAD
            }
            GSYNC();
        }
        {
            PHASE_BEGIN();
            pg8::Gemm g{HB, WIN_T, NTOK, IN_PAD, D, 0, 0}; pg8::StaticOrder so; so.init(NTOK, IN_PAD, G, bid);
            pg8::EpiBf16 E{PB, IN_COLS, IN_COLS};
            pg8::gemm_phase<pg8::EpiBf16, pg8::StaticOrder, true, true>(ldsb, g, so, E);
            { const int nwg = (NTOK / 256) * (IN_PAD / 256), busy = nwg % G;
              if (busy != 0 && bid >= busy) CVT_MOE_RANGE(l, 0, (G - busy) * 8 * CVT_PER_WAVE, (bid - busy) * 8 + (tid >> 6), (G - busy) * 8);
              moe_done = busy != 0 ? (G - busy) * 8 * CVT_PER_WAVE : 0; }
            GSYNC();
        }
        {
            PHASE_BEGIN();
            const float* cw = kp_->in[I_CONVW] + (size_t)l * 3 * 768; const float* cb = kp_->in[I_CONVB] + (size_t)l * 768;
            {
                float* cwl = (float*)lds_raw;
                __syncthreads();
                for (int i = tid; i < 4 * 768; i += NTHREADS) cwl[i] = i < 3 * 768 ? cw[i] : cb[i - 3 * 768];
                __syncthreads();
                const int stride = gridDim.x * NTHREADS;
                for (int i0 = blockIdx.x * NTHREADS + tid; i0 < NTOK * 192; i0 += 4 * stride) {
                    uint2 u0[4], um[4], up[4];
#pragma unroll
                    for (int q = 0; q < 4; ++q) { const int i = i0 + q * stride; const unsigned z_ = (unsigned)tid >> 20; u0[q] = make_uint2(z_, z_); um[q] = u0[q]; up[q] = u0[q];
                        if (i < NTOK * 192) { const int c = (i % 192) * 4, r = i / 192; const bool lat = r < NLAT; const int L = lat ? S : CTX; const int t = lat ? r % S : (r - NLAT) % CTX;
                            const bf16_t* u = PB + (size_t)r * IN_COLS + C_XBC + c; u0[q] = *(const uint2*)u; if (t > 0) um[q] = *(const uint2*)(u - IN_COLS); if (t < L - 1) up[q] = *(const uint2*)(u + IN_COLS); } }
#pragma unroll
                    for (int q = 0; q < 4; ++q) { const int i = i0 + q * stride;
                        if (i < NTOK * 192) { const int c = (i % 192) * 4, r = i / 192;
                            float4 acc = f4add(*(const float4*)(cwl + 3 * 768 + c), f4mul(*(const float4*)(cwl + 768 + c), up4(u0[q])));
                            acc = f4add(acc, f4mul(*(const float4*)(cwl + c), up4(um[q]))); acc = f4add(acc, f4mul(*(const float4*)(cwl + 2 * 768 + c), up4(up[q])));
                            *(uint2*)(XBC + (size_t)r * 768 + c) = pk4(make_float4(siluf(acc.x), siluf(acc.y), siluf(acc.z), siluf(acc.w))); } }
                }
            }
            const float* dtb = kp_->in[I_DTB] + l * 16;
            ITEMS(i, NTOK * 16) { const int j = i % 16, r = i / 16; DT[i] = softplusf(bf2f(PB[(size_t)r * IN_COLS + C_DT + j]) + dtb[j]); }
            ITEMS(i, NTOK * 16) {
                const int g = i & 15, r = i >> 4; const int hm = g & 7, isk = g >> 3;
                const bool lat = r < NLAT; const int b = lat ? r / S : (r - NLAT) / CTX, t = lat ? r % S : (r - NLAT) % CTX;
                if (!isk && !lat && !ctx_out) continue;
                const bf16_t* vp = PB + (size_t)r * IN_COLS + (isk ? C_DK : C_DQ) + hm * 32;
                float v[32];
#pragma unroll
                for (int k = 0; k < 32; k += 4) { const float4 x = ld4h(vp + k); v[k] = x.x; v[k + 1] = x.y; v[k + 2] = x.z; v[k + 3] = x.w; }
                if (lat) rope32(v, t, ROPE);
                const float sc = isk ? 1.0f : 0.17677669529663687f * 1.4426950408889634f;
                bf16_t* dst = isk ? KD + ((size_t)(b * 8 + hm) * SK + (lat ? CTX + t : t)) * 32 : (lat ? QD + ((size_t)(b * 8 + hm) * S + t) * 32 : QDC + ((size_t)(b * 8 + hm) * CTX + t) * 32);
#pragma unroll
                for (int k = 0; k < 32; k += 8) *(uint4*)(dst + k) = make_uint4(pk2(v[k] * sc, v[k + 1] * sc), pk2(v[k + 2] * sc, v[k + 3] * sc), pk2(v[k + 4] * sc, v[k + 5] * sc), pk2(v[k + 6] * sc, v[k + 7] * sc));
            }
            ITEMS(i, NB * 4 * (SK / 8) * 64) {
                const int d = i & 63, j8 = (i >> 6) % (SK / 8), hh = (i / (64 * (SK / 8))) & 3, b = i / (256 * (SK / 8));
                const int r0 = j8 * 8 < CTX ? tok_row(false, b, j8 * 8) : tok_row(true, b, j8 * 8 - CTX);
                const bf16_t* sp = PB + (size_t)r0 * IN_COLS + C_DV + hh * 64 + d;
                unsigned v[8];
#pragma unroll
                for (int jj = 0; jj < 8; ++jj) v[jj] = sp[(size_t)jj * IN_COLS];
                *(uint4*)(VDT + ((size_t)(b * 4 + hh) * 64 + d) * SK + j8 * 8) = make_uint4(v[0] | (v[1] << 16), v[2] | (v[3] << 16), v[4] | (v[5] << 16), v[6] | (v[7] << 16));
            }
            const float* qn = kp_->in[I_QNORM] + l * 192; const float* kvn = kp_->in[I_KVNORM] + l * 128;
            { const int lane = tid & 63;
            uint2 xq = make_uint2((unsigned)tid >> 20, (unsigned)tid >> 20);
            const int wstride = gridDim.x * 8; int i = blockIdx.x * 8 + (tid >> 6);
#define NRM_LOAD(ii) do { const int wh_ = (ii) & 1, r_ = (ii) >> 1; if (lane < (wh_ ? 32 : 48)) xq = *(const uint2*)(PB + (size_t)r_ * IN_COLS + (wh_ ? C_CKV : C_CQ) + lane * 4); } while (0)
            if (i < NTOK * 2) NRM_LOAD(i);
            for (; i < NTOK * 2; i += wstride) {
                const int which = i & 1, r = i >> 1; const int n4 = which ? 32 : 48;
                const float4* w = (const float4*)(which ? kvn : qn);
                float4 x = make_float4(0.f, 0.f, 0.f, 0.f); if (lane < n4) x = up4(xq);
                if (i + wstride < NTOK * 2) NRM_LOAD(i + wstride);
                const float ss = wave_sum(f4dot(x, x));
                const float rs = 1.0f / sqrtf(ss / (n4 * 4) + EPS);
                bf16_t* dst = which ? CKVB + (size_t)r * 128 : CQB + (size_t)r * 256;
                if (lane < n4) *(uint2*)(dst + lane * 4) = pk4(f4scale(f4mul(x, w[lane]), rs));
                else if (!which) { const unsigned z_ = (unsigned)tid >> 20; *(uint2*)(dst + lane * 4) = make_uint2(z_, z_); }
            }
#undef NRM_LOAD
            }
            GSYNC();
        }
        {
            PHASE_BEGIN();
            const int half = (G * 5) / 8;
            if (bid < half) {
                pg8::Gemm g{CQB, WQ_T, NTOK, 512, 256, 0, 0}; pg8::StaticOrder so; so.init(NTOK, 512, half, bid);
                pg8::EpiBf16 E{MQ, 384, 384};
                pg8::gemm_phase<pg8::EpiBf16, pg8::StaticOrder, true, true>(ldsb, g, so, E);
            } else {
                pg8::Gemm g{CKVB, WKV_T, NTOK, 512, 128, 0, 0}; pg8::StaticOrder so; so.init(NTOK, 512, G - half, bid - half);
                pg8::EpiBf16 E{MKV, 512, 512};
                pg8::gemm_phase<pg8::EpiBf16, pg8::StaticOrder, true, true>(ldsb, g, so, E);
            }
            for (int it = vcu; it < NB * NCH * 8; it += G) {
                const int hp = it & 3, dir = (it >> 2) & 1, cp = (it >> 3) % NCH, b = it / (8 * NCH);
                const int k = dir ? (cp < 2 ? 1 - cp : 35 - cp) : cp;
                if (k == NCH - 1) continue;
                ssd_block<false>(b, dir, k, hp, XBC, DT, kp_->in[I_ALOG] + l * 16, HS, ALAST, nullptr, (float*)lds_raw, tid);
            }
            GSYNC();
        }
        {
            PHASE_BEGIN();
            ITEMS(i, NTOK * 8) {
                const int g = i & 7, r = i >> 3; const int hh = g & 3, isk = g >> 2;
                const bool lat = r < NLAT; const int b = lat ? r / S : (r - NLAT) / CTX, t = lat ? r % S : (r - NLAT) % CTX;
                if (!isk && !lat && !ctx_out) continue;
                const bf16_t* npb = isk ? MKV + (size_t)r * 512 + hh * 128 : MQ + (size_t)r * 384 + hh * 96;
                const bf16_t* rp = isk ? PB + (size_t)r * IN_COLS + C_KR : npb + 64;
                float v[32], np[64];
#pragma unroll
                for (int k = 0; k < 32; k += 4) { const float4 x = ld4h(rp + k); v[k] = x.x; v[k + 1] = x.y; v[k + 2] = x.z; v[k + 3] = x.w; }
#pragma unroll
                for (int k = 0; k < 64; k += 4) { const float4 x = ld4h(npb + k); np[k] = x.x; np[k + 1] = x.y; np[k + 2] = x.z; np[k + 3] = x.w; }
                if (lat) rope32(v, t, ROPE);
                const float sc = isk ? 1.0f : 0.10206207261596575f * 1.4426950408889634f;
                bf16_t* dst = isk ? KM + ((size_t)(b * 4 + hh) * SK + (lat ? CTX + t : t)) * 96 : (lat ? QM + ((size_t)(b * 4 + hh) * S + t) * 96 : QMC + ((size_t)(b * 4 + hh) * CTX + t) * 96);
#pragma unroll
                for (int k = 0; k < 64; k += 8) *(uint4*)(dst + k) = make_uint4(pk2(np[k] * sc, np[k + 1] * sc), pk2(np[k + 2] * sc, np[k + 3] * sc), pk2(np[k + 4] * sc, np[k + 5] * sc), pk2(np[k + 6] * sc, np[k + 7] * sc));
#pragma unroll
                for (int k = 0; k < 32; k += 8) *(uint4*)(dst + 64 + k) = make_uint4(pk2(v[k] * sc, v[k + 1] * sc), pk2(v[k + 2] * sc, v[k + 3] * sc), pk2(v[k + 4] * sc, v[k + 5] * sc), pk2(v[k + 6] * sc, v[k + 7] * sc));
            }
            ITEMS(i, NB * 4 * (SK / 8) * 64) {
                const int d = i & 63, j8 = (i >> 6) % (SK / 8), hh = (i / (64 * (SK / 8))) & 3, b = i / (256 * (SK / 8));
                const int r0 = j8 * 8 < CTX ? tok_row(false, b, j8 * 8) : tok_row(true, b, j8 * 8 - CTX);
                const bf16_t* sp = MKV + (size_t)r0 * 512 + hh * 128 + 64 + d;
                unsigned v[8];
#pragma unroll
                for (int jj = 0; jj < 8; ++jj) v[jj] = sp[(size_t)jj * 512];
                *(uint4*)(VMT + ((size_t)(b * 4 + hh) * 64 + d) * SK + j8 * 8) = make_uint4(v[0] | (v[1] << 16), v[2] | (v[3] << 16), v[4] | (v[5] << 16), v[6] | (v[7] << 16));
            }
            ITEMS(i, NB * 2 * 8 * 4096) {
                const int e = i & 4095, h = (i >> 12) & 7, bd = i >> 15;
                float* hp0 = HS + ((size_t)bd * NCH * 8 + h) * 4096 + e; const float* al0 = ALAST + (size_t)bd * NCH * 8 + h;
                float sv[NCH - 1], dk[NCH - 1];
#pragma unroll
                for (int k = 0; k < NCH - 1; ++k) { sv[k] = hp0[(size_t)k * 8 * 4096]; dk[k] = al0[k * 8]; }
                float Hc = 0.f;
#pragma unroll
                for (int k = 0; k < NCH; ++k) { hp0[(size_t)k * 8 * 4096] = Hc; if (k < NCH - 1) Hc = Hc * __expf(dk[k]) + sv[k]; }
            }
            GSYNC();
        }
        {
            PHASE_BEGIN();
            for (int it = vcu; it < NB * 2 * NCH * 4; it += G) {
                const int hp = it & 3, dir = (it >> 2) & 1, cp = (it >> 3) % NCH, b = it / (8 * NCH);
                const int k = dir ? (cp < 2 ? 1 - cp : 35 - cp) : cp;
                if (k < 2 && !ctx_out) continue;
                ssd_block<true>(b, dir, k, hp, XBC, DT, kp_->in[I_ALOG] + l * 16, HS, ALAST, YD, (float*)lds_raw, tid);
            }
            const int lane = tid & 63, wave = tid >> 6, qr = lane & 31, hf = lane >> 5;
            {
                const float* lq1 = kp_->in[I_LQ1] + l * 32; const float* lk1 = kp_->in[I_LK1] + l * 32; const float* lq2 = kp_->in[I_LQ2] + l * 32; const float* lk2 = kp_->in[I_LK2] + l * 32;
                const float* subw = kp_->in[I_SUBLN] + l * 64;
                const int nlat = NB * 4 * (S / 256), nit = nlat + (ctx_out ? NB * 4 : 0);
                for (int it = vcu; it < nit; it += G) {
                    const bool lat = it < nlat; const int u = lat ? it : it - nlat;
                    const int qb = lat ? u % (S / 256) : 0, hh = lat ? (u / (S / 256)) % 4 : u % 4, b = lat ? u / (4 * (S / 256)) : u / 4;
                    const int t = qb * 256 + wave * 32 + qr; const int row = tok_row(lat, b, t); const int nkt = lat ? SK / 64 : CTX / 64;
                    f32x16 oacc[2]; unsigned o1p[2][8];
#pragma unroll 1
                    for (int mp = 0; mp < 2; ++mp) {
                        const int hm = hh * 2 + mp;
                        const bf16_t* qrow = lat ? QD + ((size_t)(b * 8 + hm) * S + t) * 32 : QDC + ((size_t)(b * 8 + hm) * CTX + t) * 32;
                        float l_run = 0.f;
#pragma unroll
                        for (int i = 0; i < 16; ++i) { oacc[0][i] = 0.f; oacc[1][i] = 0.f; }
                        attn_pass<32>(qrow, KD + (size_t)(b * 8 + hm) * SK * 32, VDT + (size_t)(b * 4 + hh) * 64 * SK, SK, nkt, ldsb, tid, oacc, l_run);
                        l_run = xor32_sum(l_run);
                        if (mp == 0) { const float i1 = 1.0f / l_run;
#pragma unroll
                            for (int db = 0; db < 2; ++db)
#pragma unroll
                                for (int i = 0; i < 8; ++i) o1p[db][i] = pk2(oacc[db][2 * i] * i1, oacc[db][2 * i + 1] * i1); }
                        else {
                            float d1 = 0.f, d2 = 0.f; for (int k = 0; k < 32; ++k) { d1 += lq1[k] * lk1[k]; d2 += lq2[k] * lk2[k]; }
                            const float lam = expf(d1) - expf(d2) + lambda_init;
                            const float i2 = lam / l_run; float ss = 0.f; f32x16 o1[2];
#pragma unroll
                            for (int db = 0; db < 2; ++db)
#pragma unroll
                                for (int i = 0; i < 16; ++i) { const float a1 = __uint_as_float((i & 1) ? (o1p[db][i >> 1] & 0xffff0000u) : (o1p[db][i >> 1] << 16)); const float v = a1 - oacc[db][i] * i2; o1[db][i] = v; ss += v * v; }
                            ss = xor32_sum(ss);
                            const float rs = (1.0f - lambda_init) / sqrtf(ss / 64 + EPS);
                            bf16_t* orow = MIXB + (size_t)row * MIXW + 512 + hh * 64;
#pragma unroll
                            for (int db = 0; db < 2; ++db)
#pragma unroll
                                for (int gq = 0; gq < 4; ++gq) { const int d0 = 32 * db + 8 * gq + 4 * hf; const float4 w4 = *(const float4*)(subw + d0);
                                    *(uint2*)(orow + d0) = make_uint2(pk2(o1[db][4 * gq] * rs * w4.x, o1[db][4 * gq + 1] * rs * w4.y), pk2(o1[db][4 * gq + 2] * rs * w4.z, o1[db][4 * gq + 3] * rs * w4.w)); }
                        }
                    }
                }
            }
            {
                const int nlat = NB * 4 * (S / 256), nit = nlat + (ctx_out ? NB * 4 : 0);
                for (int it = vcu; it < nit; it += G) {
                    const bool lat = it < nlat; const int u = lat ? it : it - nlat;
                    const int qb = lat ? u % (S / 256) : 0, hh = lat ? (u / (S / 256)) % 4 : u % 4, b = lat ? u / (4 * (S / 256)) : u / 4;
                    const int t = qb * 256 + wave * 32 + qr; const int row = tok_row(lat, b, t); const int nkt = lat ? SK / 64 : CTX / 64;
                    const bf16_t* qrow = lat ? QM + ((size_t)(b * 4 + hh) * S + t) * 96 : QMC + ((size_t)(b * 4 + hh) * CTX + t) * 96;
                    f32x16 oacc[2]; float l_run = 0.f;
#pragma unroll
                    for (int i = 0; i < 16; ++i) { oacc[0][i] = 0.f; oacc[1][i] = 0.f; }
                    attn_pass<96>(qrow, KM + (size_t)(b * 4 + hh) * SK * 96, VMT + (size_t)(b * 4 + hh) * 64 * SK, SK, nkt, ldsb, tid, oacc, l_run);
                    l_run = xor32_sum(l_run);
                    const float inv = 1.0f / l_run;
                    bf16_t* orow = MIXB + (size_t)row * MIXW + 768 + hh * 64;
#pragma unroll
                    for (int db = 0; db < 2; ++db)
#pragma unroll
                        for (int gq = 0; gq < 4; ++gq) { const int d0 = 32 * db + 8 * gq + 4 * hf;
                            *(uint2*)(orow + d0) = make_uint2(pk2(oacc[db][4 * gq] * inv, oacc[db][4 * gq + 1] * inv), pk2(oacc[db][4 * gq + 2] * inv, oacc[db][4 * gq + 3] * inv)); }
                }
            }
            GSYNC();
        }
        {
            PHASE_BEGIN();
            const float* nw = kp_->in[I_SSDN] + l * 512; const float* dsk = kp_->in[I_SSDD] + l * 8;
            const int lane = tid & 63;
            uint2 q0, q1, q2, q3; { const unsigned z_ = (unsigned)tid >> 20; q0 = make_uint2(z_, z_); q1 = q0; q2 = q0; q3 = q0; }
            const int wstride = gridDim.x * 8; int i = blockIdx.x * 8 + (tid >> 6);
#define GN_LOAD(ii) do { const int g_ = (ii) & 1, r_ = (ii) >> 1, c_ = g_ * 256 + lane * 4; q0 = *(const uint2*)(XBC + (size_t)r_ * 768 + c_); q1 = *(const uint2*)(YD + (size_t)r_ * 512 + c_); \
                q2 = *(const uint2*)(YD + ((size_t)NTOK + r_) * 512 + c_); q3 = *(const uint2*)(PB + (size_t)r_ * IN_COLS + C_Z + c_); } while (0)
            if (i < nrows_out * 2) GN_LOAD(i);
            for (; i < nrows_out * 2; i += wstride) {
                const int g = i & 1, r = i >> 1, c = g * 256 + lane * 4;
                const float4 x = up4(q0), y0 = up4(q1), y1 = up4(q2), z = up4(q3);
                if (i + wstride < nrows_out * 2) GN_LOAD(i + wstride);
                const float ds = dsk[c >> 6];
                float4 v = make_float4((ds * x.x + y0.x + y1.x) * siluf(z.x), (ds * x.y + y0.y + y1.y) * siluf(z.y), (ds * x.z + y0.z + y1.z) * siluf(z.z), (ds * x.w + y0.w + y1.w) * siluf(z.w));
                const float ss = wave_sum(f4dot(v, v));
                const float rs = 1.0f / sqrtf(ss / 256 + EPS);
                *(uint2*)(MIXB + (size_t)r * MIXW + c) = pk4(f4scale(f4mul(v, *(const float4*)(nw + c)), rs));
            }
#undef GN_LOAD
            GSYNC();
        }
        {
            PHASE_BEGIN();
            pg8::Gemm g{MIXB, WOUT_T, nrows_out, D, MIXW, 0, 0}; pg8::StaticOrder so; so.init(nrows_out, D, G, bid);
            pg8::EpiBf16 E{MOUT, D, D};
            pg8::gemm_phase<pg8::EpiBf16, pg8::StaticOrder, true, true>(ldsb, g, so, E);
            { const int nwg = (nrows_out / 256) * (D / 256), busy = nwg % G; const int id0 = moe_done;
              if (busy != 0 && bid >= busy) CVT_MOE_RANGE(l, id0, id0 + (G - busy) * 8 * CVT_PER_WAVE, (bid - busy) * 8 + (tid >> 6), (G - busy) * 8);
              if (busy != 0) moe_done = id0 + (G - busy) * 8 * CVT_PER_WAVE; }
            GSYNC();
        }
        {
            PHASE_BEGIN();
            const float* wpost = kp_->in[I_NMPOST] + l * D; const float* wpre = kp_->in[I_NFPRE] + l * D;
            const float* rw = kp_->in[I_RW] + (size_t)l * D * NE; const float* rb = kp_->in[I_RB] + l * NE;
            const int lane = tid & 63;
            float* rwl = (float*)lds_raw;
            for (int i = tid; i < D * NE / 4; i += NTHREADS) { const int k = i >> 2, e4 = i & 3; ((float4*)rwl)[(((k & 3) * 256 + (k >> 2)) << 2) + e4] = ((const float4*)rw)[i]; }
            float4* aux = (float4*)(rwl + D * NE);
            for (int i = tid; i < 17 * (D / 4); i += NTHREADS) { const int v = i / (D / 4), k4 = i % (D / 4);
                const float* src = v == 0 ? wpost : v == 1 ? wpre : modl + (size_t)((v - 2) % 5) * NMOD * D + (2 + (v - 2) / 5) * D;
                aux[i] = ((const float4*)src)[k4]; }
            __syncthreads();
            uint2 mq[4]; float4 xq[4];
            { const float zf_ = (float)(tid >> 20);
#pragma unroll
              for (int i = 0; i < 4; ++i) { xq[i] = make_float4(zf_, zf_, zf_, zf_); mq[i] = make_uint2((unsigned)tid >> 20, (unsigned)tid >> 20); } }
            const int wstride = gridDim.x * 8; int r = blockIdx.x * 8 + (tid >> 6);
#define P7_LOAD(rr) do { const float4* xin_ = (const float4*)((rr) < NLAT ? XSRC + (size_t)(rr) * D : CSRC + (size_t)((rr) - NLAT) * D); const bf16_t* m_ = MOUT + (size_t)(rr) * D; \
                _Pragma("unroll") for (int i = 0; i < 4; ++i) { mq[i] = *(const uint2*)(m_ + (i * 64 + lane) * 4); xq[i] = xin_[i * 64 + lane]; } } while (0)
            if (r < nrows_out) P7_LOAD(r);
            for (; r < nrows_out; r += wstride) {
                float4* xr = (float4*)(r < NLAT ? xcur + (size_t)r * D : CTXC + (size_t)(r - NLAT) * D);
                const int bsel = r < NLAT ? r / S : NB;
                float4 mv[4], xv[4]; float ss = 0.f;
#pragma unroll
                for (int i = 0; i < 4; ++i) { mv[i] = up4(mq[i]); xv[i] = xq[i]; ss += f4dot(mv[i], mv[i]); }
                if (r + wstride < nrows_out) P7_LOAD(r + wstride);
                ss = wave_sum(ss);
                const float rs = 1.0f / sqrtf(ss / D + EPS);
                float s2 = 0.f;
#pragma unroll
                for (int i = 0; i < 4; ++i) { const int k4 = i * 64 + lane;
                    xv[i] = f4add(xv[i], f4mul(aux[(2 + bsel) * (D / 4) + k4], f4scale(f4mul(mv[i], aux[k4]), rs))); xr[k4] = xv[i]; s2 += f4dot(xv[i], xv[i]); }
                s2 = wave_sum(s2);
                const float r2 = 1.0f / sqrtf(s2 / D + EPS);
                float lg[NE];
#pragma unroll
                for (int e = 0; e < NE; ++e) lg[e] = 0.f;
#pragma unroll
                for (int i = 0; i < 4; ++i) { const int k4 = i * 64 + lane; const float4 w4 = aux[(D / 4) + k4], sc = aux[(12 + bsel) * (D / 4) + k4], sh = aux[(7 + bsel) * (D / 4) + k4];
                    const float hv[4] = {xv[i].x * r2 * w4.x * (1.0f + sc.x) + sh.x, xv[i].y * r2 * w4.y * (1.0f + sc.y) + sh.y, xv[i].z * r2 * w4.z * (1.0f + sc.z) + sh.z, xv[i].w * r2 * w4.w * (1.0f + sc.w) + sh.w};
                    *(uint2*)(HB + (size_t)r * D + k4 * 4) = make_uint2(pk2(hv[0], hv[1]), pk2(hv[2], hv[3]));
#pragma unroll
                    for (int c = 0; c < 4; ++c) { const float4* rwp = (const float4*)(rwl + (size_t)(c * 256 + k4) * NE);
#pragma unroll
                        for (int e4 = 0; e4 < 4; ++e4) { const float4 w = rwp[e4]; lg[4 * e4] += hv[c] * w.x; lg[4 * e4 + 1] += hv[c] * w.y; lg[4 * e4 + 2] += hv[c] * w.z; lg[4 * e4 + 3] += hv[c] * w.w; }
                        SCHED_FENCE(); }
                }
#pragma unroll
                for (int e = 0; e < NE; ++e) lg[e] = wave_sum(lg[e]) + rb[e];
                float mx = lg[0];
#pragma unroll
                for (int e = 1; e < NE; ++e) mx = fmaxf(mx, lg[e]);
                float sum = 0.f;
#pragma unroll
                for (int e = 0; e < NE; ++e) { lg[e] = expf(lg[e] - mx); sum += lg[e]; }
                const float is = 1.0f / sum;
                float mine = lg[0];
#pragma unroll
                for (int e = 1; e < NE; ++e) mine = lane == e ? lg[e] : mine;
                if (lane < NE) AFF[(size_t)r * NE + lane] = mine * is;
            }
#undef P7_LOAD
            GSYNC();
        }
        {
            PHASE_BEGIN();
            CVT_MOE_RANGE(l, moe_done, MOE_TILES, bid * 8 + (tid >> 6), G * 8);
            {
                volatile int* sh = (volatile int*)lds_raw;
                const int nsel = (ctx_out ? 2 : 1) * NB * NE;
                for (int it = bid; it < nsel; it += G) {
                    const bool lat = it < NB * NE; const int u = lat ? it : it - NB * NE; const int e = u % NE, b = u / NE;
                    const int L = lat ? S : CTX, cap = lat ? CAP_L : CAP_C, npt = lat ? S / NTHREADS : 1, base = tok_row(lat, b, 0);
                    const bool act = lat || tid < CTX;
                    unsigned key[S / NTHREADS];
#pragma unroll
                    for (int i = 0; i < S / NTHREADS; ++i) key[i] = (act && i < npt) ? __float_as_uint(AFF[(size_t)(base + tid * npt + i) * NE + e]) : 0u;
                    __syncthreads();
                    unsigned T = 0u;
                    for (int bit = 30; bit >= 0; --bit) {
                        const unsigned cand = T | (1u << bit); int c = 0;
#pragma unroll
                        for (int i = 0; i < S / NTHREADS; ++i) c += (key[i] >= cand) ? 1 : 0;
                        if (block_sum(c, tid, sh, bit & 1) >= cap) T = cand;
                    }
                    int cg = 0, ct = 0;
#pragma unroll
                    for (int i = 0; i < S / NTHREADS; ++i) { cg += (key[i] > T) ? 1 : 0; ct += (key[i] == T && key[i] != 0u) ? 1 : 0; }
                    int tot_g, tot_t;
                    (void)block_excl_scan(cg, tid, sh, tot_g);
                    int tie_rank = block_excl_scan(ct, tid, sh, tot_t);
                    const int need = cap - tot_g;
                    int sel[S / NTHREADS], cs = 0;
#pragma unroll
                    for (int i = 0; i < S / NTHREADS; ++i) { const bool tie = key[i] == T && key[i] != 0u; sel[i] = (key[i] > T || (tie && tie_rank < need)) ? 1 : 0; tie_rank += tie ? 1 : 0; cs += sel[i]; }
                    int tot_s; int slot = block_excl_scan(cs, tid, sh, tot_s);
#pragma unroll
                    for (int i = 0; i < S / NTHREADS; ++i) if (act && i < npt) {
                        const int row = base + tid * npt + i; int sa = -1;
                        if (sel[i]) { sa = (lat ? b * CAP_L : NB * CAP_L + b * CAP_C) + slot; ++slot; SELIDX[e * ER_MAX + sa] = row; SELGATE[e * ER_MAX + sa] = __uint_as_float(key[i]); }
                        TOKSLOT[(size_t)row * NE + e] = sa;
                    }
                }
            }
            GSYNC();
        }
        {
            PHASE_BEGIN();
            const int used = ctx_out ? NB * (CAP_L + CAP_C) : NB * CAP_L;
            ITEMS(i, NE * ER * (D / 8)) {
                const int c8 = i % (D / 8), slot = (i / (D / 8)) % ER, e = i / ((D / 8) * ER);
                uint4 v = make_uint4(0, 0, 0, 0);
                if (slot < used) v = *(const uint4*)(HB + (size_t)SELIDX[e * ER_MAX + slot] * D + c8 * 8);
                *(uint4*)(XG + ((size_t)e * ER + slot) * D + c8 * 8) = v;
            }
            GSYNC();
        }
        {
            PHASE_BEGIN();
            pg8::Gemm g{XG, WGU_T, NE * ER, 2 * FF, D, ER / 256, (size_t)2 * FF * D * 2}; pg8::StaticOrder so; so.init(NE * ER, 2 * FF, G, bid);
            pg8::EpiSwiGLU E{HID, FF};
            pg8::gemm_phase<pg8::EpiSwiGLU, pg8::StaticOrder, true, true>(ldsb, g, so, E);
            GSYNC();
        }
        {
            PHASE_BEGIN();
            pg8::Gemm g{HID, WD_T, NE * ER, D, FF, ER / 256, (size_t)D * FF * 2}; pg8::StaticOrder so; so.init(NE * ER, D, G, bid);
            pg8::EpiRowScaleBf16 E{Y, D, SELGATE, ER};
            pg8::gemm_phase<pg8::EpiRowScaleBf16, pg8::StaticOrder, true, true>(ldsb, g, so, E);
            GSYNC();
        }
        {
            PHASE_BEGIN();
            const float* wpost = kp_->in[I_NFPOST] + l * D;
            const int lane = tid & 63;
            {
                float4 xq[4]; int slq = -1;
                { const float zf_ = (float)(tid >> 20);
#pragma unroll
                  for (int i = 0; i < 4; ++i) xq[i] = make_float4(zf_, zf_, zf_, zf_); }
                float4* aux = (float4*)lds_raw;
                __syncthreads();
                for (int i = tid; i < 6 * (D / 4); i += NTHREADS) { const int v = i / (D / 4), k4 = i % (D / 4);
                    const float* src = v == 0 ? wpost : modl + (size_t)(v - 1) * NMOD * D + 5 * D;
                    aux[i] = ((const float4*)src)[k4]; }
                __syncthreads();
                const int wstride = gridDim.x * 8; int r = blockIdx.x * 8 + (tid >> 6);
#define P11_LOAD(rr) do { const float4* xin_ = (const float4*)((rr) < NLAT ? xcur + (size_t)(rr) * D : CTXC + (size_t)((rr) - NLAT) * D); slq = lane < NE ? TOKSLOT[(size_t)(rr) * NE + lane] : -1; \
                    _Pragma("unroll") for (int i = 0; i < 4; ++i) xq[i] = xin_[i * 64 + lane]; } while (0)
                if (r < nrows_out) P11_LOAD(r);
                for (; r < nrows_out; r += wstride) {
                    float4* xr = (float4*)(r < NLAT ? xcur + (size_t)r * D : CTXC + (size_t)(r - NLAT) * D);
                    const int bsel = r < NLAT ? r / S : NB;
                    const int myslot = slq; float4 xv[4], f[4];
#pragma unroll
                    for (int i = 0; i < 4; ++i) { xv[i] = xq[i]; f[i] = make_float4(0.f, 0.f, 0.f, 0.f); }
#pragma unroll
                    for (int e = 0; e < NE; ++e) {
                        const int sl = __builtin_amdgcn_readlane(myslot, e);
                        if (sl >= 0) { const bf16_t* yp = Y + ((size_t)e * ER + sl) * D;
#pragma unroll
                            for (int i = 0; i < 4; ++i) f[i] = f4add(f[i], ld4h(yp + (i * 64 + lane) * 4)); }
                    }
                    if (r + wstride < nrows_out) P11_LOAD(r + wstride);
                    float ss = 0.f;
#pragma unroll
                    for (int i = 0; i < 4; ++i) ss += f4dot(f[i], f[i]);
                    ss = wave_sum(ss);
                    const float rs = 1.0f / sqrtf(ss / D + EPS);
#pragma unroll
                    for (int i = 0; i < 4; ++i) { const int k4 = i * 64 + lane; xr[k4] = f4add(xv[i], f4mul(aux[(1 + bsel) * (D / 4) + k4], f4scale(f4mul(f[i], aux[k4]), rs))); }
                }
#undef P11_LOAD
            }
            GSYNC();
        }
    }
}

extern "C" void kernel_launch(void* const* d_in, const int* in_sizes, int n_in, void* d_out, int out_size, void* d_ws, size_t ws_size, hipStream_t stream) {
    static int grid = 0;
    if (grid == 0) {
        if (n_in != N_IN || out_size != NLAT * D || ws_size < WS_END) { fprintf(stderr, "kernel_launch: unexpected shapes: n_in %d out %d ws %zu (need %zu)\n", n_in, out_size, ws_size, (size_t)WS_END); grid = -1; return; }
        int dev = 0, cus = 0, per_cu = 0;
        (void)hipGetDevice(&dev);
        (void)hipDeviceGetAttribute(&cus, hipDeviceAttributeMultiprocessorCount, dev);
        (void)hipFuncSetAttribute((const void*)mk_forward, hipFuncAttributeMaxDynamicSharedMemorySize, LDS_BYTES);
        (void)hipOccupancyMaxActiveBlocksPerMultiprocessor(&per_cu, (const void*)mk_forward, NTHREADS, LDS_BYTES);
        (void)hipGetLastError();
        if (per_cu < 1) { fprintf(stderr, "kernel_launch: occupancy query says %d blocks/CU\n", per_cu); grid = -1; return; }
        grid = cus;
    }
    if (grid < 0) return;
    (void)hipMemsetAsync((char*)d_ws + WS_CTL, 0, CTL_BYTES, stream);
    Prm p{};
    for (int i = 0; i < N_IN; ++i) p.in[i] = (const float*)d_in[i];
    p.out = (float*)d_out; p.ws = (char*)d_ws;
    void* args[] = {&p};
    hipError_t e = hipLaunchCooperativeKernel((const void*)mk_forward, dim3(grid), dim3(NTHREADS), args, LDS_BYTES, stream);
    if (e != hipSuccess) fprintf(stderr, "kernel_launch: cooperative launch failed: %s (grid %d)\n", hipGetErrorString(e), grid);
}
```

```cpp
#include <hip/hip_runtime.h>
#include <cstdio>
#include <cstdint>

constexpr int D = 1024, NB = 4, S = 4096, CTX = 256, FF = 1024;
constexpr int DEPTH = 2, GRID_W = 64, NMOD = 6, NE = 16;
constexpr int NLAT = NB * S, NCTX = NB * CTX, NTOK = NLAT + NCTX;
constexpr int IN_COLS = 2416, IN_PAD = 2560;
constexpr int C_Z = 0, C_XBC = 512, C_DT = 1280, C_DQ = 1296, C_DK = 1552, C_DV = 1808, C_CQ = 2064, C_CKV = 2256, C_KR = 2384;
constexpr int MIXW = 1024;
constexpr int CAP_L = 2 * S / NE, CAP_C = 2 * CTX / NE;
constexpr int ER_MAX = 2304;
constexpr float EPS = 1e-6f;
static_assert(NB * CAP_L == 2048 && NB * CAP_C == 128, "expert row layout");

enum { I_X = 0, I_C, I_CTX, I_CCTX, I_ADAW, I_ADAB, I_NMPRE, I_NMPOST, I_NFPRE, I_NFPOST, I_WIN, I_CONVW, I_CONVB, I_ALOG, I_DTB, I_SSDD, I_SSDN,
       I_LQ1, I_LK1, I_LQ2, I_LK2, I_SUBLN, I_QNORM, I_WQUP, I_KVNORM, I_WKVUP, I_WOUT, I_RW, I_RB, I_WG, I_WU, I_WD, N_IN };
struct Prm { const float* in[N_IN]; float* out; char* ws; };

typedef unsigned short bf16_t;
constexpr size_t al256(size_t x) { return (x + 255) & ~(size_t)255; }
constexpr size_t WS_CTL = 0, CTL_BYTES = 65536;
constexpr size_t WS_MOD = WS_CTL + CTL_BYTES;
constexpr size_t WS_CTXC = al256(WS_MOD + (size_t)DEPTH * (NB + 1) * NMOD * D * 4);
constexpr size_t WS_AFF = al256(WS_CTXC + (size_t)NCTX * D * 4);
constexpr size_t WS_TOKSLOT = al256(WS_AFF + (size_t)NTOK * NE * 4);
constexpr size_t WS_SELIDX = al256(WS_TOKSLOT + (size_t)NTOK * NE * 4);
constexpr size_t WS_SELGATE = al256(WS_SELIDX + (size_t)NE * ER_MAX * 4);
constexpr size_t WS_DT = al256(WS_SELGATE + (size_t)NE * ER_MAX * 4);
constexpr int NCH = 34;
constexpr size_t WS_ROPE = al256(WS_DT + (size_t)NTOK * 16 * 4);
constexpr size_t WS_ALAST = al256(WS_ROPE + (size_t)S * 32 * 4);
constexpr size_t WS_HB = al256(WS_ALAST + (size_t)NB * 2 * NCH * 8 * 4);
constexpr size_t WS_P = al256(WS_HB + (size_t)NTOK * D * 2);
constexpr size_t WS_G2 = al256(WS_P + (size_t)NTOK * IN_COLS * 4);
constexpr size_t WS_XBC = WS_G2;
constexpr size_t WS_MQ = al256(WS_XBC + (size_t)NTOK * 768 * 4);
constexpr size_t WS_MKV = al256(WS_MQ + (size_t)NTOK * 384 * 4);
constexpr size_t WS_CQB = al256(WS_MKV + (size_t)NTOK * 512 * 4);
constexpr size_t WS_CKVB = al256(WS_CQB + (size_t)NTOK * 256 * 2);
constexpr size_t WS_MIXB = al256(WS_CKVB + (size_t)NTOK * 128 * 2);
constexpr size_t WS_G2END = al256(WS_MIXB + (size_t)NTOK * MIXW * 2);
constexpr size_t WS_HS = WS_HB;
constexpr size_t WS_YD = WS_MQ;
constexpr size_t WS_MOUT = WS_P;
constexpr size_t WS_XG = WS_P;
constexpr size_t WS_HID = al256(WS_XG + (size_t)NE * ER_MAX * D * 2);
constexpr size_t WS_Y = WS_G2;
constexpr size_t WS_WIN = WS_G2END;
constexpr size_t WS_WQ = al256(WS_WIN + (size_t)IN_PAD * D * 2);
constexpr size_t WS_WKV = al256(WS_WQ + (size_t)512 * 256 * 2);
constexpr size_t WS_WOUT = al256(WS_WKV + (size_t)512 * 128 * 2);
constexpr size_t WS_WGU = al256(WS_WOUT + (size_t)D * MIXW * 2);
constexpr size_t WS_WD = al256(WS_WGU + (size_t)NE * 2 * FF * D * 2);
constexpr size_t WS_END = al256(WS_WD + (size_t)NE * D * FF * 2);
constexpr int SK = CTX + S;
constexpr size_t WS_QD = al256(WS_P + (size_t)NTOK * IN_COLS * 2);
constexpr size_t WS_QDC = al256(WS_QD + (size_t)NB * 8 * S * 32 * 2);
constexpr size_t WS_KD = al256(WS_QDC + (size_t)NB * 8 * CTX * 32 * 2);
constexpr size_t WS_VDT = al256(WS_KD + (size_t)NB * 8 * SK * 32 * 2);
constexpr size_t WS_QM = al256(WS_VDT + (size_t)NB * 4 * 64 * SK * 2);
constexpr size_t WS_QMC = al256(WS_QM + (size_t)NB * 4 * S * 96 * 2);
constexpr size_t WS_KM = al256(WS_QMC + (size_t)NB * 4 * CTX * 96 * 2);
constexpr size_t WS_VMT = al256(WS_KM + (size_t)NB * 4 * SK * 96 * 2);
constexpr size_t WS_ATTEND = al256(WS_VMT + (size_t)NB * 4 * 64 * SK * 2);
static_assert(WS_ATTEND <= WS_G2, "attention operands fit in the spare half of the P slot");
static_assert(WS_HID + (size_t)NE * ER_MAX * FF * 2 <= WS_G2, "XG+HID fit in the P region");
static_assert((size_t)NE * ER_MAX * D * 4 <= WS_G2END - WS_G2, "Y fits in the G2 region");
static_assert((size_t)NB * 2 * NCH * 8 * 4096 * 4 <= (size_t)NTOK * D * 2, "HS fits in HB");
static_assert(WS_YD + (size_t)2 * NTOK * 512 * 4 <= WS_MIXB, "YD ends below MIXB");

#define LAS __attribute__((address_space(3)))
constexpr int NTHREADS = 512;
constexpr int LDS_BYTES = 147456;
#define ITEMS(i, n) for (int i = blockIdx.x * NTHREADS + tid; i < (n); i += gridDim.x * NTHREADS)

__device__ __forceinline__ float siluf(float x) { return x / (1.0f + expf(-x)); }
__device__ __forceinline__ float softplusf(float x) { return x > 20.f ? x : log1pf(expf(x)); }
__device__ __forceinline__ unsigned f2bf(float f) { unsigned u = __builtin_bit_cast(unsigned, f); return (u + 0x7fffu + ((u >> 16) & 1u)) >> 16; }
typedef float f32x2_t __attribute__((ext_vector_type(2)));
typedef __bf16 bf16x2_t __attribute__((ext_vector_type(2)));
__device__ __forceinline__ unsigned pk2(float lo, float hi) { const f32x2_t v = {lo, hi}; return __builtin_bit_cast(unsigned, __builtin_convertvector(v, bf16x2_t)); }
__device__ __forceinline__ float bf2f(bf16_t h) { return __builtin_bit_cast(float, (unsigned)h << 16); }
#define SCHED_FENCE() __builtin_amdgcn_sched_barrier(0)
__device__ __forceinline__ int mk_tid_impl(int wave_s) { unsigned z; asm volatile("s_mov_b32 %0, 0" : "=s"(z));
    return (wave_s << 6) | (int)__builtin_amdgcn_mbcnt_hi(~0u, __builtin_amdgcn_mbcnt_lo(~0u, z)); }
__device__ __forceinline__ float dpp_row_shr(float v, int n) {
    const int iv = __builtin_bit_cast(int, v); int r;
    switch (n) { case 1: r = __builtin_amdgcn_update_dpp(0, iv, 0x111, 0xf, 0xf, true); break; case 2: r = __builtin_amdgcn_update_dpp(0, iv, 0x112, 0xf, 0xf, true); break;
                 case 4: r = __builtin_amdgcn_update_dpp(0, iv, 0x114, 0xf, 0xf, true); break; default: r = __builtin_amdgcn_update_dpp(0, iv, 0x118, 0xf, 0xf, true); break; }
    return __builtin_bit_cast(float, r);
}
__device__ __forceinline__ float wave_sum(float v) {
    v += dpp_row_shr(v, 1); v += dpp_row_shr(v, 2); v += dpp_row_shr(v, 4); v += dpp_row_shr(v, 8);
    v += __builtin_bit_cast(float, __builtin_amdgcn_update_dpp(0, __builtin_bit_cast(int, v), 0x142, 0xa, 0xf, false));
    v += __builtin_bit_cast(float, __builtin_amdgcn_update_dpp(0, __builtin_bit_cast(int, v), 0x143, 0xc, 0xf, false));
    return __builtin_bit_cast(float, __builtin_amdgcn_readlane(__builtin_bit_cast(int, v), 63)); }
__device__ __forceinline__ float xor32_max(float x) { auto t = __builtin_amdgcn_permlane32_swap(__float_as_uint(x), __float_as_uint(x), false, false); return fmaxf(__uint_as_float(t[0]), __uint_as_float(t[1])); }
__device__ __forceinline__ float xor32_sum(float x) { auto t = __builtin_amdgcn_permlane32_swap(__float_as_uint(x), __float_as_uint(x), false, false); return __uint_as_float(t[0]) + __uint_as_float(t[1]); }
#define WITEMS(i, n) for (int i = blockIdx.x * 8 + (tid >> 6); i < (n); i += gridDim.x * 8)
__device__ __forceinline__ float4 f4mul(float4 a, float4 b) { return make_float4(a.x * b.x, a.y * b.y, a.z * b.z, a.w * b.w); }
__device__ __forceinline__ float4 f4add(float4 a, float4 b) { return make_float4(a.x + b.x, a.y + b.y, a.z + b.z, a.w + b.w); }
__device__ __forceinline__ float4 f4scale(float4 a, float s) { return make_float4(a.x * s, a.y * s, a.z * s, a.w * s); }
__device__ __forceinline__ float f4dot(float4 a, float4 b) { return a.x * b.x + a.y * b.y + a.z * b.z + a.w * b.w; }
__device__ __forceinline__ uint2 pk4(float4 v) { return make_uint2(pk2(v.x, v.y), pk2(v.z, v.w)); }
__device__ __forceinline__ float4 up4(uint2 u) { return make_float4(__uint_as_float(u.x << 16), __uint_as_float(u.x & 0xffff0000u), __uint_as_float(u.y << 16), __uint_as_float(u.y & 0xffff0000u)); }
__device__ __forceinline__ float4 ld4h(const bf16_t* p) { return up4(*(const uint2*)p); }

__device__ __forceinline__ void rope32(float* v, int t, const float* tab) {
    const float4* tp = (const float4*)(tab + (size_t)t * 32);
    float cs[32];
#pragma unroll
    for (int i = 0; i < 8; ++i) { const float4 x = tp[i]; cs[4 * i] = x.x; cs[4 * i + 1] = x.y; cs[4 * i + 2] = x.z; cs[4 * i + 3] = x.w; }
#pragma unroll
    for (int i = 0; i < 8; ++i) {
        { const float c = cs[i], sn = cs[8 + i]; const float x1 = v[i], x2 = v[8 + i]; v[i] = x1 * c - x2 * sn; v[8 + i] = x1 * sn + x2 * c; }
        { const float c = cs[16 + i], sn = cs[24 + i]; const float x1 = v[16 + i], x2 = v[24 + i]; v[16 + i] = x1 * c - x2 * sn; v[24 + i] = x1 * sn + x2 * c; }
    }
}
__device__ __forceinline__ int tok_row(bool lat, int b, int t) { return lat ? b * S + t : NLAT + b * CTX + t; }

namespace pg8 {
#define PG8_LAS __attribute__((address_space(3)))
typedef short bf16x8 __attribute__((ext_vector_type(8)));
typedef float f32x4 __attribute__((ext_vector_type(4)));
typedef unsigned u32x4 __attribute__((ext_vector_type(4)));
constexpr int BM = 256, BK = 64, HALF = 128, HTB = HALF * BK * 2  , STAGE_BYTES = 8 * HTB, NXCD = 8, WGM = 8;

__host__ __device__ __forceinline__ int lds_byte(int r, int c) { const int st = (r >> 4) * 2 + (c >> 5), rr = r & 15, cc = c & 31, ob = rr * 64 + cc * 2; return st * 1024 + (ob ^ (((ob >> 9) & 1) << 5)); }
__host__ __device__ __forceinline__ void stage_rc(int b, int& R, int& C) { const int st = b / 1024, sb = b % 1024, swz = sb ^ (((sb >> 9) & 1) << 5); R = (st >> 1) * 16 + swz / 64; C = (st & 1) * 32 + (swz % 64) / 2; }
__host__ __device__ __forceinline__ int perm32(int rho) { const int n = rho >> 4, i = rho & 15; return 8 * (i >> 2) + 4 * n + (i & 3); }

struct Unit { int pm, pn; };
struct Gemm { const bf16_t* A; const bf16_t* Bt; int M, N, K; int grp_tiles; size_t grp_stride; };

struct StaticOrder {
    int nM, nN, nwg, G, c;
    __host__ __device__ void init(int M, int N, int G_, int c_) { nM = M / BM; nN = N / BM; nwg = nM * nN; G = G_; c = c_; }
    __host__ __device__ bool next(int i, Unit& u) const {
        const long L = (long)i * G + c; if (L >= nwg) return false;
        int wgid = (int)L; { const int q = nwg / NXCD, r = nwg % NXCD, xcd = wgid % NXCD, off = wgid / NXCD; wgid = (xcd < r ? xcd * (q + 1) : r * (q + 1) + (xcd - r) * q) + off; }
        const int nig = WGM * nN, gid = wgid / nig, fm = gid * WGM, gsz = (nM - fm) < WGM ? (nM - fm) : WGM;
        u.pm = fm + ((wgid % nig) % gsz); u.pn = (wgid % nig) / gsz; return true;
    }
    __device__ __forceinline__ void a_ready(const Unit&) const {}
    __device__ __forceinline__ void done(const Unit&) const {}
};

__device__ __forceinline__ unsigned cvt_pk_bf16(float lo, float hi) { unsigned r; asm volatile("v_cvt_pk_bf16_f32 %0, %1, %2" : "=v"(r) : "v"(lo), "v"(hi)); return r; }

typedef unsigned u32x2 __attribute__((ext_vector_type(2)));
struct EpiF32 {
    static constexpr bool PERM = false, AFTER_DRAIN = false;
    float* C; int ldc; int ncols;
    __device__ __forceinline__ void operator()(const f32x4 (&acc)[2][2][4][2], const Unit& u, int wr, int wc, int fr, int fq) const {
        const int row0 = u.pm * BM + wr * 64 + fr, col0 = u.pn * BM + wc * 32 + 4 * fq;
#pragma unroll
        for (int ai = 0; ai < 2; ++ai)
#pragma unroll
            for (int m = 0; m < 4; ++m) { float* rowp = C + (size_t)(row0 + ai * HALF + m * 16) * ldc;
#pragma unroll
                for (int bj = 0; bj < 2; ++bj)
#pragma unroll
                    for (int n = 0; n < 2; ++n) { const int col = col0 + bj * HALF + n * 16; if (col < ncols) *(f32x4*)(rowp + col) = acc[ai][bj][m][n]; } }
    }
};
struct EpiRowScaleF32 {
    static constexpr bool PERM = false, AFTER_DRAIN = false;
    float* C; int ldc; const float* gate; int er;
    __device__ __forceinline__ void operator()(const f32x4 (&acc)[2][2][4][2], const Unit& u, int wr, int wc, int fr, int fq) const {
        const int row0 = u.pm * BM + wr * 64 + fr, col0 = u.pn * BM + wc * 32 + 4 * fq;
#pragma unroll
        for (int ai = 0; ai < 2; ++ai)
#pragma unroll
            for (int m = 0; m < 4; ++m) { const int row = row0 + ai * HALF + m * 16; float* rowp = C + (size_t)row * ldc; const float sc = gate[(row / er) * ER_MAX + row % er];
#pragma unroll
                for (int bj = 0; bj < 2; ++bj)
#pragma unroll
                    for (int n = 0; n < 2; ++n) *(f32x4*)(rowp + col0 + bj * HALF + n * 16) = acc[ai][bj][m][n] * sc; }
    }
};
struct EpiSwiGLU {
    static constexpr bool PERM = true, AFTER_DRAIN = false;
    bf16_t* O; int ldo;
    __device__ __forceinline__ void operator()(const f32x4 (&acc)[2][2][4][2], const Unit& u, int wr, int wc, int fr, int fq) const {
        const int row0 = u.pm * BM + wr * 64 + fr, col0 = u.pn * BM + wc * 32 + 8 * fq;
#pragma unroll
        for (int ai = 0; ai < 2; ++ai)
#pragma unroll
            for (int m = 0; m < 4; ++m) { bf16_t* rowp = O + (size_t)(row0 + ai * HALF + m * 16) * ldo;
#pragma unroll
                for (int bj = 0; bj < 2; ++bj) { const f32x4 gt = acc[ai][bj][m][0], up = acc[ai][bj][m][1]; f32x4 h;
#pragma unroll
                    for (int i = 0; i < 4; ++i) h[i] = gt[i] / (1.0f + __expf(-gt[i])) * up[i];
                    u32x2 w; w.x = cvt_pk_bf16(h[0], h[1]); w.y = cvt_pk_bf16(h[2], h[3]);
                    *(u32x2*)(rowp + (col0 + bj * HALF) / 2) = w; } }
    }
};

struct EpiBf16 {
    static constexpr bool PERM = true, AFTER_DRAIN = false;
    bf16_t* O; int ldo; int ncols;
    __device__ __forceinline__ void operator()(const f32x4 (&acc)[2][2][4][2], const Unit& u, int wr, int wc, int fr, int fq) const {
        const int row0 = u.pm * BM + wr * 64 + fr, col0 = u.pn * BM + wc * 32 + 8 * fq;
#pragma unroll
        for (int ai = 0; ai < 2; ++ai)
#pragma unroll
            for (int m = 0; m < 4; ++m) { bf16_t* rowp = O + (size_t)(row0 + ai * HALF + m * 16) * ldo;
#pragma unroll
                for (int bj = 0; bj < 2; ++bj) { const int col = col0 + bj * HALF; const f32x4 v0 = acc[ai][bj][m][0], v1 = acc[ai][bj][m][1];
                    u32x4 w; w.x = cvt_pk_bf16(v0[0], v0[1]); w.y = cvt_pk_bf16(v0[2], v0[3]); w.z = cvt_pk_bf16(v1[0], v1[1]); w.w = cvt_pk_bf16(v1[2], v1[3]);
                    if (col < ncols) *(u32x4*)(rowp + col) = w; } }
    }
};
struct EpiRowScaleBf16 {
    static constexpr bool PERM = true, AFTER_DRAIN = false;
    bf16_t* O; int ldo; const float* gate; int er;
    __device__ __forceinline__ void operator()(const f32x4 (&acc)[2][2][4][2], const Unit& u, int wr, int wc, int fr, int fq) const {
        const int row0 = u.pm * BM + wr * 64 + fr, col0 = u.pn * BM + wc * 32 + 8 * fq;
#pragma unroll
        for (int ai = 0; ai < 2; ++ai)
#pragma unroll
            for (int m = 0; m < 4; ++m) { const int row = row0 + ai * HALF + m * 16; bf16_t* rowp = O + (size_t)row * ldo; const float sc = gate[(row / er) * ER_MAX + row % er];
#pragma unroll
                for (int bj = 0; bj < 2; ++bj) { const f32x4 v0 = acc[ai][bj][m][0] * sc, v1 = acc[ai][bj][m][1] * sc;
                    u32x4 w; w.x = cvt_pk_bf16(v0[0], v0[1]); w.y = cvt_pk_bf16(v0[2], v0[3]); w.z = cvt_pk_bf16(v1[0], v1[1]); w.w = cvt_pk_bf16(v1[2], v1[3]);
                    *(u32x4*)(rowp + col0 + bj * HALF) = w; } }
    }
};
template <class Epi, class Sched, bool ALIGN_EPI = false, bool SP2 = false>
__device__ __forceinline__ void gemm_phase(PG8_LAS unsigned char* lds, const Gemm g, const Sched& S, const Epi& E, int tid_in) {
    int tid_ = tid_in; asm volatile("" : "+v"(tid_));
    const int tid = tid_, wid = __builtin_amdgcn_readfirstlane(tid >> 6), lane = tid & 63, wr = wid >> 2, wc = wid & 3, fr = lane & 15, fq = lane >> 4;
    int K_ = g.K; asm volatile("" : "+s"(K_));
    const int K = K_, nt = K / BK;
    unsigned voffA[2], voffB[2];
#pragma unroll
    for (int i = 0; i < 2; ++i) { int R, C; stage_rc(tid * 16 + i * 8192, R, C); const int Rb = Epi::PERM ? ((R & ~31) + perm32(R & 31)) : R;
        voffA[i] = (unsigned)(R * K + C) * 2u; voffB[i] = (unsigned)(Rb * K + C) * 2u; }
    const size_t kstep = (size_t)(BK * 2);
    const size_t hstep = (size_t)HALF * K * 2;
    const size_t tstep = 2 * hstep;
    const unsigned ldsw = (unsigned)wid * 1024u;
    const int aoff = lds_byte(wr * 64 + fr, fq * 8), boff = lds_byte(wc * 32 + fr, fq * 8);
#define PG8_SA(b, h) (((b) * 2 + (h)) * HTB)
#define PG8_SB(b, h) ((4 + (b) * 2 + (h)) * HTB)
#define PG8_STAGE(bufoff, gbase, voff) do { _Pragma("unroll") for (int _i = 0; _i < 2; ++_i) \
        __builtin_amdgcn_global_load_lds((const unsigned*)((const char*)(gbase) + (voff)[_i]), (PG8_LAS unsigned*)(lds + (bufoff) + ldsw + _i * 8192), 16, 0, 0); } while (0)
#define PG8_LDA(dst, b, h) do { _Pragma("unroll") for (int m = 0; m < 4; ++m) _Pragma("unroll") for (int k = 0; k < 2; ++k) dst[m][k] = *(const PG8_LAS bf16x8*)(lds + PG8_SA(b, h) + aoff + m * 2048 + k * 1024); } while (0)
#define PG8_LDB(dst, b, h) do { _Pragma("unroll") for (int n = 0; n < 2; ++n) _Pragma("unroll") for (int k = 0; k < 2; ++k) dst[n][k] = *(const PG8_LAS bf16x8*)(lds + PG8_SB(b, h) + boff + n * 2048 + k * 1024); } while (0)
#define PG8_MMA(ai, bj, At, Bt) do { __builtin_amdgcn_s_setprio(1); _Pragma("unroll") for (int m = 0; m < 4; ++m) _Pragma("unroll") for (int n = 0; n < 2; ++n) _Pragma("unroll") for (int k = 0; k < 2; ++k) \
        acc[ai][bj][m][n] = __builtin_amdgcn_mfma_f32_16x16x32_bf16(Bt[n][k], At[m][k], acc[ai][bj][m][n], 0, 0, 0); __builtin_amdgcn_s_setprio(0); } while (0)
#define PG8_WAIT_V(n) asm volatile("s_waitcnt vmcnt(" #n ")" ::: "memory")
#define PG8_WAIT_L(n) asm volatile("s_waitcnt lgkmcnt(" #n ")" ::: "memory")
#define PG8_BAR __builtin_amdgcn_s_barrier()
#define PG8_SCHED __builtin_amdgcn_sched_barrier(0)
    Unit cur, nxt; int ui = 0;
    if (!S.next(0, cur)) return;
    f32x4 acc[2][2][4][2];
#pragma unroll
    for (int a = 0; a < 2; ++a)
#pragma unroll
        for (int b = 0; b < 2; ++b)
#pragma unroll
            for (int m = 0; m < 4; ++m)
#pragma unroll
                for (int n = 0; n < 2; ++n) acc[a][b][m][n] = (f32x4){0.f, 0.f, 0.f, 0.f};
    bf16x8 At[4][2], B0[2][2], B1[2][2];
    const char* cA = (const char*)g.A + (size_t)cur.pm * tstep; const char* cB = (const char*)g.Bt + (size_t)cur.pn * tstep + (g.grp_tiles ? (size_t)(cur.pm / g.grp_tiles) * g.grp_stride : (size_t)0);
    S.a_ready(cur);
    if constexpr (SP2) {
        PG8_STAGE(PG8_SB(0, 0), cB, voffB); PG8_STAGE(PG8_SB(0, 1), cB + hstep, voffB); PG8_STAGE(PG8_SA(0, 0), cA, voffA); PG8_STAGE(PG8_SA(0, 1), cA + hstep, voffA);
        if (wr == 1) PG8_BAR;
        PG8_WAIT_V(2); PG8_BAR;
        PG8_STAGE(PG8_SB(1, 0), cB + kstep, voffB); PG8_STAGE(PG8_SA(1, 0), cA + kstep, voffA); PG8_STAGE(PG8_SB(1, 1), cB + hstep + kstep, voffB);
        PG8_WAIT_V(6); PG8_BAR;
    } else {
        PG8_STAGE(PG8_SB(0, 0), cB, voffB); PG8_STAGE(PG8_SA(0, 0), cA, voffA); PG8_STAGE(PG8_SB(0, 1), cB + hstep, voffB); PG8_STAGE(PG8_SA(0, 1), cA + hstep, voffA);
        if (wr == 1) PG8_BAR;
        PG8_WAIT_V(4); PG8_BAR;
        PG8_STAGE(PG8_SB(1, 0), cB + kstep, voffB); PG8_STAGE(PG8_SA(1, 0), cA + kstep, voffA); PG8_STAGE(PG8_SB(1, 1), cB + hstep + kstep, voffB);
        PG8_WAIT_V(6); PG8_BAR;
    }
    for (;;) {
        const bool has_next = S.next(ui + 1, nxt);
        const char* nA = has_next ? (const char*)g.A + (size_t)nxt.pm * tstep : cA; const char* nB = has_next ? (const char*)g.Bt + (size_t)nxt.pn * tstep + (g.grp_tiles ? (size_t)(nxt.pm / g.grp_tiles) * g.grp_stride : (size_t)0) : cB;
        for (int t = 0; t < nt; t += 2) {
            const bool last = (t == nt - 2);
            const char* a1 = cA + (size_t)(t + 1) * kstep;
            const char* a2 = last ? nA : cA + (size_t)(t + 2) * kstep; const char* b2 = last ? nB : cB + (size_t)(t + 2) * kstep;
            const char* a3 = a2 + kstep; const char* b3 = b2 + kstep;
            if (last && has_next) S.a_ready(nxt);
            if constexpr (SP2) {
            PG8_LDB(B0, 0, 0); PG8_LDB(B1, 0, 1); PG8_SCHED; PG8_LDA(At, 0, 0); PG8_STAGE(PG8_SA(1, 1), a1 + hstep, voffA);
            PG8_WAIT_V(8); PG8_WAIT_L(0); PG8_BAR; PG8_MMA(0, 0, At, B0); PG8_MMA(0, 1, At, B1); PG8_BAR; PG8_SCHED;
            PG8_LDA(At, 0, 1); PG8_STAGE(PG8_SB(0, 0), b2, voffB); PG8_STAGE(PG8_SB(0, 1), b2 + hstep, voffB); PG8_STAGE(PG8_SA(0, 0), a2, voffA);
            PG8_WAIT_V(8); PG8_WAIT_L(0); PG8_BAR; PG8_MMA(1, 0, At, B0); PG8_MMA(1, 1, At, B1); PG8_BAR; PG8_SCHED;
            PG8_LDB(B0, 1, 0); PG8_LDB(B1, 1, 1); PG8_SCHED; PG8_LDA(At, 1, 0); PG8_STAGE(PG8_SA(0, 1), a2 + hstep, voffA);
            PG8_WAIT_V(8); PG8_WAIT_L(0); PG8_BAR; PG8_MMA(0, 0, At, B0); PG8_MMA(0, 1, At, B1); PG8_BAR; PG8_SCHED;
            PG8_LDA(At, 1, 1); PG8_STAGE(PG8_SB(1, 0), b3, voffB); PG8_STAGE(PG8_SB(1, 1), b3 + hstep, voffB); PG8_STAGE(PG8_SA(1, 0), a3, voffA);
            PG8_WAIT_V(8); PG8_WAIT_L(0); PG8_BAR; PG8_MMA(1, 0, At, B0); PG8_MMA(1, 1, At, B1); PG8_BAR; PG8_SCHED;
            } else {
            PG8_LDB(B0, 0, 0); PG8_SCHED; PG8_LDA(At, 0, 0); PG8_STAGE(PG8_SA(1, 1), a1 + hstep, voffA);
            PG8_WAIT_L(8); PG8_BAR; PG8_WAIT_L(0); PG8_MMA(0, 0, At, B0); PG8_BAR; PG8_SCHED;
            PG8_LDB(B1, 0, 1); PG8_STAGE(PG8_SB(0, 0), b2, voffB);
            PG8_BAR; PG8_WAIT_L(0); PG8_MMA(0, 1, At, B1); PG8_BAR;
            PG8_LDA(At, 0, 1); PG8_STAGE(PG8_SA(0, 0), a2, voffA);
            PG8_BAR; PG8_WAIT_L(0); PG8_MMA(1, 0, At, B0); PG8_BAR; PG8_SCHED;
            PG8_STAGE(PG8_SB(0, 1), b2 + hstep, voffB);
            PG8_WAIT_V(6); PG8_BAR; PG8_MMA(1, 1, At, B1); PG8_BAR;
            PG8_LDB(B0, 1, 0); PG8_SCHED; PG8_LDA(At, 1, 0); PG8_STAGE(PG8_SA(0, 1), a2 + hstep, voffA);
            PG8_WAIT_L(8); PG8_BAR; PG8_WAIT_L(0); PG8_MMA(0, 0, At, B0); PG8_BAR; PG8_SCHED;
            PG8_LDB(B1, 1, 1); PG8_STAGE(PG8_SB(1, 0), b3, voffB);
            PG8_BAR; PG8_WAIT_L(0); PG8_MMA(0, 1, At, B1); PG8_BAR;
            PG8_LDA(At, 1, 1); PG8_STAGE(PG8_SA(1, 0), a3, voffA);
            PG8_BAR; PG8_WAIT_L(0); PG8_MMA(1, 0, At, B0); PG8_BAR; PG8_SCHED;
            PG8_STAGE(PG8_SB(1, 1), b3 + hstep, voffB);
            PG8_WAIT_V(6); PG8_BAR; PG8_MMA(1, 1, At, B1); PG8_BAR;
            }
        }
        if constexpr (ALIGN_EPI) { if (wr == 0) PG8_BAR; }
        if constexpr (!Epi::AFTER_DRAIN) { E(acc, cur, wr, wc, fr, fq); S.done(cur); }
        if (!has_next) break;
#pragma unroll
        for (int a = 0; a < 2; ++a)
#pragma unroll
            for (int b = 0; b < 2; ++b)
#pragma unroll
                for (int m = 0; m < 4; ++m)
#pragma unroll
                    for (int n = 0; n < 2; ++n) acc[a][b][m][n] = (f32x4){0.f, 0.f, 0.f, 0.f};
        cur = nxt; cA = nA; cB = nB; ++ui;
        if constexpr (ALIGN_EPI) { if (wr == 1) PG8_BAR; }
    }
    PG8_WAIT_V(0);
    if constexpr (!ALIGN_EPI) { if (wr == 0) PG8_BAR; }
    PG8_BAR;
    if constexpr (Epi::AFTER_DRAIN) { E.fused(acc, cur, wr, wc, fr, fq, lds, wid, lane); S.done(cur); }
#undef PG8_SA
#undef PG8_SB
#undef PG8_STAGE
#undef PG8_LDA
#undef PG8_LDB
#undef PG8_MMA
#undef PG8_WAIT_V
#undef PG8_WAIT_L
#undef PG8_BAR
#undef PG8_SCHED
}
}


#define XB_TMO      128
#define XB_XCNT(j)  (256  + 64 * (j))
#define XB_XSUB(j)  (1280 + 64 * (j))
#define XB_XGEN(j)  (2304 + 64 * (j))
#define XB_TOP      3328
#define XB_TOPGEN   3392
#define XCD_BAR_WORDS 3456
#define XB_SPIN_CAP (1u << 22)
__device__ __forceinline__ unsigned xb_ld(unsigned* p)              { return __hip_atomic_load(p, __ATOMIC_RELAXED, __HIP_MEMORY_SCOPE_AGENT); }
__device__ __forceinline__ unsigned xb_add(unsigned* p, unsigned v) { return __hip_atomic_fetch_add(p, v, __ATOMIC_RELAXED, __HIP_MEMORY_SCOPE_AGENT); }
__device__ __forceinline__ unsigned xb_xcc_id() { return (unsigned)__builtin_amdgcn_s_getreg((3 << 11) | 20) & 0xFu; }
#define XB_SPIN(cond, bar) do { unsigned _sp = 0; while (cond) { __builtin_amdgcn_s_sleep(1); \
    if ((++_sp & 255u) == 0u) { if (xb_ld(&(bar)[XB_TMO])) break; if (_sp > XB_SPIN_CAP) { atomicAdd(&(bar)[XB_TMO], 1u); break; } } } } while (0)
struct XcdBarrier { unsigned* bar; unsigned x; volatile LAS unsigned* st; };
__device__ __forceinline__ XcdBarrier xcd_barrier_post(unsigned* bar, volatile LAS unsigned* st, int tid_in) {
    XcdBarrier b; b.bar = bar; b.x = xb_xcc_id(); b.st = st;
    if (tid_in == 0) (void)xb_add(&bar[XB_XCNT(b.x)], 1u);
    return b;
}
__device__ __forceinline__ void xcd_barrier_complete(unsigned* bar, unsigned x, unsigned& nloc, unsigned& nx) {
    const unsigned G = gridDim.x * gridDim.y * gridDim.z;
    unsigned sum, cnt, mine, sp = 0u;
    for (;;) {
        sum = 0u; cnt = 0u; mine = 0u;
#pragma unroll
        for (unsigned j = 0; j < 16; ++j) { const unsigned c = xb_ld(&bar[XB_XCNT(j)]); sum += c; cnt += (c > 0u) ? 1u : 0u; mine = (j == x) ? c : mine; }
        if (sum == G) break;
        __builtin_amdgcn_s_sleep(1);
        if ((++sp & 255u) == 0u) { if (xb_ld(&bar[XB_TMO])) break; if (sp > XB_SPIN_CAP) { atomicAdd(&bar[XB_TMO], 1u); break; } }
    }
    nloc = mine > 0u ? mine : 1u; nx = cnt > 0u ? cnt : 1u;
}
__device__ __forceinline__ void xcd_barrier(const XcdBarrier& b, int tid_in) {
    asm volatile("s_waitcnt vmcnt(0)" ::: "memory");
    __syncthreads();
    if (tid_in == 0) {
        unsigned* bar = b.bar;
        __builtin_amdgcn_s_waitcnt(0);
        unsigned nloc = b.st[0], nx = b.st[1];
        if (nloc == 0u) { xcd_barrier_complete(bar, b.x, nloc, nx); b.st[0] = nloc; b.st[1] = nx; }
        const unsigned old = xb_add(&bar[XB_XSUB(b.x)], 1u);
        const unsigned gen = old / nloc;
        if (old + 1u == (gen + 1u) * nloc) {
            __builtin_amdgcn_fence(__ATOMIC_RELEASE, "agent");
            asm volatile("s_waitcnt vmcnt(0)" ::: "memory");
            const unsigned og = xb_add(&bar[XB_TOP], 1u);
            const unsigned tg = og / nx;
            if (og + 1u == (tg + 1u) * nx) xb_add(&bar[XB_TOPGEN], 1u);
            else XB_SPIN(xb_ld(&bar[XB_TOPGEN]) == tg, bar);
            __builtin_amdgcn_fence(__ATOMIC_ACQUIRE, "agent");
            xb_add(&bar[XB_XGEN(b.x)], 1u);
            asm volatile("s_waitcnt vmcnt(0)" ::: "memory");
        } else {
            XB_SPIN(xb_ld(&bar[XB_XGEN(b.x)]) == gen, bar);
            __builtin_amdgcn_fence(__ATOMIC_ACQUIRE, "agent");
            asm volatile("s_waitcnt vmcnt(0)" ::: "memory");
        }
    }
    __syncthreads();
}


typedef short bf16x8 __attribute__((ext_vector_type(8)));
typedef short s16x4 __attribute__((ext_vector_type(4)));
typedef float f32x16 __attribute__((ext_vector_type(16)));
typedef unsigned v4u __attribute__((ext_vector_type(4)));
typedef unsigned v2u __attribute__((ext_vector_type(2)));
constexpr float ATT_THR = 5.0f;
template <int DK> struct AttL { static constexpr int KSTR = DK * 2 + 16, KBYTES = 64 * KSTR, VSTR = 136, VBYTES = 64 * VSTR, KCH = 64 * DK / 8, KPT = (KCH + NTHREADS - 1) / NTHREADS;
    static constexpr int K_OFF = 0, V_OFF = 2 * KBYTES; };

template <int DK>
__device__ __forceinline__ void attn_pass(const bf16_t* Qrow, const bf16_t* Kp, const bf16_t* Vtp, int vt_ld, int nkt, LAS unsigned char* lds, int tid, f32x16 (&oacc)[2], float& l_run) {
    typedef AttL<DK> L;
    constexpr bool AUG = DK <= 32;
    const int lane = tid & 63, r = lane & 31, h = lane >> 5;
    bf16x8 qf[DK / 16];
#pragma unroll
    for (int ks = 0; ks < DK / 16; ++ks) qf[ks] = *(const bf16x8*)(Qrow + 16 * ks + 8 * h);
    const short z_ = (short)(tid >> 20);
    bf16x8 aone = {z_, z_, z_, z_, z_, z_, z_, z_}, bneg = {z_, z_, z_, z_, z_, z_, z_, z_};
    if (h == 0) aone[0] = (short)0x3F80;
    float m_run = 0.f;
    v4u kreg[L::KPT]; v4u vreg;
    const int vd = tid >> 3, vpart = tid & 7;
#define ATT_LOADK(j) do { _Pragma("unroll") for (int i_ = 0; i_ < L::KPT; ++i_) { const int c_ = tid + i_ * NTHREADS; if (c_ < L::KCH) kreg[i_] = *(const v4u*)(Kp + (size_t)(j) * 64 * DK + c_ * 8); } } while (0)
#define ATT_LOADV(j) do { vreg = *(const v4u*)(Vtp + (size_t)vd * vt_ld + (j) * 64 + vpart * 8); } while (0)
#define ATT_STOREK(buf) do { _Pragma("unroll") for (int i_ = 0; i_ < L::KPT; ++i_) { const int c_ = tid + i_ * NTHREADS; if (c_ < L::KCH) { const int key_ = c_ / (DK / 8), part_ = c_ % (DK / 8); \
            *(LAS v4u*)(lds + L::K_OFF + (buf) * L::KBYTES + key_ * L::KSTR + part_ * 16) = kreg[i_]; } } } while (0)
#define ATT_STOREV(buf) do { LAS unsigned char* vp_ = lds + L::V_OFF + (buf) * L::VBYTES + vd * L::VSTR + vpart * 16; *(LAS v2u*)vp_ = (v2u){vreg.x, vreg.y}; *(LAS v2u*)(vp_ + 8) = (v2u){vreg.z, vreg.w}; } while (0)
#define ATT_QK(dst, buf) do { _Pragma("unroll") for (int kb = 0; kb < 2; ++kb) { _Pragma("unroll") for (int i = 0; i < 16; ++i) dst[kb][i] = 0.f; \
        if (AUG) dst[kb] = __builtin_amdgcn_mfma_f32_32x32x16_bf16(aone, bneg, dst[kb], 0, 0, 0); \
        _Pragma("unroll") for (int ks = 0; ks < DK / 16; ++ks) { const bf16x8 a_ = *(const LAS bf16x8*)(lds + L::K_OFF + (buf) * L::KBYTES + (32 * kb + r) * L::KSTR + (16 * ks + 8 * h) * 2); \
            dst[kb] = __builtin_amdgcn_mfma_f32_32x32x16_bf16(a_, qf[ks], dst[kb], 0, 0, 0); } } } while (0)
#define ATT_BODY(SC, SN, j) do { \
        if ((j) + 2 < nkt) ATT_LOADK((j) + 2); \
        if ((j) + 1 < nkt) { ATT_LOADV((j) + 1); ATT_QK(SN, ((j) + 1) & 1); } \
        if (((j) & 3) == 0) { \
            float t0 = fmaxf(fmaxf(SC[0][0], SC[0][1]), SC[0][2]), t1 = fmaxf(fmaxf(SC[0][3], SC[0][4]), SC[0][5]), t2 = fmaxf(fmaxf(SC[0][6], SC[0][7]), SC[0][8]), t3 = fmaxf(fmaxf(SC[0][9], SC[0][10]), SC[0][11]); \
            float t4 = fmaxf(fmaxf(SC[0][12], SC[0][13]), SC[0][14]), t5 = fmaxf(fmaxf(SC[0][15], SC[1][0]), SC[1][1]), t6 = fmaxf(fmaxf(SC[1][2], SC[1][3]), SC[1][4]), t7 = fmaxf(fmaxf(SC[1][5], SC[1][6]), SC[1][7]); \
            float t8 = fmaxf(fmaxf(SC[1][8], SC[1][9]), SC[1][10]), t9 = fmaxf(fmaxf(SC[1][11], SC[1][12]), SC[1][13]), t10 = fmaxf(SC[1][14], SC[1][15]); \
            float tmax = fmaxf(fmaxf(fmaxf(fmaxf(t0, t1), t2), fmaxf(fmaxf(t3, t4), t5)), fmaxf(fmaxf(fmaxf(t6, t7), t8), fmaxf(t9, t10))); \
            tmax = xor32_max(tmax); if (!AUG) tmax -= m_run;            \
            if ((j) == 0 || __any(tmax > ATT_THR)) {                   \
                const float want = (j) == 0 ? tmax : m_run + fmaxf(tmax, 0.f); \
                const float mn = __uint_as_float(pk2(want, 0.f) << 16), dlt = mn - m_run, alpha = __builtin_amdgcn_exp2f(-dlt); \
                _Pragma("unroll") for (int i = 0; i < 16; ++i) { oacc[0][i] *= alpha; oacc[1][i] *= alpha; if (AUG) { SC[0][i] -= dlt; SC[1][i] -= dlt; SN[0][i] -= dlt; SN[1][i] -= dlt; } } \
                l_run *= alpha; m_run = mn; if (AUG && h == 0) bneg[0] = (short)(__float_as_uint(-mn) >> 16); \
            } \
        } \
        float ps0 = 0.f, ps1 = 0.f, ps2 = 0.f, ps3 = 0.f; \
        _Pragma("unroll") for (int kb = 0; kb < 2; ++kb) \
            _Pragma("unroll") for (int i = 0; i < 16; i += 4) { const float mo = AUG ? 0.f : m_run; const float p0 = __builtin_amdgcn_exp2f(SC[kb][i] - mo), p1 = __builtin_amdgcn_exp2f(SC[kb][i + 1] - mo), p2 = __builtin_amdgcn_exp2f(SC[kb][i + 2] - mo), p3 = __builtin_amdgcn_exp2f(SC[kb][i + 3] - mo); \
                SC[kb][i] = p0; SC[kb][i + 1] = p1; SC[kb][i + 2] = p2; SC[kb][i + 3] = p3; ps0 += p0; ps1 += p1; ps2 += p2; ps3 += p3; } \
        l_run += (ps0 + ps1) + (ps2 + ps3); \
        _Pragma("unroll") for (int kb = 0; kb < 2; ++kb) \
            _Pragma("unroll") for (int s2 = 0; s2 < 2; ++s2) { \
                union { bf16x8 v; unsigned u[4]; } pf; \
                _Pragma("unroll") for (int i = 0; i < 4; ++i) pf.u[i] = pk2(SC[kb][8 * s2 + 2 * i], SC[kb][8 * s2 + 2 * i + 1]); \
                _Pragma("unroll") for (int db = 0; db < 2; ++db) { \
                    const LAS unsigned char* vp = lds + L::V_OFF + ((j) & 1) * L::VBYTES + (32 * db + r) * L::VSTR + (32 * kb + 16 * s2 + 4 * h) * 2; \
                    union { bf16x8 v; v2u u[2]; } af; af.u[0] = *(const LAS v2u*)vp; af.u[1] = *(const LAS v2u*)(vp + 16); \
                    oacc[db] = __builtin_amdgcn_mfma_f32_32x32x16_bf16(af.v, pf.v, oacc[db], 0, 0, 0); } } \
        if ((j) + 2 < nkt) ATT_STOREK((j) & 1);               \
        if ((j) + 1 < nkt) ATT_STOREV(((j) + 1) & 1);         \
        __syncthreads(); \
    } while (0)
    __syncthreads();
    ATT_LOADK(0); ATT_LOADV(0); ATT_STOREK(0); ATT_STOREV(0);
    if (nkt > 1) { ATT_LOADK(1); ATT_STOREK(1); }
    __syncthreads();
    f32x16 sa[2], sb[2];
#pragma unroll
    for (int i = 0; i < 16; ++i) { sb[0][i] = (float)z_; sb[1][i] = (float)z_; }
    ATT_QK(sa, 0);
    for (int j = 0; j < nkt; j += 2) {
        ATT_BODY(sa, sb, j);
        if (j + 1 < nkt) ATT_BODY(sb, sa, j + 1);
    }
#undef ATT_BODY
#undef ATT_LOADK
#undef ATT_LOADV
#undef ATT_STOREK
#undef ATT_STOREV
#undef ATT_QK
}


constexpr int SLD = 65, SHLD = 72, XTLD = 132;
__device__ __forceinline__ int rm32(int t, int h) { return (t & 3) + 8 * (t >> 2) + 4 * h; }
template <bool WITH_Y>
__device__ __forceinline__ void ssd_block(int b, int dir, int k, int hp, const bf16_t* xbc, const float* dtp, const float* alog, float* hs, float* alast, bf16_t* yd, float* lds, int tid) {
    const bool lat = k >= 2; const int c = lat ? (dir ? 33 - k : k - 2) : (dir ? 1 - k : k);
    const int row0 = tok_row(lat, b, c * 128), g = hp >> 1;
    float* sB = lds; bf16_t* sBh = (bf16_t*)lds; bf16_t* sCh = sBh + 128 * SHLD;
    float* sX = WITH_Y ? lds + (2 * 128 * SHLD * 2) / 4 : sB + 128 * SLD; bf16_t* sXT = (bf16_t*)sX;
    float* sDT = sX + 128 * 128; float* sCum = sDT + 256; float* sW = sCum + 256; float* sSc = sW + 256;
    const int wave = tid >> 6, lane = tid & 63, r = lane & 31, h = lane >> 5, hl = wave >> 2, head = 2 * hp + hl;
    float* hsp = hs + (((size_t)(b * 2 + dir) * NCH + k) * 8 + head) * 4096;
    union { bf16x8 v; unsigned u[4]; } hfrag[WITH_Y ? 8 : 1];
    if (WITH_Y) {
#pragma unroll
        for (int Pb = 0; Pb < 2; ++Pb)
#pragma unroll
            for (int ks = 0; ks < 4; ++ks) { const float4 x0 = *(const float4*)(hsp + (32 * Pb + r) * 64 + 16 * ks + 8 * h), x1 = *(const float4*)(hsp + (32 * Pb + r) * 64 + 16 * ks + 8 * h + 4);
                hfrag[Pb * 4 + ks].u[0] = pk2(x0.x, x0.y); hfrag[Pb * 4 + ks].u[1] = pk2(x0.z, x0.w); hfrag[Pb * 4 + ks].u[2] = pk2(x1.x, x1.y); hfrag[Pb * 4 + ks].u[3] = pk2(x1.z, x1.w); }
    }
    uint2 vb[8]; float4 vx[8]; float dx[8]; float dtv = 0.f, dav = 0.f;
#pragma unroll
    for (int u = 0; u < 8; ++u) { const int i = tid + u * NTHREADS, t = i >> 5, c4 = i & 31;
        vb[u] = *(const uint2*)(xbc + (size_t)(row0 + t) * 768 + 512 + (c4 >> 4) * 128 + g * 64 + (c4 & 15) * 4);
        vx[u] = ld4h(xbc + (size_t)(row0 + t) * 768 + hp * 128 + c4 * 4);
        dx[u] = dtp[(size_t)(row0 + t) * 16 + dir * 8 + 2 * hp + (c4 >> 4)]; }
    if (tid < 256) { const int hl = tid >> 7, t = tid & 127, h = 2 * hp + hl; dtv = dtp[(size_t)(row0 + t) * 16 + dir * 8 + h]; dav = dtv * -expf(alog[dir * 8 + h]); }
    __syncthreads();
#pragma unroll
    for (int u = 0; u < 8; ++u) { const int i = tid + u * NTHREADS, t = i >> 5, c4 = i & 31;
        if (WITH_Y) *(uint2*)((c4 >> 4 ? sCh : sBh) + t * SHLD + (c4 & 15) * 4) = vb[u];
        else if (!(c4 >> 4)) { const float4 f = up4(vb[u]); float* d = sB + t * SLD + (c4 & 15) * 4; d[0] = f.x; d[1] = f.y; d[2] = f.z; d[3] = f.w; }
        if (WITH_Y) { const float4 xs = f4scale(vx[u], dx[u]); sXT[(c4 * 4 + 0) * XTLD + t] = (bf16_t)(pk2(xs.x, 0.f)); sXT[(c4 * 4 + 1) * XTLD + t] = (bf16_t)(pk2(xs.y, 0.f)); sXT[(c4 * 4 + 2) * XTLD + t] = (bf16_t)(pk2(xs.z, 0.f)); sXT[(c4 * 4 + 3) * XTLD + t] = (bf16_t)(pk2(xs.w, 0.f)); }
        else *(float4*)(sX + t * 128 + c4 * 4) = f4scale(vx[u], dx[u]); }
    if (tid < 256) { const int t = tid & 127; sSc[(tid & 128) + (dir ? 127 - t : t)] = dav; }
    __syncthreads();
    for (int off = 1; off < 128; off <<= 1) { float v = 0.f; const int sI = tid & 127;
        if (tid < 256) { v = sSc[tid]; if (sI >= off) v += sSc[tid - off]; }
        __syncthreads(); if (tid < 256) sSc[tid] = v; __syncthreads(); }
    if (tid < 256) { const int hl = tid >> 7, sI = tid & 127, t = dir ? 127 - sI : sI; const float cu = sSc[tid], tot = sSc[hl * 128 + 127];
        sCum[hl * 128 + t] = cu; sW[hl * 128 + t] = expf(tot - cu);
        if (!WITH_Y && sI == 127) alast[((size_t)(b * 2 + dir) * NCH + k) * 8 + 2 * hp + hl] = tot; }
    __syncthreads();
    if (WITH_Y) {
        const int I = hl ? 3 - (wave & 3) : (wave & 3), ti = 32 * I + r;
        const float cum_i = sCum[hl * 128 + ti];
        f32x16 Y[2], Yo[2];
#pragma unroll
        for (int i = 0; i < 16; ++i) { Y[0][i] = 0.f; Y[1][i] = 0.f; Yo[0][i] = 0.f; Yo[1][i] = 0.f; }
        bf16x8 cfrag[4];
#pragma unroll
        for (int ks = 0; ks < 4; ++ks) cfrag[ks] = *(const bf16x8*)(sCh + (32 * I + r) * SHLD + 16 * ks + 8 * h);
#pragma unroll
        for (int Pb = 0; Pb < 2; ++Pb)
#pragma unroll
            for (int ks = 0; ks < 4; ++ks) Yo[Pb] = __builtin_amdgcn_mfma_f32_32x32x16_bf16(hfrag[Pb * 4 + ks].v, cfrag[ks], Yo[Pb], 0, 0, 0);
        const int J0 = dir ? I : 0, J1 = dir ? 3 : I;
        for (int J = J0; J <= J1; ++J) {
            f32x16 Gt;
#pragma unroll
            for (int i = 0; i < 16; ++i) Gt[i] = 0.f;
#pragma unroll
            for (int ks = 0; ks < 4; ++ks) Gt = __builtin_amdgcn_mfma_f32_32x32x16_bf16(*(const bf16x8*)(sBh + (32 * J + r) * SHLD + 16 * ks + 8 * h), cfrag[ks], Gt, 0, 0, 0);
#pragma unroll
            for (int t = 0; t < 16; ++t) { const int tj = 32 * J + rm32(t, h); const bool valid = (J != I) || (dir ? tj >= ti : tj <= ti);
                Gt[t] *= valid ? __expf(cum_i - sCum[hl * 128 + tj]) : 0.f; }
#pragma unroll
            for (int s2 = 0; s2 < 2; ++s2) {
                union { bf16x8 v; unsigned u[4]; } pf;
#pragma unroll
                for (int i = 0; i < 4; ++i) pf.u[i] = pk2(Gt[8 * s2 + 2 * i], Gt[8 * s2 + 2 * i + 1]);
#pragma unroll
                for (int Pb = 0; Pb < 2; ++Pb) {
                    const bf16_t* xp = sXT + (hl * 64 + 32 * Pb + r) * XTLD + 32 * J + 16 * s2 + 4 * h;
                    union { bf16x8 v; uint2 u[2]; } af; af.u[0] = *(const uint2*)xp; af.u[1] = *(const uint2*)(xp + 8);
                    Y[Pb] = __builtin_amdgcn_mfma_f32_32x32x16_bf16(af.v, pf.v, Y[Pb], 0, 0, 0);
                }
            }
        }
        const float ei = __expf(cum_i);
        bf16_t* yrow = yd + ((size_t)dir * NTOK + row0 + ti) * 512 + head * 64;
#pragma unroll
        for (int Pb = 0; Pb < 2; ++Pb)
#pragma unroll
            for (int tq = 0; tq < 4; ++tq)
                *(uint2*)(yrow + 32 * Pb + 8 * tq + 4 * h) = pk4(make_float4(Y[Pb][4 * tq] + ei * Yo[Pb][4 * tq], Y[Pb][4 * tq + 1] + ei * Yo[Pb][4 * tq + 1], Y[Pb][4 * tq + 2] + ei * Yo[Pb][4 * tq + 2], Y[Pb][4 * tq + 3] + ei * Yo[Pb][4 * tq + 3]));
    } else {
        const int Pb = (wave >> 1) & 1, Nb = wave & 1;
        f32x16 acc;
#pragma unroll
        for (int i = 0; i < 16; ++i) acc[i] = 0.f;
#pragma unroll 8
        for (int ks = 0; ks < 64; ++ks) { const int j = 2 * ks + h;
            acc = __builtin_amdgcn_mfma_f32_32x32x2f32(sX[j * 128 + hl * 64 + 32 * Pb + r] * sW[hl * 128 + j], sB[j * SLD + 32 * Nb + r], acc, 0, 0, 0); }
#pragma unroll
        for (int t = 0; t < 16; ++t) hsp[(32 * Pb + rm32(t, h)) * 64 + 32 * Nb + r] = acc[t];
    }
}

template <class RM>
__device__ __forceinline__ void cvt_tile(const float* src, int N, bf16_t* dst, int ldd, RM rowmap, int k0, int n0, int lane) {
    const int n = n0 + lane;
    if (n < N) {
        const float* sp = src + (size_t)k0 * N + n;
        float v[32];
#pragma unroll
        for (int kk = 0; kk < 32; ++kk) v[kk] = sp[(size_t)kk * N];
        uint4* dp = (uint4*)(dst + (size_t)rowmap(n) * ldd + k0);
#pragma unroll
        for (int i = 0; i < 4; ++i) dp[i] = make_uint4(pk2(v[8 * i], v[8 * i + 1]), pk2(v[8 * i + 2], v[8 * i + 3]), pk2(v[8 * i + 4], v[8 * i + 5]), pk2(v[8 * i + 6], v[8 * i + 7]));
    }
}
__device__ __forceinline__ int block_excl_scan(int v, int tid, volatile int* sh, int& total) {
    const int lane = tid & 63, wave = tid >> 6; int x = v;
    x += __builtin_amdgcn_update_dpp(0, x, 0x111, 0xf, 0xf, true); x += __builtin_amdgcn_update_dpp(0, x, 0x112, 0xf, 0xf, true);
    x += __builtin_amdgcn_update_dpp(0, x, 0x114, 0xf, 0xf, true); x += __builtin_amdgcn_update_dpp(0, x, 0x118, 0xf, 0xf, true);
    x += __builtin_amdgcn_update_dpp(0, x, 0x142, 0xa, 0xf, false); x += __builtin_amdgcn_update_dpp(0, x, 0x143, 0xc, 0xf, false);
    __syncthreads();
    if (lane == 63) sh[wave] = x;
    __syncthreads();
    int off = 0, tot = 0;
#pragma unroll
    for (int w = 0; w < 8; ++w) { const int c = sh[w]; tot += c; if (w < wave) off += c; }
    total = tot;
    return off + x - v;
}
__device__ __forceinline__ int block_sum(int v, int tid, volatile int* sh, int parity) {
    const int lane = tid & 63, wave = tid >> 6;
    v += __builtin_amdgcn_update_dpp(0, v, 0x111, 0xf, 0xf, true); v += __builtin_amdgcn_update_dpp(0, v, 0x112, 0xf, 0xf, true);
    v += __builtin_amdgcn_update_dpp(0, v, 0x114, 0xf, 0xf, true); v += __builtin_amdgcn_update_dpp(0, v, 0x118, 0xf, 0xf, true);
    v += __builtin_amdgcn_update_dpp(0, v, 0x142, 0xa, 0xf, false); v += __builtin_amdgcn_update_dpp(0, v, 0x143, 0xc, 0xf, false);
    if (lane == 63) sh[parity * 8 + wave] = v;
    __syncthreads();
    int tot = 0;
#pragma unroll
    for (int w = 0; w < 8; ++w) tot += sh[parity * 8 + w];
    return tot;
}

#define MOD ((float*)(kp_->ws + WS_MOD))
#define CTXC ((float*)(kp_->ws + WS_CTXC))
#define AFF ((float*)(kp_->ws + WS_AFF))
#define TOKSLOT ((int*)(kp_->ws + WS_TOKSLOT))
#define SELIDX ((int*)(kp_->ws + WS_SELIDX))
#define SELGATE ((float*)(kp_->ws + WS_SELGATE))
#define DT ((float*)(kp_->ws + WS_DT))
#define HB ((bf16_t*)(kp_->ws + WS_HB))
#define HS ((float*)(kp_->ws + WS_HS))
#define YD ((bf16_t*)(kp_->ws + WS_YD))
#define ALAST ((float*)(kp_->ws + WS_ALAST))
#define ROPE ((float*)(kp_->ws + WS_ROPE))
#define PB ((bf16_t*)(kp_->ws + WS_P))
#define XBC ((bf16_t*)(kp_->ws + WS_XBC))
#define MQ ((bf16_t*)(kp_->ws + WS_MQ))
#define MKV ((bf16_t*)(kp_->ws + WS_MKV))
#define CQB ((bf16_t*)(kp_->ws + WS_CQB))
#define CKVB ((bf16_t*)(kp_->ws + WS_CKVB))
#define MIXB ((bf16_t*)(kp_->ws + WS_MIXB))
#define MOUT ((bf16_t*)(kp_->ws + WS_MOUT))
#define XG ((bf16_t*)(kp_->ws + WS_XG))
#define HID ((bf16_t*)(kp_->ws + WS_HID))
#define Y ((bf16_t*)(kp_->ws + WS_Y))
#define WIN_T ((bf16_t*)(kp_->ws + WS_WIN))
#define WQ_T ((bf16_t*)(kp_->ws + WS_WQ))
#define WKV_T ((bf16_t*)(kp_->ws + WS_WKV))
#define WOUT_T ((bf16_t*)(kp_->ws + WS_WOUT))
#define WGU_T ((bf16_t*)(kp_->ws + WS_WGU))
#define WD_T ((bf16_t*)(kp_->ws + WS_WD))
#define QD ((bf16_t*)(kp_->ws + WS_QD))
#define QDC ((bf16_t*)(kp_->ws + WS_QDC))
#define KD ((bf16_t*)(kp_->ws + WS_KD))
#define VDT ((bf16_t*)(kp_->ws + WS_VDT))
#define QM ((bf16_t*)(kp_->ws + WS_QM))
#define QMC ((bf16_t*)(kp_->ws + WS_QMC))
#define KM ((bf16_t*)(kp_->ws + WS_KM))
#define VMT ((bf16_t*)(kp_->ws + WS_VMT))
#define xcur (kp_->out)
#define XSRC (l == 0 ? kp_->in[I_X] : (const float*)kp_->out)
#define CSRC (l == 0 ? kp_->in[I_CTX] : (const float*)CTXC)
#define DTMP XBC
#define modl (MOD + (size_t)l * (NB + 1) * NMOD * D)
typedef const __attribute__((address_space(4))) Prm* KPrm;
#define PHASE_BEGIN() KPrm kp_ = (KPrm)__builtin_amdgcn_kernarg_segment_ptr(); asm volatile("" : "+s"(kp_)); int tid = MK_TID(); asm volatile("" : "+v"(tid)); (void)tid
#define GSYNC() do { XcdBarrier b_; b_.bar = (unsigned*)(kp_->ws + WS_CTL); b_.x = xb_xcc_id(); b_.st = (volatile LAS unsigned*)(ldsb + LDS_BYTES - 64); xcd_barrier(b_, tid); } while (0)
#define CVT_MOE_RANGE(LW, ID0, ID1, SLOT, NSLOTS) do { const int lane_ = tid & 63; \
        for (int id = (ID0) + (SLOT); id < (ID1); id += (NSLOTS)) { \
            const int mat = id >> 9, tl = id & 511, e = mat / 3, which = mat % 3, k0 = (tl >> 4) * 32, n0 = (tl & 15) * 64; \
            if (which == 0) cvt_tile(kp_->in[I_WG] + ((size_t)(LW) * NE + e) * D * FF, FF, WGU_T + (size_t)e * 2 * FF * D, D, [](int n) { return (n >> 2) * 8 + (n & 3); }, k0, n0, lane_); \
            else if (which == 1) cvt_tile(kp_->in[I_WU] + ((size_t)(LW) * NE + e) * D * FF, FF, WGU_T + (size_t)e * 2 * FF * D, D, [](int n) { return (n >> 2) * 8 + 4 + (n & 3); }, k0, n0, lane_); \
            else cvt_tile(kp_->in[I_WD] + ((size_t)(LW) * NE + e) * FF * D, D, WD_T + (size_t)e * D * FF, FF, [](int n) { return n; }, k0, n0, lane_); } } while (0)
constexpr int MOE_TILES = NE * 3 * 512;
constexpr int CVT_PER_WAVE = 4;
__global__ void __launch_bounds__(NTHREADS, 2) mk_forward(Prm p) {
    extern __shared__ __attribute__((aligned(16))) unsigned char lds_raw[];
    LAS unsigned char* const ldsb = (LAS unsigned char*)lds_raw;
    volatile LAS unsigned* st = (volatile LAS unsigned*)(ldsb + LDS_BYTES - 64);
    const int wave_s = __builtin_amdgcn_readfirstlane((int)threadIdx.x >> 6);
#define MK_TID() mk_tid_impl(wave_s)
    if (MK_TID() < 16) st[MK_TID()] = 0u;
    __syncthreads();
    (void)xcd_barrier_post((unsigned*)(p.ws + WS_CTL), st, MK_TID());
    const int G = gridDim.x, bid = blockIdx.x;
    const int vcu = (G % 8 == 0) ? (bid % 8) * (G / 8) + bid / 8 : bid;

    {
        PHASE_BEGIN();
        const float* c = kp_->in[I_C]; const float* cc = kp_->in[I_CCTX]; const float* adaw = kp_->in[I_ADAW]; const float* adab = kp_->in[I_ADAB];
        float* sc_l = (float*)lds_raw;
        for (int i = tid; i < (NB + 1) * D; i += NTHREADS) { const int r = i / D, k = i % D; sc_l[i] = siluf(r < NB ? c[(size_t)r * D + k] : cc[k]); }
        __syncthreads();
        {
            float* red = sc_l + (NB + 1) * D;
            const int lane = tid & 63, wv = tid >> 6;
            for (int it = bid; it < DEPTH * (NMOD * D / 64); it += G) {
                const int l = it / (NMOD * D / 64), j = (it % (NMOD * D / 64)) * 64 + lane;
                const float* w = adaw + ((size_t)l * D + wv * 128) * NMOD * D + j;
                float a0 = 0.f, a1 = 0.f, a2 = 0.f, a3 = 0.f, a4 = 0.f;
#pragma unroll 8
                for (int k = 0; k < 128; ++k) { const float wk = w[(size_t)k * NMOD * D]; const int kk = wv * 128 + k;
                    a0 += sc_l[kk] * wk; a1 += sc_l[D + kk] * wk; a2 += sc_l[2 * D + kk] * wk; a3 += sc_l[3 * D + kk] * wk; a4 += sc_l[4 * D + kk] * wk; }
                __syncthreads();
                red[(wv * 5 + 0) * 64 + lane] = a0; red[(wv * 5 + 1) * 64 + lane] = a1; red[(wv * 5 + 2) * 64 + lane] = a2; red[(wv * 5 + 3) * 64 + lane] = a3; red[(wv * 5 + 4) * 64 + lane] = a4;
                __syncthreads();
                if (tid < 5 * 64) { const int r = tid >> 6; float acc = adab[l * NMOD * D + j - lane + (tid & 63)];
#pragma unroll
                    for (int q = 0; q < 8; ++q) acc += red[(q * 5 + r) * 64 + (tid & 63)];
                    MOD[((size_t)l * (NB + 1) + r) * NMOD * D + (j - lane) + (tid & 63)] = acc; }
            }
        }
        ITEMS(i, S * 16) {
            const int t = i >> 4, w = i & 15, ii = w & 7; const float pos = (float)(w < 8 ? t / GRID_W : t % GRID_W);
            const float ang = pos * powf(10000.0f, -(float)ii / 8.0f);
            ROPE[(size_t)t * 32 + (w < 8 ? 0 : 16) + ii] = cosf(ang); ROPE[(size_t)t * 32 + (w < 8 ? 8 : 24) + ii] = sinf(ang);
        }
        GSYNC();
    }

#pragma unroll 1
    for (int l = 0; l < DEPTH; ++l) {
        const bool ctx_out = l < DEPTH - 1;
        const float lambda_init = 0.8f - 0.6f * expf(-0.3f * (float)l);
        const int nrows_out = ctx_out ? NTOK : NLAT;
        const int ER = ctx_out ? ER_MAX : NB * CAP_L;
        int moe_done = 0;

        {
            PHASE_BEGIN();
            {
                const int lane = tid & 63; auto idm = [](int n) { return n; };
                constexpr int T_WIN = (D / 32) * ((IN_COLS + 63) / 64), T_WQ = (192 / 32) * (384 / 64), T_WKV = (128 / 32) * (512 / 64), T_WOUT = (MIXW / 32) * (D / 64);
                WITEMS(id, T_WIN + T_WQ + T_WKV + T_WOUT) {
                    if (id < T_WIN) { const int nt = (IN_COLS + 63) / 64; cvt_tile(kp_->in[I_WIN] + (size_t)l * D * IN_COLS, IN_COLS, WIN_T, D, idm, (id / nt) * 32, (id % nt) * 64, lane); }
                    else if (id < T_WIN + T_WQ) { const int u = id - T_WIN; cvt_tile(kp_->in[I_WQUP] + (size_t)l * 192 * 384, 384, WQ_T, 256, idm, (u / 6) * 32, (u % 6) * 64, lane); }
                    else if (id < T_WIN + T_WQ + T_WKV) { const int u = id - T_WIN - T_WQ; cvt_tile(kp_->in[I_WKVUP] + (size_t)l * 128 * 512, 512, WKV_T, 128, idm, (u / 8) * 32, (u % 8) * 64, lane); }
                    else { const int u = id - T_WIN - T_WQ - T_WKV; cvt_tile(kp_->in[I_WOUT] + (size_t)l * MIXW * D, D, WOUT_T, MIXW, idm, (u / 16) * 32, (u % 16) * 64, lane); }
                }
            }
            ITEMS(i, (IN_PAD - IN_COLS) * D / 8) ((uint4*)(WIN_T + (size_t)IN_COLS * D))[i] = make_uint4(0, 0, 0, 0);
            ITEMS(i, 128 * 256 / 8) ((uint4*)(WQ_T + (size_t)384 * 256))[i] = make_uint4(0, 0, 0, 0);
            ITEMS(i, 384 * 8) { const int r = i >> 3, c8 = i & 7; *(uint4*)(WQ_T + (size_t)r * 256 + 192 + c8 * 8) = make_uint4(0, 0, 0, 0); }

            const float* w = kp_->in[I_NMPRE] + l * D;
            const int lane = tid & 63;
            {
                float4 xq[4];
                { const float zf_ = (float)(tid >> 20);
#pragma unroll
                  for (int i = 0; i < 4; ++i) xq[i] = make_float4(zf_, zf_, zf_, zf_); }
                float4* aux = (float4*)lds_raw;
                __syncthreads();
                for (int i = tid; i < 11 * (D / 4); i += NTHREADS) { const int v = i / (D / 4), k4 = i % (D / 4);
                    const float* src = v == 0 ? w : modl + (size_t)((v - 1) % 5) * NMOD * D + ((v - 1) / 5) * D;
                    aux[i] = ((const float4*)src)[k4]; }
                __syncthreads();
                const int wstride = gridDim.x * 8; int r = blockIdx.x * 8 + (tid >> 6);
#define P1_LOAD(rr) do { const float4* src_ = (const float4*)((rr) < NLAT ? XSRC + (size_t)(rr) * D : CSRC + (size_t)((rr) - NLAT) * D); _Pragma("unroll") for (int i = 0; i < 4; ++i) xq[i] = src_[i * 64 + lane]; } while (0)
                if (r < NTOK) P1_LOAD(r);
                for (; r < NTOK; r += wstride) {
                    const int bsel = r < NLAT ? r / S : NB;
                    float4 v[4]; float ss = 0.f;
#pragma unroll
                    for (int i = 0; i < 4; ++i) { v[i] = xq[i]; ss += f4dot(v[i], v[i]); }
                    if (r + wstride < NTOK) P1_LOAD(r + wstride);
                    ss = wave_sum(ss);
                    const float rs = 1.0f / sqrtf(ss / D + EPS);
#pragma unroll
                    for (int i = 0; i < 4; ++i) { const int k4 = i * 64 + lane; const float4 w4 = aux[k4], sc = aux[(6 + bsel) * (D / 4) + k4], sh = aux[(1 + bsel) * (D / 4) + k4];
                        const float4 o = make_float4(v[i].x * rs * w4.x * (1.0f + sc.x) + sh.x, v[i].y * rs * w4.y * (1.0f + sc.y) + sh.y, v[i].z * rs * w4.z * (1.0f + sc.z) + sh.z, v[i].w * rs * w4.w * (1.0f + sc.w) + sh.w);
                        *(uint2*)(HB + (size_t)r * D + k4 * 4) = pk4(o); }
                }
#undef P1_LOAD
            }
            GSYNC();
        }
        {
            PHASE_BEGIN();
            pg8::Gemm g{HB, WIN_T, NTOK, IN_PAD, D, 0, 0}; pg8::StaticOrder so; so.init(NTOK, IN_PAD, G, bid);
            pg8::EpiBf16 E{PB, IN_COLS, IN_COLS};
            pg8::gemm_phase<pg8::EpiBf16, pg8::StaticOrder, true, true>(ldsb, g, so, E, tid);
            { const int nwg = (NTOK / 256) * (IN_PAD / 256), busy = nwg % G;
              if (busy != 0 && bid >= busy) CVT_MOE_RANGE(l, 0, (G - busy) * 8 * CVT_PER_WAVE, (bid - busy) * 8 + (tid >> 6), (G - busy) * 8);
              moe_done = busy != 0 ? (G - busy) * 8 * CVT_PER_WAVE : 0; }
            GSYNC();
        }
        {
            PHASE_BEGIN();
            const float* cw = kp_->in[I_CONVW] + (size_t)l * 3 * 768; const float* cb = kp_->in[I_CONVB] + (size_t)l * 768;
            {
                float* cwl = (float*)lds_raw;
                __syncthreads();
                for (int i = tid; i < 4 * 768; i += NTHREADS) cwl[i] = i < 3 * 768 ? cw[i] : cb[i - 3 * 768];
                __syncthreads();
                const int stride = gridDim.x * NTHREADS;
                for (int i0 = blockIdx.x * NTHREADS + tid; i0 < NTOK * 192; i0 += 4 * stride) {
                    uint2 u0[4], um[4], up[4];
#pragma unroll
                    for (int q = 0; q < 4; ++q) { const int i = i0 + q * stride; const unsigned z_ = (unsigned)tid >> 20; u0[q] = make_uint2(z_, z_); um[q] = u0[q]; up[q] = u0[q];
                        if (i < NTOK * 192) { const int c = (i % 192) * 4, r = i / 192; const bool lat = r < NLAT; const int L = lat ? S : CTX; const int t = lat ? r % S : (r - NLAT) % CTX;
                            const bf16_t* u = PB + (size_t)r * IN_COLS + C_XBC + c; u0[q] = *(const uint2*)u; if (t > 0) um[q] = *(const uint2*)(u - IN_COLS); if (t < L - 1) up[q] = *(const uint2*)(u + IN_COLS); } }
#pragma unroll
                    for (int q = 0; q < 4; ++q) { const int i = i0 + q * stride;
                        if (i < NTOK * 192) { const int c = (i % 192) * 4, r = i / 192;
                            float4 acc = f4add(*(const float4*)(cwl + 3 * 768 + c), f4mul(*(const float4*)(cwl + 768 + c), up4(u0[q])));
                            acc = f4add(acc, f4mul(*(const float4*)(cwl + c), up4(um[q]))); acc = f4add(acc, f4mul(*(const float4*)(cwl + 2 * 768 + c), up4(up[q])));
                            *(uint2*)(XBC + (size_t)r * 768 + c) = pk4(make_float4(siluf(acc.x), siluf(acc.y), siluf(acc.z), siluf(acc.w))); } }
                }
            }
            const float* dtb = kp_->in[I_DTB] + l * 16;
            ITEMS(i, NTOK * 16) { const int j = i % 16, r = i / 16; DT[i] = softplusf(bf2f(PB[(size_t)r * IN_COLS + C_DT + j]) + dtb[j]); }
            ITEMS(i, NTOK * 16) {
                const int g = i & 15, r = i >> 4; const int hm = g & 7, isk = g >> 3;
                const bool lat = r < NLAT; const int b = lat ? r / S : (r - NLAT) / CTX, t = lat ? r % S : (r - NLAT) % CTX;
                if (!isk && !lat && !ctx_out) continue;
                const bf16_t* vp = PB + (size_t)r * IN_COLS + (isk ? C_DK : C_DQ) + hm * 32;
                float v[32];
#pragma unroll
                for (int k = 0; k < 32; k += 4) { const float4 x = ld4h(vp + k); v[k] = x.x; v[k + 1] = x.y; v[k + 2] = x.z; v[k + 3] = x.w; }
                if (lat) rope32(v, t, ROPE);
                const float sc = isk ? 1.0f : 0.17677669529663687f * 1.4426950408889634f;
                bf16_t* dst = isk ? KD + ((size_t)(b * 8 + hm) * SK + (lat ? CTX + t : t)) * 32 : (lat ? QD + ((size_t)(b * 8 + hm) * S + t) * 32 : QDC + ((size_t)(b * 8 + hm) * CTX + t) * 32);
#pragma unroll
                for (int k = 0; k < 32; k += 8) *(uint4*)(dst + k) = make_uint4(pk2(v[k] * sc, v[k + 1] * sc), pk2(v[k + 2] * sc, v[k + 3] * sc), pk2(v[k + 4] * sc, v[k + 5] * sc), pk2(v[k + 6] * sc, v[k + 7] * sc));
            }
            ITEMS(i, NB * 4 * (SK / 8) * 64) {
                const int d = i & 63, j8 = (i >> 6) % (SK / 8), hh = (i / (64 * (SK / 8))) & 3, b = i / (256 * (SK / 8));
                const int r0 = j8 * 8 < CTX ? tok_row(false, b, j8 * 8) : tok_row(true, b, j8 * 8 - CTX);
                const bf16_t* sp = PB + (size_t)r0 * IN_COLS + C_DV + hh * 64 + d;
                unsigned v[8];
#pragma unroll
                for (int jj = 0; jj < 8; ++jj) v[jj] = sp[(size_t)jj * IN_COLS];
                *(uint4*)(VDT + ((size_t)(b * 4 + hh) * 64 + d) * SK + j8 * 8) = make_uint4(v[0] | (v[1] << 16), v[2] | (v[3] << 16), v[4] | (v[5] << 16), v[6] | (v[7] << 16));
            }
            const float* qn = kp_->in[I_QNORM] + l * 192; const float* kvn = kp_->in[I_KVNORM] + l * 128;
            { const int lane = tid & 63;
            uint2 xq = make_uint2((unsigned)tid >> 20, (unsigned)tid >> 20);
            const int wstride = gridDim.x * 8; int i = blockIdx.x * 8 + (tid >> 6);
#define NRM_LOAD(ii) do { const int wh_ = (ii) & 1, r_ = (ii) >> 1; if (lane < (wh_ ? 32 : 48)) xq = *(const uint2*)(PB + (size_t)r_ * IN_COLS + (wh_ ? C_CKV : C_CQ) + lane * 4); } while (0)
            if (i < NTOK * 2) NRM_LOAD(i);
            for (; i < NTOK * 2; i += wstride) {
                const int which = i & 1, r = i >> 1; const int n4 = which ? 32 : 48;
                const float4* w = (const float4*)(which ? kvn : qn);
                float4 x = make_float4(0.f, 0.f, 0.f, 0.f); if (lane < n4) x = up4(xq);
                if (i + wstride < NTOK * 2) NRM_LOAD(i + wstride);
                const float ss = wave_sum(f4dot(x, x));
                const float rs = 1.0f / sqrtf(ss / (n4 * 4) + EPS);
                bf16_t* dst = which ? CKVB + (size_t)r * 128 : CQB + (size_t)r * 256;
                if (lane < n4) *(uint2*)(dst + lane * 4) = pk4(f4scale(f4mul(x, w[lane]), rs));
                else if (!which) { const unsigned z_ = (unsigned)tid >> 20; *(uint2*)(dst + lane * 4) = make_uint2(z_, z_); }
            }
#undef NRM_LOAD
            }
            GSYNC();
        }
        {
            PHASE_BEGIN();
            const int half = (G * 5) / 8;
            if (bid < half) {
                pg8::Gemm g{CQB, WQ_T, NTOK, 512, 256, 0, 0}; pg8::StaticOrder so; so.init(NTOK, 512, half, bid);
                pg8::EpiBf16 E{MQ, 384, 384};
                pg8::gemm_phase<pg8::EpiBf16, pg8::StaticOrder, true, true>(ldsb, g, so, E, tid);
            } else {
                pg8::Gemm g{CKVB, WKV_T, NTOK, 512, 128, 0, 0}; pg8::StaticOrder so; so.init(NTOK, 512, G - half, bid - half);
                pg8::EpiBf16 E{MKV, 512, 512};
                pg8::gemm_phase<pg8::EpiBf16, pg8::StaticOrder, true, true>(ldsb, g, so, E, tid);
            }
            for (int it = vcu; it < NB * NCH * 8; it += G) {
                const int hp = it & 3, dir = (it >> 2) & 1, cp = (it >> 3) % NCH, b = it / (8 * NCH);
                const int k = dir ? (cp < 2 ? 1 - cp : 35 - cp) : cp;
                if (k == NCH - 1) continue;
                ssd_block<false>(b, dir, k, hp, XBC, DT, kp_->in[I_ALOG] + l * 16, HS, ALAST, nullptr, (float*)lds_raw, tid);
            }
            GSYNC();
        }
        {
            PHASE_BEGIN();
            ITEMS(i, NTOK * 8) {
                const int g = i & 7, r = i >> 3; const int hh = g & 3, isk = g >> 2;
                const bool lat = r < NLAT; const int b = lat ? r / S : (r - NLAT) / CTX, t = lat ? r % S : (r - NLAT) % CTX;
                if (!isk && !lat && !ctx_out) continue;
                const bf16_t* npb = isk ? MKV + (size_t)r * 512 + hh * 128 : MQ + (size_t)r * 384 + hh * 96;
                const bf16_t* rp = isk ? PB + (size_t)r * IN_COLS + C_KR : npb + 64;
                float v[32], np[64];
#pragma unroll
                for (int k = 0; k < 32; k += 4) { const float4 x = ld4h(rp + k); v[k] = x.x; v[k + 1] = x.y; v[k + 2] = x.z; v[k + 3] = x.w; }
#pragma unroll
                for (int k = 0; k < 64; k += 4) { const float4 x = ld4h(npb + k); np[k] = x.x; np[k + 1] = x.y; np[k + 2] = x.z; np[k + 3] = x.w; }
                if (lat) rope32(v, t, ROPE);
                const float sc = isk ? 1.0f : 0.10206207261596575f * 1.4426950408889634f;
                bf16_t* dst = isk ? KM + ((size_t)(b * 4 + hh) * SK + (lat ? CTX + t : t)) * 96 : (lat ? QM + ((size_t)(b * 4 + hh) * S + t) * 96 : QMC + ((size_t)(b * 4 + hh) * CTX + t) * 96);
#pragma unroll
                for (int k = 0; k < 64; k += 8) *(uint4*)(dst + k) = make_uint4(pk2(np[k] * sc, np[k + 1] * sc), pk2(np[k + 2] * sc, np[k + 3] * sc), pk2(np[k + 4] * sc, np[k + 5] * sc), pk2(np[k + 6] * sc, np[k + 7] * sc));
#pragma unroll
                for (int k = 0; k < 32; k += 8) *(uint4*)(dst + 64 + k) = make_uint4(pk2(v[k] * sc, v[k + 1] * sc), pk2(v[k + 2] * sc, v[k + 3] * sc), pk2(v[k + 4] * sc, v[k + 5] * sc), pk2(v[k + 6] * sc, v[k + 7] * sc));
            }
            ITEMS(i, NB * 4 * (SK / 8) * 64) {
                const int d = i & 63, j8 = (i >> 6) % (SK / 8), hh = (i / (64 * (SK / 8))) & 3, b = i / (256 * (SK / 8));
                const int r0 = j8 * 8 < CTX ? tok_row(false, b, j8 * 8) : tok_row(true, b, j8 * 8 - CTX);
                const bf16_t* sp = MKV + (size_t)r0 * 512 + hh * 128 + 64 + d;
                unsigned v[8];
#pragma unroll
                for (int jj = 0; jj < 8; ++jj) v[jj] = sp[(size_t)jj * 512];
                *(uint4*)(VMT + ((size_t)(b * 4 + hh) * 64 + d) * SK + j8 * 8) = make_uint4(v[0] | (v[1] << 16), v[2] | (v[3] << 16), v[4] | (v[5] << 16), v[6] | (v[7] << 16));
            }
            ITEMS(i, NB * 2 * 8 * 4096) {
                const int e = i & 4095, h = (i >> 12) & 7, bd = i >> 15;
                float* hp0 = HS + ((size_t)bd * NCH * 8 + h) * 4096 + e; const float* al0 = ALAST + (size_t)bd * NCH * 8 + h;
                float sv[NCH - 1], dk[NCH - 1];
#pragma unroll
                for (int k = 0; k < NCH - 1; ++k) { sv[k] = hp0[(size_t)k * 8 * 4096]; dk[k] = al0[k * 8]; }
                float Hc = 0.f;
#pragma unroll
                for (int k = 0; k < NCH; ++k) { hp0[(size_t)k * 8 * 4096] = Hc; if (k < NCH - 1) Hc = Hc * __expf(dk[k]) + sv[k]; }
            }
            GSYNC();
        }
        {
            PHASE_BEGIN();
            for (int it = vcu; it < NB * 2 * NCH * 4; it += G) {
                const int hp = it & 3, dir = (it >> 2) & 1, cp = (it >> 3) % NCH, b = it / (8 * NCH);
                const int k = dir ? (cp < 2 ? 1 - cp : 35 - cp) : cp;
                if (k < 2 && !ctx_out) continue;
                ssd_block<true>(b, dir, k, hp, XBC, DT, kp_->in[I_ALOG] + l * 16, HS, ALAST, YD, (float*)lds_raw, tid);
            }
            const int lane = tid & 63, wave = tid >> 6, qr = lane & 31, hf = lane >> 5;
            {
                const float* lq1 = kp_->in[I_LQ1] + l * 32; const float* lk1 = kp_->in[I_LK1] + l * 32; const float* lq2 = kp_->in[I_LQ2] + l * 32; const float* lk2 = kp_->in[I_LK2] + l * 32;
                const float* subw = kp_->in[I_SUBLN] + l * 64;
                const int nlat = NB * 4 * (S / 256), nit = nlat + (ctx_out ? NB * 4 : 0);
                for (int it = vcu; it < nit; it += G) {
                    const bool lat = it < nlat; const int u = lat ? it : it - nlat;
                    const int qb = lat ? u % (S / 256) : 0, hh = lat ? (u / (S / 256)) % 4 : u % 4, b = lat ? u / (4 * (S / 256)) : u / 4;
                    const int t = qb * 256 + wave * 32 + qr; const int row = tok_row(lat, b, t); const int nkt = lat ? SK / 64 : CTX / 64;
                    f32x16 oacc[2]; unsigned o1p[2][8];
#pragma unroll 1
                    for (int mp = 0; mp < 2; ++mp) {
                        const int hm = hh * 2 + mp;
                        const bf16_t* qrow = lat ? QD + ((size_t)(b * 8 + hm) * S + t) * 32 : QDC + ((size_t)(b * 8 + hm) * CTX + t) * 32;
                        float l_run = 0.f;
#pragma unroll
                        for (int i = 0; i < 16; ++i) { oacc[0][i] = 0.f; oacc[1][i] = 0.f; }
                        attn_pass<32>(qrow, KD + (size_t)(b * 8 + hm) * SK * 32, VDT + (size_t)(b * 4 + hh) * 64 * SK, SK, nkt, ldsb, tid, oacc, l_run);
                        l_run = xor32_sum(l_run);
                        if (mp == 0) { const float i1 = 1.0f / l_run;
#pragma unroll
                            for (int db = 0; db < 2; ++db)
#pragma unroll
                                for (int i = 0; i < 8; ++i) o1p[db][i] = pk2(oacc[db][2 * i] * i1, oacc[db][2 * i + 1] * i1); }
                        else {
                            float d1 = 0.f, d2 = 0.f; for (int k = 0; k < 32; ++k) { d1 += lq1[k] * lk1[k]; d2 += lq2[k] * lk2[k]; }
                            const float lam = expf(d1) - expf(d2) + lambda_init;
                            const float i2 = lam / l_run; float ss = 0.f; f32x16 o1[2];
#pragma unroll
                            for (int db = 0; db < 2; ++db)
#pragma unroll
                                for (int i = 0; i < 16; ++i) { const float a1 = __uint_as_float((i & 1) ? (o1p[db][i >> 1] & 0xffff0000u) : (o1p[db][i >> 1] << 16)); const float v = a1 - oacc[db][i] * i2; o1[db][i] = v; ss += v * v; }
                            ss = xor32_sum(ss);
                            const float rs = (1.0f - lambda_init) / sqrtf(ss / 64 + EPS);
                            bf16_t* orow = MIXB + (size_t)row * MIXW + 512 + hh * 64;
#pragma unroll
                            for (int db = 0; db < 2; ++db)
#pragma unroll
                                for (int gq = 0; gq < 4; ++gq) { const int d0 = 32 * db + 8 * gq + 4 * hf; const float4 w4 = *(const float4*)(subw + d0);
                                    *(uint2*)(orow + d0) = make_uint2(pk2(o1[db][4 * gq] * rs * w4.x, o1[db][4 * gq + 1] * rs * w4.y), pk2(o1[db][4 * gq + 2] * rs * w4.z, o1[db][4 * gq + 3] * rs * w4.w)); }
                        }
                    }
                }
            }
            {
                const int nlat = NB * 4 * (S / 256), nit = nlat + (ctx_out ? NB * 4 : 0);
                for (int it = vcu; it < nit; it += G) {
                    const bool lat = it < nlat; const int u = lat ? it : it - nlat;
                    const int qb = lat ? u % (S / 256) : 0, hh = lat ? (u / (S / 256)) % 4 : u % 4, b = lat ? u / (4 * (S / 256)) : u / 4;
                    const int t = qb * 256 + wave * 32 + qr; const int row = tok_row(lat, b, t); const int nkt = lat ? SK / 64 : CTX / 64;
                    const bf16_t* qrow = lat ? QM + ((size_t)(b * 4 + hh) * S + t) * 96 : QMC + ((size_t)(b * 4 + hh) * CTX + t) * 96;
                    f32x16 oacc[2]; float l_run = 0.f;
#pragma unroll
                    for (int i = 0; i < 16; ++i) { oacc[0][i] = 0.f; oacc[1][i] = 0.f; }
                    attn_pass<96>(qrow, KM + (size_t)(b * 4 + hh) * SK * 96, VMT + (size_t)(b * 4 + hh) * 64 * SK, SK, nkt, ldsb, tid, oacc, l_run);
                    l_run = xor32_sum(l_run);
                    const float inv = 1.0f / l_run;
                    bf16_t* orow = MIXB + (size_t)row * MIXW + 768 + hh * 64;
#pragma unroll
                    for (int db = 0; db < 2; ++db)
#pragma unroll
                        for (int gq = 0; gq < 4; ++gq) { const int d0 = 32 * db + 8 * gq + 4 * hf;
                            *(uint2*)(orow + d0) = make_uint2(pk2(oacc[db][4 * gq] * inv, oacc[db][4 * gq + 1] * inv), pk2(oacc[db][4 * gq + 2] * inv, oacc[db][4 * gq + 3] * inv)); }
                }
            }
            GSYNC();
        }
        {
            PHASE_BEGIN();
            const float* nw = kp_->in[I_SSDN] + l * 512; const float* dsk = kp_->in[I_SSDD] + l * 8;
            const int lane = tid & 63;
            uint2 q0, q1, q2, q3; { const unsigned z_ = (unsigned)tid >> 20; q0 = make_uint2(z_, z_); q1 = q0; q2 = q0; q3 = q0; }
            const int wstride = gridDim.x * 8; int i = blockIdx.x * 8 + (tid >> 6);
#define GN_LOAD(ii) do { const int g_ = (ii) & 1, r_ = (ii) >> 1, c_ = g_ * 256 + lane * 4; q0 = *(const uint2*)(XBC + (size_t)r_ * 768 + c_); q1 = *(const uint2*)(YD + (size_t)r_ * 512 + c_); \
                q2 = *(const uint2*)(YD + ((size_t)NTOK + r_) * 512 + c_); q3 = *(const uint2*)(PB + (size_t)r_ * IN_COLS + C_Z + c_); } while (0)
            if (i < nrows_out * 2) GN_LOAD(i);
            for (; i < nrows_out * 2; i += wstride) {
                const int g = i & 1, r = i >> 1, c = g * 256 + lane * 4;
                const float4 x = up4(q0), y0 = up4(q1), y1 = up4(q2), z = up4(q3);
                if (i + wstride < nrows_out * 2) GN_LOAD(i + wstride);
                const float ds = dsk[c >> 6];
                float4 v = make_float4((ds * x.x + y0.x + y1.x) * siluf(z.x), (ds * x.y + y0.y + y1.y) * siluf(z.y), (ds * x.z + y0.z + y1.z) * siluf(z.z), (ds * x.w + y0.w + y1.w) * siluf(z.w));
                const float ss = wave_sum(f4dot(v, v));
                const float rs = 1.0f / sqrtf(ss / 256 + EPS);
                *(uint2*)(MIXB + (size_t)r * MIXW + c) = pk4(f4scale(f4mul(v, *(const float4*)(nw + c)), rs));
            }
#undef GN_LOAD
            GSYNC();
        }
        {
            PHASE_BEGIN();
            pg8::Gemm g{MIXB, WOUT_T, nrows_out, D, MIXW, 0, 0}; pg8::StaticOrder so; so.init(nrows_out, D, G, bid);
            pg8::EpiBf16 E{MOUT, D, D};
            pg8::gemm_phase<pg8::EpiBf16, pg8::StaticOrder, true, true>(ldsb, g, so, E, tid);
            { const int nwg = (nrows_out / 256) * (D / 256), busy = nwg % G; const int id0 = moe_done;
              if (busy != 0 && bid >= busy) CVT_MOE_RANGE(l, id0, id0 + (G - busy) * 8 * CVT_PER_WAVE, (bid - busy) * 8 + (tid >> 6), (G - busy) * 8);
              if (busy != 0) moe_done = id0 + (G - busy) * 8 * CVT_PER_WAVE; }
            GSYNC();
        }
        {
            PHASE_BEGIN();
            const float* wpost = kp_->in[I_NMPOST] + l * D; const float* wpre = kp_->in[I_NFPRE] + l * D;
            const float* rw = kp_->in[I_RW] + (size_t)l * D * NE; const float* rb = kp_->in[I_RB] + l * NE;
            const int lane = tid & 63;
            float* rwl = (float*)lds_raw;
            for (int i = tid; i < D * NE / 4; i += NTHREADS) { const int k = i >> 2, e4 = i & 3; ((float4*)rwl)[(((k & 3) * 256 + (k >> 2)) << 2) + e4] = ((const float4*)rw)[i]; }
            float4* aux = (float4*)(rwl + D * NE);
            for (int i = tid; i < 17 * (D / 4); i += NTHREADS) { const int v = i / (D / 4), k4 = i % (D / 4);
                const float* src = v == 0 ? wpost : v == 1 ? wpre : modl + (size_t)((v - 2) % 5) * NMOD * D + (2 + (v - 2) / 5) * D;
                aux[i] = ((const float4*)src)[k4]; }
            __syncthreads();
            uint2 mq[4]; float4 xq[4];
            { const float zf_ = (float)(tid >> 20);
#pragma unroll
              for (int i = 0; i < 4; ++i) { xq[i] = make_float4(zf_, zf_, zf_, zf_); mq[i] = make_uint2((unsigned)tid >> 20, (unsigned)tid >> 20); } }
            const int wstride = gridDim.x * 8; int r = blockIdx.x * 8 + (tid >> 6);
#define P7_LOAD(rr) do { const float4* xin_ = (const float4*)((rr) < NLAT ? XSRC + (size_t)(rr) * D : CSRC + (size_t)((rr) - NLAT) * D); const bf16_t* m_ = MOUT + (size_t)(rr) * D; \
                _Pragma("unroll") for (int i = 0; i < 4; ++i) { mq[i] = *(const uint2*)(m_ + (i * 64 + lane) * 4); xq[i] = xin_[i * 64 + lane]; } } while (0)
            if (r < nrows_out) P7_LOAD(r);
            for (; r < nrows_out; r += wstride) {
                float4* xr = (float4*)(r < NLAT ? xcur + (size_t)r * D : CTXC + (size_t)(r - NLAT) * D);
                const int bsel = r < NLAT ? r / S : NB;
                float4 mv[4], xv[4]; float ss = 0.f;
#pragma unroll
                for (int i = 0; i < 4; ++i) { mv[i] = up4(mq[i]); xv[i] = xq[i]; ss += f4dot(mv[i], mv[i]); }
                if (r + wstride < nrows_out) P7_LOAD(r + wstride);
                ss = wave_sum(ss);
                const float rs = 1.0f / sqrtf(ss / D + EPS);
                float s2 = 0.f;
#pragma unroll
                for (int i = 0; i < 4; ++i) { const int k4 = i * 64 + lane;
                    xv[i] = f4add(xv[i], f4mul(aux[(2 + bsel) * (D / 4) + k4], f4scale(f4mul(mv[i], aux[k4]), rs))); xr[k4] = xv[i]; s2 += f4dot(xv[i], xv[i]); }
                s2 = wave_sum(s2);
                const float r2 = 1.0f / sqrtf(s2 / D + EPS);
                float lg[NE];
#pragma unroll
                for (int e = 0; e < NE; ++e) lg[e] = 0.f;
#pragma unroll
                for (int i = 0; i < 4; ++i) { const int k4 = i * 64 + lane; const float4 w4 = aux[(D / 4) + k4], sc = aux[(12 + bsel) * (D / 4) + k4], sh = aux[(7 + bsel) * (D / 4) + k4];
                    const float hv[4] = {xv[i].x * r2 * w4.x * (1.0f + sc.x) + sh.x, xv[i].y * r2 * w4.y * (1.0f + sc.y) + sh.y, xv[i].z * r2 * w4.z * (1.0f + sc.z) + sh.z, xv[i].w * r2 * w4.w * (1.0f + sc.w) + sh.w};
                    *(uint2*)(HB + (size_t)r * D + k4 * 4) = make_uint2(pk2(hv[0], hv[1]), pk2(hv[2], hv[3]));
#pragma unroll
                    for (int c = 0; c < 4; ++c) { const float4* rwp = (const float4*)(rwl + (size_t)(c * 256 + k4) * NE);
#pragma unroll
                        for (int e4 = 0; e4 < 4; ++e4) { const float4 w = rwp[e4]; lg[4 * e4] += hv[c] * w.x; lg[4 * e4 + 1] += hv[c] * w.y; lg[4 * e4 + 2] += hv[c] * w.z; lg[4 * e4 + 3] += hv[c] * w.w; }
                        SCHED_FENCE(); }
                }
#pragma unroll
                for (int e = 0; e < NE; ++e) lg[e] = wave_sum(lg[e]) + rb[e];
                float mx = lg[0];
#pragma unroll
                for (int e = 1; e < NE; ++e) mx = fmaxf(mx, lg[e]);
                float sum = 0.f;
#pragma unroll
                for (int e = 0; e < NE; ++e) { lg[e] = expf(lg[e] - mx); sum += lg[e]; }
                const float is = 1.0f / sum;
                float mine = lg[0];
#pragma unroll
                for (int e = 1; e < NE; ++e) mine = lane == e ? lg[e] : mine;
                if (lane < NE) AFF[(size_t)r * NE + lane] = mine * is;
            }
#undef P7_LOAD
            GSYNC();
        }
        {
            PHASE_BEGIN();
            CVT_MOE_RANGE(l, moe_done, MOE_TILES, bid * 8 + (tid >> 6), G * 8);
            {
                volatile int* sh = (volatile int*)lds_raw;
                const int nsel = (ctx_out ? 2 : 1) * NB * NE;
                for (int it = bid; it < nsel; it += G) {
                    const bool lat = it < NB * NE; const int u = lat ? it : it - NB * NE; const int e = u % NE, b = u / NE;
                    const int L = lat ? S : CTX, cap = lat ? CAP_L : CAP_C, npt = lat ? S / NTHREADS : 1, base = tok_row(lat, b, 0);
                    const bool act = lat || tid < CTX;
                    unsigned key[S / NTHREADS];
#pragma unroll
                    for (int i = 0; i < S / NTHREADS; ++i) key[i] = (act && i < npt) ? __float_as_uint(AFF[(size_t)(base + tid * npt + i) * NE + e]) : 0u;
                    __syncthreads();
                    unsigned T = 0u;
                    for (int bit = 30; bit >= 0; --bit) {
                        const unsigned cand = T | (1u << bit); int c = 0;
#pragma unroll
                        for (int i = 0; i < S / NTHREADS; ++i) c += (key[i] >= cand) ? 1 : 0;
                        if (block_sum(c, tid, sh, bit & 1) >= cap) T = cand;
                    }
                    int cg = 0, ct = 0;
#pragma unroll
                    for (int i = 0; i < S / NTHREADS; ++i) { cg += (key[i] > T) ? 1 : 0; ct += (key[i] == T && key[i] != 0u) ? 1 : 0; }
                    int tot_g, tot_t;
                    (void)block_excl_scan(cg, tid, sh, tot_g);
                    int tie_rank = block_excl_scan(ct, tid, sh, tot_t);
                    const int need = cap - tot_g;
                    int sel[S / NTHREADS], cs = 0;
#pragma unroll
                    for (int i = 0; i < S / NTHREADS; ++i) { const bool tie = key[i] == T && key[i] != 0u; sel[i] = (key[i] > T || (tie && tie_rank < need)) ? 1 : 0; tie_rank += tie ? 1 : 0; cs += sel[i]; }
                    int tot_s; int slot = block_excl_scan(cs, tid, sh, tot_s);
#pragma unroll
                    for (int i = 0; i < S / NTHREADS; ++i) if (act && i < npt) {
                        const int row = base + tid * npt + i; int sa = -1;
                        if (sel[i]) { sa = (lat ? b * CAP_L : NB * CAP_L + b * CAP_C) + slot; ++slot; SELIDX[e * ER_MAX + sa] = row; SELGATE[e * ER_MAX + sa] = __uint_as_float(key[i]); }
                        TOKSLOT[(size_t)row * NE + e] = sa;
                    }
                }
            }
            GSYNC();
        }
        {
            PHASE_BEGIN();
            const int used = ctx_out ? NB * (CAP_L + CAP_C) : NB * CAP_L;
            ITEMS(i, NE * ER * (D / 8)) {
                const int c8 = i % (D / 8), slot = (i / (D / 8)) % ER, e = i / ((D / 8) * ER);
                uint4 v = make_uint4(0, 0, 0, 0);
                if (slot < used) v = *(const uint4*)(HB + (size_t)SELIDX[e * ER_MAX + slot] * D + c8 * 8);
                *(uint4*)(XG + ((size_t)e * ER + slot) * D + c8 * 8) = v;
            }
            GSYNC();
        }
        {
            PHASE_BEGIN();
            pg8::Gemm g{XG, WGU_T, NE * ER, 2 * FF, D, ER / 256, (size_t)2 * FF * D * 2}; pg8::StaticOrder so; so.init(NE * ER, 2 * FF, G, bid);
            pg8::EpiSwiGLU E{HID, FF};
            pg8::gemm_phase<pg8::EpiSwiGLU, pg8::StaticOrder, true, true>(ldsb, g, so, E, tid);
            GSYNC();
        }
        {
            PHASE_BEGIN();
            pg8::Gemm g{HID, WD_T, NE * ER, D, FF, ER / 256, (size_t)D * FF * 2}; pg8::StaticOrder so; so.init(NE * ER, D, G, bid);
            pg8::EpiRowScaleBf16 E{Y, D, SELGATE, ER};
            pg8::gemm_phase<pg8::EpiRowScaleBf16, pg8::StaticOrder, true, true>(ldsb, g, so, E, tid);
            GSYNC();
        }
        {
            PHASE_BEGIN();
            const float* wpost = kp_->in[I_NFPOST] + l * D;
            const int lane = tid & 63;
            {
                float4 xq[4]; int slq = -1;
                { const float zf_ = (float)(tid >> 20);
#pragma unroll
                  for (int i = 0; i < 4; ++i) xq[i] = make_float4(zf_, zf_, zf_, zf_); }
                float4* aux = (float4*)lds_raw;
                __syncthreads();
                for (int i = tid; i < 6 * (D / 4); i += NTHREADS) { const int v = i / (D / 4), k4 = i % (D / 4);
                    const float* src = v == 0 ? wpost : modl + (size_t)(v - 1) * NMOD * D + 5 * D;
                    aux[i] = ((const float4*)src)[k4]; }
                __syncthreads();
                const int wstride = gridDim.x * 8; int r = blockIdx.x * 8 + (tid >> 6);
#define P11_LOAD(rr) do { const float4* xin_ = (const float4*)((rr) < NLAT ? xcur + (size_t)(rr) * D : CTXC + (size_t)((rr) - NLAT) * D); slq = lane < NE ? TOKSLOT[(size_t)(rr) * NE + lane] : -1; \
                    _Pragma("unroll") for (int i = 0; i < 4; ++i) xq[i] = xin_[i * 64 + lane]; } while (0)
                if (r < nrows_out) P11_LOAD(r);
                for (; r < nrows_out; r += wstride) {
                    float4* xr = (float4*)(r < NLAT ? xcur + (size_t)r * D : CTXC + (size_t)(r - NLAT) * D);
                    const int bsel = r < NLAT ? r / S : NB;
                    const int myslot = slq; float4 xv[4], f[4];
#pragma unroll
                    for (int i = 0; i < 4; ++i) { xv[i] = xq[i]; f[i] = make_float4(0.f, 0.f, 0.f, 0.f); }
#pragma unroll
                    for (int e = 0; e < NE; ++e) {
                        const int sl = __builtin_amdgcn_readlane(myslot, e);
                        if (sl >= 0) { const bf16_t* yp = Y + ((size_t)e * ER + sl) * D;
#pragma unroll
                            for (int i = 0; i < 4; ++i) f[i] = f4add(f[i], ld4h(yp + (i * 64 + lane) * 4)); }
                    }
                    if (r + wstride < nrows_out) P11_LOAD(r + wstride);
                    float ss = 0.f;
#pragma unroll
                    for (int i = 0; i < 4; ++i) ss += f4dot(f[i], f[i]);
                    ss = wave_sum(ss);
                    const float rs = 1.0f / sqrtf(ss / D + EPS);
#pragma unroll
                    for (int i = 0; i < 4; ++i) { const int k4 = i * 64 + lane; xr[k4] = f4add(xv[i], f4mul(aux[(1 + bsel) * (D / 4) + k4], f4scale(f4mul(f[i], aux[k4]), rs))); }
                }
#undef P11_LOAD
            }
            GSYNC();
        }
    }
}

extern "C" void kernel_launch(void* const* d_in, const int* in_sizes, int n_in, void* d_out, int out_size, void* d_ws, size_t ws_size, hipStream_t stream) {
    static int grid = 0;
    if (grid == 0) {
        if (n_in != N_IN || out_size != NLAT * D || ws_size < WS_END) { fprintf(stderr, "kernel_launch: unexpected shapes: n_in %d out %d ws %zu (need %zu)\n", n_in, out_size, ws_size, (size_t)WS_END); grid = -1; return; }
        int dev = 0, cus = 0, per_cu = 0;
        (void)hipGetDevice(&dev);
        (void)hipDeviceGetAttribute(&cus, hipDeviceAttributeMultiprocessorCount, dev);
        (void)hipFuncSetAttribute((const void*)mk_forward, hipFuncAttributeMaxDynamicSharedMemorySize, LDS_BYTES);
        (void)hipOccupancyMaxActiveBlocksPerMultiprocessor(&per_cu, (const void*)mk_forward, NTHREADS, LDS_BYTES);
        (void)hipGetLastError();
        if (per_cu < 1) { fprintf(stderr, "kernel_launch: occupancy query says %d blocks/CU\n", per_cu); grid = -1; return; }
        grid = cus;
    }
    if (grid < 0) return;
    (void)hipMemsetAsync((char*)d_ws + WS_CTL, 0, CTL_BYTES, stream);
    Prm p{};
    for (int i = 0; i < N_IN; ++i) p.in[i] = (const float*)d_in[i];
    p.out = (float*)d_out; p.ws = (char*)d_ws;
    void* args[] = {&p};
    hipError_t e = hipLaunchCooperativeKernel((const void*)mk_forward, dim3(grid), dim3(NTHREADS), args, LDS_BYTES, stream);
    if (e != hipSuccess) fprintf(stderr, "kernel_launch: cooperative launch failed: %s (grid %d)\n", hipGetErrorString(e), grid);
}
```

```cpp
#include <hip/hip_runtime.h>
#include <cstdio>
#include <cstdint>

constexpr int D = 1024, NB = 4, S = 4096, CTX = 256, FF = 1024;
constexpr int DEPTH = 2, GRID_W = 64, NMOD = 6, NE = 16;
constexpr int NLAT = NB * S, NCTX = NB * CTX, NTOK = NLAT + NCTX;
constexpr int IN_COLS = 2416, IN_PAD = 2560;
constexpr int C_Z = 0, C_XBC = 512, C_DT = 1280, C_DQ = 1296, C_DK = 1552, C_DV = 1808, C_CQ = 2064, C_CKV = 2256, C_KR = 2384;
constexpr int MIXW = 1024;
constexpr int CAP_L = 2 * S / NE, CAP_C = 2 * CTX / NE;
constexpr int ER_MAX = 2304;
constexpr float EPS = 1e-6f;
static_assert(NB * CAP_L == 2048 && NB * CAP_C == 128, "expert row layout");

enum { I_X = 0, I_C, I_CTX, I_CCTX, I_ADAW, I_ADAB, I_NMPRE, I_NMPOST, I_NFPRE, I_NFPOST, I_WIN, I_CONVW, I_CONVB, I_ALOG, I_DTB, I_SSDD, I_SSDN,
       I_LQ1, I_LK1, I_LQ2, I_LK2, I_SUBLN, I_QNORM, I_WQUP, I_KVNORM, I_WKVUP, I_WOUT, I_RW, I_RB, I_WG, I_WU, I_WD, N_IN };
struct Prm { const float* in[N_IN]; float* out; char* ws; };

typedef unsigned short bf16_t;
constexpr size_t al256(size_t x) { return (x + 255) & ~(size_t)255; }
constexpr size_t WS_CTL = 0, CTL_BYTES = 65536;
constexpr size_t WS_MOD = WS_CTL + CTL_BYTES;
constexpr size_t WS_CTXC = al256(WS_MOD + (size_t)DEPTH * (NB + 1) * NMOD * D * 4);
constexpr size_t WS_AFF = al256(WS_CTXC + (size_t)NCTX * D * 4);
constexpr size_t WS_TOKSLOT = al256(WS_AFF + (size_t)NTOK * NE * 4);
constexpr size_t WS_SELIDX = al256(WS_TOKSLOT + (size_t)NTOK * NE * 4);
constexpr size_t WS_SELGATE = al256(WS_SELIDX + (size_t)NE * ER_MAX * 4);
constexpr size_t WS_DT = al256(WS_SELGATE + (size_t)NE * ER_MAX * 4);
constexpr int NCH = 34;
constexpr size_t WS_ROPE = al256(WS_DT + (size_t)NTOK * 16 * 4);
constexpr size_t WS_ALAST = al256(WS_ROPE + (size_t)S * 32 * 4);
constexpr size_t WS_HB = al256(WS_ALAST + (size_t)NB * 2 * NCH * 8 * 4);
constexpr size_t WS_P = al256(WS_HB + (size_t)NTOK * D * 2);
constexpr size_t WS_G2 = al256(WS_P + (size_t)NTOK * IN_COLS * 4);
constexpr size_t WS_XBC = WS_G2;
constexpr size_t WS_MQ = al256(WS_XBC + (size_t)NTOK * 768 * 4);
constexpr size_t WS_MKV = al256(WS_MQ + (size_t)NTOK * 384 * 4);
constexpr size_t WS_CQB = al256(WS_MKV + (size_t)NTOK * 512 * 4);
constexpr size_t WS_CKVB = al256(WS_CQB + (size_t)NTOK * 256 * 2);
constexpr size_t WS_MIXB = al256(WS_CKVB + (size_t)NTOK * 128 * 2);
constexpr size_t WS_G2END = al256(WS_MIXB + (size_t)NTOK * MIXW * 2);
constexpr size_t WS_HS = WS_HB;
constexpr size_t WS_YD = WS_MQ;
constexpr size_t WS_MOUT = WS_P;
constexpr size_t WS_XG = WS_P;
constexpr size_t WS_HID = al256(WS_XG + (size_t)NE * ER_MAX * D * 2);
constexpr size_t WS_Y = WS_G2;
constexpr size_t WS_WIN = WS_G2END;
constexpr size_t WS_WQ = al256(WS_WIN + (size_t)IN_PAD * D * 2);
constexpr size_t WS_WKV = al256(WS_WQ + (size_t)512 * 256 * 2);
constexpr size_t WS_WOUT = al256(WS_WKV + (size_t)512 * 128 * 2);
constexpr size_t WS_WGU = al256(WS_WOUT + (size_t)D * MIXW * 2);
constexpr size_t WS_WD = al256(WS_WGU + (size_t)NE * 2 * FF * D * 2);
constexpr size_t WS_END = al256(WS_WD + (size_t)NE * D * FF * 2);
constexpr int SK = CTX + S;
constexpr size_t WS_QD = al256(WS_P + (size_t)NTOK * IN_COLS * 2);
constexpr size_t WS_QDC = al256(WS_QD + (size_t)NB * 8 * S * 32 * 2);
constexpr size_t WS_KD = al256(WS_QDC + (size_t)NB * 8 * CTX * 32 * 2);
constexpr size_t WS_VDT = al256(WS_KD + (size_t)NB * 8 * SK * 32 * 2);
constexpr size_t WS_QM = al256(WS_VDT + (size_t)NB * 4 * 64 * SK * 2);
constexpr size_t WS_QMC = al256(WS_QM + (size_t)NB * 4 * S * 96 * 2);
constexpr size_t WS_KM = al256(WS_QMC + (size_t)NB * 4 * CTX * 96 * 2);
constexpr size_t WS_VMT = al256(WS_KM + (size_t)NB * 4 * SK * 96 * 2);
constexpr size_t WS_ATTEND = al256(WS_VMT + (size_t)NB * 4 * 64 * SK * 2);
static_assert(WS_ATTEND <= WS_G2, "attention operands fit in the spare half of the P slot");
static_assert(WS_HID + (size_t)NE * ER_MAX * FF * 2 <= WS_G2, "XG+HID fit in the P region");
static_assert((size_t)NE * ER_MAX * D * 4 <= WS_G2END - WS_G2, "Y fits in the G2 region");
static_assert((size_t)NB * 2 * NCH * 8 * 4096 * 4 <= (size_t)NTOK * D * 2, "HS fits in HB");
static_assert(WS_YD + (size_t)2 * NTOK * 512 * 4 <= WS_MIXB, "YD ends below MIXB");

#define LAS __attribute__((address_space(3)))
constexpr int NTHREADS = 512;
constexpr int LDS_BYTES = 147456;
#define ITEMS(i, n) for (int i = blockIdx.x * NTHREADS + tid; i < (n); i += gridDim.x * NTHREADS)

__device__ __forceinline__ float siluf(float x) { return x / (1.0f + expf(-x)); }
__device__ __forceinline__ float softplusf(float x) { return x > 20.f ? x : log1pf(expf(x)); }
__device__ __forceinline__ unsigned f2bf(float f) { unsigned u = __builtin_bit_cast(unsigned, f); return (u + 0x7fffu + ((u >> 16) & 1u)) >> 16; }
typedef float f32x2_t __attribute__((ext_vector_type(2)));
typedef __bf16 bf16x2_t __attribute__((ext_vector_type(2)));
__device__ __forceinline__ unsigned pk2(float lo, float hi) { const f32x2_t v = {lo, hi}; return __builtin_bit_cast(unsigned, __builtin_convertvector(v, bf16x2_t)); }
__device__ __forceinline__ float bf2f(bf16_t h) { return __builtin_bit_cast(float, (unsigned)h << 16); }
#define SCHED_FENCE() __builtin_amdgcn_sched_barrier(0)
__device__ __forceinline__ int mk_tid_impl(int wave_s) { unsigned z; asm volatile("s_mov_b32 %0, 0" : "=s"(z));
    return (wave_s << 6) | (int)__builtin_amdgcn_mbcnt_hi(~0u, __builtin_amdgcn_mbcnt_lo(~0u, z)); }
__device__ __forceinline__ float dpp_row_shr(float v, int n) {
    const int iv = __builtin_bit_cast(int, v); int r;
    switch (n) { case 1: r = __builtin_amdgcn_update_dpp(0, iv, 0x111, 0xf, 0xf, true); break; case 2: r = __builtin_amdgcn_update_dpp(0, iv, 0x112, 0xf, 0xf, true); break;
                 case 4: r = __builtin_amdgcn_update_dpp(0, iv, 0x114, 0xf, 0xf, true); break; default: r = __builtin_amdgcn_update_dpp(0, iv, 0x118, 0xf, 0xf, true); break; }
    return __builtin_bit_cast(float, r);
}
__device__ __forceinline__ float wave_sum(float v) {
    v += dpp_row_shr(v, 1); v += dpp_row_shr(v, 2); v += dpp_row_shr(v, 4); v += dpp_row_shr(v, 8);
    v += __builtin_bit_cast(float, __builtin_amdgcn_update_dpp(0, __builtin_bit_cast(int, v), 0x142, 0xa, 0xf, false));
    v += __builtin_bit_cast(float, __builtin_amdgcn_update_dpp(0, __builtin_bit_cast(int, v), 0x143, 0xc, 0xf, false));
    return __builtin_bit_cast(float, __builtin_amdgcn_readlane(__builtin_bit_cast(int, v), 63)); }
__device__ __forceinline__ float xor32_max(float x) { auto t = __builtin_amdgcn_permlane32_swap(__float_as_uint(x), __float_as_uint(x), false, false); return fmaxf(__uint_as_float(t[0]), __uint_as_float(t[1])); }
__device__ __forceinline__ float xor32_sum(float x) { auto t = __builtin_amdgcn_permlane32_swap(__float_as_uint(x), __float_as_uint(x), false, false); return __uint_as_float(t[0]) + __uint_as_float(t[1]); }
#define WITEMS(i, n) for (int i = blockIdx.x * 8 + (tid >> 6); i < (n); i += gridDim.x * 8)
__device__ __forceinline__ float4 f4mul(float4 a, float4 b) { return make_float4(a.x * b.x, a.y * b.y, a.z * b.z, a.w * b.w); }
__device__ __forceinline__ float4 f4add(float4 a, float4 b) { return make_float4(a.x + b.x, a.y + b.y, a.z + b.z, a.w + b.w); }
__device__ __forceinline__ float4 f4scale(float4 a, float s) { return make_float4(a.x * s, a.y * s, a.z * s, a.w * s); }
__device__ __forceinline__ float f4dot(float4 a, float4 b) { return a.x * b.x + a.y * b.y + a.z * b.z + a.w * b.w; }
__device__ __forceinline__ uint2 pk4(float4 v) { return make_uint2(pk2(v.x, v.y), pk2(v.z, v.w)); }
__device__ __forceinline__ float4 up4(uint2 u) { return make_float4(__uint_as_float(u.x << 16), __uint_as_float(u.x & 0xffff0000u), __uint_as_float(u.y << 16), __uint_as_float(u.y & 0xffff0000u)); }
__device__ __forceinline__ float4 ld4h(const bf16_t* p) { return up4(*(const uint2*)p); }

__device__ __forceinline__ void rope32(float* v, int t, const float* tab) {
    const float4* tp = (const float4*)(tab + (size_t)t * 32);
    float cs[32];
#pragma unroll
    for (int i = 0; i < 8; ++i) { const float4 x = tp[i]; cs[4 * i] = x.x; cs[4 * i + 1] = x.y; cs[4 * i + 2] = x.z; cs[4 * i + 3] = x.w; }
#pragma unroll
    for (int i = 0; i < 8; ++i) {
        { const float c = cs[i], sn = cs[8 + i]; const float x1 = v[i], x2 = v[8 + i]; v[i] = x1 * c - x2 * sn; v[8 + i] = x1 * sn + x2 * c; }
        { const float c = cs[16 + i], sn = cs[24 + i]; const float x1 = v[16 + i], x2 = v[24 + i]; v[16 + i] = x1 * c - x2 * sn; v[24 + i] = x1 * sn + x2 * c; }
    }
}
__device__ __forceinline__ int tok_row(bool lat, int b, int t) { return lat ? b * S + t : NLAT + b * CTX + t; }

namespace pg8 {
#define PG8_LAS __attribute__((address_space(3)))
typedef short bf16x8 __attribute__((ext_vector_type(8)));
typedef float f32x4 __attribute__((ext_vector_type(4)));
typedef unsigned u32x4 __attribute__((ext_vector_type(4)));
constexpr int BM = 256, BK = 64, HALF = 128, HTB = HALF * BK * 2  , STAGE_BYTES = 8 * HTB, NXCD = 8, WGM = 8;

__host__ __device__ __forceinline__ int lds_byte(int r, int c) { const int st = (r >> 4) * 2 + (c >> 5), rr = r & 15, cc = c & 31, ob = rr * 64 + cc * 2; return st * 1024 + (ob ^ (((ob >> 9) & 1) << 5)); }
__host__ __device__ __forceinline__ void stage_rc(int b, int& R, int& C) { const int st = b / 1024, sb = b % 1024, swz = sb ^ (((sb >> 9) & 1) << 5); R = (st >> 1) * 16 + swz / 64; C = (st & 1) * 32 + (swz % 64) / 2; }
__host__ __device__ __forceinline__ int perm32(int rho) { const int n = rho >> 4, i = rho & 15; return 8 * (i >> 2) + 4 * n + (i & 3); }

struct Unit { int pm, pn; };
struct Gemm { const bf16_t* A; const bf16_t* Bt; int M, N, K; int grp_tiles; size_t grp_stride; };

struct StaticOrder {
    int nM, nN, nwg, G, c;
    __host__ __device__ void init(int M, int N, int G_, int c_) { nM = M / BM; nN = N / BM; nwg = nM * nN; G = G_; c = c_; }
    __host__ __device__ bool next(int i, Unit& u) const {
        const long L = (long)i * G + c; if (L >= nwg) return false;
        int wgid = (int)L; { const int q = nwg / NXCD, r = nwg % NXCD, xcd = wgid % NXCD, off = wgid / NXCD; wgid = (xcd < r ? xcd * (q + 1) : r * (q + 1) + (xcd - r) * q) + off; }
        const int nig = WGM * nN, gid = wgid / nig, fm = gid * WGM, gsz = (nM - fm) < WGM ? (nM - fm) : WGM;
        u.pm = fm + ((wgid % nig) % gsz); u.pn = (wgid % nig) / gsz; return true;
    }
    __device__ __forceinline__ void a_ready(const Unit&) const {}
    __device__ __forceinline__ void done(const Unit&) const {}
};

__device__ __forceinline__ unsigned cvt_pk_bf16(float lo, float hi) { unsigned r; asm volatile("v_cvt_pk_bf16_f32 %0, %1, %2" : "=v"(r) : "v"(lo), "v"(hi)); return r; }

typedef unsigned u32x2 __attribute__((ext_vector_type(2)));
struct EpiF32 {
    static constexpr bool PERM = false, AFTER_DRAIN = false;
    float* C; int ldc; int ncols;
    __device__ __forceinline__ void operator()(const f32x4 (&acc)[2][2][4][2], const Unit& u, int wr, int wc, int fr, int fq) const {
        const int row0 = u.pm * BM + wr * 64 + fr, col0 = u.pn * BM + wc * 32 + 4 * fq;
#pragma unroll
        for (int ai = 0; ai < 2; ++ai)
#pragma unroll
            for (int m = 0; m < 4; ++m) { float* rowp = C + (size_t)(row0 + ai * HALF + m * 16) * ldc;
#pragma unroll
                for (int bj = 0; bj < 2; ++bj)
#pragma unroll
                    for (int n = 0; n < 2; ++n) { const int col = col0 + bj * HALF + n * 16; if (col < ncols) *(f32x4*)(rowp + col) = acc[ai][bj][m][n]; } }
    }
};
struct EpiRowScaleF32 {
    static constexpr bool PERM = false, AFTER_DRAIN = false;
    float* C; int ldc; const float* gate; int er;
    __device__ __forceinline__ void operator()(const f32x4 (&acc)[2][2][4][2], const Unit& u, int wr, int wc, int fr, int fq) const {
        const int row0 = u.pm * BM + wr * 64 + fr, col0 = u.pn * BM + wc * 32 + 4 * fq;
#pragma unroll
        for (int ai = 0; ai < 2; ++ai)
#pragma unroll
            for (int m = 0; m < 4; ++m) { const int row = row0 + ai * HALF + m * 16; float* rowp = C + (size_t)row * ldc; const float sc = gate[(row / er) * ER_MAX + row % er];
#pragma unroll
                for (int bj = 0; bj < 2; ++bj)
#pragma unroll
                    for (int n = 0; n < 2; ++n) *(f32x4*)(rowp + col0 + bj * HALF + n * 16) = acc[ai][bj][m][n] * sc; }
    }
};
struct EpiSwiGLU {
    static constexpr bool PERM = true, AFTER_DRAIN = false;
    bf16_t* O; int ldo;
    __device__ __forceinline__ void operator()(const f32x4 (&acc)[2][2][4][2], const Unit& u, int wr, int wc, int fr, int fq) const {
        const int row0 = u.pm * BM + wr * 64 + fr, col0 = u.pn * BM + wc * 32 + 8 * fq;
#pragma unroll
        for (int ai = 0; ai < 2; ++ai)
#pragma unroll
            for (int m = 0; m < 4; ++m) { bf16_t* rowp = O + (size_t)(row0 + ai * HALF + m * 16) * ldo;
#pragma unroll
                for (int bj = 0; bj < 2; ++bj) { const f32x4 gt = acc[ai][bj][m][0], up = acc[ai][bj][m][1]; f32x4 h;
#pragma unroll
                    for (int i = 0; i < 4; ++i) h[i] = gt[i] / (1.0f + __expf(-gt[i])) * up[i];
                    u32x2 w; w.x = cvt_pk_bf16(h[0], h[1]); w.y = cvt_pk_bf16(h[2], h[3]);
                    *(u32x2*)(rowp + (col0 + bj * HALF) / 2) = w; } }
    }
};

struct EpiBf16 {
    static constexpr bool PERM = true, AFTER_DRAIN = false;
    bf16_t* O; int ldo; int ncols;
    __device__ __forceinline__ void operator()(const f32x4 (&acc)[2][2][4][2], const Unit& u, int wr, int wc, int fr, int fq) const {
        const int row0 = u.pm * BM + wr * 64 + fr, col0 = u.pn * BM + wc * 32 + 8 * fq;
#pragma unroll
        for (int ai = 0; ai < 2; ++ai)
#pragma unroll
            for (int m = 0; m < 4; ++m) { bf16_t* rowp = O + (size_t)(row0 + ai * HALF + m * 16) * ldo;
#pragma unroll
                for (int bj = 0; bj < 2; ++bj) { const int col = col0 + bj * HALF; const f32x4 v0 = acc[ai][bj][m][0], v1 = acc[ai][bj][m][1];
                    u32x4 w; w.x = cvt_pk_bf16(v0[0], v0[1]); w.y = cvt_pk_bf16(v0[2], v0[3]); w.z = cvt_pk_bf16(v1[0], v1[1]); w.w = cvt_pk_bf16(v1[2], v1[3]);
                    if (col < ncols) *(u32x4*)(rowp + col) = w; } }
    }
};
struct EpiRowScaleBf16 {
    static constexpr bool PERM = true, AFTER_DRAIN = false;
    bf16_t* O; int ldo; const float* gate; int er;
    __device__ __forceinline__ void operator()(const f32x4 (&acc)[2][2][4][2], const Unit& u, int wr, int wc, int fr, int fq) const {
        const int row0 = u.pm * BM + wr * 64 + fr, col0 = u.pn * BM + wc * 32 + 8 * fq;
#pragma unroll
        for (int ai = 0; ai < 2; ++ai)
#pragma unroll
            for (int m = 0; m < 4; ++m) { const int row = row0 + ai * HALF + m * 16; bf16_t* rowp = O + (size_t)row * ldo; const float sc = gate[(row / er) * ER_MAX + row % er];
#pragma unroll
                for (int bj = 0; bj < 2; ++bj) { const f32x4 v0 = acc[ai][bj][m][0] * sc, v1 = acc[ai][bj][m][1] * sc;
                    u32x4 w; w.x = cvt_pk_bf16(v0[0], v0[1]); w.y = cvt_pk_bf16(v0[2], v0[3]); w.z = cvt_pk_bf16(v1[0], v1[1]); w.w = cvt_pk_bf16(v1[2], v1[3]);
                    *(u32x4*)(rowp + col0 + bj * HALF) = w; } }
    }
};
template <class Epi, class Sched, bool ALIGN_EPI = false, bool SP2 = false>
__device__ __forceinline__ void gemm_phase(PG8_LAS unsigned char* lds, const Gemm g, const Sched& S, const Epi& E, int tid_in) {
    int tid_ = tid_in; asm volatile("" : "+v"(tid_));
    const int tid = tid_, wid = __builtin_amdgcn_readfirstlane(tid >> 6), lane = tid & 63, wr = wid >> 2, wc = wid & 3, fr = lane & 15, fq = lane >> 4;
    int K_ = g.K; asm volatile("" : "+s"(K_));
    const int K = K_, nt = K / BK;
    unsigned voffA[2], voffB[2];
#pragma unroll
    for (int i = 0; i < 2; ++i) { int R, C; stage_rc(tid * 16 + i * 8192, R, C); const int Rb = Epi::PERM ? ((R & ~31) + perm32(R & 31)) : R;
        voffA[i] = (unsigned)(R * K + C) * 2u; voffB[i] = (unsigned)(Rb * K + C) * 2u; }
    const size_t kstep = (size_t)(BK * 2);
    const size_t hstep = (size_t)HALF * K * 2;
    const size_t tstep = 2 * hstep;
    const unsigned ldsw = (unsigned)wid * 1024u;
    const int aoff = lds_byte(wr * 64 + fr, fq * 8), boff = lds_byte(wc * 32 + fr, fq * 8);
#define PG8_SA(b, h) (((b) * 2 + (h)) * HTB)
#define PG8_SB(b, h) ((4 + (b) * 2 + (h)) * HTB)
#define PG8_STAGE(bufoff, gbase, voff) do { _Pragma("unroll") for (int _i = 0; _i < 2; ++_i) \
        __builtin_amdgcn_global_load_lds((const unsigned*)((const char*)(gbase) + (voff)[_i]), (PG8_LAS unsigned*)(lds + (bufoff) + ldsw + _i * 8192), 16, 0, 0); } while (0)
#define PG8_LDA(dst, b, h) do { _Pragma("unroll") for (int m = 0; m < 4; ++m) _Pragma("unroll") for (int k = 0; k < 2; ++k) dst[m][k] = *(const PG8_LAS bf16x8*)(lds + PG8_SA(b, h) + aoff + m * 2048 + k * 1024); } while (0)
#define PG8_LDB(dst, b, h) do { _Pragma("unroll") for (int n = 0; n < 2; ++n) _Pragma("unroll") for (int k = 0; k < 2; ++k) dst[n][k] = *(const PG8_LAS bf16x8*)(lds + PG8_SB(b, h) + boff + n * 2048 + k * 1024); } while (0)
#define PG8_MMA(ai, bj, At, Bt) do { __builtin_amdgcn_s_setprio(1); _Pragma("unroll") for (int m = 0; m < 4; ++m) _Pragma("unroll") for (int n = 0; n < 2; ++n) _Pragma("unroll") for (int k = 0; k < 2; ++k) \
        acc[ai][bj][m][n] = __builtin_amdgcn_mfma_f32_16x16x32_bf16(Bt[n][k], At[m][k], acc[ai][bj][m][n], 0, 0, 0); __builtin_amdgcn_s_setprio(0); } while (0)
#define PG8_WAIT_V(n) asm volatile("s_waitcnt vmcnt(" #n ")" ::: "memory")
#define PG8_WAIT_L(n) asm volatile("s_waitcnt lgkmcnt(" #n ")" ::: "memory")
#define PG8_BAR __builtin_amdgcn_s_barrier()
#define PG8_SCHED __builtin_amdgcn_sched_barrier(0)
    Unit cur, nxt; int ui = 0;
    if (!S.next(0, cur)) return;
    f32x4 acc[2][2][4][2];
#pragma unroll
    for (int a = 0; a < 2; ++a)
#pragma unroll
        for (int b = 0; b < 2; ++b)
#pragma unroll
            for (int m = 0; m < 4; ++m)
#pragma unroll
                for (int n = 0; n < 2; ++n) acc[a][b][m][n] = (f32x4){0.f, 0.f, 0.f, 0.f};
    bf16x8 At[4][2], B0[2][2], B1[2][2];
    const char* cA = (const char*)g.A + (size_t)cur.pm * tstep; const char* cB = (const char*)g.Bt + (size_t)cur.pn * tstep + (g.grp_tiles ? (size_t)(cur.pm / g.grp_tiles) * g.grp_stride : (size_t)0);
    S.a_ready(cur);
    if constexpr (SP2) {
        PG8_STAGE(PG8_SB(0, 0), cB, voffB); PG8_STAGE(PG8_SB(0, 1), cB + hstep, voffB); PG8_STAGE(PG8_SA(0, 0), cA, voffA); PG8_STAGE(PG8_SA(0, 1), cA + hstep, voffA);
        if (wr == 1) PG8_BAR;
        PG8_WAIT_V(2); PG8_BAR;
        PG8_STAGE(PG8_SB(1, 0), cB + kstep, voffB); PG8_STAGE(PG8_SA(1, 0), cA + kstep, voffA); PG8_STAGE(PG8_SB(1, 1), cB + hstep + kstep, voffB);
        PG8_WAIT_V(6); PG8_BAR;
    } else {
        PG8_STAGE(PG8_SB(0, 0), cB, voffB); PG8_STAGE(PG8_SA(0, 0), cA, voffA); PG8_STAGE(PG8_SB(0, 1), cB + hstep, voffB); PG8_STAGE(PG8_SA(0, 1), cA + hstep, voffA);
        if (wr == 1) PG8_BAR;
        PG8_WAIT_V(4); PG8_BAR;
        PG8_STAGE(PG8_SB(1, 0), cB + kstep, voffB); PG8_STAGE(PG8_SA(1, 0), cA + kstep, voffA); PG8_STAGE(PG8_SB(1, 1), cB + hstep + kstep, voffB);
        PG8_WAIT_V(6); PG8_BAR;
    }
    for (;;) {
        const bool has_next = S.next(ui + 1, nxt);
        const char* nA = has_next ? (const char*)g.A + (size_t)nxt.pm * tstep : cA; const char* nB = has_next ? (const char*)g.Bt + (size_t)nxt.pn * tstep + (g.grp_tiles ? (size_t)(nxt.pm / g.grp_tiles) * g.grp_stride : (size_t)0) : cB;
        for (int t = 0; t < nt; t += 2) {
            const bool last = (t == nt - 2);
            const char* a1 = cA + (size_t)(t + 1) * kstep;
            const char* a2 = last ? nA : cA + (size_t)(t + 2) * kstep; const char* b2 = last ? nB : cB + (size_t)(t + 2) * kstep;
            const char* a3 = a2 + kstep; const char* b3 = b2 + kstep;
            if (last && has_next) S.a_ready(nxt);
            if constexpr (SP2) {
            PG8_LDB(B0, 0, 0); PG8_LDB(B1, 0, 1); PG8_SCHED; PG8_LDA(At, 0, 0); PG8_STAGE(PG8_SA(1, 1), a1 + hstep, voffA);
            PG8_WAIT_V(8); PG8_WAIT_L(0); PG8_BAR; PG8_MMA(0, 0, At, B0); PG8_MMA(0, 1, At, B1); PG8_BAR; PG8_SCHED;
            PG8_LDA(At, 0, 1); PG8_STAGE(PG8_SB(0, 0), b2, voffB); PG8_STAGE(PG8_SB(0, 1), b2 + hstep, voffB); PG8_STAGE(PG8_SA(0, 0), a2, voffA);
            PG8_WAIT_V(8); PG8_WAIT_L(0); PG8_BAR; PG8_MMA(1, 0, At, B0); PG8_MMA(1, 1, At, B1); PG8_BAR; PG8_SCHED;
            PG8_LDB(B0, 1, 0); PG8_LDB(B1, 1, 1); PG8_SCHED; PG8_LDA(At, 1, 0); PG8_STAGE(PG8_SA(0, 1), a2 + hstep, voffA);
            PG8_WAIT_V(8); PG8_WAIT_L(0); PG8_BAR; PG8_MMA(0, 0, At, B0); PG8_MMA(0, 1, At, B1); PG8_BAR; PG8_SCHED;
            PG8_LDA(At, 1, 1); PG8_STAGE(PG8_SB(1, 0), b3, voffB); PG8_STAGE(PG8_SB(1, 1), b3 + hstep, voffB); PG8_STAGE(PG8_SA(1, 0), a3, voffA);
            PG8_WAIT_V(8); PG8_WAIT_L(0); PG8_BAR; PG8_MMA(1, 0, At, B0); PG8_MMA(1, 1, At, B1); PG8_BAR; PG8_SCHED;
            } else {
            PG8_LDB(B0, 0, 0); PG8_SCHED; PG8_LDA(At, 0, 0); PG8_STAGE(PG8_SA(1, 1), a1 + hstep, voffA);
            PG8_WAIT_L(8); PG8_BAR; PG8_WAIT_L(0); PG8_MMA(0, 0, At, B0); PG8_BAR; PG8_SCHED;
            PG8_LDB(B1, 0, 1); PG8_STAGE(PG8_SB(0, 0), b2, voffB);
            PG8_BAR; PG8_WAIT_L(0); PG8_MMA(0, 1, At, B1); PG8_BAR;
            PG8_LDA(At, 0, 1); PG8_STAGE(PG8_SA(0, 0), a2, voffA);
            PG8_BAR; PG8_WAIT_L(0); PG8_MMA(1, 0, At, B0); PG8_BAR; PG8_SCHED;
            PG8_STAGE(PG8_SB(0, 1), b2 + hstep, voffB);
            PG8_WAIT_V(6); PG8_BAR; PG8_MMA(1, 1, At, B1); PG8_BAR;
            PG8_LDB(B0, 1, 0); PG8_SCHED; PG8_LDA(At, 1, 0); PG8_STAGE(PG8_SA(0, 1), a2 + hstep, voffA);
            PG8_WAIT_L(8); PG8_BAR; PG8_WAIT_L(0); PG8_MMA(0, 0, At, B0); PG8_BAR; PG8_SCHED;
            PG8_LDB(B1, 1, 1); PG8_STAGE(PG8_SB(1, 0), b3, voffB);
            PG8_BAR; PG8_WAIT_L(0); PG8_MMA(0, 1, At, B1); PG8_BAR;
            PG8_LDA(At, 1, 1); PG8_STAGE(PG8_SA(1, 0), a3, voffA);
            PG8_BAR; PG8_WAIT_L(0); PG8_MMA(1, 0, At, B0); PG8_BAR; PG8_SCHED;
            PG8_STAGE(PG8_SB(1, 1), b3 + hstep, voffB);
            PG8_WAIT_V(6); PG8_BAR; PG8_MMA(1, 1, At, B1); PG8_BAR;
            }
        }
        if constexpr (ALIGN_EPI) { if (wr == 0) PG8_BAR; }
        if constexpr (!Epi::AFTER_DRAIN) { E(acc, cur, wr, wc, fr, fq); S.done(cur); }
        if (!has_next) break;
#pragma unroll
        for (int a = 0; a < 2; ++a)
#pragma unroll
            for (int b = 0; b < 2; ++b)
#pragma unroll
                for (int m = 0; m < 4; ++m)
#pragma unroll
                    for (int n = 0; n < 2; ++n) acc[a][b][m][n] = (f32x4){0.f, 0.f, 0.f, 0.f};
        cur = nxt; cA = nA; cB = nB; ++ui;
        if constexpr (ALIGN_EPI) { if (wr == 1) PG8_BAR; }
    }
    PG8_WAIT_V(0);
    if constexpr (!ALIGN_EPI) { if (wr == 0) PG8_BAR; }
    PG8_BAR;
    if constexpr (Epi::AFTER_DRAIN) { E.fused(acc, cur, wr, wc, fr, fq, lds, wid, lane); S.done(cur); }
#undef PG8_SA
#undef PG8_SB
#undef PG8_STAGE
#undef PG8_LDA
#undef PG8_LDB
#undef PG8_MMA
#undef PG8_WAIT_V
#undef PG8_WAIT_L
#undef PG8_BAR
#undef PG8_SCHED
}
}


#define XB_TMO      128
#define XB_XCNT(j)  (256  + 64 * (j))
#define XB_XSUB(j)  (1280 + 64 * (j))
#define XB_XGEN(j)  (2304 + 64 * (j))
#define XB_TOP      3328
#define XB_TOPGEN   3392
#define XCD_BAR_WORDS 3456
#define XB_SPIN_CAP (1u << 22)
__device__ __forceinline__ unsigned xb_ld(unsigned* p)              { return __hip_atomic_load(p, __ATOMIC_RELAXED, __HIP_MEMORY_SCOPE_AGENT); }
__device__ __forceinline__ unsigned xb_add(unsigned* p, unsigned v) { return __hip_atomic_fetch_add(p, v, __ATOMIC_RELAXED, __HIP_MEMORY_SCOPE_AGENT); }
__device__ __forceinline__ unsigned xb_xcc_id() { return (unsigned)__builtin_amdgcn_s_getreg((3 << 11) | 20) & 0xFu; }
#define XB_SPIN(cond, bar) do { unsigned _sp = 0; while (cond) { __builtin_amdgcn_s_sleep(1); \
    if ((++_sp & 255u) == 0u) { if (xb_ld(&(bar)[XB_TMO])) break; if (_sp > XB_SPIN_CAP) { atomicAdd(&(bar)[XB_TMO], 1u); break; } } } } while (0)
struct XcdBarrier { unsigned* bar; unsigned x; volatile LAS unsigned* st; };
__device__ __forceinline__ XcdBarrier xcd_barrier_post(unsigned* bar, volatile LAS unsigned* st, int tid_in) {
    XcdBarrier b; b.bar = bar; b.x = xb_xcc_id(); b.st = st;
    if (tid_in == 0) (void)xb_add(&bar[XB_XCNT(b.x)], 1u);
    return b;
}
__device__ __forceinline__ void xcd_barrier_complete(unsigned* bar, unsigned x, unsigned& nloc, unsigned& nx) {
    const unsigned G = gridDim.x * gridDim.y * gridDim.z;
    unsigned sum, cnt, mine, sp = 0u;
    for (;;) {
        sum = 0u; cnt = 0u; mine = 0u;
#pragma unroll
        for (unsigned j = 0; j < 16; ++j) { const unsigned c = xb_ld(&bar[XB_XCNT(j)]); sum += c; cnt += (c > 0u) ? 1u : 0u; mine = (j == x) ? c : mine; }
        if (sum == G) break;
        __builtin_amdgcn_s_sleep(1);
        if ((++sp & 255u) == 0u) { if (xb_ld(&bar[XB_TMO])) break; if (sp > XB_SPIN_CAP) { atomicAdd(&bar[XB_TMO], 1u); break; } }
    }
    nloc = mine > 0u ? mine : 1u; nx = cnt > 0u ? cnt : 1u;
}
__device__ __forceinline__ void xcd_barrier(const XcdBarrier& b, int tid_in) {
    asm volatile("s_waitcnt vmcnt(0)" ::: "memory");
    __syncthreads();
    if (tid_in == 0) {
        unsigned* bar = b.bar;
        __builtin_amdgcn_s_waitcnt(0);
        unsigned nloc = b.st[0], nx = b.st[1];
        if (nloc == 0u) { xcd_barrier_complete(bar, b.x, nloc, nx); b.st[0] = nloc; b.st[1] = nx; }
        const unsigned old = xb_add(&bar[XB_XSUB(b.x)], 1u);
        const unsigned gen = old / nloc;
        if (old + 1u == (gen + 1u) * nloc) {
            __builtin_amdgcn_fence(__ATOMIC_RELEASE, "agent");
            asm volatile("s_waitcnt vmcnt(0)" ::: "memory");
            const unsigned og = xb_add(&bar[XB_TOP], 1u);
            const unsigned tg = og / nx;
            if (og + 1u == (tg + 1u) * nx) xb_add(&bar[XB_TOPGEN], 1u);
            else XB_SPIN(xb_ld(&bar[XB_TOPGEN]) == tg, bar);
            __builtin_amdgcn_fence(__ATOMIC_ACQUIRE, "agent");
            xb_add(&bar[XB_XGEN(b.x)], 1u);
            asm volatile("s_waitcnt vmcnt(0)" ::: "memory");
        } else {
            XB_SPIN(xb_ld(&bar[XB_XGEN(b.x)]) == gen, bar);
            __builtin_amdgcn_fence(__ATOMIC_ACQUIRE, "agent");
            asm volatile("s_waitcnt vmcnt(0)" ::: "memory");
        }
    }
    __syncthreads();
}


typedef short bf16x8 __attribute__((ext_vector_type(8)));
typedef short s16x4 __attribute__((ext_vector_type(4)));
typedef float f32x16 __attribute__((ext_vector_type(16)));
typedef unsigned v4u __attribute__((ext_vector_type(4)));
typedef unsigned v2u __attribute__((ext_vector_type(2)));
constexpr float ATT_THR = 5.0f;
template <int DK> struct AttL { static constexpr int KSTR = DK * 2 + 16, KBYTES = 64 * KSTR, VSTR = 136, VBYTES = 64 * VSTR, KCH = 64 * DK / 8, KPT = (KCH + NTHREADS - 1) / NTHREADS;
    static constexpr int K_OFF = 0, V_OFF = 2 * KBYTES; };

template <int DK>
__device__ __forceinline__ void attn_pass(const bf16_t* Qrow, const bf16_t* Kp, const bf16_t* Vtp, int vt_ld, int nkt, LAS unsigned char* lds, int tid, f32x16 (&oacc)[2], float& l_run) {
    typedef AttL<DK> L;
    constexpr bool AUG = DK <= 32;
    const int lane = tid & 63, r = lane & 31, h = lane >> 5;
    bf16x8 qf[DK / 16];
#pragma unroll
    for (int ks = 0; ks < DK / 16; ++ks) qf[ks] = *(const bf16x8*)(Qrow + 16 * ks + 8 * h);
    const short z_ = (short)(tid >> 20);
    bf16x8 aone = {z_, z_, z_, z_, z_, z_, z_, z_}, bneg = {z_, z_, z_, z_, z_, z_, z_, z_};
    if (h == 0) aone[0] = (short)0x3F80;
    float m_run = 0.f;
    v4u kreg[L::KPT]; v4u vreg;
    const int vd = tid >> 3, vpart = tid & 7;
#define ATT_LOADK(j) do { _Pragma("unroll") for (int i_ = 0; i_ < L::KPT; ++i_) { const int c_ = tid + i_ * NTHREADS; if (c_ < L::KCH) kreg[i_] = *(const v4u*)(Kp + (size_t)(j) * 64 * DK + c_ * 8); } } while (0)
#define ATT_LOADV(j) do { vreg = *(const v4u*)(Vtp + (size_t)vd * vt_ld + (j) * 64 + vpart * 8); } while (0)
#define ATT_STOREK(buf) do { _Pragma("unroll") for (int i_ = 0; i_ < L::KPT; ++i_) { const int c_ = tid + i_ * NTHREADS; if (c_ < L::KCH) { const int key_ = c_ / (DK / 8), part_ = c_ % (DK / 8); \
            *(LAS v4u*)(lds + L::K_OFF + (buf) * L::KBYTES + key_ * L::KSTR + part_ * 16) = kreg[i_]; } } } while (0)
#define ATT_STOREV(buf) do { LAS unsigned char* vp_ = lds + L::V_OFF + (buf) * L::VBYTES + vd * L::VSTR + vpart * 16; *(LAS v2u*)vp_ = (v2u){vreg.x, vreg.y}; *(LAS v2u*)(vp_ + 8) = (v2u){vreg.z, vreg.w}; } while (0)
#define ATT_QK(dst, buf) do { _Pragma("unroll") for (int kb = 0; kb < 2; ++kb) { _Pragma("unroll") for (int i = 0; i < 16; ++i) dst[kb][i] = 0.f; \
        if (AUG) dst[kb] = __builtin_amdgcn_mfma_f32_32x32x16_bf16(aone, bneg, dst[kb], 0, 0, 0); \
        _Pragma("unroll") for (int ks = 0; ks < DK / 16; ++ks) { const bf16x8 a_ = *(const LAS bf16x8*)(lds + L::K_OFF + (buf) * L::KBYTES + (32 * kb + r) * L::KSTR + (16 * ks + 8 * h) * 2); \
            dst[kb] = __builtin_amdgcn_mfma_f32_32x32x16_bf16(a_, qf[ks], dst[kb], 0, 0, 0); } } } while (0)
#define ATT_BODY(SC, SN, j) do { \
        if ((j) + 2 < nkt) ATT_LOADK((j) + 2); \
        if ((j) + 1 < nkt) { ATT_LOADV((j) + 1); ATT_QK(SN, ((j) + 1) & 1); } \
        if (((j) & 3) == 0) { \
            float t0 = fmaxf(fmaxf(SC[0][0], SC[0][1]), SC[0][2]), t1 = fmaxf(fmaxf(SC[0][3], SC[0][4]), SC[0][5]), t2 = fmaxf(fmaxf(SC[0][6], SC[0][7]), SC[0][8]), t3 = fmaxf(fmaxf(SC[0][9], SC[0][10]), SC[0][11]); \
            float t4 = fmaxf(fmaxf(SC[0][12], SC[0][13]), SC[0][14]), t5 = fmaxf(fmaxf(SC[0][15], SC[1][0]), SC[1][1]), t6 = fmaxf(fmaxf(SC[1][2], SC[1][3]), SC[1][4]), t7 = fmaxf(fmaxf(SC[1][5], SC[1][6]), SC[1][7]); \
            float t8 = fmaxf(fmaxf(SC[1][8], SC[1][9]), SC[1][10]), t9 = fmaxf(fmaxf(SC[1][11], SC[1][12]), SC[1][13]), t10 = fmaxf(SC[1][14], SC[1][15]); \
            float tmax = fmaxf(fmaxf(fmaxf(fmaxf(t0, t1), t2), fmaxf(fmaxf(t3, t4), t5)), fmaxf(fmaxf(fmaxf(t6, t7), t8), fmaxf(t9, t10))); \
            tmax = xor32_max(tmax); if (!AUG) tmax -= m_run;            \
            if ((j) == 0 || __any(tmax > ATT_THR)) {                   \
                const float want = (j) == 0 ? tmax : m_run + fmaxf(tmax, 0.f); \
                const float mn = __uint_as_float(pk2(want, 0.f) << 16), dlt = mn - m_run, alpha = __builtin_amdgcn_exp2f(-dlt); \
                _Pragma("unroll") for (int i = 0; i < 16; ++i) { oacc[0][i] *= alpha; oacc[1][i] *= alpha; if (AUG) { SC[0][i] -= dlt; SC[1][i] -= dlt; SN[0][i] -= dlt; SN[1][i] -= dlt; } } \
                l_run *= alpha; m_run = mn; if (AUG && h == 0) bneg[0] = (short)(__float_as_uint(-mn) >> 16); \
            } \
        } \
        float ps0 = 0.f, ps1 = 0.f, ps2 = 0.f, ps3 = 0.f; \
        _Pragma("unroll") for (int kb = 0; kb < 2; ++kb) \
            _Pragma("unroll") for (int i = 0; i < 16; i += 4) { const float mo = AUG ? 0.f : m_run; const float p0 = __builtin_amdgcn_exp2f(SC[kb][i] - mo), p1 = __builtin_amdgcn_exp2f(SC[kb][i + 1] - mo), p2 = __builtin_amdgcn_exp2f(SC[kb][i + 2] - mo), p3 = __builtin_amdgcn_exp2f(SC[kb][i + 3] - mo); \
                SC[kb][i] = p0; SC[kb][i + 1] = p1; SC[kb][i + 2] = p2; SC[kb][i + 3] = p3; ps0 += p0; ps1 += p1; ps2 += p2; ps3 += p3; } \
        l_run += (ps0 + ps1) + (ps2 + ps3); \
        _Pragma("unroll") for (int kb = 0; kb < 2; ++kb) \
            _Pragma("unroll") for (int s2 = 0; s2 < 2; ++s2) { \
                union { bf16x8 v; unsigned u[4]; } pf; \
                _Pragma("unroll") for (int i = 0; i < 4; ++i) pf.u[i] = pk2(SC[kb][8 * s2 + 2 * i], SC[kb][8 * s2 + 2 * i + 1]); \
                _Pragma("unroll") for (int db = 0; db < 2; ++db) { \
                    const LAS unsigned char* vp = lds + L::V_OFF + ((j) & 1) * L::VBYTES + (32 * db + r) * L::VSTR + (32 * kb + 16 * s2 + 4 * h) * 2; \
                    union { bf16x8 v; v2u u[2]; } af; af.u[0] = *(const LAS v2u*)vp; af.u[1] = *(const LAS v2u*)(vp + 16); \
                    oacc[db] = __builtin_amdgcn_mfma_f32_32x32x16_bf16(af.v, pf.v, oacc[db], 0, 0, 0); } } \
        if ((j) + 2 < nkt) ATT_STOREK((j) & 1);               \
        if ((j) + 1 < nkt) ATT_STOREV(((j) + 1) & 1);         \
        __syncthreads(); \
    } while (0)
    __syncthreads();
    ATT_LOADK(0); ATT_LOADV(0); ATT_STOREK(0); ATT_STOREV(0);
    if (nkt > 1) { ATT_LOADK(1); ATT_STOREK(1); }
    __syncthreads();
    f32x16 sa[2], sb[2];
#pragma unroll
    for (int i = 0; i < 16; ++i) { sb[0][i] = (float)z_; sb[1][i] = (float)z_; }
    ATT_QK(sa, 0);
    for (int j = 0; j < nkt; j += 2) {
        ATT_BODY(sa, sb, j);
        if (j + 1 < nkt) ATT_BODY(sb, sa, j + 1);
    }
#undef ATT_BODY
#undef ATT_LOADK
#undef ATT_LOADV
#undef ATT_STOREK
#undef ATT_STOREV
#undef ATT_QK
}


constexpr int SLD = 65, SHLD = 72, XTLD = 132;
__device__ __forceinline__ int rm32(int t, int h) { return (t & 3) + 8 * (t >> 2) + 4 * h; }
template <bool WITH_Y>
__device__ __forceinline__ void ssd_block(int b, int dir, int k, int hp, const bf16_t* xbc, const float* dtp, const float* alog, float* hs, float* alast, bf16_t* yd, float* lds, int tid) {
    const bool lat = k >= 2; const int c = lat ? (dir ? 33 - k : k - 2) : (dir ? 1 - k : k);
    const int row0 = tok_row(lat, b, c * 128), g = hp >> 1;
    float* sB = lds; bf16_t* sBh = (bf16_t*)lds; bf16_t* sCh = sBh + 128 * SHLD;
    float* sX = WITH_Y ? lds + (2 * 128 * SHLD * 2) / 4 : sB + 128 * SLD; bf16_t* sXT = (bf16_t*)sX;
    float* sDT = sX + 128 * 128; float* sCum = sDT + 256; float* sW = sCum + 256; float* sSc = sW + 256;
    const int wave = tid >> 6, lane = tid & 63, r = lane & 31, h = lane >> 5, hl = wave >> 2, head = 2 * hp + hl;
    float* hsp = hs + (((size_t)(b * 2 + dir) * NCH + k) * 8 + head) * 4096;
    union { bf16x8 v; unsigned u[4]; } hfrag[WITH_Y ? 8 : 1];
    if (WITH_Y) {
#pragma unroll
        for (int Pb = 0; Pb < 2; ++Pb)
#pragma unroll
            for (int ks = 0; ks < 4; ++ks) { const float4 x0 = *(const float4*)(hsp + (32 * Pb + r) * 64 + 16 * ks + 8 * h), x1 = *(const float4*)(hsp + (32 * Pb + r) * 64 + 16 * ks + 8 * h + 4);
                hfrag[Pb * 4 + ks].u[0] = pk2(x0.x, x0.y); hfrag[Pb * 4 + ks].u[1] = pk2(x0.z, x0.w); hfrag[Pb * 4 + ks].u[2] = pk2(x1.x, x1.y); hfrag[Pb * 4 + ks].u[3] = pk2(x1.z, x1.w); }
    }
    uint2 vb[8]; float4 vx[8]; float dx[8]; float dtv = 0.f, dav = 0.f;
#pragma unroll
    for (int u = 0; u < 8; ++u) { const int i = tid + u * NTHREADS, t = i >> 5, c4 = i & 31;
        vb[u] = *(const uint2*)(xbc + (size_t)(row0 + t) * 768 + 512 + (c4 >> 4) * 128 + g * 64 + (c4 & 15) * 4);
        vx[u] = ld4h(xbc + (size_t)(row0 + t) * 768 + hp * 128 + c4 * 4);
        dx[u] = dtp[(size_t)(row0 + t) * 16 + dir * 8 + 2 * hp + (c4 >> 4)]; }
    if (tid < 256) { const int hl = tid >> 7, t = tid & 127, h = 2 * hp + hl; dtv = dtp[(size_t)(row0 + t) * 16 + dir * 8 + h]; dav = dtv * -expf(alog[dir * 8 + h]); }
    __syncthreads();
#pragma unroll
    for (int u = 0; u < 8; ++u) { const int i = tid + u * NTHREADS, t = i >> 5, c4 = i & 31;
        if (WITH_Y) *(uint2*)((c4 >> 4 ? sCh : sBh) + t * SHLD + (c4 & 15) * 4) = vb[u];
        else if (!(c4 >> 4)) { const float4 f = up4(vb[u]); float* d = sB + t * SLD + (c4 & 15) * 4; d[0] = f.x; d[1] = f.y; d[2] = f.z; d[3] = f.w; }
        if (WITH_Y) { const float4 xs = f4scale(vx[u], dx[u]); sXT[(c4 * 4 + 0) * XTLD + t] = (bf16_t)(pk2(xs.x, 0.f)); sXT[(c4 * 4 + 1) * XTLD + t] = (bf16_t)(pk2(xs.y, 0.f)); sXT[(c4 * 4 + 2) * XTLD + t] = (bf16_t)(pk2(xs.z, 0.f)); sXT[(c4 * 4 + 3) * XTLD + t] = (bf16_t)(pk2(xs.w, 0.f)); }
        else *(float4*)(sX + t * 128 + c4 * 4) = f4scale(vx[u], dx[u]); }
    if (tid < 256) { const int t = tid & 127; sSc[(tid & 128) + (dir ? 127 - t : t)] = dav; }
    __syncthreads();
    for (int off = 1; off < 128; off <<= 1) { float v = 0.f; const int sI = tid & 127;
        if (tid < 256) { v = sSc[tid]; if (sI >= off) v += sSc[tid - off]; }
        __syncthreads(); if (tid < 256) sSc[tid] = v; __syncthreads(); }
    if (tid < 256) { const int hl = tid >> 7, sI = tid & 127, t = dir ? 127 - sI : sI; const float cu = sSc[tid], tot = sSc[hl * 128 + 127];
        sCum[hl * 128 + t] = cu; sW[hl * 128 + t] = expf(tot - cu);
        if (!WITH_Y && sI == 127) alast[((size_t)(b * 2 + dir) * NCH + k) * 8 + 2 * hp + hl] = tot; }
    __syncthreads();
    if (WITH_Y) {
        const int I = hl ? 3 - (wave & 3) : (wave & 3), ti = 32 * I + r;
        const float cum_i = sCum[hl * 128 + ti];
        f32x16 Y[2], Yo[2];
#pragma unroll
        for (int i = 0; i < 16; ++i) { Y[0][i] = 0.f; Y[1][i] = 0.f; Yo[0][i] = 0.f; Yo[1][i] = 0.f; }
        bf16x8 cfrag[4];
#pragma unroll
        for (int ks = 0; ks < 4; ++ks) cfrag[ks] = *(const bf16x8*)(sCh + (32 * I + r) * SHLD + 16 * ks + 8 * h);
#pragma unroll
        for (int Pb = 0; Pb < 2; ++Pb)
#pragma unroll
            for (int ks = 0; ks < 4; ++ks) Yo[Pb] = __builtin_amdgcn_mfma_f32_32x32x16_bf16(hfrag[Pb * 4 + ks].v, cfrag[ks], Yo[Pb], 0, 0, 0);
        const int J0 = dir ? I : 0, J1 = dir ? 3 : I;
        for (int J = J0; J <= J1; ++J) {
            f32x16 Gt;
#pragma unroll
            for (int i = 0; i < 16; ++i) Gt[i] = 0.f;
#pragma unroll
            for (int ks = 0; ks < 4; ++ks) Gt = __builtin_amdgcn_mfma_f32_32x32x16_bf16(*(const bf16x8*)(sBh + (32 * J + r) * SHLD + 16 * ks + 8 * h), cfrag[ks], Gt, 0, 0, 0);
#pragma unroll
            for (int t = 0; t < 16; ++t) { const int tj = 32 * J + rm32(t, h); const bool valid = (J != I) || (dir ? tj >= ti : tj <= ti);
                Gt[t] *= valid ? __expf(cum_i - sCum[hl * 128 + tj]) : 0.f; }
#pragma unroll
            for (int s2 = 0; s2 < 2; ++s2) {
                union { bf16x8 v; unsigned u[4]; } pf;
#pragma unroll
                for (int i = 0; i < 4; ++i) pf.u[i] = pk2(Gt[8 * s2 + 2 * i], Gt[8 * s2 + 2 * i + 1]);
#pragma unroll
                for (int Pb = 0; Pb < 2; ++Pb) {
                    const bf16_t* xp = sXT + (hl * 64 + 32 * Pb + r) * XTLD + 32 * J + 16 * s2 + 4 * h;
                    union { bf16x8 v; uint2 u[2]; } af; af.u[0] = *(const uint2*)xp; af.u[1] = *(const uint2*)(xp + 8);
                    Y[Pb] = __builtin_amdgcn_mfma_f32_32x32x16_bf16(af.v, pf.v, Y[Pb], 0, 0, 0);
                }
            }
        }
        const float ei = __expf(cum_i);
        bf16_t* yrow = yd + ((size_t)dir * NTOK + row0 + ti) * 512 + head * 64;
#pragma unroll
        for (int Pb = 0; Pb < 2; ++Pb)
#pragma unroll
            for (int tq = 0; tq < 4; ++tq)
                *(uint2*)(yrow + 32 * Pb + 8 * tq + 4 * h) = pk4(make_float4(Y[Pb][4 * tq] + ei * Yo[Pb][4 * tq], Y[Pb][4 * tq + 1] + ei * Yo[Pb][4 * tq + 1], Y[Pb][4 * tq + 2] + ei * Yo[Pb][4 * tq + 2], Y[Pb][4 * tq + 3] + ei * Yo[Pb][4 * tq + 3]));
    } else {
        const int Pb = (wave >> 1) & 1, Nb = wave & 1;
        f32x16 acc;
#pragma unroll
        for (int i = 0; i < 16; ++i) acc[i] = 0.f;
#pragma unroll 8
        for (int ks = 0; ks < 64; ++ks) { const int j = 2 * ks + h;
            acc = __builtin_amdgcn_mfma_f32_32x32x2f32(sX[j * 128 + hl * 64 + 32 * Pb + r] * sW[hl * 128 + j], sB[j * SLD + 32 * Nb + r], acc, 0, 0, 0); }
#pragma unroll
        for (int t = 0; t < 16; ++t) hsp[(32 * Pb + rm32(t, h)) * 64 + 32 * Nb + r] = acc[t];
    }
}

template <class RM>
__device__ __forceinline__ void cvt_tile(const float* src, int N, bf16_t* dst, int ldd, RM rowmap, int k0, int n0, int lane) {
    const int n = n0 + lane;
    if (n < N) {
        const float* sp = src + (size_t)k0 * N + n;
        float v[32];
#pragma unroll
        for (int kk = 0; kk < 32; ++kk) v[kk] = sp[(size_t)kk * N];
        uint4* dp = (uint4*)(dst + (size_t)rowmap(n) * ldd + k0);
#pragma unroll
        for (int i = 0; i < 4; ++i) dp[i] = make_uint4(pk2(v[8 * i], v[8 * i + 1]), pk2(v[8 * i + 2], v[8 * i + 3]), pk2(v[8 * i + 4], v[8 * i + 5]), pk2(v[8 * i + 6], v[8 * i + 7]));
    }
}
__device__ __forceinline__ int block_excl_scan(int v, int tid, volatile int* sh, int& total) {
    const int lane = tid & 63, wave = tid >> 6; int x = v;
    x += __builtin_amdgcn_update_dpp(0, x, 0x111, 0xf, 0xf, true); x += __builtin_amdgcn_update_dpp(0, x, 0x112, 0xf, 0xf, true);
    x += __builtin_amdgcn_update_dpp(0, x, 0x114, 0xf, 0xf, true); x += __builtin_amdgcn_update_dpp(0, x, 0x118, 0xf, 0xf, true);
    x += __builtin_amdgcn_update_dpp(0, x, 0x142, 0xa, 0xf, false); x += __builtin_amdgcn_update_dpp(0, x, 0x143, 0xc, 0xf, false);
    __syncthreads();
    if (lane == 63) sh[wave] = x;
    __syncthreads();
    int off = 0, tot = 0;
#pragma unroll
    for (int w = 0; w < 8; ++w) { const int c = sh[w]; tot += c; if (w < wave) off += c; }
    total = tot;
    return off + x - v;
}
__device__ __forceinline__ int block_sum(int v, int tid, volatile int* sh, int parity) {
    const int lane = tid & 63, wave = tid >> 6;
    v += __builtin_amdgcn_update_dpp(0, v, 0x111, 0xf, 0xf, true); v += __builtin_amdgcn_update_dpp(0, v, 0x112, 0xf, 0xf, true);
    v += __builtin_amdgcn_update_dpp(0, v, 0x114, 0xf, 0xf, true); v += __builtin_amdgcn_update_dpp(0, v, 0x118, 0xf, 0xf, true);
    v += __builtin_amdgcn_update_dpp(0, v, 0x142, 0xa, 0xf, false); v += __builtin_amdgcn_update_dpp(0, v, 0x143, 0xc, 0xf, false);
    if (lane == 63) sh[parity * 8 + wave] = v;
    __syncthreads();
    int tot = 0;
#pragma unroll
    for (int w = 0; w < 8; ++w) tot += sh[parity * 8 + w];
    return tot;
}

#define MOD ((float*)(kp_->ws + WS_MOD))
#define CTXC ((float*)(kp_->ws + WS_CTXC))
#define AFF ((float*)(kp_->ws + WS_AFF))
#define TOKSLOT ((int*)(kp_->ws + WS_TOKSLOT))
#define SELIDX ((int*)(kp_->ws + WS_SELIDX))
#define SELGATE ((float*)(kp_->ws + WS_SELGATE))
#define DT ((float*)(kp_->ws + WS_DT))
#define HB ((bf16_t*)(kp_->ws + WS_HB))
#define HS ((float*)(kp_->ws + WS_HS))
#define YD ((bf16_t*)(kp_->ws + WS_YD))
#define ALAST ((float*)(kp_->ws + WS_ALAST))
#define ROPE ((float*)(kp_->ws + WS_ROPE))
#define PB ((bf16_t*)(kp_->ws + WS_P))
#define XBC ((bf16_t*)(kp_->ws + WS_XBC))
#define MQ ((bf16_t*)(kp_->ws + WS_MQ))
#define MKV ((bf16_t*)(kp_->ws + WS_MKV))
#define CQB ((bf16_t*)(kp_->ws + WS_CQB))
#define CKVB ((bf16_t*)(kp_->ws + WS_CKVB))
#define MIXB ((bf16_t*)(kp_->ws + WS_MIXB))
#define MOUT ((bf16_t*)(kp_->ws + WS_MOUT))
#define XG ((bf16_t*)(kp_->ws + WS_XG))
#define HID ((bf16_t*)(kp_->ws + WS_HID))
#define Y ((bf16_t*)(kp_->ws + WS_Y))
#define WIN_T ((bf16_t*)(kp_->ws + WS_WIN))
#define WQ_T ((bf16_t*)(kp_->ws + WS_WQ))
#define WKV_T ((bf16_t*)(kp_->ws + WS_WKV))
#define WOUT_T ((bf16_t*)(kp_->ws + WS_WOUT))
#define WGU_T ((bf16_t*)(kp_->ws + WS_WGU))
#define WD_T ((bf16_t*)(kp_->ws + WS_WD))
#define QD ((bf16_t*)(kp_->ws + WS_QD))
#define QDC ((bf16_t*)(kp_->ws + WS_QDC))
#define KD ((bf16_t*)(kp_->ws + WS_KD))
#define VDT ((bf16_t*)(kp_->ws + WS_VDT))
#define QM ((bf16_t*)(kp_->ws + WS_QM))
#define QMC ((bf16_t*)(kp_->ws + WS_QMC))
#define KM ((bf16_t*)(kp_->ws + WS_KM))
#define VMT ((bf16_t*)(kp_->ws + WS_VMT))
#define xcur (kp_->out)
#define XSRC (l == 0 ? kp_->in[I_X] : (const float*)kp_->out)
#define CSRC (l == 0 ? kp_->in[I_CTX] : (const float*)CTXC)
#define DTMP XBC
#define modl (MOD + (size_t)l * (NB + 1) * NMOD * D)
typedef const __attribute__((address_space(4))) Prm* KPrm;
#define PHASE_BEGIN() KPrm kp_ = (KPrm)__builtin_amdgcn_kernarg_segment_ptr(); asm volatile("" : "+s"(kp_)); int tid = MK_TID(); asm volatile("" : "+v"(tid)); (void)tid
#define GSYNC() do { XcdBarrier b_; b_.bar = (unsigned*)(kp_->ws + WS_CTL); b_.x = xb_xcc_id(); b_.st = (volatile LAS unsigned*)(ldsb + LDS_BYTES - 64); xcd_barrier(b_, tid); } while (0)
#define CVT_MOE_RANGE(LW, ID0, ID1, SLOT, NSLOTS) do { const int lane_ = tid & 63; \
        for (int id = (ID0) + (SLOT); id < (ID1); id += (NSLOTS)) { \
            const int mat = id >> 9, tl = id & 511, e = mat / 3, which = mat % 3, k0 = (tl >> 4) * 32, n0 = (tl & 15) * 64; \
            if (which == 0) cvt_tile(kp_->in[I_WG] + ((size_t)(LW) * NE + e) * D * FF, FF, WGU_T + (size_t)e * 2 * FF * D, D, [](int n) { return (n >> 2) * 8 + (n & 3); }, k0, n0, lane_); \
            else if (which == 1) cvt_tile(kp_->in[I_WU] + ((size_t)(LW) * NE + e) * D * FF, FF, WGU_T + (size_t)e * 2 * FF * D, D, [](int n) { return (n >> 2) * 8 + 4 + (n & 3); }, k0, n0, lane_); \
            else cvt_tile(kp_->in[I_WD] + ((size_t)(LW) * NE + e) * FF * D, D, WD_T + (size_t)e * D * FF, FF, [](int n) { return n; }, k0, n0, lane_); } } while (0)
constexpr int MOE_TILES = NE * 3 * 512;
constexpr int CVT_PER_WAVE = 4;
__global__ void __launch_bounds__(NTHREADS, 2) mk_forward(Prm p) {
    extern __shared__ __attribute__((aligned(16))) unsigned char lds_raw[];
    LAS unsigned char* const ldsb = (LAS unsigned char*)lds_raw;
    volatile LAS unsigned* st = (volatile LAS unsigned*)(ldsb + LDS_BYTES - 64);
    const int wave_s = __builtin_amdgcn_readfirstlane((int)threadIdx.x >> 6);
#define MK_TID() mk_tid_impl(wave_s)
    if (MK_TID() < 16) st[MK_TID()] = 0u;
    __syncthreads();
    (void)xcd_barrier_post((unsigned*)(p.ws + WS_CTL), st, MK_TID());
    const int G = gridDim.x, bid = blockIdx.x;
    const int vcu = (G % 8 == 0) ? (bid % 8) * (G / 8) + bid / 8 : bid;

    {
        PHASE_BEGIN();
        const float* c = kp_->in[I_C]; const float* cc = kp_->in[I_CCTX]; const float* adaw = kp_->in[I_ADAW]; const float* adab = kp_->in[I_ADAB];
        float* sc_l = (float*)lds_raw;
        for (int i = tid; i < (NB + 1) * D; i += NTHREADS) { const int r = i / D, k = i % D; sc_l[i] = siluf(r < NB ? c[(size_t)r * D + k] : cc[k]); }
        __syncthreads();
        {
            float* red = sc_l + (NB + 1) * D;
            const int lane = tid & 63, wv = tid >> 6;
            for (int it = bid; it < DEPTH * (NMOD * D / 64); it += G) {
                const int l = it / (NMOD * D / 64), j = (it % (NMOD * D / 64)) * 64 + lane;
                const float* w = adaw + ((size_t)l * D + wv * 128) * NMOD * D + j;
                float a0 = 0.f, a1 = 0.f, a2 = 0.f, a3 = 0.f, a4 = 0.f;
#pragma unroll 8
                for (int k = 0; k < 128; ++k) { const float wk = w[(size_t)k * NMOD * D]; const int kk = wv * 128 + k;
                    a0 += sc_l[kk] * wk; a1 += sc_l[D + kk] * wk; a2 += sc_l[2 * D + kk] * wk; a3 += sc_l[3 * D + kk] * wk; a4 += sc_l[4 * D + kk] * wk; }
                __syncthreads();
                red[(wv * 5 + 0) * 64 + lane] = a0; red[(wv * 5 + 1) * 64 + lane] = a1; red[(wv * 5 + 2) * 64 + lane] = a2; red[(wv * 5 + 3) * 64 + lane] = a3; red[(wv * 5 + 4) * 64 + lane] = a4;
                __syncthreads();
                if (tid < 5 * 64) { const int r = tid >> 6; float acc = adab[l * NMOD * D + j - lane + (tid & 63)];
#pragma unroll
                    for (int q = 0; q < 8; ++q) acc += red[(q * 5 + r) * 64 + (tid & 63)];
                    MOD[((size_t)l * (NB + 1) + r) * NMOD * D + (j - lane) + (tid & 63)] = acc; }
            }
        }
        ITEMS(i, S * 16) {
            const int t = i >> 4, w = i & 15, ii = w & 7; const float pos = (float)(w < 8 ? t / GRID_W : t % GRID_W);
            const float ang = pos * powf(10000.0f, -(float)ii / 8.0f);
            ROPE[(size_t)t * 32 + (w < 8 ? 0 : 16) + ii] = cosf(ang); ROPE[(size_t)t * 32 + (w < 8 ? 8 : 24) + ii] = sinf(ang);
        }
        GSYNC();
    }

#pragma unroll 1
    for (int l = 0; l < DEPTH; ++l) {
        const bool ctx_out = l < DEPTH - 1;
        const float lambda_init = 0.8f - 0.6f * expf(-0.3f * (float)l);
        const int nrows_out = ctx_out ? NTOK : NLAT;
        const int ER = ctx_out ? ER_MAX : NB * CAP_L;
        int moe_done = 0;

        {
            PHASE_BEGIN();
            {
                const int lane = tid & 63; auto idm = [](int n) { return n; };
                constexpr int T_WIN = (D / 32) * ((IN_COLS + 63) / 64), T_WQ = (192 / 32) * (384 / 64), T_WKV = (128 / 32) * (512 / 64), T_WOUT = (MIXW / 32) * (D / 64);
                WITEMS(id, T_WIN + T_WQ + T_WKV + T_WOUT) {
                    if (id < T_WIN) { const int nt = (IN_COLS + 63) / 64; cvt_tile(kp_->in[I_WIN] + (size_t)l * D * IN_COLS, IN_COLS, WIN_T, D, idm, (id / nt) * 32, (id % nt) * 64, lane); }
                    else if (id < T_WIN + T_WQ) { const int u = id - T_WIN; cvt_tile(kp_->in[I_WQUP] + (size_t)l * 192 * 384, 384, WQ_T, 256, idm, (u / 6) * 32, (u % 6) * 64, lane); }
                    else if (id < T_WIN + T_WQ + T_WKV) { const int u = id - T_WIN - T_WQ; cvt_tile(kp_->in[I_WKVUP] + (size_t)l * 128 * 512, 512, WKV_T, 128, idm, (u / 8) * 32, (u % 8) * 64, lane); }
                    else { const int u = id - T_WIN - T_WQ - T_WKV; cvt_tile(kp_->in[I_WOUT] + (size_t)l * MIXW * D, D, WOUT_T, MIXW, idm, (u / 16) * 32, (u % 16) * 64, lane); }
                }
            }
            ITEMS(i, (IN_PAD - IN_COLS) * D / 8) ((uint4*)(WIN_T + (size_t)IN_COLS * D))[i] = make_uint4(0, 0, 0, 0);
            ITEMS(i, 128 * 256 / 8) ((uint4*)(WQ_T + (size_t)384 * 256))[i] = make_uint4(0, 0, 0, 0);
            ITEMS(i, 384 * 8) { const int r = i >> 3, c8 = i & 7; *(uint4*)(WQ_T + (size_t)r * 256 + 192 + c8 * 8) = make_uint4(0, 0, 0, 0); }

            const float* w = kp_->in[I_NMPRE] + l * D;
            const int lane = tid & 63;
            {
                float4 xq[4];
                { const float zf_ = (float)(tid >> 20);
#pragma unroll
                  for (int i = 0; i < 4; ++i) xq[i] = make_float4(zf_, zf_, zf_, zf_); }
                float4* aux = (float4*)lds_raw;
                __syncthreads();
                for (int i = tid; i < 11 * (D / 4); i += NTHREADS) { const int v = i / (D / 4), k4 = i % (D / 4);
                    const float* src = v == 0 ? w : modl + (size_t)((v - 1) % 5) * NMOD * D + ((v - 1) / 5) * D;
                    aux[i] = ((const float4*)src)[k4]; }
                __syncthreads();
                const int wstride = gridDim.x * 8; int r = blockIdx.x * 8 + (tid >> 6);
#define P1_LOAD(rr) do { const float4* src_ = (const float4*)((rr) < NLAT ? XSRC + (size_t)(rr) * D : CSRC + (size_t)((rr) - NLAT) * D); _Pragma("unroll") for (int i = 0; i < 4; ++i) xq[i] = src_[i * 64 + lane]; } while (0)
                if (r < NTOK) P1_LOAD(r);
                for (; r < NTOK; r += wstride) {
                    const int bsel = r < NLAT ? r / S : NB;
                    float4 v[4]; float ss = 0.f;
#pragma unroll
                    for (int i = 0; i < 4; ++i) { v[i] = xq[i]; ss += f4dot(v[i], v[i]); }
                    if (r + wstride < NTOK) P1_LOAD(r + wstride);
                    ss = wave_sum(ss);
                    const float rs = 1.0f / sqrtf(ss / D + EPS);
#pragma unroll
                    for (int i = 0; i < 4; ++i) { const int k4 = i * 64 + lane; const float4 w4 = aux[k4], sc = aux[(6 + bsel) * (D / 4) + k4], sh = aux[(1 + bsel) * (D / 4) + k4];
                        const float4 o = make_float4(v[i].x * rs * w4.x * (1.0f + sc.x) + sh.x, v[i].y * rs * w4.y * (1.0f + sc.y) + sh.y, v[i].z * rs * w4.z * (1.0f + sc.z) + sh.z, v[i].w * rs * w4.w * (1.0f + sc.w) + sh.w);
                        *(uint2*)(HB + (size_t)r * D + k4 * 4) = pk4(o); }
                }
#undef P1_LOAD
            }
            GSYNC();
        }
        {
            PHASE_BEGIN();
            pg8::Gemm g{HB, WIN_T, NTOK, IN_PAD, D, 0, 0}; pg8::StaticOrder so; so.init(NTOK, IN_PAD, G, bid);
            pg8::EpiBf16 E{PB, IN_COLS, IN_COLS};
            pg8::gemm_phase<pg8::EpiBf16, pg8::StaticOrder, true, true>(ldsb, g, so, E, tid);
            { const int nwg = (NTOK / 256) * (IN_PAD / 256), busy = nwg % G;
              if (busy != 0 && bid >= busy) CVT_MOE_RANGE(l, 0, (G - busy) * 8 * CVT_PER_WAVE, (bid - busy) * 8 + (tid >> 6), (G - busy) * 8);
              moe_done = busy != 0 ? (G - busy) * 8 * CVT_PER_WAVE : 0; }
            GSYNC();
        }
        {
            PHASE_BEGIN();
            const float* cw = kp_->in[I_CONVW] + (size_t)l * 3 * 768; const float* cb = kp_->in[I_CONVB] + (size_t)l * 768;
            {
                float* cwl = (float*)lds_raw;
                __syncthreads();
                for (int i = tid; i < 4 * 768; i += NTHREADS) cwl[i] = i < 3 * 768 ? cw[i] : cb[i - 3 * 768];
                __syncthreads();
                const int stride = gridDim.x * NTHREADS;
                for (int i0 = blockIdx.x * NTHREADS + tid; i0 < NTOK * 192; i0 += 4 * stride) {
                    uint2 u0[4], um[4], up[4];
#pragma unroll
                    for (int q = 0; q < 4; ++q) { const int i = i0 + q * stride; const unsigned z_ = (unsigned)tid >> 20; u0[q] = make_uint2(z_, z_); um[q] = u0[q]; up[q] = u0[q];
                        if (i < NTOK * 192) { const int c = (i % 192) * 4, r = i / 192; const bool lat = r < NLAT; const int L = lat ? S : CTX; const int t = lat ? r % S : (r - NLAT) % CTX;
                            const bf16_t* u = PB + (size_t)r * IN_COLS + C_XBC + c; u0[q] = *(const uint2*)u; if (t > 0) um[q] = *(const uint2*)(u - IN_COLS); if (t < L - 1) up[q] = *(const uint2*)(u + IN_COLS); } }
#pragma unroll
                    for (int q = 0; q < 4; ++q) { const int i = i0 + q * stride;
                        if (i < NTOK * 192) { const int c = (i % 192) * 4, r = i / 192;
                            float4 acc = f4add(*(const float4*)(cwl + 3 * 768 + c), f4mul(*(const float4*)(cwl + 768 + c), up4(u0[q])));
                            acc = f4add(acc, f4mul(*(const float4*)(cwl + c), up4(um[q]))); acc = f4add(acc, f4mul(*(const float4*)(cwl + 2 * 768 + c), up4(up[q])));
                            *(uint2*)(XBC + (size_t)r * 768 + c) = pk4(make_float4(siluf(acc.x), siluf(acc.y), siluf(acc.z), siluf(acc.w))); } }
                }
            }
            const float* dtb = kp_->in[I_DTB] + l * 16;
            ITEMS(i, NTOK * 16) { const int j = i % 16, r = i / 16; DT[i] = softplusf(bf2f(PB[(size_t)r * IN_COLS + C_DT + j]) + dtb[j]); }
            ITEMS(i, NTOK * 16) {
                const int g = i & 15, r = i >> 4; const int hm = g & 7, isk = g >> 3;
                const bool lat = r < NLAT; const int b = lat ? r / S : (r - NLAT) / CTX, t = lat ? r % S : (r - NLAT) % CTX;
                if (!isk && !lat && !ctx_out) continue;
                const bf16_t* vp = PB + (size_t)r * IN_COLS + (isk ? C_DK : C_DQ) + hm * 32;
                float v[32];
#pragma unroll
                for (int k = 0; k < 32; k += 4) { const float4 x = ld4h(vp + k); v[k] = x.x; v[k + 1] = x.y; v[k + 2] = x.z; v[k + 3] = x.w; }
                if (lat) rope32(v, t, ROPE);
                const float sc = isk ? 1.0f : 0.17677669529663687f * 1.4426950408889634f;
                bf16_t* dst = isk ? KD + ((size_t)(b * 8 + hm) * SK + (lat ? CTX + t : t)) * 32 : (lat ? QD + ((size_t)(b * 8 + hm) * S + t) * 32 : QDC + ((size_t)(b * 8 + hm) * CTX + t) * 32);
#pragma unroll
                for (int k = 0; k < 32; k += 8) *(uint4*)(dst + k) = make_uint4(pk2(v[k] * sc, v[k + 1] * sc), pk2(v[k + 2] * sc, v[k + 3] * sc), pk2(v[k + 4] * sc, v[k + 5] * sc), pk2(v[k + 6] * sc, v[k + 7] * sc));
            }
            ITEMS(i, NB * 4 * (SK / 8) * 64) {
                const int d = i & 63, j8 = (i >> 6) % (SK / 8), hh = (i / (64 * (SK / 8))) & 3, b = i / (256 * (SK / 8));
                const int r0 = j8 * 8 < CTX ? tok_row(false, b, j8 * 8) : tok_row(true, b, j8 * 8 - CTX);
                const bf16_t* sp = PB + (size_t)r0 * IN_COLS + C_DV + hh * 64 + d;
                unsigned v[8];
#pragma unroll
                for (int jj = 0; jj < 8; ++jj) v[jj] = sp[(size_t)jj * IN_COLS];
                *(uint4*)(VDT + ((size_t)(b * 4 + hh) * 64 + d) * SK + j8 * 8) = make_uint4(v[0] | (v[1] << 16), v[2] | (v[3] << 16), v[4] | (v[5] << 16), v[6] | (v[7] << 16));
            }
            const float* qn = kp_->in[I_QNORM] + l * 192; const float* kvn = kp_->in[I_KVNORM] + l * 128;
            { const int lane = tid & 63;
            uint2 xq = make_uint2((unsigned)tid >> 20, (unsigned)tid >> 20);
            const int wstride = gridDim.x * 8; int i = blockIdx.x * 8 + (tid >> 6);
#define NRM_LOAD(ii) do { const int wh_ = (ii) & 1, r_ = (ii) >> 1; if (lane < (wh_ ? 32 : 48)) xq = *(const uint2*)(PB + (size_t)r_ * IN_COLS + (wh_ ? C_CKV : C_CQ) + lane * 4); } while (0)
            if (i < NTOK * 2) NRM_LOAD(i);
            for (; i < NTOK * 2; i += wstride) {
                const int which = i & 1, r = i >> 1; const int n4 = which ? 32 : 48;
                const float4* w = (const float4*)(which ? kvn : qn);
                float4 x = make_float4(0.f, 0.f, 0.f, 0.f); if (lane < n4) x = up4(xq);
                if (i + wstride < NTOK * 2) NRM_LOAD(i + wstride);
                const float ss = wave_sum(f4dot(x, x));
                const float rs = 1.0f / sqrtf(ss / (n4 * 4) + EPS);
                bf16_t* dst = which ? CKVB + (size_t)r * 128 : CQB + (size_t)r * 256;
                if (lane < n4) *(uint2*)(dst + lane * 4) = pk4(f4scale(f4mul(x, w[lane]), rs));
                else if (!which) { const unsigned z_ = (unsigned)tid >> 20; *(uint2*)(dst + lane * 4) = make_uint2(z_, z_); }
            }
#undef NRM_LOAD
            }
            GSYNC();
        }
        {
            PHASE_BEGIN();
            const int half = (G * 5) / 8;
            if (bid < half) {
                pg8::Gemm g{CQB, WQ_T, NTOK, 512, 256, 0, 0}; pg8::StaticOrder so; so.init(NTOK, 512, half, bid);
                pg8::EpiBf16 E{MQ, 384, 384};
                pg8::gemm_phase<pg8::EpiBf16, pg8::StaticOrder, true, true>(ldsb, g, so, E, tid);
            } else {
                pg8::Gemm g{CKVB, WKV_T, NTOK, 512, 128, 0, 0}; pg8::StaticOrder so; so.init(NTOK, 512, G - half, bid - half);
                pg8::EpiBf16 E{MKV, 512, 512};
                pg8::gemm_phase<pg8::EpiBf16, pg8::StaticOrder, true, true>(ldsb, g, so, E, tid);
            }
            for (int it = vcu; it < NB * NCH * 8; it += G) {
                const int hp = it & 3, dir = (it >> 2) & 1, cp = (it >> 3) % NCH, b = it / (8 * NCH);
                const int k = dir ? (cp < 2 ? 1 - cp : 35 - cp) : cp;
                if (k == NCH - 1) continue;
                ssd_block<false>(b, dir, k, hp, XBC, DT, kp_->in[I_ALOG] + l * 16, HS, ALAST, nullptr, (float*)lds_raw, tid);
            }
            GSYNC();
        }
        {
            PHASE_BEGIN();
            ITEMS(i, NTOK * 8) {
                const int g = i & 7, r = i >> 3; const int hh = g & 3, isk = g >> 2;
                const bool lat = r < NLAT; const int b = lat ? r / S : (r - NLAT) / CTX, t = lat ? r % S : (r - NLAT) % CTX;
                if (!isk && !lat && !ctx_out) continue;
                const bf16_t* npb = isk ? MKV + (size_t)r * 512 + hh * 128 : MQ + (size_t)r * 384 + hh * 96;
                const bf16_t* rp = isk ? PB + (size_t)r * IN_COLS + C_KR : npb + 64;
                float v[32], np[64];
#pragma unroll
                for (int k = 0; k < 32; k += 4) { const float4 x = ld4h(rp + k); v[k] = x.x; v[k + 1] = x.y; v[k + 2] = x.z; v[k + 3] = x.w; }
#pragma unroll
                for (int k = 0; k < 64; k += 4) { const float4 x = ld4h(npb + k); np[k] = x.x; np[k + 1] = x.y; np[k + 2] = x.z; np[k + 3] = x.w; }
                if (lat) rope32(v, t, ROPE);
                const float sc = isk ? 1.0f : 0.10206207261596575f * 1.4426950408889634f;
                bf16_t* dst = isk ? KM + ((size_t)(b * 4 + hh) * SK + (lat ? CTX + t : t)) * 96 : (lat ? QM + ((size_t)(b * 4 + hh) * S + t) * 96 : QMC + ((size_t)(b * 4 + hh) * CTX + t) * 96);
#pragma unroll
                for (int k = 0; k < 64; k += 8) *(uint4*)(dst + k) = make_uint4(pk2(np[k] * sc, np[k + 1] * sc), pk2(np[k + 2] * sc, np[k + 3] * sc), pk2(np[k + 4] * sc, np[k + 5] * sc), pk2(np[k + 6] * sc, np[k + 7] * sc));
#pragma unroll
                for (int k = 0; k < 32; k += 8) *(uint4*)(dst + 64 + k) = make_uint4(pk2(v[k] * sc, v[k + 1] * sc), pk2(v[k + 2] * sc, v[k + 3] * sc), pk2(v[k + 4] * sc, v[k + 5] * sc), pk2(v[k + 6] * sc, v[k + 7] * sc));
            }
            ITEMS(i, NB * 4 * (SK / 8) * 64) {
                const int d = i & 63, j8 = (i >> 6) % (SK / 8), hh = (i / (64 * (SK / 8))) & 3, b = i / (256 * (SK / 8));
                const int r0 = j8 * 8 < CTX ? tok_row(false, b, j8 * 8) : tok_row(true, b, j8 * 8 - CTX);
                const bf16_t* sp = MKV + (size_t)r0 * 512 + hh * 128 + 64 + d;
                unsigned v[8];
#pragma unroll
                for (int jj = 0; jj < 8; ++jj) v[jj] = sp[(size_t)jj * 512];
                *(uint4*)(VMT + ((size_t)(b * 4 + hh) * 64 + d) * SK + j8 * 8) = make_uint4(v[0] | (v[1] << 16), v[2] | (v[3] << 16), v[4] | (v[5] << 16), v[6] | (v[7] << 16));
            }
            ITEMS(i, NB * 2 * 8 * 4096) {
                const int e = i & 4095, h = (i >> 12) & 7, bd = i >> 15;
                float* hp0 = HS + ((size_t)bd * NCH * 8 + h) * 4096 + e; const float* al0 = ALAST + (size_t)bd * NCH * 8 + h;
                float sv[NCH - 1], dk[NCH - 1];
#pragma unroll
                for (int k = 0; k < NCH - 1; ++k) { sv[k] = hp0[(size_t)k * 8 * 4096]; dk[k] = al0[k * 8]; }
                float Hc = 0.f;
#pragma unroll
                for (int k = 0; k < NCH; ++k) { hp0[(size_t)k * 8 * 4096] = Hc; if (k < NCH - 1) Hc = Hc * __expf(dk[k]) + sv[k]; }
            }
            GSYNC();
        }
        {
            PHASE_BEGIN();
            for (int kq = 0; kq * G < NB * 2 * NCH * 4; ++kq) {
                int it = vcu + kq * G;
                { const int T_ = NB * 2 * NCH * 4, full_ = (T_ / G) * G, rem_ = T_ - full_;
                  if (ctx_out && kq * G == full_) it = vcu >= G - rem_ ? full_ + vcu - (G - rem_) : T_; }
                if (it >= NB * 2 * NCH * 4) continue;
                const int hp = it & 3, dir = (it >> 2) & 1, cp = (it >> 3) % NCH, b = it / (8 * NCH);
                const int k = dir ? (cp < 2 ? 1 - cp : 35 - cp) : cp;
                if (k < 2 && !ctx_out) continue;
                ssd_block<true>(b, dir, k, hp, XBC, DT, kp_->in[I_ALOG] + l * 16, HS, ALAST, YD, (float*)lds_raw, tid);
            }
            const int lane = tid & 63, wave = tid >> 6, qr = lane & 31, hf = lane >> 5;
            {
                const float* lq1 = kp_->in[I_LQ1] + l * 32; const float* lk1 = kp_->in[I_LK1] + l * 32; const float* lq2 = kp_->in[I_LQ2] + l * 32; const float* lk2 = kp_->in[I_LK2] + l * 32;
                const float* subw = kp_->in[I_SUBLN] + l * 64;
                const int nlat = NB * 4 * (S / 256), nit = nlat + (ctx_out ? NB * 4 : 0);
                for (int it = vcu; it < nit; it += G) {
                    const bool lat = it < nlat; const int u = lat ? it : it - nlat;
                    const int qb = lat ? u % (S / 256) : 0, hh = lat ? (u / (S / 256)) % 4 : u % 4, b = lat ? u / (4 * (S / 256)) : u / 4;
                    const int t = qb * 256 + wave * 32 + qr; const int row = tok_row(lat, b, t); const int nkt = lat ? SK / 64 : CTX / 64;
                    f32x16 oacc[2]; unsigned o1p[2][8];
#pragma unroll 1
                    for (int mp = 0; mp < 2; ++mp) {
                        const int hm = hh * 2 + mp;
                        const bf16_t* qrow = lat ? QD + ((size_t)(b * 8 + hm) * S + t) * 32 : QDC + ((size_t)(b * 8 + hm) * CTX + t) * 32;
                        float l_run = 0.f;
#pragma unroll
                        for (int i = 0; i < 16; ++i) { oacc[0][i] = 0.f; oacc[1][i] = 0.f; }
                        attn_pass<32>(qrow, KD + (size_t)(b * 8 + hm) * SK * 32, VDT + (size_t)(b * 4 + hh) * 64 * SK, SK, nkt, ldsb, tid, oacc, l_run);
                        l_run = xor32_sum(l_run);
                        if (mp == 0) { const float i1 = 1.0f / l_run;
#pragma unroll
                            for (int db = 0; db < 2; ++db)
#pragma unroll
                                for (int i = 0; i < 8; ++i) o1p[db][i] = pk2(oacc[db][2 * i] * i1, oacc[db][2 * i + 1] * i1); }
                        else {
                            float d1 = 0.f, d2 = 0.f; for (int k = 0; k < 32; ++k) { d1 += lq1[k] * lk1[k]; d2 += lq2[k] * lk2[k]; }
                            const float lam = expf(d1) - expf(d2) + lambda_init;
                            const float i2 = lam / l_run; float ss = 0.f; f32x16 o1[2];
#pragma unroll
                            for (int db = 0; db < 2; ++db)
#pragma unroll
                                for (int i = 0; i < 16; ++i) { const float a1 = __uint_as_float((i & 1) ? (o1p[db][i >> 1] & 0xffff0000u) : (o1p[db][i >> 1] << 16)); const float v = a1 - oacc[db][i] * i2; o1[db][i] = v; ss += v * v; }
                            ss = xor32_sum(ss);
                            const float rs = (1.0f - lambda_init) / sqrtf(ss / 64 + EPS);
                            bf16_t* orow = MIXB + (size_t)row * MIXW + 512 + hh * 64;
#pragma unroll
                            for (int db = 0; db < 2; ++db)
#pragma unroll
                                for (int gq = 0; gq < 4; ++gq) { const int d0 = 32 * db + 8 * gq + 4 * hf; const float4 w4 = *(const float4*)(subw + d0);
                                    *(uint2*)(orow + d0) = make_uint2(pk2(o1[db][4 * gq] * rs * w4.x, o1[db][4 * gq + 1] * rs * w4.y), pk2(o1[db][4 * gq + 2] * rs * w4.z, o1[db][4 * gq + 3] * rs * w4.w)); }
                        }
                    }
                }
            }
            {
                const int nlat = NB * 4 * (S / 256), nit = nlat + (ctx_out ? NB * 4 : 0);
                for (int it = vcu; it < nit; it += G) {
                    const bool lat = it < nlat; const int u = lat ? it : it - nlat;
                    const int qb = lat ? u % (S / 256) : 0, hh = lat ? (u / (S / 256)) % 4 : u % 4, b = lat ? u / (4 * (S / 256)) : u / 4;
                    const int t = qb * 256 + wave * 32 + qr; const int row = tok_row(lat, b, t); const int nkt = lat ? SK / 64 : CTX / 64;
                    const bf16_t* qrow = lat ? QM + ((size_t)(b * 4 + hh) * S + t) * 96 : QMC + ((size_t)(b * 4 + hh) * CTX + t) * 96;
                    f32x16 oacc[2]; float l_run = 0.f;
#pragma unroll
                    for (int i = 0; i < 16; ++i) { oacc[0][i] = 0.f; oacc[1][i] = 0.f; }
                    attn_pass<96>(qrow, KM + (size_t)(b * 4 + hh) * SK * 96, VMT + (size_t)(b * 4 + hh) * 64 * SK, SK, nkt, ldsb, tid, oacc, l_run);
                    l_run = xor32_sum(l_run);
                    const float inv = 1.0f / l_run;
                    bf16_t* orow = MIXB + (size_t)row * MIXW + 768 + hh * 64;
#pragma unroll
                    for (int db = 0; db < 2; ++db)
#pragma unroll
                        for (int gq = 0; gq < 4; ++gq) { const int d0 = 32 * db + 8 * gq + 4 * hf;
                            *(uint2*)(orow + d0) = make_uint2(pk2(oacc[db][4 * gq] * inv, oacc[db][4 * gq + 1] * inv), pk2(oacc[db][4 * gq + 2] * inv, oacc[db][4 * gq + 3] * inv)); }
                }
            }
            GSYNC();
        }
        {
            PHASE_BEGIN();
            const float* nw = kp_->in[I_SSDN] + l * 512; const float* dsk = kp_->in[I_SSDD] + l * 8;
            const int lane = tid & 63;
            uint2 q0, q1, q2, q3; { const unsigned z_ = (unsigned)tid >> 20; q0 = make_uint2(z_, z_); q1 = q0; q2 = q0; q3 = q0; }
            const int wstride = gridDim.x * 8; int i = blockIdx.x * 8 + (tid >> 6);
#define GN_LOAD(ii) do { const int g_ = (ii) & 1, r_ = (ii) >> 1, c_ = g_ * 256 + lane * 4; q0 = *(const uint2*)(XBC + (size_t)r_ * 768 + c_); q1 = *(const uint2*)(YD + (size_t)r_ * 512 + c_); \
                q2 = *(const uint2*)(YD + ((size_t)NTOK + r_) * 512 + c_); q3 = *(const uint2*)(PB + (size_t)r_ * IN_COLS + C_Z + c_); } while (0)
            if (i < nrows_out * 2) GN_LOAD(i);
            for (; i < nrows_out * 2; i += wstride) {
                const int g = i & 1, r = i >> 1, c = g * 256 + lane * 4;
                const float4 x = up4(q0), y0 = up4(q1), y1 = up4(q2), z = up4(q3);
                if (i + wstride < nrows_out * 2) GN_LOAD(i + wstride);
                const float ds = dsk[c >> 6];
                float4 v = make_float4((ds * x.x + y0.x + y1.x) * siluf(z.x), (ds * x.y + y0.y + y1.y) * siluf(z.y), (ds * x.z + y0.z + y1.z) * siluf(z.z), (ds * x.w + y0.w + y1.w) * siluf(z.w));
                const float ss = wave_sum(f4dot(v, v));
                const float rs = 1.0f / sqrtf(ss / 256 + EPS);
                *(uint2*)(MIXB + (size_t)r * MIXW + c) = pk4(f4scale(f4mul(v, *(const float4*)(nw + c)), rs));
            }
#undef GN_LOAD
            GSYNC();
        }
        {
            PHASE_BEGIN();
            pg8::Gemm g{MIXB, WOUT_T, nrows_out, D, MIXW, 0, 0}; pg8::StaticOrder so; so.init(nrows_out, D, G, bid);
            pg8::EpiBf16 E{MOUT, D, D};
            pg8::gemm_phase<pg8::EpiBf16, pg8::StaticOrder, true, true>(ldsb, g, so, E, tid);
            { const int nwg = (nrows_out / 256) * (D / 256), busy = nwg % G; const int id0 = moe_done;
              if (busy != 0 && bid >= busy) CVT_MOE_RANGE(l, id0, id0 + (G - busy) * 8 * CVT_PER_WAVE, (bid - busy) * 8 + (tid >> 6), (G - busy) * 8);
              if (busy != 0) moe_done = id0 + (G - busy) * 8 * CVT_PER_WAVE; }
            GSYNC();
        }
        {
            PHASE_BEGIN();
            const float* wpost = kp_->in[I_NMPOST] + l * D; const float* wpre = kp_->in[I_NFPRE] + l * D;
            const float* rw = kp_->in[I_RW] + (size_t)l * D * NE; const float* rb = kp_->in[I_RB] + l * NE;
            const int lane = tid & 63;
            float* rwl = (float*)lds_raw;
            for (int i = tid; i < D * NE / 4; i += NTHREADS) { const int k = i >> 2, e4 = i & 3; ((float4*)rwl)[(((k & 3) * 256 + (k >> 2)) << 2) + e4] = ((const float4*)rw)[i]; }
            float4* aux = (float4*)(rwl + D * NE);
            for (int i = tid; i < 17 * (D / 4); i += NTHREADS) { const int v = i / (D / 4), k4 = i % (D / 4);
                const float* src = v == 0 ? wpost : v == 1 ? wpre : modl + (size_t)((v - 2) % 5) * NMOD * D + (2 + (v - 2) / 5) * D;
                aux[i] = ((const float4*)src)[k4]; }
            __syncthreads();
            uint2 mq[4]; float4 xq[4];
            { const float zf_ = (float)(tid >> 20);
#pragma unroll
              for (int i = 0; i < 4; ++i) { xq[i] = make_float4(zf_, zf_, zf_, zf_); mq[i] = make_uint2((unsigned)tid >> 20, (unsigned)tid >> 20); } }
            const int wstride = gridDim.x * 8; int r = blockIdx.x * 8 + (tid >> 6);
#define P7_LOAD(rr) do { const float4* xin_ = (const float4*)((rr) < NLAT ? XSRC + (size_t)(rr) * D : CSRC + (size_t)((rr) - NLAT) * D); const bf16_t* m_ = MOUT + (size_t)(rr) * D; \
                _Pragma("unroll") for (int i = 0; i < 4; ++i) { mq[i] = *(const uint2*)(m_ + (i * 64 + lane) * 4); xq[i] = xin_[i * 64 + lane]; } } while (0)
            if (r < nrows_out) P7_LOAD(r);
            for (; r < nrows_out; r += wstride) {
                float4* xr = (float4*)(r < NLAT ? xcur + (size_t)r * D : CTXC + (size_t)(r - NLAT) * D);
                const int bsel = r < NLAT ? r / S : NB;
                float4 mv[4], xv[4]; float ss = 0.f;
#pragma unroll
                for (int i = 0; i < 4; ++i) { mv[i] = up4(mq[i]); xv[i] = xq[i]; ss += f4dot(mv[i], mv[i]); }
                if (r + wstride < nrows_out) P7_LOAD(r + wstride);
                ss = wave_sum(ss);
                const float rs = 1.0f / sqrtf(ss / D + EPS);
                float s2 = 0.f;
#pragma unroll
                for (int i = 0; i < 4; ++i) { const int k4 = i * 64 + lane;
                    xv[i] = f4add(xv[i], f4mul(aux[(2 + bsel) * (D / 4) + k4], f4scale(f4mul(mv[i], aux[k4]), rs))); xr[k4] = xv[i]; s2 += f4dot(xv[i], xv[i]); }
                s2 = wave_sum(s2);
                const float r2 = 1.0f / sqrtf(s2 / D + EPS);
                float lg[NE];
#pragma unroll
                for (int e = 0; e < NE; ++e) lg[e] = 0.f;
#pragma unroll
                for (int i = 0; i < 4; ++i) { const int k4 = i * 64 + lane; const float4 w4 = aux[(D / 4) + k4], sc = aux[(12 + bsel) * (D / 4) + k4], sh = aux[(7 + bsel) * (D / 4) + k4];
                    const float hv[4] = {xv[i].x * r2 * w4.x * (1.0f + sc.x) + sh.x, xv[i].y * r2 * w4.y * (1.0f + sc.y) + sh.y, xv[i].z * r2 * w4.z * (1.0f + sc.z) + sh.z, xv[i].w * r2 * w4.w * (1.0f + sc.w) + sh.w};
                    *(uint2*)(HB + (size_t)r * D + k4 * 4) = make_uint2(pk2(hv[0], hv[1]), pk2(hv[2], hv[3]));
#pragma unroll
                    for (int c = 0; c < 4; ++c) { const float4* rwp = (const float4*)(rwl + (size_t)(c * 256 + k4) * NE);
#pragma unroll
                        for (int e4 = 0; e4 < 4; ++e4) { const float4 w = rwp[e4]; lg[4 * e4] += hv[c] * w.x; lg[4 * e4 + 1] += hv[c] * w.y; lg[4 * e4 + 2] += hv[c] * w.z; lg[4 * e4 + 3] += hv[c] * w.w; }
                        SCHED_FENCE(); }
                }
#pragma unroll
                for (int e = 0; e < NE; ++e) lg[e] = wave_sum(lg[e]) + rb[e];
                float mx = lg[0];
#pragma unroll
                for (int e = 1; e < NE; ++e) mx = fmaxf(mx, lg[e]);
                float sum = 0.f;
#pragma unroll
                for (int e = 0; e < NE; ++e) { lg[e] = expf(lg[e] - mx); sum += lg[e]; }
                const float is = 1.0f / sum;
                float mine = lg[0];
#pragma unroll
                for (int e = 1; e < NE; ++e) mine = lane == e ? lg[e] : mine;
                if (lane < NE) AFF[(size_t)r * NE + lane] = mine * is;
            }
#undef P7_LOAD
            GSYNC();
        }
        {
            PHASE_BEGIN();
            CVT_MOE_RANGE(l, moe_done, MOE_TILES, bid * 8 + (tid >> 6), G * 8);
            {
                volatile int* sh = (volatile int*)lds_raw;
                const int nsel = (ctx_out ? 2 : 1) * NB * NE;
                for (int it = bid; it < nsel; it += G) {
                    const bool lat = it < NB * NE; const int u = lat ? it : it - NB * NE; const int e = u % NE, b = u / NE;
                    const int L = lat ? S : CTX, cap = lat ? CAP_L : CAP_C, npt = lat ? S / NTHREADS : 1, base = tok_row(lat, b, 0);
                    const bool act = lat || tid < CTX;
                    unsigned key[S / NTHREADS];
#pragma unroll
                    for (int i = 0; i < S / NTHREADS; ++i) key[i] = (act && i < npt) ? __float_as_uint(AFF[(size_t)(base + tid * npt + i) * NE + e]) : 0u;
                    __syncthreads();
                    unsigned T = 0u;
                    for (int bit = 30; bit >= 0; --bit) {
                        const unsigned cand = T | (1u << bit); int c = 0;
#pragma unroll
                        for (int i = 0; i < S / NTHREADS; ++i) c += (key[i] >= cand) ? 1 : 0;
                        if (block_sum(c, tid, sh, bit & 1) >= cap) T = cand;
                    }
                    int cg = 0, ct = 0;
#pragma unroll
                    for (int i = 0; i < S / NTHREADS; ++i) { cg += (key[i] > T) ? 1 : 0; ct += (key[i] == T && key[i] != 0u) ? 1 : 0; }
                    int tot_g, tot_t;
                    (void)block_excl_scan(cg, tid, sh, tot_g);
                    int tie_rank = block_excl_scan(ct, tid, sh, tot_t);
                    const int need = cap - tot_g;
                    int sel[S / NTHREADS], cs = 0;
#pragma unroll
                    for (int i = 0; i < S / NTHREADS; ++i) { const bool tie = key[i] == T && key[i] != 0u; sel[i] = (key[i] > T || (tie && tie_rank < need)) ? 1 : 0; tie_rank += tie ? 1 : 0; cs += sel[i]; }
                    int tot_s; int slot = block_excl_scan(cs, tid, sh, tot_s);
#pragma unroll
                    for (int i = 0; i < S / NTHREADS; ++i) if (act && i < npt) {
                        const int row = base + tid * npt + i; int sa = -1;
                        if (sel[i]) { sa = (lat ? b * CAP_L : NB * CAP_L + b * CAP_C) + slot; ++slot; SELIDX[e * ER_MAX + sa] = row; SELGATE[e * ER_MAX + sa] = __uint_as_float(key[i]); }
                        TOKSLOT[(size_t)row * NE + e] = sa;
                    }
                }
            }
            GSYNC();
        }
        {
            PHASE_BEGIN();
            const int used = ctx_out ? NB * (CAP_L + CAP_C) : NB * CAP_L;
            ITEMS(i, NE * ER * (D / 8)) {
                const int c8 = i % (D / 8), slot = (i / (D / 8)) % ER, e = i / ((D / 8) * ER);
                uint4 v = make_uint4(0, 0, 0, 0);
                if (slot < used) v = *(const uint4*)(HB + (size_t)SELIDX[e * ER_MAX + slot] * D + c8 * 8);
                *(uint4*)(XG + ((size_t)e * ER + slot) * D + c8 * 8) = v;
            }
            GSYNC();
        }
        {
            PHASE_BEGIN();
            pg8::Gemm g{XG, WGU_T, NE * ER, 2 * FF, D, ER / 256, (size_t)2 * FF * D * 2}; pg8::StaticOrder so; so.init(NE * ER, 2 * FF, G, bid);
            pg8::EpiSwiGLU E{HID, FF};
            pg8::gemm_phase<pg8::EpiSwiGLU, pg8::StaticOrder, true, true>(ldsb, g, so, E, tid);
            GSYNC();
        }
        {
            PHASE_BEGIN();
            pg8::Gemm g{HID, WD_T, NE * ER, D, FF, ER / 256, (size_t)D * FF * 2}; pg8::StaticOrder so; so.init(NE * ER, D, G, bid);
            pg8::EpiRowScaleBf16 E{Y, D, SELGATE, ER};
            pg8::gemm_phase<pg8::EpiRowScaleBf16, pg8::StaticOrder, true, true>(ldsb, g, so, E, tid);
            GSYNC();
        }
        {
            PHASE_BEGIN();
            const float* wpost = kp_->in[I_NFPOST] + l * D;
            const int lane = tid & 63;
            {
                float4 xq[4]; int slq = -1;
                { const float zf_ = (float)(tid >> 20);
#pragma unroll
                  for (int i = 0; i < 4; ++i) xq[i] = make_float4(zf_, zf_, zf_, zf_); }
                float4* aux = (float4*)lds_raw;
                __syncthreads();
                for (int i = tid; i < 6 * (D / 4); i += NTHREADS) { const int v = i / (D / 4), k4 = i % (D / 4);
                    const float* src = v == 0 ? wpost : modl + (size_t)(v - 1) * NMOD * D + 5 * D;
                    aux[i] = ((const float4*)src)[k4]; }
                __syncthreads();
                const int wstride = gridDim.x * 8; int r = blockIdx.x * 8 + (tid >> 6);
#define P11_LOAD(rr) do { const float4* xin_ = (const float4*)((rr) < NLAT ? xcur + (size_t)(rr) * D : CTXC + (size_t)((rr) - NLAT) * D); slq = lane < NE ? TOKSLOT[(size_t)(rr) * NE + lane] : -1; \
                    _Pragma("unroll") for (int i = 0; i < 4; ++i) xq[i] = xin_[i * 64 + lane]; } while (0)
                if (r < nrows_out) P11_LOAD(r);
                for (; r < nrows_out; r += wstride) {
                    float4* xr = (float4*)(r < NLAT ? xcur + (size_t)r * D : CTXC + (size_t)(r - NLAT) * D);
                    const int bsel = r < NLAT ? r / S : NB;
                    const int myslot = slq; float4 xv[4], f[4];
#pragma unroll
                    for (int i = 0; i < 4; ++i) { xv[i] = xq[i]; f[i] = make_float4(0.f, 0.f, 0.f, 0.f); }
#pragma unroll
                    for (int e = 0; e < NE; ++e) {
                        const int sl = __builtin_amdgcn_readlane(myslot, e);
                        if (sl >= 0) { const bf16_t* yp = Y + ((size_t)e * ER + sl) * D;
#pragma unroll
                            for (int i = 0; i < 4; ++i) f[i] = f4add(f[i], ld4h(yp + (i * 64 + lane) * 4)); }
                    }
                    if (r + wstride < nrows_out) P11_LOAD(r + wstride);
                    float ss = 0.f;
#pragma unroll
                    for (int i = 0; i < 4; ++i) ss += f4dot(f[i], f[i]);
                    ss = wave_sum(ss);
                    const float rs = 1.0f / sqrtf(ss / D + EPS);
#pragma unroll
                    for (int i = 0; i < 4; ++i) { const int k4 = i * 64 + lane; xr[k4] = f4add(xv[i], f4mul(aux[(1 + bsel) * (D / 4) + k4], f4scale(f4mul(f[i], aux[k4]), rs))); }
                }
#undef P11_LOAD
            }
            GSYNC();
        }
    }
}

extern "C" void kernel_launch(void* const* d_in, const int* in_sizes, int n_in, void* d_out, int out_size, void* d_ws, size_t ws_size, hipStream_t stream) {
    static int grid = 0;
    if (grid == 0) {
        if (n_in != N_IN || out_size != NLAT * D || ws_size < WS_END) { fprintf(stderr, "kernel_launch: unexpected shapes: n_in %d out %d ws %zu (need %zu)\n", n_in, out_size, ws_size, (size_t)WS_END); grid = -1; return; }
        int dev = 0, cus = 0, per_cu = 0;
        (void)hipGetDevice(&dev);
        (void)hipDeviceGetAttribute(&cus, hipDeviceAttributeMultiprocessorCount, dev);
        (void)hipFuncSetAttribute((const void*)mk_forward, hipFuncAttributeMaxDynamicSharedMemorySize, LDS_BYTES);
        (void)hipOccupancyMaxActiveBlocksPerMultiprocessor(&per_cu, (const void*)mk_forward, NTHREADS, LDS_BYTES);
        (void)hipGetLastError();
        if (per_cu < 1) { fprintf(stderr, "kernel_launch: occupancy query says %d blocks/CU\n", per_cu); grid = -1; return; }
        grid = cus;
    }
    if (grid < 0) return;
    (void)hipMemsetAsync((char*)d_ws + WS_CTL, 0, CTL_BYTES, stream);
    Prm p{};
    for (int i = 0; i < N_IN; ++i) p.in[i] = (const float*)d_in[i];
    p.out = (float*)d_out; p.ws = (char*)d_ws;
    void* args[] = {&p};
    hipError_t e = hipLaunchCooperativeKernel((const void*)mk_forward, dim3(grid), dim3(NTHREADS), args, LDS_BYTES, stream);
    if (e != hipSuccess) fprintf(stderr, "kernel_launch: cooperative launch failed: %s (grid %d)\n", hipGetErrorString(e), grid);
}
```

```cpp
#include <hip/hip_runtime.h>
#include <cstdio>
#include <cstdint>

constexpr int D = 1024, NB = 4, S = 4096, CTX = 256, FF = 1024;
constexpr int DEPTH = 2, GRID_W = 64, NMOD = 6, NE = 16;
constexpr int NLAT = NB * S, NCTX = NB * CTX, NTOK = NLAT + NCTX;
constexpr int IN_COLS = 2416, IN_PAD = 2560;
constexpr int C_Z = 0, C_XBC = 512, C_DT = 1280, C_DQ = 1296, C_DK = 1552, C_DV = 1808, C_CQ = 2064, C_CKV = 2256, C_KR = 2384;
constexpr int MIXW = 1024;
constexpr int CAP_L = 2 * S / NE, CAP_C = 2 * CTX / NE;
constexpr int ER_MAX = 2304;
constexpr float EPS = 1e-6f;
static_assert(NB * CAP_L == 2048 && NB * CAP_C == 128, "expert row layout");

enum { I_X = 0, I_C, I_CTX, I_CCTX, I_ADAW, I_ADAB, I_NMPRE, I_NMPOST, I_NFPRE, I_NFPOST, I_WIN, I_CONVW, I_CONVB, I_ALOG, I_DTB, I_SSDD, I_SSDN,
       I_LQ1, I_LK1, I_LQ2, I_LK2, I_SUBLN, I_QNORM, I_WQUP, I_KVNORM, I_WKVUP, I_WOUT, I_RW, I_RB, I_WG, I_WU, I_WD, N_IN };
struct Prm { const float* in[N_IN]; float* out; char* ws; };

typedef unsigned short bf16_t;
constexpr size_t al256(size_t x) { return (x + 255) & ~(size_t)255; }
constexpr size_t WS_CTL = 0, CTL_BYTES = 65536;
constexpr size_t WS_MOD = WS_CTL + CTL_BYTES;
constexpr size_t WS_CTXC = al256(WS_MOD + (size_t)DEPTH * (NB + 1) * NMOD * D * 4);
constexpr size_t WS_AFF = al256(WS_CTXC + (size_t)NCTX * D * 4);
constexpr size_t WS_TOKSLOT = al256(WS_AFF + (size_t)NTOK * NE * 4);
constexpr size_t WS_SELIDX = al256(WS_TOKSLOT + (size_t)NTOK * NE * 4);
constexpr size_t WS_SELGATE = al256(WS_SELIDX + (size_t)NE * ER_MAX * 4);
constexpr size_t WS_DT = al256(WS_SELGATE + (size_t)NE * ER_MAX * 4);
constexpr int NCH = 34;
constexpr size_t WS_ROPE = al256(WS_DT + (size_t)NTOK * 16 * 4);
constexpr size_t WS_ALAST = al256(WS_ROPE + (size_t)S * 32 * 4);
constexpr size_t WS_HB = al256(WS_ALAST + (size_t)NB * 2 * NCH * 8 * 4);
constexpr size_t WS_P = al256(WS_HB + (size_t)NTOK * D * 2);
constexpr size_t WS_G2 = al256(WS_P + (size_t)NTOK * IN_COLS * 4);
constexpr size_t WS_XBC = WS_G2;
constexpr size_t WS_MQ = al256(WS_XBC + (size_t)NTOK * 768 * 4);
constexpr size_t WS_MKV = al256(WS_MQ + (size_t)NTOK * 384 * 4);
constexpr size_t WS_CQB = al256(WS_MKV + (size_t)NTOK * 512 * 4);
constexpr size_t WS_CKVB = al256(WS_CQB + (size_t)NTOK * 256 * 2);
constexpr size_t WS_MIXB = al256(WS_CKVB + (size_t)NTOK * 128 * 2);
constexpr size_t WS_G2END = al256(WS_MIXB + (size_t)NTOK * MIXW * 2);
constexpr size_t WS_HS = WS_HB;
constexpr size_t WS_YD = WS_MQ;
constexpr size_t WS_MOUT = WS_P;
constexpr size_t WS_XG = WS_P;
constexpr size_t WS_HID = al256(WS_XG + (size_t)NE * ER_MAX * D * 2);
constexpr size_t WS_Y = WS_G2;
constexpr size_t WS_WIN = WS_G2END;
constexpr size_t WS_WQ = al256(WS_WIN + (size_t)IN_PAD * D * 2);
constexpr size_t WS_WKV = al256(WS_WQ + (size_t)512 * 256 * 2);
constexpr size_t WS_WOUT = al256(WS_WKV + (size_t)512 * 128 * 2);
constexpr size_t WS_WGU = al256(WS_WOUT + (size_t)D * MIXW * 2);
constexpr size_t WS_WD = al256(WS_WGU + (size_t)NE * 2 * FF * D * 2);
constexpr size_t WS_END = al256(WS_WD + (size_t)NE * D * FF * 2);
constexpr int SK = CTX + S;
constexpr size_t WS_QD = al256(WS_P + (size_t)NTOK * IN_COLS * 2);
constexpr size_t WS_QDC = al256(WS_QD + (size_t)NB * 8 * S * 32 * 2);
constexpr size_t WS_KD = al256(WS_QDC + (size_t)NB * 8 * CTX * 32 * 2);
constexpr size_t WS_VDT = al256(WS_KD + (size_t)NB * 8 * SK * 32 * 2);
constexpr size_t WS_QM = al256(WS_VDT + (size_t)NB * 4 * 64 * SK * 2);
constexpr size_t WS_QMC = al256(WS_QM + (size_t)NB * 4 * S * 96 * 2);
constexpr size_t WS_KM = al256(WS_QMC + (size_t)NB * 4 * CTX * 96 * 2);
constexpr size_t WS_VMT = al256(WS_KM + (size_t)NB * 4 * SK * 96 * 2);
constexpr size_t WS_ATTEND = al256(WS_VMT + (size_t)NB * 4 * 64 * SK * 2);
static_assert(WS_ATTEND <= WS_G2, "attention operands fit in the spare half of the P slot");
static_assert(WS_HID + (size_t)NE * ER_MAX * FF * 2 <= WS_G2, "XG+HID fit in the P region");
static_assert((size_t)NE * ER_MAX * D * 4 <= WS_G2END - WS_G2, "Y fits in the G2 region");
static_assert((size_t)NB * 2 * NCH * 8 * 4096 * 4 <= (size_t)NTOK * D * 2, "HS fits in HB");
static_assert(WS_YD + (size_t)2 * NTOK * 512 * 4 <= WS_MIXB, "YD ends below MIXB");

#define LAS __attribute__((address_space(3)))
constexpr int NTHREADS = 512;
constexpr int LDS_BYTES = 147456;
#define ITEMS(i, n) for (int i = blockIdx.x * NTHREADS + tid; i < (n); i += gridDim.x * NTHREADS)

__device__ __forceinline__ float siluf(float x) { return x / (1.0f + expf(-x)); }
__device__ __forceinline__ float softplusf(float x) { return x > 20.f ? x : log1pf(expf(x)); }
__device__ __forceinline__ unsigned f2bf(float f) { unsigned u = __builtin_bit_cast(unsigned, f); return (u + 0x7fffu + ((u >> 16) & 1u)) >> 16; }
typedef float f32x2_t __attribute__((ext_vector_type(2)));
typedef __bf16 bf16x2_t __attribute__((ext_vector_type(2)));
__device__ __forceinline__ unsigned pk2(float lo, float hi) { const f32x2_t v = {lo, hi}; return __builtin_bit_cast(unsigned, __builtin_convertvector(v, bf16x2_t)); }
__device__ __forceinline__ float bf2f(bf16_t h) { return __builtin_bit_cast(float, (unsigned)h << 16); }
#define SCHED_FENCE() __builtin_amdgcn_sched_barrier(0)
__device__ __forceinline__ int mk_tid_impl(int wave_s) { unsigned z; asm volatile("s_mov_b32 %0, 0" : "=s"(z));
    return (wave_s << 6) | (int)__builtin_amdgcn_mbcnt_hi(~0u, __builtin_amdgcn_mbcnt_lo(~0u, z)); }
__device__ __forceinline__ float dpp_row_shr(float v, int n) {
    const int iv = __builtin_bit_cast(int, v); int r;
    switch (n) { case 1: r = __builtin_amdgcn_update_dpp(0, iv, 0x111, 0xf, 0xf, true); break; case 2: r = __builtin_amdgcn_update_dpp(0, iv, 0x112, 0xf, 0xf, true); break;
                 case 4: r = __builtin_amdgcn_update_dpp(0, iv, 0x114, 0xf, 0xf, true); break; default: r = __builtin_amdgcn_update_dpp(0, iv, 0x118, 0xf, 0xf, true); break; }
    return __builtin_bit_cast(float, r);
}
__device__ __forceinline__ float wave_sum(float v) {
    v += dpp_row_shr(v, 1); v += dpp_row_shr(v, 2); v += dpp_row_shr(v, 4); v += dpp_row_shr(v, 8);
    v += __builtin_bit_cast(float, __builtin_amdgcn_update_dpp(0, __builtin_bit_cast(int, v), 0x142, 0xa, 0xf, false));
    v += __builtin_bit_cast(float, __builtin_amdgcn_update_dpp(0, __builtin_bit_cast(int, v), 0x143, 0xc, 0xf, false));
    return __builtin_bit_cast(float, __builtin_amdgcn_readlane(__builtin_bit_cast(int, v), 63)); }
__device__ __forceinline__ float xor32_max(float x) { auto t = __builtin_amdgcn_permlane32_swap(__float_as_uint(x), __float_as_uint(x), false, false); return fmaxf(__uint_as_float(t[0]), __uint_as_float(t[1])); }
__device__ __forceinline__ float xor32_sum(float x) { auto t = __builtin_amdgcn_permlane32_swap(__float_as_uint(x), __float_as_uint(x), false, false); return __uint_as_float(t[0]) + __uint_as_float(t[1]); }
#define WITEMS(i, n) for (int i = blockIdx.x * 8 + (tid >> 6); i < (n); i += gridDim.x * 8)
__device__ __forceinline__ float4 f4mul(float4 a, float4 b) { return make_float4(a.x * b.x, a.y * b.y, a.z * b.z, a.w * b.w); }
__device__ __forceinline__ float4 f4add(float4 a, float4 b) { return make_float4(a.x + b.x, a.y + b.y, a.z + b.z, a.w + b.w); }
__device__ __forceinline__ float4 f4scale(float4 a, float s) { return make_float4(a.x * s, a.y * s, a.z * s, a.w * s); }
__device__ __forceinline__ float f4dot(float4 a, float4 b) { return a.x * b.x + a.y * b.y + a.z * b.z + a.w * b.w; }
__device__ __forceinline__ uint2 pk4(float4 v) { return make_uint2(pk2(v.x, v.y), pk2(v.z, v.w)); }
__device__ __forceinline__ float4 up4(uint2 u) { return make_float4(__uint_as_float(u.x << 16), __uint_as_float(u.x & 0xffff0000u), __uint_as_float(u.y << 16), __uint_as_float(u.y & 0xffff0000u)); }
__device__ __forceinline__ float4 ld4h(const bf16_t* p) { return up4(*(const uint2*)p); }

__device__ __forceinline__ void rope32(float* v, int t, const float* tab) {
    const float4* tp = (const float4*)(tab + (size_t)t * 32);
    float cs[32];
#pragma unroll
    for (int i = 0; i < 8; ++i) { const float4 x = tp[i]; cs[4 * i] = x.x; cs[4 * i + 1] = x.y; cs[4 * i + 2] = x.z; cs[4 * i + 3] = x.w; }
#pragma unroll
    for (int i = 0; i < 8; ++i) {
        { const float c = cs[i], sn = cs[8 + i]; const float x1 = v[i], x2 = v[8 + i]; v[i] = x1 * c - x2 * sn; v[8 + i] = x1 * sn + x2 * c; }
        { const float c = cs[16 + i], sn = cs[24 + i]; const float x1 = v[16 + i], x2 = v[24 + i]; v[16 + i] = x1 * c - x2 * sn; v[24 + i] = x1 * sn + x2 * c; }
    }
}
__device__ __forceinline__ int tok_row(bool lat, int b, int t) { return lat ? b * S + t : NLAT + b * CTX + t; }

namespace pg8 {
#define PG8_LAS __attribute__((address_space(3)))
typedef short bf16x8 __attribute__((ext_vector_type(8)));
typedef float f32x4 __attribute__((ext_vector_type(4)));
typedef unsigned u32x4 __attribute__((ext_vector_type(4)));
constexpr int BM = 256, BK = 64, HALF = 128, HTB = HALF * BK * 2  , STAGE_BYTES = 8 * HTB, NXCD = 8, WGM = 16;

__host__ __device__ __forceinline__ int lds_byte(int r, int c) { const int st = (r >> 4) * 2 + (c >> 5), rr = r & 15, cc = c & 31, ob = rr * 64 + cc * 2; return st * 1024 + (ob ^ (((ob >> 9) & 1) << 5)); }
__host__ __device__ __forceinline__ void stage_rc(int b, int& R, int& C) { const int st = b / 1024, sb = b % 1024, swz = sb ^ (((sb >> 9) & 1) << 5); R = (st >> 1) * 16 + swz / 64; C = (st & 1) * 32 + (swz % 64) / 2; }
__host__ __device__ __forceinline__ int perm32(int rho) { const int n = rho >> 4, i = rho & 15; return 8 * (i >> 2) + 4 * n + (i & 3); }

struct Unit { int pm, pn; };
struct Gemm { const bf16_t* A; const bf16_t* Bt; int M, N, K; int grp_tiles; size_t grp_stride; };

struct StaticOrder {
    int nM, nN, nwg, G, c;
    __host__ __device__ void init(int M, int N, int G_, int c_) { nM = M / BM; nN = N / BM; nwg = nM * nN; G = G_; c = c_; }
    __host__ __device__ bool next(int i, Unit& u) const {
        const long L = (long)i * G + c; if (L >= nwg) return false;
        int wgid = (int)L; { const int q = nwg / NXCD, r = nwg % NXCD, xcd = wgid % NXCD, off = wgid / NXCD; wgid = (xcd < r ? xcd * (q + 1) : r * (q + 1) + (xcd - r) * q) + off; }
        const int nig = WGM * nN, gid = wgid / nig, fm = gid * WGM, gsz = (nM - fm) < WGM ? (nM - fm) : WGM;
        u.pm = fm + ((wgid % nig) % gsz); u.pn = (wgid % nig) / gsz; return true;
    }
    __device__ __forceinline__ void a_ready(const Unit&) const {}
    __device__ __forceinline__ void done(const Unit&) const {}
};

__device__ __forceinline__ unsigned cvt_pk_bf16(float lo, float hi) { unsigned r; asm volatile("v_cvt_pk_bf16_f32 %0, %1, %2" : "=v"(r) : "v"(lo), "v"(hi)); return r; }

typedef unsigned u32x2 __attribute__((ext_vector_type(2)));
struct EpiF32 {
    static constexpr bool PERM = false, AFTER_DRAIN = false;
    float* C; int ldc; int ncols;
    __device__ __forceinline__ void operator()(const f32x4 (&acc)[2][2][4][2], const Unit& u, int wr, int wc, int fr, int fq) const {
        const int row0 = u.pm * BM + wr * 64 + fr, col0 = u.pn * BM + wc * 32 + 4 * fq;
#pragma unroll
        for (int ai = 0; ai < 2; ++ai)
#pragma unroll
            for (int m = 0; m < 4; ++m) { float* rowp = C + (size_t)(row0 + ai * HALF + m * 16) * ldc;
#pragma unroll
                for (int bj = 0; bj < 2; ++bj)
#pragma unroll
                    for (int n = 0; n < 2; ++n) { const int col = col0 + bj * HALF + n * 16; if (col < ncols) *(f32x4*)(rowp + col) = acc[ai][bj][m][n]; } }
    }
};
struct EpiRowScaleF32 {
    static constexpr bool PERM = false, AFTER_DRAIN = false;
    float* C; int ldc; const float* gate; int er;
    __device__ __forceinline__ void operator()(const f32x4 (&acc)[2][2][4][2], const Unit& u, int wr, int wc, int fr, int fq) const {
        const int row0 = u.pm * BM + wr * 64 + fr, col0 = u.pn * BM + wc * 32 + 4 * fq;
#pragma unroll
        for (int ai = 0; ai < 2; ++ai)
#pragma unroll
            for (int m = 0; m < 4; ++m) { const int row = row0 + ai * HALF + m * 16; float* rowp = C + (size_t)row * ldc; const float sc = gate[(row / er) * ER_MAX + row % er];
#pragma unroll
                for (int bj = 0; bj < 2; ++bj)
#pragma unroll
                    for (int n = 0; n < 2; ++n) *(f32x4*)(rowp + col0 + bj * HALF + n * 16) = acc[ai][bj][m][n] * sc; }
    }
};
struct EpiSwiGLU {
    static constexpr bool PERM = true, AFTER_DRAIN = false;
    bf16_t* O; int ldo;
    __device__ __forceinline__ void operator()(const f32x4 (&acc)[2][2][4][2], const Unit& u, int wr, int wc, int fr, int fq) const {
        const int row0 = u.pm * BM + wr * 64 + fr, col0 = u.pn * BM + wc * 32 + 8 * fq;
#pragma unroll
        for (int ai = 0; ai < 2; ++ai)
#pragma unroll
            for (int m = 0; m < 4; ++m) { bf16_t* rowp = O + (size_t)(row0 + ai * HALF + m * 16) * ldo;
#pragma unroll
                for (int bj = 0; bj < 2; ++bj) { const f32x4 gt = acc[ai][bj][m][0], up = acc[ai][bj][m][1]; f32x4 h;
#pragma unroll
                    for (int i = 0; i < 4; ++i) h[i] = gt[i] / (1.0f + __expf(-gt[i])) * up[i];
                    u32x2 w; w.x = cvt_pk_bf16(h[0], h[1]); w.y = cvt_pk_bf16(h[2], h[3]);
                    *(u32x2*)(rowp + (col0 + bj * HALF) / 2) = w; } }
    }
};

struct EpiBf16 {
    static constexpr bool PERM = true, AFTER_DRAIN = false;
    bf16_t* O; int ldo; int ncols;
    __device__ __forceinline__ void operator()(const f32x4 (&acc)[2][2][4][2], const Unit& u, int wr, int wc, int fr, int fq) const {
        const int row0 = u.pm * BM + wr * 64 + fr, col0 = u.pn * BM + wc * 32 + 8 * fq;
#pragma unroll
        for (int ai = 0; ai < 2; ++ai)
#pragma unroll
            for (int m = 0; m < 4; ++m) { bf16_t* rowp = O + (size_t)(row0 + ai * HALF + m * 16) * ldo;
#pragma unroll
                for (int bj = 0; bj < 2; ++bj) { const int col = col0 + bj * HALF; const f32x4 v0 = acc[ai][bj][m][0], v1 = acc[ai][bj][m][1];
                    u32x4 w; w.x = cvt_pk_bf16(v0[0], v0[1]); w.y = cvt_pk_bf16(v0[2], v0[3]); w.z = cvt_pk_bf16(v1[0], v1[1]); w.w = cvt_pk_bf16(v1[2], v1[3]);
                    if (col < ncols) *(u32x4*)(rowp + col) = w; } }
    }
};
struct EpiRowScaleBf16 {
    static constexpr bool PERM = true, AFTER_DRAIN = false;
    bf16_t* O; int ldo; const float* gate; int er;
    __device__ __forceinline__ void operator()(const f32x4 (&acc)[2][2][4][2], const Unit& u, int wr, int wc, int fr, int fq) const {
        const int row0 = u.pm * BM + wr * 64 + fr, col0 = u.pn * BM + wc * 32 + 8 * fq;
#pragma unroll
        for (int ai = 0; ai < 2; ++ai)
#pragma unroll
            for (int m = 0; m < 4; ++m) { const int row = row0 + ai * HALF + m * 16; bf16_t* rowp = O + (size_t)row * ldo; const float sc = gate[(row / er) * ER_MAX + row % er];
#pragma unroll
                for (int bj = 0; bj < 2; ++bj) { const f32x4 v0 = acc[ai][bj][m][0] * sc, v1 = acc[ai][bj][m][1] * sc;
                    u32x4 w; w.x = cvt_pk_bf16(v0[0], v0[1]); w.y = cvt_pk_bf16(v0[2], v0[3]); w.z = cvt_pk_bf16(v1[0], v1[1]); w.w = cvt_pk_bf16(v1[2], v1[3]);
                    *(u32x4*)(rowp + col0 + bj * HALF) = w; } }
    }
};
template <class Epi, class Sched, bool ALIGN_EPI = false, bool SP2 = false>
__device__ __forceinline__ void gemm_phase(PG8_LAS unsigned char* lds, const Gemm g, const Sched& S, const Epi& E, int tid_in) {
    int tid_ = tid_in; asm volatile("" : "+v"(tid_));
    const int tid = tid_, wid = __builtin_amdgcn_readfirstlane(tid >> 6), lane = tid & 63, wr = wid >> 2, wc = wid & 3, fr = lane & 15, fq = lane >> 4;
    int K_ = g.K; asm volatile("" : "+s"(K_));
    const int K = K_, nt = K / BK;
    unsigned voffA[2], voffB[2];
#pragma unroll
    for (int i = 0; i < 2; ++i) { int R, C; stage_rc(tid * 16 + i * 8192, R, C); const int Rb = Epi::PERM ? ((R & ~31) + perm32(R & 31)) : R;
        voffA[i] = (unsigned)(R * K + C) * 2u; voffB[i] = (unsigned)(Rb * K + C) * 2u; }
    const size_t kstep = (size_t)(BK * 2);
    const size_t hstep = (size_t)HALF * K * 2;
    const size_t tstep = 2 * hstep;
    const unsigned ldsw = (unsigned)wid * 1024u;
    const int aoff = lds_byte(wr * 64 + fr, fq * 8), boff = lds_byte(wc * 32 + fr, fq * 8);
#define PG8_SA(b, h) (((b) * 2 + (h)) * HTB)
#define PG8_SB(b, h) ((4 + (b) * 2 + (h)) * HTB)
#define PG8_STAGE(bufoff, gbase, voff) do { _Pragma("unroll") for (int _i = 0; _i < 2; ++_i) \
        __builtin_amdgcn_global_load_lds((const unsigned*)((const char*)(gbase) + (voff)[_i]), (PG8_LAS unsigned*)(lds + (bufoff) + ldsw + _i * 8192), 16, 0, 0); } while (0)
#define PG8_LDA(dst, b, h) do { _Pragma("unroll") for (int m = 0; m < 4; ++m) _Pragma("unroll") for (int k = 0; k < 2; ++k) dst[m][k] = *(const PG8_LAS bf16x8*)(lds + PG8_SA(b, h) + aoff + m * 2048 + k * 1024); } while (0)
#define PG8_LDB(dst, b, h) do { _Pragma("unroll") for (int n = 0; n < 2; ++n) _Pragma("unroll") for (int k = 0; k < 2; ++k) dst[n][k] = *(const PG8_LAS bf16x8*)(lds + PG8_SB(b, h) + boff + n * 2048 + k * 1024); } while (0)
#define PG8_MMA(ai, bj, At, Bt) do { __builtin_amdgcn_s_setprio(1); _Pragma("unroll") for (int m = 0; m < 4; ++m) _Pragma("unroll") for (int n = 0; n < 2; ++n) _Pragma("unroll") for (int k = 0; k < 2; ++k) \
        acc[ai][bj][m][n] = __builtin_amdgcn_mfma_f32_16x16x32_bf16(Bt[n][k], At[m][k], acc[ai][bj][m][n], 0, 0, 0); __builtin_amdgcn_s_setprio(0); } while (0)
#define PG8_WAIT_V(n) asm volatile("s_waitcnt vmcnt(" #n ")" ::: "memory")
#define PG8_WAIT_L(n) asm volatile("s_waitcnt lgkmcnt(" #n ")" ::: "memory")
#define PG8_BAR __builtin_amdgcn_s_barrier()
#define PG8_SCHED __builtin_amdgcn_sched_barrier(0)
    Unit cur, nxt; int ui = 0;
    if (!S.next(0, cur)) return;
    f32x4 acc[2][2][4][2];
#pragma unroll
    for (int a = 0; a < 2; ++a)
#pragma unroll
        for (int b = 0; b < 2; ++b)
#pragma unroll
            for (int m = 0; m < 4; ++m)
#pragma unroll
                for (int n = 0; n < 2; ++n) acc[a][b][m][n] = (f32x4){0.f, 0.f, 0.f, 0.f};
    bf16x8 At[4][2], B0[2][2], B1[2][2];
    const char* cA = (const char*)g.A + (size_t)cur.pm * tstep; const char* cB = (const char*)g.Bt + (size_t)cur.pn * tstep + (g.grp_tiles ? (size_t)(cur.pm / g.grp_tiles) * g.grp_stride : (size_t)0);
    S.a_ready(cur);
    if constexpr (SP2) {
        PG8_STAGE(PG8_SB(0, 0), cB, voffB); PG8_STAGE(PG8_SB(0, 1), cB + hstep, voffB); PG8_STAGE(PG8_SA(0, 0), cA, voffA); PG8_STAGE(PG8_SA(0, 1), cA + hstep, voffA);
        if (wr == 1) PG8_BAR;
        PG8_WAIT_V(2); PG8_BAR;
        PG8_STAGE(PG8_SB(1, 0), cB + kstep, voffB); PG8_STAGE(PG8_SA(1, 0), cA + kstep, voffA); PG8_STAGE(PG8_SB(1, 1), cB + hstep + kstep, voffB);
        PG8_WAIT_V(6); PG8_BAR;
    } else {
        PG8_STAGE(PG8_SB(0, 0), cB, voffB); PG8_STAGE(PG8_SA(0, 0), cA, voffA); PG8_STAGE(PG8_SB(0, 1), cB + hstep, voffB); PG8_STAGE(PG8_SA(0, 1), cA + hstep, voffA);
        if (wr == 1) PG8_BAR;
        PG8_WAIT_V(4); PG8_BAR;
        PG8_STAGE(PG8_SB(1, 0), cB + kstep, voffB); PG8_STAGE(PG8_SA(1, 0), cA + kstep, voffA); PG8_STAGE(PG8_SB(1, 1), cB + hstep + kstep, voffB);
        PG8_WAIT_V(6); PG8_BAR;
    }
    for (;;) {
        const bool has_next = S.next(ui + 1, nxt);
        const char* nA = has_next ? (const char*)g.A + (size_t)nxt.pm * tstep : cA; const char* nB = has_next ? (const char*)g.Bt + (size_t)nxt.pn * tstep + (g.grp_tiles ? (size_t)(nxt.pm / g.grp_tiles) * g.grp_stride : (size_t)0) : cB;
        for (int t = 0; t < nt; t += 2) {
            const bool last = (t == nt - 2);
            const char* a1 = cA + (size_t)(t + 1) * kstep;
            const char* a2 = last ? nA : cA + (size_t)(t + 2) * kstep; const char* b2 = last ? nB : cB + (size_t)(t + 2) * kstep;
            const char* a3 = a2 + kstep; const char* b3 = b2 + kstep;
            if (last && has_next) S.a_ready(nxt);
            if constexpr (SP2) {
            PG8_LDB(B0, 0, 0); PG8_LDB(B1, 0, 1); PG8_SCHED; PG8_LDA(At, 0, 0); PG8_STAGE(PG8_SA(1, 1), a1 + hstep, voffA);
            PG8_WAIT_V(8); PG8_WAIT_L(0); PG8_BAR; PG8_MMA(0, 0, At, B0); PG8_MMA(0, 1, At, B1); PG8_BAR; PG8_SCHED;
            PG8_LDA(At, 0, 1); PG8_STAGE(PG8_SB(0, 0), b2, voffB); PG8_STAGE(PG8_SB(0, 1), b2 + hstep, voffB); PG8_STAGE(PG8_SA(0, 0), a2, voffA);
            PG8_WAIT_V(8); PG8_WAIT_L(0); PG8_BAR; PG8_MMA(1, 0, At, B0); PG8_MMA(1, 1, At, B1); PG8_BAR; PG8_SCHED;
            PG8_LDB(B0, 1, 0); PG8_LDB(B1, 1, 1); PG8_SCHED; PG8_LDA(At, 1, 0); PG8_STAGE(PG8_SA(0, 1), a2 + hstep, voffA);
            PG8_WAIT_V(8); PG8_WAIT_L(0); PG8_BAR; PG8_MMA(0, 0, At, B0); PG8_MMA(0, 1, At, B1); PG8_BAR; PG8_SCHED;
            PG8_LDA(At, 1, 1); PG8_STAGE(PG8_SB(1, 0), b3, voffB); PG8_STAGE(PG8_SB(1, 1), b3 + hstep, voffB); PG8_STAGE(PG8_SA(1, 0), a3, voffA);
            PG8_WAIT_V(8); PG8_WAIT_L(0); PG8_BAR; PG8_MMA(1, 0, At, B0); PG8_MMA(1, 1, At, B1); PG8_BAR; PG8_SCHED;
            } else {
            PG8_LDB(B0, 0, 0); PG8_SCHED; PG8_LDA(At, 0, 0); PG8_STAGE(PG8_SA(1, 1), a1 + hstep, voffA);
            PG8_WAIT_L(8); PG8_BAR; PG8_WAIT_L(0); PG8_MMA(0, 0, At, B0); PG8_BAR; PG8_SCHED;
            PG8_LDB(B1, 0, 1); PG8_STAGE(PG8_SB(0, 0), b2, voffB);
            PG8_BAR; PG8_WAIT_L(0); PG8_MMA(0, 1, At, B1); PG8_BAR;
            PG8_LDA(At, 0, 1); PG8_STAGE(PG8_SA(0, 0), a2, voffA);
            PG8_BAR; PG8_WAIT_L(0); PG8_MMA(1, 0, At, B0); PG8_BAR; PG8_SCHED;
            PG8_STAGE(PG8_SB(0, 1), b2 + hstep, voffB);
            PG8_WAIT_V(6); PG8_BAR; PG8_MMA(1, 1, At, B1); PG8_BAR;
            PG8_LDB(B0, 1, 0); PG8_SCHED; PG8_LDA(At, 1, 0); PG8_STAGE(PG8_SA(0, 1), a2 + hstep, voffA);
            PG8_WAIT_L(8); PG8_BAR; PG8_WAIT_L(0); PG8_MMA(0, 0, At, B0); PG8_BAR; PG8_SCHED;
            PG8_LDB(B1, 1, 1); PG8_STAGE(PG8_SB(1, 0), b3, voffB);
            PG8_BAR; PG8_WAIT_L(0); PG8_MMA(0, 1, At, B1); PG8_BAR;
            PG8_LDA(At, 1, 1); PG8_STAGE(PG8_SA(1, 0), a3, voffA);
            PG8_BAR; PG8_WAIT_L(0); PG8_MMA(1, 0, At, B0); PG8_BAR; PG8_SCHED;
            PG8_STAGE(PG8_SB(1, 1), b3 + hstep, voffB);
            PG8_WAIT_V(6); PG8_BAR; PG8_MMA(1, 1, At, B1); PG8_BAR;
            }
        }
        if constexpr (ALIGN_EPI) { if (wr == 0) PG8_BAR; }
        if constexpr (!Epi::AFTER_DRAIN) { E(acc, cur, wr, wc, fr, fq); S.done(cur); }
        if (!has_next) break;
#pragma unroll
        for (int a = 0; a < 2; ++a)
#pragma unroll
            for (int b = 0; b < 2; ++b)
#pragma unroll
                for (int m = 0; m < 4; ++m)
#pragma unroll
                    for (int n = 0; n < 2; ++n) acc[a][b][m][n] = (f32x4){0.f, 0.f, 0.f, 0.f};
        cur = nxt; cA = nA; cB = nB; ++ui;
        if constexpr (ALIGN_EPI) { if (wr == 1) PG8_BAR; }
    }
    PG8_WAIT_V(0);
    if constexpr (!ALIGN_EPI) { if (wr == 0) PG8_BAR; }
    PG8_BAR;
    if constexpr (Epi::AFTER_DRAIN) { E.fused(acc, cur, wr, wc, fr, fq, lds, wid, lane); S.done(cur); }
#undef PG8_SA
#undef PG8_SB
#undef PG8_STAGE
#undef PG8_LDA
#undef PG8_LDB
#undef PG8_MMA
#undef PG8_WAIT_V
#undef PG8_WAIT_L
#undef PG8_BAR
#undef PG8_SCHED
}
}


#define XB_TMO      128
#define XB_XCNT(j)  (256  + 64 * (j))
#define XB_XSUB(j)  (1280 + 64 * (j))
#define XB_XGEN(j)  (2304 + 64 * (j))
#define XB_TOP      3328
#define XB_TOPGEN   3392
#define XCD_BAR_WORDS 3456
#define XB_SPIN_CAP (1u << 22)
__device__ __forceinline__ unsigned xb_ld(unsigned* p)              { return __hip_atomic_load(p, __ATOMIC_RELAXED, __HIP_MEMORY_SCOPE_AGENT); }
__device__ __forceinline__ unsigned xb_add(unsigned* p, unsigned v) { return __hip_atomic_fetch_add(p, v, __ATOMIC_RELAXED, __HIP_MEMORY_SCOPE_AGENT); }
__device__ __forceinline__ unsigned xb_xcc_id() { return (unsigned)__builtin_amdgcn_s_getreg((3 << 11) | 20) & 0xFu; }
#define XB_SPIN(cond, bar) do { unsigned _sp = 0; while (cond) { __builtin_amdgcn_s_sleep(1); \
    if ((++_sp & 255u) == 0u) { if (xb_ld(&(bar)[XB_TMO])) break; if (_sp > XB_SPIN_CAP) { atomicAdd(&(bar)[XB_TMO], 1u); break; } } } } while (0)
struct XcdBarrier { unsigned* bar; unsigned x; volatile LAS unsigned* st; };
__device__ __forceinline__ XcdBarrier xcd_barrier_post(unsigned* bar, volatile LAS unsigned* st, int tid_in) {
    XcdBarrier b; b.bar = bar; b.x = xb_xcc_id(); b.st = st;
    if (tid_in == 0) (void)xb_add(&bar[XB_XCNT(b.x)], 1u);
    return b;
}
__device__ __forceinline__ void xcd_barrier_complete(unsigned* bar, unsigned x, unsigned& nloc, unsigned& nx) {
    const unsigned G = gridDim.x * gridDim.y * gridDim.z;
    unsigned sum, cnt, mine, sp = 0u;
    for (;;) {
        sum = 0u; cnt = 0u; mine = 0u;
#pragma unroll
        for (unsigned j = 0; j < 16; ++j) { const unsigned c = xb_ld(&bar[XB_XCNT(j)]); sum += c; cnt += (c > 0u) ? 1u : 0u; mine = (j == x) ? c : mine; }
        if (sum == G) break;
        __builtin_amdgcn_s_sleep(1);
        if ((++sp & 255u) == 0u) { if (xb_ld(&bar[XB_TMO])) break; if (sp > XB_SPIN_CAP) { atomicAdd(&bar[XB_TMO], 1u); break; } }
    }
    nloc = mine > 0u ? mine : 1u; nx = cnt > 0u ? cnt : 1u;
}
__device__ __forceinline__ void xcd_barrier(const XcdBarrier& b, int tid_in) {
    asm volatile("s_waitcnt vmcnt(0)" ::: "memory");
    __syncthreads();
    if (tid_in == 0) {
        unsigned* bar = b.bar;
        __builtin_amdgcn_s_waitcnt(0);
        unsigned nloc = b.st[0], nx = b.st[1];
        if (nloc == 0u) { xcd_barrier_complete(bar, b.x, nloc, nx); b.st[0] = nloc; b.st[1] = nx; }
        const unsigned old = xb_add(&bar[XB_XSUB(b.x)], 1u);
        const unsigned gen = old / nloc;
        if (old + 1u == (gen + 1u) * nloc) {
            __builtin_amdgcn_fence(__ATOMIC_RELEASE, "agent");
            asm volatile("s_waitcnt vmcnt(0)" ::: "memory");
            const unsigned og = xb_add(&bar[XB_TOP], 1u);
            const unsigned tg = og / nx;
            if (og + 1u == (tg + 1u) * nx) xb_add(&bar[XB_TOPGEN], 1u);
            else XB_SPIN(xb_ld(&bar[XB_TOPGEN]) == tg, bar);
            __builtin_amdgcn_fence(__ATOMIC_ACQUIRE, "agent");
            xb_add(&bar[XB_XGEN(b.x)], 1u);
            asm volatile("s_waitcnt vmcnt(0)" ::: "memory");
        } else {
            XB_SPIN(xb_ld(&bar[XB_XGEN(b.x)]) == gen, bar);
            __builtin_amdgcn_fence(__ATOMIC_ACQUIRE, "agent");
            asm volatile("s_waitcnt vmcnt(0)" ::: "memory");
        }
    }
    __syncthreads();
}


typedef short bf16x8 __attribute__((ext_vector_type(8)));
typedef short s16x4 __attribute__((ext_vector_type(4)));
typedef float f32x16 __attribute__((ext_vector_type(16)));
typedef unsigned v4u __attribute__((ext_vector_type(4)));
typedef unsigned v2u __attribute__((ext_vector_type(2)));
constexpr float ATT_THR = 5.0f;
template <int DK> struct AttL { static constexpr int KSTR = DK * 2 + 16, KBYTES = 64 * KSTR, VSTR = 136, VBYTES = 64 * VSTR, KCH = 64 * DK / 8, KPT = (KCH + NTHREADS - 1) / NTHREADS;
    static constexpr int K_OFF = 0, V_OFF = 2 * KBYTES; };

template <int DK>
__device__ __forceinline__ void attn_pass(const bf16_t* Qrow, const bf16_t* Kp, const bf16_t* Vtp, int vt_ld, int nkt, LAS unsigned char* lds, int tid, f32x16 (&oacc)[2], float& l_run) {
    typedef AttL<DK> L;
    constexpr bool AUG = DK <= 32;
    const int lane = tid & 63, r = lane & 31, h = lane >> 5;
    bf16x8 qf[DK / 16];
#pragma unroll
    for (int ks = 0; ks < DK / 16; ++ks) qf[ks] = *(const bf16x8*)(Qrow + 16 * ks + 8 * h);
    const short z_ = (short)(tid >> 20);
    bf16x8 aone = {z_, z_, z_, z_, z_, z_, z_, z_}, bneg = {z_, z_, z_, z_, z_, z_, z_, z_};
    if (h == 0) aone[0] = (short)0x3F80;
    float m_run = 0.f;
    v4u kreg[L::KPT]; v4u vreg;
    const int vd = tid >> 3, vpart = tid & 7;
#define ATT_LOADK(j) do { _Pragma("unroll") for (int i_ = 0; i_ < L::KPT; ++i_) { const int c_ = tid + i_ * NTHREADS; if (c_ < L::KCH) kreg[i_] = *(const v4u*)(Kp + (size_t)(j) * 64 * DK + c_ * 8); } } while (0)
#define ATT_LOADV(j) do { vreg = *(const v4u*)(Vtp + (size_t)vd * vt_ld + (j) * 64 + vpart * 8); } while (0)
#define ATT_STOREK(buf) do { _Pragma("unroll") for (int i_ = 0; i_ < L::KPT; ++i_) { const int c_ = tid + i_ * NTHREADS; if (c_ < L::KCH) { const int key_ = c_ / (DK / 8), part_ = c_ % (DK / 8); \
            *(LAS v4u*)(lds + L::K_OFF + (buf) * L::KBYTES + key_ * L::KSTR + part_ * 16) = kreg[i_]; } } } while (0)
#define ATT_STOREV(buf) do { LAS unsigned char* vp_ = lds + L::V_OFF + (buf) * L::VBYTES + vd * L::VSTR + vpart * 16; *(LAS v2u*)vp_ = (v2u){vreg.x, vreg.y}; *(LAS v2u*)(vp_ + 8) = (v2u){vreg.z, vreg.w}; } while (0)
#define ATT_QK(dst, buf) do { _Pragma("unroll") for (int kb = 0; kb < 2; ++kb) { _Pragma("unroll") for (int i = 0; i < 16; ++i) dst[kb][i] = 0.f; \
        if (AUG) dst[kb] = __builtin_amdgcn_mfma_f32_32x32x16_bf16(aone, bneg, dst[kb], 0, 0, 0); \
        _Pragma("unroll") for (int ks = 0; ks < DK / 16; ++ks) { const bf16x8 a_ = *(const LAS bf16x8*)(lds + L::K_OFF + (buf) * L::KBYTES + (32 * kb + r) * L::KSTR + (16 * ks + 8 * h) * 2); \
            dst[kb] = __builtin_amdgcn_mfma_f32_32x32x16_bf16(a_, qf[ks], dst[kb], 0, 0, 0); } } } while (0)
#define ATT_BODY(SC, SN, j) do { \
        if ((j) + 2 < nkt) ATT_LOADK((j) + 2); \
        if ((j) + 1 < nkt) { ATT_LOADV((j) + 1); ATT_QK(SN, ((j) + 1) & 1); } \
        if (((j) & 3) == 0) { \
            float t0 = fmaxf(fmaxf(SC[0][0], SC[0][1]), SC[0][2]), t1 = fmaxf(fmaxf(SC[0][3], SC[0][4]), SC[0][5]), t2 = fmaxf(fmaxf(SC[0][6], SC[0][7]), SC[0][8]), t3 = fmaxf(fmaxf(SC[0][9], SC[0][10]), SC[0][11]); \
            float t4 = fmaxf(fmaxf(SC[0][12], SC[0][13]), SC[0][14]), t5 = fmaxf(fmaxf(SC[0][15], SC[1][0]), SC[1][1]), t6 = fmaxf(fmaxf(SC[1][2], SC[1][3]), SC[1][4]), t7 = fmaxf(fmaxf(SC[1][5], SC[1][6]), SC[1][7]); \
            float t8 = fmaxf(fmaxf(SC[1][8], SC[1][9]), SC[1][10]), t9 = fmaxf(fmaxf(SC[1][11], SC[1][12]), SC[1][13]), t10 = fmaxf(SC[1][14], SC[1][15]); \
            float tmax = fmaxf(fmaxf(fmaxf(fmaxf(t0, t1), t2), fmaxf(fmaxf(t3, t4), t5)), fmaxf(fmaxf(fmaxf(t6, t7), t8), fmaxf(t9, t10))); \
            tmax = xor32_max(tmax); if (!AUG) tmax -= m_run;            \
            if ((j) == 0 || __any(tmax > ATT_THR)) {                   \
                const float want = (j) == 0 ? tmax : m_run + fmaxf(tmax, 0.f); \
                const float mn = __uint_as_float(pk2(want, 0.f) << 16), dlt = mn - m_run, alpha = __builtin_amdgcn_exp2f(-dlt); \
                _Pragma("unroll") for (int i = 0; i < 16; ++i) { oacc[0][i] *= alpha; oacc[1][i] *= alpha; if (AUG) { SC[0][i] -= dlt; SC[1][i] -= dlt; SN[0][i] -= dlt; SN[1][i] -= dlt; } } \
                l_run *= alpha; m_run = mn; if (AUG && h == 0) bneg[0] = (short)(__float_as_uint(-mn) >> 16); \
            } \
        } \
        float ps0 = 0.f, ps1 = 0.f, ps2 = 0.f, ps3 = 0.f; \
        _Pragma("unroll") for (int kb = 0; kb < 2; ++kb) \
            _Pragma("unroll") for (int i = 0; i < 16; i += 4) { const float mo = AUG ? 0.f : m_run; const float p0 = __builtin_amdgcn_exp2f(SC[kb][i] - mo), p1 = __builtin_amdgcn_exp2f(SC[kb][i + 1] - mo), p2 = __builtin_amdgcn_exp2f(SC[kb][i + 2] - mo), p3 = __builtin_amdgcn_exp2f(SC[kb][i + 3] - mo); \
                SC[kb][i] = p0; SC[kb][i + 1] = p1; SC[kb][i + 2] = p2; SC[kb][i + 3] = p3; ps0 += p0; ps1 += p1; ps2 += p2; ps3 += p3; } \
        l_run += (ps0 + ps1) + (ps2 + ps3); \
        _Pragma("unroll") for (int kb = 0; kb < 2; ++kb) \
            _Pragma("unroll") for (int s2 = 0; s2 < 2; ++s2) { \
                union { bf16x8 v; unsigned u[4]; } pf; \
                _Pragma("unroll") for (int i = 0; i < 4; ++i) pf.u[i] = pk2(SC[kb][8 * s2 + 2 * i], SC[kb][8 * s2 + 2 * i + 1]); \
                _Pragma("unroll") for (int db = 0; db < 2; ++db) { \
                    const LAS unsigned char* vp = lds + L::V_OFF + ((j) & 1) * L::VBYTES + (32 * db + r) * L::VSTR + (32 * kb + 16 * s2 + 4 * h) * 2; \
                    union { bf16x8 v; v2u u[2]; } af; af.u[0] = *(const LAS v2u*)vp; af.u[1] = *(const LAS v2u*)(vp + 16); \
                    oacc[db] = __builtin_amdgcn_mfma_f32_32x32x16_bf16(af.v, pf.v, oacc[db], 0, 0, 0); } } \
        if ((j) + 2 < nkt) ATT_STOREK((j) & 1);               \
        if ((j) + 1 < nkt) ATT_STOREV(((j) + 1) & 1);         \
        __syncthreads(); \
    } while (0)
    __syncthreads();
    ATT_LOADK(0); ATT_LOADV(0); ATT_STOREK(0); ATT_STOREV(0);
    if (nkt > 1) { ATT_LOADK(1); ATT_STOREK(1); }
    __syncthreads();
    f32x16 sa[2], sb[2];
#pragma unroll
    for (int i = 0; i < 16; ++i) { sb[0][i] = (float)z_; sb[1][i] = (float)z_; }
    ATT_QK(sa, 0);
    for (int j = 0; j < nkt; j += 2) {
        ATT_BODY(sa, sb, j);
        if (j + 1 < nkt) ATT_BODY(sb, sa, j + 1);
    }
#undef ATT_BODY
#undef ATT_LOADK
#undef ATT_LOADV
#undef ATT_STOREK
#undef ATT_STOREV
#undef ATT_QK
}


constexpr int SLD = 65, SHLD = 72, XTLD = 132;
__device__ __forceinline__ int rm32(int t, int h) { return (t & 3) + 8 * (t >> 2) + 4 * h; }
template <bool WITH_Y>
__device__ __forceinline__ void ssd_block(int b, int dir, int k, int hp, const bf16_t* xbc, const float* dtp, const float* alog, float* hs, float* alast, bf16_t* yd, float* lds, int tid) {
    const bool lat = k >= 2; const int c = lat ? (dir ? 33 - k : k - 2) : (dir ? 1 - k : k);
    const int row0 = tok_row(lat, b, c * 128), g = hp >> 1;
    float* sB = lds; bf16_t* sBh = (bf16_t*)lds; bf16_t* sCh = sBh + 128 * SHLD;
    float* sX = WITH_Y ? lds + (2 * 128 * SHLD * 2) / 4 : sB + 128 * SLD; bf16_t* sXT = (bf16_t*)sX;
    float* sDT = sX + 128 * 128; float* sCum = sDT + 256; float* sW = sCum + 256; float* sSc = sW + 256;
    const int wave = tid >> 6, lane = tid & 63, r = lane & 31, h = lane >> 5, hl = wave >> 2, head = 2 * hp + hl;
    float* hsp = hs + (((size_t)(b * 2 + dir) * NCH + k) * 8 + head) * 4096;
    union { bf16x8 v; unsigned u[4]; } hfrag[WITH_Y ? 8 : 1];
    if (WITH_Y) {
#pragma unroll
        for (int Pb = 0; Pb < 2; ++Pb)
#pragma unroll
            for (int ks = 0; ks < 4; ++ks) { const float4 x0 = *(const float4*)(hsp + (32 * Pb + r) * 64 + 16 * ks + 8 * h), x1 = *(const float4*)(hsp + (32 * Pb + r) * 64 + 16 * ks + 8 * h + 4);
                hfrag[Pb * 4 + ks].u[0] = pk2(x0.x, x0.y); hfrag[Pb * 4 + ks].u[1] = pk2(x0.z, x0.w); hfrag[Pb * 4 + ks].u[2] = pk2(x1.x, x1.y); hfrag[Pb * 4 + ks].u[3] = pk2(x1.z, x1.w); }
    }
    uint2 vb[8]; float4 vx[8]; float dx[8]; float dtv = 0.f, dav = 0.f;
#pragma unroll
    for (int u = 0; u < 8; ++u) { const int i = tid + u * NTHREADS, t = i >> 5, c4 = i & 31;
        vb[u] = *(const uint2*)(xbc + (size_t)(row0 + t) * 768 + 512 + (c4 >> 4) * 128 + g * 64 + (c4 & 15) * 4);
        vx[u] = ld4h(xbc + (size_t)(row0 + t) * 768 + hp * 128 + c4 * 4);
        dx[u] = dtp[(size_t)(row0 + t) * 16 + dir * 8 + 2 * hp + (c4 >> 4)]; }
    if (tid < 256) { const int hl = tid >> 7, t = tid & 127, h = 2 * hp + hl; dtv = dtp[(size_t)(row0 + t) * 16 + dir * 8 + h]; dav = dtv * -expf(alog[dir * 8 + h]); }
    __syncthreads();
#pragma unroll
    for (int u = 0; u < 8; ++u) { const int i = tid + u * NTHREADS, t = i >> 5, c4 = i & 31;
        if (WITH_Y) *(uint2*)((c4 >> 4 ? sCh : sBh) + t * SHLD + (c4 & 15) * 4) = vb[u];
        else if (!(c4 >> 4)) { const float4 f = up4(vb[u]); float* d = sB + t * SLD + (c4 & 15) * 4; d[0] = f.x; d[1] = f.y; d[2] = f.z; d[3] = f.w; }
        if (WITH_Y) { const float4 xs = f4scale(vx[u], dx[u]); sXT[(c4 * 4 + 0) * XTLD + t] = (bf16_t)(pk2(xs.x, 0.f)); sXT[(c4 * 4 + 1) * XTLD + t] = (bf16_t)(pk2(xs.y, 0.f)); sXT[(c4 * 4 + 2) * XTLD + t] = (bf16_t)(pk2(xs.z, 0.f)); sXT[(c4 * 4 + 3) * XTLD + t] = (bf16_t)(pk2(xs.w, 0.f)); }
        else *(float4*)(sX + t * 128 + c4 * 4) = f4scale(vx[u], dx[u]); }
    if (tid < 256) { const int t = tid & 127; sSc[(tid & 128) + (dir ? 127 - t : t)] = dav; }
    __syncthreads();
    for (int off = 1; off < 128; off <<= 1) { float v = 0.f; const int sI = tid & 127;
        if (tid < 256) { v = sSc[tid]; if (sI >= off) v += sSc[tid - off]; }
        __syncthreads(); if (tid < 256) sSc[tid] = v; __syncthreads(); }
    if (tid < 256) { const int hl = tid >> 7, sI = tid & 127, t = dir ? 127 - sI : sI; const float cu = sSc[tid], tot = sSc[hl * 128 + 127];
        sCum[hl * 128 + t] = cu; sW[hl * 128 + t] = expf(tot - cu);
        if (!WITH_Y && sI == 127) alast[((size_t)(b * 2 + dir) * NCH + k) * 8 + 2 * hp + hl] = tot; }
    __syncthreads();
    if (WITH_Y) {
        const int I = hl ? 3 - (wave & 3) : (wave & 3), ti = 32 * I + r;
        const float cum_i = sCum[hl * 128 + ti];
        f32x16 Y[2], Yo[2];
#pragma unroll
        for (int i = 0; i < 16; ++i) { Y[0][i] = 0.f; Y[1][i] = 0.f; Yo[0][i] = 0.f; Yo[1][i] = 0.f; }
        bf16x8 cfrag[4];
#pragma unroll
        for (int ks = 0; ks < 4; ++ks) cfrag[ks] = *(const bf16x8*)(sCh + (32 * I + r) * SHLD + 16 * ks + 8 * h);
#pragma unroll
        for (int Pb = 0; Pb < 2; ++Pb)
#pragma unroll
            for (int ks = 0; ks < 4; ++ks) Yo[Pb] = __builtin_amdgcn_mfma_f32_32x32x16_bf16(hfrag[Pb * 4 + ks].v, cfrag[ks], Yo[Pb], 0, 0, 0);
        const int J0 = dir ? I : 0, J1 = dir ? 3 : I;
        for (int J = J0; J <= J1; ++J) {
            f32x16 Gt;
#pragma unroll
            for (int i = 0; i < 16; ++i) Gt[i] = 0.f;
#pragma unroll
            for (int ks = 0; ks < 4; ++ks) Gt = __builtin_amdgcn_mfma_f32_32x32x16_bf16(*(const bf16x8*)(sBh + (32 * J + r) * SHLD + 16 * ks + 8 * h), cfrag[ks], Gt, 0, 0, 0);
#pragma unroll
            for (int t = 0; t < 16; ++t) { const int tj = 32 * J + rm32(t, h); const bool valid = (J != I) || (dir ? tj >= ti : tj <= ti);
                Gt[t] *= valid ? __expf(cum_i - sCum[hl * 128 + tj]) : 0.f; }
#pragma unroll
            for (int s2 = 0; s2 < 2; ++s2) {
                union { bf16x8 v; unsigned u[4]; } pf;
#pragma unroll
                for (int i = 0; i < 4; ++i) pf.u[i] = pk2(Gt[8 * s2 + 2 * i], Gt[8 * s2 + 2 * i + 1]);
#pragma unroll
                for (int Pb = 0; Pb < 2; ++Pb) {
                    const bf16_t* xp = sXT + (hl * 64 + 32 * Pb + r) * XTLD + 32 * J + 16 * s2 + 4 * h;
                    union { bf16x8 v; uint2 u[2]; } af; af.u[0] = *(const uint2*)xp; af.u[1] = *(const uint2*)(xp + 8);
                    Y[Pb] = __builtin_amdgcn_mfma_f32_32x32x16_bf16(af.v, pf.v, Y[Pb], 0, 0, 0);
                }
            }
        }
        const float ei = __expf(cum_i);
        bf16_t* yrow = yd + ((size_t)dir * NTOK + row0 + ti) * 512 + head * 64;
#pragma unroll
        for (int Pb = 0; Pb < 2; ++Pb)
#pragma unroll
            for (int tq = 0; tq < 4; ++tq)
                *(uint2*)(yrow + 32 * Pb + 8 * tq + 4 * h) = pk4(make_float4(Y[Pb][4 * tq] + ei * Yo[Pb][4 * tq], Y[Pb][4 * tq + 1] + ei * Yo[Pb][4 * tq + 1], Y[Pb][4 * tq + 2] + ei * Yo[Pb][4 * tq + 2], Y[Pb][4 * tq + 3] + ei * Yo[Pb][4 * tq + 3]));
    } else {
        const int Pb = (wave >> 1) & 1, Nb = wave & 1;
        f32x16 acc;
#pragma unroll
        for (int i = 0; i < 16; ++i) acc[i] = 0.f;
#pragma unroll 8
        for (int ks = 0; ks < 64; ++ks) { const int j = 2 * ks + h;
            acc = __builtin_amdgcn_mfma_f32_32x32x2f32(sX[j * 128 + hl * 64 + 32 * Pb + r] * sW[hl * 128 + j], sB[j * SLD + 32 * Nb + r], acc, 0, 0, 0); }
#pragma unroll
        for (int t = 0; t < 16; ++t) hsp[(32 * Pb + rm32(t, h)) * 64 + 32 * Nb + r] = acc[t];
    }
}

template <class RM>
__device__ __forceinline__ void cvt_tile(const float* src, int N, bf16_t* dst, int ldd, RM rowmap, int k0, int n0, int lane) {
    const int n = n0 + lane;
    if (n < N) {
        const float* sp = src + (size_t)k0 * N + n;
        float v[32];
#pragma unroll
        for (int kk = 0; kk < 32; ++kk) v[kk] = sp[(size_t)kk * N];
        uint4* dp = (uint4*)(dst + (size_t)rowmap(n) * ldd + k0);
#pragma unroll
        for (int i = 0; i < 4; ++i) dp[i] = make_uint4(pk2(v[8 * i], v[8 * i + 1]), pk2(v[8 * i + 2], v[8 * i + 3]), pk2(v[8 * i + 4], v[8 * i + 5]), pk2(v[8 * i + 6], v[8 * i + 7]));
    }
}
__device__ __forceinline__ int block_excl_scan(int v, int tid, volatile int* sh, int& total) {
    const int lane = tid & 63, wave = tid >> 6; int x = v;
    x += __builtin_amdgcn_update_dpp(0, x, 0x111, 0xf, 0xf, true); x += __builtin_amdgcn_update_dpp(0, x, 0x112, 0xf, 0xf, true);
    x += __builtin_amdgcn_update_dpp(0, x, 0x114, 0xf, 0xf, true); x += __builtin_amdgcn_update_dpp(0, x, 0x118, 0xf, 0xf, true);
    x += __builtin_amdgcn_update_dpp(0, x, 0x142, 0xa, 0xf, false); x += __builtin_amdgcn_update_dpp(0, x, 0x143, 0xc, 0xf, false);
    __syncthreads();
    if (lane == 63) sh[wave] = x;
    __syncthreads();
    int off = 0, tot = 0;
#pragma unroll
    for (int w = 0; w < 8; ++w) { const int c = sh[w]; tot += c; if (w < wave) off += c; }
    total = tot;
    return off + x - v;
}
__device__ __forceinline__ int block_sum(int v, int tid, volatile int* sh, int parity) {
    const int lane = tid & 63, wave = tid >> 6;
    v += __builtin_amdgcn_update_dpp(0, v, 0x111, 0xf, 0xf, true); v += __builtin_amdgcn_update_dpp(0, v, 0x112, 0xf, 0xf, true);
    v += __builtin_amdgcn_update_dpp(0, v, 0x114, 0xf, 0xf, true); v += __builtin_amdgcn_update_dpp(0, v, 0x118, 0xf, 0xf, true);
    v += __builtin_amdgcn_update_dpp(0, v, 0x142, 0xa, 0xf, false); v += __builtin_amdgcn_update_dpp(0, v, 0x143, 0xc, 0xf, false);
    if (lane == 63) sh[parity * 8 + wave] = v;
    __syncthreads();
    int tot = 0;
#pragma unroll
    for (int w = 0; w < 8; ++w) tot += sh[parity * 8 + w];
    return tot;
}

#define MOD ((float*)(kp_->ws + WS_MOD))
#define CTXC ((float*)(kp_->ws + WS_CTXC))
#define AFF ((float*)(kp_->ws + WS_AFF))
#define TOKSLOT ((int*)(kp_->ws + WS_TOKSLOT))
#define SELIDX ((int*)(kp_->ws + WS_SELIDX))
#define SELGATE ((float*)(kp_->ws + WS_SELGATE))
#define DT ((float*)(kp_->ws + WS_DT))
#define HB ((bf16_t*)(kp_->ws + WS_HB))
#define HS ((float*)(kp_->ws + WS_HS))
#define YD ((bf16_t*)(kp_->ws + WS_YD))
#define ALAST ((float*)(kp_->ws + WS_ALAST))
#define ROPE ((float*)(kp_->ws + WS_ROPE))
#define PB ((bf16_t*)(kp_->ws + WS_P))
#define XBC ((bf16_t*)(kp_->ws + WS_XBC))
#define MQ ((bf16_t*)(kp_->ws + WS_MQ))
#define MKV ((bf16_t*)(kp_->ws + WS_MKV))
#define CQB ((bf16_t*)(kp_->ws + WS_CQB))
#define CKVB ((bf16_t*)(kp_->ws + WS_CKVB))
#define MIXB ((bf16_t*)(kp_->ws + WS_MIXB))
#define MOUT ((bf16_t*)(kp_->ws + WS_MOUT))
#define XG ((bf16_t*)(kp_->ws + WS_XG))
#define HID ((bf16_t*)(kp_->ws + WS_HID))
#define Y ((bf16_t*)(kp_->ws + WS_Y))
#define WIN_T ((bf16_t*)(kp_->ws + WS_WIN))
#define WQ_T ((bf16_t*)(kp_->ws + WS_WQ))
#define WKV_T ((bf16_t*)(kp_->ws + WS_WKV))
#define WOUT_T ((bf16_t*)(kp_->ws + WS_WOUT))
#define WGU_T ((bf16_t*)(kp_->ws + WS_WGU))
#define WD_T ((bf16_t*)(kp_->ws + WS_WD))
#define QD ((bf16_t*)(kp_->ws + WS_QD))
#define QDC ((bf16_t*)(kp_->ws + WS_QDC))
#define KD ((bf16_t*)(kp_->ws + WS_KD))
#define VDT ((bf16_t*)(kp_->ws + WS_VDT))
#define QM ((bf16_t*)(kp_->ws + WS_QM))
#define QMC ((bf16_t*)(kp_->ws + WS_QMC))
#define KM ((bf16_t*)(kp_->ws + WS_KM))
#define VMT ((bf16_t*)(kp_->ws + WS_VMT))
#define xcur (kp_->out)
#define XSRC (l == 0 ? kp_->in[I_X] : (const float*)kp_->out)
#define CSRC (l == 0 ? kp_->in[I_CTX] : (const float*)CTXC)
#define DTMP XBC
#define modl (MOD + (size_t)l * (NB + 1) * NMOD * D)
typedef const __attribute__((address_space(4))) Prm* KPrm;
#define PHASE_BEGIN() KPrm kp_ = (KPrm)__builtin_amdgcn_kernarg_segment_ptr(); asm volatile("" : "+s"(kp_)); int tid = MK_TID(); asm volatile("" : "+v"(tid)); (void)tid
#define GSYNC() do { XcdBarrier b_; b_.bar = (unsigned*)(kp_->ws + WS_CTL); b_.x = xb_xcc_id(); b_.st = (volatile LAS unsigned*)(ldsb + LDS_BYTES - 64); xcd_barrier(b_, tid); } while (0)
#define CVT_MOE_RANGE(LW, ID0, ID1, SLOT, NSLOTS) do { const int lane_ = tid & 63; \
        for (int id = (ID0) + (SLOT); id < (ID1); id += (NSLOTS)) { \
            const int mat = id >> 9, tl = id & 511, e = mat / 3, which = mat % 3, k0 = (tl >> 4) * 32, n0 = (tl & 15) * 64; \
            if (which == 0) cvt_tile(kp_->in[I_WG] + ((size_t)(LW) * NE + e) * D * FF, FF, WGU_T + (size_t)e * 2 * FF * D, D, [](int n) { return (n >> 2) * 8 + (n & 3); }, k0, n0, lane_); \
            else if (which == 1) cvt_tile(kp_->in[I_WU] + ((size_t)(LW) * NE + e) * D * FF, FF, WGU_T + (size_t)e * 2 * FF * D, D, [](int n) { return (n >> 2) * 8 + 4 + (n & 3); }, k0, n0, lane_); \
            else cvt_tile(kp_->in[I_WD] + ((size_t)(LW) * NE + e) * FF * D, D, WD_T + (size_t)e * D * FF, FF, [](int n) { return n; }, k0, n0, lane_); } } while (0)
constexpr int MOE_TILES = NE * 3 * 512;
constexpr int CVT_PER_WAVE = 4;
__global__ void __launch_bounds__(NTHREADS, 2) mk_forward(Prm p) {
    extern __shared__ __attribute__((aligned(16))) unsigned char lds_raw[];
    LAS unsigned char* const ldsb = (LAS unsigned char*)lds_raw;
    volatile LAS unsigned* st = (volatile LAS unsigned*)(ldsb + LDS_BYTES - 64);
    const int wave_s = __builtin_amdgcn_readfirstlane((int)threadIdx.x >> 6);
#define MK_TID() mk_tid_impl(wave_s)
    if (MK_TID() < 16) st[MK_TID()] = 0u;
    __syncthreads();
    (void)xcd_barrier_post((unsigned*)(p.ws + WS_CTL), st, MK_TID());
    const int G = gridDim.x, bid = blockIdx.x;
    const int vcu = (G % 8 == 0) ? (bid % 8) * (G / 8) + bid / 8 : bid;

    {
        PHASE_BEGIN();
        const float* c = kp_->in[I_C]; const float* cc = kp_->in[I_CCTX]; const float* adaw = kp_->in[I_ADAW]; const float* adab = kp_->in[I_ADAB];
        float* sc_l = (float*)lds_raw;
        for (int i = tid; i < (NB + 1) * D; i += NTHREADS) { const int r = i / D, k = i % D; sc_l[i] = siluf(r < NB ? c[(size_t)r * D + k] : cc[k]); }
        __syncthreads();
        {
            float* red = sc_l + (NB + 1) * D;
            const int lane = tid & 63, wv = tid >> 6;
            for (int it = bid; it < DEPTH * (NMOD * D / 64); it += G) {
                const int l = it / (NMOD * D / 64), j = (it % (NMOD * D / 64)) * 64 + lane;
                const float* w = adaw + ((size_t)l * D + wv * 128) * NMOD * D + j;
                float a0 = 0.f, a1 = 0.f, a2 = 0.f, a3 = 0.f, a4 = 0.f;
#pragma unroll 8
                for (int k = 0; k < 128; ++k) { const float wk = w[(size_t)k * NMOD * D]; const int kk = wv * 128 + k;
                    a0 += sc_l[kk] * wk; a1 += sc_l[D + kk] * wk; a2 += sc_l[2 * D + kk] * wk; a3 += sc_l[3 * D + kk] * wk; a4 += sc_l[4 * D + kk] * wk; }
                __syncthreads();
                red[(wv * 5 + 0) * 64 + lane] = a0; red[(wv * 5 + 1) * 64 + lane] = a1; red[(wv * 5 + 2) * 64 + lane] = a2; red[(wv * 5 + 3) * 64 + lane] = a3; red[(wv * 5 + 4) * 64 + lane] = a4;
                __syncthreads();
                if (tid < 5 * 64) { const int r = tid >> 6; float acc = adab[l * NMOD * D + j - lane + (tid & 63)];
#pragma unroll
                    for (int q = 0; q < 8; ++q) acc += red[(q * 5 + r) * 64 + (tid & 63)];
                    MOD[((size_t)l * (NB + 1) + r) * NMOD * D + (j - lane) + (tid & 63)] = acc; }
            }
        }
        ITEMS(i, S * 16) {
            const int t = i >> 4, w = i & 15, ii = w & 7; const float pos = (float)(w < 8 ? t / GRID_W : t % GRID_W);
            const float ang = pos * powf(10000.0f, -(float)ii / 8.0f);
            ROPE[(size_t)t * 32 + (w < 8 ? 0 : 16) + ii] = cosf(ang); ROPE[(size_t)t * 32 + (w < 8 ? 8 : 24) + ii] = sinf(ang);
        }
        GSYNC();
    }

#pragma unroll 1
    for (int l = 0; l < DEPTH; ++l) {
        const bool ctx_out = l < DEPTH - 1;
        const float lambda_init = 0.8f - 0.6f * expf(-0.3f * (float)l);
        const int nrows_out = ctx_out ? NTOK : NLAT;
        const int ER = ctx_out ? ER_MAX : NB * CAP_L;
        int moe_done = 0;

        {
            PHASE_BEGIN();
            {
                const int lane = tid & 63; auto idm = [](int n) { return n; };
                constexpr int T_WIN = (D / 32) * ((IN_COLS + 63) / 64), T_WQ = (192 / 32) * (384 / 64), T_WKV = (128 / 32) * (512 / 64), T_WOUT = (MIXW / 32) * (D / 64);
                WITEMS(id, T_WIN + T_WQ + T_WKV + T_WOUT) {
                    if (id < T_WIN) { const int nt = (IN_COLS + 63) / 64; cvt_tile(kp_->in[I_WIN] + (size_t)l * D * IN_COLS, IN_COLS, WIN_T, D, idm, (id / nt) * 32, (id % nt) * 64, lane); }
                    else if (id < T_WIN + T_WQ) { const int u = id - T_WIN; cvt_tile(kp_->in[I_WQUP] + (size_t)l * 192 * 384, 384, WQ_T, 256, idm, (u / 6) * 32, (u % 6) * 64, lane); }
                    else if (id < T_WIN + T_WQ + T_WKV) { const int u = id - T_WIN - T_WQ; cvt_tile(kp_->in[I_WKVUP] + (size_t)l * 128 * 512, 512, WKV_T, 128, idm, (u / 8) * 32, (u % 8) * 64, lane); }
                    else { const int u = id - T_WIN - T_WQ - T_WKV; cvt_tile(kp_->in[I_WOUT] + (size_t)l * MIXW * D, D, WOUT_T, MIXW, idm, (u / 16) * 32, (u % 16) * 64, lane); }
                }
            }
            ITEMS(i, (IN_PAD - IN_COLS) * D / 8) ((uint4*)(WIN_T + (size_t)IN_COLS * D))[i] = make_uint4(0, 0, 0, 0);
            ITEMS(i, 128 * 256 / 8) ((uint4*)(WQ_T + (size_t)384 * 256))[i] = make_uint4(0, 0, 0, 0);
            ITEMS(i, 384 * 8) { const int r = i >> 3, c8 = i & 7; *(uint4*)(WQ_T + (size_t)r * 256 + 192 + c8 * 8) = make_uint4(0, 0, 0, 0); }

            const float* w = kp_->in[I_NMPRE] + l * D;
            const int lane = tid & 63;
            {
                float4 xq[4];
                { const float zf_ = (float)(tid >> 20);
#pragma unroll
                  for (int i = 0; i < 4; ++i) xq[i] = make_float4(zf_, zf_, zf_, zf_); }
                float4* aux = (float4*)lds_raw;
                __syncthreads();
                for (int i = tid; i < 11 * (D / 4); i += NTHREADS) { const int v = i / (D / 4), k4 = i % (D / 4);
                    const float* src = v == 0 ? w : modl + (size_t)((v - 1) % 5) * NMOD * D + ((v - 1) / 5) * D;
                    aux[i] = ((const float4*)src)[k4]; }
                __syncthreads();
                const int wstride = gridDim.x * 8; int r = blockIdx.x * 8 + (tid >> 6);
#define P1_LOAD(rr) do { const float4* src_ = (const float4*)((rr) < NLAT ? XSRC + (size_t)(rr) * D : CSRC + (size_t)((rr) - NLAT) * D); _Pragma("unroll") for (int i = 0; i < 4; ++i) xq[i] = src_[i * 64 + lane]; } while (0)
                if (r < NTOK) P1_LOAD(r);
                for (; r < NTOK; r += wstride) {
                    const int bsel = r < NLAT ? r / S : NB;
                    float4 v[4]; float ss = 0.f;
#pragma unroll
                    for (int i = 0; i < 4; ++i) { v[i] = xq[i]; ss += f4dot(v[i], v[i]); }
                    if (r + wstride < NTOK) P1_LOAD(r + wstride);
                    ss = wave_sum(ss);
                    const float rs = 1.0f / sqrtf(ss / D + EPS);
#pragma unroll
                    for (int i = 0; i < 4; ++i) { const int k4 = i * 64 + lane; const float4 w4 = aux[k4], sc = aux[(6 + bsel) * (D / 4) + k4], sh = aux[(1 + bsel) * (D / 4) + k4];
                        const float4 o = make_float4(v[i].x * rs * w4.x * (1.0f + sc.x) + sh.x, v[i].y * rs * w4.y * (1.0f + sc.y) + sh.y, v[i].z * rs * w4.z * (1.0f + sc.z) + sh.z, v[i].w * rs * w4.w * (1.0f + sc.w) + sh.w);
                        *(uint2*)(HB + (size_t)r * D + k4 * 4) = pk4(o); }
                }
#undef P1_LOAD
            }
            GSYNC();
        }
        {
            PHASE_BEGIN();
            pg8::Gemm g{HB, WIN_T, NTOK, IN_PAD, D, 0, 0}; pg8::StaticOrder so; so.init(NTOK, IN_PAD, G, bid);
            pg8::EpiBf16 E{PB, IN_COLS, IN_COLS};
            pg8::gemm_phase<pg8::EpiBf16, pg8::StaticOrder, true, true>(ldsb, g, so, E, tid);
            { const int nwg = (NTOK / 256) * (IN_PAD / 256), busy = nwg % G;
              if (busy != 0 && bid >= busy) CVT_MOE_RANGE(l, 0, (G - busy) * 8 * CVT_PER_WAVE, (bid - busy) * 8 + (tid >> 6), (G - busy) * 8);
              moe_done = busy != 0 ? (G - busy) * 8 * CVT_PER_WAVE : 0; }
            GSYNC();
        }
        {
            PHASE_BEGIN();
            const float* cw = kp_->in[I_CONVW] + (size_t)l * 3 * 768; const float* cb = kp_->in[I_CONVB] + (size_t)l * 768;
            {
                float* cwl = (float*)lds_raw;
                __syncthreads();
                for (int i = tid; i < 4 * 768; i += NTHREADS) cwl[i] = i < 3 * 768 ? cw[i] : cb[i - 3 * 768];
                __syncthreads();
                const int stride = gridDim.x * NTHREADS;
                for (int i0 = blockIdx.x * NTHREADS + tid; i0 < NTOK * 192; i0 += 4 * stride) {
                    uint2 u0[4], um[4], up[4];
#pragma unroll
                    for (int q = 0; q < 4; ++q) { const int i = i0 + q * stride; const unsigned z_ = (unsigned)tid >> 20; u0[q] = make_uint2(z_, z_); um[q] = u0[q]; up[q] = u0[q];
                        if (i < NTOK * 192) { const int c = (i % 192) * 4, r = i / 192; const bool lat = r < NLAT; const int L = lat ? S : CTX; const int t = lat ? r % S : (r - NLAT) % CTX;
                            const bf16_t* u = PB + (size_t)r * IN_COLS + C_XBC + c; u0[q] = *(const uint2*)u; if (t > 0) um[q] = *(const uint2*)(u - IN_COLS); if (t < L - 1) up[q] = *(const uint2*)(u + IN_COLS); } }
#pragma unroll
                    for (int q = 0; q < 4; ++q) { const int i = i0 + q * stride;
                        if (i < NTOK * 192) { const int c = (i % 192) * 4, r = i / 192;
                            float4 acc = f4add(*(const float4*)(cwl + 3 * 768 + c), f4mul(*(const float4*)(cwl + 768 + c), up4(u0[q])));
                            acc = f4add(acc, f4mul(*(const float4*)(cwl + c), up4(um[q]))); acc = f4add(acc, f4mul(*(const float4*)(cwl + 2 * 768 + c), up4(up[q])));
                            *(uint2*)(XBC + (size_t)r * 768 + c) = pk4(make_float4(siluf(acc.x), siluf(acc.y), siluf(acc.z), siluf(acc.w))); } }
                }
            }
            const float* dtb = kp_->in[I_DTB] + l * 16;
            ITEMS(i, NTOK * 16) { const int j = i % 16, r = i / 16; DT[i] = softplusf(bf2f(PB[(size_t)r * IN_COLS + C_DT + j]) + dtb[j]); }
            ITEMS(i, NTOK * 16) {
                const int g = i & 15, r = i >> 4; const int hm = g & 7, isk = g >> 3;
                const bool lat = r < NLAT; const int b = lat ? r / S : (r - NLAT) / CTX, t = lat ? r % S : (r - NLAT) % CTX;
                if (!isk && !lat && !ctx_out) continue;
                const bf16_t* vp = PB + (size_t)r * IN_COLS + (isk ? C_DK : C_DQ) + hm * 32;
                float v[32];
#pragma unroll
                for (int k = 0; k < 32; k += 4) { const float4 x = ld4h(vp + k); v[k] = x.x; v[k + 1] = x.y; v[k + 2] = x.z; v[k + 3] = x.w; }
                if (lat) rope32(v, t, ROPE);
                const float sc = isk ? 1.0f : 0.17677669529663687f * 1.4426950408889634f;
                bf16_t* dst = isk ? KD + ((size_t)(b * 8 + hm) * SK + (lat ? CTX + t : t)) * 32 : (lat ? QD + ((size_t)(b * 8 + hm) * S + t) * 32 : QDC + ((size_t)(b * 8 + hm) * CTX + t) * 32);
#pragma unroll
                for (int k = 0; k < 32; k += 8) *(uint4*)(dst + k) = make_uint4(pk2(v[k] * sc, v[k + 1] * sc), pk2(v[k + 2] * sc, v[k + 3] * sc), pk2(v[k + 4] * sc, v[k + 5] * sc), pk2(v[k + 6] * sc, v[k + 7] * sc));
            }
            ITEMS(i, NB * 4 * (SK / 8) * 64) {
                const int d = i & 63, j8 = (i >> 6) % (SK / 8), hh = (i / (64 * (SK / 8))) & 3, b = i / (256 * (SK / 8));
                const int r0 = j8 * 8 < CTX ? tok_row(false, b, j8 * 8) : tok_row(true, b, j8 * 8 - CTX);
                const bf16_t* sp = PB + (size_t)r0 * IN_COLS + C_DV + hh * 64 + d;
                unsigned v[8];
#pragma unroll
                for (int jj = 0; jj < 8; ++jj) v[jj] = sp[(size_t)jj * IN_COLS];
                *(uint4*)(VDT + ((size_t)(b * 4 + hh) * 64 + d) * SK + j8 * 8) = make_uint4(v[0] | (v[1] << 16), v[2] | (v[3] << 16), v[4] | (v[5] << 16), v[6] | (v[7] << 16));
            }
            const float* qn = kp_->in[I_QNORM] + l * 192; const float* kvn = kp_->in[I_KVNORM] + l * 128;
            { const int lane = tid & 63;
            uint2 xq = make_uint2((unsigned)tid >> 20, (unsigned)tid >> 20);
            const int wstride = gridDim.x * 8; int i = blockIdx.x * 8 + (tid >> 6);
#define NRM_LOAD(ii) do { const int wh_ = (ii) & 1, r_ = (ii) >> 1; if (lane < (wh_ ? 32 : 48)) xq = *(const uint2*)(PB + (size_t)r_ * IN_COLS + (wh_ ? C_CKV : C_CQ) + lane * 4); } while (0)
            if (i < NTOK * 2) NRM_LOAD(i);
            for (; i < NTOK * 2; i += wstride) {
                const int which = i & 1, r = i >> 1; const int n4 = which ? 32 : 48;
                const float4* w = (const float4*)(which ? kvn : qn);
                float4 x = make_float4(0.f, 0.f, 0.f, 0.f); if (lane < n4) x = up4(xq);
                if (i + wstride < NTOK * 2) NRM_LOAD(i + wstride);
                const float ss = wave_sum(f4dot(x, x));
                const float rs = 1.0f / sqrtf(ss / (n4 * 4) + EPS);
                bf16_t* dst = which ? CKVB + (size_t)r * 128 : CQB + (size_t)r * 256;
                if (lane < n4) *(uint2*)(dst + lane * 4) = pk4(f4scale(f4mul(x, w[lane]), rs));
                else if (!which) { const unsigned z_ = (unsigned)tid >> 20; *(uint2*)(dst + lane * 4) = make_uint2(z_, z_); }
            }
#undef NRM_LOAD
            }
            GSYNC();
        }
        {
            PHASE_BEGIN();
            const int half = (G * 5) / 8;
            if (bid < half) {
                pg8::Gemm g{CQB, WQ_T, NTOK, 512, 256, 0, 0}; pg8::StaticOrder so; so.init(NTOK, 512, half, bid);
                pg8::EpiBf16 E{MQ, 384, 384};
                pg8::gemm_phase<pg8::EpiBf16, pg8::StaticOrder, true, true>(ldsb, g, so, E, tid);
            } else {
                pg8::Gemm g{CKVB, WKV_T, NTOK, 512, 128, 0, 0}; pg8::StaticOrder so; so.init(NTOK, 512, G - half, bid - half);
                pg8::EpiBf16 E{MKV, 512, 512};
                pg8::gemm_phase<pg8::EpiBf16, pg8::StaticOrder, true, true>(ldsb, g, so, E, tid);
            }
            for (int it = vcu; it < NB * NCH * 8; it += G) {
                const int hp = it & 3, dir = (it >> 2) & 1, cp = (it >> 3) % NCH, b = it / (8 * NCH);
                const int k = dir ? (cp < 2 ? 1 - cp : 35 - cp) : cp;
                if (k == NCH - 1) continue;
                ssd_block<false>(b, dir, k, hp, XBC, DT, kp_->in[I_ALOG] + l * 16, HS, ALAST, nullptr, (float*)lds_raw, tid);
            }
            GSYNC();
        }
        {
            PHASE_BEGIN();
            ITEMS(i, NTOK * 8) {
                const int g = i & 7, r = i >> 3; const int hh = g & 3, isk = g >> 2;
                const bool lat = r < NLAT; const int b = lat ? r / S : (r - NLAT) / CTX, t = lat ? r % S : (r - NLAT) % CTX;
                if (!isk && !lat && !ctx_out) continue;
                const bf16_t* npb = isk ? MKV + (size_t)r * 512 + hh * 128 : MQ + (size_t)r * 384 + hh * 96;
                const bf16_t* rp = isk ? PB + (size_t)r * IN_COLS + C_KR : npb + 64;
                float v[32], np[64];
#pragma unroll
                for (int k = 0; k < 32; k += 4) { const float4 x = ld4h(rp + k); v[k] = x.x; v[k + 1] = x.y; v[k + 2] = x.z; v[k + 3] = x.w; }
#pragma unroll
                for (int k = 0; k < 64; k += 4) { const float4 x = ld4h(npb + k); np[k] = x.x; np[k + 1] = x.y; np[k + 2] = x.z; np[k + 3] = x.w; }
                if (lat) rope32(v, t, ROPE);
                const float sc = isk ? 1.0f : 0.10206207261596575f * 1.4426950408889634f;
                bf16_t* dst = isk ? KM + ((size_t)(b * 4 + hh) * SK + (lat ? CTX + t : t)) * 96 : (lat ? QM + ((size_t)(b * 4 + hh) * S + t) * 96 : QMC + ((size_t)(b * 4 + hh) * CTX + t) * 96);
#pragma unroll
                for (int k = 0; k < 64; k += 8) *(uint4*)(dst + k) = make_uint4(pk2(np[k] * sc, np[k + 1] * sc), pk2(np[k + 2] * sc, np[k + 3] * sc), pk2(np[k + 4] * sc, np[k + 5] * sc), pk2(np[k + 6] * sc, np[k + 7] * sc));
#pragma unroll
                for (int k = 0; k < 32; k += 8) *(uint4*)(dst + 64 + k) = make_uint4(pk2(v[k] * sc, v[k + 1] * sc), pk2(v[k + 2] * sc, v[k + 3] * sc), pk2(v[k + 4] * sc, v[k + 5] * sc), pk2(v[k + 6] * sc, v[k + 7] * sc));
            }
            ITEMS(i, NB * 4 * (SK / 8) * 64) {
                const int d = i & 63, j8 = (i >> 6) % (SK / 8), hh = (i / (64 * (SK / 8))) & 3, b = i / (256 * (SK / 8));
                const int r0 = j8 * 8 < CTX ? tok_row(false, b, j8 * 8) : tok_row(true, b, j8 * 8 - CTX);
                const bf16_t* sp = MKV + (size_t)r0 * 512 + hh * 128 + 64 + d;
                unsigned v[8];
#pragma unroll
                for (int jj = 0; jj < 8; ++jj) v[jj] = sp[(size_t)jj * 512];
                *(uint4*)(VMT + ((size_t)(b * 4 + hh) * 64 + d) * SK + j8 * 8) = make_uint4(v[0] | (v[1] << 16), v[2] | (v[3] << 16), v[4] | (v[5] << 16), v[6] | (v[7] << 16));
            }
            ITEMS(i, NB * 2 * 8 * 4096) {
                const int e = i & 4095, h = (i >> 12) & 7, bd = i >> 15;
                float* hp0 = HS + ((size_t)bd * NCH * 8 + h) * 4096 + e; const float* al0 = ALAST + (size_t)bd * NCH * 8 + h;
                float sv[NCH - 1], dk[NCH - 1];
#pragma unroll
                for (int k = 0; k < NCH - 1; ++k) { sv[k] = hp0[(size_t)k * 8 * 4096]; dk[k] = al0[k * 8]; }
                float Hc = 0.f;
#pragma unroll
                for (int k = 0; k < NCH; ++k) { hp0[(size_t)k * 8 * 4096] = Hc; if (k < NCH - 1) Hc = Hc * __expf(dk[k]) + sv[k]; }
            }
            GSYNC();
        }
        {
            PHASE_BEGIN();
            for (int kq = 0; kq * G < NB * 2 * NCH * 4; ++kq) {
                int it = vcu + kq * G;
                { const int T_ = NB * 2 * NCH * 4, full_ = (T_ / G) * G, rem_ = T_ - full_;
                  if (ctx_out && kq * G == full_) it = vcu >= G - rem_ ? full_ + vcu - (G - rem_) : T_; }
                if (it >= NB * 2 * NCH * 4) continue;
                const int hp = it & 3, dir = (it >> 2) & 1, cp = (it >> 3) % NCH, b = it / (8 * NCH);
                const int k = dir ? (cp < 2 ? 1 - cp : 35 - cp) : cp;
                if (k < 2 && !ctx_out) continue;
                ssd_block<true>(b, dir, k, hp, XBC, DT, kp_->in[I_ALOG] + l * 16, HS, ALAST, YD, (float*)lds_raw, tid);
            }
            const int lane = tid & 63, wave = tid >> 6, qr = lane & 31, hf = lane >> 5;
            {
                const float* lq1 = kp_->in[I_LQ1] + l * 32; const float* lk1 = kp_->in[I_LK1] + l * 32; const float* lq2 = kp_->in[I_LQ2] + l * 32; const float* lk2 = kp_->in[I_LK2] + l * 32;
                const float* subw = kp_->in[I_SUBLN] + l * 64;
                const int nlat = NB * 4 * (S / 256), nit = nlat + (ctx_out ? NB * 4 : 0);
                for (int it = vcu; it < nit; it += G) {
                    const bool lat = it < nlat; const int u = lat ? it : it - nlat;
                    const int qb = lat ? u % (S / 256) : 0, hh = lat ? (u / (S / 256)) % 4 : u % 4, b = lat ? u / (4 * (S / 256)) : u / 4;
                    const int t = qb * 256 + wave * 32 + qr; const int row = tok_row(lat, b, t); const int nkt = lat ? SK / 64 : CTX / 64;
                    f32x16 oacc[2]; unsigned o1p[2][8];
#pragma unroll 1
                    for (int mp = 0; mp < 2; ++mp) {
                        const int hm = hh * 2 + mp;
                        const bf16_t* qrow = lat ? QD + ((size_t)(b * 8 + hm) * S + t) * 32 : QDC + ((size_t)(b * 8 + hm) * CTX + t) * 32;
                        float l_run = 0.f;
#pragma unroll
                        for (int i = 0; i < 16; ++i) { oacc[0][i] = 0.f; oacc[1][i] = 0.f; }
                        attn_pass<32>(qrow, KD + (size_t)(b * 8 + hm) * SK * 32, VDT + (size_t)(b * 4 + hh) * 64 * SK, SK, nkt, ldsb, tid, oacc, l_run);
                        l_run = xor32_sum(l_run);
                        if (mp == 0) { const float i1 = 1.0f / l_run;
#pragma unroll
                            for (int db = 0; db < 2; ++db)
#pragma unroll
                                for (int i = 0; i < 8; ++i) o1p[db][i] = pk2(oacc[db][2 * i] * i1, oacc[db][2 * i + 1] * i1); }
                        else {
                            float d1 = 0.f, d2 = 0.f; for (int k = 0; k < 32; ++k) { d1 += lq1[k] * lk1[k]; d2 += lq2[k] * lk2[k]; }
                            const float lam = expf(d1) - expf(d2) + lambda_init;
                            const float i2 = lam / l_run; float ss = 0.f; f32x16 o1[2];
#pragma unroll
                            for (int db = 0; db < 2; ++db)
#pragma unroll
                                for (int i = 0; i < 16; ++i) { const float a1 = __uint_as_float((i & 1) ? (o1p[db][i >> 1] & 0xffff0000u) : (o1p[db][i >> 1] << 16)); const float v = a1 - oacc[db][i] * i2; o1[db][i] = v; ss += v * v; }
                            ss = xor32_sum(ss);
                            const float rs = (1.0f - lambda_init) / sqrtf(ss / 64 + EPS);
                            bf16_t* orow = MIXB + (size_t)row * MIXW + 512 + hh * 64;
#pragma unroll
                            for (int db = 0; db < 2; ++db)
#pragma unroll
                                for (int gq = 0; gq < 4; ++gq) { const int d0 = 32 * db + 8 * gq + 4 * hf; const float4 w4 = *(const float4*)(subw + d0);
                                    *(uint2*)(orow + d0) = make_uint2(pk2(o1[db][4 * gq] * rs * w4.x, o1[db][4 * gq + 1] * rs * w4.y), pk2(o1[db][4 * gq + 2] * rs * w4.z, o1[db][4 * gq + 3] * rs * w4.w)); }
                        }
                    }
                }
            }
            {
                const int nlat = NB * 4 * (S / 256), nit = nlat + (ctx_out ? NB * 4 : 0);
                for (int it = vcu; it < nit; it += G) {
                    const bool lat = it < nlat; const int u = lat ? it : it - nlat;
                    const int qb = lat ? u % (S / 256) : 0, hh = lat ? (u / (S / 256)) % 4 : u % 4, b = lat ? u / (4 * (S / 256)) : u / 4;
                    const int t = qb * 256 + wave * 32 + qr; const int row = tok_row(lat, b, t); const int nkt = lat ? SK / 64 : CTX / 64;
                    const bf16_t* qrow = lat ? QM + ((size_t)(b * 4 + hh) * S + t) * 96 : QMC + ((size_t)(b * 4 + hh) * CTX + t) * 96;
                    f32x16 oacc[2]; float l_run = 0.f;
#pragma unroll
                    for (int i = 0; i < 16; ++i) { oacc[0][i] = 0.f; oacc[1][i] = 0.f; }
                    attn_pass<96>(qrow, KM + (size_t)(b * 4 + hh) * SK * 96, VMT + (size_t)(b * 4 + hh) * 64 * SK, SK, nkt, ldsb, tid, oacc, l_run);
                    l_run = xor32_sum(l_run);
                    const float inv = 1.0f / l_run;
                    bf16_t* orow = MIXB + (size_t)row * MIXW + 768 + hh * 64;
#pragma unroll
                    for (int db = 0; db < 2; ++db)
#pragma unroll
                        for (int gq = 0; gq < 4; ++gq) { const int d0 = 32 * db + 8 * gq + 4 * hf;
                            *(uint2*)(orow + d0) = make_uint2(pk2(oacc[db][4 * gq] * inv, oacc[db][4 * gq + 1] * inv), pk2(oacc[db][4 * gq + 2] * inv, oacc[db][4 * gq + 3] * inv)); }
                }
            }
            GSYNC();
        }
        {
            PHASE_BEGIN();
            const float* nw = kp_->in[I_SSDN] + l * 512; const float* dsk = kp_->in[I_SSDD] + l * 8;
            const int lane = tid & 63;
            uint2 q0, q1, q2, q3; { const unsigned z_ = (unsigned)tid >> 20; q0 = make_uint2(z_, z_); q1 = q0; q2 = q0; q3 = q0; }
            const int wstride = gridDim.x * 8; int i = blockIdx.x * 8 + (tid >> 6);
#define GN_LOAD(ii) do { const int g_ = (ii) & 1, r_ = (ii) >> 1, c_ = g_ * 256 + lane * 4; q0 = *(const uint2*)(XBC + (size_t)r_ * 768 + c_); q1 = *(const uint2*)(YD + (size_t)r_ * 512 + c_); \
                q2 = *(const uint2*)(YD + ((size_t)NTOK + r_) * 512 + c_); q3 = *(const uint2*)(PB + (size_t)r_ * IN_COLS + C_Z + c_); } while (0)
            if (i < nrows_out * 2) GN_LOAD(i);
            for (; i < nrows_out * 2; i += wstride) {
                const int g = i & 1, r = i >> 1, c = g * 256 + lane * 4;
                const float4 x = up4(q0), y0 = up4(q1), y1 = up4(q2), z = up4(q3);
                if (i + wstride < nrows_out * 2) GN_LOAD(i + wstride);
                const float ds = dsk[c >> 6];
                float4 v = make_float4((ds * x.x + y0.x + y1.x) * siluf(z.x), (ds * x.y + y0.y + y1.y) * siluf(z.y), (ds * x.z + y0.z + y1.z) * siluf(z.z), (ds * x.w + y0.w + y1.w) * siluf(z.w));
                const float ss = wave_sum(f4dot(v, v));
                const float rs = 1.0f / sqrtf(ss / 256 + EPS);
                *(uint2*)(MIXB + (size_t)r * MIXW + c) = pk4(f4scale(f4mul(v, *(const float4*)(nw + c)), rs));
            }
#undef GN_LOAD
            GSYNC();
        }
        {
            PHASE_BEGIN();
            pg8::Gemm g{MIXB, WOUT_T, nrows_out, D, MIXW, 0, 0}; pg8::StaticOrder so; so.init(nrows_out, D, G, bid);
            pg8::EpiBf16 E{MOUT, D, D};
            pg8::gemm_phase<pg8::EpiBf16, pg8::StaticOrder, true, true>(ldsb, g, so, E, tid);
            { const int nwg = (nrows_out / 256) * (D / 256), busy = nwg % G; const int id0 = moe_done;
              if (busy != 0 && bid >= busy) CVT_MOE_RANGE(l, id0, id0 + (G - busy) * 8 * CVT_PER_WAVE, (bid - busy) * 8 + (tid >> 6), (G - busy) * 8);
              if (busy != 0) moe_done = id0 + (G - busy) * 8 * CVT_PER_WAVE; }
            GSYNC();
        }
        {
            PHASE_BEGIN();
            const float* wpost = kp_->in[I_NMPOST] + l * D; const float* wpre = kp_->in[I_NFPRE] + l * D;
            const float* rw = kp_->in[I_RW] + (size_t)l * D * NE; const float* rb = kp_->in[I_RB] + l * NE;
            const int lane = tid & 63;
            float* rwl = (float*)lds_raw;
            for (int i = tid; i < D * NE / 4; i += NTHREADS) { const int k = i >> 2, e4 = i & 3; ((float4*)rwl)[(((k & 3) * 256 + (k >> 2)) << 2) + e4] = ((const float4*)rw)[i]; }
            float4* aux = (float4*)(rwl + D * NE);
            for (int i = tid; i < 17 * (D / 4); i += NTHREADS) { const int v = i / (D / 4), k4 = i % (D / 4);
                const float* src = v == 0 ? wpost : v == 1 ? wpre : modl + (size_t)((v - 2) % 5) * NMOD * D + (2 + (v - 2) / 5) * D;
                aux[i] = ((const float4*)src)[k4]; }
            __syncthreads();
            uint2 mq[4]; float4 xq[4];
            { const float zf_ = (float)(tid >> 20);
#pragma unroll
              for (int i = 0; i < 4; ++i) { xq[i] = make_float4(zf_, zf_, zf_, zf_); mq[i] = make_uint2((unsigned)tid >> 20, (unsigned)tid >> 20); } }
            const int wstride = gridDim.x * 8; int r = blockIdx.x * 8 + (tid >> 6);
#define P7_LOAD(rr) do { const float4* xin_ = (const float4*)((rr) < NLAT ? XSRC + (size_t)(rr) * D : CSRC + (size_t)((rr) - NLAT) * D); const bf16_t* m_ = MOUT + (size_t)(rr) * D; \
                _Pragma("unroll") for (int i = 0; i < 4; ++i) { mq[i] = *(const uint2*)(m_ + (i * 64 + lane) * 4); xq[i] = xin_[i * 64 + lane]; } } while (0)
            if (r < nrows_out) P7_LOAD(r);
            for (; r < nrows_out; r += wstride) {
                float4* xr = (float4*)(r < NLAT ? xcur + (size_t)r * D : CTXC + (size_t)(r - NLAT) * D);
                const int bsel = r < NLAT ? r / S : NB;
                float4 mv[4], xv[4]; float ss = 0.f;
#pragma unroll
                for (int i = 0; i < 4; ++i) { mv[i] = up4(mq[i]); xv[i] = xq[i]; ss += f4dot(mv[i], mv[i]); }
                if (r + wstride < nrows_out) P7_LOAD(r + wstride);
                ss = wave_sum(ss);
                const float rs = 1.0f / sqrtf(ss / D + EPS);
                float s2 = 0.f;
#pragma unroll
                for (int i = 0; i < 4; ++i) { const int k4 = i * 64 + lane;
                    xv[i] = f4add(xv[i], f4mul(aux[(2 + bsel) * (D / 4) + k4], f4scale(f4mul(mv[i], aux[k4]), rs))); xr[k4] = xv[i]; s2 += f4dot(xv[i], xv[i]); }
                s2 = wave_sum(s2);
                const float r2 = 1.0f / sqrtf(s2 / D + EPS);
                float lg[NE];
#pragma unroll
                for (int e = 0; e < NE; ++e) lg[e] = 0.f;
#pragma unroll
                for (int i = 0; i < 4; ++i) { const int k4 = i * 64 + lane; const float4 w4 = aux[(D / 4) + k4], sc = aux[(12 + bsel) * (D / 4) + k4], sh = aux[(7 + bsel) * (D / 4) + k4];
                    const float hv[4] = {xv[i].x * r2 * w4.x * (1.0f + sc.x) + sh.x, xv[i].y * r2 * w4.y * (1.0f + sc.y) + sh.y, xv[i].z * r2 * w4.z * (1.0f + sc.z) + sh.z, xv[i].w * r2 * w4.w * (1.0f + sc.w) + sh.w};
                    *(uint2*)(HB + (size_t)r * D + k4 * 4) = make_uint2(pk2(hv[0], hv[1]), pk2(hv[2], hv[3]));
#pragma unroll
                    for (int c = 0; c < 4; ++c) { const float4* rwp = (const float4*)(rwl + (size_t)(c * 256 + k4) * NE);
#pragma unroll
                        for (int e4 = 0; e4 < 4; ++e4) { const float4 w = rwp[e4]; lg[4 * e4] += hv[c] * w.x; lg[4 * e4 + 1] += hv[c] * w.y; lg[4 * e4 + 2] += hv[c] * w.z; lg[4 * e4 + 3] += hv[c] * w.w; }
                        SCHED_FENCE(); }
                }
#pragma unroll
                for (int e = 0; e < NE; ++e) lg[e] = wave_sum(lg[e]) + rb[e];
                float mx = lg[0];
#pragma unroll
                for (int e = 1; e < NE; ++e) mx = fmaxf(mx, lg[e]);
                float sum = 0.f;
#pragma unroll
                for (int e = 0; e < NE; ++e) { lg[e] = expf(lg[e] - mx); sum += lg[e]; }
                const float is = 1.0f / sum;
                float mine = lg[0];
#pragma unroll
                for (int e = 1; e < NE; ++e) mine = lane == e ? lg[e] : mine;
                if (lane < NE) AFF[(size_t)r * NE + lane] = mine * is;
            }
#undef P7_LOAD
            GSYNC();
        }
        {
            PHASE_BEGIN();
            CVT_MOE_RANGE(l, moe_done, MOE_TILES, bid * 8 + (tid >> 6), G * 8);
            {
                volatile int* sh = (volatile int*)lds_raw;
                const int nsel = (ctx_out ? 2 : 1) * NB * NE;
                for (int it = bid; it < nsel; it += G) {
                    const bool lat = it < NB * NE; const int u = lat ? it : it - NB * NE; const int e = u % NE, b = u / NE;
                    const int L = lat ? S : CTX, cap = lat ? CAP_L : CAP_C, npt = lat ? S / NTHREADS : 1, base = tok_row(lat, b, 0);
                    const bool act = lat || tid < CTX;
                    unsigned key[S / NTHREADS];
#pragma unroll
                    for (int i = 0; i < S / NTHREADS; ++i) key[i] = (act && i < npt) ? __float_as_uint(AFF[(size_t)(base + tid * npt + i) * NE + e]) : 0u;
                    __syncthreads();
                    unsigned T = 0u;
                    for (int bit = 30; bit >= 0; --bit) {
                        const unsigned cand = T | (1u << bit); int c = 0;
#pragma unroll
                        for (int i = 0; i < S / NTHREADS; ++i) c += (key[i] >= cand) ? 1 : 0;
                        if (block_sum(c, tid, sh, bit & 1) >= cap) T = cand;
                    }
                    int cg = 0, ct = 0;
#pragma unroll
                    for (int i = 0; i < S / NTHREADS; ++i) { cg += (key[i] > T) ? 1 : 0; ct += (key[i] == T && key[i] != 0u) ? 1 : 0; }
                    int tot_g, tot_t;
                    (void)block_excl_scan(cg, tid, sh, tot_g);
                    int tie_rank = block_excl_scan(ct, tid, sh, tot_t);
                    const int need = cap - tot_g;
                    int sel[S / NTHREADS], cs = 0;
#pragma unroll
                    for (int i = 0; i < S / NTHREADS; ++i) { const bool tie = key[i] == T && key[i] != 0u; sel[i] = (key[i] > T || (tie && tie_rank < need)) ? 1 : 0; tie_rank += tie ? 1 : 0; cs += sel[i]; }
                    int tot_s; int slot = block_excl_scan(cs, tid, sh, tot_s);
#pragma unroll
                    for (int i = 0; i < S / NTHREADS; ++i) if (act && i < npt) {
                        const int row = base + tid * npt + i; int sa = -1;
                        if (sel[i]) { sa = (lat ? b * CAP_L : NB * CAP_L + b * CAP_C) + slot; ++slot; SELIDX[e * ER_MAX + sa] = row; SELGATE[e * ER_MAX + sa] = __uint_as_float(key[i]); }
                        TOKSLOT[(size_t)row * NE + e] = sa;
                    }
                }
            }
            GSYNC();
        }
        {
            PHASE_BEGIN();
            const int used = ctx_out ? NB * (CAP_L + CAP_C) : NB * CAP_L;
            ITEMS(i, NE * ER * (D / 8)) {
                const int c8 = i % (D / 8), slot = (i / (D / 8)) % ER, e = i / ((D / 8) * ER);
                uint4 v = make_uint4(0, 0, 0, 0);
                if (slot < used) v = *(const uint4*)(HB + (size_t)SELIDX[e * ER_MAX + slot] * D + c8 * 8);
                *(uint4*)(XG + ((size_t)e * ER + slot) * D + c8 * 8) = v;
            }
            GSYNC();
        }
        {
            PHASE_BEGIN();
            pg8::Gemm g{XG, WGU_T, NE * ER, 2 * FF, D, ER / 256, (size_t)2 * FF * D * 2}; pg8::StaticOrder so; so.init(NE * ER, 2 * FF, G, bid);
            pg8::EpiSwiGLU E{HID, FF};
            pg8::gemm_phase<pg8::EpiSwiGLU, pg8::StaticOrder, true, true>(ldsb, g, so, E, tid);
            GSYNC();
        }
        {
            PHASE_BEGIN();
            pg8::Gemm g{HID, WD_T, NE * ER, D, FF, ER / 256, (size_t)D * FF * 2}; pg8::StaticOrder so; so.init(NE * ER, D, G, bid);
            pg8::EpiRowScaleBf16 E{Y, D, SELGATE, ER};
            pg8::gemm_phase<pg8::EpiRowScaleBf16, pg8::StaticOrder, true, true>(ldsb, g, so, E, tid);
            GSYNC();
        }
        {
            PHASE_BEGIN();
            const float* wpost = kp_->in[I_NFPOST] + l * D;
            const int lane = tid & 63;
            {
                float4 xq[4]; int slq = -1;
                { const float zf_ = (float)(tid >> 20);
#pragma unroll
                  for (int i = 0; i < 4; ++i) xq[i] = make_float4(zf_, zf_, zf_, zf_); }
                float4* aux = (float4*)lds_raw;
                __syncthreads();
                for (int i = tid; i < 6 * (D / 4); i += NTHREADS) { const int v = i / (D / 4), k4 = i % (D / 4);
                    const float* src = v == 0 ? wpost : modl + (size_t)(v - 1) * NMOD * D + 5 * D;
                    aux[i] = ((const float4*)src)[k4]; }
                __syncthreads();
                const int wstride = gridDim.x * 8; int r = blockIdx.x * 8 + (tid >> 6);
#define P11_LOAD(rr) do { const float4* xin_ = (const float4*)((rr) < NLAT ? xcur + (size_t)(rr) * D : CTXC + (size_t)((rr) - NLAT) * D); slq = lane < NE ? TOKSLOT[(size_t)(rr) * NE + lane] : -1; \
                    _Pragma("unroll") for (int i = 0; i < 4; ++i) xq[i] = xin_[i * 64 + lane]; } while (0)
                if (r < nrows_out) P11_LOAD(r);
                for (; r < nrows_out; r += wstride) {
                    float4* xr = (float4*)(r < NLAT ? xcur + (size_t)r * D : CTXC + (size_t)(r - NLAT) * D);
                    const int bsel = r < NLAT ? r / S : NB;
                    const int myslot = slq; float4 xv[4], f[4];
#pragma unroll
                    for (int i = 0; i < 4; ++i) { xv[i] = xq[i]; f[i] = make_float4(0.f, 0.f, 0.f, 0.f); }
#pragma unroll
                    for (int e = 0; e < NE; ++e) {
                        const int sl = __builtin_amdgcn_readlane(myslot, e);
                        if (sl >= 0) { const bf16_t* yp = Y + ((size_t)e * ER + sl) * D;
#pragma unroll
                            for (int i = 0; i < 4; ++i) f[i] = f4add(f[i], ld4h(yp + (i * 64 + lane) * 4)); }
                    }
                    if (r + wstride < nrows_out) P11_LOAD(r + wstride);
                    float ss = 0.f;
#pragma unroll
                    for (int i = 0; i < 4; ++i) ss += f4dot(f[i], f[i]);
                    ss = wave_sum(ss);
                    const float rs = 1.0f / sqrtf(ss / D + EPS);
#pragma unroll
                    for (int i = 0; i < 4; ++i) { const int k4 = i * 64 + lane; xr[k4] = f4add(xv[i], f4mul(aux[(1 + bsel) * (D / 4) + k4], f4scale(f4mul(f[i], aux[k4]), rs))); }
                }
#undef P11_LOAD
            }
            GSYNC();
        }
    }
}

extern "C" void kernel_launch(void* const* d_in, const int* in_sizes, int n_in, void* d_out, int out_size, void* d_ws, size_t ws_size, hipStream_t stream) {
    static int grid = 0;
    if (grid == 0) {
        if (n_in != N_IN || out_size != NLAT * D || ws_size < WS_END) { fprintf(stderr, "kernel_launch: unexpected shapes: n_in %d out %d ws %zu (need %zu)\n", n_in, out_size, ws_size, (size_t)WS_END); grid = -1; return; }
        int dev = 0, cus = 0, per_cu = 0;
        (void)hipGetDevice(&dev);
        (void)hipDeviceGetAttribute(&cus, hipDeviceAttributeMultiprocessorCount, dev);
        (void)hipFuncSetAttribute((const void*)mk_forward, hipFuncAttributeMaxDynamicSharedMemorySize, LDS_BYTES);
        (void)hipOccupancyMaxActiveBlocksPerMultiprocessor(&per_cu, (const void*)mk_forward, NTHREADS, LDS_BYTES);
        (void)hipGetLastError();
        if (per_cu < 1) { fprintf(stderr, "kernel_launch: occupancy query says %d blocks/CU\n", per_cu); grid = -1; return; }
        grid = cus;
    }
    if (grid < 0) return;
    (void)hipMemsetAsync((char*)d_ws + WS_CTL, 0, CTL_BYTES, stream);
    Prm p{};
    for (int i = 0; i < N_IN; ++i) p.in[i] = (const float*)d_in[i];
    p.out = (float*)d_out; p.ws = (char*)d_ws;
    void* args[] = {&p};
    hipError_t e = hipLaunchCooperativeKernel((const void*)mk_forward, dim3(grid), dim3(NTHREADS), args, LDS_BYTES, stream);
    if (e != hipSuccess) fprintf(stderr, "kernel_launch: cooperative launch failed: %s (grid %d)\n", hipGetErrorString(e), grid);
}
```

```cpp
#include <hip/hip_runtime.h>
#include <cstdio>
#include <cstdint>

constexpr int D = 1024, NB = 4, S = 4096, CTX = 256, FF = 1024;
constexpr int DEPTH = 2, GRID_W = 64, NMOD = 6, NE = 16;
constexpr int NLAT = NB * S, NCTX = NB * CTX, NTOK = NLAT + NCTX;
constexpr int IN_COLS = 2416, IN_PAD = 2560;
constexpr int C_Z = 0, C_XBC = 512, C_DT = 1280, C_DQ = 1296, C_DK = 1552, C_DV = 1808, C_CQ = 2064, C_CKV = 2256, C_KR = 2384;
constexpr int MIXW = 1024;
constexpr int CAP_L = 2 * S / NE, CAP_C = 2 * CTX / NE;
constexpr int ER_MAX = 2304;
constexpr float EPS = 1e-6f;
static_assert(NB * CAP_L == 2048 && NB * CAP_C == 128, "expert row layout");

enum { I_X = 0, I_C, I_CTX, I_CCTX, I_ADAW, I_ADAB, I_NMPRE, I_NMPOST, I_NFPRE, I_NFPOST, I_WIN, I_CONVW, I_CONVB, I_ALOG, I_DTB, I_SSDD, I_SSDN,
       I_LQ1, I_LK1, I_LQ2, I_LK2, I_SUBLN, I_QNORM, I_WQUP, I_KVNORM, I_WKVUP, I_WOUT, I_RW, I_RB, I_WG, I_WU, I_WD, N_IN };
struct Prm { const float* in[N_IN]; float* out; char* ws; };

typedef unsigned short bf16_t;
constexpr size_t al256(size_t x) { return (x + 255) & ~(size_t)255; }
constexpr size_t WS_CTL = 0, CTL_BYTES = 65536;
constexpr size_t WS_MOD = WS_CTL + CTL_BYTES;
constexpr size_t WS_CTXC = al256(WS_MOD + (size_t)DEPTH * (NB + 1) * NMOD * D * 4);
constexpr size_t WS_AFF = al256(WS_CTXC + (size_t)NCTX * D * 4);
constexpr size_t WS_TOKSLOT = al256(WS_AFF + (size_t)NTOK * NE * 4);
constexpr size_t WS_SELIDX = al256(WS_TOKSLOT + (size_t)NTOK * NE * 4);
constexpr size_t WS_SELGATE = al256(WS_SELIDX + (size_t)NE * ER_MAX * 4);
constexpr size_t WS_DT = al256(WS_SELGATE + (size_t)NE * ER_MAX * 4);
constexpr int NCH = 34;
constexpr size_t WS_ROPE = al256(WS_DT + (size_t)NTOK * 16 * 4);
constexpr size_t WS_ALAST = al256(WS_ROPE + (size_t)S * 32 * 4);
constexpr size_t WS_HB = al256(WS_ALAST + (size_t)NB * 2 * NCH * 8 * 4);
constexpr size_t WS_P = al256(WS_HB + (size_t)NTOK * D * 2);
constexpr size_t WS_G2 = al256(WS_P + (size_t)NTOK * IN_COLS * 4);
constexpr size_t WS_XBC = WS_G2;
constexpr size_t WS_MQ = al256(WS_XBC + (size_t)NTOK * 768 * 4);
constexpr size_t WS_MKV = al256(WS_MQ + (size_t)NTOK * 384 * 4);
constexpr size_t WS_CQB = al256(WS_MKV + (size_t)NTOK * 512 * 4);
constexpr size_t WS_CKVB = al256(WS_CQB + (size_t)NTOK * 256 * 2);
constexpr size_t WS_MIXB = al256(WS_CKVB + (size_t)NTOK * 128 * 2);
constexpr size_t WS_G2END = al256(WS_MIXB + (size_t)NTOK * MIXW * 2);
constexpr size_t WS_HS = WS_HB;
constexpr size_t WS_YD = WS_MQ;
constexpr size_t WS_MOUT = WS_P;
constexpr size_t WS_XG = WS_P;
constexpr size_t WS_HID = al256(WS_XG + (size_t)NE * ER_MAX * D * 2);
constexpr size_t WS_Y = WS_G2;
constexpr size_t WS_WIN = WS_G2END;
constexpr size_t WS_WQ = al256(WS_WIN + (size_t)IN_PAD * D * 2);
constexpr size_t WS_WKV = al256(WS_WQ + (size_t)512 * 256 * 2);
constexpr size_t WS_WOUT = al256(WS_WKV + (size_t)512 * 128 * 2);
constexpr size_t WS_WGU = al256(WS_WOUT + (size_t)D * MIXW * 2);
constexpr size_t WS_WD = al256(WS_WGU + (size_t)NE * 2 * FF * D * 2);
constexpr size_t WS_END = al256(WS_WD + (size_t)NE * D * FF * 2);
constexpr int SK = CTX + S;
constexpr size_t WS_QD = al256(WS_P + (size_t)NTOK * IN_COLS * 2);
constexpr size_t WS_QDC = al256(WS_QD + (size_t)NB * 8 * S * 32 * 2);
constexpr size_t WS_KD = al256(WS_QDC + (size_t)NB * 8 * CTX * 32 * 2);
constexpr size_t WS_VDT = al256(WS_KD + (size_t)NB * 8 * SK * 32 * 2);
constexpr size_t WS_QM = al256(WS_VDT + (size_t)NB * 4 * 64 * SK * 2);
constexpr size_t WS_QMC = al256(WS_QM + (size_t)NB * 4 * S * 96 * 2);
constexpr size_t WS_KM = al256(WS_QMC + (size_t)NB * 4 * CTX * 96 * 2);
constexpr size_t WS_VMT = al256(WS_KM + (size_t)NB * 4 * SK * 96 * 2);
constexpr size_t WS_ATTEND = al256(WS_VMT + (size_t)NB * 4 * 64 * SK * 2);
static_assert(WS_ATTEND <= WS_G2, "attention operands fit in the spare half of the P slot");
static_assert(WS_HID + (size_t)NE * ER_MAX * FF * 2 <= WS_G2, "XG+HID fit in the P region");
static_assert((size_t)NE * ER_MAX * D * 4 <= WS_G2END - WS_G2, "Y fits in the G2 region");
static_assert((size_t)NB * 2 * NCH * 8 * 4096 * 4 <= (size_t)NTOK * D * 2, "HS fits in HB");
static_assert(WS_YD + (size_t)2 * NTOK * 512 * 4 <= WS_MIXB, "YD ends below MIXB");

#define LAS __attribute__((address_space(3)))
constexpr int NTHREADS = 512;
constexpr int LDS_BYTES = 147456;
#define ITEMS(i, n) for (int i = blockIdx.x * NTHREADS + tid; i < (n); i += gridDim.x * NTHREADS)

__device__ __forceinline__ float siluf(float x) { return x / (1.0f + expf(-x)); }
__device__ __forceinline__ float softplusf(float x) { return x > 20.f ? x : log1pf(expf(x)); }
__device__ __forceinline__ unsigned f2bf(float f) { unsigned u = __builtin_bit_cast(unsigned, f); return (u + 0x7fffu + ((u >> 16) & 1u)) >> 16; }
typedef float f32x2_t __attribute__((ext_vector_type(2)));
typedef __bf16 bf16x2_t __attribute__((ext_vector_type(2)));
__device__ __forceinline__ unsigned pk2(float lo, float hi) { const f32x2_t v = {lo, hi}; return __builtin_bit_cast(unsigned, __builtin_convertvector(v, bf16x2_t)); }
__device__ __forceinline__ float bf2f(bf16_t h) { return __builtin_bit_cast(float, (unsigned)h << 16); }
#define SCHED_FENCE() __builtin_amdgcn_sched_barrier(0)
__device__ __forceinline__ int mk_tid_impl(int wave_s) { unsigned z; asm volatile("s_mov_b32 %0, 0" : "=s"(z));
    return (wave_s << 6) | (int)__builtin_amdgcn_mbcnt_hi(~0u, __builtin_amdgcn_mbcnt_lo(~0u, z)); }
__device__ __forceinline__ float dpp_row_shr(float v, int n) {
    const int iv = __builtin_bit_cast(int, v); int r;
    switch (n) { case 1: r = __builtin_amdgcn_update_dpp(0, iv, 0x111, 0xf, 0xf, true); break; case 2: r = __builtin_amdgcn_update_dpp(0, iv, 0x112, 0xf, 0xf, true); break;
                 case 4: r = __builtin_amdgcn_update_dpp(0, iv, 0x114, 0xf, 0xf, true); break; default: r = __builtin_amdgcn_update_dpp(0, iv, 0x118, 0xf, 0xf, true); break; }
    return __builtin_bit_cast(float, r);
}
__device__ __forceinline__ float wave_sum(float v) {
    v += dpp_row_shr(v, 1); v += dpp_row_shr(v, 2); v += dpp_row_shr(v, 4); v += dpp_row_shr(v, 8);
    v += __builtin_bit_cast(float, __builtin_amdgcn_update_dpp(0, __builtin_bit_cast(int, v), 0x142, 0xa, 0xf, false));
    v += __builtin_bit_cast(float, __builtin_amdgcn_update_dpp(0, __builtin_bit_cast(int, v), 0x143, 0xc, 0xf, false));
    return __builtin_bit_cast(float, __builtin_amdgcn_readlane(__builtin_bit_cast(int, v), 63)); }
__device__ __forceinline__ float xor32_max(float x) { auto t = __builtin_amdgcn_permlane32_swap(__float_as_uint(x), __float_as_uint(x), false, false); return fmaxf(__uint_as_float(t[0]), __uint_as_float(t[1])); }
__device__ __forceinline__ float xor32_sum(float x) { auto t = __builtin_amdgcn_permlane32_swap(__float_as_uint(x), __float_as_uint(x), false, false); return __uint_as_float(t[0]) + __uint_as_float(t[1]); }
#define WITEMS(i, n) for (int i = blockIdx.x * 8 + (tid >> 6); i < (n); i += gridDim.x * 8)
__device__ __forceinline__ float4 f4mul(float4 a, float4 b) { return make_float4(a.x * b.x, a.y * b.y, a.z * b.z, a.w * b.w); }
__device__ __forceinline__ float4 f4add(float4 a, float4 b) { return make_float4(a.x + b.x, a.y + b.y, a.z + b.z, a.w + b.w); }
__device__ __forceinline__ float4 f4scale(float4 a, float s) { return make_float4(a.x * s, a.y * s, a.z * s, a.w * s); }
__device__ __forceinline__ float f4dot(float4 a, float4 b) { return a.x * b.x + a.y * b.y + a.z * b.z + a.w * b.w; }
__device__ __forceinline__ uint2 pk4(float4 v) { return make_uint2(pk2(v.x, v.y), pk2(v.z, v.w)); }
__device__ __forceinline__ float4 up4(uint2 u) { return make_float4(__uint_as_float(u.x << 16), __uint_as_float(u.x & 0xffff0000u), __uint_as_float(u.y << 16), __uint_as_float(u.y & 0xffff0000u)); }
__device__ __forceinline__ float4 ld4h(const bf16_t* p) { return up4(*(const uint2*)p); }

__device__ __forceinline__ void rope32(float* v, int t, const float* tab) {
    const float4* tp = (const float4*)(tab + (size_t)t * 32);
    float cs[32];
#pragma unroll
    for (int i = 0; i < 8; ++i) { const float4 x = tp[i]; cs[4 * i] = x.x; cs[4 * i + 1] = x.y; cs[4 * i + 2] = x.z; cs[4 * i + 3] = x.w; }
#pragma unroll
    for (int i = 0; i < 8; ++i) {
        { const float c = cs[i], sn = cs[8 + i]; const float x1 = v[i], x2 = v[8 + i]; v[i] = x1 * c - x2 * sn; v[8 + i] = x1 * sn + x2 * c; }
        { const float c = cs[16 + i], sn = cs[24 + i]; const float x1 = v[16 + i], x2 = v[24 + i]; v[16 + i] = x1 * c - x2 * sn; v[24 + i] = x1 * sn + x2 * c; }
    }
}
__device__ __forceinline__ int tok_row(bool lat, int b, int t) { return lat ? b * S + t : NLAT + b * CTX + t; }

namespace pg8 {
#define PG8_LAS __attribute__((address_space(3)))
typedef short bf16x8 __attribute__((ext_vector_type(8)));
typedef float f32x4 __attribute__((ext_vector_type(4)));
typedef unsigned u32x4 __attribute__((ext_vector_type(4)));
constexpr int BM = 256, BK = 64, HALF = 128, HTB = HALF * BK * 2  , STAGE_BYTES = 8 * HTB, NXCD = 8, WGM = 16;

__host__ __device__ __forceinline__ int lds_byte(int r, int c) { const int st = (r >> 4) * 2 + (c >> 5), rr = r & 15, cc = c & 31, ob = rr * 64 + cc * 2; return st * 1024 + (ob ^ (((ob >> 9) & 1) << 5)); }
__host__ __device__ __forceinline__ void stage_rc(int b, int& R, int& C) { const int st = b / 1024, sb = b % 1024, swz = sb ^ (((sb >> 9) & 1) << 5); R = (st >> 1) * 16 + swz / 64; C = (st & 1) * 32 + (swz % 64) / 2; }
__host__ __device__ __forceinline__ int perm32(int rho) { const int n = rho >> 4, i = rho & 15; return 8 * (i >> 2) + 4 * n + (i & 3); }

struct Unit { int pm, pn; };
struct Gemm { const bf16_t* A; const bf16_t* Bt; int M, N, K; int grp_tiles; size_t grp_stride; };

struct StaticOrder {
    int nM, nN, nwg, G, c;
    __host__ __device__ void init(int M, int N, int G_, int c_) { nM = M / BM; nN = N / BM; nwg = nM * nN; G = G_; c = c_; }
    __host__ __device__ bool next(int i, Unit& u) const {
        const long L = (long)i * G + c; if (L >= nwg) return false;
        int wgid = (int)L; { const int q = nwg / NXCD, r = nwg % NXCD, xcd = wgid % NXCD, off = wgid / NXCD; wgid = (xcd < r ? xcd * (q + 1) : r * (q + 1) + (xcd - r) * q) + off; }
        const int nig = WGM * nN, gid = wgid / nig, fm = gid * WGM, gsz = (nM - fm) < WGM ? (nM - fm) : WGM;
        u.pm = fm + ((wgid % nig) % gsz); u.pn = (wgid % nig) / gsz; return true;
    }
    __device__ __forceinline__ void a_ready(const Unit&) const {}
    __device__ __forceinline__ void done(const Unit&) const {}
};

__device__ __forceinline__ unsigned cvt_pk_bf16(float lo, float hi) { unsigned r; asm volatile("v_cvt_pk_bf16_f32 %0, %1, %2" : "=v"(r) : "v"(lo), "v"(hi)); return r; }

typedef unsigned u32x2 __attribute__((ext_vector_type(2)));
struct EpiF32 {
    static constexpr bool PERM = false, AFTER_DRAIN = false;
    float* C; int ldc; int ncols;
    __device__ __forceinline__ void operator()(const f32x4 (&acc)[2][2][4][2], const Unit& u, int wr, int wc, int fr, int fq) const {
        const int row0 = u.pm * BM + wr * 64 + fr, col0 = u.pn * BM + wc * 32 + 4 * fq;
#pragma unroll
        for (int ai = 0; ai < 2; ++ai)
#pragma unroll
            for (int m = 0; m < 4; ++m) { float* rowp = C + (size_t)(row0 + ai * HALF + m * 16) * ldc;
#pragma unroll
                for (int bj = 0; bj < 2; ++bj)
#pragma unroll
                    for (int n = 0; n < 2; ++n) { const int col = col0 + bj * HALF + n * 16; if (col < ncols) *(f32x4*)(rowp + col) = acc[ai][bj][m][n]; } }
    }
};
struct EpiRowScaleF32 {
    static constexpr bool PERM = false, AFTER_DRAIN = false;
    float* C; int ldc; const float* gate; int er;
    __device__ __forceinline__ void operator()(const f32x4 (&acc)[2][2][4][2], const Unit& u, int wr, int wc, int fr, int fq) const {
        const int row0 = u.pm * BM + wr * 64 + fr, col0 = u.pn * BM + wc * 32 + 4 * fq;
#pragma unroll
        for (int ai = 0; ai < 2; ++ai)
#pragma unroll
            for (int m = 0; m < 4; ++m) { const int row = row0 + ai * HALF + m * 16; float* rowp = C + (size_t)row * ldc; const float sc = gate[(row / er) * ER_MAX + row % er];
#pragma unroll
                for (int bj = 0; bj < 2; ++bj)
#pragma unroll
                    for (int n = 0; n < 2; ++n) *(f32x4*)(rowp + col0 + bj * HALF + n * 16) = acc[ai][bj][m][n] * sc; }
    }
};
struct EpiSwiGLU {
    static constexpr bool PERM = true, AFTER_DRAIN = false;
    bf16_t* O; int ldo;
    __device__ __forceinline__ void operator()(const f32x4 (&acc)[2][2][4][2], const Unit& u, int wr, int wc, int fr, int fq) const {
        const int row0 = u.pm * BM + wr * 64 + fr, col0 = u.pn * BM + wc * 32 + 8 * fq;
#pragma unroll
        for (int ai = 0; ai < 2; ++ai)
#pragma unroll
            for (int m = 0; m < 4; ++m) { bf16_t* rowp = O + (size_t)(row0 + ai * HALF + m * 16) * ldo;
#pragma unroll
                for (int bj = 0; bj < 2; ++bj) { const f32x4 gt = acc[ai][bj][m][0], up = acc[ai][bj][m][1]; f32x4 h;
#pragma unroll
                    for (int i = 0; i < 4; ++i) h[i] = gt[i] / (1.0f + __expf(-gt[i])) * up[i];
                    u32x2 w; w.x = cvt_pk_bf16(h[0], h[1]); w.y = cvt_pk_bf16(h[2], h[3]);
                    *(u32x2*)(rowp + (col0 + bj * HALF) / 2) = w; } }
    }
};

struct EpiBf16 {
    static constexpr bool PERM = true, AFTER_DRAIN = false;
    bf16_t* O; int ldo; int ncols;
    __device__ __forceinline__ void operator()(const f32x4 (&acc)[2][2][4][2], const Unit& u, int wr, int wc, int fr, int fq) const {
        const int row0 = u.pm * BM + wr * 64 + fr, col0 = u.pn * BM + wc * 32 + 8 * fq;
#pragma unroll
        for (int ai = 0; ai < 2; ++ai)
#pragma unroll
            for (int m = 0; m < 4; ++m) { bf16_t* rowp = O + (size_t)(row0 + ai * HALF + m * 16) * ldo;
#pragma unroll
                for (int bj = 0; bj < 2; ++bj) { const int col = col0 + bj * HALF; const f32x4 v0 = acc[ai][bj][m][0], v1 = acc[ai][bj][m][1];
                    u32x4 w; w.x = cvt_pk_bf16(v0[0], v0[1]); w.y = cvt_pk_bf16(v0[2], v0[3]); w.z = cvt_pk_bf16(v1[0], v1[1]); w.w = cvt_pk_bf16(v1[2], v1[3]);
                    if (col < ncols) *(u32x4*)(rowp + col) = w; } }
    }
};
struct EpiRowScaleBf16 {
    static constexpr bool PERM = true, AFTER_DRAIN = false;
    bf16_t* O; int ldo; const float* gate; int er;
    __device__ __forceinline__ void operator()(const f32x4 (&acc)[2][2][4][2], const Unit& u, int wr, int wc, int fr, int fq) const {
        const int row0 = u.pm * BM + wr * 64 + fr, col0 = u.pn * BM + wc * 32 + 8 * fq;
#pragma unroll
        for (int ai = 0; ai < 2; ++ai)
#pragma unroll
            for (int m = 0; m < 4; ++m) { const int row = row0 + ai * HALF + m * 16; bf16_t* rowp = O + (size_t)row * ldo; const float sc = gate[(row / er) * ER_MAX + row % er];
#pragma unroll
                for (int bj = 0; bj < 2; ++bj) { const f32x4 v0 = acc[ai][bj][m][0] * sc, v1 = acc[ai][bj][m][1] * sc;
                    u32x4 w; w.x = cvt_pk_bf16(v0[0], v0[1]); w.y = cvt_pk_bf16(v0[2], v0[3]); w.z = cvt_pk_bf16(v1[0], v1[1]); w.w = cvt_pk_bf16(v1[2], v1[3]);
                    *(u32x4*)(rowp + col0 + bj * HALF) = w; } }
    }
};
template <class Epi, class Sched, bool ALIGN_EPI = false, bool SP2 = false>
__device__ __forceinline__ void gemm_phase(PG8_LAS unsigned char* lds, const Gemm g, const Sched& S, const Epi& E, int tid_in) {
    int tid_ = tid_in; asm volatile("" : "+v"(tid_));
    const int tid = tid_, wid = __builtin_amdgcn_readfirstlane(tid >> 6), lane = tid & 63, wr = wid >> 2, wc = wid & 3, fr = lane & 15, fq = lane >> 4;
    int K_ = g.K; asm volatile("" : "+s"(K_));
    const int K = K_, nt = K / BK;
    unsigned voffA[2], voffB[2];
#pragma unroll
    for (int i = 0; i < 2; ++i) { int R, C; stage_rc(tid * 16 + i * 8192, R, C); const int Rb = Epi::PERM ? ((R & ~31) + perm32(R & 31)) : R;
        voffA[i] = (unsigned)(R * K + C) * 2u; voffB[i] = (unsigned)(Rb * K + C) * 2u; }
    const size_t kstep = (size_t)(BK * 2);
    const size_t hstep = (size_t)HALF * K * 2;
    const size_t tstep = 2 * hstep;
    const unsigned ldsw = (unsigned)wid * 1024u;
    const int aoff = lds_byte(wr * 64 + fr, fq * 8), boff = lds_byte(wc * 32 + fr, fq * 8);
#define PG8_SA(b, h) (((b) * 2 + (h)) * HTB)
#define PG8_SB(b, h) ((4 + (b) * 2 + (h)) * HTB)
#define PG8_STAGE(bufoff, gbase, voff) do { _Pragma("unroll") for (int _i = 0; _i < 2; ++_i) \
        __builtin_amdgcn_global_load_lds((const unsigned*)((const char*)(gbase) + (voff)[_i]), (PG8_LAS unsigned*)(lds + (bufoff) + ldsw + _i * 8192), 16, 0, 0); } while (0)
#define PG8_LDA(dst, b, h) do { _Pragma("unroll") for (int m = 0; m < 4; ++m) _Pragma("unroll") for (int k = 0; k < 2; ++k) dst[m][k] = *(const PG8_LAS bf16x8*)(lds + PG8_SA(b, h) + aoff + m * 2048 + k * 1024); } while (0)
#define PG8_LDB(dst, b, h) do { _Pragma("unroll") for (int n = 0; n < 2; ++n) _Pragma("unroll") for (int k = 0; k < 2; ++k) dst[n][k] = *(const PG8_LAS bf16x8*)(lds + PG8_SB(b, h) + boff + n * 2048 + k * 1024); } while (0)
#define PG8_MMA(ai, bj, At, Bt) do { __builtin_amdgcn_s_setprio(1); _Pragma("unroll") for (int m = 0; m < 4; ++m) _Pragma("unroll") for (int n = 0; n < 2; ++n) _Pragma("unroll") for (int k = 0; k < 2; ++k) \
        acc[ai][bj][m][n] = __builtin_amdgcn_mfma_f32_16x16x32_bf16(Bt[n][k], At[m][k], acc[ai][bj][m][n], 0, 0, 0); __builtin_amdgcn_s_setprio(0); } while (0)
#define PG8_WAIT_V(n) asm volatile("s_waitcnt vmcnt(" #n ")" ::: "memory")
#define PG8_WAIT_L(n) asm volatile("s_waitcnt lgkmcnt(" #n ")" ::: "memory")
#define PG8_BAR __builtin_amdgcn_s_barrier()
#define PG8_SCHED __builtin_amdgcn_sched_barrier(0)
    Unit cur, nxt; int ui = 0;
    if (!S.next(0, cur)) return;
    f32x4 acc[2][2][4][2];
#pragma unroll
    for (int a = 0; a < 2; ++a)
#pragma unroll
        for (int b = 0; b < 2; ++b)
#pragma unroll
            for (int m = 0; m < 4; ++m)
#pragma unroll
                for (int n = 0; n < 2; ++n) acc[a][b][m][n] = (f32x4){0.f, 0.f, 0.f, 0.f};
    bf16x8 At[4][2], B0[2][2], B1[2][2];
    const char* cA = (const char*)g.A + (size_t)cur.pm * tstep; const char* cB = (const char*)g.Bt + (size_t)cur.pn * tstep + (g.grp_tiles ? (size_t)(cur.pm / g.grp_tiles) * g.grp_stride : (size_t)0);
    S.a_ready(cur);
    if constexpr (SP2) {
        PG8_STAGE(PG8_SB(0, 0), cB, voffB); PG8_STAGE(PG8_SB(0, 1), cB + hstep, voffB); PG8_STAGE(PG8_SA(0, 0), cA, voffA); PG8_STAGE(PG8_SA(0, 1), cA + hstep, voffA);
        if (wr == 1) PG8_BAR;
        PG8_WAIT_V(2); PG8_BAR;
        PG8_STAGE(PG8_SB(1, 0), cB + kstep, voffB); PG8_STAGE(PG8_SA(1, 0), cA + kstep, voffA); PG8_STAGE(PG8_SB(1, 1), cB + hstep + kstep, voffB);
        PG8_WAIT_V(6); PG8_BAR;
    } else {
        PG8_STAGE(PG8_SB(0, 0), cB, voffB); PG8_STAGE(PG8_SA(0, 0), cA, voffA); PG8_STAGE(PG8_SB(0, 1), cB + hstep, voffB); PG8_STAGE(PG8_SA(0, 1), cA + hstep, voffA);
        if (wr == 1) PG8_BAR;
        PG8_WAIT_V(4); PG8_BAR;
        PG8_STAGE(PG8_SB(1, 0), cB + kstep, voffB); PG8_STAGE(PG8_SA(1, 0), cA + kstep, voffA); PG8_STAGE(PG8_SB(1, 1), cB + hstep + kstep, voffB);
        PG8_WAIT_V(6); PG8_BAR;
    }
    for (;;) {
        const bool has_next = S.next(ui + 1, nxt);
        const char* nA = has_next ? (const char*)g.A + (size_t)nxt.pm * tstep : cA; const char* nB = has_next ? (const char*)g.Bt + (size_t)nxt.pn * tstep + (g.grp_tiles ? (size_t)(nxt.pm / g.grp_tiles) * g.grp_stride : (size_t)0) : cB;
        for (int t = 0; t < nt; t += 2) {
            const bool last = (t == nt - 2);
            const char* a1 = cA + (size_t)(t + 1) * kstep;
            const char* a2 = last ? nA : cA + (size_t)(t + 2) * kstep; const char* b2 = last ? nB : cB + (size_t)(t + 2) * kstep;
            const char* a3 = a2 + kstep; const char* b3 = b2 + kstep;
            if (last && has_next) S.a_ready(nxt);
            if constexpr (SP2) {
            PG8_LDB(B0, 0, 0); PG8_LDB(B1, 0, 1); PG8_SCHED; PG8_LDA(At, 0, 0); PG8_STAGE(PG8_SA(1, 1), a1 + hstep, voffA);
            PG8_WAIT_V(8); PG8_WAIT_L(0); PG8_BAR; PG8_MMA(0, 0, At, B0); PG8_MMA(0, 1, At, B1); PG8_BAR; PG8_SCHED;
            PG8_LDA(At, 0, 1); PG8_STAGE(PG8_SB(0, 0), b2, voffB); PG8_STAGE(PG8_SB(0, 1), b2 + hstep, voffB); PG8_STAGE(PG8_SA(0, 0), a2, voffA);
            PG8_WAIT_V(8); PG8_WAIT_L(0); PG8_BAR; PG8_MMA(1, 0, At, B0); PG8_MMA(1, 1, At, B1); PG8_BAR; PG8_SCHED;
            PG8_LDB(B0, 1, 0); PG8_LDB(B1, 1, 1); PG8_SCHED; PG8_LDA(At, 1, 0); PG8_STAGE(PG8_SA(0, 1), a2 + hstep, voffA);
            PG8_WAIT_V(8); PG8_WAIT_L(0); PG8_BAR; PG8_MMA(0, 0, At, B0); PG8_MMA(0, 1, At, B1); PG8_BAR; PG8_SCHED;
            PG8_LDA(At, 1, 1); PG8_STAGE(PG8_SB(1, 0), b3, voffB); PG8_STAGE(PG8_SB(1, 1), b3 + hstep, voffB); PG8_STAGE(PG8_SA(1, 0), a3, voffA);
            PG8_WAIT_V(8); PG8_WAIT_L(0); PG8_BAR; PG8_MMA(1, 0, At, B0); PG8_MMA(1, 1, At, B1); PG8_BAR; PG8_SCHED;
            } else {
            PG8_LDB(B0, 0, 0); PG8_SCHED; PG8_LDA(At, 0, 0); PG8_STAGE(PG8_SA(1, 1), a1 + hstep, voffA);
            PG8_WAIT_L(8); PG8_BAR; PG8_WAIT_L(0); PG8_MMA(0, 0, At, B0); PG8_BAR; PG8_SCHED;
            PG8_LDB(B1, 0, 1); PG8_STAGE(PG8_SB(0, 0), b2, voffB);
            PG8_BAR; PG8_WAIT_L(0); PG8_MMA(0, 1, At, B1); PG8_BAR;
            PG8_LDA(At, 0, 1); PG8_STAGE(PG8_SA(0, 0), a2, voffA);
            PG8_BAR; PG8_WAIT_L(0); PG8_MMA(1, 0, At, B0); PG8_BAR; PG8_SCHED;
            PG8_STAGE(PG8_SB(0, 1), b2 + hstep, voffB);
            PG8_WAIT_V(6); PG8_BAR; PG8_MMA(1, 1, At, B1); PG8_BAR;
            PG8_LDB(B0, 1, 0); PG8_SCHED; PG8_LDA(At, 1, 0); PG8_STAGE(PG8_SA(0, 1), a2 + hstep, voffA);
            PG8_WAIT_L(8); PG8_BAR; PG8_WAIT_L(0); PG8_MMA(0, 0, At, B0); PG8_BAR; PG8_SCHED;
            PG8_LDB(B1, 1, 1); PG8_STAGE(PG8_SB(1, 0), b3, voffB);
            PG8_BAR; PG8_WAIT_L(0); PG8_MMA(0, 1, At, B1); PG8_BAR;
            PG8_LDA(At, 1, 1); PG8_STAGE(PG8_SA(1, 0), a3, voffA);
            PG8_BAR; PG8_WAIT_L(0); PG8_MMA(1, 0, At, B0); PG8_BAR; PG8_SCHED;
            PG8_STAGE(PG8_SB(1, 1), b3 + hstep, voffB);
            PG8_WAIT_V(6); PG8_BAR; PG8_MMA(1, 1, At, B1); PG8_BAR;
            }
        }
        if constexpr (ALIGN_EPI) { if (wr == 0) PG8_BAR; }
        if constexpr (!Epi::AFTER_DRAIN) { E(acc, cur, wr, wc, fr, fq); S.done(cur); }
        if (!has_next) break;
#pragma unroll
        for (int a = 0; a < 2; ++a)
#pragma unroll
            for (int b = 0; b < 2; ++b)
#pragma unroll
                for (int m = 0; m < 4; ++m)
#pragma unroll
                    for (int n = 0; n < 2; ++n) acc[a][b][m][n] = (f32x4){0.f, 0.f, 0.f, 0.f};
        cur = nxt; cA = nA; cB = nB; ++ui;
        if constexpr (ALIGN_EPI) { if (wr == 1) PG8_BAR; }
    }
    PG8_WAIT_V(0);
    if constexpr (!ALIGN_EPI) { if (wr == 0) PG8_BAR; }
    PG8_BAR;
    if constexpr (Epi::AFTER_DRAIN) { E.fused(acc, cur, wr, wc, fr, fq, lds, wid, lane); S.done(cur); }
#undef PG8_SA
#undef PG8_SB
#undef PG8_STAGE
#undef PG8_LDA
#undef PG8_LDB
#undef PG8_MMA
#undef PG8_WAIT_V
#undef PG8_WAIT_L
#undef PG8_BAR
#undef PG8_SCHED
}
}


#define XB_TMO      128
#define XB_XCNT(j)  (256  + 64 * (j))
#define XB_XSUB(j)  (1280 + 64 * (j))
#define XB_XGEN(j)  (2304 + 64 * (j))
#define XB_TOP      3328
#define XB_TOPGEN   3392
#define XCD_BAR_WORDS 3456
#define XB_SPIN_CAP (1u << 22)
__device__ __forceinline__ unsigned xb_ld(unsigned* p)              { return __hip_atomic_load(p, __ATOMIC_RELAXED, __HIP_MEMORY_SCOPE_AGENT); }
__device__ __forceinline__ unsigned xb_add(unsigned* p, unsigned v) { return __hip_atomic_fetch_add(p, v, __ATOMIC_RELAXED, __HIP_MEMORY_SCOPE_AGENT); }
__device__ __forceinline__ unsigned xb_xcc_id() { return (unsigned)__builtin_amdgcn_s_getreg((3 << 11) | 20) & 0xFu; }
#define XB_SPIN(cond, bar) do { unsigned _sp = 0; while (cond) { __builtin_amdgcn_s_sleep(1); \
    if ((++_sp & 255u) == 0u) { if (xb_ld(&(bar)[XB_TMO])) break; if (_sp > XB_SPIN_CAP) { atomicAdd(&(bar)[XB_TMO], 1u); break; } } } } while (0)
struct XcdBarrier { unsigned* bar; unsigned x; volatile LAS unsigned* st; };
__device__ __forceinline__ XcdBarrier xcd_barrier_post(unsigned* bar, volatile LAS unsigned* st, int tid_in) {
    XcdBarrier b; b.bar = bar; b.x = xb_xcc_id(); b.st = st;
    if (tid_in == 0) (void)xb_add(&bar[XB_XCNT(b.x)], 1u);
    return b;
}
__device__ __forceinline__ void xcd_barrier_complete(unsigned* bar, unsigned x, unsigned& nloc, unsigned& nx) {
    const unsigned G = gridDim.x * gridDim.y * gridDim.z;
    unsigned sum, cnt, mine, sp = 0u;
    for (;;) {
        sum = 0u; cnt = 0u; mine = 0u;
#pragma unroll
        for (unsigned j = 0; j < 16; ++j) { const unsigned c = xb_ld(&bar[XB_XCNT(j)]); sum += c; cnt += (c > 0u) ? 1u : 0u; mine = (j == x) ? c : mine; }
        if (sum == G) break;
        __builtin_amdgcn_s_sleep(1);
        if ((++sp & 255u) == 0u) { if (xb_ld(&bar[XB_TMO])) break; if (sp > XB_SPIN_CAP) { atomicAdd(&bar[XB_TMO], 1u); break; } }
    }
    nloc = mine > 0u ? mine : 1u; nx = cnt > 0u ? cnt : 1u;
}
__device__ __forceinline__ void xcd_barrier(const XcdBarrier& b, int tid_in) {
    asm volatile("s_waitcnt vmcnt(0)" ::: "memory");
    __syncthreads();
    if (tid_in == 0) {
        unsigned* bar = b.bar;
        __builtin_amdgcn_s_waitcnt(0);
        unsigned nloc = b.st[0], nx = b.st[1];
        if (nloc == 0u) { xcd_barrier_complete(bar, b.x, nloc, nx); b.st[0] = nloc; b.st[1] = nx; }
        const unsigned old = xb_add(&bar[XB_XSUB(b.x)], 1u);
        const unsigned gen = old / nloc;
        if (old + 1u == (gen + 1u) * nloc) {
            __builtin_amdgcn_fence(__ATOMIC_RELEASE, "agent");
            asm volatile("s_waitcnt vmcnt(0)" ::: "memory");
            const unsigned og = xb_add(&bar[XB_TOP], 1u);
            const unsigned tg = og / nx;
            if (og + 1u == (tg + 1u) * nx) xb_add(&bar[XB_TOPGEN], 1u);
            else XB_SPIN(xb_ld(&bar[XB_TOPGEN]) == tg, bar);
            __builtin_amdgcn_fence(__ATOMIC_ACQUIRE, "agent");
            xb_add(&bar[XB_XGEN(b.x)], 1u);
            asm volatile("s_waitcnt vmcnt(0)" ::: "memory");
        } else {
            XB_SPIN(xb_ld(&bar[XB_XGEN(b.x)]) == gen, bar);
            __builtin_amdgcn_fence(__ATOMIC_ACQUIRE, "agent");
            asm volatile("s_waitcnt vmcnt(0)" ::: "memory");
        }
    }
    __syncthreads();
}


typedef short bf16x8 __attribute__((ext_vector_type(8)));
typedef short s16x4 __attribute__((ext_vector_type(4)));
typedef float f32x16 __attribute__((ext_vector_type(16)));
typedef unsigned v4u __attribute__((ext_vector_type(4)));
typedef unsigned v2u __attribute__((ext_vector_type(2)));
constexpr float ATT_THR = 5.0f;
template <int DK> struct AttL { static constexpr int KSTR = DK * 2 + 16, KBYTES = 64 * KSTR, VSTR = 136, VBYTES = 64 * VSTR, KCH = 64 * DK / 8, KPT = (KCH + NTHREADS - 1) / NTHREADS;
    static constexpr int K_OFF = 0, V_OFF = 2 * KBYTES; };

template <int DK>
__device__ __forceinline__ void attn_pass(const bf16_t* Qrow, const bf16_t* Kp, const bf16_t* Vtp, int vt_ld, int nkt, LAS unsigned char* lds, int tid, f32x16 (&oacc)[2], float& l_run) {
    typedef AttL<DK> L;
    constexpr bool AUG = DK <= 32;
    const int lane = tid & 63, r = lane & 31, h = lane >> 5;
    bf16x8 qf[DK / 16];
#pragma unroll
    for (int ks = 0; ks < DK / 16; ++ks) qf[ks] = *(const bf16x8*)(Qrow + 16 * ks + 8 * h);
    const short z_ = (short)(tid >> 20);
    bf16x8 aone = {z_, z_, z_, z_, z_, z_, z_, z_}, bneg = {z_, z_, z_, z_, z_, z_, z_, z_};
    if (h == 0) aone[0] = (short)0x3F80;
    float m_run = 0.f;
    v4u kreg[L::KPT]; v4u vreg;
    const int vd = tid >> 3, vpart = tid & 7;
#define ATT_LOADK(j) do { _Pragma("unroll") for (int i_ = 0; i_ < L::KPT; ++i_) { const int c_ = tid + i_ * NTHREADS; if (c_ < L::KCH) kreg[i_] = *(const v4u*)(Kp + (size_t)(j) * 64 * DK + c_ * 8); } } while (0)
#define ATT_LOADV(j) do { vreg = *(const v4u*)(Vtp + (size_t)vd * vt_ld + (j) * 64 + vpart * 8); } while (0)
#define ATT_STOREK(buf) do { _Pragma("unroll") for (int i_ = 0; i_ < L::KPT; ++i_) { const int c_ = tid + i_ * NTHREADS; if (c_ < L::KCH) { const int key_ = c_ / (DK / 8), part_ = c_ % (DK / 8); \
            *(LAS v4u*)(lds + L::K_OFF + (buf) * L::KBYTES + key_ * L::KSTR + part_ * 16) = kreg[i_]; } } } while (0)
#define ATT_STOREV(buf) do { LAS unsigned char* vp_ = lds + L::V_OFF + (buf) * L::VBYTES + vd * L::VSTR + vpart * 16; *(LAS v2u*)vp_ = (v2u){vreg.x, vreg.y}; *(LAS v2u*)(vp_ + 8) = (v2u){vreg.z, vreg.w}; } while (0)
#define ATT_QK(dst, buf) do { _Pragma("unroll") for (int kb = 0; kb < 2; ++kb) { _Pragma("unroll") for (int i = 0; i < 16; ++i) dst[kb][i] = 0.f; \
        if (AUG) dst[kb] = __builtin_amdgcn_mfma_f32_32x32x16_bf16(aone, bneg, dst[kb], 0, 0, 0); \
        _Pragma("unroll") for (int ks = 0; ks < DK / 16; ++ks) { const bf16x8 a_ = *(const LAS bf16x8*)(lds + L::K_OFF + (buf) * L::KBYTES + (32 * kb + r) * L::KSTR + (16 * ks + 8 * h) * 2); \
            dst[kb] = __builtin_amdgcn_mfma_f32_32x32x16_bf16(a_, qf[ks], dst[kb], 0, 0, 0); } } } while (0)
#define ATT_BODY(SC, SN, j) do { \
        if ((j) + 2 < nkt) ATT_LOADK((j) + 2); \
        if ((j) + 1 < nkt) { ATT_LOADV((j) + 1); ATT_QK(SN, ((j) + 1) & 1); } \
        if (((j) & 3) == 0) { \
            float t0 = fmaxf(fmaxf(SC[0][0], SC[0][1]), SC[0][2]), t1 = fmaxf(fmaxf(SC[0][3], SC[0][4]), SC[0][5]), t2 = fmaxf(fmaxf(SC[0][6], SC[0][7]), SC[0][8]), t3 = fmaxf(fmaxf(SC[0][9], SC[0][10]), SC[0][11]); \
            float t4 = fmaxf(fmaxf(SC[0][12], SC[0][13]), SC[0][14]), t5 = fmaxf(fmaxf(SC[0][15], SC[1][0]), SC[1][1]), t6 = fmaxf(fmaxf(SC[1][2], SC[1][3]), SC[1][4]), t7 = fmaxf(fmaxf(SC[1][5], SC[1][6]), SC[1][7]); \
            float t8 = fmaxf(fmaxf(SC[1][8], SC[1][9]), SC[1][10]), t9 = fmaxf(fmaxf(SC[1][11], SC[1][12]), SC[1][13]), t10 = fmaxf(SC[1][14], SC[1][15]); \
            float tmax = fmaxf(fmaxf(fmaxf(fmaxf(t0, t1), t2), fmaxf(fmaxf(t3, t4), t5)), fmaxf(fmaxf(fmaxf(t6, t7), t8), fmaxf(t9, t10))); \
            tmax = xor32_max(tmax); if (!AUG) tmax -= m_run;            \
            if ((j) == 0 || __any(tmax > ATT_THR)) {                   \
                const float want = (j) == 0 ? tmax : m_run + fmaxf(tmax, 0.f); \
                const float mn = __uint_as_float(pk2(want, 0.f) << 16), dlt = mn - m_run, alpha = __builtin_amdgcn_exp2f(-dlt); \
                _Pragma("unroll") for (int i = 0; i < 16; ++i) { oacc[0][i] *= alpha; oacc[1][i] *= alpha; if (AUG) { SC[0][i] -= dlt; SC[1][i] -= dlt; SN[0][i] -= dlt; SN[1][i] -= dlt; } } \
                l_run *= alpha; m_run = mn; if (AUG && h == 0) bneg[0] = (short)(__float_as_uint(-mn) >> 16); \
            } \
        } \
        float ps0 = 0.f, ps1 = 0.f, ps2 = 0.f, ps3 = 0.f; \
        _Pragma("unroll") for (int kb = 0; kb < 2; ++kb) \
            _Pragma("unroll") for (int i = 0; i < 16; i += 4) { const float mo = AUG ? 0.f : m_run; const float p0 = __builtin_amdgcn_exp2f(SC[kb][i] - mo), p1 = __builtin_amdgcn_exp2f(SC[kb][i + 1] - mo), p2 = __builtin_amdgcn_exp2f(SC[kb][i + 2] - mo), p3 = __builtin_amdgcn_exp2f(SC[kb][i + 3] - mo); \
                SC[kb][i] = p0; SC[kb][i + 1] = p1; SC[kb][i + 2] = p2; SC[kb][i + 3] = p3; ps0 += p0; ps1 += p1; ps2 += p2; ps3 += p3; } \
        l_run += (ps0 + ps1) + (ps2 + ps3); \
        _Pragma("unroll") for (int kb = 0; kb < 2; ++kb) \
            _Pragma("unroll") for (int s2 = 0; s2 < 2; ++s2) { \
                union { bf16x8 v; unsigned u[4]; } pf; \
                _Pragma("unroll") for (int i = 0; i < 4; ++i) pf.u[i] = pk2(SC[kb][8 * s2 + 2 * i], SC[kb][8 * s2 + 2 * i + 1]); \
                _Pragma("unroll") for (int db = 0; db < 2; ++db) { \
                    const LAS unsigned char* vp = lds + L::V_OFF + ((j) & 1) * L::VBYTES + (32 * db + r) * L::VSTR + (32 * kb + 16 * s2 + 4 * h) * 2; \
                    union { bf16x8 v; v2u u[2]; } af; af.u[0] = *(const LAS v2u*)vp; af.u[1] = *(const LAS v2u*)(vp + 16); \
                    oacc[db] = __builtin_amdgcn_mfma_f32_32x32x16_bf16(af.v, pf.v, oacc[db], 0, 0, 0); } } \
        if ((j) + 2 < nkt) ATT_STOREK((j) & 1);               \
        if ((j) + 1 < nkt) ATT_STOREV(((j) + 1) & 1);         \
        __syncthreads(); \
    } while (0)
    __syncthreads();
    ATT_LOADK(0); ATT_LOADV(0); ATT_STOREK(0); ATT_STOREV(0);
    if (nkt > 1) { ATT_LOADK(1); ATT_STOREK(1); }
    __syncthreads();
    f32x16 sa[2], sb[2];
#pragma unroll
    for (int i = 0; i < 16; ++i) { sb[0][i] = (float)z_; sb[1][i] = (float)z_; }
    ATT_QK(sa, 0);
    for (int j = 0; j < nkt; j += 2) {
        ATT_BODY(sa, sb, j);
        if (j + 1 < nkt) ATT_BODY(sb, sa, j + 1);
    }
#undef ATT_BODY
#undef ATT_LOADK
#undef ATT_LOADV
#undef ATT_STOREK
#undef ATT_STOREV
#undef ATT_QK
}


constexpr int SLD = 65, SHLD = 72, XTLD = 132;
__device__ __forceinline__ int rm32(int t, int h) { return (t & 3) + 8 * (t >> 2) + 4 * h; }
template <bool WITH_Y>
__device__ __forceinline__ void ssd_block(int b, int dir, int k, int hp, const bf16_t* xbc, const float* dtp, const float* alog, float* hs, float* alast, bf16_t* yd, float* lds, int tid) {
    const bool lat = k >= 2; const int c = lat ? (dir ? 33 - k : k - 2) : (dir ? 1 - k : k);
    const int row0 = tok_row(lat, b, c * 128), g = hp >> 1;
    float* sB = lds; bf16_t* sBh = (bf16_t*)lds; bf16_t* sCh = sBh + 128 * SHLD;
    float* sX = WITH_Y ? lds + (2 * 128 * SHLD * 2) / 4 : sB + 128 * SLD; bf16_t* sXT = (bf16_t*)sX;
    float* sDT = sX + 128 * 128; float* sCum = sDT + 256; float* sW = sCum + 256; float* sSc = sW + 256;
    const int wave = tid >> 6, lane = tid & 63, r = lane & 31, h = lane >> 5, hl = wave >> 2, head = 2 * hp + hl;
    float* hsp = hs + (((size_t)(b * 2 + dir) * NCH + k) * 8 + head) * 4096;
    union { bf16x8 v; unsigned u[4]; } hfrag[WITH_Y ? 8 : 1];
    if (WITH_Y) {
#pragma unroll
        for (int Pb = 0; Pb < 2; ++Pb)
#pragma unroll
            for (int ks = 0; ks < 4; ++ks) { const float4 x0 = *(const float4*)(hsp + (32 * Pb + r) * 64 + 16 * ks + 8 * h), x1 = *(const float4*)(hsp + (32 * Pb + r) * 64 + 16 * ks + 8 * h + 4);
                hfrag[Pb * 4 + ks].u[0] = pk2(x0.x, x0.y); hfrag[Pb * 4 + ks].u[1] = pk2(x0.z, x0.w); hfrag[Pb * 4 + ks].u[2] = pk2(x1.x, x1.y); hfrag[Pb * 4 + ks].u[3] = pk2(x1.z, x1.w); }
    }
    uint2 vb[8]; float4 vx[8]; float dx[8]; float dtv = 0.f, dav = 0.f;
#pragma unroll
    for (int u = 0; u < 8; ++u) { const int i = tid + u * NTHREADS, t = i >> 5, c4 = i & 31;
        vb[u] = *(const uint2*)(xbc + (size_t)(row0 + t) * 768 + 512 + (c4 >> 4) * 128 + g * 64 + (c4 & 15) * 4);
        vx[u] = ld4h(xbc + (size_t)(row0 + t) * 768 + hp * 128 + c4 * 4);
        dx[u] = dtp[(size_t)(row0 + t) * 16 + dir * 8 + 2 * hp + (c4 >> 4)]; }
    if (tid < 256) { const int hl = tid >> 7, t = tid & 127, h = 2 * hp + hl; dtv = dtp[(size_t)(row0 + t) * 16 + dir * 8 + h]; dav = dtv * -expf(alog[dir * 8 + h]); }
    __syncthreads();
#pragma unroll
    for (int u = 0; u < 8; ++u) { const int i = tid + u * NTHREADS, t = i >> 5, c4 = i & 31;
        if (WITH_Y) *(uint2*)((c4 >> 4 ? sCh : sBh) + t * SHLD + (c4 & 15) * 4) = vb[u];
        else if (!(c4 >> 4)) { const float4 f = up4(vb[u]); float* d = sB + t * SLD + (c4 & 15) * 4; d[0] = f.x; d[1] = f.y; d[2] = f.z; d[3] = f.w; }
        if (WITH_Y) { const float4 xs = f4scale(vx[u], dx[u]); sXT[(c4 * 4 + 0) * XTLD + t] = (bf16_t)(pk2(xs.x, 0.f)); sXT[(c4 * 4 + 1) * XTLD + t] = (bf16_t)(pk2(xs.y, 0.f)); sXT[(c4 * 4 + 2) * XTLD + t] = (bf16_t)(pk2(xs.z, 0.f)); sXT[(c4 * 4 + 3) * XTLD + t] = (bf16_t)(pk2(xs.w, 0.f)); }
        else *(float4*)(sX + t * 128 + c4 * 4) = f4scale(vx[u], dx[u]); }
    if (tid < 256) { const int t = tid & 127; sSc[(tid & 128) + (dir ? 127 - t : t)] = dav; }
    __syncthreads();
    for (int off = 1; off < 128; off <<= 1) { float v = 0.f; const int sI = tid & 127;
        if (tid < 256) { v = sSc[tid]; if (sI >= off) v += sSc[tid - off]; }
        __syncthreads(); if (tid < 256) sSc[tid] = v; __syncthreads(); }
    if (tid < 256) { const int hl = tid >> 7, sI = tid & 127, t = dir ? 127 - sI : sI; const float cu = sSc[tid], tot = sSc[hl * 128 + 127];
        sCum[hl * 128 + t] = cu; sW[hl * 128 + t] = expf(tot - cu);
        if (!WITH_Y && sI == 127) alast[((size_t)(b * 2 + dir) * NCH + k) * 8 + 2 * hp + hl] = tot; }
    __syncthreads();
    if (WITH_Y) {
        const int I = hl ? 3 - (wave & 3) : (wave & 3), ti = 32 * I + r;
        const float cum_i = sCum[hl * 128 + ti];
        f32x16 Y[2], Yo[2];
#pragma unroll
        for (int i = 0; i < 16; ++i) { Y[0][i] = 0.f; Y[1][i] = 0.f; Yo[0][i] = 0.f; Yo[1][i] = 0.f; }
        bf16x8 cfrag[4];
#pragma unroll
        for (int ks = 0; ks < 4; ++ks) cfrag[ks] = *(const bf16x8*)(sCh + (32 * I + r) * SHLD + 16 * ks + 8 * h);
#pragma unroll
        for (int Pb = 0; Pb < 2; ++Pb)
#pragma unroll
            for (int ks = 0; ks < 4; ++ks) Yo[Pb] = __builtin_amdgcn_mfma_f32_32x32x16_bf16(hfrag[Pb * 4 + ks].v, cfrag[ks], Yo[Pb], 0, 0, 0);
        const int J0 = dir ? I : 0, J1 = dir ? 3 : I;
        for (int J = J0; J <= J1; ++J) {
            f32x16 Gt;
#pragma unroll
            for (int i = 0; i < 16; ++i) Gt[i] = 0.f;
#pragma unroll
            for (int ks = 0; ks < 4; ++ks) Gt = __builtin_amdgcn_mfma_f32_32x32x16_bf16(*(const bf16x8*)(sBh + (32 * J + r) * SHLD + 16 * ks + 8 * h), cfrag[ks], Gt, 0, 0, 0);
#pragma unroll
            for (int t = 0; t < 16; ++t) { const int tj = 32 * J + rm32(t, h); const bool valid = (J != I) || (dir ? tj >= ti : tj <= ti);
                Gt[t] *= valid ? __expf(cum_i - sCum[hl * 128 + tj]) : 0.f; }
#pragma unroll
            for (int s2 = 0; s2 < 2; ++s2) {
                union { bf16x8 v; unsigned u[4]; } pf;
#pragma unroll
                for (int i = 0; i < 4; ++i) pf.u[i] = pk2(Gt[8 * s2 + 2 * i], Gt[8 * s2 + 2 * i + 1]);
#pragma unroll
                for (int Pb = 0; Pb < 2; ++Pb) {
                    const bf16_t* xp = sXT + (hl * 64 + 32 * Pb + r) * XTLD + 32 * J + 16 * s2 + 4 * h;
                    union { bf16x8 v; uint2 u[2]; } af; af.u[0] = *(const uint2*)xp; af.u[1] = *(const uint2*)(xp + 8);
                    Y[Pb] = __builtin_amdgcn_mfma_f32_32x32x16_bf16(af.v, pf.v, Y[Pb], 0, 0, 0);
                }
            }
        }
        const float ei = __expf(cum_i);
        bf16_t* yrow = yd + ((size_t)dir * NTOK + row0 + ti) * 512 + head * 64;
#pragma unroll
        for (int Pb = 0; Pb < 2; ++Pb)
#pragma unroll
            for (int tq = 0; tq < 4; ++tq)
                *(uint2*)(yrow + 32 * Pb + 8 * tq + 4 * h) = pk4(make_float4(Y[Pb][4 * tq] + ei * Yo[Pb][4 * tq], Y[Pb][4 * tq + 1] + ei * Yo[Pb][4 * tq + 1], Y[Pb][4 * tq + 2] + ei * Yo[Pb][4 * tq + 2], Y[Pb][4 * tq + 3] + ei * Yo[Pb][4 * tq + 3]));
    } else {
        const int Pb = (wave >> 1) & 1, Nb = wave & 1;
        f32x16 acc;
#pragma unroll
        for (int i = 0; i < 16; ++i) acc[i] = 0.f;
#pragma unroll 8
        for (int ks = 0; ks < 64; ++ks) { const int j = 2 * ks + h;
            acc = __builtin_amdgcn_mfma_f32_32x32x2f32(sX[j * 128 + hl * 64 + 32 * Pb + r] * sW[hl * 128 + j], sB[j * SLD + 32 * Nb + r], acc, 0, 0, 0); }
#pragma unroll
        for (int t = 0; t < 16; ++t) hsp[(32 * Pb + rm32(t, h)) * 64 + 32 * Nb + r] = acc[t];
    }
}

template <class RM>
__device__ __forceinline__ void cvt_tile(const float* src, int N, bf16_t* dst, int ldd, RM rowmap, int k0, int n0, int lane) {
    const int n = n0 + lane;
    if (n < N) {
        const float* sp = src + (size_t)k0 * N + n;
        float v[32];
#pragma unroll
        for (int kk = 0; kk < 32; ++kk) v[kk] = sp[(size_t)kk * N];
        uint4* dp = (uint4*)(dst + (size_t)rowmap(n) * ldd + k0);
#pragma unroll
        for (int i = 0; i < 4; ++i) dp[i] = make_uint4(pk2(v[8 * i], v[8 * i + 1]), pk2(v[8 * i + 2], v[8 * i + 3]), pk2(v[8 * i + 4], v[8 * i + 5]), pk2(v[8 * i + 6], v[8 * i + 7]));
    }
}
__device__ __forceinline__ int block_excl_scan(int v, int tid, volatile int* sh, int& total) {
    const int lane = tid & 63, wave = tid >> 6; int x = v;
    x += __builtin_amdgcn_update_dpp(0, x, 0x111, 0xf, 0xf, true); x += __builtin_amdgcn_update_dpp(0, x, 0x112, 0xf, 0xf, true);
    x += __builtin_amdgcn_update_dpp(0, x, 0x114, 0xf, 0xf, true); x += __builtin_amdgcn_update_dpp(0, x, 0x118, 0xf, 0xf, true);
    x += __builtin_amdgcn_update_dpp(0, x, 0x142, 0xa, 0xf, false); x += __builtin_amdgcn_update_dpp(0, x, 0x143, 0xc, 0xf, false);
    __syncthreads();
    if (lane == 63) sh[wave] = x;
    __syncthreads();
    int off = 0, tot = 0;
#pragma unroll
    for (int w = 0; w < 8; ++w) { const int c = sh[w]; tot += c; if (w < wave) off += c; }
    total = tot;
    return off + x - v;
}
__device__ __forceinline__ int block_sum(int v, int tid, volatile int* sh, int parity) {
    const int lane = tid & 63, wave = tid >> 6;
    v += __builtin_amdgcn_update_dpp(0, v, 0x111, 0xf, 0xf, true); v += __builtin_amdgcn_update_dpp(0, v, 0x112, 0xf, 0xf, true);
    v += __builtin_amdgcn_update_dpp(0, v, 0x114, 0xf, 0xf, true); v += __builtin_amdgcn_update_dpp(0, v, 0x118, 0xf, 0xf, true);
    v += __builtin_amdgcn_update_dpp(0, v, 0x142, 0xa, 0xf, false); v += __builtin_amdgcn_update_dpp(0, v, 0x143, 0xc, 0xf, false);
    if (lane == 63) sh[parity * 8 + wave] = v;
    __syncthreads();
    int tot = 0;
#pragma unroll
    for (int w = 0; w < 8; ++w) tot += sh[parity * 8 + w];
    return tot;
}

#define MOD ((float*)(kp_->ws + WS_MOD))
#define CTXC ((float*)(kp_->ws + WS_CTXC))
#define AFF ((float*)(kp_->ws + WS_AFF))
#define TOKSLOT ((int*)(kp_->ws + WS_TOKSLOT))
#define SELIDX ((int*)(kp_->ws + WS_SELIDX))
#define SELGATE ((float*)(kp_->ws + WS_SELGATE))
#define DT ((float*)(kp_->ws + WS_DT))
#define HB ((bf16_t*)(kp_->ws + WS_HB))
#define HS ((float*)(kp_->ws + WS_HS))
#define YD ((bf16_t*)(kp_->ws + WS_YD))
#define ALAST ((float*)(kp_->ws + WS_ALAST))
#define ROPE ((float*)(kp_->ws + WS_ROPE))
#define PB ((bf16_t*)(kp_->ws + WS_P))
#define XBC ((bf16_t*)(kp_->ws + WS_XBC))
#define MQ ((bf16_t*)(kp_->ws + WS_MQ))
#define MKV ((bf16_t*)(kp_->ws + WS_MKV))
#define CQB ((bf16_t*)(kp_->ws + WS_CQB))
#define CKVB ((bf16_t*)(kp_->ws + WS_CKVB))
#define MIXB ((bf16_t*)(kp_->ws + WS_MIXB))
#define MOUT ((bf16_t*)(kp_->ws + WS_MOUT))
#define XG ((bf16_t*)(kp_->ws + WS_XG))
#define HID ((bf16_t*)(kp_->ws + WS_HID))
#define Y ((bf16_t*)(kp_->ws + WS_Y))
#define WIN_T ((bf16_t*)(kp_->ws + WS_WIN))
#define WQ_T ((bf16_t*)(kp_->ws + WS_WQ))
#define WKV_T ((bf16_t*)(kp_->ws + WS_WKV))
#define WOUT_T ((bf16_t*)(kp_->ws + WS_WOUT))
#define WGU_T ((bf16_t*)(kp_->ws + WS_WGU))
#define WD_T ((bf16_t*)(kp_->ws + WS_WD))
#define QD ((bf16_t*)(kp_->ws + WS_QD))
#define QDC ((bf16_t*)(kp_->ws + WS_QDC))
#define KD ((bf16_t*)(kp_->ws + WS_KD))
#define VDT ((bf16_t*)(kp_->ws + WS_VDT))
#define QM ((bf16_t*)(kp_->ws + WS_QM))
#define QMC ((bf16_t*)(kp_->ws + WS_QMC))
#define KM ((bf16_t*)(kp_->ws + WS_KM))
#define VMT ((bf16_t*)(kp_->ws + WS_VMT))
#define xcur (kp_->out)
#define XSRC (l == 0 ? kp_->in[I_X] : (const float*)kp_->out)
#define CSRC (l == 0 ? kp_->in[I_CTX] : (const float*)CTXC)
#define DTMP XBC
#define modl (MOD + (size_t)l * (NB + 1) * NMOD * D)
typedef const __attribute__((address_space(4))) Prm* KPrm;
#define PHASE_BEGIN() KPrm kp_ = (KPrm)__builtin_amdgcn_kernarg_segment_ptr(); asm volatile("" : "+s"(kp_)); int tid = MK_TID(); asm volatile("" : "+v"(tid)); (void)tid
#define GSYNC() do { XcdBarrier b_; b_.bar = (unsigned*)(kp_->ws + WS_CTL); b_.x = xb_xcc_id(); b_.st = (volatile LAS unsigned*)(ldsb + LDS_BYTES - 64); xcd_barrier(b_, tid); } while (0)
#define CVT_MOE_RANGE(LW, ID0, ID1, SLOT, NSLOTS) do { const int lane_ = tid & 63; \
        for (int id = (ID0) + (SLOT); id < (ID1); id += (NSLOTS)) { \
            const int mat = id >> 9, tl = id & 511, e = mat / 3, which = mat % 3, k0 = (tl >> 4) * 32, n0 = (tl & 15) * 64; \
            if (which == 0) cvt_tile(kp_->in[I_WG] + ((size_t)(LW) * NE + e) * D * FF, FF, WGU_T + (size_t)e * 2 * FF * D, D, [](int n) { return (n >> 2) * 8 + (n & 3); }, k0, n0, lane_); \
            else if (which == 1) cvt_tile(kp_->in[I_WU] + ((size_t)(LW) * NE + e) * D * FF, FF, WGU_T + (size_t)e * 2 * FF * D, D, [](int n) { return (n >> 2) * 8 + 4 + (n & 3); }, k0, n0, lane_); \
            else cvt_tile(kp_->in[I_WD] + ((size_t)(LW) * NE + e) * FF * D, D, WD_T + (size_t)e * D * FF, FF, [](int n) { return n; }, k0, n0, lane_); } } while (0)
constexpr int MOE_TILES = NE * 3 * 512;
constexpr int CVT_PER_WAVE = 4;
__global__ void __launch_bounds__(NTHREADS, 2) mk_forward(Prm p) {
    extern __shared__ __attribute__((aligned(16))) unsigned char lds_raw[];
    LAS unsigned char* const ldsb = (LAS unsigned char*)lds_raw;
    volatile LAS unsigned* st = (volatile LAS unsigned*)(ldsb + LDS_BYTES - 64);
    const int wave_s = __builtin_amdgcn_readfirstlane((int)threadIdx.x >> 6);
#define MK_TID() mk_tid_impl(wave_s)
    if (MK_TID() < 16) st[MK_TID()] = 0u;
    __syncthreads();
    (void)xcd_barrier_post((unsigned*)(p.ws + WS_CTL), st, MK_TID());
    const int G = gridDim.x, bid = blockIdx.x;
    const int vcu = (G % 8 == 0) ? (bid % 8) * (G / 8) + bid / 8 : bid;

    {
        PHASE_BEGIN();
        const float* c = kp_->in[I_C]; const float* cc = kp_->in[I_CCTX]; const float* adaw = kp_->in[I_ADAW]; const float* adab = kp_->in[I_ADAB];
        float* sc_l = (float*)lds_raw;
        for (int i = tid; i < (NB + 1) * D; i += NTHREADS) { const int r = i / D, k = i % D; sc_l[i] = siluf(r < NB ? c[(size_t)r * D + k] : cc[k]); }
        __syncthreads();
        {
            float* red = sc_l + (NB + 1) * D;
            const int lane = tid & 63, wv = tid >> 6;
            for (int it = bid; it < DEPTH * (NMOD * D / 64); it += G) {
                const int l = it / (NMOD * D / 64), j = (it % (NMOD * D / 64)) * 64 + lane;
                const float* w = adaw + ((size_t)l * D + wv * 128) * NMOD * D + j;
                float a0 = 0.f, a1 = 0.f, a2 = 0.f, a3 = 0.f, a4 = 0.f;
#pragma unroll 8
                for (int k = 0; k < 128; ++k) { const float wk = w[(size_t)k * NMOD * D]; const int kk = wv * 128 + k;
                    a0 += sc_l[kk] * wk; a1 += sc_l[D + kk] * wk; a2 += sc_l[2 * D + kk] * wk; a3 += sc_l[3 * D + kk] * wk; a4 += sc_l[4 * D + kk] * wk; }
                __syncthreads();
                red[(wv * 5 + 0) * 64 + lane] = a0; red[(wv * 5 + 1) * 64 + lane] = a1; red[(wv * 5 + 2) * 64 + lane] = a2; red[(wv * 5 + 3) * 64 + lane] = a3; red[(wv * 5 + 4) * 64 + lane] = a4;
                __syncthreads();
                if (tid < 5 * 64) { const int r = tid >> 6; float acc = adab[l * NMOD * D + j - lane + (tid & 63)];
#pragma unroll
                    for (int q = 0; q < 8; ++q) acc += red[(q * 5 + r) * 64 + (tid & 63)];
                    MOD[((size_t)l * (NB + 1) + r) * NMOD * D + (j - lane) + (tid & 63)] = acc; }
            }
        }
        ITEMS(i, S * 16) {
            const int t = i >> 4, w = i & 15, ii = w & 7; const float pos = (float)(w < 8 ? t / GRID_W : t % GRID_W);
            const float ang = pos * powf(10000.0f, -(float)ii / 8.0f);
            ROPE[(size_t)t * 32 + (w < 8 ? 0 : 16) + ii] = cosf(ang); ROPE[(size_t)t * 32 + (w < 8 ? 8 : 24) + ii] = sinf(ang);
        }
        GSYNC();
    }

#pragma unroll 1
    for (int l = 0; l < DEPTH; ++l) {
        const bool ctx_out = l < DEPTH - 1;
        const float lambda_init = 0.8f - 0.6f * expf(-0.3f * (float)l);
        const int nrows_out = ctx_out ? NTOK : NLAT;
        const int ER = ctx_out ? ER_MAX : NB * CAP_L;
        int moe_done = 0;

        {
            PHASE_BEGIN();
            {
                const int lane = tid & 63; auto idm = [](int n) { return n; };
                constexpr int T_WIN = (D / 32) * ((IN_COLS + 63) / 64), T_WQ = (192 / 32) * (384 / 64), T_WKV = (128 / 32) * (512 / 64), T_WOUT = (MIXW / 32) * (D / 64);
                WITEMS(id, T_WIN + T_WQ + T_WKV + T_WOUT) {
                    if (id < T_WIN) { const int nt = (IN_COLS + 63) / 64; cvt_tile(kp_->in[I_WIN] + (size_t)l * D * IN_COLS, IN_COLS, WIN_T, D, idm, (id / nt) * 32, (id % nt) * 64, lane); }
                    else if (id < T_WIN + T_WQ) { const int u = id - T_WIN; cvt_tile(kp_->in[I_WQUP] + (size_t)l * 192 * 384, 384, WQ_T, 256, idm, (u / 6) * 32, (u % 6) * 64, lane); }
                    else if (id < T_WIN + T_WQ + T_WKV) { const int u = id - T_WIN - T_WQ; cvt_tile(kp_->in[I_WKVUP] + (size_t)l * 128 * 512, 512, WKV_T, 128, idm, (u / 8) * 32, (u % 8) * 64, lane); }
                    else { const int u = id - T_WIN - T_WQ - T_WKV; cvt_tile(kp_->in[I_WOUT] + (size_t)l * MIXW * D, D, WOUT_T, MIXW, idm, (u / 16) * 32, (u % 16) * 64, lane); }
                }
            }
            ITEMS(i, (IN_PAD - IN_COLS) * D / 8) ((uint4*)(WIN_T + (size_t)IN_COLS * D))[i] = make_uint4(0, 0, 0, 0);
            ITEMS(i, 128 * 256 / 8) ((uint4*)(WQ_T + (size_t)384 * 256))[i] = make_uint4(0, 0, 0, 0);
            ITEMS(i, 384 * 8) { const int r = i >> 3, c8 = i & 7; *(uint4*)(WQ_T + (size_t)r * 256 + 192 + c8 * 8) = make_uint4(0, 0, 0, 0); }

            const float* w = kp_->in[I_NMPRE] + l * D;
            const int lane = tid & 63;
            {
                float4 xq[4];
                { const float zf_ = (float)(tid >> 20);
#pragma unroll
                  for (int i = 0; i < 4; ++i) xq[i] = make_float4(zf_, zf_, zf_, zf_); }
                float4* aux = (float4*)lds_raw;
                __syncthreads();
                for (int i = tid; i < 11 * (D / 4); i += NTHREADS) { const int v = i / (D / 4), k4 = i % (D / 4);
                    const float* src = v == 0 ? w : modl + (size_t)((v - 1) % 5) * NMOD * D + ((v - 1) / 5) * D;
                    aux[i] = ((const float4*)src)[k4]; }
                __syncthreads();
                const int wstride = gridDim.x * 8; int r = blockIdx.x * 8 + (tid >> 6);
#define P1_LOAD(rr) do { const float4* src_ = (const float4*)((rr) < NLAT ? XSRC + (size_t)(rr) * D : CSRC + (size_t)((rr) - NLAT) * D); _Pragma("unroll") for (int i = 0; i < 4; ++i) xq[i] = src_[i * 64 + lane]; } while (0)
                if (r < NTOK) P1_LOAD(r);
                for (; r < NTOK; r += wstride) {
                    const int bsel = r < NLAT ? r / S : NB;
                    float4 v[4]; float ss = 0.f;
#pragma unroll
                    for (int i = 0; i < 4; ++i) { v[i] = xq[i]; ss += f4dot(v[i], v[i]); }
                    if (r + wstride < NTOK) P1_LOAD(r + wstride);
                    ss = wave_sum(ss);
                    const float rs = 1.0f / sqrtf(ss / D + EPS);
#pragma unroll
                    for (int i = 0; i < 4; ++i) { const int k4 = i * 64 + lane; const float4 w4 = aux[k4], sc = aux[(6 + bsel) * (D / 4) + k4], sh = aux[(1 + bsel) * (D / 4) + k4];
                        const float4 o = make_float4(v[i].x * rs * w4.x * (1.0f + sc.x) + sh.x, v[i].y * rs * w4.y * (1.0f + sc.y) + sh.y, v[i].z * rs * w4.z * (1.0f + sc.z) + sh.z, v[i].w * rs * w4.w * (1.0f + sc.w) + sh.w);
                        *(uint2*)(HB + (size_t)r * D + k4 * 4) = pk4(o); }
                }
#undef P1_LOAD
            }
            GSYNC();
        }
        {
            PHASE_BEGIN();
            pg8::Gemm g{HB, WIN_T, NTOK, IN_PAD, D, 0, 0}; pg8::StaticOrder so; so.init(NTOK, IN_PAD, G, bid);
            pg8::EpiBf16 E{PB, IN_COLS, IN_COLS};
            pg8::gemm_phase<pg8::EpiBf16, pg8::StaticOrder, true, true>(ldsb, g, so, E, tid);
            { const int nwg = (NTOK / 256) * (IN_PAD / 256), busy = nwg % G;
              if (busy != 0 && bid >= busy) CVT_MOE_RANGE(l, 0, (G - busy) * 8 * CVT_PER_WAVE, (bid - busy) * 8 + (tid >> 6), (G - busy) * 8);
              moe_done = busy != 0 ? (G - busy) * 8 * CVT_PER_WAVE : 0; }
            GSYNC();
        }
        {
            PHASE_BEGIN();
            const float* cw = kp_->in[I_CONVW] + (size_t)l * 3 * 768; const float* cb = kp_->in[I_CONVB] + (size_t)l * 768;
            {
                float* cwl = (float*)lds_raw;
                __syncthreads();
                for (int i = tid; i < 4 * 768; i += NTHREADS) cwl[i] = i < 3 * 768 ? cw[i] : cb[i - 3 * 768];
                __syncthreads();
                const int stride = gridDim.x * NTHREADS;
                for (int i0 = blockIdx.x * NTHREADS + tid; i0 < NTOK * 192; i0 += 4 * stride) {
                    uint2 u0[4], um[4], up[4];
#pragma unroll
                    for (int q = 0; q < 4; ++q) { const int i = i0 + q * stride; const unsigned z_ = (unsigned)tid >> 20; u0[q] = make_uint2(z_, z_); um[q] = u0[q]; up[q] = u0[q];
                        if (i < NTOK * 192) { const int c = (i % 192) * 4, r = i / 192; const bool lat = r < NLAT; const int L = lat ? S : CTX; const int t = lat ? r % S : (r - NLAT) % CTX;
                            const bf16_t* u = PB + (size_t)r * IN_COLS + C_XBC + c; u0[q] = *(const uint2*)u; if (t > 0) um[q] = *(const uint2*)(u - IN_COLS); if (t < L - 1) up[q] = *(const uint2*)(u + IN_COLS); } }
#pragma unroll
                    for (int q = 0; q < 4; ++q) { const int i = i0 + q * stride;
                        if (i < NTOK * 192) { const int c = (i % 192) * 4, r = i / 192;
                            float4 acc = f4add(*(const float4*)(cwl + 3 * 768 + c), f4mul(*(const float4*)(cwl + 768 + c), up4(u0[q])));
                            acc = f4add(acc, f4mul(*(const float4*)(cwl + c), up4(um[q]))); acc = f4add(acc, f4mul(*(const float4*)(cwl + 2 * 768 + c), up4(up[q])));
                            *(uint2*)(XBC + (size_t)r * 768 + c) = pk4(make_float4(siluf(acc.x), siluf(acc.y), siluf(acc.z), siluf(acc.w))); } }
                }
            }
            const float* dtb = kp_->in[I_DTB] + l * 16;
            ITEMS(i, NTOK * 16) { const int j = i % 16, r = i / 16; DT[i] = softplusf(bf2f(PB[(size_t)r * IN_COLS + C_DT + j]) + dtb[j]); }
            ITEMS(i, NTOK * 16) {
                const int g = i & 15, r = i >> 4; const int hm = g & 7, isk = g >> 3;
                const bool lat = r < NLAT; const int b = lat ? r / S : (r - NLAT) / CTX, t = lat ? r % S : (r - NLAT) % CTX;
                if (!isk && !lat && !ctx_out) continue;
                const bf16_t* vp = PB + (size_t)r * IN_COLS + (isk ? C_DK : C_DQ) + hm * 32;
                float v[32];
#pragma unroll
                for (int k = 0; k < 32; k += 4) { const float4 x = ld4h(vp + k); v[k] = x.x; v[k + 1] = x.y; v[k + 2] = x.z; v[k + 3] = x.w; }
                if (lat) rope32(v, t, ROPE);
                const float sc = isk ? 1.0f : 0.17677669529663687f * 1.4426950408889634f;
                bf16_t* dst = isk ? KD + ((size_t)(b * 8 + hm) * SK + (lat ? CTX + t : t)) * 32 : (lat ? QD + ((size_t)(b * 8 + hm) * S + t) * 32 : QDC + ((size_t)(b * 8 + hm) * CTX + t) * 32);
#pragma unroll
                for (int k = 0; k < 32; k += 8) *(uint4*)(dst + k) = make_uint4(pk2(v[k] * sc, v[k + 1] * sc), pk2(v[k + 2] * sc, v[k + 3] * sc), pk2(v[k + 4] * sc, v[k + 5] * sc), pk2(v[k + 6] * sc, v[k + 7] * sc));
            }
            ITEMS(i, NB * 4 * (SK / 8) * 64) {
                const int d = i & 63, j8 = (i >> 6) % (SK / 8), hh = (i / (64 * (SK / 8))) & 3, b = i / (256 * (SK / 8));
                const int r0 = j8 * 8 < CTX ? tok_row(false, b, j8 * 8) : tok_row(true, b, j8 * 8 - CTX);
                const bf16_t* sp = PB + (size_t)r0 * IN_COLS + C_DV + hh * 64 + d;
                unsigned v[8];
#pragma unroll
                for (int jj = 0; jj < 8; ++jj) v[jj] = sp[(size_t)jj * IN_COLS];
                *(uint4*)(VDT + ((size_t)(b * 4 + hh) * 64 + d) * SK + j8 * 8) = make_uint4(v[0] | (v[1] << 16), v[2] | (v[3] << 16), v[4] | (v[5] << 16), v[6] | (v[7] << 16));
            }
            const float* qn = kp_->in[I_QNORM] + l * 192; const float* kvn = kp_->in[I_KVNORM] + l * 128;
            { const int lane = tid & 63;
            uint2 xq = make_uint2((unsigned)tid >> 20, (unsigned)tid >> 20);
            const int wstride = gridDim.x * 8; int i = blockIdx.x * 8 + (tid >> 6);
#define NRM_LOAD(ii) do { const int wh_ = (ii) & 1, r_ = (ii) >> 1; if (lane < (wh_ ? 32 : 48)) xq = *(const uint2*)(PB + (size_t)r_ * IN_COLS + (wh_ ? C_CKV : C_CQ) + lane * 4); } while (0)
            if (i < NTOK * 2) NRM_LOAD(i);
            for (; i < NTOK * 2; i += wstride) {
                const int which = i & 1, r = i >> 1; const int n4 = which ? 32 : 48;
                const float4* w = (const float4*)(which ? kvn : qn);
                float4 x = make_float4(0.f, 0.f, 0.f, 0.f); if (lane < n4) x = up4(xq);
                if (i + wstride < NTOK * 2) NRM_LOAD(i + wstride);
                const float ss = wave_sum(f4dot(x, x));
                const float rs = 1.0f / sqrtf(ss / (n4 * 4) + EPS);
                bf16_t* dst = which ? CKVB + (size_t)r * 128 : CQB + (size_t)r * 256;
                if (lane < n4) *(uint2*)(dst + lane * 4) = pk4(f4scale(f4mul(x, w[lane]), rs));
                else if (!which) { const unsigned z_ = (unsigned)tid >> 20; *(uint2*)(dst + lane * 4) = make_uint2(z_, z_); }
            }
#undef NRM_LOAD
            }
            GSYNC();
        }
        {
            PHASE_BEGIN();
            const int half = (G * 5) / 8;
            if (bid < half) {
                pg8::Gemm g{CQB, WQ_T, NTOK, 512, 256, 0, 0}; pg8::StaticOrder so; so.init(NTOK, 512, half, bid);
                pg8::EpiBf16 E{MQ, 384, 384};
                pg8::gemm_phase<pg8::EpiBf16, pg8::StaticOrder, true, true>(ldsb, g, so, E, tid);
            } else {
                pg8::Gemm g{CKVB, WKV_T, NTOK, 512, 128, 0, 0}; pg8::StaticOrder so; so.init(NTOK, 512, G - half, bid - half);
                pg8::EpiBf16 E{MKV, 512, 512};
                pg8::gemm_phase<pg8::EpiBf16, pg8::StaticOrder, true, true>(ldsb, g, so, E, tid);
            }
            for (int it = vcu; it < NB * NCH * 8; it += G) {
                const int hp = it & 3, dir = (it >> 2) & 1, cp = (it >> 3) % NCH, b = it / (8 * NCH);
                const int k = dir ? (cp < 2 ? 1 - cp : 35 - cp) : cp;
                if (k == NCH - 1) continue;
                ssd_block<false>(b, dir, k, hp, XBC, DT, kp_->in[I_ALOG] + l * 16, HS, ALAST, nullptr, (float*)lds_raw, tid);
            }
            GSYNC();
        }
        {
            PHASE_BEGIN();
            ITEMS(i, NTOK * 8) {
                const int g = i & 7, r = i >> 3; const int hh = g & 3, isk = g >> 2;
                const bool lat = r < NLAT; const int b = lat ? r / S : (r - NLAT) / CTX, t = lat ? r % S : (r - NLAT) % CTX;
                if (!isk && !lat && !ctx_out) continue;
                const bf16_t* npb = isk ? MKV + (size_t)r * 512 + hh * 128 : MQ + (size_t)r * 384 + hh * 96;
                const bf16_t* rp = isk ? PB + (size_t)r * IN_COLS + C_KR : npb + 64;
                float v[32], np[64];
#pragma unroll
                for (int k = 0; k < 32; k += 4) { const float4 x = ld4h(rp + k); v[k] = x.x; v[k + 1] = x.y; v[k + 2] = x.z; v[k + 3] = x.w; }
#pragma unroll
                for (int k = 0; k < 64; k += 4) { const float4 x = ld4h(npb + k); np[k] = x.x; np[k + 1] = x.y; np[k + 2] = x.z; np[k + 3] = x.w; }
                if (lat) rope32(v, t, ROPE);
                const float sc = isk ? 1.0f : 0.10206207261596575f * 1.4426950408889634f;
                bf16_t* dst = isk ? KM + ((size_t)(b * 4 + hh) * SK + (lat ? CTX + t : t)) * 96 : (lat ? QM + ((size_t)(b * 4 + hh) * S + t) * 96 : QMC + ((size_t)(b * 4 + hh) * CTX + t) * 96);
#pragma unroll
                for (int k = 0; k < 64; k += 8) *(uint4*)(dst + k) = make_uint4(pk2(np[k] * sc, np[k + 1] * sc), pk2(np[k + 2] * sc, np[k + 3] * sc), pk2(np[k + 4] * sc, np[k + 5] * sc), pk2(np[k + 6] * sc, np[k + 7] * sc));
#pragma unroll
                for (int k = 0; k < 32; k += 8) *(uint4*)(dst + 64 + k) = make_uint4(pk2(v[k] * sc, v[k + 1] * sc), pk2(v[k + 2] * sc, v[k + 3] * sc), pk2(v[k + 4] * sc, v[k + 5] * sc), pk2(v[k + 6] * sc, v[k + 7] * sc));
            }
            ITEMS(i, NB * 4 * (SK / 8) * 64) {
                const int d = i & 63, j8 = (i >> 6) % (SK / 8), hh = (i / (64 * (SK / 8))) & 3, b = i / (256 * (SK / 8));
                const int r0 = j8 * 8 < CTX ? tok_row(false, b, j8 * 8) : tok_row(true, b, j8 * 8 - CTX);
                const bf16_t* sp = MKV + (size_t)r0 * 512 + hh * 128 + 64 + d;
                unsigned v[8];
#pragma unroll
                for (int jj = 0; jj < 8; ++jj) v[jj] = sp[(size_t)jj * 512];
                *(uint4*)(VMT + ((size_t)(b * 4 + hh) * 64 + d) * SK + j8 * 8) = make_uint4(v[0] | (v[1] << 16), v[2] | (v[3] << 16), v[4] | (v[5] << 16), v[6] | (v[7] << 16));
            }
            ITEMS(i, NB * 2 * 8 * 4096) {
                const int e = i & 4095, h = (i >> 12) & 7, bd = i >> 15;
                float* hp0 = HS + ((size_t)bd * NCH * 8 + h) * 4096 + e; const float* al0 = ALAST + (size_t)bd * NCH * 8 + h;
                float sv[NCH - 1], dk[NCH - 1];
#pragma unroll
                for (int k = 0; k < NCH - 1; ++k) { sv[k] = hp0[(size_t)k * 8 * 4096]; dk[k] = al0[k * 8]; }
                float Hc = 0.f;
#pragma unroll
                for (int k = 0; k < NCH; ++k) { hp0[(size_t)k * 8 * 4096] = Hc; if (k < NCH - 1) Hc = Hc * __expf(dk[k]) + sv[k]; }
            }
            GSYNC();
        }
        {
            PHASE_BEGIN();
            for (int kq = 0; kq * G < NB * 2 * NCH * 4; ++kq) {
                int it = vcu + kq * G;
                { const int T_ = NB * 2 * NCH * 4, full_ = (T_ / G) * G, rem_ = T_ - full_;
                  if (ctx_out && kq * G == full_) it = vcu >= G - rem_ ? full_ + vcu - (G - rem_) : T_; }
                if (it >= NB * 2 * NCH * 4) continue;
                const int hp = it & 3, dir = (it >> 2) & 1, cp = (it >> 3) % NCH, b = it / (8 * NCH);
                const int k = dir ? (cp < 2 ? 1 - cp : 35 - cp) : cp;
                if (k < 2 && !ctx_out) continue;
                ssd_block<true>(b, dir, k, hp, XBC, DT, kp_->in[I_ALOG] + l * 16, HS, ALAST, YD, (float*)lds_raw, tid);
            }
            const int lane = tid & 63, wave = tid >> 6, qr = lane & 31, hf = lane >> 5;
            {
                const float* lq1 = kp_->in[I_LQ1] + l * 32; const float* lk1 = kp_->in[I_LK1] + l * 32; const float* lq2 = kp_->in[I_LQ2] + l * 32; const float* lk2 = kp_->in[I_LK2] + l * 32;
                const float* subw = kp_->in[I_SUBLN] + l * 64;
                const int nlat = NB * 4 * (S / 256), nit = nlat + (ctx_out ? NB * 4 : 0);
                for (int it = vcu; it < nit; it += G) {
                    const bool lat = it < nlat; const int u = lat ? it : it - nlat;
                    const int qb = lat ? u % (S / 256) : 0, hh = lat ? (u / (S / 256)) % 4 : u % 4, b = lat ? u / (4 * (S / 256)) : u / 4;
                    const int t = qb * 256 + wave * 32 + qr; const int row = tok_row(lat, b, t); const int nkt = lat ? SK / 64 : CTX / 64;
                    f32x16 oacc[2]; unsigned o1p[2][8];
#pragma unroll 1
                    for (int mp = 0; mp < 2; ++mp) {
                        const int hm = hh * 2 + mp;
                        const bf16_t* qrow = lat ? QD + ((size_t)(b * 8 + hm) * S + t) * 32 : QDC + ((size_t)(b * 8 + hm) * CTX + t) * 32;
                        float l_run = 0.f;
#pragma unroll
                        for (int i = 0; i < 16; ++i) { oacc[0][i] = 0.f; oacc[1][i] = 0.f; }
                        attn_pass<32>(qrow, KD + (size_t)(b * 8 + hm) * SK * 32, VDT + (size_t)(b * 4 + hh) * 64 * SK, SK, nkt, ldsb, tid, oacc, l_run);
                        l_run = xor32_sum(l_run);
                        if (mp == 0) { const float i1 = 1.0f / l_run;
#pragma unroll
                            for (int db = 0; db < 2; ++db)
#pragma unroll
                                for (int i = 0; i < 8; ++i) o1p[db][i] = pk2(oacc[db][2 * i] * i1, oacc[db][2 * i + 1] * i1); }
                        else {
                            float d1 = 0.f, d2 = 0.f; for (int k = 0; k < 32; ++k) { d1 += lq1[k] * lk1[k]; d2 += lq2[k] * lk2[k]; }
                            const float lam = expf(d1) - expf(d2) + lambda_init;
                            const float i2 = lam / l_run; float ss = 0.f; f32x16 o1[2];
#pragma unroll
                            for (int db = 0; db < 2; ++db)
#pragma unroll
                                for (int i = 0; i < 16; ++i) { const float a1 = __uint_as_float((i & 1) ? (o1p[db][i >> 1] & 0xffff0000u) : (o1p[db][i >> 1] << 16)); const float v = a1 - oacc[db][i] * i2; o1[db][i] = v; ss += v * v; }
                            ss = xor32_sum(ss);
                            const float rs = (1.0f - lambda_init) / sqrtf(ss / 64 + EPS);
                            bf16_t* orow = MIXB + (size_t)row * MIXW + 512 + hh * 64;
#pragma unroll
                            for (int db = 0; db < 2; ++db)
#pragma unroll
                                for (int gq = 0; gq < 4; ++gq) { const int d0 = 32 * db + 8 * gq + 4 * hf; const float4 w4 = *(const float4*)(subw + d0);
                                    *(uint2*)(orow + d0) = make_uint2(pk2(o1[db][4 * gq] * rs * w4.x, o1[db][4 * gq + 1] * rs * w4.y), pk2(o1[db][4 * gq + 2] * rs * w4.z, o1[db][4 * gq + 3] * rs * w4.w)); }
                        }
                    }
                }
            }
            {
                const int nlat = NB * 4 * (S / 256), nit = nlat + (ctx_out ? NB * 4 : 0);
                for (int it = vcu; it < nit; it += G) {
                    const bool lat = it < nlat; const int u = lat ? it : it - nlat;
                    const int qb = lat ? u % (S / 256) : 0, hh = lat ? (u / (S / 256)) % 4 : u % 4, b = lat ? u / (4 * (S / 256)) : u / 4;
                    const int t = qb * 256 + wave * 32 + qr; const int row = tok_row(lat, b, t); const int nkt = lat ? SK / 64 : CTX / 64;
                    const bf16_t* qrow = lat ? QM + ((size_t)(b * 4 + hh) * S + t) * 96 : QMC + ((size_t)(b * 4 + hh) * CTX + t) * 96;
                    f32x16 oacc[2]; float l_run = 0.f;
#pragma unroll
                    for (int i = 0; i < 16; ++i) { oacc[0][i] = 0.f; oacc[1][i] = 0.f; }
                    attn_pass<96>(qrow, KM + (size_t)(b * 4 + hh) * SK * 96, VMT + (size_t)(b * 4 + hh) * 64 * SK, SK, nkt, ldsb, tid, oacc, l_run);
                    l_run = xor32_sum(l_run);
                    const float inv = 1.0f / l_run;
                    bf16_t* orow = MIXB + (size_t)row * MIXW + 768 + hh * 64;
#pragma unroll
                    for (int db = 0; db < 2; ++db)
#pragma unroll
                        for (int gq = 0; gq < 4; ++gq) { const int d0 = 32 * db + 8 * gq + 4 * hf;
                            *(uint2*)(orow + d0) = make_uint2(pk2(oacc[db][4 * gq] * inv, oacc[db][4 * gq + 1] * inv), pk2(oacc[db][4 * gq + 2] * inv, oacc[db][4 * gq + 3] * inv)); }
                }
            }
            GSYNC();
        }
        {
            PHASE_BEGIN();
            const float* nw = kp_->in[I_SSDN] + l * 512; const float* dsk = kp_->in[I_SSDD] + l * 8;
            const int lane = tid & 63;
            uint2 q0, q1, q2, q3; { const unsigned z_ = (unsigned)tid >> 20; q0 = make_uint2(z_, z_); q1 = q0; q2 = q0; q3 = q0; }
            const int wstride = gridDim.x * 8; int i = blockIdx.x * 8 + (tid >> 6);
#define GN_LOAD(ii) do { const int g_ = (ii) & 1, r_ = (ii) >> 1, c_ = g_ * 256 + lane * 4; q0 = *(const uint2*)(XBC + (size_t)r_ * 768 + c_); q1 = *(const uint2*)(YD + (size_t)r_ * 512 + c_); \
                q2 = *(const uint2*)(YD + ((size_t)NTOK + r_) * 512 + c_); q3 = *(const uint2*)(PB + (size_t)r_ * IN_COLS + C_Z + c_); } while (0)
            if (i < nrows_out * 2) GN_LOAD(i);
            for (; i < nrows_out * 2; i += wstride) {
                const int g = i & 1, r = i >> 1, c = g * 256 + lane * 4;
                const float4 x = up4(q0), y0 = up4(q1), y1 = up4(q2), z = up4(q3);
                if (i + wstride < nrows_out * 2) GN_LOAD(i + wstride);
                const float ds = dsk[c >> 6];
                float4 v = make_float4((ds * x.x + y0.x + y1.x) * siluf(z.x), (ds * x.y + y0.y + y1.y) * siluf(z.y), (ds * x.z + y0.z + y1.z) * siluf(z.z), (ds * x.w + y0.w + y1.w) * siluf(z.w));
                const float ss = wave_sum(f4dot(v, v));
                const float rs = 1.0f / sqrtf(ss / 256 + EPS);
                *(uint2*)(MIXB + (size_t)r * MIXW + c) = pk4(f4scale(f4mul(v, *(const float4*)(nw + c)), rs));
            }
#undef GN_LOAD
            GSYNC();
        }
        {
            PHASE_BEGIN();
            pg8::Gemm g{MIXB, WOUT_T, nrows_out, D, MIXW, 0, 0}; pg8::StaticOrder so; so.init(nrows_out, D, G, bid);
            pg8::EpiBf16 E{MOUT, D, D};
            pg8::gemm_phase<pg8::EpiBf16, pg8::StaticOrder, true, true>(ldsb, g, so, E, tid);
            { const int nwg = (nrows_out / 256) * (D / 256), busy = nwg % G; const int id0 = moe_done;
              if (busy != 0 && bid >= busy) CVT_MOE_RANGE(l, id0, id0 + (G - busy) * 8 * CVT_PER_WAVE, (bid - busy) * 8 + (tid >> 6), (G - busy) * 8);
              if (busy != 0) moe_done = id0 + (G - busy) * 8 * CVT_PER_WAVE; }
            GSYNC();
        }
        {
            PHASE_BEGIN();
            const float* wpost = kp_->in[I_NMPOST] + l * D; const float* wpre = kp_->in[I_NFPRE] + l * D;
            const float* rw = kp_->in[I_RW] + (size_t)l * D * NE; const float* rb = kp_->in[I_RB] + l * NE;
            const int lane = tid & 63;
            float* rwl = (float*)lds_raw;
            for (int i = tid; i < D * NE / 4; i += NTHREADS) { const int k = i >> 2, e4 = i & 3; ((float4*)rwl)[(((k & 3) * 256 + (k >> 2)) << 2) + e4] = ((const float4*)rw)[i]; }
            float4* aux = (float4*)(rwl + D * NE);
            for (int i = tid; i < 17 * (D / 4); i += NTHREADS) { const int v = i / (D / 4), k4 = i % (D / 4);
                const float* src = v == 0 ? wpost : v == 1 ? wpre : modl + (size_t)((v - 2) % 5) * NMOD * D + (2 + (v - 2) / 5) * D;
                aux[i] = ((const float4*)src)[k4]; }
            __syncthreads();
            uint2 mq[4]; float4 xq[4];
            { const float zf_ = (float)(tid >> 20);
#pragma unroll
              for (int i = 0; i < 4; ++i) { xq[i] = make_float4(zf_, zf_, zf_, zf_); mq[i] = make_uint2((unsigned)tid >> 20, (unsigned)tid >> 20); } }
            const int wstride = gridDim.x * 8; int r = blockIdx.x * 8 + (tid >> 6);
#define P7_LOAD(rr) do { const float4* xin_ = (const float4*)((rr) < NLAT ? XSRC + (size_t)(rr) * D : CSRC + (size_t)((rr) - NLAT) * D); const bf16_t* m_ = MOUT + (size_t)(rr) * D; \
                _Pragma("unroll") for (int i = 0; i < 4; ++i) { mq[i] = *(const uint2*)(m_ + (i * 64 + lane) * 4); xq[i] = xin_[i * 64 + lane]; } } while (0)
            if (r < nrows_out) P7_LOAD(r);
            for (; r < nrows_out; r += wstride) {
                float4* xr = (float4*)(r < NLAT ? xcur + (size_t)r * D : CTXC + (size_t)(r - NLAT) * D);
                const int bsel = r < NLAT ? r / S : NB;
                float4 mv[4], xv[4]; float ss = 0.f;
#pragma unroll
                for (int i = 0; i < 4; ++i) { mv[i] = up4(mq[i]); xv[i] = xq[i]; ss += f4dot(mv[i], mv[i]); }
                if (r + wstride < nrows_out) P7_LOAD(r + wstride);
                ss = wave_sum(ss);
                const float rs = 1.0f / sqrtf(ss / D + EPS);
                float s2 = 0.f;
#pragma unroll
                for (int i = 0; i < 4; ++i) { const int k4 = i * 64 + lane;
                    xv[i] = f4add(xv[i], f4mul(aux[(2 + bsel) * (D / 4) + k4], f4scale(f4mul(mv[i], aux[k4]), rs))); xr[k4] = xv[i]; s2 += f4dot(xv[i], xv[i]); }
                s2 = wave_sum(s2);
                const float r2 = 1.0f / sqrtf(s2 / D + EPS);
                float lg[NE];
#pragma unroll
                for (int e = 0; e < NE; ++e) lg[e] = 0.f;
#pragma unroll
                for (int i = 0; i < 4; ++i) { const int k4 = i * 64 + lane; const float4 w4 = aux[(D / 4) + k4], sc = aux[(12 + bsel) * (D / 4) + k4], sh = aux[(7 + bsel) * (D / 4) + k4];
                    const float hv[4] = {xv[i].x * r2 * w4.x * (1.0f + sc.x) + sh.x, xv[i].y * r2 * w4.y * (1.0f + sc.y) + sh.y, xv[i].z * r2 * w4.z * (1.0f + sc.z) + sh.z, xv[i].w * r2 * w4.w * (1.0f + sc.w) + sh.w};
                    *(uint2*)(HB + (size_t)r * D + k4 * 4) = make_uint2(pk2(hv[0], hv[1]), pk2(hv[2], hv[3]));
#pragma unroll
                    for (int c = 0; c < 4; ++c) { const float4* rwp = (const float4*)(rwl + (size_t)(c * 256 + k4) * NE);
#pragma unroll
                        for (int e4 = 0; e4 < 4; ++e4) { const float4 w = rwp[e4]; lg[4 * e4] += hv[c] * w.x; lg[4 * e4 + 1] += hv[c] * w.y; lg[4 * e4 + 2] += hv[c] * w.z; lg[4 * e4 + 3] += hv[c] * w.w; }
                        SCHED_FENCE(); }
                }
#pragma unroll
                for (int e = 0; e < NE; ++e) lg[e] = wave_sum(lg[e]) + rb[e];
                float mx = lg[0];
#pragma unroll
                for (int e = 1; e < NE; ++e) mx = fmaxf(mx, lg[e]);
                float sum = 0.f;
#pragma unroll
                for (int e = 0; e < NE; ++e) { lg[e] = expf(lg[e] - mx); sum += lg[e]; }
                const float is = 1.0f / sum;
                float mine = lg[0];
#pragma unroll
                for (int e = 1; e < NE; ++e) mine = lane == e ? lg[e] : mine;
                if (lane < NE) AFF[(size_t)r * NE + lane] = mine * is;
            }
#undef P7_LOAD
            GSYNC();
        }
        {
            PHASE_BEGIN();
            CVT_MOE_RANGE(l, moe_done, MOE_TILES, bid * 8 + (tid >> 6), G * 8);
            {
                volatile int* sh = (volatile int*)lds_raw;
                const int nsel = (ctx_out ? 2 : 1) * NB * NE;
                for (int it = bid; it < nsel; it += G) {
                    const bool lat = it < NB * NE; const int u = lat ? it : it - NB * NE; const int e = u % NE, b = u / NE;
                    const int L = lat ? S : CTX, cap = lat ? CAP_L : CAP_C, npt = lat ? S / NTHREADS : 1, base = tok_row(lat, b, 0);
                    const bool act = lat || tid < CTX;
                    unsigned key[S / NTHREADS];
#pragma unroll
                    for (int i = 0; i < S / NTHREADS; ++i) key[i] = (act && i < npt) ? __float_as_uint(AFF[(size_t)(base + tid * npt + i) * NE + e]) : 0u;
                    __syncthreads();
                    unsigned T = 0u;
                    for (int bit = 30; bit >= 0; --bit) {
                        const unsigned cand = T | (1u << bit); int c = 0;
#pragma unroll
                        for (int i = 0; i < S / NTHREADS; ++i) c += (key[i] >= cand) ? 1 : 0;
                        if (block_sum(c, tid, sh, bit & 1) >= cap) T = cand;
                    }
                    int cg = 0, ct = 0;
#pragma unroll
                    for (int i = 0; i < S / NTHREADS; ++i) { cg += (key[i] > T) ? 1 : 0; ct += (key[i] == T && key[i] != 0u) ? 1 : 0; }
                    int tot_g, tot_t;
                    (void)block_excl_scan(cg, tid, sh, tot_g);
                    int tie_rank = block_excl_scan(ct, tid, sh, tot_t);
                    const int need = cap - tot_g;
                    int sel[S / NTHREADS], cs = 0;
#pragma unroll
                    for (int i = 0; i < S / NTHREADS; ++i) { const bool tie = key[i] == T && key[i] != 0u; sel[i] = (key[i] > T || (tie && tie_rank < need)) ? 1 : 0; tie_rank += tie ? 1 : 0; cs += sel[i]; }
                    int tot_s; int slot = block_excl_scan(cs, tid, sh, tot_s);
#pragma unroll
                    for (int i = 0; i < S / NTHREADS; ++i) if (act && i < npt) {
                        const int row = base + tid * npt + i; int sa = -1;
                        if (sel[i]) { sa = (lat ? b * CAP_L : NB * CAP_L + b * CAP_C) + slot; ++slot; SELIDX[e * ER_MAX + sa] = row; SELGATE[e * ER_MAX + sa] = __uint_as_float(key[i]); }
                        TOKSLOT[(size_t)row * NE + e] = sa;
                    }
                }
            }
            GSYNC();
        }
        {
            PHASE_BEGIN();
            const int used = ctx_out ? NB * (CAP_L + CAP_C) : NB * CAP_L;
            {
                const int lane = tid & 63, wstride = gridDim.x * 8, nrow = NE * ER;
                for (int r0 = (blockIdx.x * 8 + (tid >> 6)) * 4; r0 < nrow; r0 += wstride * 4) {
                    int src[4]; uint4 v0[4], v1[4];
#pragma unroll
                    for (int q = 0; q < 4; ++q) { const int rr = r0 + q, e = rr / ER, slot = rr % ER; src[q] = (rr < nrow && slot < used) ? SELIDX[e * ER_MAX + slot] : -1; }
#pragma unroll
                    for (int q = 0; q < 4; ++q) { const unsigned z_ = (unsigned)tid >> 20; v0[q] = make_uint4(z_, z_, z_, z_); v1[q] = v0[q];
                        if (src[q] >= 0) { const uint4* sp = (const uint4*)(HB + (size_t)src[q] * D); v0[q] = sp[lane]; v1[q] = sp[64 + lane]; } }
#pragma unroll
                    for (int q = 0; q < 4; ++q) if (r0 + q < nrow) { uint4* dp = (uint4*)(XG + (size_t)(r0 + q) * D); dp[lane] = v0[q]; dp[64 + lane] = v1[q]; }
                }
            }
            GSYNC();
        }
        {
            PHASE_BEGIN();
            pg8::Gemm g{XG, WGU_T, NE * ER, 2 * FF, D, ER / 256, (size_t)2 * FF * D * 2}; pg8::StaticOrder so; so.init(NE * ER, 2 * FF, G, bid);
            pg8::EpiSwiGLU E{HID, FF};
            pg8::gemm_phase<pg8::EpiSwiGLU, pg8::StaticOrder, true, true>(ldsb, g, so, E, tid);
            GSYNC();
        }
        {
            PHASE_BEGIN();
            pg8::Gemm g{HID, WD_T, NE * ER, D, FF, ER / 256, (size_t)D * FF * 2}; pg8::StaticOrder so; so.init(NE * ER, D, G, bid);
            pg8::EpiRowScaleBf16 E{Y, D, SELGATE, ER};
            pg8::gemm_phase<pg8::EpiRowScaleBf16, pg8::StaticOrder, true, true>(ldsb, g, so, E, tid);
            GSYNC();
        }
        {
            PHASE_BEGIN();
            const float* wpost = kp_->in[I_NFPOST] + l * D;
            const int lane = tid & 63;
            {
                float4 xq[4]; int slq = -1;
                { const float zf_ = (float)(tid >> 20);
#pragma unroll
                  for (int i = 0; i < 4; ++i) xq[i] = make_float4(zf_, zf_, zf_, zf_); }
                float4* aux = (float4*)lds_raw;
                __syncthreads();
                for (int i = tid; i < 6 * (D / 4); i += NTHREADS) { const int v = i / (D / 4), k4 = i % (D / 4);
                    const float* src = v == 0 ? wpost : modl + (size_t)(v - 1) * NMOD * D + 5 * D;
                    aux[i] = ((const float4*)src)[k4]; }
                __syncthreads();
                const int wstride = gridDim.x * 8; int r = blockIdx.x * 8 + (tid >> 6);
#define P11_LOAD(rr) do { const float4* xin_ = (const float4*)((rr) < NLAT ? xcur + (size_t)(rr) * D : CTXC + (size_t)((rr) - NLAT) * D); slq = lane < NE ? TOKSLOT[(size_t)(rr) * NE + lane] : -1; \
                    _Pragma("unroll") for (int i = 0; i < 4; ++i) xq[i] = xin_[i * 64 + lane]; } while (0)
                if (r < nrows_out) P11_LOAD(r);
                for (; r < nrows_out; r += wstride) {
                    float4* xr = (float4*)(r < NLAT ? xcur + (size_t)r * D : CTXC + (size_t)(r - NLAT) * D);
                    const int bsel = r < NLAT ? r / S : NB;
                    const int myslot = slq; float4 xv[4], f[4];
#pragma unroll
                    for (int i = 0; i < 4; ++i) { xv[i] = xq[i]; f[i] = make_float4(0.f, 0.f, 0.f, 0.f); }
#pragma unroll
                    for (int e = 0; e < NE; ++e) {
                        const int sl = __builtin_amdgcn_readlane(myslot, e);
                        if (sl >= 0) { const bf16_t* yp = Y + ((size_t)e * ER + sl) * D;
#pragma unroll
                            for (int i = 0; i < 4; ++i) f[i] = f4add(f[i], ld4h(yp + (i * 64 + lane) * 4)); }
                    }
                    if (r + wstride < nrows_out) P11_LOAD(r + wstride);
                    float ss = 0.f;
#pragma unroll
                    for (int i = 0; i < 4; ++i) ss += f4dot(f[i], f[i]);
                    ss = wave_sum(ss);
                    const float rs = 1.0f / sqrtf(ss / D + EPS);
#pragma unroll
                    for (int i = 0; i < 4; ++i) { const int k4 = i * 64 + lane; xr[k4] = f4add(xv[i], f4mul(aux[(1 + bsel) * (D / 4) + k4], f4scale(f4mul(f[i], aux[k4]), rs))); }
                }
#undef P11_LOAD
            }
            GSYNC();
        }
    }
}

extern "C" void kernel_launch(void* const* d_in, const int* in_sizes, int n_in, void* d_out, int out_size, void* d_ws, size_t ws_size, hipStream_t stream) {
    static int grid = 0;
    if (grid == 0) {
        if (n_in != N_IN || out_size != NLAT * D || ws_size < WS_END) { fprintf(stderr, "kernel_launch: unexpected shapes: n_in %d out %d ws %zu (need %zu)\n", n_in, out_size, ws_size, (size_t)WS_END); grid = -1; return; }
        int dev = 0, cus = 0, per_cu = 0;
        (void)hipGetDevice(&dev);
        (void)hipDeviceGetAttribute(&cus, hipDeviceAttributeMultiprocessorCount, dev);
        (void)hipFuncSetAttribute((const void*)mk_forward, hipFuncAttributeMaxDynamicSharedMemorySize, LDS_BYTES);
        (void)hipOccupancyMaxActiveBlocksPerMultiprocessor(&per_cu, (const void*)mk_forward, NTHREADS, LDS_BYTES);
        (void)hipGetLastError();
        if (per_cu < 1) { fprintf(stderr, "kernel_launch: occupancy query says %d blocks/CU\n", per_cu); grid = -1; return; }
        grid = cus;
    }
    if (grid < 0) return;
    (void)hipMemsetAsync((char*)d_ws + WS_CTL, 0, CTL_BYTES, stream);
    Prm p{};
    for (int i = 0; i < N_IN; ++i) p.in[i] = (const float*)d_in[i];
    p.out = (float*)d_out; p.ws = (char*)d_ws;
    void* args[] = {&p};
    hipError_t e = hipLaunchCooperativeKernel((const void*)mk_forward, dim3(grid), dim3(NTHREADS), args, LDS_BYTES, stream);
    if (e != hipSuccess) fprintf(stderr, "kernel_launch: cooperative launch failed: %s (grid %d)\n", hipGetErrorString(e), grid);
}
```

```cpp
#include <hip/hip_runtime.h>
#include <cstdio>
#include <cstdint>

constexpr int D = 1024, NB = 4, S = 4096, CTX = 256, FF = 1024;
constexpr int DEPTH = 2, GRID_W = 64, NMOD = 6, NE = 16;
constexpr int NLAT = NB * S, NCTX = NB * CTX, NTOK = NLAT + NCTX;
constexpr int IN_COLS = 2416, IN_PAD = 2560;
constexpr int C_Z = 0, C_XBC = 512, C_DT = 1280, C_DQ = 1296, C_DK = 1552, C_DV = 1808, C_CQ = 2064, C_CKV = 2256, C_KR = 2384;
constexpr int MIXW = 1024;
constexpr int CAP_L = 2 * S / NE, CAP_C = 2 * CTX / NE;
constexpr int ER_MAX = 2304;
constexpr float EPS = 1e-6f;
static_assert(NB * CAP_L == 2048 && NB * CAP_C == 128, "expert row layout");

enum { I_X = 0, I_C, I_CTX, I_CCTX, I_ADAW, I_ADAB, I_NMPRE, I_NMPOST, I_NFPRE, I_NFPOST, I_WIN, I_CONVW, I_CONVB, I_ALOG, I_DTB, I_SSDD, I_SSDN,
       I_LQ1, I_LK1, I_LQ2, I_LK2, I_SUBLN, I_QNORM, I_WQUP, I_KVNORM, I_WKVUP, I_WOUT, I_RW, I_RB, I_WG, I_WU, I_WD, N_IN };
struct Prm { const float* in[N_IN]; float* out; char* ws; };

typedef unsigned short bf16_t;
constexpr size_t al256(size_t x) { return (x + 255) & ~(size_t)255; }
constexpr size_t WS_CTL = 0, CTL_BYTES = 65536;
constexpr size_t WS_MOD = WS_CTL + CTL_BYTES;
constexpr size_t WS_CTXC = al256(WS_MOD + (size_t)DEPTH * (NB + 1) * NMOD * D * 4);
constexpr size_t WS_AFF = al256(WS_CTXC + (size_t)NCTX * D * 4);
constexpr size_t WS_TOKSLOT = al256(WS_AFF + (size_t)NTOK * NE * 4);
constexpr size_t WS_SELIDX = al256(WS_TOKSLOT + (size_t)NTOK * NE * 4);
constexpr size_t WS_SELGATE = al256(WS_SELIDX + (size_t)NE * ER_MAX * 4);
constexpr size_t WS_DT = al256(WS_SELGATE + (size_t)NE * ER_MAX * 4);
constexpr int NCH = 34;
constexpr size_t WS_ROPE = al256(WS_DT + (size_t)NTOK * 16 * 4);
constexpr size_t WS_ALAST = al256(WS_ROPE + (size_t)S * 32 * 4);
constexpr size_t WS_HB = al256(WS_ALAST + (size_t)NB * 2 * NCH * 8 * 4);
constexpr size_t WS_P = al256(WS_HB + (size_t)NTOK * D * 2);
constexpr size_t WS_G2 = al256(WS_P + (size_t)NTOK * IN_COLS * 4);
constexpr size_t WS_XBC = WS_G2;
constexpr size_t WS_MQ = al256(WS_XBC + (size_t)NTOK * 768 * 4);
constexpr size_t WS_MKV = al256(WS_MQ + (size_t)NTOK * 384 * 4);
constexpr size_t WS_CQB = al256(WS_MKV + (size_t)NTOK * 512 * 4);
constexpr size_t WS_CKVB = al256(WS_CQB + (size_t)NTOK * 256 * 2);
constexpr size_t WS_MIXB = al256(WS_CKVB + (size_t)NTOK * 128 * 2);
constexpr size_t WS_G2END = al256(WS_MIXB + (size_t)NTOK * MIXW * 2);
constexpr size_t WS_HS = WS_HB;
constexpr size_t WS_YD = WS_MQ;
constexpr size_t WS_MOUT = WS_P;
constexpr size_t WS_XG = WS_P;
constexpr size_t WS_HID = al256(WS_XG + (size_t)NE * ER_MAX * D * 2);
constexpr size_t WS_Y = WS_G2;
constexpr size_t WS_WIN = WS_G2END;
constexpr size_t WS_WQ = al256(WS_WIN + (size_t)IN_PAD * D * 2);
constexpr size_t WS_WKV = al256(WS_WQ + (size_t)512 * 256 * 2);
constexpr size_t WS_WOUT = al256(WS_WKV + (size_t)512 * 128 * 2);
constexpr size_t WS_WGU = al256(WS_WOUT + (size_t)D * MIXW * 2);
constexpr size_t WS_WD = al256(WS_WGU + (size_t)NE * 2 * FF * D * 2);
constexpr size_t WS_END = al256(WS_WD + (size_t)NE * D * FF * 2);
constexpr int SK = CTX + S;
constexpr size_t WS_QD = al256(WS_P + (size_t)NTOK * IN_COLS * 2);
constexpr size_t WS_QDC = al256(WS_QD + (size_t)NB * 8 * S * 32 * 2);
constexpr size_t WS_KD = al256(WS_QDC + (size_t)NB * 8 * CTX * 32 * 2);
constexpr size_t WS_VDT = al256(WS_KD + (size_t)NB * 8 * SK * 32 * 2);
constexpr size_t WS_QM = al256(WS_VDT + (size_t)NB * 4 * 64 * SK * 2);
constexpr size_t WS_QMC = al256(WS_QM + (size_t)NB * 4 * S * 96 * 2);
constexpr size_t WS_KM = al256(WS_QMC + (size_t)NB * 4 * CTX * 96 * 2);
constexpr size_t WS_VMT = al256(WS_KM + (size_t)NB * 4 * SK * 96 * 2);
constexpr size_t WS_ATTEND = al256(WS_VMT + (size_t)NB * 4 * 64 * SK * 2);
static_assert(WS_ATTEND <= WS_G2, "attention operands fit in the spare half of the P slot");
static_assert(WS_HID + (size_t)NE * ER_MAX * FF * 2 <= WS_G2, "XG+HID fit in the P region");
static_assert((size_t)NE * ER_MAX * D * 4 <= WS_G2END - WS_G2, "Y fits in the G2 region");
static_assert((size_t)NB * 2 * NCH * 8 * 4096 * 4 <= (size_t)NTOK * D * 2, "HS fits in HB");
static_assert(WS_YD + (size_t)2 * NTOK * 512 * 4 <= WS_MIXB, "YD ends below MIXB");

#define LAS __attribute__((address_space(3)))
constexpr int NTHREADS = 512;
constexpr int LDS_BYTES = 147456;
#define ITEMS(i, n) for (int i = blockIdx.x * NTHREADS + tid; i < (n); i += gridDim.x * NTHREADS)

__device__ __forceinline__ float siluf(float x) { return x / (1.0f + expf(-x)); }
__device__ __forceinline__ float softplusf(float x) { return x > 20.f ? x : log1pf(expf(x)); }
__device__ __forceinline__ unsigned f2bf(float f) { unsigned u = __builtin_bit_cast(unsigned, f); return (u + 0x7fffu + ((u >> 16) & 1u)) >> 16; }
typedef float f32x2_t __attribute__((ext_vector_type(2)));
typedef __bf16 bf16x2_t __attribute__((ext_vector_type(2)));
__device__ __forceinline__ unsigned pk2(float lo, float hi) { const f32x2_t v = {lo, hi}; return __builtin_bit_cast(unsigned, __builtin_convertvector(v, bf16x2_t)); }
__device__ __forceinline__ float bf2f(bf16_t h) { return __builtin_bit_cast(float, (unsigned)h << 16); }
#define SCHED_FENCE() __builtin_amdgcn_sched_barrier(0)
__device__ __forceinline__ int mk_tid_impl(int wave_s) { unsigned z; asm volatile("s_mov_b32 %0, 0" : "=s"(z));
    return (wave_s << 6) | (int)__builtin_amdgcn_mbcnt_hi(~0u, __builtin_amdgcn_mbcnt_lo(~0u, z)); }
__device__ __forceinline__ float dpp_row_shr(float v, int n) {
    const int iv = __builtin_bit_cast(int, v); int r;
    switch (n) { case 1: r = __builtin_amdgcn_update_dpp(0, iv, 0x111, 0xf, 0xf, true); break; case 2: r = __builtin_amdgcn_update_dpp(0, iv, 0x112, 0xf, 0xf, true); break;
                 case 4: r = __builtin_amdgcn_update_dpp(0, iv, 0x114, 0xf, 0xf, true); break; default: r = __builtin_amdgcn_update_dpp(0, iv, 0x118, 0xf, 0xf, true); break; }
    return __builtin_bit_cast(float, r);
}
__device__ __forceinline__ float wave_sum(float v) {
    v += dpp_row_shr(v, 1); v += dpp_row_shr(v, 2); v += dpp_row_shr(v, 4); v += dpp_row_shr(v, 8);
    v += __builtin_bit_cast(float, __builtin_amdgcn_update_dpp(0, __builtin_bit_cast(int, v), 0x142, 0xa, 0xf, false));
    v += __builtin_bit_cast(float, __builtin_amdgcn_update_dpp(0, __builtin_bit_cast(int, v), 0x143, 0xc, 0xf, false));
    return __builtin_bit_cast(float, __builtin_amdgcn_readlane(__builtin_bit_cast(int, v), 63)); }
__device__ __forceinline__ float xor32_max(float x) { auto t = __builtin_amdgcn_permlane32_swap(__float_as_uint(x), __float_as_uint(x), false, false); return fmaxf(__uint_as_float(t[0]), __uint_as_float(t[1])); }
__device__ __forceinline__ float xor32_sum(float x) { auto t = __builtin_amdgcn_permlane32_swap(__float_as_uint(x), __float_as_uint(x), false, false); return __uint_as_float(t[0]) + __uint_as_float(t[1]); }
#define WITEMS(i, n) for (int i = blockIdx.x * 8 + (tid >> 6); i < (n); i += gridDim.x * 8)
__device__ __forceinline__ float4 f4mul(float4 a, float4 b) { return make_float4(a.x * b.x, a.y * b.y, a.z * b.z, a.w * b.w); }
__device__ __forceinline__ float4 f4add(float4 a, float4 b) { return make_float4(a.x + b.x, a.y + b.y, a.z + b.z, a.w + b.w); }
__device__ __forceinline__ float4 f4scale(float4 a, float s) { return make_float4(a.x * s, a.y * s, a.z * s, a.w * s); }
__device__ __forceinline__ float f4dot(float4 a, float4 b) { return a.x * b.x + a.y * b.y + a.z * b.z + a.w * b.w; }
__device__ __forceinline__ uint2 pk4(float4 v) { return make_uint2(pk2(v.x, v.y), pk2(v.z, v.w)); }
__device__ __forceinline__ float4 up4(uint2 u) { return make_float4(__uint_as_float(u.x << 16), __uint_as_float(u.x & 0xffff0000u), __uint_as_float(u.y << 16), __uint_as_float(u.y & 0xffff0000u)); }
__device__ __forceinline__ float4 ld4h(const bf16_t* p) { return up4(*(const uint2*)p); }

__device__ __forceinline__ void rope32(float* v, int t, const float* tab) {
    const float4* tp = (const float4*)(tab + (size_t)t * 32);
    float cs[32];
#pragma unroll
    for (int i = 0; i < 8; ++i) { const float4 x = tp[i]; cs[4 * i] = x.x; cs[4 * i + 1] = x.y; cs[4 * i + 2] = x.z; cs[4 * i + 3] = x.w; }
#pragma unroll
    for (int i = 0; i < 8; ++i) {
        { const float c = cs[i], sn = cs[8 + i]; const float x1 = v[i], x2 = v[8 + i]; v[i] = x1 * c - x2 * sn; v[8 + i] = x1 * sn + x2 * c; }
        { const float c = cs[16 + i], sn = cs[24 + i]; const float x1 = v[16 + i], x2 = v[24 + i]; v[16 + i] = x1 * c - x2 * sn; v[24 + i] = x1 * sn + x2 * c; }
    }
}
__device__ __forceinline__ int tok_row(bool lat, int b, int t) { return lat ? b * S + t : NLAT + b * CTX + t; }

namespace pg8 {
#define PG8_LAS __attribute__((address_space(3)))
typedef short bf16x8 __attribute__((ext_vector_type(8)));
typedef float f32x4 __attribute__((ext_vector_type(4)));
typedef unsigned u32x4 __attribute__((ext_vector_type(4)));
constexpr int BM = 256, BK = 64, HALF = 128, HTB = HALF * BK * 2  , STAGE_BYTES = 8 * HTB, NXCD = 8, WGM = 16;

__host__ __device__ __forceinline__ int lds_byte(int r, int c) { const int st = (r >> 4) * 2 + (c >> 5), rr = r & 15, cc = c & 31, ob = rr * 64 + cc * 2; return st * 1024 + (ob ^ (((ob >> 9) & 1) << 5)); }
__host__ __device__ __forceinline__ void stage_rc(int b, int& R, int& C) { const int st = b / 1024, sb = b % 1024, swz = sb ^ (((sb >> 9) & 1) << 5); R = (st >> 1) * 16 + swz / 64; C = (st & 1) * 32 + (swz % 64) / 2; }
__host__ __device__ __forceinline__ int perm32(int rho) { const int n = rho >> 4, i = rho & 15; return 8 * (i >> 2) + 4 * n + (i & 3); }

struct Unit { int pm, pn; };
struct Gemm { const bf16_t* A; const bf16_t* Bt; int M, N, K; int grp_tiles; size_t grp_stride; };

struct StaticOrder {
    int nM, nN, nwg, G, c;
    __host__ __device__ void init(int M, int N, int G_, int c_) { nM = M / BM; nN = N / BM; nwg = nM * nN; G = G_; c = c_; }
    __host__ __device__ bool next(int i, Unit& u) const {
        const long L = (long)i * G + c; if (L >= nwg) return false;
        int wgid = (int)L; { const int q = nwg / NXCD, r = nwg % NXCD, xcd = wgid % NXCD, off = wgid / NXCD; wgid = (xcd < r ? xcd * (q + 1) : r * (q + 1) + (xcd - r) * q) + off; }
        const int nig = WGM * nN, gid = wgid / nig, fm = gid * WGM, gsz = (nM - fm) < WGM ? (nM - fm) : WGM;
        u.pm = fm + ((wgid % nig) % gsz); u.pn = (wgid % nig) / gsz; return true;
    }
    __device__ __forceinline__ void a_ready(const Unit&) const {}
    __device__ __forceinline__ void done(const Unit&) const {}
};

__device__ __forceinline__ unsigned cvt_pk_bf16(float lo, float hi) { unsigned r; asm volatile("v_cvt_pk_bf16_f32 %0, %1, %2" : "=v"(r) : "v"(lo), "v"(hi)); return r; }

typedef unsigned u32x2 __attribute__((ext_vector_type(2)));
struct EpiF32 {
    static constexpr bool PERM = false, AFTER_DRAIN = false;
    float* C; int ldc; int ncols;
    __device__ __forceinline__ void operator()(const f32x4 (&acc)[2][2][4][2], const Unit& u, int wr, int wc, int fr, int fq) const {
        const int row0 = u.pm * BM + wr * 64 + fr, col0 = u.pn * BM + wc * 32 + 4 * fq;
#pragma unroll
        for (int ai = 0; ai < 2; ++ai)
#pragma unroll
            for (int m = 0; m < 4; ++m) { float* rowp = C + (size_t)(row0 + ai * HALF + m * 16) * ldc;
#pragma unroll
                for (int bj = 0; bj < 2; ++bj)
#pragma unroll
                    for (int n = 0; n < 2; ++n) { const int col = col0 + bj * HALF + n * 16; if (col < ncols) *(f32x4*)(rowp + col) = acc[ai][bj][m][n]; } }
    }
};
struct EpiRowScaleF32 {
    static constexpr bool PERM = false, AFTER_DRAIN = false;
    float* C; int ldc; const float* gate; int er;
    __device__ __forceinline__ void operator()(const f32x4 (&acc)[2][2][4][2], const Unit& u, int wr, int wc, int fr, int fq) const {
        const int row0 = u.pm * BM + wr * 64 + fr, col0 = u.pn * BM + wc * 32 + 4 * fq;
#pragma unroll
        for (int ai = 0; ai < 2; ++ai)
#pragma unroll
            for (int m = 0; m < 4; ++m) { const int row = row0 + ai * HALF + m * 16; float* rowp = C + (size_t)row * ldc; const float sc = gate[(row / er) * ER_MAX + row % er];
#pragma unroll
                for (int bj = 0; bj < 2; ++bj)
#pragma unroll
                    for (int n = 0; n < 2; ++n) *(f32x4*)(rowp + col0 + bj * HALF + n * 16) = acc[ai][bj][m][n] * sc; }
    }
};
struct EpiSwiGLU {
    static constexpr bool PERM = true, AFTER_DRAIN = false;
    bf16_t* O; int ldo;
    __device__ __forceinline__ void operator()(const f32x4 (&acc)[2][2][4][2], const Unit& u, int wr, int wc, int fr, int fq) const {
        const int row0 = u.pm * BM + wr * 64 + fr, col0 = u.pn * BM + wc * 32 + 8 * fq;
#pragma unroll
        for (int ai = 0; ai < 2; ++ai)
#pragma unroll
            for (int m = 0; m < 4; ++m) { bf16_t* rowp = O + (size_t)(row0 + ai * HALF + m * 16) * ldo;
#pragma unroll
                for (int bj = 0; bj < 2; ++bj) { const f32x4 gt = acc[ai][bj][m][0], up = acc[ai][bj][m][1]; f32x4 h;
#pragma unroll
                    for (int i = 0; i < 4; ++i) h[i] = gt[i] / (1.0f + __expf(-gt[i])) * up[i];
                    u32x2 w; w.x = cvt_pk_bf16(h[0], h[1]); w.y = cvt_pk_bf16(h[2], h[3]);
                    *(u32x2*)(rowp + (col0 + bj * HALF) / 2) = w; } }
    }
};

struct EpiBf16 {
    static constexpr bool PERM = true, AFTER_DRAIN = false;
    bf16_t* O; int ldo; int ncols;
    __device__ __forceinline__ void operator()(const f32x4 (&acc)[2][2][4][2], const Unit& u, int wr, int wc, int fr, int fq) const {
        const int row0 = u.pm * BM + wr * 64 + fr, col0 = u.pn * BM + wc * 32 + 8 * fq;
#pragma unroll
        for (int ai = 0; ai < 2; ++ai)
#pragma unroll
            for (int m = 0; m < 4; ++m) { bf16_t* rowp = O + (size_t)(row0 + ai * HALF + m * 16) * ldo;
#pragma unroll
                for (int bj = 0; bj < 2; ++bj) { const int col = col0 + bj * HALF; const f32x4 v0 = acc[ai][bj][m][0], v1 = acc[ai][bj][m][1];
                    u32x4 w; w.x = cvt_pk_bf16(v0[0], v0[1]); w.y = cvt_pk_bf16(v0[2], v0[3]); w.z = cvt_pk_bf16(v1[0], v1[1]); w.w = cvt_pk_bf16(v1[2], v1[3]);
                    if (col < ncols) *(u32x4*)(rowp + col) = w; } }
    }
};
struct EpiRowScaleBf16 {
    static constexpr bool PERM = true, AFTER_DRAIN = false;
    bf16_t* O; int ldo; const float* gate; int er;
    __device__ __forceinline__ void operator()(const f32x4 (&acc)[2][2][4][2], const Unit& u, int wr, int wc, int fr, int fq) const {
        const int row0 = u.pm * BM + wr * 64 + fr, col0 = u.pn * BM + wc * 32 + 8 * fq;
#pragma unroll
        for (int ai = 0; ai < 2; ++ai)
#pragma unroll
            for (int m = 0; m < 4; ++m) { const int row = row0 + ai * HALF + m * 16; bf16_t* rowp = O + (size_t)row * ldo; const float sc = gate[(row / er) * ER_MAX + row % er];
#pragma unroll
                for (int bj = 0; bj < 2; ++bj) { const f32x4 v0 = acc[ai][bj][m][0] * sc, v1 = acc[ai][bj][m][1] * sc;
                    u32x4 w; w.x = cvt_pk_bf16(v0[0], v0[1]); w.y = cvt_pk_bf16(v0[2], v0[3]); w.z = cvt_pk_bf16(v1[0], v1[1]); w.w = cvt_pk_bf16(v1[2], v1[3]);
                    *(u32x4*)(rowp + col0 + bj * HALF) = w; } }
    }
};
template <class Epi, class Sched, bool ALIGN_EPI = false, bool SP2 = false>
__device__ __forceinline__ void gemm_phase(PG8_LAS unsigned char* lds, const Gemm g, const Sched& S, const Epi& E, int tid_in) {
    int tid_ = tid_in; asm volatile("" : "+v"(tid_));
    const int tid = tid_, wid = __builtin_amdgcn_readfirstlane(tid >> 6), lane = tid & 63, wr = wid >> 2, wc = wid & 3, fr = lane & 15, fq = lane >> 4;
    int K_ = g.K; asm volatile("" : "+s"(K_));
    const int K = K_, nt = K / BK;
    unsigned voffA[2], voffB[2];
#pragma unroll
    for (int i = 0; i < 2; ++i) { int R, C; stage_rc(tid * 16 + i * 8192, R, C); const int Rb = Epi::PERM ? ((R & ~31) + perm32(R & 31)) : R;
        voffA[i] = (unsigned)(R * K + C) * 2u; voffB[i] = (unsigned)(Rb * K + C) * 2u; }
    const size_t kstep = (size_t)(BK * 2);
    const size_t hstep = (size_t)HALF * K * 2;
    const size_t tstep = 2 * hstep;
    const unsigned ldsw = (unsigned)wid * 1024u;
    const int aoff = lds_byte(wr * 64 + fr, fq * 8), boff = lds_byte(wc * 32 + fr, fq * 8);
#define PG8_SA(b, h) (((b) * 2 + (h)) * HTB)
#define PG8_SB(b, h) ((4 + (b) * 2 + (h)) * HTB)
#define PG8_STAGE(bufoff, gbase, voff) do { _Pragma("unroll") for (int _i = 0; _i < 2; ++_i) \
        __builtin_amdgcn_global_load_lds((const unsigned*)((const char*)(gbase) + (voff)[_i]), (PG8_LAS unsigned*)(lds + (bufoff) + ldsw + _i * 8192), 16, 0, 0); } while (0)
#define PG8_LDA(dst, b, h) do { _Pragma("unroll") for (int m = 0; m < 4; ++m) _Pragma("unroll") for (int k = 0; k < 2; ++k) dst[m][k] = *(const PG8_LAS bf16x8*)(lds + PG8_SA(b, h) + aoff + m * 2048 + k * 1024); } while (0)
#define PG8_LDB(dst, b, h) do { _Pragma("unroll") for (int n = 0; n < 2; ++n) _Pragma("unroll") for (int k = 0; k < 2; ++k) dst[n][k] = *(const PG8_LAS bf16x8*)(lds + PG8_SB(b, h) + boff + n * 2048 + k * 1024); } while (0)
#define PG8_MMA(ai, bj, At, Bt) do { __builtin_amdgcn_s_setprio(1); _Pragma("unroll") for (int m = 0; m < 4; ++m) _Pragma("unroll") for (int n = 0; n < 2; ++n) _Pragma("unroll") for (int k = 0; k < 2; ++k) \
        acc[ai][bj][m][n] = __builtin_amdgcn_mfma_f32_16x16x32_bf16(Bt[n][k], At[m][k], acc[ai][bj][m][n], 0, 0, 0); __builtin_amdgcn_s_setprio(0); } while (0)
#define PG8_WAIT_V(n) asm volatile("s_waitcnt vmcnt(" #n ")" ::: "memory")
#define PG8_WAIT_L(n) asm volatile("s_waitcnt lgkmcnt(" #n ")" ::: "memory")
#define PG8_BAR __builtin_amdgcn_s_barrier()
#define PG8_SCHED __builtin_amdgcn_sched_barrier(0)
    Unit cur, nxt; int ui = 0;
    if (!S.next(0, cur)) return;
    f32x4 acc[2][2][4][2];
#pragma unroll
    for (int a = 0; a < 2; ++a)
#pragma unroll
        for (int b = 0; b < 2; ++b)
#pragma unroll
            for (int m = 0; m < 4; ++m)
#pragma unroll
                for (int n = 0; n < 2; ++n) acc[a][b][m][n] = (f32x4){0.f, 0.f, 0.f, 0.f};
    bf16x8 At[4][2], B0[2][2], B1[2][2];
    const char* cA = (const char*)g.A + (size_t)cur.pm * tstep; const char* cB = (const char*)g.Bt + (size_t)cur.pn * tstep + (g.grp_tiles ? (size_t)(cur.pm / g.grp_tiles) * g.grp_stride : (size_t)0);
    S.a_ready(cur);
    if constexpr (SP2) {
        PG8_STAGE(PG8_SB(0, 0), cB, voffB); PG8_STAGE(PG8_SB(0, 1), cB + hstep, voffB); PG8_STAGE(PG8_SA(0, 0), cA, voffA); PG8_STAGE(PG8_SA(0, 1), cA + hstep, voffA);
        if (wr == 1) PG8_BAR;
        PG8_WAIT_V(2); PG8_BAR;
        PG8_STAGE(PG8_SB(1, 0), cB + kstep, voffB); PG8_STAGE(PG8_SA(1, 0), cA + kstep, voffA); PG8_STAGE(PG8_SB(1, 1), cB + hstep + kstep, voffB);
        PG8_WAIT_V(6); PG8_BAR;
    } else {
        PG8_STAGE(PG8_SB(0, 0), cB, voffB); PG8_STAGE(PG8_SA(0, 0), cA, voffA); PG8_STAGE(PG8_SB(0, 1), cB + hstep, voffB); PG8_STAGE(PG8_SA(0, 1), cA + hstep, voffA);
        if (wr == 1) PG8_BAR;
        PG8_WAIT_V(4); PG8_BAR;
        PG8_STAGE(PG8_SB(1, 0), cB + kstep, voffB); PG8_STAGE(PG8_SA(1, 0), cA + kstep, voffA); PG8_STAGE(PG8_SB(1, 1), cB + hstep + kstep, voffB);
        PG8_WAIT_V(6); PG8_BAR;
    }
    for (;;) {
        const bool has_next = S.next(ui + 1, nxt);
        const char* nA = has_next ? (const char*)g.A + (size_t)nxt.pm * tstep : cA; const char* nB = has_next ? (const char*)g.Bt + (size_t)nxt.pn * tstep + (g.grp_tiles ? (size_t)(nxt.pm / g.grp_tiles) * g.grp_stride : (size_t)0) : cB;
        for (int t = 0; t < nt; t += 2) {
            const bool last = (t == nt - 2);
            const char* a1 = cA + (size_t)(t + 1) * kstep;
            const char* a2 = last ? nA : cA + (size_t)(t + 2) * kstep; const char* b2 = last ? nB : cB + (size_t)(t + 2) * kstep;
            const char* a3 = a2 + kstep; const char* b3 = b2 + kstep;
            if (last && has_next) S.a_ready(nxt);
            if constexpr (SP2) {
            PG8_LDB(B0, 0, 0); PG8_LDB(B1, 0, 1); PG8_SCHED; PG8_LDA(At, 0, 0); PG8_STAGE(PG8_SA(1, 1), a1 + hstep, voffA);
            PG8_WAIT_V(8); PG8_WAIT_L(0); PG8_BAR; PG8_MMA(0, 0, At, B0); PG8_MMA(0, 1, At, B1); PG8_BAR; PG8_SCHED;
            PG8_LDA(At, 0, 1); PG8_STAGE(PG8_SB(0, 0), b2, voffB); PG8_STAGE(PG8_SB(0, 1), b2 + hstep, voffB); PG8_STAGE(PG8_SA(0, 0), a2, voffA);
            PG8_WAIT_V(8); PG8_WAIT_L(0); PG8_BAR; PG8_MMA(1, 0, At, B0); PG8_MMA(1, 1, At, B1); PG8_BAR; PG8_SCHED;
            PG8_LDB(B0, 1, 0); PG8_LDB(B1, 1, 1); PG8_SCHED; PG8_LDA(At, 1, 0); PG8_STAGE(PG8_SA(0, 1), a2 + hstep, voffA);
            PG8_WAIT_V(8); PG8_WAIT_L(0); PG8_BAR; PG8_MMA(0, 0, At, B0); PG8_MMA(0, 1, At, B1); PG8_BAR; PG8_SCHED;
            PG8_LDA(At, 1, 1); PG8_STAGE(PG8_SB(1, 0), b3, voffB); PG8_STAGE(PG8_SB(1, 1), b3 + hstep, voffB); PG8_STAGE(PG8_SA(1, 0), a3, voffA);
            PG8_WAIT_V(8); PG8_WAIT_L(0); PG8_BAR; PG8_MMA(1, 0, At, B0); PG8_MMA(1, 1, At, B1); PG8_BAR; PG8_SCHED;
            } else {
            PG8_LDB(B0, 0, 0); PG8_SCHED; PG8_LDA(At, 0, 0); PG8_STAGE(PG8_SA(1, 1), a1 + hstep, voffA);
            PG8_WAIT_L(8); PG8_BAR; PG8_WAIT_L(0); PG8_MMA(0, 0, At, B0); PG8_BAR; PG8_SCHED;
            PG8_LDB(B1, 0, 1); PG8_STAGE(PG8_SB(0, 0), b2, voffB);
            PG8_BAR; PG8_WAIT_L(0); PG8_MMA(0, 1, At, B1); PG8_BAR;
            PG8_LDA(At, 0, 1); PG8_STAGE(PG8_SA(0, 0), a2, voffA);
            PG8_BAR; PG8_WAIT_L(0); PG8_MMA(1, 0, At, B0); PG8_BAR; PG8_SCHED;
            PG8_STAGE(PG8_SB(0, 1), b2 + hstep, voffB);
            PG8_WAIT_V(6); PG8_BAR; PG8_MMA(1, 1, At, B1); PG8_BAR;
            PG8_LDB(B0, 1, 0); PG8_SCHED; PG8_LDA(At, 1, 0); PG8_STAGE(PG8_SA(0, 1), a2 + hstep, voffA);
            PG8_WAIT_L(8); PG8_BAR; PG8_WAIT_L(0); PG8_MMA(0, 0, At, B0); PG8_BAR; PG8_SCHED;
            PG8_LDB(B1, 1, 1); PG8_STAGE(PG8_SB(1, 0), b3, voffB);
            PG8_BAR; PG8_WAIT_L(0); PG8_MMA(0, 1, At, B1); PG8_BAR;
            PG8_LDA(At, 1, 1); PG8_STAGE(PG8_SA(1, 0), a3, voffA);
            PG8_BAR; PG8_WAIT_L(0); PG8_MMA(1, 0, At, B0); PG8_BAR; PG8_SCHED;
            PG8_STAGE(PG8_SB(1, 1), b3 + hstep, voffB);
            PG8_WAIT_V(6); PG8_BAR; PG8_MMA(1, 1, At, B1); PG8_BAR;
            }
        }
        if constexpr (ALIGN_EPI) { if (wr == 0) PG8_BAR; }
        if constexpr (!Epi::AFTER_DRAIN) { E(acc, cur, wr, wc, fr, fq); S.done(cur); }
        if (!has_next) break;
#pragma unroll
        for (int a = 0; a < 2; ++a)
#pragma unroll
            for (int b = 0; b < 2; ++b)
#pragma unroll
                for (int m = 0; m < 4; ++m)
#pragma unroll
                    for (int n = 0; n < 2; ++n) acc[a][b][m][n] = (f32x4){0.f, 0.f, 0.f, 0.f};
        cur = nxt; cA = nA; cB = nB; ++ui;
        if constexpr (ALIGN_EPI) { if (wr == 1) PG8_BAR; }
    }
    PG8_WAIT_V(0);
    if constexpr (!ALIGN_EPI) { if (wr == 0) PG8_BAR; }
    PG8_BAR;
    if constexpr (Epi::AFTER_DRAIN) { E.fused(acc, cur, wr, wc, fr, fq, lds, wid, lane); S.done(cur); }
#undef PG8_SA
#undef PG8_SB
#undef PG8_STAGE
#undef PG8_LDA
#undef PG8_LDB
#undef PG8_MMA
#undef PG8_WAIT_V
#undef PG8_WAIT_L
#undef PG8_BAR
#undef PG8_SCHED
}
}


#define XB_TMO      128
#define XB_XCNT(j)  (256  + 64 * (j))
#define XB_XSUB(j)  (1280 + 64 * (j))
#define XB_XGEN(j)  (2304 + 64 * (j))
#define XB_TOP      3328
#define XB_TOPGEN   3392
#define XCD_BAR_WORDS 3456
#define XB_SPIN_CAP (1u << 22)
__device__ __forceinline__ unsigned xb_ld(unsigned* p)              { return __hip_atomic_load(p, __ATOMIC_RELAXED, __HIP_MEMORY_SCOPE_AGENT); }
__device__ __forceinline__ unsigned xb_add(unsigned* p, unsigned v) { return __hip_atomic_fetch_add(p, v, __ATOMIC_RELAXED, __HIP_MEMORY_SCOPE_AGENT); }
__device__ __forceinline__ unsigned xb_xcc_id() { return (unsigned)__builtin_amdgcn_s_getreg((3 << 11) | 20) & 0xFu; }
#define XB_SPIN(cond, bar) do { unsigned _sp = 0; while (cond) { __builtin_amdgcn_s_sleep(1); \
    if ((++_sp & 255u) == 0u) { if (xb_ld(&(bar)[XB_TMO])) break; if (_sp > XB_SPIN_CAP) { atomicAdd(&(bar)[XB_TMO], 1u); break; } } } } while (0)
struct XcdBarrier { unsigned* bar; unsigned x; volatile LAS unsigned* st; };
__device__ __forceinline__ XcdBarrier xcd_barrier_post(unsigned* bar, volatile LAS unsigned* st, int tid_in) {
    XcdBarrier b; b.bar = bar; b.x = xb_xcc_id(); b.st = st;
    if (tid_in == 0) (void)xb_add(&bar[XB_XCNT(b.x)], 1u);
    return b;
}
__device__ __forceinline__ void xcd_barrier_complete(unsigned* bar, unsigned x, unsigned& nloc, unsigned& nx) {
    const unsigned G = gridDim.x * gridDim.y * gridDim.z;
    unsigned sum, cnt, mine, sp = 0u;
    for (;;) {
        sum = 0u; cnt = 0u; mine = 0u;
#pragma unroll
        for (unsigned j = 0; j < 16; ++j) { const unsigned c = xb_ld(&bar[XB_XCNT(j)]); sum += c; cnt += (c > 0u) ? 1u : 0u; mine = (j == x) ? c : mine; }
        if (sum == G) break;
        __builtin_amdgcn_s_sleep(1);
        if ((++sp & 255u) == 0u) { if (xb_ld(&bar[XB_TMO])) break; if (sp > XB_SPIN_CAP) { atomicAdd(&bar[XB_TMO], 1u); break; } }
    }
    nloc = mine > 0u ? mine : 1u; nx = cnt > 0u ? cnt : 1u;
}
__device__ __forceinline__ void xcd_barrier(const XcdBarrier& b, int tid_in) {
    asm volatile("s_waitcnt vmcnt(0)" ::: "memory");
    __syncthreads();
    if (tid_in == 0) {
        unsigned* bar = b.bar;
        __builtin_amdgcn_s_waitcnt(0);
        unsigned nloc = b.st[0], nx = b.st[1];
        if (nloc == 0u) { xcd_barrier_complete(bar, b.x, nloc, nx); b.st[0] = nloc; b.st[1] = nx; }
        const unsigned old = xb_add(&bar[XB_XSUB(b.x)], 1u);
        const unsigned gen = old / nloc;
        if (old + 1u == (gen + 1u) * nloc) {
            __builtin_amdgcn_fence(__ATOMIC_RELEASE, "agent");
            asm volatile("s_waitcnt vmcnt(0)" ::: "memory");
            const unsigned og = xb_add(&bar[XB_TOP], 1u);
            const unsigned tg = og / nx;
            if (og + 1u == (tg + 1u) * nx) xb_add(&bar[XB_TOPGEN], 1u);
            else XB_SPIN(xb_ld(&bar[XB_TOPGEN]) == tg, bar);
            __builtin_amdgcn_fence(__ATOMIC_ACQUIRE, "agent");
            xb_add(&bar[XB_XGEN(b.x)], 1u);
            asm volatile("s_waitcnt vmcnt(0)" ::: "memory");
        } else {
            XB_SPIN(xb_ld(&bar[XB_XGEN(b.x)]) == gen, bar);
            __builtin_amdgcn_fence(__ATOMIC_ACQUIRE, "agent");
            asm volatile("s_waitcnt vmcnt(0)" ::: "memory");
        }
    }
    __syncthreads();
}


typedef short bf16x8 __attribute__((ext_vector_type(8)));
typedef short s16x4 __attribute__((ext_vector_type(4)));
typedef float f32x16 __attribute__((ext_vector_type(16)));
typedef unsigned v4u __attribute__((ext_vector_type(4)));
typedef unsigned v2u __attribute__((ext_vector_type(2)));
constexpr float ATT_THR = 5.0f;
template <int DK> struct AttL { static constexpr int KSTR = DK * 2 + 16, KBYTES = 64 * KSTR, VSTR = 136, VBYTES = 64 * VSTR, KCH = 64 * DK / 8, KPT = (KCH + NTHREADS - 1) / NTHREADS;
    static constexpr int K_OFF = 0, V_OFF = 2 * KBYTES; };

template <int DK>
__device__ __forceinline__ void attn_pass(const bf16_t* Qrow, const bf16_t* Kp, const bf16_t* Vtp, int vt_ld, int nkt, LAS unsigned char* lds, int tid, f32x16 (&oacc)[2], float& l_run) {
    typedef AttL<DK> L;
    constexpr bool AUG = DK <= 32;
    const int lane = tid & 63, r = lane & 31, h = lane >> 5;
    bf16x8 qf[DK / 16];
#pragma unroll
    for (int ks = 0; ks < DK / 16; ++ks) qf[ks] = *(const bf16x8*)(Qrow + 16 * ks + 8 * h);
    const short z_ = (short)(tid >> 20);
    bf16x8 aone = {z_, z_, z_, z_, z_, z_, z_, z_}, bneg = {z_, z_, z_, z_, z_, z_, z_, z_};
    if (h == 0) aone[0] = (short)0x3F80;
    float m_run = 0.f;
    v4u kreg[L::KPT]; v4u vreg;
    const int vd = tid >> 3, vpart = tid & 7;
#define ATT_LOADK(j) do { _Pragma("unroll") for (int i_ = 0; i_ < L::KPT; ++i_) { const int c_ = tid + i_ * NTHREADS; if (c_ < L::KCH) kreg[i_] = *(const v4u*)(Kp + (size_t)(j) * 64 * DK + c_ * 8); } } while (0)
#define ATT_LOADV(j) do { vreg = *(const v4u*)(Vtp + (size_t)vd * vt_ld + (j) * 64 + vpart * 8); } while (0)
#define ATT_STOREK(buf) do { _Pragma("unroll") for (int i_ = 0; i_ < L::KPT; ++i_) { const int c_ = tid + i_ * NTHREADS; if (c_ < L::KCH) { const int key_ = c_ / (DK / 8), part_ = c_ % (DK / 8); \
            *(LAS v4u*)(lds + L::K_OFF + (buf) * L::KBYTES + key_ * L::KSTR + part_ * 16) = kreg[i_]; } } } while (0)
#define ATT_STOREV(buf) do { LAS unsigned char* vp_ = lds + L::V_OFF + (buf) * L::VBYTES + vd * L::VSTR + vpart * 16; *(LAS v2u*)vp_ = (v2u){vreg.x, vreg.y}; *(LAS v2u*)(vp_ + 8) = (v2u){vreg.z, vreg.w}; } while (0)
#define ATT_QK(dst, buf) do { _Pragma("unroll") for (int kb = 0; kb < 2; ++kb) { _Pragma("unroll") for (int i = 0; i < 16; ++i) dst[kb][i] = 0.f; \
        if (AUG) dst[kb] = __builtin_amdgcn_mfma_f32_32x32x16_bf16(aone, bneg, dst[kb], 0, 0, 0); \
        _Pragma("unroll") for (int ks = 0; ks < DK / 16; ++ks) { const bf16x8 a_ = *(const LAS bf16x8*)(lds + L::K_OFF + (buf) * L::KBYTES + (32 * kb + r) * L::KSTR + (16 * ks + 8 * h) * 2); \
            dst[kb] = __builtin_amdgcn_mfma_f32_32x32x16_bf16(a_, qf[ks], dst[kb], 0, 0, 0); } } } while (0)
#define ATT_BODY(SC, SN, j) do { \
        if ((j) + 2 < nkt) ATT_LOADK((j) + 2); \
        if ((j) + 1 < nkt) { ATT_LOADV((j) + 1); ATT_QK(SN, ((j) + 1) & 1); } \
        if (((j) & 3) == 0) { \
            float t0 = fmaxf(fmaxf(SC[0][0], SC[0][1]), SC[0][2]), t1 = fmaxf(fmaxf(SC[0][3], SC[0][4]), SC[0][5]), t2 = fmaxf(fmaxf(SC[0][6], SC[0][7]), SC[0][8]), t3 = fmaxf(fmaxf(SC[0][9], SC[0][10]), SC[0][11]); \
            float t4 = fmaxf(fmaxf(SC[0][12], SC[0][13]), SC[0][14]), t5 = fmaxf(fmaxf(SC[0][15], SC[1][0]), SC[1][1]), t6 = fmaxf(fmaxf(SC[1][2], SC[1][3]), SC[1][4]), t7 = fmaxf(fmaxf(SC[1][5], SC[1][6]), SC[1][7]); \
            float t8 = fmaxf(fmaxf(SC[1][8], SC[1][9]), SC[1][10]), t9 = fmaxf(fmaxf(SC[1][11], SC[1][12]), SC[1][13]), t10 = fmaxf(SC[1][14], SC[1][15]); \
            float tmax = fmaxf(fmaxf(fmaxf(fmaxf(t0, t1), t2), fmaxf(fmaxf(t3, t4), t5)), fmaxf(fmaxf(fmaxf(t6, t7), t8), fmaxf(t9, t10))); \
            tmax = xor32_max(tmax); if (!AUG) tmax -= m_run;            \
            if ((j) == 0 || __any(tmax > ATT_THR)) {                   \
                const float want = (j) == 0 ? tmax : m_run + fmaxf(tmax, 0.f); \
                const float mn = __uint_as_float(pk2(want, 0.f) << 16), dlt = mn - m_run, alpha = __builtin_amdgcn_exp2f(-dlt); \
                _Pragma("unroll") for (int i = 0; i < 16; ++i) { oacc[0][i] *= alpha; oacc[1][i] *= alpha; if (AUG) { SC[0][i] -= dlt; SC[1][i] -= dlt; SN[0][i] -= dlt; SN[1][i] -= dlt; } } \
                l_run *= alpha; m_run = mn; if (AUG && h == 0) bneg[0] = (short)(__float_as_uint(-mn) >> 16); \
            } \
        } \
        float ps0 = 0.f, ps1 = 0.f, ps2 = 0.f, ps3 = 0.f; \
        _Pragma("unroll") for (int kb = 0; kb < 2; ++kb) \
            _Pragma("unroll") for (int i = 0; i < 16; i += 4) { const float mo = AUG ? 0.f : m_run; const float p0 = __builtin_amdgcn_exp2f(SC[kb][i] - mo), p1 = __builtin_amdgcn_exp2f(SC[kb][i + 1] - mo), p2 = __builtin_amdgcn_exp2f(SC[kb][i + 2] - mo), p3 = __builtin_amdgcn_exp2f(SC[kb][i + 3] - mo); \
                SC[kb][i] = p0; SC[kb][i + 1] = p1; SC[kb][i + 2] = p2; SC[kb][i + 3] = p3; ps0 += p0; ps1 += p1; ps2 += p2; ps3 += p3; } \
        l_run += (ps0 + ps1) + (ps2 + ps3); \
        _Pragma("unroll") for (int kb = 0; kb < 2; ++kb) \
            _Pragma("unroll") for (int s2 = 0; s2 < 2; ++s2) { \
                union { bf16x8 v; unsigned u[4]; } pf; \
                _Pragma("unroll") for (int i = 0; i < 4; ++i) pf.u[i] = pk2(SC[kb][8 * s2 + 2 * i], SC[kb][8 * s2 + 2 * i + 1]); \
                _Pragma("unroll") for (int db = 0; db < 2; ++db) { \
                    const LAS unsigned char* vp = lds + L::V_OFF + ((j) & 1) * L::VBYTES + (32 * db + r) * L::VSTR + (32 * kb + 16 * s2 + 4 * h) * 2; \
                    union { bf16x8 v; v2u u[2]; } af; af.u[0] = *(const LAS v2u*)vp; af.u[1] = *(const LAS v2u*)(vp + 16); \
                    oacc[db] = __builtin_amdgcn_mfma_f32_32x32x16_bf16(af.v, pf.v, oacc[db], 0, 0, 0); } } \
        if ((j) + 2 < nkt) ATT_STOREK((j) & 1);               \
        if ((j) + 1 < nkt) ATT_STOREV(((j) + 1) & 1);         \
        __syncthreads(); \
    } while (0)
    __syncthreads();
    ATT_LOADK(0); ATT_LOADV(0); ATT_STOREK(0); ATT_STOREV(0);
    if (nkt > 1) { ATT_LOADK(1); ATT_STOREK(1); }
    __syncthreads();
    f32x16 sa[2], sb[2];
#pragma unroll
    for (int i = 0; i < 16; ++i) { sb[0][i] = (float)z_; sb[1][i] = (float)z_; }
    ATT_QK(sa, 0);
    for (int j = 0; j < nkt; j += 2) {
        ATT_BODY(sa, sb, j);
        if (j + 1 < nkt) ATT_BODY(sb, sa, j + 1);
    }
#undef ATT_BODY
#undef ATT_LOADK
#undef ATT_LOADV
#undef ATT_STOREK
#undef ATT_STOREV
#undef ATT_QK
}


constexpr int SLD = 65, SHLD = 72, XTLD = 132;
__device__ __forceinline__ int rm32(int t, int h) { return (t & 3) + 8 * (t >> 2) + 4 * h; }
template <bool WITH_Y>
__device__ __forceinline__ void ssd_block(int b, int dir, int k, int hp, const bf16_t* xbc, const float* dtp, const float* alog, float* hs, float* alast, bf16_t* yd, float* lds, int tid) {
    const bool lat = k >= 2; const int c = lat ? (dir ? 33 - k : k - 2) : (dir ? 1 - k : k);
    const int row0 = tok_row(lat, b, c * 128), g = hp >> 1;
    float* sB = lds; bf16_t* sBh = (bf16_t*)lds; bf16_t* sCh = sBh + 128 * SHLD;
    float* sX = WITH_Y ? lds + (2 * 128 * SHLD * 2) / 4 : sB + 128 * SLD; bf16_t* sXT = (bf16_t*)sX;
    float* sDT = sX + 128 * 128; float* sCum = sDT + 256; float* sW = sCum + 256; float* sSc = sW + 256;
    const int wave = tid >> 6, lane = tid & 63, r = lane & 31, h = lane >> 5, hl = wave >> 2, head = 2 * hp + hl;
    float* hsp = hs + (((size_t)(b * 2 + dir) * NCH + k) * 8 + head) * 4096;
    union { bf16x8 v; unsigned u[4]; } hfrag[WITH_Y ? 8 : 1];
    if (WITH_Y) {
#pragma unroll
        for (int Pb = 0; Pb < 2; ++Pb)
#pragma unroll
            for (int ks = 0; ks < 4; ++ks) { const float4 x0 = *(const float4*)(hsp + (32 * Pb + r) * 64 + 16 * ks + 8 * h), x1 = *(const float4*)(hsp + (32 * Pb + r) * 64 + 16 * ks + 8 * h + 4);
                hfrag[Pb * 4 + ks].u[0] = pk2(x0.x, x0.y); hfrag[Pb * 4 + ks].u[1] = pk2(x0.z, x0.w); hfrag[Pb * 4 + ks].u[2] = pk2(x1.x, x1.y); hfrag[Pb * 4 + ks].u[3] = pk2(x1.z, x1.w); }
    }
    uint2 vb[8]; float4 vx[8]; float dx[8]; float dtv = 0.f, dav = 0.f;
#pragma unroll
    for (int u = 0; u < 8; ++u) { const int i = tid + u * NTHREADS, t = i >> 5, c4 = i & 31;
        vb[u] = *(const uint2*)(xbc + (size_t)(row0 + t) * 768 + 512 + (c4 >> 4) * 128 + g * 64 + (c4 & 15) * 4);
        vx[u] = ld4h(xbc + (size_t)(row0 + t) * 768 + hp * 128 + c4 * 4);
        dx[u] = dtp[(size_t)(row0 + t) * 16 + dir * 8 + 2 * hp + (c4 >> 4)]; }
    if (tid < 256) { const int hl = tid >> 7, t = tid & 127, h = 2 * hp + hl; dtv = dtp[(size_t)(row0 + t) * 16 + dir * 8 + h]; dav = dtv * -expf(alog[dir * 8 + h]); }
    __syncthreads();
#pragma unroll
    for (int u = 0; u < 8; ++u) { const int i = tid + u * NTHREADS, t = i >> 5, c4 = i & 31;
        if (WITH_Y) *(uint2*)((c4 >> 4 ? sCh : sBh) + t * SHLD + (c4 & 15) * 4) = vb[u];
        else if (!(c4 >> 4)) { const float4 f = up4(vb[u]); float* d = sB + t * SLD + (c4 & 15) * 4; d[0] = f.x; d[1] = f.y; d[2] = f.z; d[3] = f.w; }
        if (WITH_Y) { const float4 xs = f4scale(vx[u], dx[u]); sXT[(c4 * 4 + 0) * XTLD + t] = (bf16_t)(pk2(xs.x, 0.f)); sXT[(c4 * 4 + 1) * XTLD + t] = (bf16_t)(pk2(xs.y, 0.f)); sXT[(c4 * 4 + 2) * XTLD + t] = (bf16_t)(pk2(xs.z, 0.f)); sXT[(c4 * 4 + 3) * XTLD + t] = (bf16_t)(pk2(xs.w, 0.f)); }
        else *(float4*)(sX + t * 128 + c4 * 4) = f4scale(vx[u], dx[u]); }
    if (tid < 256) { const int t = tid & 127; sSc[(tid & 128) + (dir ? 127 - t : t)] = dav; }
    __syncthreads();
    for (int off = 1; off < 128; off <<= 1) { float v = 0.f; const int sI = tid & 127;
        if (tid < 256) { v = sSc[tid]; if (sI >= off) v += sSc[tid - off]; }
        __syncthreads(); if (tid < 256) sSc[tid] = v; __syncthreads(); }
    if (tid < 256) { const int hl = tid >> 7, sI = tid & 127, t = dir ? 127 - sI : sI; const float cu = sSc[tid], tot = sSc[hl * 128 + 127];
        sCum[hl * 128 + t] = cu; sW[hl * 128 + t] = expf(tot - cu);
        if (!WITH_Y && sI == 127) alast[((size_t)(b * 2 + dir) * NCH + k) * 8 + 2 * hp + hl] = tot; }
    __syncthreads();
    if (WITH_Y) {
        const int I = hl ? 3 - (wave & 3) : (wave & 3), ti = 32 * I + r;
        const float cum_i = sCum[hl * 128 + ti];
        f32x16 Y[2], Yo[2];
#pragma unroll
        for (int i = 0; i < 16; ++i) { Y[0][i] = 0.f; Y[1][i] = 0.f; Yo[0][i] = 0.f; Yo[1][i] = 0.f; }
        bf16x8 cfrag[4];
#pragma unroll
        for (int ks = 0; ks < 4; ++ks) cfrag[ks] = *(const bf16x8*)(sCh + (32 * I + r) * SHLD + 16 * ks + 8 * h);
#pragma unroll
        for (int Pb = 0; Pb < 2; ++Pb)
#pragma unroll
            for (int ks = 0; ks < 4; ++ks) Yo[Pb] = __builtin_amdgcn_mfma_f32_32x32x16_bf16(hfrag[Pb * 4 + ks].v, cfrag[ks], Yo[Pb], 0, 0, 0);
        const int J0 = dir ? I : 0, J1 = dir ? 3 : I;
        for (int J = J0; J <= J1; ++J) {
            f32x16 Gt;
#pragma unroll
            for (int i = 0; i < 16; ++i) Gt[i] = 0.f;
#pragma unroll
            for (int ks = 0; ks < 4; ++ks) Gt = __builtin_amdgcn_mfma_f32_32x32x16_bf16(*(const bf16x8*)(sBh + (32 * J + r) * SHLD + 16 * ks + 8 * h), cfrag[ks], Gt, 0, 0, 0);
#pragma unroll
            for (int t = 0; t < 16; ++t) { const int tj = 32 * J + rm32(t, h); const bool valid = (J != I) || (dir ? tj >= ti : tj <= ti);
                Gt[t] *= valid ? __expf(cum_i - sCum[hl * 128 + tj]) : 0.f; }
#pragma unroll
            for (int s2 = 0; s2 < 2; ++s2) {
                union { bf16x8 v; unsigned u[4]; } pf;
#pragma unroll
                for (int i = 0; i < 4; ++i) pf.u[i] = pk2(Gt[8 * s2 + 2 * i], Gt[8 * s2 + 2 * i + 1]);
#pragma unroll
                for (int Pb = 0; Pb < 2; ++Pb) {
                    const bf16_t* xp = sXT + (hl * 64 + 32 * Pb + r) * XTLD + 32 * J + 16 * s2 + 4 * h;
                    union { bf16x8 v; uint2 u[2]; } af; af.u[0] = *(const uint2*)xp; af.u[1] = *(const uint2*)(xp + 8);
                    Y[Pb] = __builtin_amdgcn_mfma_f32_32x32x16_bf16(af.v, pf.v, Y[Pb], 0, 0, 0);
                }
            }
        }
        const float ei = __expf(cum_i);
        bf16_t* yrow = yd + ((size_t)dir * NTOK + row0 + ti) * 512 + head * 64;
#pragma unroll
        for (int Pb = 0; Pb < 2; ++Pb)
#pragma unroll
            for (int tq = 0; tq < 4; ++tq)
                *(uint2*)(yrow + 32 * Pb + 8 * tq + 4 * h) = pk4(make_float4(Y[Pb][4 * tq] + ei * Yo[Pb][4 * tq], Y[Pb][4 * tq + 1] + ei * Yo[Pb][4 * tq + 1], Y[Pb][4 * tq + 2] + ei * Yo[Pb][4 * tq + 2], Y[Pb][4 * tq + 3] + ei * Yo[Pb][4 * tq + 3]));
    } else {
        const int Pb = (wave >> 1) & 1, Nb = wave & 1;
        f32x16 acc;
#pragma unroll
        for (int i = 0; i < 16; ++i) acc[i] = 0.f;
#pragma unroll 8
        for (int ks = 0; ks < 64; ++ks) { const int j = 2 * ks + h;
            acc = __builtin_amdgcn_mfma_f32_32x32x2f32(sX[j * 128 + hl * 64 + 32 * Pb + r] * sW[hl * 128 + j], sB[j * SLD + 32 * Nb + r], acc, 0, 0, 0); }
#pragma unroll
        for (int t = 0; t < 16; ++t) hsp[(32 * Pb + rm32(t, h)) * 64 + 32 * Nb + r] = acc[t];
    }
}

template <class RM>
__device__ __forceinline__ void cvt_tile(const float* src, int N, bf16_t* dst, int ldd, RM rowmap, int k0, int n0, int lane) {
    const int n = n0 + lane;
    if (n < N) {
        const float* sp = src + (size_t)k0 * N + n;
        float v[32];
#pragma unroll
        for (int kk = 0; kk < 32; ++kk) v[kk] = sp[(size_t)kk * N];
        uint4* dp = (uint4*)(dst + (size_t)rowmap(n) * ldd + k0);
#pragma unroll
        for (int i = 0; i < 4; ++i) dp[i] = make_uint4(pk2(v[8 * i], v[8 * i + 1]), pk2(v[8 * i + 2], v[8 * i + 3]), pk2(v[8 * i + 4], v[8 * i + 5]), pk2(v[8 * i + 6], v[8 * i + 7]));
    }
}
__device__ __forceinline__ int block_excl_scan(int v, int tid, volatile int* sh, int& total) {
    const int lane = tid & 63, wave = tid >> 6; int x = v;
    x += __builtin_amdgcn_update_dpp(0, x, 0x111, 0xf, 0xf, true); x += __builtin_amdgcn_update_dpp(0, x, 0x112, 0xf, 0xf, true);
    x += __builtin_amdgcn_update_dpp(0, x, 0x114, 0xf, 0xf, true); x += __builtin_amdgcn_update_dpp(0, x, 0x118, 0xf, 0xf, true);
    x += __builtin_amdgcn_update_dpp(0, x, 0x142, 0xa, 0xf, false); x += __builtin_amdgcn_update_dpp(0, x, 0x143, 0xc, 0xf, false);
    __syncthreads();
    if (lane == 63) sh[wave] = x;
    __syncthreads();
    int off = 0, tot = 0;
#pragma unroll
    for (int w = 0; w < 8; ++w) { const int c = sh[w]; tot += c; if (w < wave) off += c; }
    total = tot;
    return off + x - v;
}
__device__ __forceinline__ int block_sum(int v, int tid, volatile int* sh, int parity) {
    const int lane = tid & 63, wave = tid >> 6;
    v += __builtin_amdgcn_update_dpp(0, v, 0x111, 0xf, 0xf, true); v += __builtin_amdgcn_update_dpp(0, v, 0x112, 0xf, 0xf, true);
    v += __builtin_amdgcn_update_dpp(0, v, 0x114, 0xf, 0xf, true); v += __builtin_amdgcn_update_dpp(0, v, 0x118, 0xf, 0xf, true);
    v += __builtin_amdgcn_update_dpp(0, v, 0x142, 0xa, 0xf, false); v += __builtin_amdgcn_update_dpp(0, v, 0x143, 0xc, 0xf, false);
    if (lane == 63) sh[parity * 8 + wave] = v;
    __syncthreads();
    int tot = 0;
#pragma unroll
    for (int w = 0; w < 8; ++w) tot += sh[parity * 8 + w];
    return tot;
}

#define MOD ((float*)(kp_->ws + WS_MOD))
#define CTXC ((float*)(kp_->ws + WS_CTXC))
#define AFF ((float*)(kp_->ws + WS_AFF))
#define TOKSLOT ((int*)(kp_->ws + WS_TOKSLOT))
#define SELIDX ((int*)(kp_->ws + WS_SELIDX))
#define SELGATE ((float*)(kp_->ws + WS_SELGATE))
#define DT ((float*)(kp_->ws + WS_DT))
#define HB ((bf16_t*)(kp_->ws + WS_HB))
#define HS ((float*)(kp_->ws + WS_HS))
#define YD ((bf16_t*)(kp_->ws + WS_YD))
#define ALAST ((float*)(kp_->ws + WS_ALAST))
#define ROPE ((float*)(kp_->ws + WS_ROPE))
#define PB ((bf16_t*)(kp_->ws + WS_P))
#define XBC ((bf16_t*)(kp_->ws + WS_XBC))
#define MQ ((bf16_t*)(kp_->ws + WS_MQ))
#define MKV ((bf16_t*)(kp_->ws + WS_MKV))
#define CQB ((bf16_t*)(kp_->ws + WS_CQB))
#define CKVB ((bf16_t*)(kp_->ws + WS_CKVB))
#define MIXB ((bf16_t*)(kp_->ws + WS_MIXB))
#define MOUT ((bf16_t*)(kp_->ws + WS_MOUT))
#define XG ((bf16_t*)(kp_->ws + WS_XG))
#define HID ((bf16_t*)(kp_->ws + WS_HID))
#define Y ((bf16_t*)(kp_->ws + WS_Y))
#define WIN_T ((bf16_t*)(kp_->ws + WS_WIN))
#define WQ_T ((bf16_t*)(kp_->ws + WS_WQ))
#define WKV_T ((bf16_t*)(kp_->ws + WS_WKV))
#define WOUT_T ((bf16_t*)(kp_->ws + WS_WOUT))
#define WGU_T ((bf16_t*)(kp_->ws + WS_WGU))
#define WD_T ((bf16_t*)(kp_->ws + WS_WD))
#define QD ((bf16_t*)(kp_->ws + WS_QD))
#define QDC ((bf16_t*)(kp_->ws + WS_QDC))
#define KD ((bf16_t*)(kp_->ws + WS_KD))
#define VDT ((bf16_t*)(kp_->ws + WS_VDT))
#define QM ((bf16_t*)(kp_->ws + WS_QM))
#define QMC ((bf16_t*)(kp_->ws + WS_QMC))
#define KM ((bf16_t*)(kp_->ws + WS_KM))
#define VMT ((bf16_t*)(kp_->ws + WS_VMT))
#define xcur (kp_->out)
#define XSRC (l == 0 ? kp_->in[I_X] : (const float*)kp_->out)
#define CSRC (l == 0 ? kp_->in[I_CTX] : (const float*)CTXC)
#define DTMP XBC
#define modl (MOD + (size_t)l * (NB + 1) * NMOD * D)
typedef const __attribute__((address_space(4))) Prm* KPrm;
#define PHASE_BEGIN() KPrm kp_ = (KPrm)__builtin_amdgcn_kernarg_segment_ptr(); asm volatile("" : "+s"(kp_)); int tid = MK_TID(); asm volatile("" : "+v"(tid)); (void)tid
#define GSYNC() do { XcdBarrier b_; b_.bar = (unsigned*)(kp_->ws + WS_CTL); b_.x = xb_xcc_id(); b_.st = (volatile LAS unsigned*)(ldsb + LDS_BYTES - 64); xcd_barrier(b_, tid); } while (0)
#define CVT_MOE_RANGE(LW, ID0, ID1, SLOT, NSLOTS) do { const int lane_ = tid & 63; \
        for (int id = (ID0) + (SLOT); id < (ID1); id += (NSLOTS)) { \
            const int mat = id >> 9, tl = id & 511, e = mat / 3, which = mat % 3, k0 = (tl >> 4) * 32, n0 = (tl & 15) * 64; \
            if (which == 0) cvt_tile(kp_->in[I_WG] + ((size_t)(LW) * NE + e) * D * FF, FF, WGU_T + (size_t)e * 2 * FF * D, D, [](int n) { return (n >> 2) * 8 + (n & 3); }, k0, n0, lane_); \
            else if (which == 1) cvt_tile(kp_->in[I_WU] + ((size_t)(LW) * NE + e) * D * FF, FF, WGU_T + (size_t)e * 2 * FF * D, D, [](int n) { return (n >> 2) * 8 + 4 + (n & 3); }, k0, n0, lane_); \
            else cvt_tile(kp_->in[I_WD] + ((size_t)(LW) * NE + e) * FF * D, D, WD_T + (size_t)e * D * FF, FF, [](int n) { return n; }, k0, n0, lane_); } } while (0)
constexpr int MOE_TILES = NE * 3 * 512;
constexpr int CVT_PER_WAVE = 4;
__global__ void __launch_bounds__(NTHREADS, 2) mk_forward(Prm p) {
    extern __shared__ __attribute__((aligned(16))) unsigned char lds_raw[];
    LAS unsigned char* const ldsb = (LAS unsigned char*)lds_raw;
    volatile LAS unsigned* st = (volatile LAS unsigned*)(ldsb + LDS_BYTES - 64);
    const int wave_s = __builtin_amdgcn_readfirstlane((int)threadIdx.x >> 6);
#define MK_TID() mk_tid_impl(wave_s)
    if (MK_TID() < 16) st[MK_TID()] = 0u;
    __syncthreads();
    (void)xcd_barrier_post((unsigned*)(p.ws + WS_CTL), st, MK_TID());
    const int G = gridDim.x, bid = blockIdx.x;
    const int vcu = (G % 8 == 0) ? (bid % 8) * (G / 8) + bid / 8 : bid;

    {
        PHASE_BEGIN();
        const float* c = kp_->in[I_C]; const float* cc = kp_->in[I_CCTX]; const float* adaw = kp_->in[I_ADAW]; const float* adab = kp_->in[I_ADAB];
        float* sc_l = (float*)lds_raw;
        for (int i = tid; i < (NB + 1) * D; i += NTHREADS) { const int r = i / D, k = i % D; sc_l[i] = siluf(r < NB ? c[(size_t)r * D + k] : cc[k]); }
        __syncthreads();
        {
            float* red = sc_l + (NB + 1) * D;
            const int lane = tid & 63, wv = tid >> 6;
            for (int it = bid; it < DEPTH * (NMOD * D / 64); it += G) {
                const int l = it / (NMOD * D / 64), j = (it % (NMOD * D / 64)) * 64 + lane;
                const float* w = adaw + ((size_t)l * D + wv * 128) * NMOD * D + j;
                float a0 = 0.f, a1 = 0.f, a2 = 0.f, a3 = 0.f, a4 = 0.f;
#pragma unroll 8
                for (int k = 0; k < 128; ++k) { const float wk = w[(size_t)k * NMOD * D]; const int kk = wv * 128 + k;
                    a0 += sc_l[kk] * wk; a1 += sc_l[D + kk] * wk; a2 += sc_l[2 * D + kk] * wk; a3 += sc_l[3 * D + kk] * wk; a4 += sc_l[4 * D + kk] * wk; }
                __syncthreads();
                red[(wv * 5 + 0) * 64 + lane] = a0; red[(wv * 5 + 1) * 64 + lane] = a1; red[(wv * 5 + 2) * 64 + lane] = a2; red[(wv * 5 + 3) * 64 + lane] = a3; red[(wv * 5 + 4) * 64 + lane] = a4;
                __syncthreads();
                if (tid < 5 * 64) { const int r = tid >> 6; float acc = adab[l * NMOD * D + j - lane + (tid & 63)];
#pragma unroll
                    for (int q = 0; q < 8; ++q) acc += red[(q * 5 + r) * 64 + (tid & 63)];
                    MOD[((size_t)l * (NB + 1) + r) * NMOD * D + (j - lane) + (tid & 63)] = acc; }
            }
        }
        ITEMS(i, S * 16) {
            const int t = i >> 4, w = i & 15, ii = w & 7; const float pos = (float)(w < 8 ? t / GRID_W : t % GRID_W);
            const float ang = pos * powf(10000.0f, -(float)ii / 8.0f);
            ROPE[(size_t)t * 32 + (w < 8 ? 0 : 16) + ii] = cosf(ang); ROPE[(size_t)t * 32 + (w < 8 ? 8 : 24) + ii] = sinf(ang);
        }
        GSYNC();
    }

#pragma unroll 1
    for (int l = 0; l < DEPTH; ++l) {
        const bool ctx_out = l < DEPTH - 1;
        const float lambda_init = 0.8f - 0.6f * expf(-0.3f * (float)l);
        const int nrows_out = ctx_out ? NTOK : NLAT;
        const int ER = ctx_out ? ER_MAX : NB * CAP_L;
        int moe_done = 0;

        {
            PHASE_BEGIN();
            {
                const int lane = tid & 63; auto idm = [](int n) { return n; };
                constexpr int T_WIN = (D / 32) * ((IN_COLS + 63) / 64), T_WQ = (192 / 32) * (384 / 64), T_WKV = (128 / 32) * (512 / 64), T_WOUT = (MIXW / 32) * (D / 64);
                WITEMS(id, T_WIN + T_WQ + T_WKV + T_WOUT) {
                    if (id < T_WIN) { const int nt = (IN_COLS + 63) / 64; cvt_tile(kp_->in[I_WIN] + (size_t)l * D * IN_COLS, IN_COLS, WIN_T, D, idm, (id / nt) * 32, (id % nt) * 64, lane); }
                    else if (id < T_WIN + T_WQ) { const int u = id - T_WIN; cvt_tile(kp_->in[I_WQUP] + (size_t)l * 192 * 384, 384, WQ_T, 256, idm, (u / 6) * 32, (u % 6) * 64, lane); }
                    else if (id < T_WIN + T_WQ + T_WKV) { const int u = id - T_WIN - T_WQ; cvt_tile(kp_->in[I_WKVUP] + (size_t)l * 128 * 512, 512, WKV_T, 128, idm, (u / 8) * 32, (u % 8) * 64, lane); }
                    else { const int u = id - T_WIN - T_WQ - T_WKV; cvt_tile(kp_->in[I_WOUT] + (size_t)l * MIXW * D, D, WOUT_T, MIXW, idm, (u / 16) * 32, (u % 16) * 64, lane); }
                }
            }
            ITEMS(i, (IN_PAD - IN_COLS) * D / 8) ((uint4*)(WIN_T + (size_t)IN_COLS * D))[i] = make_uint4(0, 0, 0, 0);
            ITEMS(i, 128 * 256 / 8) ((uint4*)(WQ_T + (size_t)384 * 256))[i] = make_uint4(0, 0, 0, 0);
            ITEMS(i, 384 * 8) { const int r = i >> 3, c8 = i & 7; *(uint4*)(WQ_T + (size_t)r * 256 + 192 + c8 * 8) = make_uint4(0, 0, 0, 0); }

            const float* w = kp_->in[I_NMPRE] + l * D;
            const int lane = tid & 63;
            {
                float4 xq[4];
                { const float zf_ = (float)(tid >> 20);
#pragma unroll
                  for (int i = 0; i < 4; ++i) xq[i] = make_float4(zf_, zf_, zf_, zf_); }
                float4* aux = (float4*)lds_raw;
                __syncthreads();
                for (int i = tid; i < 11 * (D / 4); i += NTHREADS) { const int v = i / (D / 4), k4 = i % (D / 4);
                    const float* src = v == 0 ? w : modl + (size_t)((v - 1) % 5) * NMOD * D + ((v - 1) / 5) * D;
                    aux[i] = ((const float4*)src)[k4]; }
                __syncthreads();
                const int wstride = gridDim.x * 8; int r = blockIdx.x * 8 + (tid >> 6);
#define P1_LOAD(rr) do { const float4* src_ = (const float4*)((rr) < NLAT ? XSRC + (size_t)(rr) * D : CSRC + (size_t)((rr) - NLAT) * D); _Pragma("unroll") for (int i = 0; i < 4; ++i) xq[i] = src_[i * 64 + lane]; } while (0)
                if (r < NTOK) P1_LOAD(r);
                for (; r < NTOK; r += wstride) {
                    const int bsel = r < NLAT ? r / S : NB;
                    float4 v[4]; float ss = 0.f;
#pragma unroll
                    for (int i = 0; i < 4; ++i) { v[i] = xq[i]; ss += f4dot(v[i], v[i]); }
                    if (r + wstride < NTOK) P1_LOAD(r + wstride);
                    ss = wave_sum(ss);
                    const float rs = 1.0f / sqrtf(ss / D + EPS);
#pragma unroll
                    for (int i = 0; i < 4; ++i) { const int k4 = i * 64 + lane; const float4 w4 = aux[k4], sc = aux[(6 + bsel) * (D / 4) + k4], sh = aux[(1 + bsel) * (D / 4) + k4];
                        const float4 o = make_float4(v[i].x * rs * w4.x * (1.0f + sc.x) + sh.x, v[i].y * rs * w4.y * (1.0f + sc.y) + sh.y, v[i].z * rs * w4.z * (1.0f + sc.z) + sh.z, v[i].w * rs * w4.w * (1.0f + sc.w) + sh.w);
                        *(uint2*)(HB + (size_t)r * D + k4 * 4) = pk4(o); }
                }
#undef P1_LOAD
            }
            GSYNC();
        }
        {
            PHASE_BEGIN();
            pg8::Gemm g{HB, WIN_T, NTOK, IN_PAD, D, 0, 0}; pg8::StaticOrder so; so.init(NTOK, IN_PAD, G, bid);
            pg8::EpiBf16 E{PB, IN_COLS, IN_COLS};
            pg8::gemm_phase<pg8::EpiBf16, pg8::StaticOrder, true, true>(ldsb, g, so, E, tid);
            { const int nwg = (NTOK / 256) * (IN_PAD / 256), busy = nwg % G;
              if (busy != 0 && bid >= busy) CVT_MOE_RANGE(l, 0, (G - busy) * 8 * CVT_PER_WAVE, (bid - busy) * 8 + (tid >> 6), (G - busy) * 8);
              moe_done = busy != 0 ? (G - busy) * 8 * CVT_PER_WAVE : 0; }
            GSYNC();
        }
        {
            PHASE_BEGIN();
            const float* cw = kp_->in[I_CONVW] + (size_t)l * 3 * 768; const float* cb = kp_->in[I_CONVB] + (size_t)l * 768;
            {
                float* cwl = (float*)lds_raw;
                __syncthreads();
                for (int i = tid; i < 4 * 768; i += NTHREADS) cwl[i] = i < 3 * 768 ? cw[i] : cb[i - 3 * 768];
                __syncthreads();
                const int stride = gridDim.x * NTHREADS;
                for (int i0 = blockIdx.x * NTHREADS + tid; i0 < NTOK * 192; i0 += 4 * stride) {
                    uint2 u0[4], um[4], up[4];
#pragma unroll
                    for (int q = 0; q < 4; ++q) { const int i = i0 + q * stride; const unsigned z_ = (unsigned)tid >> 20; u0[q] = make_uint2(z_, z_); um[q] = u0[q]; up[q] = u0[q];
                        if (i < NTOK * 192) { const int c = (i % 192) * 4, r = i / 192; const bool lat = r < NLAT; const int L = lat ? S : CTX; const int t = lat ? r % S : (r - NLAT) % CTX;
                            const bf16_t* u = PB + (size_t)r * IN_COLS + C_XBC + c; u0[q] = *(const uint2*)u; if (t > 0) um[q] = *(const uint2*)(u - IN_COLS); if (t < L - 1) up[q] = *(const uint2*)(u + IN_COLS); } }
#pragma unroll
                    for (int q = 0; q < 4; ++q) { const int i = i0 + q * stride;
                        if (i < NTOK * 192) { const int c = (i % 192) * 4, r = i / 192;
                            float4 acc = f4add(*(const float4*)(cwl + 3 * 768 + c), f4mul(*(const float4*)(cwl + 768 + c), up4(u0[q])));
                            acc = f4add(acc, f4mul(*(const float4*)(cwl + c), up4(um[q]))); acc = f4add(acc, f4mul(*(const float4*)(cwl + 2 * 768 + c), up4(up[q])));
                            *(uint2*)(XBC + (size_t)r * 768 + c) = pk4(make_float4(siluf(acc.x), siluf(acc.y), siluf(acc.z), siluf(acc.w))); } }
                }
            }
            const float* dtb = kp_->in[I_DTB] + l * 16;
            ITEMS(i, NTOK * 16) { const int j = i % 16, r = i / 16; DT[i] = softplusf(bf2f(PB[(size_t)r * IN_COLS + C_DT + j]) + dtb[j]); }
            ITEMS(i, NTOK * 16) {
                const int g = i & 15, r = i >> 4; const int hm = g & 7, isk = g >> 3;
                const bool lat = r < NLAT; const int b = lat ? r / S : (r - NLAT) / CTX, t = lat ? r % S : (r - NLAT) % CTX;
                if (!isk && !lat && !ctx_out) continue;
                const bf16_t* vp = PB + (size_t)r * IN_COLS + (isk ? C_DK : C_DQ) + hm * 32;
                float v[32];
#pragma unroll
                for (int k = 0; k < 32; k += 4) { const float4 x = ld4h(vp + k); v[k] = x.x; v[k + 1] = x.y; v[k + 2] = x.z; v[k + 3] = x.w; }
                if (lat) rope32(v, t, ROPE);
                const float sc = isk ? 1.0f : 0.17677669529663687f * 1.4426950408889634f;
                bf16_t* dst = isk ? KD + ((size_t)(b * 8 + hm) * SK + (lat ? CTX + t : t)) * 32 : (lat ? QD + ((size_t)(b * 8 + hm) * S + t) * 32 : QDC + ((size_t)(b * 8 + hm) * CTX + t) * 32);
#pragma unroll
                for (int k = 0; k < 32; k += 8) *(uint4*)(dst + k) = make_uint4(pk2(v[k] * sc, v[k + 1] * sc), pk2(v[k + 2] * sc, v[k + 3] * sc), pk2(v[k + 4] * sc, v[k + 5] * sc), pk2(v[k + 6] * sc, v[k + 7] * sc));
            }
            ITEMS(i, NB * 4 * (SK / 8) * 64) {
                const int d = i & 63, j8 = (i >> 6) % (SK / 8), hh = (i / (64 * (SK / 8))) & 3, b = i / (256 * (SK / 8));
                const int r0 = j8 * 8 < CTX ? tok_row(false, b, j8 * 8) : tok_row(true, b, j8 * 8 - CTX);
                const bf16_t* sp = PB + (size_t)r0 * IN_COLS + C_DV + hh * 64 + d;
                unsigned v[8];
#pragma unroll
                for (int jj = 0; jj < 8; ++jj) v[jj] = sp[(size_t)jj * IN_COLS];
                *(uint4*)(VDT + ((size_t)(b * 4 + hh) * 64 + d) * SK + j8 * 8) = make_uint4(v[0] | (v[1] << 16), v[2] | (v[3] << 16), v[4] | (v[5] << 16), v[6] | (v[7] << 16));
            }
            const float* qn = kp_->in[I_QNORM] + l * 192; const float* kvn = kp_->in[I_KVNORM] + l * 128;
            { const int lane = tid & 63;
            uint2 xq = make_uint2((unsigned)tid >> 20, (unsigned)tid >> 20);
            const int wstride = gridDim.x * 8; int i = blockIdx.x * 8 + (tid >> 6);
#define NRM_LOAD(ii) do { const int wh_ = (ii) & 1, r_ = (ii) >> 1; if (lane < (wh_ ? 32 : 48)) xq = *(const uint2*)(PB + (size_t)r_ * IN_COLS + (wh_ ? C_CKV : C_CQ) + lane * 4); } while (0)
            if (i < NTOK * 2) NRM_LOAD(i);
            for (; i < NTOK * 2; i += wstride) {
                const int which = i & 1, r = i >> 1; const int n4 = which ? 32 : 48;
                const float4* w = (const float4*)(which ? kvn : qn);
                float4 x = make_float4(0.f, 0.f, 0.f, 0.f); if (lane < n4) x = up4(xq);
                if (i + wstride < NTOK * 2) NRM_LOAD(i + wstride);
                const float ss = wave_sum(f4dot(x, x));
                const float rs = 1.0f / sqrtf(ss / (n4 * 4) + EPS);
                bf16_t* dst = which ? CKVB + (size_t)r * 128 : CQB + (size_t)r * 256;
                if (lane < n4) *(uint2*)(dst + lane * 4) = pk4(f4scale(f4mul(x, w[lane]), rs));
                else if (!which) { const unsigned z_ = (unsigned)tid >> 20; *(uint2*)(dst + lane * 4) = make_uint2(z_, z_); }
            }
#undef NRM_LOAD
            }
            GSYNC();
        }
        {
            PHASE_BEGIN();
            const int half = (G * 5) / 8;
            if (bid < half) {
                pg8::Gemm g{CQB, WQ_T, NTOK, 512, 256, 0, 0}; pg8::StaticOrder so; so.init(NTOK, 512, half, bid);
                pg8::EpiBf16 E{MQ, 384, 384};
                pg8::gemm_phase<pg8::EpiBf16, pg8::StaticOrder, true, true>(ldsb, g, so, E, tid);
            } else {
                pg8::Gemm g{CKVB, WKV_T, NTOK, 512, 128, 0, 0}; pg8::StaticOrder so; so.init(NTOK, 512, G - half, bid - half);
                pg8::EpiBf16 E{MKV, 512, 512};
                pg8::gemm_phase<pg8::EpiBf16, pg8::StaticOrder, true, true>(ldsb, g, so, E, tid);
            }
            for (int it = vcu; it < NB * NCH * 8; it += G) {
                const int hp = it & 3, dir = (it >> 2) & 1, cp = (it >> 3) % NCH, b = it / (8 * NCH);
                const int k = dir ? (cp < 2 ? 1 - cp : 35 - cp) : cp;
                if (k == NCH - 1) continue;
                ssd_block<false>(b, dir, k, hp, XBC, DT, kp_->in[I_ALOG] + l * 16, HS, ALAST, nullptr, (float*)lds_raw, tid);
            }
            GSYNC();
        }
        {
            PHASE_BEGIN();
            ITEMS(i, NTOK * 8) {
                const int g = i & 7, r = i >> 3; const int hh = g & 3, isk = g >> 2;
                const bool lat = r < NLAT; const int b = lat ? r / S : (r - NLAT) / CTX, t = lat ? r % S : (r - NLAT) % CTX;
                if (!isk && !lat && !ctx_out) continue;
                const bf16_t* npb = isk ? MKV + (size_t)r * 512 + hh * 128 : MQ + (size_t)r * 384 + hh * 96;
                const bf16_t* rp = isk ? PB + (size_t)r * IN_COLS + C_KR : npb + 64;
                float v[32], np[64];
#pragma unroll
                for (int k = 0; k < 32; k += 4) { const float4 x = ld4h(rp + k); v[k] = x.x; v[k + 1] = x.y; v[k + 2] = x.z; v[k + 3] = x.w; }
#pragma unroll
                for (int k = 0; k < 64; k += 4) { const float4 x = ld4h(npb + k); np[k] = x.x; np[k + 1] = x.y; np[k + 2] = x.z; np[k + 3] = x.w; }
                if (lat) rope32(v, t, ROPE);
                const float sc = isk ? 1.0f : 0.10206207261596575f * 1.4426950408889634f;
                bf16_t* dst = isk ? KM + ((size_t)(b * 4 + hh) * SK + (lat ? CTX + t : t)) * 96 : (lat ? QM + ((size_t)(b * 4 + hh) * S + t) * 96 : QMC + ((size_t)(b * 4 + hh) * CTX + t) * 96);
#pragma unroll
                for (int k = 0; k < 64; k += 8) *(uint4*)(dst + k) = make_uint4(pk2(np[k] * sc, np[k + 1] * sc), pk2(np[k + 2] * sc, np[k + 3] * sc), pk2(np[k + 4] * sc, np[k + 5] * sc), pk2(np[k + 6] * sc, np[k + 7] * sc));
#pragma unroll
                for (int k = 0; k < 32; k += 8) *(uint4*)(dst + 64 + k) = make_uint4(pk2(v[k] * sc, v[k + 1] * sc), pk2(v[k + 2] * sc, v[k + 3] * sc), pk2(v[k + 4] * sc, v[k + 5] * sc), pk2(v[k + 6] * sc, v[k + 7] * sc));
            }
            ITEMS(i, NB * 4 * (SK / 8) * 64) {
                const int d = i & 63, j8 = (i >> 6) % (SK / 8), hh = (i / (64 * (SK / 8))) & 3, b = i / (256 * (SK / 8));
                const int r0 = j8 * 8 < CTX ? tok_row(false, b, j8 * 8) : tok_row(true, b, j8 * 8 - CTX);
                const bf16_t* sp = MKV + (size_t)r0 * 512 + hh * 128 + 64 + d;
                unsigned v[8];
#pragma unroll
                for (int jj = 0; jj < 8; ++jj) v[jj] = sp[(size_t)jj * 512];
                *(uint4*)(VMT + ((size_t)(b * 4 + hh) * 64 + d) * SK + j8 * 8) = make_uint4(v[0] | (v[1] << 16), v[2] | (v[3] << 16), v[4] | (v[5] << 16), v[6] | (v[7] << 16));
            }
            ITEMS(i, NB * 2 * 8 * 4096) {
                const int e = i & 4095, h = (i >> 12) & 7, bd = i >> 15;
                float* hp0 = HS + ((size_t)bd * NCH * 8 + h) * 4096 + e; const float* al0 = ALAST + (size_t)bd * NCH * 8 + h;
                float sv[NCH - 1], dk[NCH - 1];
#pragma unroll
                for (int k = 0; k < NCH - 1; ++k) { sv[k] = hp0[(size_t)k * 8 * 4096]; dk[k] = al0[k * 8]; }
                float Hc = 0.f;
#pragma unroll
                for (int k = 0; k < NCH; ++k) { hp0[(size_t)k * 8 * 4096] = Hc; if (k < NCH - 1) Hc = Hc * __expf(dk[k]) + sv[k]; }
            }
            GSYNC();
        }
        {
            PHASE_BEGIN();
            for (int kq = 0; kq * G < NB * 2 * NCH * 4; ++kq) {
                int it = vcu + kq * G;
                { const int T_ = NB * 2 * NCH * 4, full_ = (T_ / G) * G, rem_ = T_ - full_;
                  if (ctx_out && kq * G == full_) it = vcu >= G - rem_ ? full_ + vcu - (G - rem_) : T_; }
                if (it >= NB * 2 * NCH * 4) continue;
                const int hp = it & 3, dir = (it >> 2) & 1, cp = (it >> 3) % NCH, b = it / (8 * NCH);
                const int k = dir ? (cp < 2 ? 1 - cp : 35 - cp) : cp;
                if (k < 2 && !ctx_out) continue;
                ssd_block<true>(b, dir, k, hp, XBC, DT, kp_->in[I_ALOG] + l * 16, HS, ALAST, YD, (float*)lds_raw, tid);
            }
            const int lane = tid & 63, wave = tid >> 6, qr = lane & 31, hf = lane >> 5;
            {
                const float* lq1 = kp_->in[I_LQ1] + l * 32; const float* lk1 = kp_->in[I_LK1] + l * 32; const float* lq2 = kp_->in[I_LQ2] + l * 32; const float* lk2 = kp_->in[I_LK2] + l * 32;
                const float* subw = kp_->in[I_SUBLN] + l * 64;
                const int nlat = NB * 4 * (S / 256), nit = nlat + (ctx_out ? NB * 4 : 0);
                for (int it = vcu; it < nit; it += G) {
                    const bool lat = it < nlat; const int u = lat ? it : it - nlat;
                    const int qb = lat ? u % (S / 256) : 0, hh = lat ? (u / (S / 256)) % 4 : u % 4, b = lat ? u / (4 * (S / 256)) : u / 4;
                    const int t = qb * 256 + wave * 32 + qr; const int row = tok_row(lat, b, t); const int nkt = lat ? SK / 64 : CTX / 64;
                    f32x16 oacc[2]; unsigned o1p[2][8];
#pragma unroll 1
                    for (int mp = 0; mp < 2; ++mp) {
                        const int hm = hh * 2 + mp;
                        const bf16_t* qrow = lat ? QD + ((size_t)(b * 8 + hm) * S + t) * 32 : QDC + ((size_t)(b * 8 + hm) * CTX + t) * 32;
                        float l_run = 0.f;
#pragma unroll
                        for (int i = 0; i < 16; ++i) { oacc[0][i] = 0.f; oacc[1][i] = 0.f; }
                        attn_pass<32>(qrow, KD + (size_t)(b * 8 + hm) * SK * 32, VDT + (size_t)(b * 4 + hh) * 64 * SK, SK, nkt, ldsb, tid, oacc, l_run);
                        l_run = xor32_sum(l_run);
                        if (mp == 0) { const float i1 = 1.0f / l_run;
#pragma unroll
                            for (int db = 0; db < 2; ++db)
#pragma unroll
                                for (int i = 0; i < 8; ++i) o1p[db][i] = pk2(oacc[db][2 * i] * i1, oacc[db][2 * i + 1] * i1); }
                        else {
                            float d1 = 0.f, d2 = 0.f; for (int k = 0; k < 32; ++k) { d1 += lq1[k] * lk1[k]; d2 += lq2[k] * lk2[k]; }
                            const float lam = expf(d1) - expf(d2) + lambda_init;
                            const float i2 = lam / l_run; float ss = 0.f; f32x16 o1[2];
#pragma unroll
                            for (int db = 0; db < 2; ++db)
#pragma unroll
                                for (int i = 0; i < 16; ++i) { const float a1 = __uint_as_float((i & 1) ? (o1p[db][i >> 1] & 0xffff0000u) : (o1p[db][i >> 1] << 16)); const float v = a1 - oacc[db][i] * i2; o1[db][i] = v; ss += v * v; }
                            ss = xor32_sum(ss);
                            const float rs = (1.0f - lambda_init) / sqrtf(ss / 64 + EPS);
                            bf16_t* orow = MIXB + (size_t)row * MIXW + 512 + hh * 64;
#pragma unroll
                            for (int db = 0; db < 2; ++db)
#pragma unroll
                                for (int gq = 0; gq < 4; ++gq) { const int d0 = 32 * db + 8 * gq + 4 * hf; const float4 w4 = *(const float4*)(subw + d0);
                                    *(uint2*)(orow + d0) = make_uint2(pk2(o1[db][4 * gq] * rs * w4.x, o1[db][4 * gq + 1] * rs * w4.y), pk2(o1[db][4 * gq + 2] * rs * w4.z, o1[db][4 * gq + 3] * rs * w4.w)); }
                        }
                    }
                }
            }
            {
                const int nlat = NB * 4 * (S / 256), nit = nlat + (ctx_out ? NB * 4 : 0);
                for (int it = vcu; it < nit; it += G) {
                    const bool lat = it < nlat; const int u = lat ? it : it - nlat;
                    const int qb = lat ? u % (S / 256) : 0, hh = lat ? (u / (S / 256)) % 4 : u % 4, b = lat ? u / (4 * (S / 256)) : u / 4;
                    const int t = qb * 256 + wave * 32 + qr; const int row = tok_row(lat, b, t); const int nkt = lat ? SK / 64 : CTX / 64;
                    const bf16_t* qrow = lat ? QM + ((size_t)(b * 4 + hh) * S + t) * 96 : QMC + ((size_t)(b * 4 + hh) * CTX + t) * 96;
                    f32x16 oacc[2]; float l_run = 0.f;
#pragma unroll
                    for (int i = 0; i < 16; ++i) { oacc[0][i] = 0.f; oacc[1][i] = 0.f; }
                    attn_pass<96>(qrow, KM + (size_t)(b * 4 + hh) * SK * 96, VMT + (size_t)(b * 4 + hh) * 64 * SK, SK, nkt, ldsb, tid, oacc, l_run);
                    l_run = xor32_sum(l_run);
                    const float inv = 1.0f / l_run;
                    bf16_t* orow = MIXB + (size_t)row * MIXW + 768 + hh * 64;
#pragma unroll
                    for (int db = 0; db < 2; ++db)
#pragma unroll
                        for (int gq = 0; gq < 4; ++gq) { const int d0 = 32 * db + 8 * gq + 4 * hf;
                            *(uint2*)(orow + d0) = make_uint2(pk2(oacc[db][4 * gq] * inv, oacc[db][4 * gq + 1] * inv), pk2(oacc[db][4 * gq + 2] * inv, oacc[db][4 * gq + 3] * inv)); }
                }
            }
            GSYNC();
        }
        {
            PHASE_BEGIN();
            const float* nw = kp_->in[I_SSDN] + l * 512; const float* dsk = kp_->in[I_SSDD] + l * 8;
            const int lane = tid & 63;
            uint2 q0, q1, q2, q3; { const unsigned z_ = (unsigned)tid >> 20; q0 = make_uint2(z_, z_); q1 = q0; q2 = q0; q3 = q0; }
            const int wstride = gridDim.x * 8; int i = blockIdx.x * 8 + (tid >> 6);
#define GN_LOAD(ii) do { const int g_ = (ii) & 1, r_ = (ii) >> 1, c_ = g_ * 256 + lane * 4; q0 = *(const uint2*)(XBC + (size_t)r_ * 768 + c_); q1 = *(const uint2*)(YD + (size_t)r_ * 512 + c_); \
                q2 = *(const uint2*)(YD + ((size_t)NTOK + r_) * 512 + c_); q3 = *(const uint2*)(PB + (size_t)r_ * IN_COLS + C_Z + c_); } while (0)
            if (i < nrows_out * 2) GN_LOAD(i);
            for (; i < nrows_out * 2; i += wstride) {
                const int g = i & 1, r = i >> 1, c = g * 256 + lane * 4;
                const float4 x = up4(q0), y0 = up4(q1), y1 = up4(q2), z = up4(q3);
                if (i + wstride < nrows_out * 2) GN_LOAD(i + wstride);
                const float ds = dsk[c >> 6];
                float4 v = make_float4((ds * x.x + y0.x + y1.x) * siluf(z.x), (ds * x.y + y0.y + y1.y) * siluf(z.y), (ds * x.z + y0.z + y1.z) * siluf(z.z), (ds * x.w + y0.w + y1.w) * siluf(z.w));
                const float ss = wave_sum(f4dot(v, v));
                const float rs = 1.0f / sqrtf(ss / 256 + EPS);
                *(uint2*)(MIXB + (size_t)r * MIXW + c) = pk4(f4scale(f4mul(v, *(const float4*)(nw + c)), rs));
            }
#undef GN_LOAD
            GSYNC();
        }
        {
            PHASE_BEGIN();
            pg8::Gemm g{MIXB, WOUT_T, nrows_out, D, MIXW, 0, 0}; pg8::StaticOrder so; so.init(nrows_out, D, G, bid);
            pg8::EpiBf16 E{MOUT, D, D};
            pg8::gemm_phase<pg8::EpiBf16, pg8::StaticOrder, true, true>(ldsb, g, so, E, tid);
            { const int nwg = (nrows_out / 256) * (D / 256), busy = nwg % G; const int id0 = moe_done;
              if (busy != 0 && bid >= busy) CVT_MOE_RANGE(l, id0, id0 + (G - busy) * 8 * CVT_PER_WAVE, (bid - busy) * 8 + (tid >> 6), (G - busy) * 8);
              if (busy != 0) moe_done = id0 + (G - busy) * 8 * CVT_PER_WAVE; }
            GSYNC();
        }
        {
            PHASE_BEGIN();
            const float* wpost = kp_->in[I_NMPOST] + l * D; const float* wpre = kp_->in[I_NFPRE] + l * D;
            const float* rw = kp_->in[I_RW] + (size_t)l * D * NE; const float* rb = kp_->in[I_RB] + l * NE;
            const int lane = tid & 63;
            float* rwl = (float*)lds_raw;
            for (int i = tid; i < D * NE / 4; i += NTHREADS) { const int k = i >> 2, e4 = i & 3; ((float4*)rwl)[(((k & 3) * 256 + (k >> 2)) << 2) + e4] = ((const float4*)rw)[i]; }
            float4* aux = (float4*)(rwl + D * NE);
            for (int i = tid; i < 17 * (D / 4); i += NTHREADS) { const int v = i / (D / 4), k4 = i % (D / 4);
                const float* src = v == 0 ? wpost : v == 1 ? wpre : modl + (size_t)((v - 2) % 5) * NMOD * D + (2 + (v - 2) / 5) * D;
                aux[i] = ((const float4*)src)[k4]; }
            __syncthreads();
            uint2 mq[4]; float4 xq[4];
            { const float zf_ = (float)(tid >> 20);
#pragma unroll
              for (int i = 0; i < 4; ++i) { xq[i] = make_float4(zf_, zf_, zf_, zf_); mq[i] = make_uint2((unsigned)tid >> 20, (unsigned)tid >> 20); } }
            const int wstride = gridDim.x * 8; int r = blockIdx.x * 8 + (tid >> 6);
#define P7_LOAD(rr) do { const float4* xin_ = (const float4*)((rr) < NLAT ? XSRC + (size_t)(rr) * D : CSRC + (size_t)((rr) - NLAT) * D); const bf16_t* m_ = MOUT + (size_t)(rr) * D; \
                _Pragma("unroll") for (int i = 0; i < 4; ++i) { mq[i] = *(const uint2*)(m_ + (i * 64 + lane) * 4); xq[i] = xin_[i * 64 + lane]; } } while (0)
            if (r < nrows_out) P7_LOAD(r);
            for (; r < nrows_out; r += wstride) {
                float4* xr = (float4*)(r < NLAT ? xcur + (size_t)r * D : CTXC + (size_t)(r - NLAT) * D);
                const int bsel = r < NLAT ? r / S : NB;
                float4 mv[4], xv[4]; float ss = 0.f;
#pragma unroll
                for (int i = 0; i < 4; ++i) { mv[i] = up4(mq[i]); xv[i] = xq[i]; ss += f4dot(mv[i], mv[i]); }
                if (r + wstride < nrows_out) P7_LOAD(r + wstride);
                ss = wave_sum(ss);
                const float rs = 1.0f / sqrtf(ss / D + EPS);
                float s2 = 0.f;
#pragma unroll
                for (int i = 0; i < 4; ++i) { const int k4 = i * 64 + lane;
                    xv[i] = f4add(xv[i], f4mul(aux[(2 + bsel) * (D / 4) + k4], f4scale(f4mul(mv[i], aux[k4]), rs))); xr[k4] = xv[i]; s2 += f4dot(xv[i], xv[i]); }
                s2 = wave_sum(s2);
                const float r2 = 1.0f / sqrtf(s2 / D + EPS);
                float lg[NE];
#pragma unroll
                for (int e = 0; e < NE; ++e) lg[e] = 0.f;
#pragma unroll
                for (int i = 0; i < 4; ++i) { const int k4 = i * 64 + lane; const float4 w4 = aux[(D / 4) + k4], sc = aux[(12 + bsel) * (D / 4) + k4], sh = aux[(7 + bsel) * (D / 4) + k4];
                    const float hv[4] = {xv[i].x * r2 * w4.x * (1.0f + sc.x) + sh.x, xv[i].y * r2 * w4.y * (1.0f + sc.y) + sh.y, xv[i].z * r2 * w4.z * (1.0f + sc.z) + sh.z, xv[i].w * r2 * w4.w * (1.0f + sc.w) + sh.w};
                    *(uint2*)(HB + (size_t)r * D + k4 * 4) = make_uint2(pk2(hv[0], hv[1]), pk2(hv[2], hv[3]));
#pragma unroll
                    for (int c = 0; c < 4; ++c) { const float4* rwp = (const float4*)(rwl + (size_t)(c * 256 + k4) * NE);
#pragma unroll
                        for (int e4 = 0; e4 < 4; ++e4) { const float4 w = rwp[e4]; lg[4 * e4] += hv[c] * w.x; lg[4 * e4 + 1] += hv[c] * w.y; lg[4 * e4 + 2] += hv[c] * w.z; lg[4 * e4 + 3] += hv[c] * w.w; }
                        SCHED_FENCE(); }
                }
#pragma unroll
                for (int e = 0; e < NE; ++e) lg[e] = wave_sum(lg[e]) + rb[e];
                float mx = lg[0];
#pragma unroll
                for (int e = 1; e < NE; ++e) mx = fmaxf(mx, lg[e]);
                float sum = 0.f;
#pragma unroll
                for (int e = 0; e < NE; ++e) { lg[e] = expf(lg[e] - mx); sum += lg[e]; }
                const float is = 1.0f / sum;
                float mine = lg[0];
#pragma unroll
                for (int e = 1; e < NE; ++e) mine = lane == e ? lg[e] : mine;
                if (lane < NE) AFF[(size_t)r * NE + lane] = mine * is;
            }
#undef P7_LOAD
            GSYNC();
        }
        {
            PHASE_BEGIN();
            CVT_MOE_RANGE(l, moe_done, MOE_TILES, bid * 8 + (tid >> 6), G * 8);
            {
                volatile int* sh = (volatile int*)lds_raw;
                const int nsel = (ctx_out ? 2 : 1) * NB * NE;
                for (int it = bid; it < nsel; it += G) {
                    const bool lat = it < NB * NE; const int u = lat ? it : it - NB * NE; const int e = u % NE, b = u / NE;
                    const int L = lat ? S : CTX, cap = lat ? CAP_L : CAP_C, npt = lat ? S / NTHREADS : 1, base = tok_row(lat, b, 0);
                    const bool act = lat || tid < CTX;
                    unsigned key[S / NTHREADS];
#pragma unroll
                    for (int i = 0; i < S / NTHREADS; ++i) key[i] = (act && i < npt) ? __float_as_uint(AFF[(size_t)(base + tid * npt + i) * NE + e]) : 0u;
                    __syncthreads();
                    unsigned T = 0u;
                    for (int bit = 30; bit >= 0; --bit) {
                        const unsigned cand = T | (1u << bit); int c = 0;
#pragma unroll
                        for (int i = 0; i < S / NTHREADS; ++i) c += (key[i] >= cand) ? 1 : 0;
                        if (block_sum(c, tid, sh, bit & 1) >= cap) T = cand;
                    }
                    int cg = 0, ct = 0;
#pragma unroll
                    for (int i = 0; i < S / NTHREADS; ++i) { cg += (key[i] > T) ? 1 : 0; ct += (key[i] == T && key[i] != 0u) ? 1 : 0; }
                    int tot_g, tot_t;
                    (void)block_excl_scan(cg, tid, sh, tot_g);
                    int tie_rank = block_excl_scan(ct, tid, sh, tot_t);
                    const int need = cap - tot_g;
                    int sel[S / NTHREADS], cs = 0;
#pragma unroll
                    for (int i = 0; i < S / NTHREADS; ++i) { const bool tie = key[i] == T && key[i] != 0u; sel[i] = (key[i] > T || (tie && tie_rank < need)) ? 1 : 0; tie_rank += tie ? 1 : 0; cs += sel[i]; }
                    int tot_s; int slot = block_excl_scan(cs, tid, sh, tot_s);
#pragma unroll
                    for (int i = 0; i < S / NTHREADS; ++i) if (act && i < npt) {
                        const int row = base + tid * npt + i; int sa = -1;
                        if (sel[i]) { sa = (lat ? b * CAP_L : NB * CAP_L + b * CAP_C) + slot; ++slot; SELIDX[e * ER_MAX + sa] = row; SELGATE[e * ER_MAX + sa] = __uint_as_float(key[i]); }
                        TOKSLOT[(size_t)row * NE + e] = sa;
                    }
                }
            }
            GSYNC();
        }
        {
            PHASE_BEGIN();
            const int used = ctx_out ? NB * (CAP_L + CAP_C) : NB * CAP_L;
            {
                const int lane = tid & 63, wstride = gridDim.x * 8, nrow = NE * ER;
                for (int r0 = (blockIdx.x * 8 + (tid >> 6)) * 4; r0 < nrow; r0 += wstride * 4) {
                    int src[4]; uint4 v0[4], v1[4];
#pragma unroll
                    for (int q = 0; q < 4; ++q) { const int rr = r0 + q, e = rr / ER, slot = rr % ER; src[q] = (rr < nrow && slot < used) ? SELIDX[e * ER_MAX + slot] : -1; }
#pragma unroll
                    for (int q = 0; q < 4; ++q) { const unsigned z_ = (unsigned)tid >> 20; v0[q] = make_uint4(z_, z_, z_, z_); v1[q] = v0[q];
                        if (src[q] >= 0) { const uint4* sp = (const uint4*)(HB + (size_t)src[q] * D); v0[q] = sp[lane]; v1[q] = sp[64 + lane]; } }
#pragma unroll
                    for (int q = 0; q < 4; ++q) if (r0 + q < nrow) { uint4* dp = (uint4*)(XG + (size_t)(r0 + q) * D); dp[lane] = v0[q]; dp[64 + lane] = v1[q]; }
                }
            }
            GSYNC();
        }
        {
            PHASE_BEGIN();
            pg8::Gemm g{XG, WGU_T, NE * ER, 2 * FF, D, ER / 256, (size_t)2 * FF * D * 2}; pg8::StaticOrder so; so.init(NE * ER, 2 * FF, G, bid);
            pg8::EpiSwiGLU E{HID, FF};
            pg8::gemm_phase<pg8::EpiSwiGLU, pg8::StaticOrder, true, true>(ldsb, g, so, E, tid);
            GSYNC();
        }
        {
            PHASE_BEGIN();
            pg8::Gemm g{HID, WD_T, NE * ER, D, FF, ER / 256, (size_t)D * FF * 2}; pg8::StaticOrder so; so.init(NE * ER, D, G, bid);
            pg8::EpiRowScaleBf16 E{Y, D, SELGATE, ER};
            pg8::gemm_phase<pg8::EpiRowScaleBf16, pg8::StaticOrder, true, true>(ldsb, g, so, E, tid);
            GSYNC();
        }
        {
            PHASE_BEGIN();
            const float* wpost = kp_->in[I_NFPOST] + l * D;
            const int lane = tid & 63;
            {
                float4 xq[4]; int slq = -1;
                { const float zf_ = (float)(tid >> 20);
#pragma unroll
                  for (int i = 0; i < 4; ++i) xq[i] = make_float4(zf_, zf_, zf_, zf_); }
                float4* aux = (float4*)lds_raw;
                __syncthreads();
                for (int i = tid; i < 6 * (D / 4); i += NTHREADS) { const int v = i / (D / 4), k4 = i % (D / 4);
                    const float* src = v == 0 ? wpost : modl + (size_t)(v - 1) * NMOD * D + 5 * D;
                    aux[i] = ((const float4*)src)[k4]; }
                __syncthreads();
                const int wstride = gridDim.x * 8; int r = blockIdx.x * 8 + (tid >> 6);
#define P11_LOAD(rr) do { const float4* xin_ = (const float4*)((rr) < NLAT ? xcur + (size_t)(rr) * D : CTXC + (size_t)((rr) - NLAT) * D); slq = lane < NE ? TOKSLOT[(size_t)(rr) * NE + lane] : -1; \
                    _Pragma("unroll") for (int i = 0; i < 4; ++i) xq[i] = xin_[i * 64 + lane]; } while (0)
                if (r < nrows_out) P11_LOAD(r);
                for (; r < nrows_out; r += wstride) {
                    float4* xr = (float4*)(r < NLAT ? xcur + (size_t)r * D : CTXC + (size_t)(r - NLAT) * D);
                    const int bsel = r < NLAT ? r / S : NB;
                    const int myslot = slq; float4 xv[4], f[4];
#pragma unroll
                    for (int i = 0; i < 4; ++i) { xv[i] = xq[i]; f[i] = make_float4(0.f, 0.f, 0.f, 0.f); }
                    {
                        unsigned msk = (unsigned)__ballot(myslot >= 0) & 0xffffu;
                        const bf16_t* zrow = (const bf16_t*)(kp_->ws + WS_CTL + 32768);
                        const bf16_t* yp[4];
#pragma unroll
                        for (int q = 0; q < 4; ++q) { yp[q] = zrow;
                            if (msk) { const int e = __builtin_ctz(msk); msk &= msk - 1; const int sl = __builtin_amdgcn_readlane(myslot, e); yp[q] = Y + ((size_t)e * ER + sl) * D; } }
                        uint2 yv[4][4];
#pragma unroll
                        for (int q = 0; q < 4; ++q)
#pragma unroll
                            for (int i = 0; i < 4; ++i) yv[q][i] = *(const uint2*)(yp[q] + (i * 64 + lane) * 4);
#pragma unroll
                        for (int q = 0; q < 4; ++q)
#pragma unroll
                            for (int i = 0; i < 4; ++i) f[i] = f4add(f[i], up4(yv[q][i]));
                        while (msk) { const int e = __builtin_ctz(msk); msk &= msk - 1; const int sl = __builtin_amdgcn_readlane(myslot, e); const bf16_t* ypx = Y + ((size_t)e * ER + sl) * D;
#pragma unroll
                            for (int i = 0; i < 4; ++i) f[i] = f4add(f[i], ld4h(ypx + (i * 64 + lane) * 4)); }
                    }
                    if (r + wstride < nrows_out) P11_LOAD(r + wstride);
                    float ss = 0.f;
#pragma unroll
                    for (int i = 0; i < 4; ++i) ss += f4dot(f[i], f[i]);
                    ss = wave_sum(ss);
                    const float rs = 1.0f / sqrtf(ss / D + EPS);
#pragma unroll
                    for (int i = 0; i < 4; ++i) { const int k4 = i * 64 + lane; xr[k4] = f4add(xv[i], f4mul(aux[(1 + bsel) * (D / 4) + k4], f4scale(f4mul(f[i], aux[k4]), rs))); }
                }
#undef P11_LOAD
            }
            GSYNC();
        }
    }
}

extern "C" void kernel_launch(void* const* d_in, const int* in_sizes, int n_in, void* d_out, int out_size, void* d_ws, size_t ws_size, hipStream_t stream) {
    static int grid = 0;
    if (grid == 0) {
        if (n_in != N_IN || out_size != NLAT * D || ws_size < WS_END) { fprintf(stderr, "kernel_launch: unexpected shapes: n_in %d out %d ws %zu (need %zu)\n", n_in, out_size, ws_size, (size_t)WS_END); grid = -1; return; }
        int dev = 0, cus = 0, per_cu = 0;
        (void)hipGetDevice(&dev);
        (void)hipDeviceGetAttribute(&cus, hipDeviceAttributeMultiprocessorCount, dev);
        (void)hipFuncSetAttribute((const void*)mk_forward, hipFuncAttributeMaxDynamicSharedMemorySize, LDS_BYTES);
        (void)hipOccupancyMaxActiveBlocksPerMultiprocessor(&per_cu, (const void*)mk_forward, NTHREADS, LDS_BYTES);
        (void)hipGetLastError();
        if (per_cu < 1) { fprintf(stderr, "kernel_launch: occupancy query says %d blocks/CU\n", per_cu); grid = -1; return; }
        grid = cus;
    }
    if (grid < 0) return;
    (void)hipMemsetAsync((char*)d_ws + WS_CTL, 0, CTL_BYTES, stream);
    Prm p{};
    for (int i = 0; i < N_IN; ++i) p.in[i] = (const float*)d_in[i];
    p.out = (float*)d_out; p.ws = (char*)d_ws;
    void* args[] = {&p};
    hipError_t e = hipLaunchCooperativeKernel((const void*)mk_forward, dim3(grid), dim3(NTHREADS), args, LDS_BYTES, stream);
    if (e != hipSuccess) fprintf(stderr, "kernel_launch: cooperative launch failed: %s (grid %d)\n", hipGetErrorString(e), grid);
}
```

```cpp
#include <hip/hip_runtime.h>
#include <cstdio>
#include <cstdint>

constexpr int D = 1024, NB = 4, S = 4096, CTX = 256, FF = 1024;
constexpr int DEPTH = 2, GRID_W = 64, NMOD = 6, NE = 16;
constexpr int NLAT = NB * S, NCTX = NB * CTX, NTOK = NLAT + NCTX;
constexpr int IN_COLS = 2416, IN_PAD = 2560;
constexpr int C_Z = 0, C_XBC = 512, C_DT = 1280, C_DQ = 1296, C_DK = 1552, C_DV = 1808, C_CQ = 2064, C_CKV = 2256, C_KR = 2384;
constexpr int MIXW = 1024;
constexpr int CAP_L = 2 * S / NE, CAP_C = 2 * CTX / NE;
constexpr int ER_MAX = 2304;
constexpr float EPS = 1e-6f;
static_assert(NB * CAP_L == 2048 && NB * CAP_C == 128, "expert row layout");

enum { I_X = 0, I_C, I_CTX, I_CCTX, I_ADAW, I_ADAB, I_NMPRE, I_NMPOST, I_NFPRE, I_NFPOST, I_WIN, I_CONVW, I_CONVB, I_ALOG, I_DTB, I_SSDD, I_SSDN,
       I_LQ1, I_LK1, I_LQ2, I_LK2, I_SUBLN, I_QNORM, I_WQUP, I_KVNORM, I_WKVUP, I_WOUT, I_RW, I_RB, I_WG, I_WU, I_WD, N_IN };
struct Prm { const float* in[N_IN]; float* out; char* ws; };

typedef unsigned short bf16_t;
constexpr size_t al256(size_t x) { return (x + 255) & ~(size_t)255; }
constexpr size_t WS_CTL = 0, CTL_BYTES = 65536;
constexpr size_t WS_MOD = WS_CTL + CTL_BYTES;
constexpr size_t WS_CTXC = al256(WS_MOD + (size_t)DEPTH * (NB + 1) * NMOD * D * 4);
constexpr size_t WS_AFF = al256(WS_CTXC + (size_t)NCTX * D * 4);
constexpr size_t WS_TOKSLOT = al256(WS_AFF + (size_t)NTOK * NE * 4);
constexpr size_t WS_SELIDX = al256(WS_TOKSLOT + (size_t)NTOK * NE * 4);
constexpr size_t WS_SELGATE = al256(WS_SELIDX + (size_t)NE * ER_MAX * 4);
constexpr size_t WS_DT = al256(WS_SELGATE + (size_t)NE * ER_MAX * 4);
constexpr int NCH = 34;
constexpr size_t WS_ROPE = al256(WS_DT + (size_t)NTOK * 16 * 4);
constexpr size_t WS_ALAST = al256(WS_ROPE + (size_t)S * 32 * 4);
constexpr size_t WS_HB = al256(WS_ALAST + (size_t)NB * 2 * NCH * 8 * 4);
constexpr size_t WS_P = al256(WS_HB + (size_t)NTOK * D * 2);
constexpr size_t WS_G2 = al256(WS_P + (size_t)NTOK * IN_COLS * 4);
constexpr size_t WS_XBC = WS_G2;
constexpr size_t WS_MQ = al256(WS_XBC + (size_t)NTOK * 768 * 4);
constexpr size_t WS_MKV = al256(WS_MQ + (size_t)NTOK * 384 * 4);
constexpr size_t WS_CQB = al256(WS_MKV + (size_t)NTOK * 512 * 4);
constexpr size_t WS_CKVB = al256(WS_CQB + (size_t)NTOK * 256 * 2);
constexpr size_t WS_MIXB = al256(WS_CKVB + (size_t)NTOK * 128 * 2);
constexpr size_t WS_G2END = al256(WS_MIXB + (size_t)NTOK * MIXW * 2);
constexpr size_t WS_HS = WS_HB;
constexpr size_t WS_YD = WS_MQ;
constexpr size_t WS_MOUT = WS_P;
constexpr size_t WS_XG = WS_P;
constexpr size_t WS_HID = al256(WS_XG + (size_t)NE * ER_MAX * D * 2);
constexpr size_t WS_Y = WS_G2;
constexpr size_t WS_WIN = WS_G2END;
constexpr size_t WS_WQ = al256(WS_WIN + (size_t)IN_PAD * D * 2);
constexpr size_t WS_WKV = al256(WS_WQ + (size_t)512 * 256 * 2);
constexpr size_t WS_WOUT = al256(WS_WKV + (size_t)512 * 128 * 2);
constexpr size_t WS_WGU = al256(WS_WOUT + (size_t)D * MIXW * 2);
constexpr size_t WS_WD = al256(WS_WGU + (size_t)NE * 2 * FF * D * 2);
constexpr size_t WS_END = al256(WS_WD + (size_t)NE * D * FF * 2);
constexpr int SK = CTX + S;
constexpr size_t WS_QD = al256(WS_P + (size_t)NTOK * IN_COLS * 2);
constexpr size_t WS_QDC = al256(WS_QD + (size_t)NB * 8 * S * 32 * 2);
constexpr size_t WS_KD = al256(WS_QDC + (size_t)NB * 8 * CTX * 32 * 2);
constexpr size_t WS_VDT = al256(WS_KD + (size_t)NB * 8 * SK * 32 * 2);
constexpr size_t WS_QM = al256(WS_VDT + (size_t)NB * 4 * 64 * SK * 2);
constexpr size_t WS_QMC = al256(WS_QM + (size_t)NB * 4 * S * 96 * 2);
constexpr size_t WS_KM = al256(WS_QMC + (size_t)NB * 4 * CTX * 96 * 2);
constexpr size_t WS_VMT = al256(WS_KM + (size_t)NB * 4 * SK * 96 * 2);
constexpr size_t WS_ATTEND = al256(WS_VMT + (size_t)NB * 4 * 64 * SK * 2);
static_assert(WS_ATTEND <= WS_G2, "attention operands fit in the spare half of the P slot");
static_assert(WS_HID + (size_t)NE * ER_MAX * FF * 2 <= WS_G2, "XG+HID fit in the P region");
static_assert((size_t)NE * ER_MAX * D * 4 <= WS_G2END - WS_G2, "Y fits in the G2 region");
static_assert((size_t)NB * 2 * NCH * 8 * 4096 * 4 <= (size_t)NTOK * D * 2, "HS fits in HB");
static_assert(WS_YD + (size_t)2 * NTOK * 512 * 4 <= WS_MIXB, "YD ends below MIXB");

#define LAS __attribute__((address_space(3)))
constexpr int NTHREADS = 512;
constexpr int LDS_BYTES = 147456;
#define ITEMS(i, n) for (int i = blockIdx.x * NTHREADS + tid; i < (n); i += gridDim.x * NTHREADS)

__device__ __forceinline__ float siluf(float x) { return x / (1.0f + expf(-x)); }
__device__ __forceinline__ float softplusf(float x) { return x > 20.f ? x : log1pf(expf(x)); }
__device__ __forceinline__ unsigned f2bf(float f) { unsigned u = __builtin_bit_cast(unsigned, f); return (u + 0x7fffu + ((u >> 16) & 1u)) >> 16; }
typedef float f32x2_t __attribute__((ext_vector_type(2)));
typedef __bf16 bf16x2_t __attribute__((ext_vector_type(2)));
__device__ __forceinline__ unsigned pk2(float lo, float hi) { const f32x2_t v = {lo, hi}; return __builtin_bit_cast(unsigned, __builtin_convertvector(v, bf16x2_t)); }
__device__ __forceinline__ float bf2f(bf16_t h) { return __builtin_bit_cast(float, (unsigned)h << 16); }
#define SCHED_FENCE() __builtin_amdgcn_sched_barrier(0)
__device__ __forceinline__ int mk_tid_impl(int wave_s) { unsigned z; asm volatile("s_mov_b32 %0, 0" : "=s"(z));
    return (wave_s << 6) | (int)__builtin_amdgcn_mbcnt_hi(~0u, __builtin_amdgcn_mbcnt_lo(~0u, z)); }
__device__ __forceinline__ float dpp_row_shr(float v, int n) {
    const int iv = __builtin_bit_cast(int, v); int r;
    switch (n) { case 1: r = __builtin_amdgcn_update_dpp(0, iv, 0x111, 0xf, 0xf, true); break; case 2: r = __builtin_amdgcn_update_dpp(0, iv, 0x112, 0xf, 0xf, true); break;
                 case 4: r = __builtin_amdgcn_update_dpp(0, iv, 0x114, 0xf, 0xf, true); break; default: r = __builtin_amdgcn_update_dpp(0, iv, 0x118, 0xf, 0xf, true); break; }
    return __builtin_bit_cast(float, r);
}
__device__ __forceinline__ float wave_sum(float v) {
    v += dpp_row_shr(v, 1); v += dpp_row_shr(v, 2); v += dpp_row_shr(v, 4); v += dpp_row_shr(v, 8);
    v += __builtin_bit_cast(float, __builtin_amdgcn_update_dpp(0, __builtin_bit_cast(int, v), 0x142, 0xa, 0xf, false));
    v += __builtin_bit_cast(float, __builtin_amdgcn_update_dpp(0, __builtin_bit_cast(int, v), 0x143, 0xc, 0xf, false));
    return __builtin_bit_cast(float, __builtin_amdgcn_readlane(__builtin_bit_cast(int, v), 63)); }
__device__ __forceinline__ float xor32_max(float x) { auto t = __builtin_amdgcn_permlane32_swap(__float_as_uint(x), __float_as_uint(x), false, false); return fmaxf(__uint_as_float(t[0]), __uint_as_float(t[1])); }
__device__ __forceinline__ float xor32_sum(float x) { auto t = __builtin_amdgcn_permlane32_swap(__float_as_uint(x), __float_as_uint(x), false, false); return __uint_as_float(t[0]) + __uint_as_float(t[1]); }
#define WITEMS(i, n) for (int i = blockIdx.x * 8 + (tid >> 6); i < (n); i += gridDim.x * 8)
__device__ __forceinline__ float4 f4mul(float4 a, float4 b) { return make_float4(a.x * b.x, a.y * b.y, a.z * b.z, a.w * b.w); }
__device__ __forceinline__ float4 f4add(float4 a, float4 b) { return make_float4(a.x + b.x, a.y + b.y, a.z + b.z, a.w + b.w); }
__device__ __forceinline__ float4 f4scale(float4 a, float s) { return make_float4(a.x * s, a.y * s, a.z * s, a.w * s); }
__device__ __forceinline__ float f4dot(float4 a, float4 b) { return a.x * b.x + a.y * b.y + a.z * b.z + a.w * b.w; }
__device__ __forceinline__ uint2 pk4(float4 v) { return make_uint2(pk2(v.x, v.y), pk2(v.z, v.w)); }
__device__ __forceinline__ float4 up4(uint2 u) { return make_float4(__uint_as_float(u.x << 16), __uint_as_float(u.x & 0xffff0000u), __uint_as_float(u.y << 16), __uint_as_float(u.y & 0xffff0000u)); }
__device__ __forceinline__ float4 ld4h(const bf16_t* p) { return up4(*(const uint2*)p); }

__device__ __forceinline__ void rope32(float* v, int t, const float* tab) {
    const float4* tp = (const float4*)(tab + (size_t)t * 32);
    float cs[32];
#pragma unroll
    for (int i = 0; i < 8; ++i) { const float4 x = tp[i]; cs[4 * i] = x.x; cs[4 * i + 1] = x.y; cs[4 * i + 2] = x.z; cs[4 * i + 3] = x.w; }
#pragma unroll
    for (int i = 0; i < 8; ++i) {
        { const float c = cs[i], sn = cs[8 + i]; const float x1 = v[i], x2 = v[8 + i]; v[i] = x1 * c - x2 * sn; v[8 + i] = x1 * sn + x2 * c; }
        { const float c = cs[16 + i], sn = cs[24 + i]; const float x1 = v[16 + i], x2 = v[24 + i]; v[16 + i] = x1 * c - x2 * sn; v[24 + i] = x1 * sn + x2 * c; }
    }
}
__device__ __forceinline__ int tok_row(bool lat, int b, int t) { return lat ? b * S + t : NLAT + b * CTX + t; }

namespace pg8 {
#define PG8_LAS __attribute__((address_space(3)))
typedef short bf16x8 __attribute__((ext_vector_type(8)));
typedef float f32x4 __attribute__((ext_vector_type(4)));
typedef unsigned u32x4 __attribute__((ext_vector_type(4)));
constexpr int BM = 256, BK = 64, HALF = 128, HTB = HALF * BK * 2  , STAGE_BYTES = 8 * HTB, NXCD = 8, WGM = 16;

__host__ __device__ __forceinline__ int lds_byte(int r, int c) { const int st = (r >> 4) * 2 + (c >> 5), rr = r & 15, cc = c & 31, ob = rr * 64 + cc * 2; return st * 1024 + (ob ^ (((ob >> 9) & 1) << 5)); }
__host__ __device__ __forceinline__ void stage_rc(int b, int& R, int& C) { const int st = b / 1024, sb = b % 1024, swz = sb ^ (((sb >> 9) & 1) << 5); R = (st >> 1) * 16 + swz / 64; C = (st & 1) * 32 + (swz % 64) / 2; }
__host__ __device__ __forceinline__ int perm32(int rho) { const int n = rho >> 4, i = rho & 15; return 8 * (i >> 2) + 4 * n + (i & 3); }

struct Unit { int pm, pn; };
struct Gemm { const bf16_t* A; const bf16_t* Bt; int M, N, K; int grp_tiles; size_t grp_stride; };

struct StaticOrder {
    int nM, nN, nwg, G, c;
    __host__ __device__ void init(int M, int N, int G_, int c_) { nM = M / BM; nN = N / BM; nwg = nM * nN; G = G_; c = c_; }
    __host__ __device__ bool next(int i, Unit& u) const {
        const long L = (long)i * G + c; if (L >= nwg) return false;
        int wgid = (int)L; { const int q = nwg / NXCD, r = nwg % NXCD, xcd = wgid % NXCD, off = wgid / NXCD; wgid = (xcd < r ? xcd * (q + 1) : r * (q + 1) + (xcd - r) * q) + off; }
        const int nig = WGM * nN, gid = wgid / nig, fm = gid * WGM, gsz = (nM - fm) < WGM ? (nM - fm) : WGM;
        u.pm = fm + ((wgid % nig) % gsz); u.pn = (wgid % nig) / gsz; return true;
    }
    __device__ __forceinline__ void a_ready(const Unit&) const {}
    __device__ __forceinline__ void done(const Unit&) const {}
};

__device__ __forceinline__ unsigned cvt_pk_bf16(float lo, float hi) { unsigned r; asm volatile("v_cvt_pk_bf16_f32 %0, %1, %2" : "=v"(r) : "v"(lo), "v"(hi)); return r; }

typedef unsigned u32x2 __attribute__((ext_vector_type(2)));
struct EpiF32 {
    static constexpr bool PERM = false, AFTER_DRAIN = false;
    float* C; int ldc; int ncols;
    __device__ __forceinline__ void operator()(const f32x4 (&acc)[2][2][4][2], const Unit& u, int wr, int wc, int fr, int fq) const {
        const int row0 = u.pm * BM + wr * 64 + fr, col0 = u.pn * BM + wc * 32 + 4 * fq;
#pragma unroll
        for (int ai = 0; ai < 2; ++ai)
#pragma unroll
            for (int m = 0; m < 4; ++m) { float* rowp = C + (size_t)(row0 + ai * HALF + m * 16) * ldc;
#pragma unroll
                for (int bj = 0; bj < 2; ++bj)
#pragma unroll
                    for (int n = 0; n < 2; ++n) { const int col = col0 + bj * HALF + n * 16; if (col < ncols) *(f32x4*)(rowp + col) = acc[ai][bj][m][n]; } }
    }
};
struct EpiRowScaleF32 {
    static constexpr bool PERM = false, AFTER_DRAIN = false;
    float* C; int ldc; const float* gate; int er;
    __device__ __forceinline__ void operator()(const f32x4 (&acc)[2][2][4][2], const Unit& u, int wr, int wc, int fr, int fq) const {
        const int row0 = u.pm * BM + wr * 64 + fr, col0 = u.pn * BM + wc * 32 + 4 * fq;
#pragma unroll
        for (int ai = 0; ai < 2; ++ai)
#pragma unroll
            for (int m = 0; m < 4; ++m) { const int row = row0 + ai * HALF + m * 16; float* rowp = C + (size_t)row * ldc; const float sc = gate[(row / er) * ER_MAX + row % er];
#pragma unroll
                for (int bj = 0; bj < 2; ++bj)
#pragma unroll
                    for (int n = 0; n < 2; ++n) *(f32x4*)(rowp + col0 + bj * HALF + n * 16) = acc[ai][bj][m][n] * sc; }
    }
};
struct EpiSwiGLU {
    static constexpr bool PERM = true, AFTER_DRAIN = false;
    bf16_t* O; int ldo;
    __device__ __forceinline__ void operator()(const f32x4 (&acc)[2][2][4][2], const Unit& u, int wr, int wc, int fr, int fq) const {
        const int row0 = u.pm * BM + wr * 64 + fr, col0 = u.pn * BM + wc * 32 + 8 * fq;
#pragma unroll
        for (int ai = 0; ai < 2; ++ai)
#pragma unroll
            for (int m = 0; m < 4; ++m) { bf16_t* rowp = O + (size_t)(row0 + ai * HALF + m * 16) * ldo;
#pragma unroll
                for (int bj = 0; bj < 2; ++bj) { const f32x4 gt = acc[ai][bj][m][0], up = acc[ai][bj][m][1]; f32x4 h;
#pragma unroll
                    for (int i = 0; i < 4; ++i) h[i] = gt[i] / (1.0f + __expf(-gt[i])) * up[i];
                    u32x2 w; w.x = cvt_pk_bf16(h[0], h[1]); w.y = cvt_pk_bf16(h[2], h[3]);
                    *(u32x2*)(rowp + (col0 + bj * HALF) / 2) = w; } }
    }
};

struct EpiBf16 {
    static constexpr bool PERM = true, AFTER_DRAIN = false;
    bf16_t* O; int ldo; int ncols;
    __device__ __forceinline__ void operator()(const f32x4 (&acc)[2][2][4][2], const Unit& u, int wr, int wc, int fr, int fq) const {
        const int row0 = u.pm * BM + wr * 64 + fr, col0 = u.pn * BM + wc * 32 + 8 * fq;
#pragma unroll
        for (int ai = 0; ai < 2; ++ai)
#pragma unroll
            for (int m = 0; m < 4; ++m) { bf16_t* rowp = O + (size_t)(row0 + ai * HALF + m * 16) * ldo;
#pragma unroll
                for (int bj = 0; bj < 2; ++bj) { const int col = col0 + bj * HALF; const f32x4 v0 = acc[ai][bj][m][0], v1 = acc[ai][bj][m][1];
                    u32x4 w; w.x = cvt_pk_bf16(v0[0], v0[1]); w.y = cvt_pk_bf16(v0[2], v0[3]); w.z = cvt_pk_bf16(v1[0], v1[1]); w.w = cvt_pk_bf16(v1[2], v1[3]);
                    if (col < ncols) *(u32x4*)(rowp + col) = w; } }
    }
};
struct EpiRowScaleBf16 {
    static constexpr bool PERM = true, AFTER_DRAIN = false;
    bf16_t* O; int ldo; const float* gate; int er;
    __device__ __forceinline__ void operator()(const f32x4 (&acc)[2][2][4][2], const Unit& u, int wr, int wc, int fr, int fq) const {
        const int row0 = u.pm * BM + wr * 64 + fr, col0 = u.pn * BM + wc * 32 + 8 * fq;
#pragma unroll
        for (int ai = 0; ai < 2; ++ai)
#pragma unroll
            for (int m = 0; m < 4; ++m) { const int row = row0 + ai * HALF + m * 16; bf16_t* rowp = O + (size_t)row * ldo; const float sc = gate[(row / er) * ER_MAX + row % er];
#pragma unroll
                for (int bj = 0; bj < 2; ++bj) { const f32x4 v0 = acc[ai][bj][m][0] * sc, v1 = acc[ai][bj][m][1] * sc;
                    u32x4 w; w.x = cvt_pk_bf16(v0[0], v0[1]); w.y = cvt_pk_bf16(v0[2], v0[3]); w.z = cvt_pk_bf16(v1[0], v1[1]); w.w = cvt_pk_bf16(v1[2], v1[3]);
                    *(u32x4*)(rowp + col0 + bj * HALF) = w; } }
    }
};
template <class Epi, class Sched, bool ALIGN_EPI = false, bool SP2 = false>
__device__ __forceinline__ void gemm_phase(PG8_LAS unsigned char* lds, const Gemm g, const Sched& S, const Epi& E, int tid_in) {
    int tid_ = tid_in; asm volatile("" : "+v"(tid_));
    const int tid = tid_, wid = __builtin_amdgcn_readfirstlane(tid >> 6), lane = tid & 63, wr = wid >> 2, wc = wid & 3, fr = lane & 15, fq = lane >> 4;
    int K_ = g.K; asm volatile("" : "+s"(K_));
    const int K = K_, nt = K / BK;
    unsigned voffA[2], voffB[2];
#pragma unroll
    for (int i = 0; i < 2; ++i) { int R, C; stage_rc(tid * 16 + i * 8192, R, C); const int Rb = Epi::PERM ? ((R & ~31) + perm32(R & 31)) : R;
        voffA[i] = (unsigned)(R * K + C) * 2u; voffB[i] = (unsigned)(Rb * K + C) * 2u; }
    const size_t kstep = (size_t)(BK * 2);
    const size_t hstep = (size_t)HALF * K * 2;
    const size_t tstep = 2 * hstep;
    const unsigned ldsw = (unsigned)wid * 1024u;
    const int aoff = lds_byte(wr * 64 + fr, fq * 8), boff = lds_byte(wc * 32 + fr, fq * 8);
#define PG8_SA(b, h) (((b) * 2 + (h)) * HTB)
#define PG8_SB(b, h) ((4 + (b) * 2 + (h)) * HTB)
#define PG8_STAGE(bufoff, gbase, voff) do { _Pragma("unroll") for (int _i = 0; _i < 2; ++_i) \
        __builtin_amdgcn_global_load_lds((const unsigned*)((const char*)(gbase) + (voff)[_i]), (PG8_LAS unsigned*)(lds + (bufoff) + ldsw + _i * 8192), 16, 0, 0); } while (0)
#define PG8_LDA(dst, b, h) do { _Pragma("unroll") for (int m = 0; m < 4; ++m) _Pragma("unroll") for (int k = 0; k < 2; ++k) dst[m][k] = *(const PG8_LAS bf16x8*)(lds + PG8_SA(b, h) + aoff + m * 2048 + k * 1024); } while (0)
#define PG8_LDB(dst, b, h) do { _Pragma("unroll") for (int n = 0; n < 2; ++n) _Pragma("unroll") for (int k = 0; k < 2; ++k) dst[n][k] = *(const PG8_LAS bf16x8*)(lds + PG8_SB(b, h) + boff + n * 2048 + k * 1024); } while (0)
#define PG8_MMA(ai, bj, At, Bt) do { __builtin_amdgcn_s_setprio(1); _Pragma("unroll") for (int m = 0; m < 4; ++m) _Pragma("unroll") for (int n = 0; n < 2; ++n) _Pragma("unroll") for (int k = 0; k < 2; ++k) \
        acc[ai][bj][m][n] = __builtin_amdgcn_mfma_f32_16x16x32_bf16(Bt[n][k], At[m][k], acc[ai][bj][m][n], 0, 0, 0); __builtin_amdgcn_s_setprio(0); } while (0)
#define PG8_WAIT_V(n) asm volatile("s_waitcnt vmcnt(" #n ")" ::: "memory")
#define PG8_WAIT_L(n) asm volatile("s_waitcnt lgkmcnt(" #n ")" ::: "memory")
#define PG8_BAR __builtin_amdgcn_s_barrier()
#define PG8_SCHED __builtin_amdgcn_sched_barrier(0)
    Unit cur, nxt; int ui = 0;
    if (!S.next(0, cur)) return;
    f32x4 acc[2][2][4][2];
#pragma unroll
    for (int a = 0; a < 2; ++a)
#pragma unroll
        for (int b = 0; b < 2; ++b)
#pragma unroll
            for (int m = 0; m < 4; ++m)
#pragma unroll
                for (int n = 0; n < 2; ++n) acc[a][b][m][n] = (f32x4){0.f, 0.f, 0.f, 0.f};
    bf16x8 At[4][2], B0[2][2], B1[2][2];
    const char* cA = (const char*)g.A + (size_t)cur.pm * tstep; const char* cB = (const char*)g.Bt + (size_t)cur.pn * tstep + (g.grp_tiles ? (size_t)(cur.pm / g.grp_tiles) * g.grp_stride : (size_t)0);
    S.a_ready(cur);
    if constexpr (SP2) {
        PG8_STAGE(PG8_SB(0, 0), cB, voffB); PG8_STAGE(PG8_SB(0, 1), cB + hstep, voffB); PG8_STAGE(PG8_SA(0, 0), cA, voffA); PG8_STAGE(PG8_SA(0, 1), cA + hstep, voffA);
        if (wr == 1) PG8_BAR;
        PG8_WAIT_V(2); PG8_BAR;
        PG8_STAGE(PG8_SB(1, 0), cB + kstep, voffB); PG8_STAGE(PG8_SA(1, 0), cA + kstep, voffA); PG8_STAGE(PG8_SB(1, 1), cB + hstep + kstep, voffB);
        PG8_WAIT_V(6); PG8_BAR;
    } else {
        PG8_STAGE(PG8_SB(0, 0), cB, voffB); PG8_STAGE(PG8_SA(0, 0), cA, voffA); PG8_STAGE(PG8_SB(0, 1), cB + hstep, voffB); PG8_STAGE(PG8_SA(0, 1), cA + hstep, voffA);
        if (wr == 1) PG8_BAR;
        PG8_WAIT_V(4); PG8_BAR;
        PG8_STAGE(PG8_SB(1, 0), cB + kstep, voffB); PG8_STAGE(PG8_SA(1, 0), cA + kstep, voffA); PG8_STAGE(PG8_SB(1, 1), cB + hstep + kstep, voffB);
        PG8_WAIT_V(6); PG8_BAR;
    }
    for (;;) {
        const bool has_next = S.next(ui + 1, nxt);
        const char* nA = has_next ? (const char*)g.A + (size_t)nxt.pm * tstep : cA; const char* nB = has_next ? (const char*)g.Bt + (size_t)nxt.pn * tstep + (g.grp_tiles ? (size_t)(nxt.pm / g.grp_tiles) * g.grp_stride : (size_t)0) : cB;
        for (int t = 0; t < nt; t += 2) {
            const bool last = (t == nt - 2);
            const char* a1 = cA + (size_t)(t + 1) * kstep;
            const char* a2 = last ? nA : cA + (size_t)(t + 2) * kstep; const char* b2 = last ? nB : cB + (size_t)(t + 2) * kstep;
            const char* a3 = a2 + kstep; const char* b3 = b2 + kstep;
            if (last && has_next) S.a_ready(nxt);
            if constexpr (SP2) {
            PG8_LDB(B0, 0, 0); PG8_LDB(B1, 0, 1); PG8_SCHED; PG8_LDA(At, 0, 0); PG8_STAGE(PG8_SA(1, 1), a1 + hstep, voffA);
            PG8_WAIT_V(8); PG8_WAIT_L(0); PG8_BAR; PG8_MMA(0, 0, At, B0); PG8_MMA(0, 1, At, B1); PG8_BAR; PG8_SCHED;
            PG8_LDA(At, 0, 1); PG8_STAGE(PG8_SB(0, 0), b2, voffB); PG8_STAGE(PG8_SB(0, 1), b2 + hstep, voffB); PG8_STAGE(PG8_SA(0, 0), a2, voffA);
            PG8_WAIT_V(8); PG8_WAIT_L(0); PG8_BAR; PG8_MMA(1, 0, At, B0); PG8_MMA(1, 1, At, B1); PG8_BAR; PG8_SCHED;
            PG8_LDB(B0, 1, 0); PG8_LDB(B1, 1, 1); PG8_SCHED; PG8_LDA(At, 1, 0); PG8_STAGE(PG8_SA(0, 1), a2 + hstep, voffA);
            PG8_WAIT_V(8); PG8_WAIT_L(0); PG8_BAR; PG8_MMA(0, 0, At, B0); PG8_MMA(0, 1, At, B1); PG8_BAR; PG8_SCHED;
            PG8_LDA(At, 1, 1); PG8_STAGE(PG8_SB(1, 0), b3, voffB); PG8_STAGE(PG8_SB(1, 1), b3 + hstep, voffB); PG8_STAGE(PG8_SA(1, 0), a3, voffA);
            PG8_WAIT_V(8); PG8_WAIT_L(0); PG8_BAR; PG8_MMA(1, 0, At, B0); PG8_MMA(1, 1, At, B1); PG8_BAR; PG8_SCHED;
            } else {
            PG8_LDB(B0, 0, 0); PG8_SCHED; PG8_LDA(At, 0, 0); PG8_STAGE(PG8_SA(1, 1), a1 + hstep, voffA);
            PG8_WAIT_L(8); PG8_BAR; PG8_WAIT_L(0); PG8_MMA(0, 0, At, B0); PG8_BAR; PG8_SCHED;
            PG8_LDB(B1, 0, 1); PG8_STAGE(PG8_SB(0, 0), b2, voffB);
            PG8_BAR; PG8_WAIT_L(0); PG8_MMA(0, 1, At, B1); PG8_BAR;
            PG8_LDA(At, 0, 1); PG8_STAGE(PG8_SA(0, 0), a2, voffA);
            PG8_BAR; PG8_WAIT_L(0); PG8_MMA(1, 0, At, B0); PG8_BAR; PG8_SCHED;
            PG8_STAGE(PG8_SB(0, 1), b2 + hstep, voffB);
            PG8_WAIT_V(6); PG8_BAR; PG8_MMA(1, 1, At, B1); PG8_BAR;
            PG8_LDB(B0, 1, 0); PG8_SCHED; PG8_LDA(At, 1, 0); PG8_STAGE(PG8_SA(0, 1), a2 + hstep, voffA);
            PG8_WAIT_L(8); PG8_BAR; PG8_WAIT_L(0); PG8_MMA(0, 0, At, B0); PG8_BAR; PG8_SCHED;
            PG8_LDB(B1, 1, 1); PG8_STAGE(PG8_SB(1, 0), b3, voffB);
            PG8_BAR; PG8_WAIT_L(0); PG8_MMA(0, 1, At, B1); PG8_BAR;
            PG8_LDA(At, 1, 1); PG8_STAGE(PG8_SA(1, 0), a3, voffA);
            PG8_BAR; PG8_WAIT_L(0); PG8_MMA(1, 0, At, B0); PG8_BAR; PG8_SCHED;
            PG8_STAGE(PG8_SB(1, 1), b3 + hstep, voffB);
            PG8_WAIT_V(6); PG8_BAR; PG8_MMA(1, 1, At, B1); PG8_BAR;
            }
        }
        if constexpr (ALIGN_EPI) { if (wr == 0) PG8_BAR; }
        if constexpr (!Epi::AFTER_DRAIN) { E(acc, cur, wr, wc, fr, fq); S.done(cur); }
        if (!has_next) break;
#pragma unroll
        for (int a = 0; a < 2; ++a)
#pragma unroll
            for (int b = 0; b < 2; ++b)
#pragma unroll
                for (int m = 0; m < 4; ++m)
#pragma unroll
                    for (int n = 0; n < 2; ++n) acc[a][b][m][n] = (f32x4){0.f, 0.f, 0.f, 0.f};
        cur = nxt; cA = nA; cB = nB; ++ui;
        if constexpr (ALIGN_EPI) { if (wr == 1) PG8_BAR; }
    }
    PG8_WAIT_V(0);
    if constexpr (!ALIGN_EPI) { if (wr == 0) PG8_BAR; }
    PG8_BAR;
    if constexpr (Epi::AFTER_DRAIN) { E.fused(acc, cur, wr, wc, fr, fq, lds, wid, lane); S.done(cur); }
#undef PG8_SA
#undef PG8_SB
#undef PG8_STAGE
#undef PG8_LDA
#undef PG8_LDB
#undef PG8_MMA
#undef PG8_WAIT_V
#undef PG8_WAIT_L
#undef PG8_BAR
#undef PG8_SCHED
}
}


#define XB_TMO      128
#define XB_XCNT(j)  (256  + 64 * (j))
#define XB_XSUB(j)  (1280 + 64 * (j))
#define XB_XGEN(j)  (2304 + 64 * (j))
#define XB_TOP      3328
#define XB_TOPGEN   3392
#define XCD_BAR_WORDS 3456
#define XB_SPIN_CAP (1u << 22)
__device__ __forceinline__ unsigned xb_ld(unsigned* p)              { return __hip_atomic_load(p, __ATOMIC_RELAXED, __HIP_MEMORY_SCOPE_AGENT); }
__device__ __forceinline__ unsigned xb_add(unsigned* p, unsigned v) { return __hip_atomic_fetch_add(p, v, __ATOMIC_RELAXED, __HIP_MEMORY_SCOPE_AGENT); }
__device__ __forceinline__ unsigned xb_xcc_id() { return (unsigned)__builtin_amdgcn_s_getreg((3 << 11) | 20) & 0xFu; }
#define XB_SPIN(cond, bar) do { unsigned _sp = 0; while (cond) { __builtin_amdgcn_s_sleep(1); \
    if ((++_sp & 255u) == 0u) { if (xb_ld(&(bar)[XB_TMO])) break; if (_sp > XB_SPIN_CAP) { atomicAdd(&(bar)[XB_TMO], 1u); break; } } } } while (0)
struct XcdBarrier { unsigned* bar; unsigned x; volatile LAS unsigned* st; };
__device__ __forceinline__ XcdBarrier xcd_barrier_post(unsigned* bar, volatile LAS unsigned* st, int tid_in) {
    XcdBarrier b; b.bar = bar; b.x = xb_xcc_id(); b.st = st;
    if (tid_in == 0) (void)xb_add(&bar[XB_XCNT(b.x)], 1u);
    return b;
}
__device__ __forceinline__ void xcd_barrier_complete(unsigned* bar, unsigned x, unsigned& nloc, unsigned& nx) {
    const unsigned G = gridDim.x * gridDim.y * gridDim.z;
    unsigned sum, cnt, mine, sp = 0u;
    for (;;) {
        sum = 0u; cnt = 0u; mine = 0u;
#pragma unroll
        for (unsigned j = 0; j < 16; ++j) { const unsigned c = xb_ld(&bar[XB_XCNT(j)]); sum += c; cnt += (c > 0u) ? 1u : 0u; mine = (j == x) ? c : mine; }
        if (sum == G) break;
        __builtin_amdgcn_s_sleep(1);
        if ((++sp & 255u) == 0u) { if (xb_ld(&bar[XB_TMO])) break; if (sp > XB_SPIN_CAP) { atomicAdd(&bar[XB_TMO], 1u); break; } }
    }
    nloc = mine > 0u ? mine : 1u; nx = cnt > 0u ? cnt : 1u;
}
__device__ __forceinline__ void xcd_barrier(const XcdBarrier& b, int tid_in) {
    asm volatile("s_waitcnt vmcnt(0)" ::: "memory");
    __syncthreads();
    if (tid_in == 0) {
        unsigned* bar = b.bar;
        __builtin_amdgcn_s_waitcnt(0);
        unsigned nloc = b.st[0], nx = b.st[1];
        if (nloc == 0u) { xcd_barrier_complete(bar, b.x, nloc, nx); b.st[0] = nloc; b.st[1] = nx; }
        const unsigned old = xb_add(&bar[XB_XSUB(b.x)], 1u);
        const unsigned gen = old / nloc;
        if (old + 1u == (gen + 1u) * nloc) {
            __builtin_amdgcn_fence(__ATOMIC_RELEASE, "agent");
            asm volatile("s_waitcnt vmcnt(0)" ::: "memory");
            const unsigned og = xb_add(&bar[XB_TOP], 1u);
            const unsigned tg = og / nx;
            if (og + 1u == (tg + 1u) * nx) xb_add(&bar[XB_TOPGEN], 1u);
            else XB_SPIN(xb_ld(&bar[XB_TOPGEN]) == tg, bar);
            __builtin_amdgcn_fence(__ATOMIC_ACQUIRE, "agent");
            xb_add(&bar[XB_XGEN(b.x)], 1u);
            asm volatile("s_waitcnt vmcnt(0)" ::: "memory");
        } else {
            XB_SPIN(xb_ld(&bar[XB_XGEN(b.x)]) == gen, bar);
            __builtin_amdgcn_fence(__ATOMIC_ACQUIRE, "agent");
            asm volatile("s_waitcnt vmcnt(0)" ::: "memory");
        }
    }
    __syncthreads();
}


typedef short bf16x8 __attribute__((ext_vector_type(8)));
typedef short s16x4 __attribute__((ext_vector_type(4)));
typedef float f32x16 __attribute__((ext_vector_type(16)));
typedef unsigned v4u __attribute__((ext_vector_type(4)));
typedef unsigned v2u __attribute__((ext_vector_type(2)));
constexpr float ATT_THR = 5.0f;
template <int DK> struct AttL { static constexpr int KSTR = DK * 2 + 16, KBYTES = 64 * KSTR, VSTR = 136, VBYTES = 64 * VSTR, KCH = 64 * DK / 8, KPT = (KCH + NTHREADS - 1) / NTHREADS;
    static constexpr int K_OFF = 0, V_OFF = 2 * KBYTES; };

template <int DK>
__device__ __forceinline__ void attn_pass(const bf16_t* Qrow, const bf16_t* Kp, const bf16_t* Vtp, int vt_ld, int nkt, LAS unsigned char* lds, int tid, f32x16 (&oacc)[2], float& l_run) {
    typedef AttL<DK> L;
    constexpr bool AUG = DK <= 32;
    const int lane = tid & 63, r = lane & 31, h = lane >> 5;
    bf16x8 qf[DK / 16];
#pragma unroll
    for (int ks = 0; ks < DK / 16; ++ks) qf[ks] = *(const bf16x8*)(Qrow + 16 * ks + 8 * h);
    const short z_ = (short)(tid >> 20);
    bf16x8 aone = {z_, z_, z_, z_, z_, z_, z_, z_}, bneg = {z_, z_, z_, z_, z_, z_, z_, z_};
    if (h == 0) aone[0] = (short)0x3F80;
    float m_run = 0.f;
    v4u kreg[L::KPT]; v4u vreg;
    const int vd = tid >> 3, vpart = tid & 7;
#define ATT_LOADK(j) do { _Pragma("unroll") for (int i_ = 0; i_ < L::KPT; ++i_) { const int c_ = tid + i_ * NTHREADS; if (c_ < L::KCH) kreg[i_] = *(const v4u*)(Kp + (size_t)(j) * 64 * DK + c_ * 8); } } while (0)
#define ATT_LOADV(j) do { vreg = *(const v4u*)(Vtp + (size_t)vd * vt_ld + (j) * 64 + vpart * 8); } while (0)
#define ATT_STOREK(buf) do { _Pragma("unroll") for (int i_ = 0; i_ < L::KPT; ++i_) { const int c_ = tid + i_ * NTHREADS; if (c_ < L::KCH) { const int key_ = c_ / (DK / 8), part_ = c_ % (DK / 8); \
            *(LAS v4u*)(lds + L::K_OFF + (buf) * L::KBYTES + key_ * L::KSTR + part_ * 16) = kreg[i_]; } } } while (0)
#define ATT_STOREV(buf) do { LAS unsigned char* vp_ = lds + L::V_OFF + (buf) * L::VBYTES + vd * L::VSTR + vpart * 16; *(LAS v2u*)vp_ = (v2u){vreg.x, vreg.y}; *(LAS v2u*)(vp_ + 8) = (v2u){vreg.z, vreg.w}; } while (0)
#define ATT_QK(dst, buf) do { _Pragma("unroll") for (int kb = 0; kb < 2; ++kb) { _Pragma("unroll") for (int i = 0; i < 16; ++i) dst[kb][i] = 0.f; \
        if (AUG) dst[kb] = __builtin_amdgcn_mfma_f32_32x32x16_bf16(aone, bneg, dst[kb], 0, 0, 0); \
        _Pragma("unroll") for (int ks = 0; ks < DK / 16; ++ks) { const bf16x8 a_ = *(const LAS bf16x8*)(lds + L::K_OFF + (buf) * L::KBYTES + (32 * kb + r) * L::KSTR + (16 * ks + 8 * h) * 2); \
            dst[kb] = __builtin_amdgcn_mfma_f32_32x32x16_bf16(a_, qf[ks], dst[kb], 0, 0, 0); } } } while (0)
#define ATT_BODY(SC, SN, j) do { \
        if ((j) + 2 < nkt) ATT_LOADK((j) + 2); \
        if ((j) + 1 < nkt) { ATT_LOADV((j) + 1); ATT_QK(SN, ((j) + 1) & 1); } \
        if (((j) & 3) == 0) { \
            float t0 = fmaxf(fmaxf(SC[0][0], SC[0][1]), SC[0][2]), t1 = fmaxf(fmaxf(SC[0][3], SC[0][4]), SC[0][5]), t2 = fmaxf(fmaxf(SC[0][6], SC[0][7]), SC[0][8]), t3 = fmaxf(fmaxf(SC[0][9], SC[0][10]), SC[0][11]); \
            float t4 = fmaxf(fmaxf(SC[0][12], SC[0][13]), SC[0][14]), t5 = fmaxf(fmaxf(SC[0][15], SC[1][0]), SC[1][1]), t6 = fmaxf(fmaxf(SC[1][2], SC[1][3]), SC[1][4]), t7 = fmaxf(fmaxf(SC[1][5], SC[1][6]), SC[1][7]); \
            float t8 = fmaxf(fmaxf(SC[1][8], SC[1][9]), SC[1][10]), t9 = fmaxf(fmaxf(SC[1][11], SC[1][12]), SC[1][13]), t10 = fmaxf(SC[1][14], SC[1][15]); \
            float tmax = fmaxf(fmaxf(fmaxf(fmaxf(t0, t1), t2), fmaxf(fmaxf(t3, t4), t5)), fmaxf(fmaxf(fmaxf(t6, t7), t8), fmaxf(t9, t10))); \
            tmax = xor32_max(tmax); if (!AUG) tmax -= m_run;            \
            if ((j) == 0 || __any(tmax > ATT_THR)) {                   \
                const float want = (j) == 0 ? tmax : m_run + fmaxf(tmax, 0.f); \
                const float mn = __uint_as_float(pk2(want, 0.f) << 16), dlt = mn - m_run, alpha = __builtin_amdgcn_exp2f(-dlt); \
                _Pragma("unroll") for (int i = 0; i < 16; ++i) { oacc[0][i] *= alpha; oacc[1][i] *= alpha; if (AUG) { SC[0][i] -= dlt; SC[1][i] -= dlt; SN[0][i] -= dlt; SN[1][i] -= dlt; } } \
                l_run *= alpha; m_run = mn; if (AUG && h == 0) bneg[0] = (short)(__float_as_uint(-mn) >> 16); \
            } \
        } \
        float ps0 = 0.f, ps1 = 0.f, ps2 = 0.f, ps3 = 0.f; \
        _Pragma("unroll") for (int kb = 0; kb < 2; ++kb) \
            _Pragma("unroll") for (int i = 0; i < 16; i += 4) { const float mo = AUG ? 0.f : m_run; const float p0 = __builtin_amdgcn_exp2f(SC[kb][i] - mo), p1 = __builtin_amdgcn_exp2f(SC[kb][i + 1] - mo), p2 = __builtin_amdgcn_exp2f(SC[kb][i + 2] - mo), p3 = __builtin_amdgcn_exp2f(SC[kb][i + 3] - mo); \
                SC[kb][i] = p0; SC[kb][i + 1] = p1; SC[kb][i + 2] = p2; SC[kb][i + 3] = p3; ps0 += p0; ps1 += p1; ps2 += p2; ps3 += p3; } \
        l_run += (ps0 + ps1) + (ps2 + ps3); \
        _Pragma("unroll") for (int kb = 0; kb < 2; ++kb) \
            _Pragma("unroll") for (int s2 = 0; s2 < 2; ++s2) { \
                union { bf16x8 v; unsigned u[4]; } pf; \
                _Pragma("unroll") for (int i = 0; i < 4; ++i) pf.u[i] = pk2(SC[kb][8 * s2 + 2 * i], SC[kb][8 * s2 + 2 * i + 1]); \
                _Pragma("unroll") for (int db = 0; db < 2; ++db) { \
                    const LAS unsigned char* vp = lds + L::V_OFF + ((j) & 1) * L::VBYTES + (32 * db + r) * L::VSTR + (32 * kb + 16 * s2 + 4 * h) * 2; \
                    union { bf16x8 v; v2u u[2]; } af; af.u[0] = *(const LAS v2u*)vp; af.u[1] = *(const LAS v2u*)(vp + 16); \
                    oacc[db] = __builtin_amdgcn_mfma_f32_32x32x16_bf16(af.v, pf.v, oacc[db], 0, 0, 0); } } \
        if ((j) + 2 < nkt) ATT_STOREK((j) & 1);               \
        if ((j) + 1 < nkt) ATT_STOREV(((j) + 1) & 1);         \
        __syncthreads(); \
    } while (0)
    __syncthreads();
    ATT_LOADK(0); ATT_LOADV(0); ATT_STOREK(0); ATT_STOREV(0);
    if (nkt > 1) { ATT_LOADK(1); ATT_STOREK(1); }
    __syncthreads();
    f32x16 sa[2], sb[2];
#pragma unroll
    for (int i = 0; i < 16; ++i) { sb[0][i] = (float)z_; sb[1][i] = (float)z_; }
    ATT_QK(sa, 0);
    for (int j = 0; j < nkt; j += 2) {
        ATT_BODY(sa, sb, j);
        if (j + 1 < nkt) ATT_BODY(sb, sa, j + 1);
    }
#undef ATT_BODY
#undef ATT_LOADK
#undef ATT_LOADV
#undef ATT_STOREK
#undef ATT_STOREV
#undef ATT_QK
}


constexpr int SLD = 65, SHLD = 72, XTLD = 132;
__device__ __forceinline__ int rm32(int t, int h) { return (t & 3) + 8 * (t >> 2) + 4 * h; }
template <bool WITH_Y>
__device__ __forceinline__ void ssd_block(int b, int dir, int k, int hp, const bf16_t* xbc, const float* dtp, const float* alog, float* hs, float* alast, bf16_t* yd, float* lds, int tid) {
    const bool lat = k >= 2; const int c = lat ? (dir ? 33 - k : k - 2) : (dir ? 1 - k : k);
    const int row0 = tok_row(lat, b, c * 128), g = hp >> 1;
    float* sB = lds; bf16_t* sBh = (bf16_t*)lds; bf16_t* sCh = sBh + 128 * SHLD;
    float* sX = WITH_Y ? lds + (2 * 128 * SHLD * 2) / 4 : sB + 128 * SLD; bf16_t* sXT = (bf16_t*)sX;
    float* sDT = sX + 128 * 128; float* sCum = sDT + 256; float* sW = sCum + 256; float* sSc = sW + 256;
    const int wave = tid >> 6, lane = tid & 63, r = lane & 31, h = lane >> 5, hl = wave >> 2, head = 2 * hp + hl;
    float* hsp = hs + (((size_t)(b * 2 + dir) * NCH + k) * 8 + head) * 4096;
    union { bf16x8 v; unsigned u[4]; } hfrag[WITH_Y ? 8 : 1];
    if (WITH_Y) {
#pragma unroll
        for (int Pb = 0; Pb < 2; ++Pb)
#pragma unroll
            for (int ks = 0; ks < 4; ++ks) { const float4 x0 = *(const float4*)(hsp + (32 * Pb + r) * 64 + 16 * ks + 8 * h), x1 = *(const float4*)(hsp + (32 * Pb + r) * 64 + 16 * ks + 8 * h + 4);
                hfrag[Pb * 4 + ks].u[0] = pk2(x0.x, x0.y); hfrag[Pb * 4 + ks].u[1] = pk2(x0.z, x0.w); hfrag[Pb * 4 + ks].u[2] = pk2(x1.x, x1.y); hfrag[Pb * 4 + ks].u[3] = pk2(x1.z, x1.w); }
    }
    uint2 vb[8]; float4 vx[8]; float dx[8]; float dtv = 0.f, dav = 0.f;
#pragma unroll
    for (int u = 0; u < 8; ++u) { const int i = tid + u * NTHREADS, t = i >> 5, c4 = i & 31;
        vb[u] = *(const uint2*)(xbc + (size_t)(row0 + t) * 768 + 512 + (c4 >> 4) * 128 + g * 64 + (c4 & 15) * 4);
        vx[u] = ld4h(xbc + (size_t)(row0 + t) * 768 + hp * 128 + c4 * 4);
        dx[u] = dtp[(size_t)(row0 + t) * 16 + dir * 8 + 2 * hp + (c4 >> 4)]; }
    if (tid < 256) { const int hl = tid >> 7, t = tid & 127, h = 2 * hp + hl; dtv = dtp[(size_t)(row0 + t) * 16 + dir * 8 + h]; dav = dtv * -expf(alog[dir * 8 + h]); }
    __syncthreads();
#pragma unroll
    for (int u = 0; u < 8; ++u) { const int i = tid + u * NTHREADS, t = i >> 5, c4 = i & 31;
        if (WITH_Y) *(uint2*)((c4 >> 4 ? sCh : sBh) + t * SHLD + (c4 & 15) * 4) = vb[u];
        else if (!(c4 >> 4)) { const float4 f = up4(vb[u]); float* d = sB + t * SLD + (c4 & 15) * 4; d[0] = f.x; d[1] = f.y; d[2] = f.z; d[3] = f.w; }
        if (WITH_Y) { const float4 xs = f4scale(vx[u], dx[u]); sXT[(c4 * 4 + 0) * XTLD + t] = (bf16_t)(pk2(xs.x, 0.f)); sXT[(c4 * 4 + 1) * XTLD + t] = (bf16_t)(pk2(xs.y, 0.f)); sXT[(c4 * 4 + 2) * XTLD + t] = (bf16_t)(pk2(xs.z, 0.f)); sXT[(c4 * 4 + 3) * XTLD + t] = (bf16_t)(pk2(xs.w, 0.f)); }
        else *(float4*)(sX + t * 128 + c4 * 4) = f4scale(vx[u], dx[u]); }
    if (tid < 256) { const int t = tid & 127; sSc[(tid & 128) + (dir ? 127 - t : t)] = dav; }
    __syncthreads();
    for (int off = 1; off < 128; off <<= 1) { float v = 0.f; const int sI = tid & 127;
        if (tid < 256) { v = sSc[tid]; if (sI >= off) v += sSc[tid - off]; }
        __syncthreads(); if (tid < 256) sSc[tid] = v; __syncthreads(); }
    if (tid < 256) { const int hl = tid >> 7, sI = tid & 127, t = dir ? 127 - sI : sI; const float cu = sSc[tid], tot = sSc[hl * 128 + 127];
        sCum[hl * 128 + t] = cu; sW[hl * 128 + t] = expf(tot - cu);
        if (!WITH_Y && sI == 127) alast[((size_t)(b * 2 + dir) * NCH + k) * 8 + 2 * hp + hl] = tot; }
    __syncthreads();
    if (WITH_Y) {
        const int I = hl ? 3 - (wave & 3) : (wave & 3), ti = 32 * I + r;
        const float cum_i = sCum[hl * 128 + ti];
        f32x16 Y[2], Yo[2];
#pragma unroll
        for (int i = 0; i < 16; ++i) { Y[0][i] = 0.f; Y[1][i] = 0.f; Yo[0][i] = 0.f; Yo[1][i] = 0.f; }
        bf16x8 cfrag[4];
#pragma unroll
        for (int ks = 0; ks < 4; ++ks) cfrag[ks] = *(const bf16x8*)(sCh + (32 * I + r) * SHLD + 16 * ks + 8 * h);
#pragma unroll
        for (int Pb = 0; Pb < 2; ++Pb)
#pragma unroll
            for (int ks = 0; ks < 4; ++ks) Yo[Pb] = __builtin_amdgcn_mfma_f32_32x32x16_bf16(hfrag[Pb * 4 + ks].v, cfrag[ks], Yo[Pb], 0, 0, 0);
        const int J0 = dir ? I : 0, J1 = dir ? 3 : I;
        for (int J = J0; J <= J1; ++J) {
            f32x16 Gt;
#pragma unroll
            for (int i = 0; i < 16; ++i) Gt[i] = 0.f;
#pragma unroll
            for (int ks = 0; ks < 4; ++ks) Gt = __builtin_amdgcn_mfma_f32_32x32x16_bf16(*(const bf16x8*)(sBh + (32 * J + r) * SHLD + 16 * ks + 8 * h), cfrag[ks], Gt, 0, 0, 0);
#pragma unroll
            for (int t = 0; t < 16; ++t) { const int tj = 32 * J + rm32(t, h); const bool valid = (J != I) || (dir ? tj >= ti : tj <= ti);
                Gt[t] *= valid ? __expf(cum_i - sCum[hl * 128 + tj]) : 0.f; }
#pragma unroll
            for (int s2 = 0; s2 < 2; ++s2) {
                union { bf16x8 v; unsigned u[4]; } pf;
#pragma unroll
                for (int i = 0; i < 4; ++i) pf.u[i] = pk2(Gt[8 * s2 + 2 * i], Gt[8 * s2 + 2 * i + 1]);
#pragma unroll
                for (int Pb = 0; Pb < 2; ++Pb) {
                    const bf16_t* xp = sXT + (hl * 64 + 32 * Pb + r) * XTLD + 32 * J + 16 * s2 + 4 * h;
                    union { bf16x8 v; uint2 u[2]; } af; af.u[0] = *(const uint2*)xp; af.u[1] = *(const uint2*)(xp + 8);
                    Y[Pb] = __builtin_amdgcn_mfma_f32_32x32x16_bf16(af.v, pf.v, Y[Pb], 0, 0, 0);
                }
            }
        }
        const float ei = __expf(cum_i);
        bf16_t* yrow = yd + ((size_t)dir * NTOK + row0 + ti) * 512 + head * 64;
#pragma unroll
        for (int Pb = 0; Pb < 2; ++Pb)
#pragma unroll
            for (int tq = 0; tq < 4; ++tq)
                *(uint2*)(yrow + 32 * Pb + 8 * tq + 4 * h) = pk4(make_float4(Y[Pb][4 * tq] + ei * Yo[Pb][4 * tq], Y[Pb][4 * tq + 1] + ei * Yo[Pb][4 * tq + 1], Y[Pb][4 * tq + 2] + ei * Yo[Pb][4 * tq + 2], Y[Pb][4 * tq + 3] + ei * Yo[Pb][4 * tq + 3]));
    } else {
        const int Pb = (wave >> 1) & 1, Nb = wave & 1;
        f32x16 acc;
#pragma unroll
        for (int i = 0; i < 16; ++i) acc[i] = 0.f;
#pragma unroll 8
        for (int ks = 0; ks < 64; ++ks) { const int j = 2 * ks + h;
            acc = __builtin_amdgcn_mfma_f32_32x32x2f32(sX[j * 128 + hl * 64 + 32 * Pb + r] * sW[hl * 128 + j], sB[j * SLD + 32 * Nb + r], acc, 0, 0, 0); }
#pragma unroll
        for (int t = 0; t < 16; ++t) hsp[(32 * Pb + rm32(t, h)) * 64 + 32 * Nb + r] = acc[t];
    }
}

template <class RM>
__device__ __forceinline__ void cvt_tile(const float* src, int N, bf16_t* dst, int ldd, RM rowmap, int k0, int n0, int lane) {
    const int n = n0 + lane;
    if (n < N) {
        const float* sp = src + (size_t)k0 * N + n;
        float v[32];
#pragma unroll
        for (int kk = 0; kk < 32; ++kk) v[kk] = sp[(size_t)kk * N];
        uint4* dp = (uint4*)(dst + (size_t)rowmap(n) * ldd + k0);
#pragma unroll
        for (int i = 0; i < 4; ++i) dp[i] = make_uint4(pk2(v[8 * i], v[8 * i + 1]), pk2(v[8 * i + 2], v[8 * i + 3]), pk2(v[8 * i + 4], v[8 * i + 5]), pk2(v[8 * i + 6], v[8 * i + 7]));
    }
}
__device__ __forceinline__ int block_excl_scan(int v, int tid, volatile int* sh, int& total) {
    const int lane = tid & 63, wave = tid >> 6; int x = v;
    x += __builtin_amdgcn_update_dpp(0, x, 0x111, 0xf, 0xf, true); x += __builtin_amdgcn_update_dpp(0, x, 0x112, 0xf, 0xf, true);
    x += __builtin_amdgcn_update_dpp(0, x, 0x114, 0xf, 0xf, true); x += __builtin_amdgcn_update_dpp(0, x, 0x118, 0xf, 0xf, true);
    x += __builtin_amdgcn_update_dpp(0, x, 0x142, 0xa, 0xf, false); x += __builtin_amdgcn_update_dpp(0, x, 0x143, 0xc, 0xf, false);
    __syncthreads();
    if (lane == 63) sh[wave] = x;
    __syncthreads();
    int off = 0, tot = 0;
#pragma unroll
    for (int w = 0; w < 8; ++w) { const int c = sh[w]; tot += c; if (w < wave) off += c; }
    total = tot;
    return off + x - v;
}
__device__ __forceinline__ int block_sum(int v, int tid, volatile int* sh, int parity) {
    const int lane = tid & 63, wave = tid >> 6;
    v += __builtin_amdgcn_update_dpp(0, v, 0x111, 0xf, 0xf, true); v += __builtin_amdgcn_update_dpp(0, v, 0x112, 0xf, 0xf, true);
    v += __builtin_amdgcn_update_dpp(0, v, 0x114, 0xf, 0xf, true); v += __builtin_amdgcn_update_dpp(0, v, 0x118, 0xf, 0xf, true);
    v += __builtin_amdgcn_update_dpp(0, v, 0x142, 0xa, 0xf, false); v += __builtin_amdgcn_update_dpp(0, v, 0x143, 0xc, 0xf, false);
    if (lane == 63) sh[parity * 8 + wave] = v;
    __syncthreads();
    int tot = 0;
#pragma unroll
    for (int w = 0; w < 8; ++w) tot += sh[parity * 8 + w];
    return tot;
}

#define MOD ((float*)(kp_->ws + WS_MOD))
#define CTXC ((float*)(kp_->ws + WS_CTXC))
#define AFF ((float*)(kp_->ws + WS_AFF))
#define TOKSLOT ((int*)(kp_->ws + WS_TOKSLOT))
#define SELIDX ((int*)(kp_->ws + WS_SELIDX))
#define SELGATE ((float*)(kp_->ws + WS_SELGATE))
#define DT ((float*)(kp_->ws + WS_DT))
#define HB ((bf16_t*)(kp_->ws + WS_HB))
#define HS ((float*)(kp_->ws + WS_HS))
#define YD ((bf16_t*)(kp_->ws + WS_YD))
#define ALAST ((float*)(kp_->ws + WS_ALAST))
#define ROPE ((float*)(kp_->ws + WS_ROPE))
#define PB ((bf16_t*)(kp_->ws + WS_P))
#define XBC ((bf16_t*)(kp_->ws + WS_XBC))
#define MQ ((bf16_t*)(kp_->ws + WS_MQ))
#define MKV ((bf16_t*)(kp_->ws + WS_MKV))
#define CQB ((bf16_t*)(kp_->ws + WS_CQB))
#define CKVB ((bf16_t*)(kp_->ws + WS_CKVB))
#define MIXB ((bf16_t*)(kp_->ws + WS_MIXB))
#define MOUT ((bf16_t*)(kp_->ws + WS_MOUT))
#define XG ((bf16_t*)(kp_->ws + WS_XG))
#define HID ((bf16_t*)(kp_->ws + WS_HID))
#define Y ((bf16_t*)(kp_->ws + WS_Y))
#define WIN_T ((bf16_t*)(kp_->ws + WS_WIN))
#define WQ_T ((bf16_t*)(kp_->ws + WS_WQ))
#define WKV_T ((bf16_t*)(kp_->ws + WS_WKV))
#define WOUT_T ((bf16_t*)(kp_->ws + WS_WOUT))
#define WGU_T ((bf16_t*)(kp_->ws + WS_WGU))
#define WD_T ((bf16_t*)(kp_->ws + WS_WD))
#define QD ((bf16_t*)(kp_->ws + WS_QD))
#define QDC ((bf16_t*)(kp_->ws + WS_QDC))
#define KD ((bf16_t*)(kp_->ws + WS_KD))
#define VDT ((bf16_t*)(kp_->ws + WS_VDT))
#define QM ((bf16_t*)(kp_->ws + WS_QM))
#define QMC ((bf16_t*)(kp_->ws + WS_QMC))
#define KM ((bf16_t*)(kp_->ws + WS_KM))
#define VMT ((bf16_t*)(kp_->ws + WS_VMT))
#define xcur (kp_->out)
#define XSRC (l == 0 ? kp_->in[I_X] : (const float*)kp_->out)
#define CSRC (l == 0 ? kp_->in[I_CTX] : (const float*)CTXC)
#define DTMP XBC
#define modl (MOD + (size_t)l * (NB + 1) * NMOD * D)
typedef const __attribute__((address_space(4))) Prm* KPrm;
#define PHASE_BEGIN() KPrm kp_ = (KPrm)__builtin_amdgcn_kernarg_segment_ptr(); asm volatile("" : "+s"(kp_)); int tid = MK_TID(); asm volatile("" : "+v"(tid)); (void)tid
#define GSYNC() do { XcdBarrier b_; b_.bar = (unsigned*)(kp_->ws + WS_CTL); b_.x = xb_xcc_id(); b_.st = (volatile LAS unsigned*)(ldsb + LDS_BYTES - 64); xcd_barrier(b_, tid); } while (0)
#define CVT_MOE_RANGE(LW, ID0, ID1, SLOT, NSLOTS) do { const int lane_ = tid & 63; \
        for (int id = (ID0) + (SLOT); id < (ID1); id += (NSLOTS)) { \
            const int mat = id >> 9, tl = id & 511, e = mat / 3, which = mat % 3, k0 = (tl >> 4) * 32, n0 = (tl & 15) * 64; \
            if (which == 0) cvt_tile(kp_->in[I_WG] + ((size_t)(LW) * NE + e) * D * FF, FF, WGU_T + (size_t)e * 2 * FF * D, D, [](int n) { return (n >> 2) * 8 + (n & 3); }, k0, n0, lane_); \
            else if (which == 1) cvt_tile(kp_->in[I_WU] + ((size_t)(LW) * NE + e) * D * FF, FF, WGU_T + (size_t)e * 2 * FF * D, D, [](int n) { return (n >> 2) * 8 + 4 + (n & 3); }, k0, n0, lane_); \
            else cvt_tile(kp_->in[I_WD] + ((size_t)(LW) * NE + e) * FF * D, D, WD_T + (size_t)e * D * FF, FF, [](int n) { return n; }, k0, n0, lane_); } } while (0)
constexpr int MOE_TILES = NE * 3 * 512;
constexpr int CVT_PER_WAVE = 4;
__global__ void __launch_bounds__(NTHREADS, 2) mk_forward(Prm p) {
    extern __shared__ __attribute__((aligned(16))) unsigned char lds_raw[];
    LAS unsigned char* const ldsb = (LAS unsigned char*)lds_raw;
    volatile LAS unsigned* st = (volatile LAS unsigned*)(ldsb + LDS_BYTES - 64);
    const int wave_s = __builtin_amdgcn_readfirstlane((int)threadIdx.x >> 6);
#define MK_TID() mk_tid_impl(wave_s)
    if (MK_TID() < 16) st[MK_TID()] = 0u;
    __syncthreads();
    (void)xcd_barrier_post((unsigned*)(p.ws + WS_CTL), st, MK_TID());
    const int G = gridDim.x, bid = blockIdx.x;
    const int vcu = (G % 8 == 0) ? (bid % 8) * (G / 8) + bid / 8 : bid;

    {
        PHASE_BEGIN();
        const float* c = kp_->in[I_C]; const float* cc = kp_->in[I_CCTX]; const float* adaw = kp_->in[I_ADAW]; const float* adab = kp_->in[I_ADAB];
        float* sc_l = (float*)lds_raw;
        for (int i = tid; i < (NB + 1) * D; i += NTHREADS) { const int r = i / D, k = i % D; sc_l[i] = siluf(r < NB ? c[(size_t)r * D + k] : cc[k]); }
        __syncthreads();
        {
            float* red = sc_l + (NB + 1) * D;
            const int lane = tid & 63, wv = tid >> 6;
            for (int it = bid; it < DEPTH * (NMOD * D / 64); it += G) {
                const int l = it / (NMOD * D / 64), j = (it % (NMOD * D / 64)) * 64 + lane;
                const float* w = adaw + ((size_t)l * D + wv * 128) * NMOD * D + j;
                float a0 = 0.f, a1 = 0.f, a2 = 0.f, a3 = 0.f, a4 = 0.f;
#pragma unroll 8
                for (int k = 0; k < 128; ++k) { const float wk = w[(size_t)k * NMOD * D]; const int kk = wv * 128 + k;
                    a0 += sc_l[kk] * wk; a1 += sc_l[D + kk] * wk; a2 += sc_l[2 * D + kk] * wk; a3 += sc_l[3 * D + kk] * wk; a4 += sc_l[4 * D + kk] * wk; }
                __syncthreads();
                red[(wv * 5 + 0) * 64 + lane] = a0; red[(wv * 5 + 1) * 64 + lane] = a1; red[(wv * 5 + 2) * 64 + lane] = a2; red[(wv * 5 + 3) * 64 + lane] = a3; red[(wv * 5 + 4) * 64 + lane] = a4;
                __syncthreads();
                if (tid < 5 * 64) { const int r = tid >> 6; float acc = adab[l * NMOD * D + j - lane + (tid & 63)];
#pragma unroll
                    for (int q = 0; q < 8; ++q) acc += red[(q * 5 + r) * 64 + (tid & 63)];
                    MOD[((size_t)l * (NB + 1) + r) * NMOD * D + (j - lane) + (tid & 63)] = acc; }
            }
        }
        ITEMS(i, S * 16) {
            const int t = i >> 4, w = i & 15, ii = w & 7; const float pos = (float)(w < 8 ? t / GRID_W : t % GRID_W);
            const float ang = pos * powf(10000.0f, -(float)ii / 8.0f);
            ROPE[(size_t)t * 32 + (w < 8 ? 0 : 16) + ii] = cosf(ang); ROPE[(size_t)t * 32 + (w < 8 ? 8 : 24) + ii] = sinf(ang);
        }
        GSYNC();
    }

#pragma unroll 1
    for (int l = 0; l < DEPTH; ++l) {
        const bool ctx_out = l < DEPTH - 1;
        const float lambda_init = 0.8f - 0.6f * expf(-0.3f * (float)l);
        const int nrows_out = ctx_out ? NTOK : NLAT;
        const int ER = ctx_out ? ER_MAX : NB * CAP_L;
        int moe_done = 0;

        {
            PHASE_BEGIN();
            {
                const int lane = tid & 63; auto idm = [](int n) { return n; };
                constexpr int T_WIN = (D / 32) * ((IN_COLS + 63) / 64), T_WQ = (192 / 32) * (384 / 64), T_WKV = (128 / 32) * (512 / 64), T_WOUT = (MIXW / 32) * (D / 64);
                WITEMS(id, T_WIN + T_WQ + T_WKV + T_WOUT) {
                    if (id < T_WIN) { const int nt = (IN_COLS + 63) / 64; cvt_tile(kp_->in[I_WIN] + (size_t)l * D * IN_COLS, IN_COLS, WIN_T, D, idm, (id / nt) * 32, (id % nt) * 64, lane); }
                    else if (id < T_WIN + T_WQ) { const int u = id - T_WIN; cvt_tile(kp_->in[I_WQUP] + (size_t)l * 192 * 384, 384, WQ_T, 256, idm, (u / 6) * 32, (u % 6) * 64, lane); }
                    else if (id < T_WIN + T_WQ + T_WKV) { const int u = id - T_WIN - T_WQ; cvt_tile(kp_->in[I_WKVUP] + (size_t)l * 128 * 512, 512, WKV_T, 128, idm, (u / 8) * 32, (u % 8) * 64, lane); }
                    else { const int u = id - T_WIN - T_WQ - T_WKV; cvt_tile(kp_->in[I_WOUT] + (size_t)l * MIXW * D, D, WOUT_T, MIXW, idm, (u / 16) * 32, (u % 16) * 64, lane); }
                }
            }
            ITEMS(i, (IN_PAD - IN_COLS) * D / 8) ((uint4*)(WIN_T + (size_t)IN_COLS * D))[i] = make_uint4(0, 0, 0, 0);
            ITEMS(i, 128 * 256 / 8) ((uint4*)(WQ_T + (size_t)384 * 256))[i] = make_uint4(0, 0, 0, 0);
            ITEMS(i, 384 * 8) { const int r = i >> 3, c8 = i & 7; *(uint4*)(WQ_T + (size_t)r * 256 + 192 + c8 * 8) = make_uint4(0, 0, 0, 0); }

            const float* w = kp_->in[I_NMPRE] + l * D;
            const int lane = tid & 63;
            {
                float4 xq[4];
                { const float zf_ = (float)(tid >> 20);
#pragma unroll
                  for (int i = 0; i < 4; ++i) xq[i] = make_float4(zf_, zf_, zf_, zf_); }
                float4* aux = (float4*)lds_raw;
                __syncthreads();
                for (int i = tid; i < 11 * (D / 4); i += NTHREADS) { const int v = i / (D / 4), k4 = i % (D / 4);
                    const float* src = v == 0 ? w : modl + (size_t)((v - 1) % 5) * NMOD * D + ((v - 1) / 5) * D;
                    aux[i] = ((const float4*)src)[k4]; }
                __syncthreads();
                const int wstride = gridDim.x * 8; int r = blockIdx.x * 8 + (tid >> 6);
#define P1_LOAD(rr) do { const float4* src_ = (const float4*)((rr) < NLAT ? XSRC + (size_t)(rr) * D : CSRC + (size_t)((rr) - NLAT) * D); _Pragma("unroll") for (int i = 0; i < 4; ++i) xq[i] = src_[i * 64 + lane]; } while (0)
                if (r < NTOK) P1_LOAD(r);
                for (; r < NTOK; r += wstride) {
                    const int bsel = r < NLAT ? r / S : NB;
                    float4 v[4]; float ss = 0.f;
#pragma unroll
                    for (int i = 0; i < 4; ++i) { v[i] = xq[i]; ss += f4dot(v[i], v[i]); }
                    if (r + wstride < NTOK) P1_LOAD(r + wstride);
                    ss = wave_sum(ss);
                    const float rs = 1.0f / sqrtf(ss / D + EPS);
#pragma unroll
                    for (int i = 0; i < 4; ++i) { const int k4 = i * 64 + lane; const float4 w4 = aux[k4], sc = aux[(6 + bsel) * (D / 4) + k4], sh = aux[(1 + bsel) * (D / 4) + k4];
                        const float4 o = make_float4(v[i].x * rs * w4.x * (1.0f + sc.x) + sh.x, v[i].y * rs * w4.y * (1.0f + sc.y) + sh.y, v[i].z * rs * w4.z * (1.0f + sc.z) + sh.z, v[i].w * rs * w4.w * (1.0f + sc.w) + sh.w);
                        *(uint2*)(HB + (size_t)r * D + k4 * 4) = pk4(o); }
                }
#undef P1_LOAD
            }
            GSYNC();
        }
        {
            PHASE_BEGIN();
            pg8::Gemm g{HB, WIN_T, NTOK, IN_PAD, D, 0, 0}; pg8::StaticOrder so; so.init(NTOK, IN_PAD, G, bid);
            pg8::EpiBf16 E{PB, IN_COLS, IN_COLS};
            pg8::gemm_phase<pg8::EpiBf16, pg8::StaticOrder, true, true>(ldsb, g, so, E, tid);
            { const int nwg = (NTOK / 256) * (IN_PAD / 256), busy = nwg % G;
              if (busy != 0 && bid >= busy) CVT_MOE_RANGE(l, 0, (G - busy) * 8 * CVT_PER_WAVE, (bid - busy) * 8 + (tid >> 6), (G - busy) * 8);
              moe_done = busy != 0 ? (G - busy) * 8 * CVT_PER_WAVE : 0; }
            GSYNC();
        }
        {
            PHASE_BEGIN();
            const float* cw = kp_->in[I_CONVW] + (size_t)l * 3 * 768; const float* cb = kp_->in[I_CONVB] + (size_t)l * 768;
            {
                float* cwl = (float*)lds_raw;
                __syncthreads();
                for (int i = tid; i < 4 * 768; i += NTHREADS) cwl[i] = i < 3 * 768 ? cw[i] : cb[i - 3 * 768];
                __syncthreads();
                const int stride = gridDim.x * NTHREADS;
                for (int i0 = blockIdx.x * NTHREADS + tid; i0 < NTOK * 192; i0 += 4 * stride) {
                    uint2 u0[4], um[4], up[4];
#pragma unroll
                    for (int q = 0; q < 4; ++q) { const int i = i0 + q * stride; const unsigned z_ = (unsigned)tid >> 20; u0[q] = make_uint2(z_, z_); um[q] = u0[q]; up[q] = u0[q];
                        if (i < NTOK * 192) { const int c = (i % 192) * 4, r = i / 192; const bool lat = r < NLAT; const int L = lat ? S : CTX; const int t = lat ? r % S : (r - NLAT) % CTX;
                            const bf16_t* u = PB + (size_t)r * IN_COLS + C_XBC + c; u0[q] = *(const uint2*)u; if (t > 0) um[q] = *(const uint2*)(u - IN_COLS); if (t < L - 1) up[q] = *(const uint2*)(u + IN_COLS); } }
#pragma unroll
                    for (int q = 0; q < 4; ++q) { const int i = i0 + q * stride;
                        if (i < NTOK * 192) { const int c = (i % 192) * 4, r = i / 192;
                            float4 acc = f4add(*(const float4*)(cwl + 3 * 768 + c), f4mul(*(const float4*)(cwl + 768 + c), up4(u0[q])));
                            acc = f4add(acc, f4mul(*(const float4*)(cwl + c), up4(um[q]))); acc = f4add(acc, f4mul(*(const float4*)(cwl + 2 * 768 + c), up4(up[q])));
                            *(uint2*)(XBC + (size_t)r * 768 + c) = pk4(make_float4(siluf(acc.x), siluf(acc.y), siluf(acc.z), siluf(acc.w))); } }
                }
            }
            const float* dtb = kp_->in[I_DTB] + l * 16;
            ITEMS(i, NTOK * 16) { const int j = i % 16, r = i / 16; DT[i] = softplusf(bf2f(PB[(size_t)r * IN_COLS + C_DT + j]) + dtb[j]); }
            ITEMS(i, NTOK * 16) {
                const int g = i & 15, r = i >> 4; const int hm = g & 7, isk = g >> 3;
                const bool lat = r < NLAT; const int b = lat ? r / S : (r - NLAT) / CTX, t = lat ? r % S : (r - NLAT) % CTX;
                if (!isk && !lat && !ctx_out) continue;
                const bf16_t* vp = PB + (size_t)r * IN_COLS + (isk ? C_DK : C_DQ) + hm * 32;
                float v[32];
#pragma unroll
                for (int k = 0; k < 32; k += 4) { const float4 x = ld4h(vp + k); v[k] = x.x; v[k + 1] = x.y; v[k + 2] = x.z; v[k + 3] = x.w; }
                if (lat) rope32(v, t, ROPE);
                const float sc = isk ? 1.0f : 0.17677669529663687f * 1.4426950408889634f;
                bf16_t* dst = isk ? KD + ((size_t)(b * 8 + hm) * SK + (lat ? CTX + t : t)) * 32 : (lat ? QD + ((size_t)(b * 8 + hm) * S + t) * 32 : QDC + ((size_t)(b * 8 + hm) * CTX + t) * 32);
#pragma unroll
                for (int k = 0; k < 32; k += 8) *(uint4*)(dst + k) = make_uint4(pk2(v[k] * sc, v[k + 1] * sc), pk2(v[k + 2] * sc, v[k + 3] * sc), pk2(v[k + 4] * sc, v[k + 5] * sc), pk2(v[k + 6] * sc, v[k + 7] * sc));
            }
            ITEMS(i, NB * 4 * (SK / 8) * 64) {
                const int d = i & 63, j8 = (i >> 6) % (SK / 8), hh = (i / (64 * (SK / 8))) & 3, b = i / (256 * (SK / 8));
                const int r0 = j8 * 8 < CTX ? tok_row(false, b, j8 * 8) : tok_row(true, b, j8 * 8 - CTX);
                const bf16_t* sp = PB + (size_t)r0 * IN_COLS + C_DV + hh * 64 + d;
                unsigned v[8];
#pragma unroll
                for (int jj = 0; jj < 8; ++jj) v[jj] = sp[(size_t)jj * IN_COLS];
                *(uint4*)(VDT + ((size_t)(b * 4 + hh) * 64 + d) * SK + j8 * 8) = make_uint4(v[0] | (v[1] << 16), v[2] | (v[3] << 16), v[4] | (v[5] << 16), v[6] | (v[7] << 16));
            }
            const float* qn = kp_->in[I_QNORM] + l * 192; const float* kvn = kp_->in[I_KVNORM] + l * 128;
            { const int lane = tid & 63;
            uint2 xq = make_uint2((unsigned)tid >> 20, (unsigned)tid >> 20);
            const float4 wq4 = lane < 48 ? ((const float4*)qn)[lane] : make_float4(0.f, 0.f, 0.f, 0.f), wkv4 = lane < 32 ? ((const float4*)kvn)[lane] : make_float4(0.f, 0.f, 0.f, 0.f);
            const int wstride = gridDim.x * 8; int i = blockIdx.x * 8 + (tid >> 6);
#define NRM_LOAD(ii) do { const int wh_ = (ii) & 1, r_ = (ii) >> 1; if (lane < (wh_ ? 32 : 48)) xq = *(const uint2*)(PB + (size_t)r_ * IN_COLS + (wh_ ? C_CKV : C_CQ) + lane * 4); } while (0)
            if (i < NTOK * 2) NRM_LOAD(i);
            for (; i < NTOK * 2; i += wstride) {
                const int which = i & 1, r = i >> 1; const int n4 = which ? 32 : 48;
                float4 x = make_float4(0.f, 0.f, 0.f, 0.f); if (lane < n4) x = up4(xq);
                if (i + wstride < NTOK * 2) NRM_LOAD(i + wstride);
                const float ss = wave_sum(f4dot(x, x));
                const float rs = 1.0f / sqrtf(ss / (n4 * 4) + EPS);
                bf16_t* dst = which ? CKVB + (size_t)r * 128 : CQB + (size_t)r * 256;
                if (lane < n4) *(uint2*)(dst + lane * 4) = pk4(f4scale(f4mul(x, which ? wkv4 : wq4), rs));
                else if (!which) { const unsigned z_ = (unsigned)tid >> 20; *(uint2*)(dst + lane * 4) = make_uint2(z_, z_); }
            }
#undef NRM_LOAD
            }
            GSYNC();
        }
        {
            PHASE_BEGIN();
            const int half = (G * 5) / 8;
            if (bid < half) {
                pg8::Gemm g{CQB, WQ_T, NTOK, 512, 256, 0, 0}; pg8::StaticOrder so; so.init(NTOK, 512, half, bid);
                pg8::EpiBf16 E{MQ, 384, 384};
                pg8::gemm_phase<pg8::EpiBf16, pg8::StaticOrder, true, true>(ldsb, g, so, E, tid);
            } else {
                pg8::Gemm g{CKVB, WKV_T, NTOK, 512, 128, 0, 0}; pg8::StaticOrder so; so.init(NTOK, 512, G - half, bid - half);
                pg8::EpiBf16 E{MKV, 512, 512};
                pg8::gemm_phase<pg8::EpiBf16, pg8::StaticOrder, true, true>(ldsb, g, so, E, tid);
            }
            for (int it = vcu; it < NB * NCH * 8; it += G) {
                const int hp = it & 3, dir = (it >> 2) & 1, cp = (it >> 3) % NCH, b = it / (8 * NCH);
                const int k = dir ? (cp < 2 ? 1 - cp : 35 - cp) : cp;
                if (k == NCH - 1) continue;
                ssd_block<false>(b, dir, k, hp, XBC, DT, kp_->in[I_ALOG] + l * 16, HS, ALAST, nullptr, (float*)lds_raw, tid);
            }
            GSYNC();
        }
        {
            PHASE_BEGIN();
            ITEMS(i, NTOK * 8) {
                const int g = i & 7, r = i >> 3; const int hh = g & 3, isk = g >> 2;
                const bool lat = r < NLAT; const int b = lat ? r / S : (r - NLAT) / CTX, t = lat ? r % S : (r - NLAT) % CTX;
                if (!isk && !lat && !ctx_out) continue;
                const bf16_t* npb = isk ? MKV + (size_t)r * 512 + hh * 128 : MQ + (size_t)r * 384 + hh * 96;
                const bf16_t* rp = isk ? PB + (size_t)r * IN_COLS + C_KR : npb + 64;
                float v[32], np[64];
#pragma unroll
                for (int k = 0; k < 32; k += 4) { const float4 x = ld4h(rp + k); v[k] = x.x; v[k + 1] = x.y; v[k + 2] = x.z; v[k + 3] = x.w; }
#pragma unroll
                for (int k = 0; k < 64; k += 4) { const float4 x = ld4h(npb + k); np[k] = x.x; np[k + 1] = x.y; np[k + 2] = x.z; np[k + 3] = x.w; }
                if (lat) rope32(v, t, ROPE);
                const float sc = isk ? 1.0f : 0.10206207261596575f * 1.4426950408889634f;
                bf16_t* dst = isk ? KM + ((size_t)(b * 4 + hh) * SK + (lat ? CTX + t : t)) * 96 : (lat ? QM + ((size_t)(b * 4 + hh) * S + t) * 96 : QMC + ((size_t)(b * 4 + hh) * CTX + t) * 96);
#pragma unroll
                for (int k = 0; k < 64; k += 8) *(uint4*)(dst + k) = make_uint4(pk2(np[k] * sc, np[k + 1] * sc), pk2(np[k + 2] * sc, np[k + 3] * sc), pk2(np[k + 4] * sc, np[k + 5] * sc), pk2(np[k + 6] * sc, np[k + 7] * sc));
#pragma unroll
                for (int k = 0; k < 32; k += 8) *(uint4*)(dst + 64 + k) = make_uint4(pk2(v[k] * sc, v[k + 1] * sc), pk2(v[k + 2] * sc, v[k + 3] * sc), pk2(v[k + 4] * sc, v[k + 5] * sc), pk2(v[k + 6] * sc, v[k + 7] * sc));
            }
            ITEMS(i, NB * 4 * (SK / 8) * 64) {
                const int d = i & 63, j8 = (i >> 6) % (SK / 8), hh = (i / (64 * (SK / 8))) & 3, b = i / (256 * (SK / 8));
                const int r0 = j8 * 8 < CTX ? tok_row(false, b, j8 * 8) : tok_row(true, b, j8 * 8 - CTX);
                const bf16_t* sp = MKV + (size_t)r0 * 512 + hh * 128 + 64 + d;
                unsigned v[8];
#pragma unroll
                for (int jj = 0; jj < 8; ++jj) v[jj] = sp[(size_t)jj * 512];
                *(uint4*)(VMT + ((size_t)(b * 4 + hh) * 64 + d) * SK + j8 * 8) = make_uint4(v[0] | (v[1] << 16), v[2] | (v[3] << 16), v[4] | (v[5] << 16), v[6] | (v[7] << 16));
            }
            ITEMS(i, NB * 2 * 8 * 4096) {
                const int e = i & 4095, h = (i >> 12) & 7, bd = i >> 15;
                float* hp0 = HS + ((size_t)bd * NCH * 8 + h) * 4096 + e; const float* al0 = ALAST + (size_t)bd * NCH * 8 + h;
                float sv[NCH - 1], dk[NCH - 1];
#pragma unroll
                for (int k = 0; k < NCH - 1; ++k) { sv[k] = hp0[(size_t)k * 8 * 4096]; dk[k] = al0[k * 8]; }
                float Hc = 0.f;
#pragma unroll
                for (int k = 0; k < NCH; ++k) { hp0[(size_t)k * 8 * 4096] = Hc; if (k < NCH - 1) Hc = Hc * __expf(dk[k]) + sv[k]; }
            }
            GSYNC();
        }
        {
            PHASE_BEGIN();
            for (int kq = 0; kq * G < NB * 2 * NCH * 4; ++kq) {
                int it = vcu + kq * G;
                { const int T_ = NB * 2 * NCH * 4, full_ = (T_ / G) * G, rem_ = T_ - full_;
                  if (ctx_out && kq * G == full_) it = vcu >= G - rem_ ? full_ + vcu - (G - rem_) : T_; }
                if (it >= NB * 2 * NCH * 4) continue;
                const int hp = it & 3, dir = (it >> 2) & 1, cp = (it >> 3) % NCH, b = it / (8 * NCH);
                const int k = dir ? (cp < 2 ? 1 - cp : 35 - cp) : cp;
                if (k < 2 && !ctx_out) continue;
                ssd_block<true>(b, dir, k, hp, XBC, DT, kp_->in[I_ALOG] + l * 16, HS, ALAST, YD, (float*)lds_raw, tid);
            }
            const int lane = tid & 63, wave = tid >> 6, qr = lane & 31, hf = lane >> 5;
            {
                const float* lq1 = kp_->in[I_LQ1] + l * 32; const float* lk1 = kp_->in[I_LK1] + l * 32; const float* lq2 = kp_->in[I_LQ2] + l * 32; const float* lk2 = kp_->in[I_LK2] + l * 32;
                const float* subw = kp_->in[I_SUBLN] + l * 64;
                const int nlat = NB * 4 * (S / 256), nit = nlat + (ctx_out ? NB * 4 : 0);
                for (int it = vcu; it < nit; it += G) {
                    const bool lat = it < nlat; const int u = lat ? it : it - nlat;
                    const int qb = lat ? u % (S / 256) : 0, hh = lat ? (u / (S / 256)) % 4 : u % 4, b = lat ? u / (4 * (S / 256)) : u / 4;
                    const int t = qb * 256 + wave * 32 + qr; const int row = tok_row(lat, b, t); const int nkt = lat ? SK / 64 : CTX / 64;
                    f32x16 oacc[2]; unsigned o1p[2][8];
#pragma unroll 1
                    for (int mp = 0; mp < 2; ++mp) {
                        const int hm = hh * 2 + mp;
                        const bf16_t* qrow = lat ? QD + ((size_t)(b * 8 + hm) * S + t) * 32 : QDC + ((size_t)(b * 8 + hm) * CTX + t) * 32;
                        float l_run = 0.f;
#pragma unroll
                        for (int i = 0; i < 16; ++i) { oacc[0][i] = 0.f; oacc[1][i] = 0.f; }
                        attn_pass<32>(qrow, KD + (size_t)(b * 8 + hm) * SK * 32, VDT + (size_t)(b * 4 + hh) * 64 * SK, SK, nkt, ldsb, tid, oacc, l_run);
                        l_run = xor32_sum(l_run);
                        if (mp == 0) { const float i1 = 1.0f / l_run;
#pragma unroll
                            for (int db = 0; db < 2; ++db)
#pragma unroll
                                for (int i = 0; i < 8; ++i) o1p[db][i] = pk2(oacc[db][2 * i] * i1, oacc[db][2 * i + 1] * i1); }
                        else {
                            float d1 = 0.f, d2 = 0.f; for (int k = 0; k < 32; ++k) { d1 += lq1[k] * lk1[k]; d2 += lq2[k] * lk2[k]; }
                            const float lam = expf(d1) - expf(d2) + lambda_init;
                            const float i2 = lam / l_run; float ss = 0.f; f32x16 o1[2];
#pragma unroll
                            for (int db = 0; db < 2; ++db)
#pragma unroll
                                for (int i = 0; i < 16; ++i) { const float a1 = __uint_as_float((i & 1) ? (o1p[db][i >> 1] & 0xffff0000u) : (o1p[db][i >> 1] << 16)); const float v = a1 - oacc[db][i] * i2; o1[db][i] = v; ss += v * v; }
                            ss = xor32_sum(ss);
                            const float rs = (1.0f - lambda_init) / sqrtf(ss / 64 + EPS);
                            bf16_t* orow = MIXB + (size_t)row * MIXW + 512 + hh * 64;
#pragma unroll
                            for (int db = 0; db < 2; ++db)
#pragma unroll
                                for (int gq = 0; gq < 4; ++gq) { const int d0 = 32 * db + 8 * gq + 4 * hf; const float4 w4 = *(const float4*)(subw + d0);
                                    *(uint2*)(orow + d0) = make_uint2(pk2(o1[db][4 * gq] * rs * w4.x, o1[db][4 * gq + 1] * rs * w4.y), pk2(o1[db][4 * gq + 2] * rs * w4.z, o1[db][4 * gq + 3] * rs * w4.w)); }
                        }
                    }
                }
            }
            {
                const int nlat = NB * 4 * (S / 256), nit = nlat + (ctx_out ? NB * 4 : 0);
                for (int it = vcu; it < nit; it += G) {
                    const bool lat = it < nlat; const int u = lat ? it : it - nlat;
                    const int qb = lat ? u % (S / 256) : 0, hh = lat ? (u / (S / 256)) % 4 : u % 4, b = lat ? u / (4 * (S / 256)) : u / 4;
                    const int t = qb * 256 + wave * 32 + qr; const int row = tok_row(lat, b, t); const int nkt = lat ? SK / 64 : CTX / 64;
                    const bf16_t* qrow = lat ? QM + ((size_t)(b * 4 + hh) * S + t) * 96 : QMC + ((size_t)(b * 4 + hh) * CTX + t) * 96;
                    f32x16 oacc[2]; float l_run = 0.f;
#pragma unroll
                    for (int i = 0; i < 16; ++i) { oacc[0][i] = 0.f; oacc[1][i] = 0.f; }
                    attn_pass<96>(qrow, KM + (size_t)(b * 4 + hh) * SK * 96, VMT + (size_t)(b * 4 + hh) * 64 * SK, SK, nkt, ldsb, tid, oacc, l_run);
                    l_run = xor32_sum(l_run);
                    const float inv = 1.0f / l_run;
                    bf16_t* orow = MIXB + (size_t)row * MIXW + 768 + hh * 64;
#pragma unroll
                    for (int db = 0; db < 2; ++db)
#pragma unroll
                        for (int gq = 0; gq < 4; ++gq) { const int d0 = 32 * db + 8 * gq + 4 * hf;
                            *(uint2*)(orow + d0) = make_uint2(pk2(oacc[db][4 * gq] * inv, oacc[db][4 * gq + 1] * inv), pk2(oacc[db][4 * gq + 2] * inv, oacc[db][4 * gq + 3] * inv)); }
                }
            }
            GSYNC();
        }
        {
            PHASE_BEGIN();
            const float* nw = kp_->in[I_SSDN] + l * 512; const float* dsk = kp_->in[I_SSDD] + l * 8;
            const int lane = tid & 63;
            uint2 q0, q1, q2, q3; { const unsigned z_ = (unsigned)tid >> 20; q0 = make_uint2(z_, z_); q1 = q0; q2 = q0; q3 = q0; }
            const float4 nw0 = *(const float4*)(nw + lane * 4), nw1 = *(const float4*)(nw + 256 + lane * 4); const float ds0 = dsk[(lane * 4) >> 6], ds1 = dsk[(256 + lane * 4) >> 6];
            const int wstride = gridDim.x * 8; int i = blockIdx.x * 8 + (tid >> 6);
#define GN_LOAD(ii) do { const int g_ = (ii) & 1, r_ = (ii) >> 1, c_ = g_ * 256 + lane * 4; q0 = *(const uint2*)(XBC + (size_t)r_ * 768 + c_); q1 = *(const uint2*)(YD + (size_t)r_ * 512 + c_); \
                q2 = *(const uint2*)(YD + ((size_t)NTOK + r_) * 512 + c_); q3 = *(const uint2*)(PB + (size_t)r_ * IN_COLS + C_Z + c_); } while (0)
            if (i < nrows_out * 2) GN_LOAD(i);
            for (; i < nrows_out * 2; i += wstride) {
                const int g = i & 1, r = i >> 1, c = g * 256 + lane * 4;
                const float4 x = up4(q0), y0 = up4(q1), y1 = up4(q2), z = up4(q3);
                if (i + wstride < nrows_out * 2) GN_LOAD(i + wstride);
                const float ds = g ? ds1 : ds0;
                float4 v = make_float4((ds * x.x + y0.x + y1.x) * siluf(z.x), (ds * x.y + y0.y + y1.y) * siluf(z.y), (ds * x.z + y0.z + y1.z) * siluf(z.z), (ds * x.w + y0.w + y1.w) * siluf(z.w));
                const float ss = wave_sum(f4dot(v, v));
                const float rs = 1.0f / sqrtf(ss / 256 + EPS);
                *(uint2*)(MIXB + (size_t)r * MIXW + c) = pk4(f4scale(f4mul(v, g ? nw1 : nw0), rs));
            }
#undef GN_LOAD
            GSYNC();
        }
        {
            PHASE_BEGIN();
            pg8::Gemm g{MIXB, WOUT_T, nrows_out, D, MIXW, 0, 0}; pg8::StaticOrder so; so.init(nrows_out, D, G, bid);
            pg8::EpiBf16 E{MOUT, D, D};
            pg8::gemm_phase<pg8::EpiBf16, pg8::StaticOrder, true, true>(ldsb, g, so, E, tid);
            { const int nwg = (nrows_out / 256) * (D / 256), busy = nwg % G; const int id0 = moe_done;
              if (busy != 0 && bid >= busy) CVT_MOE_RANGE(l, id0, id0 + (G - busy) * 8 * CVT_PER_WAVE, (bid - busy) * 8 + (tid >> 6), (G - busy) * 8);
              if (busy != 0) moe_done = id0 + (G - busy) * 8 * CVT_PER_WAVE; }
            GSYNC();
        }
        {
            PHASE_BEGIN();
            const float* wpost = kp_->in[I_NMPOST] + l * D; const float* wpre = kp_->in[I_NFPRE] + l * D;
            const float* rw = kp_->in[I_RW] + (size_t)l * D * NE; const float* rb = kp_->in[I_RB] + l * NE;
            const int lane = tid & 63;
            float* rwl = (float*)lds_raw;
            for (int i = tid; i < D * NE / 4; i += NTHREADS) { const int k = i >> 2, e4 = i & 3; ((float4*)rwl)[(((k & 3) * 256 + (k >> 2)) << 2) + e4] = ((const float4*)rw)[i]; }
            float4* aux = (float4*)(rwl + D * NE);
            for (int i = tid; i < 17 * (D / 4); i += NTHREADS) { const int v = i / (D / 4), k4 = i % (D / 4);
                const float* src = v == 0 ? wpost : v == 1 ? wpre : modl + (size_t)((v - 2) % 5) * NMOD * D + (2 + (v - 2) / 5) * D;
                aux[i] = ((const float4*)src)[k4]; }
            __syncthreads();
            float rbv[NE];
#pragma unroll
            for (int e = 0; e < NE; ++e) rbv[e] = rb[e];
            uint2 mq[4]; float4 xq[4];
            { const float zf_ = (float)(tid >> 20);
#pragma unroll
              for (int i = 0; i < 4; ++i) { xq[i] = make_float4(zf_, zf_, zf_, zf_); mq[i] = make_uint2((unsigned)tid >> 20, (unsigned)tid >> 20); } }
            const int wstride = gridDim.x * 8; int r = blockIdx.x * 8 + (tid >> 6);
#define P7_LOAD(rr) do { const float4* xin_ = (const float4*)((rr) < NLAT ? XSRC + (size_t)(rr) * D : CSRC + (size_t)((rr) - NLAT) * D); const bf16_t* m_ = MOUT + (size_t)(rr) * D; \
                _Pragma("unroll") for (int i = 0; i < 4; ++i) { mq[i] = *(const uint2*)(m_ + (i * 64 + lane) * 4); xq[i] = xin_[i * 64 + lane]; } } while (0)
            if (r < nrows_out) P7_LOAD(r);
            for (; r < nrows_out; r += wstride) {
                float4* xr = (float4*)(r < NLAT ? xcur + (size_t)r * D : CTXC + (size_t)(r - NLAT) * D);
                const int bsel = r < NLAT ? r / S : NB;
                float4 mv[4], xv[4]; float ss = 0.f;
#pragma unroll
                for (int i = 0; i < 4; ++i) { mv[i] = up4(mq[i]); xv[i] = xq[i]; ss += f4dot(mv[i], mv[i]); }
                if (r + wstride < nrows_out) P7_LOAD(r + wstride);
                ss = wave_sum(ss);
                const float rs = 1.0f / sqrtf(ss / D + EPS);
                float s2 = 0.f;
#pragma unroll
                for (int i = 0; i < 4; ++i) { const int k4 = i * 64 + lane;
                    xv[i] = f4add(xv[i], f4mul(aux[(2 + bsel) * (D / 4) + k4], f4scale(f4mul(mv[i], aux[k4]), rs))); xr[k4] = xv[i]; s2 += f4dot(xv[i], xv[i]); }
                s2 = wave_sum(s2);
                const float r2 = 1.0f / sqrtf(s2 / D + EPS);
                float lg[NE];
#pragma unroll
                for (int e = 0; e < NE; ++e) lg[e] = 0.f;
#pragma unroll
                for (int i = 0; i < 4; ++i) { const int k4 = i * 64 + lane; const float4 w4 = aux[(D / 4) + k4], sc = aux[(12 + bsel) * (D / 4) + k4], sh = aux[(7 + bsel) * (D / 4) + k4];
                    const float hv[4] = {xv[i].x * r2 * w4.x * (1.0f + sc.x) + sh.x, xv[i].y * r2 * w4.y * (1.0f + sc.y) + sh.y, xv[i].z * r2 * w4.z * (1.0f + sc.z) + sh.z, xv[i].w * r2 * w4.w * (1.0f + sc.w) + sh.w};
                    *(uint2*)(HB + (size_t)r * D + k4 * 4) = make_uint2(pk2(hv[0], hv[1]), pk2(hv[2], hv[3]));
#pragma unroll
                    for (int c = 0; c < 4; ++c) { const float4* rwp = (const float4*)(rwl + (size_t)(c * 256 + k4) * NE);
#pragma unroll
                        for (int e4 = 0; e4 < 4; ++e4) { const float4 w = rwp[e4]; lg[4 * e4] += hv[c] * w.x; lg[4 * e4 + 1] += hv[c] * w.y; lg[4 * e4 + 2] += hv[c] * w.z; lg[4 * e4 + 3] += hv[c] * w.w; }
                        SCHED_FENCE(); }
                }
#pragma unroll
                for (int e = 0; e < NE; ++e) lg[e] = wave_sum(lg[e]) + rbv[e];
                float mx = lg[0];
#pragma unroll
                for (int e = 1; e < NE; ++e) mx = fmaxf(mx, lg[e]);
                float sum = 0.f;
#pragma unroll
                for (int e = 0; e < NE; ++e) { lg[e] = expf(lg[e] - mx); sum += lg[e]; }
                const float is = 1.0f / sum;
                float mine = lg[0];
#pragma unroll
                for (int e = 1; e < NE; ++e) mine = lane == e ? lg[e] : mine;
                if (lane < NE) AFF[(size_t)r * NE + lane] = mine * is;
            }
#undef P7_LOAD
            GSYNC();
        }
        {
            PHASE_BEGIN();
            CVT_MOE_RANGE(l, moe_done, MOE_TILES, bid * 8 + (tid >> 6), G * 8);
            {
                volatile int* sh = (volatile int*)lds_raw;
                const int nsel = (ctx_out ? 2 : 1) * NB * NE;
                for (int it = bid; it < nsel; it += G) {
                    const bool lat = it < NB * NE; const int u = lat ? it : it - NB * NE; const int e = u % NE, b = u / NE;
                    const int L = lat ? S : CTX, cap = lat ? CAP_L : CAP_C, npt = lat ? S / NTHREADS : 1, base = tok_row(lat, b, 0);
                    const bool act = lat || tid < CTX;
                    unsigned key[S / NTHREADS];
#pragma unroll
                    for (int i = 0; i < S / NTHREADS; ++i) key[i] = (act && i < npt) ? __float_as_uint(AFF[(size_t)(base + tid * npt + i) * NE + e]) : 0u;
                    __syncthreads();
                    unsigned T = 0u;
                    for (int bit = 30; bit >= 0; --bit) {
                        const unsigned cand = T | (1u << bit); int c = 0;
#pragma unroll
                        for (int i = 0; i < S / NTHREADS; ++i) c += (key[i] >= cand) ? 1 : 0;
                        if (block_sum(c, tid, sh, bit & 1) >= cap) T = cand;
                    }
                    int cg = 0, ct = 0;
#pragma unroll
                    for (int i = 0; i < S / NTHREADS; ++i) { cg += (key[i] > T) ? 1 : 0; ct += (key[i] == T && key[i] != 0u) ? 1 : 0; }
                    int tot_g, tot_t;
                    (void)block_excl_scan(cg, tid, sh, tot_g);
                    int tie_rank = block_excl_scan(ct, tid, sh, tot_t);
                    const int need = cap - tot_g;
                    int sel[S / NTHREADS], cs = 0;
#pragma unroll
                    for (int i = 0; i < S / NTHREADS; ++i) { const bool tie = key[i] == T && key[i] != 0u; sel[i] = (key[i] > T || (tie && tie_rank < need)) ? 1 : 0; tie_rank += tie ? 1 : 0; cs += sel[i]; }
                    int tot_s; int slot = block_excl_scan(cs, tid, sh, tot_s);
#pragma unroll
                    for (int i = 0; i < S / NTHREADS; ++i) if (act && i < npt) {
                        const int row = base + tid * npt + i; int sa = -1;
                        if (sel[i]) { sa = (lat ? b * CAP_L : NB * CAP_L + b * CAP_C) + slot; ++slot; SELIDX[e * ER_MAX + sa] = row; SELGATE[e * ER_MAX + sa] = __uint_as_float(key[i]); }
                        TOKSLOT[(size_t)row * NE + e] = sa;
                    }
                }
            }
            GSYNC();
        }
        {
            PHASE_BEGIN();
            const int used = ctx_out ? NB * (CAP_L + CAP_C) : NB * CAP_L;
            {
                const int lane = tid & 63, wstride = gridDim.x * 8, nrow = NE * ER;
                for (int r0 = (blockIdx.x * 8 + (tid >> 6)) * 4; r0 < nrow; r0 += wstride * 4) {
                    int src[4]; uint4 v0[4], v1[4];
#pragma unroll
                    for (int q = 0; q < 4; ++q) { const int rr = r0 + q, e = rr / ER, slot = rr % ER; src[q] = (rr < nrow && slot < used) ? SELIDX[e * ER_MAX + slot] : -1; }
#pragma unroll
                    for (int q = 0; q < 4; ++q) { const unsigned z_ = (unsigned)tid >> 20; v0[q] = make_uint4(z_, z_, z_, z_); v1[q] = v0[q];
                        if (src[q] >= 0) { const uint4* sp = (const uint4*)(HB + (size_t)src[q] * D); v0[q] = sp[lane]; v1[q] = sp[64 + lane]; } }
#pragma unroll
                    for (int q = 0; q < 4; ++q) if (r0 + q < nrow) { uint4* dp = (uint4*)(XG + (size_t)(r0 + q) * D); dp[lane] = v0[q]; dp[64 + lane] = v1[q]; }
                }
            }
            GSYNC();
        }
        {
            PHASE_BEGIN();
            pg8::Gemm g{XG, WGU_T, NE * ER, 2 * FF, D, ER / 256, (size_t)2 * FF * D * 2}; pg8::StaticOrder so; so.init(NE * ER, 2 * FF, G, bid);
            pg8::EpiSwiGLU E{HID, FF};
            pg8::gemm_phase<pg8::EpiSwiGLU, pg8::StaticOrder, true, true>(ldsb, g, so, E, tid);
            GSYNC();
        }
        {
            PHASE_BEGIN();
            pg8::Gemm g{HID, WD_T, NE * ER, D, FF, ER / 256, (size_t)D * FF * 2}; pg8::StaticOrder so; so.init(NE * ER, D, G, bid);
            pg8::EpiRowScaleBf16 E{Y, D, SELGATE, ER};
            pg8::gemm_phase<pg8::EpiRowScaleBf16, pg8::StaticOrder, true, true>(ldsb, g, so, E, tid);
            GSYNC();
        }
        {
            PHASE_BEGIN();
            const float* wpost = kp_->in[I_NFPOST] + l * D;
            const int lane = tid & 63;
            {
                float4 xq[4]; int slq = -1;
                { const float zf_ = (float)(tid >> 20);
#pragma unroll
                  for (int i = 0; i < 4; ++i) xq[i] = make_float4(zf_, zf_, zf_, zf_); }
                float4* aux = (float4*)lds_raw;
                __syncthreads();
                for (int i = tid; i < 6 * (D / 4); i += NTHREADS) { const int v = i / (D / 4), k4 = i % (D / 4);
                    const float* src = v == 0 ? wpost : modl + (size_t)(v - 1) * NMOD * D + 5 * D;
                    aux[i] = ((const float4*)src)[k4]; }
                __syncthreads();
                const int wstride = gridDim.x * 8; int r = blockIdx.x * 8 + (tid >> 6);
#define P11_LOAD(rr) do { const float4* xin_ = (const float4*)((rr) < NLAT ? xcur + (size_t)(rr) * D : CTXC + (size_t)((rr) - NLAT) * D); slq = lane < NE ? TOKSLOT[(size_t)(rr) * NE + lane] : -1; \
                    _Pragma("unroll") for (int i = 0; i < 4; ++i) xq[i] = xin_[i * 64 + lane]; } while (0)
                if (r < nrows_out) P11_LOAD(r);
                for (; r < nrows_out; r += wstride) {
                    float4* xr = (float4*)(r < NLAT ? xcur + (size_t)r * D : CTXC + (size_t)(r - NLAT) * D);
                    const int bsel = r < NLAT ? r / S : NB;
                    const int myslot = slq; float4 xv[4], f[4];
#pragma unroll
                    for (int i = 0; i < 4; ++i) { xv[i] = xq[i]; f[i] = make_float4(0.f, 0.f, 0.f, 0.f); }
                    {
                        unsigned msk = (unsigned)__ballot(myslot >= 0) & 0xffffu;
                        const bf16_t* zrow = (const bf16_t*)(kp_->ws + WS_CTL + 32768);
                        const bf16_t* yp[4];
#pragma unroll
                        for (int q = 0; q < 4; ++q) { yp[q] = zrow;
                            if (msk) { const int e = __builtin_ctz(msk); msk &= msk - 1; const int sl = __builtin_amdgcn_readlane(myslot, e); yp[q] = Y + ((size_t)e * ER + sl) * D; } }
                        uint2 yv[4][4];
#pragma unroll
                        for (int q = 0; q < 4; ++q)
#pragma unroll
                            for (int i = 0; i < 4; ++i) yv[q][i] = *(const uint2*)(yp[q] + (i * 64 + lane) * 4);
#pragma unroll
                        for (int q = 0; q < 4; ++q)
#pragma unroll
                            for (int i = 0; i < 4; ++i) f[i] = f4add(f[i], up4(yv[q][i]));
                        while (msk) { const int e = __builtin_ctz(msk); msk &= msk - 1; const int sl = __builtin_amdgcn_readlane(myslot, e); const bf16_t* ypx = Y + ((size_t)e * ER + sl) * D;
#pragma unroll
                            for (int i = 0; i < 4; ++i) f[i] = f4add(f[i], ld4h(ypx + (i * 64 + lane) * 4)); }
                    }
                    if (r + wstride < nrows_out) P11_LOAD(r + wstride);
                    float ss = 0.f;
#pragma unroll
                    for (int i = 0; i < 4; ++i) ss += f4dot(f[i], f[i]);
                    ss = wave_sum(ss);
                    const float rs = 1.0f / sqrtf(ss / D + EPS);
#pragma unroll
                    for (int i = 0; i < 4; ++i) { const int k4 = i * 64 + lane; xr[k4] = f4add(xv[i], f4mul(aux[(1 + bsel) * (D / 4) + k4], f4scale(f4mul(f[i], aux[k4]), rs))); }
                }
#undef P11_LOAD
            }
            GSYNC();
        }
    }
}

extern "C" void kernel_launch(void* const* d_in, const int* in_sizes, int n_in, void* d_out, int out_size, void* d_ws, size_t ws_size, hipStream_t stream) {
    static int grid = 0;
    if (grid == 0) {
        if (n_in != N_IN || out_size != NLAT * D || ws_size < WS_END) { fprintf(stderr, "kernel_launch: unexpected shapes: n_in %d out %d ws %zu (need %zu)\n", n_in, out_size, ws_size, (size_t)WS_END); grid = -1; return; }
        int dev = 0, cus = 0, per_cu = 0;
        (void)hipGetDevice(&dev);
        (void)hipDeviceGetAttribute(&cus, hipDeviceAttributeMultiprocessorCount, dev);
        (void)hipFuncSetAttribute((const void*)mk_forward, hipFuncAttributeMaxDynamicSharedMemorySize, LDS_BYTES);
        (void)hipOccupancyMaxActiveBlocksPerMultiprocessor(&per_cu, (const void*)mk_forward, NTHREADS, LDS_BYTES);
        (void)hipGetLastError();
        if (per_cu < 1) { fprintf(stderr, "kernel_launch: occupancy query says %d blocks/CU\n", per_cu); grid = -1; return; }
        grid = cus;
    }
    if (grid < 0) return;
    (void)hipMemsetAsync((char*)d_ws + WS_CTL, 0, CTL_BYTES, stream);
    Prm p{};
    for (int i = 0; i < N_IN; ++i) p.in[i] = (const float*)d_in[i];
    p.out = (float*)d_out; p.ws = (char*)d_ws;
    void* args[] = {&p};
    hipError_t e = hipLaunchCooperativeKernel((const void*)mk_forward, dim3(grid), dim3(NTHREADS), args, LDS_BYTES, stream);
    if (e != hipSuccess) fprintf(stderr, "kernel_launch: cooperative launch failed: %s (grid %d)\n", hipGetErrorString(e), grid);
}
```

```cpp
#include <hip/hip_runtime.h>
#include <cstdio>
#include <cstdint>

constexpr int D = 1024, NB = 4, S = 4096, CTX = 256, FF = 1024;
constexpr int DEPTH = 2, GRID_W = 64, NMOD = 6, NE = 16;
constexpr int NLAT = NB * S, NCTX = NB * CTX, NTOK = NLAT + NCTX;
constexpr int IN_COLS = 2416, IN_PAD = 2560;
constexpr int C_Z = 0, C_XBC = 512, C_DT = 1280, C_DQ = 1296, C_DK = 1552, C_DV = 1808, C_CQ = 2064, C_CKV = 2256, C_KR = 2384;
constexpr int MIXW = 1024;
constexpr int CAP_L = 2 * S / NE, CAP_C = 2 * CTX / NE;
constexpr int ER_MAX = 2304;
constexpr float EPS = 1e-6f;
static_assert(NB * CAP_L == 2048 && NB * CAP_C == 128, "expert row layout");

enum { I_X = 0, I_C, I_CTX, I_CCTX, I_ADAW, I_ADAB, I_NMPRE, I_NMPOST, I_NFPRE, I_NFPOST, I_WIN, I_CONVW, I_CONVB, I_ALOG, I_DTB, I_SSDD, I_SSDN,
       I_LQ1, I_LK1, I_LQ2, I_LK2, I_SUBLN, I_QNORM, I_WQUP, I_KVNORM, I_WKVUP, I_WOUT, I_RW, I_RB, I_WG, I_WU, I_WD, N_IN };
struct Prm { const float* in[N_IN]; float* out; char* ws; };

typedef unsigned short bf16_t;
constexpr size_t al256(size_t x) { return (x + 255) & ~(size_t)255; }
constexpr size_t WS_CTL = 0, CTL_BYTES = 65536;
constexpr size_t WS_MOD = WS_CTL + CTL_BYTES;
constexpr size_t WS_CTXC = al256(WS_MOD + (size_t)DEPTH * (NB + 1) * NMOD * D * 4);
constexpr size_t WS_AFF = al256(WS_CTXC + (size_t)NCTX * D * 4);
constexpr size_t WS_TOKSLOT = al256(WS_AFF + (size_t)NTOK * NE * 4);
constexpr size_t WS_SELIDX = al256(WS_TOKSLOT + (size_t)NTOK * NE * 4);
constexpr size_t WS_SELGATE = al256(WS_SELIDX + (size_t)NE * ER_MAX * 4);
constexpr size_t WS_DT = al256(WS_SELGATE + (size_t)NE * ER_MAX * 4);
constexpr int NCH = 34;
constexpr size_t WS_ROPE = al256(WS_DT + (size_t)NTOK * 16 * 4);
constexpr size_t WS_ALAST = al256(WS_ROPE + (size_t)S * 32 * 4);
constexpr size_t WS_HB = al256(WS_ALAST + (size_t)NB * 2 * NCH * 8 * 4);
constexpr size_t WS_P = al256(WS_HB + (size_t)NTOK * D * 2);
constexpr size_t WS_G2 = al256(WS_P + (size_t)NTOK * IN_COLS * 4);
constexpr size_t WS_XBC = WS_G2;
constexpr size_t WS_MQ = al256(WS_XBC + (size_t)NTOK * 768 * 4);
constexpr size_t WS_MKV = al256(WS_MQ + (size_t)NTOK * 384 * 4);
constexpr size_t WS_CQB = al256(WS_MKV + (size_t)NTOK * 512 * 4);
constexpr size_t WS_CKVB = al256(WS_CQB + (size_t)NTOK * 256 * 2);
constexpr size_t WS_MIXB = al256(WS_CKVB + (size_t)NTOK * 128 * 2);
constexpr size_t WS_G2END = al256(WS_MIXB + (size_t)NTOK * MIXW * 2);
constexpr size_t WS_HS = WS_HB;
constexpr size_t WS_YD = WS_MQ;
constexpr size_t WS_MOUT = WS_P;
constexpr size_t WS_XG = WS_P;
constexpr size_t WS_HID = al256(WS_XG + (size_t)NE * ER_MAX * D * 2);
constexpr size_t WS_Y = WS_G2;
constexpr size_t WS_WIN = WS_G2END;
constexpr size_t WS_WQ = al256(WS_WIN + (size_t)IN_PAD * D * 2);
constexpr size_t WS_WKV = al256(WS_WQ + (size_t)512 * 256 * 2);
constexpr size_t WS_WOUT = al256(WS_WKV + (size_t)512 * 128 * 2);
constexpr size_t WS_WGU = al256(WS_WOUT + (size_t)D * MIXW * 2);
constexpr size_t WS_WD = al256(WS_WGU + (size_t)NE * 2 * FF * D * 2);
constexpr size_t WS_END = al256(WS_WD + (size_t)NE * D * FF * 2);
constexpr int SK = CTX + S;
constexpr size_t WS_QD = al256(WS_P + (size_t)NTOK * IN_COLS * 2);
constexpr size_t WS_QDC = al256(WS_QD + (size_t)NB * 8 * S * 32 * 2);
constexpr size_t WS_KD = al256(WS_QDC + (size_t)NB * 8 * CTX * 32 * 2);
constexpr size_t WS_VDT = al256(WS_KD + (size_t)NB * 8 * SK * 32 * 2);
constexpr size_t WS_QM = al256(WS_VDT + (size_t)NB * 4 * 64 * SK * 2);
constexpr size_t WS_QMC = al256(WS_QM + (size_t)NB * 4 * S * 96 * 2);
constexpr size_t WS_KM = al256(WS_QMC + (size_t)NB * 4 * CTX * 96 * 2);
constexpr size_t WS_VMT = al256(WS_KM + (size_t)NB * 4 * SK * 96 * 2);
constexpr size_t WS_ATTEND = al256(WS_VMT + (size_t)NB * 4 * 64 * SK * 2);
static_assert(WS_ATTEND <= WS_G2, "attention operands fit in the spare half of the P slot");
static_assert(WS_HID + (size_t)NE * ER_MAX * FF * 2 <= WS_G2, "XG+HID fit in the P region");
static_assert((size_t)NE * ER_MAX * D * 4 <= WS_G2END - WS_G2, "Y fits in the G2 region");
static_assert((size_t)NB * 2 * NCH * 8 * 4096 * 4 <= (size_t)NTOK * D * 2, "HS fits in HB");
static_assert(WS_YD + (size_t)2 * NTOK * 512 * 4 <= WS_MIXB, "YD ends below MIXB");

#define LAS __attribute__((address_space(3)))
constexpr int NTHREADS = 512;
constexpr int LDS_BYTES = 147456;
#define ITEMS(i, n) for (int i = blockIdx.x * NTHREADS + tid; i < (n); i += gridDim.x * NTHREADS)

__device__ __forceinline__ float siluf(float x) { return x / (1.0f + expf(-x)); }
__device__ __forceinline__ float softplusf(float x) {
    const float e = __builtin_amdgcn_exp2f(x * 1.44269504f);
    const float sm = e * fmaf(e, fmaf(e, 0.33333334f, -0.5f), 1.0f), lg = __builtin_amdgcn_logf(1.0f + e) * 0.69314718f;
    return x > 20.f ? x : (e < 1e-3f ? sm : lg); }
__device__ __forceinline__ unsigned f2bf(float f) { unsigned u = __builtin_bit_cast(unsigned, f); return (u + 0x7fffu + ((u >> 16) & 1u)) >> 16; }
typedef float f32x2_t __attribute__((ext_vector_type(2)));
typedef __bf16 bf16x2_t __attribute__((ext_vector_type(2)));
__device__ __forceinline__ unsigned pk2(float lo, float hi) { const f32x2_t v = {lo, hi}; return __builtin_bit_cast(unsigned, __builtin_convertvector(v, bf16x2_t)); }
__device__ __forceinline__ float bf2f(bf16_t h) { return __builtin_bit_cast(float, (unsigned)h << 16); }
#define SCHED_FENCE() __builtin_amdgcn_sched_barrier(0)
__device__ __forceinline__ int mk_tid_impl(int wave_s) { unsigned z; asm volatile("s_mov_b32 %0, 0" : "=s"(z));
    return (wave_s << 6) | (int)__builtin_amdgcn_mbcnt_hi(~0u, __builtin_amdgcn_mbcnt_lo(~0u, z)); }
__device__ __forceinline__ float dpp_row_shr(float v, int n) {
    const int iv = __builtin_bit_cast(int, v); int r;
    switch (n) { case 1: r = __builtin_amdgcn_update_dpp(0, iv, 0x111, 0xf, 0xf, true); break; case 2: r = __builtin_amdgcn_update_dpp(0, iv, 0x112, 0xf, 0xf, true); break;
                 case 4: r = __builtin_amdgcn_update_dpp(0, iv, 0x114, 0xf, 0xf, true); break; default: r = __builtin_amdgcn_update_dpp(0, iv, 0x118, 0xf, 0xf, true); break; }
    return __builtin_bit_cast(float, r);
}
__device__ __forceinline__ float wave_sum(float v) {
    v += dpp_row_shr(v, 1); v += dpp_row_shr(v, 2); v += dpp_row_shr(v, 4); v += dpp_row_shr(v, 8);
    v += __builtin_bit_cast(float, __builtin_amdgcn_update_dpp(0, __builtin_bit_cast(int, v), 0x142, 0xa, 0xf, false));
    v += __builtin_bit_cast(float, __builtin_amdgcn_update_dpp(0, __builtin_bit_cast(int, v), 0x143, 0xc, 0xf, false));
    return __builtin_bit_cast(float, __builtin_amdgcn_readlane(__builtin_bit_cast(int, v), 63)); }
__device__ __forceinline__ float xor32_max(float x) { auto t = __builtin_amdgcn_permlane32_swap(__float_as_uint(x), __float_as_uint(x), false, false); return fmaxf(__uint_as_float(t[0]), __uint_as_float(t[1])); }
__device__ __forceinline__ float xor32_sum(float x) { auto t = __builtin_amdgcn_permlane32_swap(__float_as_uint(x), __float_as_uint(x), false, false); return __uint_as_float(t[0]) + __uint_as_float(t[1]); }
#define WITEMS(i, n) for (int i = blockIdx.x * 8 + (tid >> 6); i < (n); i += gridDim.x * 8)
__device__ __forceinline__ float4 f4mul(float4 a, float4 b) { return make_float4(a.x * b.x, a.y * b.y, a.z * b.z, a.w * b.w); }
__device__ __forceinline__ float4 f4add(float4 a, float4 b) { return make_float4(a.x + b.x, a.y + b.y, a.z + b.z, a.w + b.w); }
__device__ __forceinline__ float4 f4scale(float4 a, float s) { return make_float4(a.x * s, a.y * s, a.z * s, a.w * s); }
__device__ __forceinline__ float f4dot(float4 a, float4 b) { return a.x * b.x + a.y * b.y + a.z * b.z + a.w * b.w; }
__device__ __forceinline__ uint2 pk4(float4 v) { return make_uint2(pk2(v.x, v.y), pk2(v.z, v.w)); }
__device__ __forceinline__ float4 up4(uint2 u) { return make_float4(__uint_as_float(u.x << 16), __uint_as_float(u.x & 0xffff0000u), __uint_as_float(u.y << 16), __uint_as_float(u.y & 0xffff0000u)); }
__device__ __forceinline__ float4 ld4h(const bf16_t* p) { return up4(*(const uint2*)p); }

__device__ __forceinline__ void rope32(float* v, int t, const float* tab) {
    const float4* tp = (const float4*)(tab + (size_t)t * 32);
    float cs[32];
#pragma unroll
    for (int i = 0; i < 8; ++i) { const float4 x = tp[i]; cs[4 * i] = x.x; cs[4 * i + 1] = x.y; cs[4 * i + 2] = x.z; cs[4 * i + 3] = x.w; }
#pragma unroll
    for (int i = 0; i < 8; ++i) {
        { const float c = cs[i], sn = cs[8 + i]; const float x1 = v[i], x2 = v[8 + i]; v[i] = x1 * c - x2 * sn; v[8 + i] = x1 * sn + x2 * c; }
        { const float c = cs[16 + i], sn = cs[24 + i]; const float x1 = v[16 + i], x2 = v[24 + i]; v[16 + i] = x1 * c - x2 * sn; v[24 + i] = x1 * sn + x2 * c; }
    }
}
__device__ __forceinline__ int tok_row(bool lat, int b, int t) { return lat ? b * S + t : NLAT + b * CTX + t; }

namespace pg8 {
#define PG8_LAS __attribute__((address_space(3)))
typedef short bf16x8 __attribute__((ext_vector_type(8)));
typedef float f32x4 __attribute__((ext_vector_type(4)));
typedef unsigned u32x4 __attribute__((ext_vector_type(4)));
constexpr int BM = 256, BK = 64, HALF = 128, HTB = HALF * BK * 2  , STAGE_BYTES = 8 * HTB, NXCD = 8, WGM = 16;

__host__ __device__ __forceinline__ int lds_byte(int r, int c) { const int st = (r >> 4) * 2 + (c >> 5), rr = r & 15, cc = c & 31, ob = rr * 64 + cc * 2; return st * 1024 + (ob ^ (((ob >> 9) & 1) << 5)); }
__host__ __device__ __forceinline__ void stage_rc(int b, int& R, int& C) { const int st = b / 1024, sb = b % 1024, swz = sb ^ (((sb >> 9) & 1) << 5); R = (st >> 1) * 16 + swz / 64; C = (st & 1) * 32 + (swz % 64) / 2; }
__host__ __device__ __forceinline__ int perm32(int rho) { const int n = rho >> 4, i = rho & 15; return 8 * (i >> 2) + 4 * n + (i & 3); }

struct Unit { int pm, pn; };
struct Gemm { const bf16_t* A; const bf16_t* Bt; int M, N, K; int grp_tiles; size_t grp_stride; };

struct StaticOrder {
    int nM, nN, nwg, G, c;
    __host__ __device__ void init(int M, int N, int G_, int c_) { nM = M / BM; nN = N / BM; nwg = nM * nN; G = G_; c = c_; }
    __host__ __device__ bool next(int i, Unit& u) const {
        const long L = (long)i * G + c; if (L >= nwg) return false;
        int wgid = (int)L; { const int q = nwg / NXCD, r = nwg % NXCD, xcd = wgid % NXCD, off = wgid / NXCD; wgid = (xcd < r ? xcd * (q + 1) : r * (q + 1) + (xcd - r) * q) + off; }
        const int nig = WGM * nN, gid = wgid / nig, fm = gid * WGM, gsz = (nM - fm) < WGM ? (nM - fm) : WGM;
        u.pm = fm + ((wgid % nig) % gsz); u.pn = (wgid % nig) / gsz; return true;
    }
    __device__ __forceinline__ void a_ready(const Unit&) const {}
    __device__ __forceinline__ void done(const Unit&) const {}
};

__device__ __forceinline__ unsigned cvt_pk_bf16(float lo, float hi) { unsigned r; asm volatile("v_cvt_pk_bf16_f32 %0, %1, %2" : "=v"(r) : "v"(lo), "v"(hi)); return r; }

typedef unsigned u32x2 __attribute__((ext_vector_type(2)));
struct EpiF32 {
    static constexpr bool PERM = false, AFTER_DRAIN = false;
    float* C; int ldc; int ncols;
    __device__ __forceinline__ void operator()(const f32x4 (&acc)[2][2][4][2], const Unit& u, int wr, int wc, int fr, int fq) const {
        const int row0 = u.pm * BM + wr * 64 + fr, col0 = u.pn * BM + wc * 32 + 4 * fq;
#pragma unroll
        for (int ai = 0; ai < 2; ++ai)
#pragma unroll
            for (int m = 0; m < 4; ++m) { float* rowp = C + (size_t)(row0 + ai * HALF + m * 16) * ldc;
#pragma unroll
                for (int bj = 0; bj < 2; ++bj)
#pragma unroll
                    for (int n = 0; n < 2; ++n) { const int col = col0 + bj * HALF + n * 16; if (col < ncols) *(f32x4*)(rowp + col) = acc[ai][bj][m][n]; } }
    }
};
struct EpiRowScaleF32 {
    static constexpr bool PERM = false, AFTER_DRAIN = false;
    float* C; int ldc; const float* gate; int er;
    __device__ __forceinline__ void operator()(const f32x4 (&acc)[2][2][4][2], const Unit& u, int wr, int wc, int fr, int fq) const {
        const int row0 = u.pm * BM + wr * 64 + fr, col0 = u.pn * BM + wc * 32 + 4 * fq;
#pragma unroll
        for (int ai = 0; ai < 2; ++ai)
#pragma unroll
            for (int m = 0; m < 4; ++m) { const int row = row0 + ai * HALF + m * 16; float* rowp = C + (size_t)row * ldc; const float sc = gate[(row / er) * ER_MAX + row % er];
#pragma unroll
                for (int bj = 0; bj < 2; ++bj)
#pragma unroll
                    for (int n = 0; n < 2; ++n) *(f32x4*)(rowp + col0 + bj * HALF + n * 16) = acc[ai][bj][m][n] * sc; }
    }
};
struct EpiSwiGLU {
    static constexpr bool PERM = true, AFTER_DRAIN = false;
    bf16_t* O; int ldo;
    __device__ __forceinline__ void operator()(const f32x4 (&acc)[2][2][4][2], const Unit& u, int wr, int wc, int fr, int fq) const {
        const int row0 = u.pm * BM + wr * 64 + fr, col0 = u.pn * BM + wc * 32 + 8 * fq;
#pragma unroll
        for (int ai = 0; ai < 2; ++ai)
#pragma unroll
            for (int m = 0; m < 4; ++m) { bf16_t* rowp = O + (size_t)(row0 + ai * HALF + m * 16) * ldo;
#pragma unroll
                for (int bj = 0; bj < 2; ++bj) { const f32x4 gt = acc[ai][bj][m][0], up = acc[ai][bj][m][1]; f32x4 h;
#pragma unroll
                    for (int i = 0; i < 4; ++i) h[i] = gt[i] / (1.0f + __expf(-gt[i])) * up[i];
                    u32x2 w; w.x = cvt_pk_bf16(h[0], h[1]); w.y = cvt_pk_bf16(h[2], h[3]);
                    *(u32x2*)(rowp + (col0 + bj * HALF) / 2) = w; } }
    }
};

struct EpiBf16 {
    static constexpr bool PERM = true, AFTER_DRAIN = false;
    bf16_t* O; int ldo; int ncols;
    __device__ __forceinline__ void operator()(const f32x4 (&acc)[2][2][4][2], const Unit& u, int wr, int wc, int fr, int fq) const {
        const int row0 = u.pm * BM + wr * 64 + fr, col0 = u.pn * BM + wc * 32 + 8 * fq;
#pragma unroll
        for (int ai = 0; ai < 2; ++ai)
#pragma unroll
            for (int m = 0; m < 4; ++m) { bf16_t* rowp = O + (size_t)(row0 + ai * HALF + m * 16) * ldo;
#pragma unroll
                for (int bj = 0; bj < 2; ++bj) { const int col = col0 + bj * HALF; const f32x4 v0 = acc[ai][bj][m][0], v1 = acc[ai][bj][m][1];
                    u32x4 w; w.x = cvt_pk_bf16(v0[0], v0[1]); w.y = cvt_pk_bf16(v0[2], v0[3]); w.z = cvt_pk_bf16(v1[0], v1[1]); w.w = cvt_pk_bf16(v1[2], v1[3]);
                    if (col < ncols) *(u32x4*)(rowp + col) = w; } }
    }
};
struct EpiRowScaleBf16 {
    static constexpr bool PERM = true, AFTER_DRAIN = false;
    bf16_t* O; int ldo; const float* gate; int er;
    __device__ __forceinline__ void operator()(const f32x4 (&acc)[2][2][4][2], const Unit& u, int wr, int wc, int fr, int fq) const {
        const int row0 = u.pm * BM + wr * 64 + fr, col0 = u.pn * BM + wc * 32 + 8 * fq;
#pragma unroll
        for (int ai = 0; ai < 2; ++ai)
#pragma unroll
            for (int m = 0; m < 4; ++m) { const int row = row0 + ai * HALF + m * 16; bf16_t* rowp = O + (size_t)row * ldo; const float sc = gate[(row / er) * ER_MAX + row % er];
#pragma unroll
                for (int bj = 0; bj < 2; ++bj) { const f32x4 v0 = acc[ai][bj][m][0] * sc, v1 = acc[ai][bj][m][1] * sc;
                    u32x4 w; w.x = cvt_pk_bf16(v0[0], v0[1]); w.y = cvt_pk_bf16(v0[2], v0[3]); w.z = cvt_pk_bf16(v1[0], v1[1]); w.w = cvt_pk_bf16(v1[2], v1[3]);
                    *(u32x4*)(rowp + col0 + bj * HALF) = w; } }
    }
};
template <class Epi, class Sched, bool ALIGN_EPI = false, bool SP2 = false>
__device__ __forceinline__ void gemm_phase(PG8_LAS unsigned char* lds, const Gemm g, const Sched& S, const Epi& E, int tid_in) {
    int tid_ = tid_in; asm volatile("" : "+v"(tid_));
    const int tid = tid_, wid = __builtin_amdgcn_readfirstlane(tid >> 6), lane = tid & 63, wr = wid >> 2, wc = wid & 3, fr = lane & 15, fq = lane >> 4;
    int K_ = g.K; asm volatile("" : "+s"(K_));
    const int K = K_, nt = K / BK;
    unsigned voffA[2], voffB[2];
#pragma unroll
    for (int i = 0; i < 2; ++i) { int R, C; stage_rc(tid * 16 + i * 8192, R, C); const int Rb = Epi::PERM ? ((R & ~31) + perm32(R & 31)) : R;
        voffA[i] = (unsigned)(R * K + C) * 2u; voffB[i] = (unsigned)(Rb * K + C) * 2u; }
    const size_t kstep = (size_t)(BK * 2);
    const size_t hstep = (size_t)HALF * K * 2;
    const size_t tstep = 2 * hstep;
    const unsigned ldsw = (unsigned)wid * 1024u;
    const int aoff = lds_byte(wr * 64 + fr, fq * 8), boff = lds_byte(wc * 32 + fr, fq * 8);
#define PG8_SA(b, h) (((b) * 2 + (h)) * HTB)
#define PG8_SB(b, h) ((4 + (b) * 2 + (h)) * HTB)
#define PG8_STAGE(bufoff, gbase, voff) do { _Pragma("unroll") for (int _i = 0; _i < 2; ++_i) \
        __builtin_amdgcn_global_load_lds((const unsigned*)((const char*)(gbase) + (voff)[_i]), (PG8_LAS unsigned*)(lds + (bufoff) + ldsw + _i * 8192), 16, 0, 0); } while (0)
#define PG8_LDA(dst, b, h) do { _Pragma("unroll") for (int m = 0; m < 4; ++m) _Pragma("unroll") for (int k = 0; k < 2; ++k) dst[m][k] = *(const PG8_LAS bf16x8*)(lds + PG8_SA(b, h) + aoff + m * 2048 + k * 1024); } while (0)
#define PG8_LDB(dst, b, h) do { _Pragma("unroll") for (int n = 0; n < 2; ++n) _Pragma("unroll") for (int k = 0; k < 2; ++k) dst[n][k] = *(const PG8_LAS bf16x8*)(lds + PG8_SB(b, h) + boff + n * 2048 + k * 1024); } while (0)
#define PG8_MMA(ai, bj, At, Bt) do { __builtin_amdgcn_s_setprio(1); _Pragma("unroll") for (int m = 0; m < 4; ++m) _Pragma("unroll") for (int n = 0; n < 2; ++n) _Pragma("unroll") for (int k = 0; k < 2; ++k) \
        acc[ai][bj][m][n] = __builtin_amdgcn_mfma_f32_16x16x32_bf16(Bt[n][k], At[m][k], acc[ai][bj][m][n], 0, 0, 0); __builtin_amdgcn_s_setprio(0); } while (0)
#define PG8_WAIT_V(n) asm volatile("s_waitcnt vmcnt(" #n ")" ::: "memory")
#define PG8_WAIT_L(n) asm volatile("s_waitcnt lgkmcnt(" #n ")" ::: "memory")
#define PG8_BAR __builtin_amdgcn_s_barrier()
#define PG8_SCHED __builtin_amdgcn_sched_barrier(0)
    Unit cur, nxt; int ui = 0;
    if (!S.next(0, cur)) return;
    f32x4 acc[2][2][4][2];
#pragma unroll
    for (int a = 0; a < 2; ++a)
#pragma unroll
        for (int b = 0; b < 2; ++b)
#pragma unroll
            for (int m = 0; m < 4; ++m)
#pragma unroll
                for (int n = 0; n < 2; ++n) acc[a][b][m][n] = (f32x4){0.f, 0.f, 0.f, 0.f};
    bf16x8 At[4][2], B0[2][2], B1[2][2];
    const char* cA = (const char*)g.A + (size_t)cur.pm * tstep; const char* cB = (const char*)g.Bt + (size_t)cur.pn * tstep + (g.grp_tiles ? (size_t)(cur.pm / g.grp_tiles) * g.grp_stride : (size_t)0);
    S.a_ready(cur);
    if constexpr (SP2) {
        PG8_STAGE(PG8_SB(0, 0), cB, voffB); PG8_STAGE(PG8_SB(0, 1), cB + hstep, voffB); PG8_STAGE(PG8_SA(0, 0), cA, voffA); PG8_STAGE(PG8_SA(0, 1), cA + hstep, voffA);
        if (wr == 1) PG8_BAR;
        PG8_WAIT_V(2); PG8_BAR;
        PG8_STAGE(PG8_SB(1, 0), cB + kstep, voffB); PG8_STAGE(PG8_SA(1, 0), cA + kstep, voffA); PG8_STAGE(PG8_SB(1, 1), cB + hstep + kstep, voffB);
        PG8_WAIT_V(6); PG8_BAR;
    } else {
        PG8_STAGE(PG8_SB(0, 0), cB, voffB); PG8_STAGE(PG8_SA(0, 0), cA, voffA); PG8_STAGE(PG8_SB(0, 1), cB + hstep, voffB); PG8_STAGE(PG8_SA(0, 1), cA + hstep, voffA);
        if (wr == 1) PG8_BAR;
        PG8_WAIT_V(4); PG8_BAR;
        PG8_STAGE(PG8_SB(1, 0), cB + kstep, voffB); PG8_STAGE(PG8_SA(1, 0), cA + kstep, voffA); PG8_STAGE(PG8_SB(1, 1), cB + hstep + kstep, voffB);
        PG8_WAIT_V(6); PG8_BAR;
    }
    for (;;) {
        const bool has_next = S.next(ui + 1, nxt);
        const char* nA = has_next ? (const char*)g.A + (size_t)nxt.pm * tstep : cA; const char* nB = has_next ? (const char*)g.Bt + (size_t)nxt.pn * tstep + (g.grp_tiles ? (size_t)(nxt.pm / g.grp_tiles) * g.grp_stride : (size_t)0) : cB;
        for (int t = 0; t < nt; t += 2) {
            const bool last = (t == nt - 2);
            const char* a1 = cA + (size_t)(t + 1) * kstep;
            const char* a2 = last ? nA : cA + (size_t)(t + 2) * kstep; const char* b2 = last ? nB : cB + (size_t)(t + 2) * kstep;
            const char* a3 = a2 + kstep; const char* b3 = b2 + kstep;
            if (last && has_next) S.a_ready(nxt);
            if constexpr (SP2) {
            PG8_LDB(B0, 0, 0); PG8_LDB(B1, 0, 1); PG8_SCHED; PG8_LDA(At, 0, 0); PG8_STAGE(PG8_SA(1, 1), a1 + hstep, voffA);
            PG8_WAIT_V(8); PG8_WAIT_L(0); PG8_BAR; PG8_MMA(0, 0, At, B0); PG8_MMA(0, 1, At, B1); PG8_BAR; PG8_SCHED;
            PG8_LDA(At, 0, 1); PG8_STAGE(PG8_SB(0, 0), b2, voffB); PG8_STAGE(PG8_SB(0, 1), b2 + hstep, voffB); PG8_STAGE(PG8_SA(0, 0), a2, voffA);
            PG8_WAIT_V(8); PG8_WAIT_L(0); PG8_BAR; PG8_MMA(1, 0, At, B0); PG8_MMA(1, 1, At, B1); PG8_BAR; PG8_SCHED;
            PG8_LDB(B0, 1, 0); PG8_LDB(B1, 1, 1); PG8_SCHED; PG8_LDA(At, 1, 0); PG8_STAGE(PG8_SA(0, 1), a2 + hstep, voffA);
            PG8_WAIT_V(8); PG8_WAIT_L(0); PG8_BAR; PG8_MMA(0, 0, At, B0); PG8_MMA(0, 1, At, B1); PG8_BAR; PG8_SCHED;
            PG8_LDA(At, 1, 1); PG8_STAGE(PG8_SB(1, 0), b3, voffB); PG8_STAGE(PG8_SB(1, 1), b3 + hstep, voffB); PG8_STAGE(PG8_SA(1, 0), a3, voffA);
            PG8_WAIT_V(8); PG8_WAIT_L(0); PG8_BAR; PG8_MMA(1, 0, At, B0); PG8_MMA(1, 1, At, B1); PG8_BAR; PG8_SCHED;
            } else {
            PG8_LDB(B0, 0, 0); PG8_SCHED; PG8_LDA(At, 0, 0); PG8_STAGE(PG8_SA(1, 1), a1 + hstep, voffA);
            PG8_WAIT_L(8); PG8_BAR; PG8_WAIT_L(0); PG8_MMA(0, 0, At, B0); PG8_BAR; PG8_SCHED;
            PG8_LDB(B1, 0, 1); PG8_STAGE(PG8_SB(0, 0), b2, voffB);
            PG8_BAR; PG8_WAIT_L(0); PG8_MMA(0, 1, At, B1); PG8_BAR;
            PG8_LDA(At, 0, 1); PG8_STAGE(PG8_SA(0, 0), a2, voffA);
            PG8_BAR; PG8_WAIT_L(0); PG8_MMA(1, 0, At, B0); PG8_BAR; PG8_SCHED;
            PG8_STAGE(PG8_SB(0, 1), b2 + hstep, voffB);
            PG8_WAIT_V(6); PG8_BAR; PG8_MMA(1, 1, At, B1); PG8_BAR;
            PG8_LDB(B0, 1, 0); PG8_SCHED; PG8_LDA(At, 1, 0); PG8_STAGE(PG8_SA(0, 1), a2 + hstep, voffA);
            PG8_WAIT_L(8); PG8_BAR; PG8_WAIT_L(0); PG8_MMA(0, 0, At, B0); PG8_BAR; PG8_SCHED;
            PG8_LDB(B1, 1, 1); PG8_STAGE(PG8_SB(1, 0), b3, voffB);
            PG8_BAR; PG8_WAIT_L(0); PG8_MMA(0, 1, At, B1); PG8_BAR;
            PG8_LDA(At, 1, 1); PG8_STAGE(PG8_SA(1, 0), a3, voffA);
            PG8_BAR; PG8_WAIT_L(0); PG8_MMA(1, 0, At, B0); PG8_BAR; PG8_SCHED;
            PG8_STAGE(PG8_SB(1, 1), b3 + hstep, voffB);
            PG8_WAIT_V(6); PG8_BAR; PG8_MMA(1, 1, At, B1); PG8_BAR;
            }
        }
        if constexpr (ALIGN_EPI) { if (wr == 0) PG8_BAR; }
        if constexpr (!Epi::AFTER_DRAIN) { E(acc, cur, wr, wc, fr, fq); S.done(cur); }
        if (!has_next) break;
#pragma unroll
        for (int a = 0; a < 2; ++a)
#pragma unroll
            for (int b = 0; b < 2; ++b)
#pragma unroll
                for (int m = 0; m < 4; ++m)
#pragma unroll
                    for (int n = 0; n < 2; ++n) acc[a][b][m][n] = (f32x4){0.f, 0.f, 0.f, 0.f};
        cur = nxt; cA = nA; cB = nB; ++ui;
        if constexpr (ALIGN_EPI) { if (wr == 1) PG8_BAR; }
    }
    PG8_WAIT_V(0);
    if constexpr (!ALIGN_EPI) { if (wr == 0) PG8_BAR; }
    PG8_BAR;
    if constexpr (Epi::AFTER_DRAIN) { E.fused(acc, cur, wr, wc, fr, fq, lds, wid, lane); S.done(cur); }
#undef PG8_SA
#undef PG8_SB
#undef PG8_STAGE
#undef PG8_LDA
#undef PG8_LDB
#undef PG8_MMA
#undef PG8_WAIT_V
#undef PG8_WAIT_L
#undef PG8_BAR
#undef PG8_SCHED
}
}


#define XB_TMO      128
#define XB_XCNT(j)  (256  + 64 * (j))
#define XB_XSUB(j)  (1280 + 64 * (j))
#define XB_XGEN(j)  (2304 + 64 * (j))
#define XB_TOP      3328
#define XB_TOPGEN   3392
#define XCD_BAR_WORDS 3456
#define XB_SPIN_CAP (1u << 22)
__device__ __forceinline__ unsigned xb_ld(unsigned* p)              { return __hip_atomic_load(p, __ATOMIC_RELAXED, __HIP_MEMORY_SCOPE_AGENT); }
__device__ __forceinline__ unsigned xb_add(unsigned* p, unsigned v) { return __hip_atomic_fetch_add(p, v, __ATOMIC_RELAXED, __HIP_MEMORY_SCOPE_AGENT); }
__device__ __forceinline__ unsigned xb_xcc_id() { return (unsigned)__builtin_amdgcn_s_getreg((3 << 11) | 20) & 0xFu; }
#define XB_SPIN(cond, bar) do { unsigned _sp = 0; while (cond) { __builtin_amdgcn_s_sleep(1); \
    if ((++_sp & 255u) == 0u) { if (xb_ld(&(bar)[XB_TMO])) break; if (_sp > XB_SPIN_CAP) { atomicAdd(&(bar)[XB_TMO], 1u); break; } } } } while (0)
struct XcdBarrier { unsigned* bar; unsigned x; volatile LAS unsigned* st; };
__device__ __forceinline__ XcdBarrier xcd_barrier_post(unsigned* bar, volatile LAS unsigned* st, int tid_in) {
    XcdBarrier b; b.bar = bar; b.x = xb_xcc_id(); b.st = st;
    if (tid_in == 0) (void)xb_add(&bar[XB_XCNT(b.x)], 1u);
    return b;
}
__device__ __forceinline__ void xcd_barrier_complete(unsigned* bar, unsigned x, unsigned& nloc, unsigned& nx) {
    const unsigned G = gridDim.x * gridDim.y * gridDim.z;
    unsigned sum, cnt, mine, sp = 0u;
    for (;;) {
        sum = 0u; cnt = 0u; mine = 0u;
#pragma unroll
        for (unsigned j = 0; j < 16; ++j) { const unsigned c = xb_ld(&bar[XB_XCNT(j)]); sum += c; cnt += (c > 0u) ? 1u : 0u; mine = (j == x) ? c : mine; }
        if (sum == G) break;
        __builtin_amdgcn_s_sleep(1);
        if ((++sp & 255u) == 0u) { if (xb_ld(&bar[XB_TMO])) break; if (sp > XB_SPIN_CAP) { atomicAdd(&bar[XB_TMO], 1u); break; } }
    }
    nloc = mine > 0u ? mine : 1u; nx = cnt > 0u ? cnt : 1u;
}
__device__ __forceinline__ void xcd_barrier(const XcdBarrier& b, int tid_in) {
    asm volatile("s_waitcnt vmcnt(0)" ::: "memory");
    __syncthreads();
    if (tid_in == 0) {
        unsigned* bar = b.bar;
        __builtin_amdgcn_s_waitcnt(0);
        unsigned nloc = b.st[0], nx = b.st[1];
        if (nloc == 0u) { xcd_barrier_complete(bar, b.x, nloc, nx); b.st[0] = nloc; b.st[1] = nx; }
        const unsigned old = xb_add(&bar[XB_XSUB(b.x)], 1u);
        const unsigned gen = old / nloc;
        if (old + 1u == (gen + 1u) * nloc) {
            __builtin_amdgcn_fence(__ATOMIC_RELEASE, "agent");
            asm volatile("s_waitcnt vmcnt(0)" ::: "memory");
            const unsigned og = xb_add(&bar[XB_TOP], 1u);
            const unsigned tg = og / nx;
            if (og + 1u == (tg + 1u) * nx) xb_add(&bar[XB_TOPGEN], 1u);
            else XB_SPIN(xb_ld(&bar[XB_TOPGEN]) == tg, bar);
            __builtin_amdgcn_fence(__ATOMIC_ACQUIRE, "agent");
            xb_add(&bar[XB_XGEN(b.x)], 1u);
            asm volatile("s_waitcnt vmcnt(0)" ::: "memory");
        } else {
            XB_SPIN(xb_ld(&bar[XB_XGEN(b.x)]) == gen, bar);
            __builtin_amdgcn_fence(__ATOMIC_ACQUIRE, "agent");
            asm volatile("s_waitcnt vmcnt(0)" ::: "memory");
        }
    }
    __syncthreads();
}


typedef short bf16x8 __attribute__((ext_vector_type(8)));
typedef short s16x4 __attribute__((ext_vector_type(4)));
typedef float f32x16 __attribute__((ext_vector_type(16)));
typedef unsigned v4u __attribute__((ext_vector_type(4)));
typedef unsigned v2u __attribute__((ext_vector_type(2)));
constexpr int MOE_TILES = NE * 3 * 512;
constexpr float ATT_THR = 5.0f;
template <int DK> struct AttL { static constexpr int KSTR = DK * 2 + 16, KBYTES = 64 * KSTR, VSTR = 136, VBYTES = 64 * VSTR, KPT = 64 * DK / 4 / NTHREADS;
    static constexpr int K_OFF = 0, V_OFF = 2 * KBYTES; };

struct CvArgs { const float* wg; const float* wu; const float* wd; bf16_t* gu; bf16_t* dn; int id0; };
template <int DK, bool CONV>
__device__ __forceinline__ void attn_pass(const bf16_t* Qrow, const bf16_t* Kp, const bf16_t* Vtp, int vt_ld, int nkt, LAS unsigned char* lds, int tid, f32x16 (&oacc)[2], float& l_run, const CvArgs& cvp) {
    typedef AttL<DK> L;
    constexpr bool AUG = DK <= 32;
    const int lane = tid & 63, r = lane & 31, h = lane >> 5;
    bf16x8 qf[DK / 16];
#pragma unroll
    for (int ks = 0; ks < DK / 16; ++ks) qf[ks] = *(const bf16x8*)(Qrow + 16 * ks + 8 * h);
    const short z_ = (short)(tid >> 20);
    bf16x8 aone = {z_, z_, z_, z_, z_, z_, z_, z_}, bneg = {z_, z_, z_, z_, z_, z_, z_, z_};
    if (h == 0) aone[0] = (short)0x3F80;
    float m_run = 0.f;
    v2u kreg[L::KPT]; v4u vreg;
    float cv[8]; const float* csrc = cvp.wg; int cid = 0, cpart = 0;
    { const unsigned zu_ = (unsigned)tid >> 20; const v4u z4_ = {zu_, zu_, zu_, zu_}; const v2u z2_ = {zu_, zu_}; vreg = z4_;
#pragma unroll
      for (int i_ = 0; i_ < L::KPT; ++i_) kreg[i_] = z2_;
#pragma unroll
      for (int i_ = 0; i_ < 8; ++i_) cv[i_] = __uint_as_float(zu_); }
    const int vd = tid >> 3, vpart = tid & 7;
    const unsigned koff = (unsigned)tid * 8u, voff = ((unsigned)vd * (unsigned)vt_ld + (unsigned)vpart * 8u) * 2u, lane4 = (unsigned)lane * 4u;
#define ATT_LOADK(j) do { const char* kb_ = (const char*)Kp + (size_t)(j) * (64 * DK * 2); _Pragma("unroll") for (int i_ = 0; i_ < L::KPT; ++i_) kreg[i_] = *(const v2u*)(kb_ + (koff + (unsigned)i_ * (NTHREADS * 8u))); } while (0)
#define ATT_LOADV(j) do { const char* vb_ = (const char*)Vtp + (size_t)(j) * 128; vreg = *(const v4u*)(vb_ + voff); } while (0)
#define ATT_STOREK(buf) do { _Pragma("unroll") for (int i_ = 0; i_ < L::KPT; ++i_) { const int c_ = tid + i_ * NTHREADS; const int key_ = c_ / (DK / 4), part_ = c_ % (DK / 4); \
            *(LAS v2u*)(lds + L::K_OFF + (buf) * L::KBYTES + key_ * L::KSTR + part_ * 8) = kreg[i_]; } } while (0)
#define ATT_STOREV(buf) do { LAS unsigned char* vp_ = lds + L::V_OFF + (buf) * L::VBYTES + vd * L::VSTR + vpart * 16; *(LAS v2u*)vp_ = (v2u){vreg.x, vreg.y}; *(LAS v2u*)(vp_ + 8) = (v2u){vreg.z, vreg.w}; } while (0)
#define ATT_QK(dst, buf) do { _Pragma("unroll") for (int kb = 0; kb < 2; ++kb) { _Pragma("unroll") for (int i = 0; i < 16; ++i) dst[kb][i] = 0.f; \
        if (AUG) dst[kb] = __builtin_amdgcn_mfma_f32_32x32x16_bf16(aone, bneg, dst[kb], 0, 0, 0); \
        _Pragma("unroll") for (int ks = 0; ks < DK / 16; ++ks) { const bf16x8 a_ = *(const LAS bf16x8*)(lds + L::K_OFF + (buf) * L::KBYTES + (32 * kb + r) * L::KSTR + (16 * ks + 8 * h) * 2); \
            dst[kb] = __builtin_amdgcn_mfma_f32_32x32x16_bf16(a_, qf[ks], dst[kb], 0, 0, 0); } } } while (0)
#define ATT_CV_PRE(R, j) do { if (CONV) { \
        if ((R) == 0) { const int ss_ = min((j) >> 2, 15); cid = min(cvp.id0 + (ss_ >> 2), MOE_TILES - 1); cpart = ss_ & 3; \
            const int mat_ = cid >> 9, tl_ = cid & 511, e_ = mat_ / 3, wh_ = mat_ - 3 * e_; \
            csrc = (wh_ == 0 ? cvp.wg : wh_ == 1 ? cvp.wu : cvp.wd) + (size_t)e_ * D * FF + (size_t)((tl_ >> 4) * 32 + 8 * cpart) * 1024 + (tl_ & 15) * 64; } \
        constexpr int i0_ = (R) == 0 ? 0 : (R) == 1 ? 3 : 6, i1_ = (R) == 0 ? 3 : (R) == 1 ? 6 : (R) == 2 ? 8 : 6; \
        _Pragma("unroll") for (int i_ = i0_; i_ < i1_; ++i_) cv[i_] = *(const float*)((const char*)csrc + (size_t)i_ * 4096 + lane4); } } while (0)
#define ATT_CV_POST(R) do { if (CONV && (R) == 3) { \
        const int mat_ = cid >> 9, tl_ = cid & 511, e_ = mat_ / 3, wh_ = mat_ - 3 * e_, n_ = (tl_ & 15) * 64 + lane; \
        const int row_ = wh_ == 2 ? n_ : ((n_ >> 2) * 8 + (n_ & 3) + 4 * wh_); \
        char* db_ = (char*)(wh_ == 2 ? cvp.dn + (size_t)e_ * D * FF : cvp.gu + (size_t)e_ * 2 * FF * D) + ((tl_ >> 4) * 32 + 8 * cpart) * 2; \
        *(uint4*)(db_ + (unsigned)row_ * 2048u) = make_uint4(pk2(cv[0], cv[1]), pk2(cv[2], cv[3]), pk2(cv[4], cv[5]), pk2(cv[6], cv[7])); } } while (0)
#define ATT_BODY(SC, SN, j, CHK, R) do { \
        ATT_LOADK(min((j) + 2, nkt - 1));                   \
        ATT_LOADV(min((j) + 1, nkt - 1)); \
        ATT_CV_PRE(R, j); \
        ATT_QK(SN, ((j) + 1) & 1);                          \
        if (CHK) { \
            float t0 = fmaxf(fmaxf(SC[0][0], SC[0][1]), SC[0][2]), t1 = fmaxf(fmaxf(SC[0][3], SC[0][4]), SC[0][5]), t2 = fmaxf(fmaxf(SC[0][6], SC[0][7]), SC[0][8]), t3 = fmaxf(fmaxf(SC[0][9], SC[0][10]), SC[0][11]); \
            float t4 = fmaxf(fmaxf(SC[0][12], SC[0][13]), SC[0][14]), t5 = fmaxf(fmaxf(SC[0][15], SC[1][0]), SC[1][1]), t6 = fmaxf(fmaxf(SC[1][2], SC[1][3]), SC[1][4]), t7 = fmaxf(fmaxf(SC[1][5], SC[1][6]), SC[1][7]); \
            float t8 = fmaxf(fmaxf(SC[1][8], SC[1][9]), SC[1][10]), t9 = fmaxf(fmaxf(SC[1][11], SC[1][12]), SC[1][13]), t10 = fmaxf(SC[1][14], SC[1][15]); \
            float tmax = fmaxf(fmaxf(fmaxf(fmaxf(t0, t1), t2), fmaxf(fmaxf(t3, t4), t5)), fmaxf(fmaxf(fmaxf(t6, t7), t8), fmaxf(t9, t10))); \
            tmax = xor32_max(tmax); if (!AUG) tmax -= m_run;            \
            if ((j) == 0 || __any(tmax > ATT_THR)) {                   \
                const float want = (j) == 0 ? tmax : m_run + fmaxf(tmax, 0.f); \
                const float mn = __uint_as_float(pk2(want, 0.f) << 16), dlt = mn - m_run, alpha = __builtin_amdgcn_exp2f(-dlt); \
                _Pragma("unroll") for (int i = 0; i < 16; ++i) { oacc[0][i] *= alpha; oacc[1][i] *= alpha; if (AUG) { SC[0][i] -= dlt; SC[1][i] -= dlt; SN[0][i] -= dlt; SN[1][i] -= dlt; } } \
                l_run *= alpha; m_run = mn; if (AUG && h == 0) bneg[0] = (short)(__float_as_uint(-mn) >> 16); \
            } \
        } \
        float ps0 = 0.f, ps1 = 0.f, ps2 = 0.f, ps3 = 0.f; \
        _Pragma("unroll") for (int kb = 0; kb < 2; ++kb) \
            _Pragma("unroll") for (int i = 0; i < 16; i += 4) { const float mo = AUG ? 0.f : m_run; const float p0 = __builtin_amdgcn_exp2f(SC[kb][i] - mo), p1 = __builtin_amdgcn_exp2f(SC[kb][i + 1] - mo), p2 = __builtin_amdgcn_exp2f(SC[kb][i + 2] - mo), p3 = __builtin_amdgcn_exp2f(SC[kb][i + 3] - mo); \
                SC[kb][i] = p0; SC[kb][i + 1] = p1; SC[kb][i + 2] = p2; SC[kb][i + 3] = p3; ps0 += p0; ps1 += p1; ps2 += p2; ps3 += p3; } \
        l_run += (ps0 + ps1) + (ps2 + ps3); \
        _Pragma("unroll") for (int kb = 0; kb < 2; ++kb) \
            _Pragma("unroll") for (int s2 = 0; s2 < 2; ++s2) { \
                union { bf16x8 v; unsigned u[4]; } pf; \
                _Pragma("unroll") for (int i = 0; i < 4; ++i) pf.u[i] = pk2(SC[kb][8 * s2 + 2 * i], SC[kb][8 * s2 + 2 * i + 1]); \
                _Pragma("unroll") for (int db = 0; db < 2; ++db) { \
                    const LAS unsigned char* vp = lds + L::V_OFF + ((j) & 1) * L::VBYTES + (32 * db + r) * L::VSTR + (32 * kb + 16 * s2 + 4 * h) * 2; \
                    union { bf16x8 v; v2u u[2]; } af; af.u[0] = *(const LAS v2u*)vp; af.u[1] = *(const LAS v2u*)(vp + 16); \
                    oacc[db] = __builtin_amdgcn_mfma_f32_32x32x16_bf16(af.v, pf.v, oacc[db], 0, 0, 0); } } \
        ATT_STOREK((j) & 1);               \
        ATT_STOREV(((j) + 1) & 1);         \
        ATT_CV_POST(R); \
        __syncthreads(); \
    } while (0)
    __syncthreads();
    { v2u k1_[L::KPT]; ATT_LOADK(0); ATT_LOADV(0);
#pragma unroll
      for (int i_ = 0; i_ < L::KPT; ++i_) k1_[i_] = *(const v2u*)((const char*)Kp + (size_t)(64 * DK * 2) + (koff + (unsigned)i_ * (NTHREADS * 8u)));
      ATT_STOREK(0); ATT_STOREV(0);
#pragma unroll
      for (int i_ = 0; i_ < L::KPT; ++i_) kreg[i_] = k1_[i_];
      ATT_STOREK(1); }
    __syncthreads();
    f32x16 sa[2], sb[2];
#pragma unroll
    for (int i = 0; i < 16; ++i) { sb[0][i] = (float)z_; sb[1][i] = (float)z_; }
    ATT_QK(sa, 0);
    __syncthreads();
    if (CONV) {
        for (int j = 0; j < nkt; j += 4) {
            ATT_BODY(sa, sb, j, true, 0);
            ATT_BODY(sb, sa, j + 1, false, 1);
            ATT_BODY(sa, sb, j + 2, false, 2);
            ATT_BODY(sb, sa, j + 3, false, 3);
        }
    } else {
        for (int j = 0; j < nkt; j += 2) {
            ATT_BODY(sa, sb, j, ((j & 3) == 0), -1);
            ATT_BODY(sb, sa, j + 1, false, -1);
        }
    }
#undef ATT_BODY
#undef ATT_CV_PRE
#undef ATT_CV_POST
#undef ATT_LOADK
#undef ATT_LOADV
#undef ATT_STOREK
#undef ATT_STOREV
#undef ATT_QK
}


constexpr int SLD = 65, SHLD = 72, XTLD = 132;
__device__ __forceinline__ int rm32(int t, int h) { return (t & 3) + 8 * (t >> 2) + 4 * h; }
template <bool WITH_Y>
__device__ __forceinline__ void ssd_block(int b, int dir, int k, int hp, const bf16_t* xbc, const float* dtp, const float* alog, float* hs, float* alast, bf16_t* yd, float* lds, int tid) {
    const bool lat = k >= 2; const int c = lat ? (dir ? 33 - k : k - 2) : (dir ? 1 - k : k);
    const int row0 = tok_row(lat, b, c * 128), g = hp >> 1;
    float* sB = lds; bf16_t* sBh = (bf16_t*)lds; bf16_t* sCh = sBh + 128 * SHLD;
    float* sX = WITH_Y ? lds + (2 * 128 * SHLD * 2) / 4 : sB + 128 * SLD; bf16_t* sXT = (bf16_t*)sX;
    float* sDT = sX + 128 * 128; float* sCum = sDT + 256; float* sW = sCum + 256; float* sSc = sW + 256;
    const int wave = tid >> 6, lane = tid & 63, r = lane & 31, h = lane >> 5, hl = wave >> 2, head = 2 * hp + hl;
    float* hsp = hs + (((size_t)(b * 2 + dir) * NCH + k) * 8 + head) * 4096;
    union { bf16x8 v; unsigned u[4]; } hfrag[WITH_Y ? 8 : 1];
    if (WITH_Y) {
#pragma unroll
        for (int Pb = 0; Pb < 2; ++Pb)
#pragma unroll
            for (int ks = 0; ks < 4; ++ks) { const float4 x0 = *(const float4*)(hsp + (32 * Pb + r) * 64 + 16 * ks + 8 * h), x1 = *(const float4*)(hsp + (32 * Pb + r) * 64 + 16 * ks + 8 * h + 4);
                hfrag[Pb * 4 + ks].u[0] = pk2(x0.x, x0.y); hfrag[Pb * 4 + ks].u[1] = pk2(x0.z, x0.w); hfrag[Pb * 4 + ks].u[2] = pk2(x1.x, x1.y); hfrag[Pb * 4 + ks].u[3] = pk2(x1.z, x1.w); }
    }
    uint2 vb[8]; float4 vx[8]; float dx[8]; float dtv = 0.f, dav = 0.f;
#pragma unroll
    for (int u = 0; u < 8; ++u) { const int i = tid + u * NTHREADS, t = i >> 5, c4 = i & 31;
        vb[u] = *(const uint2*)(xbc + (size_t)(row0 + t) * 768 + 512 + (c4 >> 4) * 128 + g * 64 + (c4 & 15) * 4);
        vx[u] = ld4h(xbc + (size_t)(row0 + t) * 768 + hp * 128 + c4 * 4);
        dx[u] = dtp[(size_t)(row0 + t) * 16 + dir * 8 + 2 * hp + (c4 >> 4)]; }
    if (tid < 256) { const int hl = tid >> 7, t = tid & 127, h = 2 * hp + hl; dtv = dtp[(size_t)(row0 + t) * 16 + dir * 8 + h]; dav = dtv * -expf(alog[dir * 8 + h]); }
    __syncthreads();
#pragma unroll
    for (int u = 0; u < 8; ++u) { const int i = tid + u * NTHREADS, t = i >> 5, c4 = i & 31;
        if (WITH_Y) *(uint2*)((c4 >> 4 ? sCh : sBh) + t * SHLD + (c4 & 15) * 4) = vb[u];
        else if (!(c4 >> 4)) { const float4 f = up4(vb[u]); float* d = sB + t * SLD + (c4 & 15) * 4; d[0] = f.x; d[1] = f.y; d[2] = f.z; d[3] = f.w; }
        if (WITH_Y) { const float4 xs = f4scale(vx[u], dx[u]); sXT[(c4 * 4 + 0) * XTLD + t] = (bf16_t)(pk2(xs.x, 0.f)); sXT[(c4 * 4 + 1) * XTLD + t] = (bf16_t)(pk2(xs.y, 0.f)); sXT[(c4 * 4 + 2) * XTLD + t] = (bf16_t)(pk2(xs.z, 0.f)); sXT[(c4 * 4 + 3) * XTLD + t] = (bf16_t)(pk2(xs.w, 0.f)); }
        else *(float4*)(sX + t * 128 + c4 * 4) = f4scale(vx[u], dx[u]); }
    if (tid < 256) { const int t = tid & 127; sSc[(tid & 128) + (dir ? 127 - t : t)] = dav; }
    __syncthreads();
    for (int off = 1; off < 128; off <<= 1) { float v = 0.f; const int sI = tid & 127;
        if (tid < 256) { v = sSc[tid]; if (sI >= off) v += sSc[tid - off]; }
        __syncthreads(); if (tid < 256) sSc[tid] = v; __syncthreads(); }
    if (tid < 256) { const int hl = tid >> 7, sI = tid & 127, t = dir ? 127 - sI : sI; const float cu = sSc[tid], tot = sSc[hl * 128 + 127];
        sCum[hl * 128 + t] = cu; sW[hl * 128 + t] = expf(tot - cu);
        if (!WITH_Y && sI == 127) alast[((size_t)(b * 2 + dir) * NCH + k) * 8 + 2 * hp + hl] = tot; }
    __syncthreads();
    if (WITH_Y) {
        const int I = hl ? 3 - (wave & 3) : (wave & 3), ti = 32 * I + r;
        const float cum_i = sCum[hl * 128 + ti];
        f32x16 Y[2], Yo[2];
#pragma unroll
        for (int i = 0; i < 16; ++i) { Y[0][i] = 0.f; Y[1][i] = 0.f; Yo[0][i] = 0.f; Yo[1][i] = 0.f; }
        bf16x8 cfrag[4];
#pragma unroll
        for (int ks = 0; ks < 4; ++ks) cfrag[ks] = *(const bf16x8*)(sCh + (32 * I + r) * SHLD + 16 * ks + 8 * h);
#pragma unroll
        for (int Pb = 0; Pb < 2; ++Pb)
#pragma unroll
            for (int ks = 0; ks < 4; ++ks) Yo[Pb] = __builtin_amdgcn_mfma_f32_32x32x16_bf16(hfrag[Pb * 4 + ks].v, cfrag[ks], Yo[Pb], 0, 0, 0);
        const int J0 = dir ? I : 0, J1 = dir ? 3 : I;
        for (int J = J0; J <= J1; ++J) {
            f32x16 Gt;
#pragma unroll
            for (int i = 0; i < 16; ++i) Gt[i] = 0.f;
#pragma unroll
            for (int ks = 0; ks < 4; ++ks) Gt = __builtin_amdgcn_mfma_f32_32x32x16_bf16(*(const bf16x8*)(sBh + (32 * J + r) * SHLD + 16 * ks + 8 * h), cfrag[ks], Gt, 0, 0, 0);
#pragma unroll
            for (int t = 0; t < 16; ++t) { const int tj = 32 * J + rm32(t, h); const bool valid = (J != I) || (dir ? tj >= ti : tj <= ti);
                Gt[t] *= valid ? __expf(cum_i - sCum[hl * 128 + tj]) : 0.f; }
#pragma unroll
            for (int s2 = 0; s2 < 2; ++s2) {
                union { bf16x8 v; unsigned u[4]; } pf;
#pragma unroll
                for (int i = 0; i < 4; ++i) pf.u[i] = pk2(Gt[8 * s2 + 2 * i], Gt[8 * s2 + 2 * i + 1]);
#pragma unroll
                for (int Pb = 0; Pb < 2; ++Pb) {
                    const bf16_t* xp = sXT + (hl * 64 + 32 * Pb + r) * XTLD + 32 * J + 16 * s2 + 4 * h;
                    union { bf16x8 v; uint2 u[2]; } af; af.u[0] = *(const uint2*)xp; af.u[1] = *(const uint2*)(xp + 8);
                    Y[Pb] = __builtin_amdgcn_mfma_f32_32x32x16_bf16(af.v, pf.v, Y[Pb], 0, 0, 0);
                }
            }
        }
        const float ei = __expf(cum_i);
        bf16_t* yrow = yd + ((size_t)dir * NTOK + row0 + ti) * 512 + head * 64;
#pragma unroll
        for (int Pb = 0; Pb < 2; ++Pb)
#pragma unroll
            for (int tq = 0; tq < 4; ++tq)
                *(uint2*)(yrow + 32 * Pb + 8 * tq + 4 * h) = pk4(make_float4(Y[Pb][4 * tq] + ei * Yo[Pb][4 * tq], Y[Pb][4 * tq + 1] + ei * Yo[Pb][4 * tq + 1], Y[Pb][4 * tq + 2] + ei * Yo[Pb][4 * tq + 2], Y[Pb][4 * tq + 3] + ei * Yo[Pb][4 * tq + 3]));
    } else {
        const int Pb = (wave >> 1) & 1, Nb = wave & 1;
        f32x16 acc;
#pragma unroll
        for (int i = 0; i < 16; ++i) acc[i] = 0.f;
#pragma unroll 8
        for (int ks = 0; ks < 64; ++ks) { const int j = 2 * ks + h;
            acc = __builtin_amdgcn_mfma_f32_32x32x2f32(sX[j * 128 + hl * 64 + 32 * Pb + r] * sW[hl * 128 + j], sB[j * SLD + 32 * Nb + r], acc, 0, 0, 0); }
#pragma unroll
        for (int t = 0; t < 16; ++t) hsp[(32 * Pb + rm32(t, h)) * 64 + 32 * Nb + r] = acc[t];
    }
}

template <class RM>
__device__ __forceinline__ void cvt_tile(const float* src, int N, bf16_t* dst, int ldd, RM rowmap, int k0, int n0, int lane) {
    const int n = n0 + lane;
    if (n < N) {
        const float* sp = src + (size_t)k0 * N + n;
        float v[32];
#pragma unroll
        for (int kk = 0; kk < 32; ++kk) v[kk] = sp[(size_t)kk * N];
        uint4* dp = (uint4*)(dst + (size_t)rowmap(n) * ldd + k0);
#pragma unroll
        for (int i = 0; i < 4; ++i) dp[i] = make_uint4(pk2(v[8 * i], v[8 * i + 1]), pk2(v[8 * i + 2], v[8 * i + 3]), pk2(v[8 * i + 4], v[8 * i + 5]), pk2(v[8 * i + 6], v[8 * i + 7]));
    }
}
__device__ __forceinline__ int block_excl_scan(int v, int tid, volatile int* sh, int& total) {
    const int lane = tid & 63, wave = tid >> 6; int x = v;
    x += __builtin_amdgcn_update_dpp(0, x, 0x111, 0xf, 0xf, true); x += __builtin_amdgcn_update_dpp(0, x, 0x112, 0xf, 0xf, true);
    x += __builtin_amdgcn_update_dpp(0, x, 0x114, 0xf, 0xf, true); x += __builtin_amdgcn_update_dpp(0, x, 0x118, 0xf, 0xf, true);
    x += __builtin_amdgcn_update_dpp(0, x, 0x142, 0xa, 0xf, false); x += __builtin_amdgcn_update_dpp(0, x, 0x143, 0xc, 0xf, false);
    __syncthreads();
    if (lane == 63) sh[wave] = x;
    __syncthreads();
    int off = 0, tot = 0;
#pragma unroll
    for (int w = 0; w < 8; ++w) { const int c = sh[w]; tot += c; if (w < wave) off += c; }
    total = tot;
    return off + x - v;
}
__device__ __forceinline__ int block_sum(int v, int tid, volatile int* sh, int parity) {
    const int lane = tid & 63, wave = tid >> 6;
    v += __builtin_amdgcn_update_dpp(0, v, 0x111, 0xf, 0xf, true); v += __builtin_amdgcn_update_dpp(0, v, 0x112, 0xf, 0xf, true);
    v += __builtin_amdgcn_update_dpp(0, v, 0x114, 0xf, 0xf, true); v += __builtin_amdgcn_update_dpp(0, v, 0x118, 0xf, 0xf, true);
    v += __builtin_amdgcn_update_dpp(0, v, 0x142, 0xa, 0xf, false); v += __builtin_amdgcn_update_dpp(0, v, 0x143, 0xc, 0xf, false);
    if (lane == 63) sh[parity * 8 + wave] = v;
    __syncthreads();
    int tot = 0;
#pragma unroll
    for (int w = 0; w < 8; ++w) tot += sh[parity * 8 + w];
    return tot;
}

#define MOD ((float*)(kp_->ws + WS_MOD))
#define CTXC ((float*)(kp_->ws + WS_CTXC))
#define AFF ((float*)(kp_->ws + WS_AFF))
#define TOKSLOT ((int*)(kp_->ws + WS_TOKSLOT))
#define SELIDX ((int*)(kp_->ws + WS_SELIDX))
#define SELGATE ((float*)(kp_->ws + WS_SELGATE))
#define DT ((float*)(kp_->ws + WS_DT))
#define HB ((bf16_t*)(kp_->ws + WS_HB))
#define HS ((float*)(kp_->ws + WS_HS))
#define YD ((bf16_t*)(kp_->ws + WS_YD))
#define ALAST ((float*)(kp_->ws + WS_ALAST))
#define ROPE ((float*)(kp_->ws + WS_ROPE))
#define PB ((bf16_t*)(kp_->ws + WS_P))
#define XBC ((bf16_t*)(kp_->ws + WS_XBC))
#define MQ ((bf16_t*)(kp_->ws + WS_MQ))
#define MKV ((bf16_t*)(kp_->ws + WS_MKV))
#define CQB ((bf16_t*)(kp_->ws + WS_CQB))
#define CKVB ((bf16_t*)(kp_->ws + WS_CKVB))
#define MIXB ((bf16_t*)(kp_->ws + WS_MIXB))
#define MOUT ((bf16_t*)(kp_->ws + WS_MOUT))
#define XG ((bf16_t*)(kp_->ws + WS_XG))
#define HID ((bf16_t*)(kp_->ws + WS_HID))
#define Y ((bf16_t*)(kp_->ws + WS_Y))
#define WIN_T ((bf16_t*)(kp_->ws + WS_WIN))
#define WQ_T ((bf16_t*)(kp_->ws + WS_WQ))
#define WKV_T ((bf16_t*)(kp_->ws + WS_WKV))
#define WOUT_T ((bf16_t*)(kp_->ws + WS_WOUT))
#define WGU_T ((bf16_t*)(kp_->ws + WS_WGU))
#define WD_T ((bf16_t*)(kp_->ws + WS_WD))
#define QD ((bf16_t*)(kp_->ws + WS_QD))
#define QDC ((bf16_t*)(kp_->ws + WS_QDC))
#define KD ((bf16_t*)(kp_->ws + WS_KD))
#define VDT ((bf16_t*)(kp_->ws + WS_VDT))
#define QM ((bf16_t*)(kp_->ws + WS_QM))
#define QMC ((bf16_t*)(kp_->ws + WS_QMC))
#define KM ((bf16_t*)(kp_->ws + WS_KM))
#define VMT ((bf16_t*)(kp_->ws + WS_VMT))
#define xcur (kp_->out)
#define XSRC (l == 0 ? kp_->in[I_X] : (const float*)kp_->out)
#define CSRC (l == 0 ? kp_->in[I_CTX] : (const float*)CTXC)
#define DTMP XBC
#define modl (MOD + (size_t)l * (NB + 1) * NMOD * D)
typedef const __attribute__((address_space(4))) Prm* KPrm;
#define PHASE_BEGIN() KPrm kp_ = (KPrm)__builtin_amdgcn_kernarg_segment_ptr(); asm volatile("" : "+s"(kp_)); int tid = MK_TID(); asm volatile("" : "+v"(tid)); (void)tid
#define GSYNC() do { XcdBarrier b_; b_.bar = (unsigned*)(kp_->ws + WS_CTL); b_.x = xb_xcc_id(); b_.st = (volatile LAS unsigned*)(ldsb + LDS_BYTES - 64); int t_ = MK_TID(); asm volatile("" : "+v"(t_)); xcd_barrier(b_, t_); } while (0)
#define CVT_MOE_RANGE(LW, ID0, ID1, SLOT, NSLOTS) do { const int lane_ = tid & 63; \
        for (int id = (ID0) + (SLOT); id < (ID1); id += (NSLOTS)) { \
            const int mat = id >> 9, tl = id & 511, e = mat / 3, which = mat % 3, k0 = (tl >> 4) * 32, n0 = (tl & 15) * 64; \
            if (which == 0) cvt_tile(kp_->in[I_WG] + ((size_t)(LW) * NE + e) * D * FF, FF, WGU_T + (size_t)e * 2 * FF * D, D, [](int n) { return (n >> 2) * 8 + (n & 3); }, k0, n0, lane_); \
            else if (which == 1) cvt_tile(kp_->in[I_WU] + ((size_t)(LW) * NE + e) * D * FF, FF, WGU_T + (size_t)e * 2 * FF * D, D, [](int n) { return (n >> 2) * 8 + 4 + (n & 3); }, k0, n0, lane_); \
            else cvt_tile(kp_->in[I_WD] + ((size_t)(LW) * NE + e) * FF * D, D, WD_T + (size_t)e * D * FF, FF, [](int n) { return n; }, k0, n0, lane_); } } while (0)
constexpr int CVT_PER_WAVE = 4;
__global__ void __launch_bounds__(NTHREADS, 2) mk_forward(Prm p) {
    extern __shared__ __attribute__((aligned(16))) unsigned char lds_raw[];
    LAS unsigned char* const ldsb = (LAS unsigned char*)lds_raw;
    volatile LAS unsigned* st = (volatile LAS unsigned*)(ldsb + LDS_BYTES - 64);
    const int wave_s = __builtin_amdgcn_readfirstlane((int)threadIdx.x >> 6);
#define MK_TID() mk_tid_impl(wave_s)
    if (MK_TID() < 16) st[MK_TID()] = 0u;
    __syncthreads();
    (void)xcd_barrier_post((unsigned*)(p.ws + WS_CTL), st, MK_TID());
    const int G = gridDim.x, bid = blockIdx.x;
    const int vcu = (G % 8 == 0) ? (bid % 8) * (G / 8) + bid / 8 : bid;

    {
        PHASE_BEGIN();
        const float* c = kp_->in[I_C]; const float* cc = kp_->in[I_CCTX]; const float* adaw = kp_->in[I_ADAW]; const float* adab = kp_->in[I_ADAB];
        float* sc_l = (float*)lds_raw;
        for (int i = tid; i < (NB + 1) * D; i += NTHREADS) { const int r = i / D, k = i % D; sc_l[i] = siluf(r < NB ? c[(size_t)r * D + k] : cc[k]); }
        __syncthreads();
        {
            float* red = sc_l + (NB + 1) * D;
            const int lane = tid & 63, wv = tid >> 6;
            for (int it = bid; it < DEPTH * (NMOD * D / 64); it += G) {
                const int l = it / (NMOD * D / 64), j = (it % (NMOD * D / 64)) * 64 + lane;
                const float* w = adaw + ((size_t)l * D + wv * 128) * NMOD * D + j;
                float a0 = 0.f, a1 = 0.f, a2 = 0.f, a3 = 0.f, a4 = 0.f;
#pragma unroll 8
                for (int k = 0; k < 128; ++k) { const float wk = w[(size_t)k * NMOD * D]; const int kk = wv * 128 + k;
                    a0 += sc_l[kk] * wk; a1 += sc_l[D + kk] * wk; a2 += sc_l[2 * D + kk] * wk; a3 += sc_l[3 * D + kk] * wk; a4 += sc_l[4 * D + kk] * wk; }
                __syncthreads();
                red[(wv * 5 + 0) * 64 + lane] = a0; red[(wv * 5 + 1) * 64 + lane] = a1; red[(wv * 5 + 2) * 64 + lane] = a2; red[(wv * 5 + 3) * 64 + lane] = a3; red[(wv * 5 + 4) * 64 + lane] = a4;
                __syncthreads();
                if (tid < 5 * 64) { const int r = tid >> 6; float acc = adab[l * NMOD * D + j - lane + (tid & 63)];
#pragma unroll
                    for (int q = 0; q < 8; ++q) acc += red[(q * 5 + r) * 64 + (tid & 63)];
                    MOD[((size_t)l * (NB + 1) + r) * NMOD * D + (j - lane) + (tid & 63)] = acc; }
            }
        }
        ITEMS(i, S * 16) {
            const int t = i >> 4, w = i & 15, ii = w & 7; const float pos = (float)(w < 8 ? t / GRID_W : t % GRID_W);
            const float ang = pos * powf(10000.0f, -(float)ii / 8.0f);
            ROPE[(size_t)t * 32 + (w < 8 ? 0 : 16) + ii] = cosf(ang); ROPE[(size_t)t * 32 + (w < 8 ? 8 : 24) + ii] = sinf(ang);
        }
        GSYNC();
    }

#pragma unroll 1
    for (int l = 0; l < DEPTH; ++l) {
        const bool ctx_out = l < DEPTH - 1;
        const float lambda_init = 0.8f - 0.6f * expf(-0.3f * (float)l);
        const int nrows_out = ctx_out ? NTOK : NLAT;
        const int ER = ctx_out ? ER_MAX : NB * CAP_L;
        int moe_done = 0;

        {
            PHASE_BEGIN();
            {
                const int lane = tid & 63; auto idm = [](int n) { return n; };
                constexpr int T_WIN = (D / 32) * ((IN_COLS + 63) / 64), T_WQ = (192 / 32) * (384 / 64), T_WKV = (128 / 32) * (512 / 64), T_WOUT = (MIXW / 32) * (D / 64);
                WITEMS(id, T_WIN + T_WQ + T_WKV + T_WOUT) {
                    if (id < T_WIN) { const int nt = (IN_COLS + 63) / 64; cvt_tile(kp_->in[I_WIN] + (size_t)l * D * IN_COLS, IN_COLS, WIN_T, D, idm, (id / nt) * 32, (id % nt) * 64, lane); }
                    else if (id < T_WIN + T_WQ) { const int u = id - T_WIN; cvt_tile(kp_->in[I_WQUP] + (size_t)l * 192 * 384, 384, WQ_T, 256, idm, (u / 6) * 32, (u % 6) * 64, lane); }
                    else if (id < T_WIN + T_WQ + T_WKV) { const int u = id - T_WIN - T_WQ; cvt_tile(kp_->in[I_WKVUP] + (size_t)l * 128 * 512, 512, WKV_T, 128, idm, (u / 8) * 32, (u % 8) * 64, lane); }
                    else { const int u = id - T_WIN - T_WQ - T_WKV; cvt_tile(kp_->in[I_WOUT] + (size_t)l * MIXW * D, D, WOUT_T, MIXW, idm, (u / 16) * 32, (u % 16) * 64, lane); }
                }
            }
            { const unsigned zz_ = (unsigned)tid >> 20; const uint4 z4_ = make_uint4(zz_, zz_, zz_, zz_);
            ITEMS(i, (IN_PAD - IN_COLS) * D / 8) ((uint4*)(WIN_T + (size_t)IN_COLS * D))[i] = z4_;
            ITEMS(i, 128 * 256 / 8) ((uint4*)(WQ_T + (size_t)384 * 256))[i] = z4_;
            ITEMS(i, 384 * 8) { const int r = i >> 3, c8 = i & 7; *(uint4*)(WQ_T + (size_t)r * 256 + 192 + c8 * 8) = z4_; } }

            const float* w = kp_->in[I_NMPRE] + l * D;
            const int lane = tid & 63;
            {
                float4 xq[4];
                { const float zf_ = (float)(tid >> 20);
#pragma unroll
                  for (int i = 0; i < 4; ++i) xq[i] = make_float4(zf_, zf_, zf_, zf_); }
                float4* aux = (float4*)lds_raw;
                __syncthreads();
                for (int i = tid; i < 11 * (D / 4); i += NTHREADS) { const int v = i / (D / 4), k4 = i % (D / 4);
                    const float* src = v == 0 ? w : modl + (size_t)((v - 1) % 5) * NMOD * D + ((v - 1) / 5) * D;
                    aux[i] = ((const float4*)src)[k4]; }
                __syncthreads();
                const int wstride = gridDim.x * 8; int r = blockIdx.x * 8 + (tid >> 6);
#define P1_LOAD(rr) do { const float4* src_ = (const float4*)((rr) < NLAT ? XSRC + (size_t)(rr) * D : CSRC + (size_t)((rr) - NLAT) * D); _Pragma("unroll") for (int i = 0; i < 4; ++i) xq[i] = src_[i * 64 + lane]; } while (0)
                if (r < NTOK) P1_LOAD(r);
                for (; r < NTOK; r += wstride) {
                    const int bsel = r < NLAT ? r / S : NB;
                    float4 v[4]; float ss = 0.f;
#pragma unroll
                    for (int i = 0; i < 4; ++i) { v[i] = xq[i]; ss += f4dot(v[i], v[i]); }
                    if (r + wstride < NTOK) P1_LOAD(r + wstride);
                    ss = wave_sum(ss);
                    const float rs = 1.0f / sqrtf(ss / D + EPS);
#pragma unroll
                    for (int i = 0; i < 4; ++i) { const int k4 = i * 64 + lane; const float4 w4 = aux[k4], sc = aux[(6 + bsel) * (D / 4) + k4], sh = aux[(1 + bsel) * (D / 4) + k4];
                        const float4 o = make_float4(v[i].x * rs * w4.x * (1.0f + sc.x) + sh.x, v[i].y * rs * w4.y * (1.0f + sc.y) + sh.y, v[i].z * rs * w4.z * (1.0f + sc.z) + sh.z, v[i].w * rs * w4.w * (1.0f + sc.w) + sh.w);
                        *(uint2*)(HB + (size_t)r * D + k4 * 4) = pk4(o); }
                }
#undef P1_LOAD
            }
            GSYNC();
        }
        {
            PHASE_BEGIN();
            pg8::Gemm g{HB, WIN_T, NTOK, IN_PAD, D, 0, 0}; pg8::StaticOrder so; so.init(NTOK, IN_PAD, G, bid);
            pg8::EpiBf16 E{PB, IN_COLS, IN_COLS};
            pg8::gemm_phase<pg8::EpiBf16, pg8::StaticOrder, true, true>(ldsb, g, so, E, tid);
            { const int nwg = (NTOK / 256) * (IN_PAD / 256), busy = nwg % G;
              if (busy != 0 && bid >= busy) CVT_MOE_RANGE(l, 0, (G - busy) * 8 * CVT_PER_WAVE, (bid - busy) * 8 + (tid >> 6), (G - busy) * 8);
              moe_done = busy != 0 ? (G - busy) * 8 * CVT_PER_WAVE : 0; }
            GSYNC();
        }
        {
            PHASE_BEGIN();
            const float* cw = kp_->in[I_CONVW] + (size_t)l * 3 * 768; const float* cb = kp_->in[I_CONVB] + (size_t)l * 768;
            {
                float* cwl = (float*)lds_raw;
                __syncthreads();
                for (int i = tid; i < 4 * 768; i += NTHREADS) cwl[i] = i < 3 * 768 ? cw[i] : cb[i - 3 * 768];
                __syncthreads();
                const int stride = gridDim.x * NTHREADS;
                for (int i0 = blockIdx.x * NTHREADS + tid; i0 < NTOK * 192; i0 += 4 * stride) {
                    uint2 u0[4], um[4], up[4];
#pragma unroll
                    for (int q = 0; q < 4; ++q) { const int i = i0 + q * stride; const unsigned z_ = (unsigned)tid >> 20; u0[q] = make_uint2(z_, z_); um[q] = u0[q]; up[q] = u0[q];
                        if (i < NTOK * 192) { const int c = (i % 192) * 4, r = i / 192; const bool lat = r < NLAT; const int L = lat ? S : CTX; const int t = lat ? r % S : (r - NLAT) % CTX;
                            const bf16_t* u = PB + (size_t)r * IN_COLS + C_XBC + c; u0[q] = *(const uint2*)u; if (t > 0) um[q] = *(const uint2*)(u - IN_COLS); if (t < L - 1) up[q] = *(const uint2*)(u + IN_COLS); } }
#pragma unroll
                    for (int q = 0; q < 4; ++q) { const int i = i0 + q * stride;
                        if (i < NTOK * 192) { const int c = (i % 192) * 4, r = i / 192;
                            float4 acc = f4add(*(const float4*)(cwl + 3 * 768 + c), f4mul(*(const float4*)(cwl + 768 + c), up4(u0[q])));
                            acc = f4add(acc, f4mul(*(const float4*)(cwl + c), up4(um[q]))); acc = f4add(acc, f4mul(*(const float4*)(cwl + 2 * 768 + c), up4(up[q])));
                            *(uint2*)(XBC + (size_t)r * 768 + c) = pk4(make_float4(siluf(acc.x), siluf(acc.y), siluf(acc.z), siluf(acc.w))); } }
                }
            }
            const float* dtb = kp_->in[I_DTB] + l * 16;
            ITEMS(i, NTOK * 16) { const int j = i % 16, r = i / 16; DT[i] = softplusf(bf2f(PB[(size_t)r * IN_COLS + C_DT + j]) + dtb[j]); }
            ITEMS(i, NTOK * 16) {
                const int g = i & 15, r = i >> 4; const int hm = g & 7, isk = g >> 3;
                const bool lat = r < NLAT; const int b = lat ? r / S : (r - NLAT) / CTX, t = lat ? r % S : (r - NLAT) % CTX;
                if (!isk && !lat && !ctx_out) continue;
                const bf16_t* vp = PB + (size_t)r * IN_COLS + (isk ? C_DK : C_DQ) + hm * 32;
                float v[32];
#pragma unroll
                for (int k = 0; k < 32; k += 4) { const float4 x = ld4h(vp + k); v[k] = x.x; v[k + 1] = x.y; v[k + 2] = x.z; v[k + 3] = x.w; }
                if (lat) rope32(v, t, ROPE);
                const float sc = isk ? 1.0f : 0.17677669529663687f * 1.4426950408889634f;
                bf16_t* dst = isk ? KD + ((size_t)(b * 8 + hm) * SK + (lat ? CTX + t : t)) * 32 : (lat ? QD + ((size_t)(b * 8 + hm) * S + t) * 32 : QDC + ((size_t)(b * 8 + hm) * CTX + t) * 32);
#pragma unroll
                for (int k = 0; k < 32; k += 8) *(uint4*)(dst + k) = make_uint4(pk2(v[k] * sc, v[k + 1] * sc), pk2(v[k + 2] * sc, v[k + 3] * sc), pk2(v[k + 4] * sc, v[k + 5] * sc), pk2(v[k + 6] * sc, v[k + 7] * sc));
            }
            ITEMS(i, NB * 4 * (SK / 8) * 64) {
                const int d = i & 63, j8 = (i >> 6) % (SK / 8), hh = (i / (64 * (SK / 8))) & 3, b = i / (256 * (SK / 8));
                const int r0 = j8 * 8 < CTX ? tok_row(false, b, j8 * 8) : tok_row(true, b, j8 * 8 - CTX);
                const bf16_t* sp = PB + (size_t)r0 * IN_COLS + C_DV + hh * 64 + d;
                unsigned v[8];
#pragma unroll
                for (int jj = 0; jj < 8; ++jj) v[jj] = sp[(size_t)jj * IN_COLS];
                *(uint4*)(VDT + ((size_t)(b * 4 + hh) * 64 + d) * SK + j8 * 8) = make_uint4(v[0] | (v[1] << 16), v[2] | (v[3] << 16), v[4] | (v[5] << 16), v[6] | (v[7] << 16));
            }
            const float* qn = kp_->in[I_QNORM] + l * 192; const float* kvn = kp_->in[I_KVNORM] + l * 128;
            { const int lane = tid & 63;
            uint2 xq = make_uint2((unsigned)tid >> 20, (unsigned)tid >> 20);
            const float4 wq4 = lane < 48 ? ((const float4*)qn)[lane] : make_float4(0.f, 0.f, 0.f, 0.f), wkv4 = lane < 32 ? ((const float4*)kvn)[lane] : make_float4(0.f, 0.f, 0.f, 0.f);
            const int wstride = gridDim.x * 8; int i = blockIdx.x * 8 + (tid >> 6);
#define NRM_LOAD(ii) do { const int wh_ = (ii) & 1, r_ = (ii) >> 1; if (lane < (wh_ ? 32 : 48)) xq = *(const uint2*)(PB + (size_t)r_ * IN_COLS + (wh_ ? C_CKV : C_CQ) + lane * 4); } while (0)
            if (i < NTOK * 2) NRM_LOAD(i);
            for (; i < NTOK * 2; i += wstride) {
                const int which = i & 1, r = i >> 1; const int n4 = which ? 32 : 48;
                float4 x = make_float4(0.f, 0.f, 0.f, 0.f); if (lane < n4) x = up4(xq);
                if (i + wstride < NTOK * 2) NRM_LOAD(i + wstride);
                const float ss = wave_sum(f4dot(x, x));
                const float rs = 1.0f / sqrtf(ss / (n4 * 4) + EPS);
                bf16_t* dst = which ? CKVB + (size_t)r * 128 : CQB + (size_t)r * 256;
                if (lane < n4) *(uint2*)(dst + lane * 4) = pk4(f4scale(f4mul(x, which ? wkv4 : wq4), rs));
                else if (!which) { const unsigned z_ = (unsigned)tid >> 20; *(uint2*)(dst + lane * 4) = make_uint2(z_, z_); }
            }
#undef NRM_LOAD
            }
            GSYNC();
        }
        {
            PHASE_BEGIN();
            const int half = (G * 5) / 8;
            if (bid < half) {
                pg8::Gemm g{CQB, WQ_T, NTOK, 512, 256, 0, 0}; pg8::StaticOrder so; so.init(NTOK, 512, half, bid);
                pg8::EpiBf16 E{MQ, 384, 384};
                pg8::gemm_phase<pg8::EpiBf16, pg8::StaticOrder, true, true>(ldsb, g, so, E, tid);
            } else {
                pg8::Gemm g{CKVB, WKV_T, NTOK, 512, 128, 0, 0}; pg8::StaticOrder so; so.init(NTOK, 512, G - half, bid - half);
                pg8::EpiBf16 E{MKV, 512, 512};
                pg8::gemm_phase<pg8::EpiBf16, pg8::StaticOrder, true, true>(ldsb, g, so, E, tid);
            }
            for (int it = vcu; it < NB * NCH * 8; it += G) {
                const int hp = it & 3, dir = (it >> 2) & 1, cp = (it >> 3) % NCH, b = it / (8 * NCH);
                const int k = dir ? (cp < 2 ? 1 - cp : 35 - cp) : cp;
                if (k == NCH - 1) continue;
                ssd_block<false>(b, dir, k, hp, XBC, DT, kp_->in[I_ALOG] + l * 16, HS, ALAST, nullptr, (float*)lds_raw, tid);
            }
            GSYNC();
        }
        {
            PHASE_BEGIN();
            ITEMS(i, NTOK * 8) {
                const int g = i & 7, r = i >> 3; const int hh = g & 3, isk = g >> 2;
                const bool lat = r < NLAT; const int b = lat ? r / S : (r - NLAT) / CTX, t = lat ? r % S : (r - NLAT) % CTX;
                if (!isk && !lat && !ctx_out) continue;
                const bf16_t* npb = isk ? MKV + (size_t)r * 512 + hh * 128 : MQ + (size_t)r * 384 + hh * 96;
                const bf16_t* rp = isk ? PB + (size_t)r * IN_COLS + C_KR : npb + 64;
                float v[32], np[64];
#pragma unroll
                for (int k = 0; k < 32; k += 4) { const float4 x = ld4h(rp + k); v[k] = x.x; v[k + 1] = x.y; v[k + 2] = x.z; v[k + 3] = x.w; }
#pragma unroll
                for (int k = 0; k < 64; k += 4) { const float4 x = ld4h(npb + k); np[k] = x.x; np[k + 1] = x.y; np[k + 2] = x.z; np[k + 3] = x.w; }
                if (lat) rope32(v, t, ROPE);
                const float sc = isk ? 1.0f : 0.10206207261596575f * 1.4426950408889634f;
                bf16_t* dst = isk ? KM + ((size_t)(b * 4 + hh) * SK + (lat ? CTX + t : t)) * 96 : (lat ? QM + ((size_t)(b * 4 + hh) * S + t) * 96 : QMC + ((size_t)(b * 4 + hh) * CTX + t) * 96);
#pragma unroll
                for (int k = 0; k < 64; k += 8) *(uint4*)(dst + k) = make_uint4(pk2(np[k] * sc, np[k + 1] * sc), pk2(np[k + 2] * sc, np[k + 3] * sc), pk2(np[k + 4] * sc, np[k + 5] * sc), pk2(np[k + 6] * sc, np[k + 7] * sc));
#pragma unroll
                for (int k = 0; k < 32; k += 8) *(uint4*)(dst + 64 + k) = make_uint4(pk2(v[k] * sc, v[k + 1] * sc), pk2(v[k + 2] * sc, v[k + 3] * sc), pk2(v[k + 4] * sc, v[k + 5] * sc), pk2(v[k + 6] * sc, v[k + 7] * sc));
            }
            ITEMS(i, NB * 4 * (SK / 8) * 64) {
                const int d = i & 63, j8 = (i >> 6) % (SK / 8), hh = (i / (64 * (SK / 8))) & 3, b = i / (256 * (SK / 8));
                const int r0 = j8 * 8 < CTX ? tok_row(false, b, j8 * 8) : tok_row(true, b, j8 * 8 - CTX);
                const bf16_t* sp = MKV + (size_t)r0 * 512 + hh * 128 + 64 + d;
                unsigned v[8];
#pragma unroll
                for (int jj = 0; jj < 8; ++jj) v[jj] = sp[(size_t)jj * 512];
                *(uint4*)(VMT + ((size_t)(b * 4 + hh) * 64 + d) * SK + j8 * 8) = make_uint4(v[0] | (v[1] << 16), v[2] | (v[3] << 16), v[4] | (v[5] << 16), v[6] | (v[7] << 16));
            }
            ITEMS(i, NB * 2 * 8 * 4096) {
                const int e = i & 4095, h = (i >> 12) & 7, bd = i >> 15;
                float* hp0 = HS + ((size_t)bd * NCH * 8 + h) * 4096 + e; const float* al0 = ALAST + (size_t)bd * NCH * 8 + h;
                float sv[NCH - 1], dk[NCH - 1];
#pragma unroll
                for (int k = 0; k < NCH - 1; ++k) { sv[k] = hp0[(size_t)k * 8 * 4096]; dk[k] = al0[k * 8]; }
                float Hc = 0.f;
#pragma unroll
                for (int k = 0; k < NCH; ++k) { hp0[(size_t)k * 8 * 4096] = Hc; if (k < NCH - 1) Hc = Hc * __expf(dk[k]) + sv[k]; }
            }
            GSYNC();
        }
        {
            PHASE_BEGIN();
            for (int kq = 0; kq * G < NB * 2 * NCH * 4; ++kq) {
                int it = vcu + kq * G;
                { const int T_ = NB * 2 * NCH * 4, full_ = (T_ / G) * G, rem_ = T_ - full_;
                  if (ctx_out && kq * G == full_) it = vcu >= G - rem_ ? full_ + vcu - (G - rem_) : T_; }
                if (it >= NB * 2 * NCH * 4) continue;
                const int hp = it & 3, dir = (it >> 2) & 1, cp = (it >> 3) % NCH, b = it / (8 * NCH);
                const int k = dir ? (cp < 2 ? 1 - cp : 35 - cp) : cp;
                if (k < 2 && !ctx_out) continue;
                ssd_block<true>(b, dir, k, hp, XBC, DT, kp_->in[I_ALOG] + l * 16, HS, ALAST, YD, (float*)lds_raw, tid);
            }
            {
                int tid = MK_TID(); asm volatile("" : "+v"(tid));
                const int lane = tid & 63, wave = tid >> 6, qr = lane & 31, hf = lane >> 5;
                const float* lq1 = kp_->in[I_LQ1] + l * 32; const float* lk1 = kp_->in[I_LK1] + l * 32; const float* lq2 = kp_->in[I_LQ2] + l * 32; const float* lk2 = kp_->in[I_LK2] + l * 32;
                const float* subw = kp_->in[I_SUBLN] + l * 64;
                const int nlat = NB * 4 * (S / 256), nit = nlat + (ctx_out ? NB * 4 : 0);
                for (int it = vcu; it < nit; it += G) {
                    const bool lat = it < nlat; const int u = lat ? it : it - nlat;
                    const int qb = lat ? u % (S / 256) : 0, hh = lat ? (u / (S / 256)) % 4 : u % 4, b = lat ? u / (4 * (S / 256)) : u / 4;
                    const int t = qb * 256 + wave * 32 + qr; const int row = tok_row(lat, b, t); const int nkt = lat ? SK / 64 : CTX / 64;
                    f32x16 oacc[2];
                    LAS v4u* const o1s = (LAS v4u*)(ldsb + 98304) + tid;
#pragma unroll 1
                    for (int mp = 0; mp < 2; ++mp) {
                        const int hm = hh * 2 + mp;
                        const bf16_t* qrow = lat ? QD + ((size_t)(b * 8 + hm) * S + t) * 32 : QDC + ((size_t)(b * 8 + hm) * CTX + t) * 32;
                        float l_run = 0.f;
#pragma unroll
                        for (int i = 0; i < 16; ++i) { oacc[0][i] = 0.f; oacc[1][i] = 0.f; }
                        const CvArgs cvp{kp_->in[I_WG] + (size_t)l * NE * D * FF, kp_->in[I_WU] + (size_t)l * NE * D * FF, kp_->in[I_WD] + (size_t)l * NE * FF * D, WGU_T, WD_T,
                                         moe_done + (((lat ? it : 0) * 8 + wave_s) * 2 + mp) * 4};
                        attn_pass<32, true>(qrow, KD + (size_t)(b * 8 + hm) * SK * 32, VDT + (size_t)(b * 4 + hh) * 64 * SK, SK, nkt, ldsb, tid, oacc, l_run, cvp);
                        l_run = xor32_sum(l_run);
                        if (mp == 0) { const float i1 = 1.0f / l_run;
#pragma unroll
                            for (int db = 0; db < 2; ++db)
#pragma unroll
                                for (int q4 = 0; q4 < 2; ++q4) o1s[(db * 2 + q4) * NTHREADS] = (v4u){pk2(oacc[db][8 * q4] * i1, oacc[db][8 * q4 + 1] * i1), pk2(oacc[db][8 * q4 + 2] * i1, oacc[db][8 * q4 + 3] * i1),
                                                                                                   pk2(oacc[db][8 * q4 + 4] * i1, oacc[db][8 * q4 + 5] * i1), pk2(oacc[db][8 * q4 + 6] * i1, oacc[db][8 * q4 + 7] * i1)}; }
                        else {
                            float d1 = 0.f, d2 = 0.f; for (int k = 0; k < 32; ++k) { d1 += lq1[k] * lk1[k]; d2 += lq2[k] * lk2[k]; }
                            const float lam = expf(d1) - expf(d2) + lambda_init;
                            const float i2 = lam / l_run; float ss = 0.f; f32x16 o1[2];
#pragma unroll
                            for (int db = 0; db < 2; ++db)
#pragma unroll
                                for (int q4 = 0; q4 < 2; ++q4) { const v4u pq = o1s[(db * 2 + q4) * NTHREADS]; const unsigned pw[4] = {pq.x, pq.y, pq.z, pq.w};
#pragma unroll
                                    for (int i2_ = 0; i2_ < 8; ++i2_) { const int i = 8 * q4 + i2_; const float a1 = __uint_as_float((i2_ & 1) ? (pw[i2_ >> 1] & 0xffff0000u) : (pw[i2_ >> 1] << 16)); const float v = a1 - oacc[db][i] * i2; o1[db][i] = v; ss += v * v; } }
                            ss = xor32_sum(ss);
                            const float rs = (1.0f - lambda_init) / sqrtf(ss / 64 + EPS);
                            bf16_t* orow = MIXB + (size_t)row * MIXW + 512 + hh * 64;
#pragma unroll
                            for (int db = 0; db < 2; ++db)
#pragma unroll
                                for (int gq = 0; gq < 4; ++gq) { const int d0 = 32 * db + 8 * gq + 4 * hf; const float4 w4 = *(const float4*)(subw + d0);
                                    *(uint2*)(orow + d0) = make_uint2(pk2(o1[db][4 * gq] * rs * w4.x, o1[db][4 * gq + 1] * rs * w4.y), pk2(o1[db][4 * gq + 2] * rs * w4.z, o1[db][4 * gq + 3] * rs * w4.w)); }
                        }
                    }
                }
            }
            moe_done = min(moe_done + NB * 4 * (S / 256) * 8 * 2 * 4, MOE_TILES);
            {
                int tid = MK_TID(); asm volatile("" : "+v"(tid));
                const int lane = tid & 63, wave = tid >> 6, qr = lane & 31, hf = lane >> 5;
                const int nlat = NB * 4 * (S / 256), nit = nlat + (ctx_out ? NB * 4 : 0);
                for (int it = vcu; it < nit; it += G) {
                    const bool lat = it < nlat; const int u = lat ? it : it - nlat;
                    const int qb = lat ? u % (S / 256) : 0, hh = lat ? (u / (S / 256)) % 4 : u % 4, b = lat ? u / (4 * (S / 256)) : u / 4;
                    const int t = qb * 256 + wave * 32 + qr; const int row = tok_row(lat, b, t); const int nkt = lat ? SK / 64 : CTX / 64;
                    const bf16_t* qrow = lat ? QM + ((size_t)(b * 4 + hh) * S + t) * 96 : QMC + ((size_t)(b * 4 + hh) * CTX + t) * 96;
                    f32x16 oacc[2]; float l_run = 0.f;
#pragma unroll
                    for (int i = 0; i < 16; ++i) { oacc[0][i] = 0.f; oacc[1][i] = 0.f; }
                    const CvArgs cvp{kp_->in[I_WG], kp_->in[I_WG], kp_->in[I_WG], WGU_T, WD_T, 0};
                    attn_pass<96, false>(qrow, KM + (size_t)(b * 4 + hh) * SK * 96, VMT + (size_t)(b * 4 + hh) * 64 * SK, SK, nkt, ldsb, tid, oacc, l_run, cvp);
                    l_run = xor32_sum(l_run);
                    const float inv = 1.0f / l_run;
                    bf16_t* orow = MIXB + (size_t)row * MIXW + 768 + hh * 64;
#pragma unroll
                    for (int db = 0; db < 2; ++db)
#pragma unroll
                        for (int gq = 0; gq < 4; ++gq) { const int d0 = 32 * db + 8 * gq + 4 * hf;
                            *(uint2*)(orow + d0) = make_uint2(pk2(oacc[db][4 * gq] * inv, oacc[db][4 * gq + 1] * inv), pk2(oacc[db][4 * gq + 2] * inv, oacc[db][4 * gq + 3] * inv)); }
                }
            }
            GSYNC();
        }
        {
            PHASE_BEGIN();
            const float* nw = kp_->in[I_SSDN] + l * 512; const float* dsk = kp_->in[I_SSDD] + l * 8;
            const int lane = tid & 63;
            uint2 q0, q1, q2, q3; { const unsigned z_ = (unsigned)tid >> 20; q0 = make_uint2(z_, z_); q1 = q0; q2 = q0; q3 = q0; }
            const float4 nw0 = *(const float4*)(nw + lane * 4), nw1 = *(const float4*)(nw + 256 + lane * 4); const float ds0 = dsk[(lane * 4) >> 6], ds1 = dsk[(256 + lane * 4) >> 6];
            const int wstride = gridDim.x * 8; int i = blockIdx.x * 8 + (tid >> 6);
#define GN_LOAD(ii) do { const int g_ = (ii) & 1, r_ = (ii) >> 1, c_ = g_ * 256 + lane * 4; q0 = *(const uint2*)(XBC + (size_t)r_ * 768 + c_); q1 = *(const uint2*)(YD + (size_t)r_ * 512 + c_); \
                q2 = *(const uint2*)(YD + ((size_t)NTOK + r_) * 512 + c_); q3 = *(const uint2*)(PB + (size_t)r_ * IN_COLS + C_Z + c_); } while (0)
            if (i < nrows_out * 2) GN_LOAD(i);
            for (; i < nrows_out * 2; i += wstride) {
                const int g = i & 1, r = i >> 1, c = g * 256 + lane * 4;
                const float4 x = up4(q0), y0 = up4(q1), y1 = up4(q2), z = up4(q3);
                if (i + wstride < nrows_out * 2) GN_LOAD(i + wstride);
                const float ds = g ? ds1 : ds0;
                float4 v = make_float4((ds * x.x + y0.x + y1.x) * siluf(z.x), (ds * x.y + y0.y + y1.y) * siluf(z.y), (ds * x.z + y0.z + y1.z) * siluf(z.z), (ds * x.w + y0.w + y1.w) * siluf(z.w));
                const float ss = wave_sum(f4dot(v, v));
                const float rs = 1.0f / sqrtf(ss / 256 + EPS);
                *(uint2*)(MIXB + (size_t)r * MIXW + c) = pk4(f4scale(f4mul(v, g ? nw1 : nw0), rs));
            }
#undef GN_LOAD
            GSYNC();
        }
        {
            PHASE_BEGIN();
            pg8::Gemm g{MIXB, WOUT_T, nrows_out, D, MIXW, 0, 0}; pg8::StaticOrder so; so.init(nrows_out, D, G, bid);
            pg8::EpiBf16 E{MOUT, D, D};
            pg8::gemm_phase<pg8::EpiBf16, pg8::StaticOrder, true, true>(ldsb, g, so, E, tid);
            { const int nwg = (nrows_out / 256) * (D / 256), busy = nwg % G; const int id0 = moe_done;
              const int id1 = min(id0 + (G - busy) * 8 * CVT_PER_WAVE, MOE_TILES);
              if (busy != 0 && bid >= busy) CVT_MOE_RANGE(l, id0, id1, (bid - busy) * 8 + (tid >> 6), (G - busy) * 8);
              if (busy != 0) moe_done = id1; }
            GSYNC();
        }
        {
            PHASE_BEGIN();
            const float* wpost = kp_->in[I_NMPOST] + l * D; const float* wpre = kp_->in[I_NFPRE] + l * D;
            const float* rw = kp_->in[I_RW] + (size_t)l * D * NE; const float* rb = kp_->in[I_RB] + l * NE;
            const int lane = tid & 63;
            float* rwl = (float*)lds_raw;
            for (int i = tid; i < D * NE / 4; i += NTHREADS) { const int k = i >> 2, e4 = i & 3; ((float4*)rwl)[(((k & 3) * 256 + (k >> 2)) << 2) + e4] = ((const float4*)rw)[i]; }
            float4* aux = (float4*)(rwl + D * NE);
            for (int i = tid; i < 17 * (D / 4); i += NTHREADS) { const int v = i / (D / 4), k4 = i % (D / 4);
                const float* src = v == 0 ? wpost : v == 1 ? wpre : modl + (size_t)((v - 2) % 5) * NMOD * D + (2 + (v - 2) / 5) * D;
                aux[i] = ((const float4*)src)[k4]; }
            __syncthreads();
            float rbv[NE];
#pragma unroll
            for (int e = 0; e < NE; ++e) rbv[e] = rb[e];
            uint2 mq[4]; float4 xq[4];
            { const float zf_ = (float)(tid >> 20);
#pragma unroll
              for (int i = 0; i < 4; ++i) { xq[i] = make_float4(zf_, zf_, zf_, zf_); mq[i] = make_uint2((unsigned)tid >> 20, (unsigned)tid >> 20); } }
            const int wstride = gridDim.x * 8; int r = blockIdx.x * 8 + (tid >> 6);
#define P7_LOAD(rr) do { const float4* xin_ = (const float4*)((rr) < NLAT ? XSRC + (size_t)(rr) * D : CSRC + (size_t)((rr) - NLAT) * D); const bf16_t* m_ = MOUT + (size_t)(rr) * D; \
                _Pragma("unroll") for (int i = 0; i < 4; ++i) { mq[i] = *(const uint2*)(m_ + (i * 64 + lane) * 4); xq[i] = xin_[i * 64 + lane]; } } while (0)
            if (r < nrows_out) P7_LOAD(r);
            for (; r < nrows_out; r += wstride) {
                float4* xr = (float4*)(r < NLAT ? xcur + (size_t)r * D : CTXC + (size_t)(r - NLAT) * D);
                const int bsel = r < NLAT ? r / S : NB;
                float4 mv[4], xv[4]; float ss = 0.f;
#pragma unroll
                for (int i = 0; i < 4; ++i) { mv[i] = up4(mq[i]); xv[i] = xq[i]; ss += f4dot(mv[i], mv[i]); }
                if (r + wstride < nrows_out) P7_LOAD(r + wstride);
                ss = wave_sum(ss);
                const float rs = 1.0f / sqrtf(ss / D + EPS);
                float s2 = 0.f;
#pragma unroll
                for (int i = 0; i < 4; ++i) { const int k4 = i * 64 + lane;
                    xv[i] = f4add(xv[i], f4mul(aux[(2 + bsel) * (D / 4) + k4], f4scale(f4mul(mv[i], aux[k4]), rs))); xr[k4] = xv[i]; s2 += f4dot(xv[i], xv[i]); }
                s2 = wave_sum(s2);
                const float r2 = 1.0f / sqrtf(s2 / D + EPS);
                float lg[NE];
#pragma unroll
                for (int e = 0; e < NE; ++e) lg[e] = 0.f;
#pragma unroll
                for (int i = 0; i < 4; ++i) { const int k4 = i * 64 + lane; const float4 w4 = aux[(D / 4) + k4], sc = aux[(12 + bsel) * (D / 4) + k4], sh = aux[(7 + bsel) * (D / 4) + k4];
                    const float hv[4] = {xv[i].x * r2 * w4.x * (1.0f + sc.x) + sh.x, xv[i].y * r2 * w4.y * (1.0f + sc.y) + sh.y, xv[i].z * r2 * w4.z * (1.0f + sc.z) + sh.z, xv[i].w * r2 * w4.w * (1.0f + sc.w) + sh.w};
                    *(uint2*)(HB + (size_t)r * D + k4 * 4) = make_uint2(pk2(hv[0], hv[1]), pk2(hv[2], hv[3]));
#pragma unroll
                    for (int c = 0; c < 4; ++c) { const float4* rwp = (const float4*)(rwl + (size_t)(c * 256 + k4) * NE);
#pragma unroll
                        for (int e4 = 0; e4 < 4; ++e4) { const float4 w = rwp[e4]; lg[4 * e4] += hv[c] * w.x; lg[4 * e4 + 1] += hv[c] * w.y; lg[4 * e4 + 2] += hv[c] * w.z; lg[4 * e4 + 3] += hv[c] * w.w; }
                        SCHED_FENCE(); }
                }
#pragma unroll
                for (int e = 0; e < NE; ++e) lg[e] = wave_sum(lg[e]) + rbv[e];
                float mx = lg[0];
#pragma unroll
                for (int e = 1; e < NE; ++e) mx = fmaxf(mx, lg[e]);
                float sum = 0.f;
#pragma unroll
                for (int e = 0; e < NE; ++e) { lg[e] = expf(lg[e] - mx); sum += lg[e]; }
                const float is = 1.0f / sum;
                float mine = lg[0];
#pragma unroll
                for (int e = 1; e < NE; ++e) mine = lane == e ? lg[e] : mine;
                if (lane < NE) AFF[(size_t)r * NE + lane] = mine * is;
            }
#undef P7_LOAD
            GSYNC();
        }
        {
            PHASE_BEGIN();
            CVT_MOE_RANGE(l, moe_done, MOE_TILES, bid * 8 + (tid >> 6), G * 8);
            {
                volatile int* sh = (volatile int*)lds_raw;
                const int nsel = (ctx_out ? 2 : 1) * NB * NE;
                for (int it = bid; it < nsel; it += G) {
                    const bool lat = it < NB * NE; const int u = lat ? it : it - NB * NE; const int e = u % NE, b = u / NE;
                    const int L = lat ? S : CTX, cap = lat ? CAP_L : CAP_C, npt = lat ? S / NTHREADS : 1, base = tok_row(lat, b, 0);
                    const bool act = lat || tid < CTX;
                    unsigned key[S / NTHREADS];
#pragma unroll
                    for (int i = 0; i < S / NTHREADS; ++i) key[i] = (act && i < npt) ? __float_as_uint(AFF[(size_t)(base + tid * npt + i) * NE + e]) : 0u;
                    __syncthreads();
                    unsigned T = 0u;
                    for (int bit = 30; bit >= 0; --bit) {
                        const unsigned cand = T | (1u << bit); int c = 0;
#pragma unroll
                        for (int i = 0; i < S / NTHREADS; ++i) c += (key[i] >= cand) ? 1 : 0;
                        if (block_sum(c, tid, sh, bit & 1) >= cap) T = cand;
                    }
                    int cg = 0, ct = 0;
#pragma unroll
                    for (int i = 0; i < S / NTHREADS; ++i) { cg += (key[i] > T) ? 1 : 0; ct += (key[i] == T && key[i] != 0u) ? 1 : 0; }
                    int tot_g, tot_t;
                    (void)block_excl_scan(cg, tid, sh, tot_g);
                    int tie_rank = block_excl_scan(ct, tid, sh, tot_t);
                    const int need = cap - tot_g;
                    int sel[S / NTHREADS], cs = 0;
#pragma unroll
                    for (int i = 0; i < S / NTHREADS; ++i) { const bool tie = key[i] == T && key[i] != 0u; sel[i] = (key[i] > T || (tie && tie_rank < need)) ? 1 : 0; tie_rank += tie ? 1 : 0; cs += sel[i]; }
                    int tot_s; int slot = block_excl_scan(cs, tid, sh, tot_s);
#pragma unroll
                    for (int i = 0; i < S / NTHREADS; ++i) if (act && i < npt) {
                        const int row = base + tid * npt + i; int sa = -1;
                        if (sel[i]) { sa = (lat ? b * CAP_L : NB * CAP_L + b * CAP_C) + slot; ++slot; SELIDX[e * ER_MAX + sa] = row; SELGATE[e * ER_MAX + sa] = __uint_as_float(key[i]); }
                        TOKSLOT[(size_t)row * NE + e] = sa;
                    }
                }
            }
            GSYNC();
        }
        {
            PHASE_BEGIN();
            const int used = ctx_out ? NB * (CAP_L + CAP_C) : NB * CAP_L;
            {
                const int lane = tid & 63, wstride = gridDim.x * 8, nrow = NE * ER;
                for (int r0 = (blockIdx.x * 8 + (tid >> 6)) * 4; r0 < nrow; r0 += wstride * 4) {
                    int src[4]; uint4 v0[4], v1[4];
#pragma unroll
                    for (int q = 0; q < 4; ++q) { const int rr = r0 + q, e = rr / ER, slot = rr % ER; src[q] = (rr < nrow && slot < used) ? SELIDX[e * ER_MAX + slot] : -1; }
#pragma unroll
                    for (int q = 0; q < 4; ++q) { const unsigned z_ = (unsigned)tid >> 20; v0[q] = make_uint4(z_, z_, z_, z_); v1[q] = v0[q];
                        if (src[q] >= 0) { const uint4* sp = (const uint4*)(HB + (size_t)src[q] * D); v0[q] = sp[lane]; v1[q] = sp[64 + lane]; } }
#pragma unroll
                    for (int q = 0; q < 4; ++q) if (r0 + q < nrow) { uint4* dp = (uint4*)(XG + (size_t)(r0 + q) * D); dp[lane] = v0[q]; dp[64 + lane] = v1[q]; }
                }
            }
            GSYNC();
        }
        {
            PHASE_BEGIN();
            pg8::Gemm g{XG, WGU_T, NE * ER, 2 * FF, D, ER / 256, (size_t)2 * FF * D * 2}; pg8::StaticOrder so; so.init(NE * ER, 2 * FF, G, bid);
            pg8::EpiSwiGLU E{HID, FF};
            pg8::gemm_phase<pg8::EpiSwiGLU, pg8::StaticOrder, true, true>(ldsb, g, so, E, tid);
            GSYNC();
        }
        {
            PHASE_BEGIN();
            pg8::Gemm g{HID, WD_T, NE * ER, D, FF, ER / 256, (size_t)D * FF * 2}; pg8::StaticOrder so; so.init(NE * ER, D, G, bid);
            pg8::EpiRowScaleBf16 E{Y, D, SELGATE, ER};
            pg8::gemm_phase<pg8::EpiRowScaleBf16, pg8::StaticOrder, true, true>(ldsb, g, so, E, tid);
            GSYNC();
        }
        {
            PHASE_BEGIN();
            const float* wpost = kp_->in[I_NFPOST] + l * D;
            const int lane = tid & 63;
            {
                float4 xq[4]; int slq = -1;
                { const float zf_ = (float)(tid >> 20);
#pragma unroll
                  for (int i = 0; i < 4; ++i) xq[i] = make_float4(zf_, zf_, zf_, zf_); }
                float4* aux = (float4*)lds_raw;
                __syncthreads();
                for (int i = tid; i < 6 * (D / 4); i += NTHREADS) { const int v = i / (D / 4), k4 = i % (D / 4);
                    const float* src = v == 0 ? wpost : modl + (size_t)(v - 1) * NMOD * D + 5 * D;
                    aux[i] = ((const float4*)src)[k4]; }
                __syncthreads();
                const int wstride = gridDim.x * 8; int r = blockIdx.x * 8 + (tid >> 6);
#define P11_LOAD(rr) do { const float4* xin_ = (const float4*)((rr) < NLAT ? xcur + (size_t)(rr) * D : CTXC + (size_t)((rr) - NLAT) * D); slq = lane < NE ? TOKSLOT[(size_t)(rr) * NE + lane] : -1; \
                    _Pragma("unroll") for (int i = 0; i < 4; ++i) xq[i] = xin_[i * 64 + lane]; } while (0)
                if (r < nrows_out) P11_LOAD(r);
                for (; r < nrows_out; r += wstride) {
                    float4* xr = (float4*)(r < NLAT ? xcur + (size_t)r * D : CTXC + (size_t)(r - NLAT) * D);
                    const int bsel = r < NLAT ? r / S : NB;
                    const int myslot = slq; float4 xv[4], f[4];
#pragma unroll
                    for (int i = 0; i < 4; ++i) { xv[i] = xq[i]; f[i] = make_float4(0.f, 0.f, 0.f, 0.f); }
                    {
                        unsigned msk = (unsigned)__ballot(myslot >= 0) & 0xffffu;
                        const bf16_t* zrow = (const bf16_t*)(kp_->ws + WS_CTL + 32768);
                        const bf16_t* yp[4];
#pragma unroll
                        for (int q = 0; q < 4; ++q) { yp[q] = zrow;
                            if (msk) { const int e = __builtin_ctz(msk); msk &= msk - 1; const int sl = __builtin_amdgcn_readlane(myslot, e); yp[q] = Y + ((size_t)e * ER + sl) * D; } }
                        uint2 yv[4][4];
#pragma unroll
                        for (int q = 0; q < 4; ++q)
#pragma unroll
                            for (int i = 0; i < 4; ++i) yv[q][i] = *(const uint2*)(yp[q] + (i * 64 + lane) * 4);
#pragma unroll
                        for (int q = 0; q < 4; ++q)
#pragma unroll
                            for (int i = 0; i < 4; ++i) f[i] = f4add(f[i], up4(yv[q][i]));
                        while (msk) { const int e = __builtin_ctz(msk); msk &= msk - 1; const int sl = __builtin_amdgcn_readlane(myslot, e); const bf16_t* ypx = Y + ((size_t)e * ER + sl) * D;
#pragma unroll
                            for (int i = 0; i < 4; ++i) f[i] = f4add(f[i], ld4h(ypx + (i * 64 + lane) * 4)); }
                    }
                    if (r + wstride < nrows_out) P11_LOAD(r + wstride);
                    float ss = 0.f;
#pragma unroll
                    for (int i = 0; i < 4; ++i) ss += f4dot(f[i], f[i]);
                    ss = wave_sum(ss);
                    const float rs = 1.0f / sqrtf(ss / D + EPS);
#pragma unroll
                    for (int i = 0; i < 4; ++i) { const int k4 = i * 64 + lane; xr[k4] = f4add(xv[i], f4mul(aux[(1 + bsel) * (D / 4) + k4], f4scale(f4mul(f[i], aux[k4]), rs))); }
                }
#undef P11_LOAD
            }
            GSYNC();
        }
    }
}

extern "C" void kernel_launch(void* const* d_in, const int* in_sizes, int n_in, void* d_out, int out_size, void* d_ws, size_t ws_size, hipStream_t stream) {
    static int grid = 0;
    if (grid == 0) {
        if (n_in != N_IN || out_size != NLAT * D || ws_size < WS_END) { fprintf(stderr, "kernel_launch: unexpected shapes: n_in %d out %d ws %zu (need %zu)\n", n_in, out_size, ws_size, (size_t)WS_END); grid = -1; return; }
        int dev = 0, cus = 0, per_cu = 0;
        (void)hipGetDevice(&dev);
        (void)hipDeviceGetAttribute(&cus, hipDeviceAttributeMultiprocessorCount, dev);
        (void)hipFuncSetAttribute((const void*)mk_forward, hipFuncAttributeMaxDynamicSharedMemorySize, LDS_BYTES);
        (void)hipOccupancyMaxActiveBlocksPerMultiprocessor(&per_cu, (const void*)mk_forward, NTHREADS, LDS_BYTES);
        (void)hipGetLastError();
        if (per_cu < 1) { fprintf(stderr, "kernel_launch: occupancy query says %d blocks/CU\n", per_cu); grid = -1; return; }
        grid = cus;
    }
    if (grid < 0) return;
    (void)hipMemsetAsync((char*)d_ws + WS_CTL, 0, CTL_BYTES, stream);
    Prm p{};
    for (int i = 0; i < N_IN; ++i) p.in[i] = (const float*)d_in[i];
    p.out = (float*)d_out; p.ws = (char*)d_ws;
    void* args[] = {&p};
    hipError_t e = hipLaunchCooperativeKernel((const void*)mk_forward, dim3(grid), dim3(NTHREADS), args, LDS_BYTES, stream);
    if (e != hipSuccess) fprintf(stderr, "kernel_launch: cooperative launch failed: %s (grid %d)\n", hipGetErrorString(e), grid);
}
```

```cpp
#include <hip/hip_runtime.h>
#include <cstdio>
#include <cstdint>

constexpr int D = 1024, NB = 4, S = 4096, CTX = 256, FF = 1024;
constexpr int DEPTH = 2, GRID_W = 64, NMOD = 6, NE = 16;
constexpr int NLAT = NB * S, NCTX = NB * CTX, NTOK = NLAT + NCTX;
constexpr int IN_COLS = 2416, IN_PAD = 2560;
constexpr int C_Z = 0, C_XBC = 512, C_DT = 1280, C_DQ = 1296, C_DK = 1552, C_DV = 1808, C_CQ = 2064, C_CKV = 2256, C_KR = 2384;
constexpr int MIXW = 1024;
constexpr int CAP_L = 2 * S / NE, CAP_C = 2 * CTX / NE;
constexpr int ER_MAX = 2304;
constexpr float EPS = 1e-6f;
static_assert(NB * CAP_L == 2048 && NB * CAP_C == 128, "expert row layout");

enum { I_X = 0, I_C, I_CTX, I_CCTX, I_ADAW, I_ADAB, I_NMPRE, I_NMPOST, I_NFPRE, I_NFPOST, I_WIN, I_CONVW, I_CONVB, I_ALOG, I_DTB, I_SSDD, I_SSDN,
       I_LQ1, I_LK1, I_LQ2, I_LK2, I_SUBLN, I_QNORM, I_WQUP, I_KVNORM, I_WKVUP, I_WOUT, I_RW, I_RB, I_WG, I_WU, I_WD, N_IN };
struct Prm { const float* in[N_IN]; float* out; char* ws; };

typedef unsigned short bf16_t;
constexpr size_t al256(size_t x) { return (x + 255) & ~(size_t)255; }
constexpr size_t WS_CTL = 0, CTL_BYTES = 65536;
constexpr size_t WS_MOD = WS_CTL + CTL_BYTES;
constexpr size_t WS_CTXC = al256(WS_MOD + (size_t)DEPTH * (NB + 1) * NMOD * D * 4);
constexpr size_t WS_AFF = al256(WS_CTXC + (size_t)NCTX * D * 4);
constexpr size_t WS_TOKSLOT = al256(WS_AFF + (size_t)NTOK * NE * 4);
constexpr size_t WS_SELIDX = al256(WS_TOKSLOT + (size_t)NTOK * NE * 4);
constexpr size_t WS_SELGATE = al256(WS_SELIDX + (size_t)NE * ER_MAX * 4);
constexpr size_t WS_DT = al256(WS_SELGATE + (size_t)NE * ER_MAX * 4);
constexpr int NCH = 34;
constexpr size_t WS_ROPE = al256(WS_DT + (size_t)NTOK * 16 * 4);
constexpr size_t WS_ALAST = al256(WS_ROPE + (size_t)S * 32 * 4);
constexpr size_t WS_HB = al256(WS_ALAST + (size_t)NB * 2 * NCH * 8 * 4);
constexpr size_t WS_P = al256(WS_HB + (size_t)NTOK * D * 2);
constexpr size_t WS_G2 = al256(WS_P + (size_t)NTOK * IN_COLS * 4);
constexpr size_t WS_XBC = WS_G2;
constexpr size_t WS_MQ = al256(WS_XBC + (size_t)NTOK * 768 * 4);
constexpr size_t WS_MKV = al256(WS_MQ + (size_t)NTOK * 384 * 4);
constexpr size_t WS_CQB = al256(WS_MKV + (size_t)NTOK * 512 * 4);
constexpr size_t WS_CKVB = al256(WS_CQB + (size_t)NTOK * 256 * 2);
constexpr size_t WS_MIXB = al256(WS_CKVB + (size_t)NTOK * 128 * 2);
constexpr size_t WS_G2END = al256(WS_MIXB + (size_t)NTOK * MIXW * 2);
constexpr size_t WS_HS = WS_HB;
constexpr size_t WS_YD = WS_MQ;
constexpr size_t WS_MOUT = WS_P;
constexpr size_t WS_XG = WS_P;
constexpr size_t WS_HID = al256(WS_XG + (size_t)NE * ER_MAX * D * 2);
constexpr size_t WS_Y = WS_G2;
constexpr size_t WS_WIN = WS_G2END;
constexpr size_t WS_WQ = al256(WS_WIN + (size_t)IN_PAD * D * 2);
constexpr size_t WS_WKV = al256(WS_WQ + (size_t)512 * 256 * 2);
constexpr size_t WS_WOUT = al256(WS_WKV + (size_t)512 * 128 * 2);
constexpr size_t WS_WGU = al256(WS_WOUT + (size_t)D * MIXW * 2);
constexpr size_t WS_WD = al256(WS_WGU + (size_t)NE * 2 * FF * D * 2);
constexpr size_t WS_XRB = al256(WS_WD + (size_t)NE * D * FF * 2);
constexpr size_t WS_END = al256(WS_XRB + (size_t)NTOK * D * 2);
constexpr int SK = CTX + S;
constexpr size_t WS_QD = al256(WS_P + (size_t)NTOK * IN_COLS * 2);
constexpr size_t WS_QDC = al256(WS_QD + (size_t)NB * 8 * S * 32 * 2);
constexpr size_t WS_KD = al256(WS_QDC + (size_t)NB * 8 * CTX * 32 * 2);
constexpr size_t WS_VDT = al256(WS_KD + (size_t)NB * 8 * SK * 32 * 2);
constexpr size_t WS_QM = al256(WS_VDT + (size_t)NB * 4 * 64 * SK * 2);
constexpr size_t WS_QMC = al256(WS_QM + (size_t)NB * 4 * S * 96 * 2);
constexpr size_t WS_KM = al256(WS_QMC + (size_t)NB * 4 * CTX * 96 * 2);
constexpr size_t WS_VMT = al256(WS_KM + (size_t)NB * 4 * SK * 96 * 2);
constexpr size_t WS_ATTEND = al256(WS_VMT + (size_t)NB * 4 * 64 * SK * 2);
static_assert(WS_ATTEND <= WS_G2, "attention operands fit in the spare half of the P slot");
static_assert(WS_HID + (size_t)NE * ER_MAX * FF * 2 <= WS_G2, "XG+HID fit in the P region");
static_assert((size_t)NE * ER_MAX * D * 4 <= WS_G2END - WS_G2, "Y fits in the G2 region");
static_assert((size_t)NB * 2 * NCH * 8 * 4096 * 4 <= (size_t)NTOK * D * 2, "HS fits in HB");
static_assert(WS_YD + (size_t)2 * NTOK * 512 * 4 <= WS_MIXB, "YD ends below MIXB");

#define LAS __attribute__((address_space(3)))
constexpr int NTHREADS = 512;
constexpr int LDS_BYTES = 147456;
#define ITEMS(i, n) for (int i = blockIdx.x * NTHREADS + tid; i < (n); i += gridDim.x * NTHREADS)

__device__ __forceinline__ float siluf(float x) { return x / (1.0f + expf(-x)); }
__device__ __forceinline__ float softplusf(float x) {
    const float e = __builtin_amdgcn_exp2f(x * 1.44269504f);
    const float sm = e * fmaf(e, fmaf(e, 0.33333334f, -0.5f), 1.0f), lg = __builtin_amdgcn_logf(1.0f + e) * 0.69314718f;
    return x > 20.f ? x : (e < 1e-3f ? sm : lg); }
__device__ __forceinline__ unsigned f2bf(float f) { unsigned u = __builtin_bit_cast(unsigned, f); return (u + 0x7fffu + ((u >> 16) & 1u)) >> 16; }
typedef float f32x2_t __attribute__((ext_vector_type(2)));
typedef __bf16 bf16x2_t __attribute__((ext_vector_type(2)));
__device__ __forceinline__ unsigned pk2(float lo, float hi) { const f32x2_t v = {lo, hi}; return __builtin_bit_cast(unsigned, __builtin_convertvector(v, bf16x2_t)); }
__device__ __forceinline__ float bf2f(bf16_t h) { return __builtin_bit_cast(float, (unsigned)h << 16); }
#define SCHED_FENCE() __builtin_amdgcn_sched_barrier(0)
__device__ __forceinline__ int mk_tid_impl(int wave_s) { unsigned z; asm volatile("s_mov_b32 %0, 0" : "=s"(z));
    return (wave_s << 6) | (int)__builtin_amdgcn_mbcnt_hi(~0u, __builtin_amdgcn_mbcnt_lo(~0u, z)); }
__device__ __forceinline__ float dpp_row_shr(float v, int n) {
    const int iv = __builtin_bit_cast(int, v); int r;
    switch (n) { case 1: r = __builtin_amdgcn_update_dpp(0, iv, 0x111, 0xf, 0xf, true); break; case 2: r = __builtin_amdgcn_update_dpp(0, iv, 0x112, 0xf, 0xf, true); break;
                 case 4: r = __builtin_amdgcn_update_dpp(0, iv, 0x114, 0xf, 0xf, true); break; default: r = __builtin_amdgcn_update_dpp(0, iv, 0x118, 0xf, 0xf, true); break; }
    return __builtin_bit_cast(float, r);
}
__device__ __forceinline__ float wave_sum(float v) {
    v += dpp_row_shr(v, 1); v += dpp_row_shr(v, 2); v += dpp_row_shr(v, 4); v += dpp_row_shr(v, 8);
    v += __builtin_bit_cast(float, __builtin_amdgcn_update_dpp(0, __builtin_bit_cast(int, v), 0x142, 0xa, 0xf, false));
    v += __builtin_bit_cast(float, __builtin_amdgcn_update_dpp(0, __builtin_bit_cast(int, v), 0x143, 0xc, 0xf, false));
    return __builtin_bit_cast(float, __builtin_amdgcn_readlane(__builtin_bit_cast(int, v), 63)); }
__device__ __forceinline__ float xor32_max(float x) { auto t = __builtin_amdgcn_permlane32_swap(__float_as_uint(x), __float_as_uint(x), false, false); return fmaxf(__uint_as_float(t[0]), __uint_as_float(t[1])); }
__device__ __forceinline__ float xor32_sum(float x) { auto t = __builtin_amdgcn_permlane32_swap(__float_as_uint(x), __float_as_uint(x), false, false); return __uint_as_float(t[0]) + __uint_as_float(t[1]); }
#define WITEMS(i, n) for (int i = blockIdx.x * 8 + (tid >> 6); i < (n); i += gridDim.x * 8)
__device__ __forceinline__ float4 f4mul(float4 a, float4 b) { return make_float4(a.x * b.x, a.y * b.y, a.z * b.z, a.w * b.w); }
__device__ __forceinline__ float4 f4add(float4 a, float4 b) { return make_float4(a.x + b.x, a.y + b.y, a.z + b.z, a.w + b.w); }
__device__ __forceinline__ float4 f4scale(float4 a, float s) { return make_float4(a.x * s, a.y * s, a.z * s, a.w * s); }
__device__ __forceinline__ float f4dot(float4 a, float4 b) { return a.x * b.x + a.y * b.y + a.z * b.z + a.w * b.w; }
__device__ __forceinline__ uint2 pk4(float4 v) { return make_uint2(pk2(v.x, v.y), pk2(v.z, v.w)); }
__device__ __forceinline__ float4 up4(uint2 u) { return make_float4(__uint_as_float(u.x << 16), __uint_as_float(u.x & 0xffff0000u), __uint_as_float(u.y << 16), __uint_as_float(u.y & 0xffff0000u)); }
__device__ __forceinline__ float4 ld4h(const bf16_t* p) { return up4(*(const uint2*)p); }

__device__ __forceinline__ void rope32(float* v, int t, const float* tab) {
    const float4* tp = (const float4*)(tab + (size_t)t * 32);
    float cs[32];
#pragma unroll
    for (int i = 0; i < 8; ++i) { const float4 x = tp[i]; cs[4 * i] = x.x; cs[4 * i + 1] = x.y; cs[4 * i + 2] = x.z; cs[4 * i + 3] = x.w; }
#pragma unroll
    for (int i = 0; i < 8; ++i) {
        { const float c = cs[i], sn = cs[8 + i]; const float x1 = v[i], x2 = v[8 + i]; v[i] = x1 * c - x2 * sn; v[8 + i] = x1 * sn + x2 * c; }
        { const float c = cs[16 + i], sn = cs[24 + i]; const float x1 = v[16 + i], x2 = v[24 + i]; v[16 + i] = x1 * c - x2 * sn; v[24 + i] = x1 * sn + x2 * c; }
    }
}
__device__ __forceinline__ int tok_row(bool lat, int b, int t) { return lat ? b * S + t : NLAT + b * CTX + t; }

namespace pg8 {
#define PG8_LAS __attribute__((address_space(3)))
typedef short bf16x8 __attribute__((ext_vector_type(8)));
typedef float f32x4 __attribute__((ext_vector_type(4)));
typedef unsigned u32x4 __attribute__((ext_vector_type(4)));
constexpr int BM = 256, BK = 64, HALF = 128, HTB = HALF * BK * 2  , STAGE_BYTES = 8 * HTB, NXCD = 8, WGM = 16;

__host__ __device__ __forceinline__ int lds_byte(int r, int c) { const int st = (r >> 4) * 2 + (c >> 5), rr = r & 15, cc = c & 31, ob = rr * 64 + cc * 2; return st * 1024 + (ob ^ (((ob >> 9) & 1) << 5)); }
__host__ __device__ __forceinline__ void stage_rc(int b, int& R, int& C) { const int st = b / 1024, sb = b % 1024, swz = sb ^ (((sb >> 9) & 1) << 5); R = (st >> 1) * 16 + swz / 64; C = (st & 1) * 32 + (swz % 64) / 2; }
__host__ __device__ __forceinline__ int perm32(int rho) { const int n = rho >> 4, i = rho & 15; return 8 * (i >> 2) + 4 * n + (i & 3); }

struct Unit { int pm, pn; };
struct Gemm { const bf16_t* A; const bf16_t* Bt; int M, N, K; int grp_tiles; size_t grp_stride; };

struct StaticOrder {
    int nM, nN, nwg, G, c;
    __host__ __device__ void init(int M, int N, int G_, int c_) { nM = M / BM; nN = N / BM; nwg = nM * nN; G = G_; c = c_; }
    __host__ __device__ bool next(int i, Unit& u) const {
        const long L = (long)i * G + c; if (L >= nwg) return false;
        int wgid = (int)L; { const int q = nwg / NXCD, r = nwg % NXCD, xcd = wgid % NXCD, off = wgid / NXCD; wgid = (xcd < r ? xcd * (q + 1) : r * (q + 1) + (xcd - r) * q) + off; }
        const int nig = WGM * nN, gid = wgid / nig, fm = gid * WGM, gsz = (nM - fm) < WGM ? (nM - fm) : WGM;
        u.pm = fm + ((wgid % nig) % gsz); u.pn = (wgid % nig) / gsz; return true;
    }
    __device__ __forceinline__ void a_ready(const Unit&) const {}
    __device__ __forceinline__ void done(const Unit&) const {}
};

__device__ __forceinline__ unsigned cvt_pk_bf16(float lo, float hi) { unsigned r; asm volatile("v_cvt_pk_bf16_f32 %0, %1, %2" : "=v"(r) : "v"(lo), "v"(hi)); return r; }

typedef unsigned u32x2 __attribute__((ext_vector_type(2)));
struct EpiF32 {
    static constexpr bool PERM = false, AFTER_DRAIN = false;
    float* C; int ldc; int ncols;
    __device__ __forceinline__ void operator()(const f32x4 (&acc)[2][2][4][2], const Unit& u, int wr, int wc, int fr, int fq) const {
        const int row0 = u.pm * BM + wr * 64 + fr, col0 = u.pn * BM + wc * 32 + 4 * fq;
#pragma unroll
        for (int ai = 0; ai < 2; ++ai)
#pragma unroll
            for (int m = 0; m < 4; ++m) { float* rowp = C + (size_t)(row0 + ai * HALF + m * 16) * ldc;
#pragma unroll
                for (int bj = 0; bj < 2; ++bj)
#pragma unroll
                    for (int n = 0; n < 2; ++n) { const int col = col0 + bj * HALF + n * 16; if (col < ncols) *(f32x4*)(rowp + col) = acc[ai][bj][m][n]; } }
    }
};
struct EpiRowScaleF32 {
    static constexpr bool PERM = false, AFTER_DRAIN = false;
    float* C; int ldc; const float* gate; int er;
    __device__ __forceinline__ void operator()(const f32x4 (&acc)[2][2][4][2], const Unit& u, int wr, int wc, int fr, int fq) const {
        const int row0 = u.pm * BM + wr * 64 + fr, col0 = u.pn * BM + wc * 32 + 4 * fq;
#pragma unroll
        for (int ai = 0; ai < 2; ++ai)
#pragma unroll
            for (int m = 0; m < 4; ++m) { const int row = row0 + ai * HALF + m * 16; float* rowp = C + (size_t)row * ldc; const float sc = gate[(row / er) * ER_MAX + row % er];
#pragma unroll
                for (int bj = 0; bj < 2; ++bj)
#pragma unroll
                    for (int n = 0; n < 2; ++n) *(f32x4*)(rowp + col0 + bj * HALF + n * 16) = acc[ai][bj][m][n] * sc; }
    }
};
struct EpiSwiGLU {
    static constexpr bool PERM = true, AFTER_DRAIN = false;
    bf16_t* O; int ldo;
    __device__ __forceinline__ void operator()(const f32x4 (&acc)[2][2][4][2], const Unit& u, int wr, int wc, int fr, int fq) const {
        const int row0 = u.pm * BM + wr * 64 + fr, col0 = u.pn * BM + wc * 32 + 8 * fq;
#pragma unroll
        for (int ai = 0; ai < 2; ++ai)
#pragma unroll
            for (int m = 0; m < 4; ++m) { bf16_t* rowp = O + (size_t)(row0 + ai * HALF + m * 16) * ldo;
#pragma unroll
                for (int bj = 0; bj < 2; ++bj) { const f32x4 gt = acc[ai][bj][m][0], up = acc[ai][bj][m][1]; f32x4 h;
#pragma unroll
                    for (int i = 0; i < 4; ++i) h[i] = gt[i] / (1.0f + __expf(-gt[i])) * up[i];
                    u32x2 w; w.x = cvt_pk_bf16(h[0], h[1]); w.y = cvt_pk_bf16(h[2], h[3]);
                    *(u32x2*)(rowp + (col0 + bj * HALF) / 2) = w; } }
    }
};

struct EpiBf16 {
    static constexpr bool PERM = true, AFTER_DRAIN = false;
    bf16_t* O; int ldo; int ncols;
    __device__ __forceinline__ void operator()(const f32x4 (&acc)[2][2][4][2], const Unit& u, int wr, int wc, int fr, int fq) const {
        const int row0 = u.pm * BM + wr * 64 + fr, col0 = u.pn * BM + wc * 32 + 8 * fq;
#pragma unroll
        for (int ai = 0; ai < 2; ++ai)
#pragma unroll
            for (int m = 0; m < 4; ++m) { bf16_t* rowp = O + (size_t)(row0 + ai * HALF + m * 16) * ldo;
#pragma unroll
                for (int bj = 0; bj < 2; ++bj) { const int col = col0 + bj * HALF; const f32x4 v0 = acc[ai][bj][m][0], v1 = acc[ai][bj][m][1];
                    u32x4 w; w.x = cvt_pk_bf16(v0[0], v0[1]); w.y = cvt_pk_bf16(v0[2], v0[3]); w.z = cvt_pk_bf16(v1[0], v1[1]); w.w = cvt_pk_bf16(v1[2], v1[3]);
                    if (col < ncols) *(u32x4*)(rowp + col) = w; } }
    }
};
struct EpiRowScaleBf16 {
    static constexpr bool PERM = true, AFTER_DRAIN = false;
    bf16_t* O; int ldo; const float* gate; int er;
    __device__ __forceinline__ void operator()(const f32x4 (&acc)[2][2][4][2], const Unit& u, int wr, int wc, int fr, int fq) const {
        const int row0 = u.pm * BM + wr * 64 + fr, col0 = u.pn * BM + wc * 32 + 8 * fq;
#pragma unroll
        for (int ai = 0; ai < 2; ++ai)
#pragma unroll
            for (int m = 0; m < 4; ++m) { const int row = row0 + ai * HALF + m * 16; bf16_t* rowp = O + (size_t)row * ldo; const float sc = gate[(row / er) * ER_MAX + row % er];
#pragma unroll
                for (int bj = 0; bj < 2; ++bj) { const f32x4 v0 = acc[ai][bj][m][0] * sc, v1 = acc[ai][bj][m][1] * sc;
                    u32x4 w; w.x = cvt_pk_bf16(v0[0], v0[1]); w.y = cvt_pk_bf16(v0[2], v0[3]); w.z = cvt_pk_bf16(v1[0], v1[1]); w.w = cvt_pk_bf16(v1[2], v1[3]);
                    *(u32x4*)(rowp + col0 + bj * HALF) = w; } }
    }
};
template <class Epi, class Sched, bool ALIGN_EPI = false, bool SP2 = false>
__device__ __forceinline__ void gemm_phase(PG8_LAS unsigned char* lds, const Gemm g, const Sched& S, const Epi& E, int tid_in) {
    int tid_ = tid_in; asm volatile("" : "+v"(tid_));
    const int tid = tid_, wid = __builtin_amdgcn_readfirstlane(tid >> 6), lane = tid & 63, wr = wid >> 2, wc = wid & 3, fr = lane & 15, fq = lane >> 4;
    int K_ = g.K; asm volatile("" : "+s"(K_));
    const int K = K_, nt = K / BK;
    unsigned voffA[2], voffB[2];
#pragma unroll
    for (int i = 0; i < 2; ++i) { int R, C; stage_rc(tid * 16 + i * 8192, R, C); const int Rb = Epi::PERM ? ((R & ~31) + perm32(R & 31)) : R;
        voffA[i] = (unsigned)(R * K + C) * 2u; voffB[i] = (unsigned)(Rb * K + C) * 2u; }
    const size_t kstep = (size_t)(BK * 2);
    const size_t hstep = (size_t)HALF * K * 2;
    const size_t tstep = 2 * hstep;
    const unsigned ldsw = (unsigned)wid * 1024u;
    const int aoff = lds_byte(wr * 64 + fr, fq * 8), boff = lds_byte(wc * 32 + fr, fq * 8);
#define PG8_SA(b, h) (((b) * 2 + (h)) * HTB)
#define PG8_SB(b, h) ((4 + (b) * 2 + (h)) * HTB)
#define PG8_STAGE(bufoff, gbase, voff) do { _Pragma("unroll") for (int _i = 0; _i < 2; ++_i) \
        __builtin_amdgcn_global_load_lds((const unsigned*)((const char*)(gbase) + (voff)[_i]), (PG8_LAS unsigned*)(lds + (bufoff) + ldsw + _i * 8192), 16, 0, 0); } while (0)
#define PG8_LDA(dst, b, h) do { _Pragma("unroll") for (int m = 0; m < 4; ++m) _Pragma("unroll") for (int k = 0; k < 2; ++k) dst[m][k] = *(const PG8_LAS bf16x8*)(lds + PG8_SA(b, h) + aoff + m * 2048 + k * 1024); } while (0)
#define PG8_LDB(dst, b, h) do { _Pragma("unroll") for (int n = 0; n < 2; ++n) _Pragma("unroll") for (int k = 0; k < 2; ++k) dst[n][k] = *(const PG8_LAS bf16x8*)(lds + PG8_SB(b, h) + boff + n * 2048 + k * 1024); } while (0)
#define PG8_MMA(ai, bj, At, Bt) do { __builtin_amdgcn_s_setprio(1); _Pragma("unroll") for (int m = 0; m < 4; ++m) _Pragma("unroll") for (int n = 0; n < 2; ++n) _Pragma("unroll") for (int k = 0; k < 2; ++k) \
        acc[ai][bj][m][n] = __builtin_amdgcn_mfma_f32_16x16x32_bf16(Bt[n][k], At[m][k], acc[ai][bj][m][n], 0, 0, 0); __builtin_amdgcn_s_setprio(0); } while (0)
#define PG8_WAIT_V(n) asm volatile("s_waitcnt vmcnt(" #n ")" ::: "memory")
#define PG8_WAIT_L(n) asm volatile("s_waitcnt lgkmcnt(" #n ")" ::: "memory")
#define PG8_BAR __builtin_amdgcn_s_barrier()
#define PG8_SCHED __builtin_amdgcn_sched_barrier(0)
    Unit cur, nxt; int ui = 0;
    if (!S.next(0, cur)) return;
    f32x4 acc[2][2][4][2];
#pragma unroll
    for (int a = 0; a < 2; ++a)
#pragma unroll
        for (int b = 0; b < 2; ++b)
#pragma unroll
            for (int m = 0; m < 4; ++m)
#pragma unroll
                for (int n = 0; n < 2; ++n) acc[a][b][m][n] = (f32x4){0.f, 0.f, 0.f, 0.f};
    bf16x8 At[4][2], B0[2][2], B1[2][2];
    const char* cA = (const char*)g.A + (size_t)cur.pm * tstep; const char* cB = (const char*)g.Bt + (size_t)cur.pn * tstep + (g.grp_tiles ? (size_t)(cur.pm / g.grp_tiles) * g.grp_stride : (size_t)0);
    S.a_ready(cur);
    if constexpr (SP2) {
        PG8_STAGE(PG8_SB(0, 0), cB, voffB); PG8_STAGE(PG8_SB(0, 1), cB + hstep, voffB); PG8_STAGE(PG8_SA(0, 0), cA, voffA); PG8_STAGE(PG8_SA(0, 1), cA + hstep, voffA);
        if (wr == 1) PG8_BAR;
        PG8_WAIT_V(2); PG8_BAR;
        PG8_STAGE(PG8_SB(1, 0), cB + kstep, voffB); PG8_STAGE(PG8_SA(1, 0), cA + kstep, voffA); PG8_STAGE(PG8_SB(1, 1), cB + hstep + kstep, voffB);
        PG8_WAIT_V(6); PG8_BAR;
    } else {
        PG8_STAGE(PG8_SB(0, 0), cB, voffB); PG8_STAGE(PG8_SA(0, 0), cA, voffA); PG8_STAGE(PG8_SB(0, 1), cB + hstep, voffB); PG8_STAGE(PG8_SA(0, 1), cA + hstep, voffA);
        if (wr == 1) PG8_BAR;
        PG8_WAIT_V(4); PG8_BAR;
        PG8_STAGE(PG8_SB(1, 0), cB + kstep, voffB); PG8_STAGE(PG8_SA(1, 0), cA + kstep, voffA); PG8_STAGE(PG8_SB(1, 1), cB + hstep + kstep, voffB);
        PG8_WAIT_V(6); PG8_BAR;
    }
    for (;;) {
        const bool has_next = S.next(ui + 1, nxt);
        const char* nA = has_next ? (const char*)g.A + (size_t)nxt.pm * tstep : cA; const char* nB = has_next ? (const char*)g.Bt + (size_t)nxt.pn * tstep + (g.grp_tiles ? (size_t)(nxt.pm / g.grp_tiles) * g.grp_stride : (size_t)0) : cB;
        for (int t = 0; t < nt; t += 2) {
            const bool last = (t == nt - 2);
            const char* a1 = cA + (size_t)(t + 1) * kstep;
            const char* a2 = last ? nA : cA + (size_t)(t + 2) * kstep; const char* b2 = last ? nB : cB + (size_t)(t + 2) * kstep;
            const char* a3 = a2 + kstep; const char* b3 = b2 + kstep;
            if (last && has_next) S.a_ready(nxt);
            if constexpr (SP2) {
            PG8_LDB(B0, 0, 0); PG8_LDB(B1, 0, 1); PG8_SCHED; PG8_LDA(At, 0, 0); PG8_STAGE(PG8_SA(1, 1), a1 + hstep, voffA);
            PG8_WAIT_V(8); PG8_WAIT_L(0); PG8_BAR; PG8_MMA(0, 0, At, B0); PG8_MMA(0, 1, At, B1); PG8_BAR; PG8_SCHED;
            PG8_LDA(At, 0, 1); PG8_STAGE(PG8_SB(0, 0), b2, voffB); PG8_STAGE(PG8_SB(0, 1), b2 + hstep, voffB); PG8_STAGE(PG8_SA(0, 0), a2, voffA);
            PG8_WAIT_V(8); PG8_WAIT_L(0); PG8_BAR; PG8_MMA(1, 0, At, B0); PG8_MMA(1, 1, At, B1); PG8_BAR; PG8_SCHED;
            PG8_LDB(B0, 1, 0); PG8_LDB(B1, 1, 1); PG8_SCHED; PG8_LDA(At, 1, 0); PG8_STAGE(PG8_SA(0, 1), a2 + hstep, voffA);
            PG8_WAIT_V(8); PG8_WAIT_L(0); PG8_BAR; PG8_MMA(0, 0, At, B0); PG8_MMA(0, 1, At, B1); PG8_BAR; PG8_SCHED;
            PG8_LDA(At, 1, 1); PG8_STAGE(PG8_SB(1, 0), b3, voffB); PG8_STAGE(PG8_SB(1, 1), b3 + hstep, voffB); PG8_STAGE(PG8_SA(1, 0), a3, voffA);
            PG8_WAIT_V(8); PG8_WAIT_L(0); PG8_BAR; PG8_MMA(1, 0, At, B0); PG8_MMA(1, 1, At, B1); PG8_BAR; PG8_SCHED;
            } else {
            PG8_LDB(B0, 0, 0); PG8_SCHED; PG8_LDA(At, 0, 0); PG8_STAGE(PG8_SA(1, 1), a1 + hstep, voffA);
            PG8_WAIT_L(8); PG8_BAR; PG8_WAIT_L(0); PG8_MMA(0, 0, At, B0); PG8_BAR; PG8_SCHED;
            PG8_LDB(B1, 0, 1); PG8_STAGE(PG8_SB(0, 0), b2, voffB);
            PG8_BAR; PG8_WAIT_L(0); PG8_MMA(0, 1, At, B1); PG8_BAR;
            PG8_LDA(At, 0, 1); PG8_STAGE(PG8_SA(0, 0), a2, voffA);
            PG8_BAR; PG8_WAIT_L(0); PG8_MMA(1, 0, At, B0); PG8_BAR; PG8_SCHED;
            PG8_STAGE(PG8_SB(0, 1), b2 + hstep, voffB);
            PG8_WAIT_V(6); PG8_BAR; PG8_MMA(1, 1, At, B1); PG8_BAR;
            PG8_LDB(B0, 1, 0); PG8_SCHED; PG8_LDA(At, 1, 0); PG8_STAGE(PG8_SA(0, 1), a2 + hstep, voffA);
            PG8_WAIT_L(8); PG8_BAR; PG8_WAIT_L(0); PG8_MMA(0, 0, At, B0); PG8_BAR; PG8_SCHED;
            PG8_LDB(B1, 1, 1); PG8_STAGE(PG8_SB(1, 0), b3, voffB);
            PG8_BAR; PG8_WAIT_L(0); PG8_MMA(0, 1, At, B1); PG8_BAR;
            PG8_LDA(At, 1, 1); PG8_STAGE(PG8_SA(1, 0), a3, voffA);
            PG8_BAR; PG8_WAIT_L(0); PG8_MMA(1, 0, At, B0); PG8_BAR; PG8_SCHED;
            PG8_STAGE(PG8_SB(1, 1), b3 + hstep, voffB);
            PG8_WAIT_V(6); PG8_BAR; PG8_MMA(1, 1, At, B1); PG8_BAR;
            }
        }
        if constexpr (ALIGN_EPI) { if (wr == 0) PG8_BAR; }
        if constexpr (!Epi::AFTER_DRAIN) { E(acc, cur, wr, wc, fr, fq); S.done(cur); }
        if (!has_next) break;
#pragma unroll
        for (int a = 0; a < 2; ++a)
#pragma unroll
            for (int b = 0; b < 2; ++b)
#pragma unroll
                for (int m = 0; m < 4; ++m)
#pragma unroll
                    for (int n = 0; n < 2; ++n) acc[a][b][m][n] = (f32x4){0.f, 0.f, 0.f, 0.f};
        cur = nxt; cA = nA; cB = nB; ++ui;
        if constexpr (ALIGN_EPI) { if (wr == 1) PG8_BAR; }
    }
    PG8_WAIT_V(0);
    if constexpr (!ALIGN_EPI) { if (wr == 0) PG8_BAR; }
    PG8_BAR;
    if constexpr (Epi::AFTER_DRAIN) { E.fused(acc, cur, wr, wc, fr, fq, lds, wid, lane); S.done(cur); }
#undef PG8_SA
#undef PG8_SB
#undef PG8_STAGE
#undef PG8_LDA
#undef PG8_LDB
#undef PG8_MMA
#undef PG8_WAIT_V
#undef PG8_WAIT_L
#undef PG8_BAR
#undef PG8_SCHED
}
}


#define XB_TMO      128
#define XB_XCNT(j)  (256  + 64 * (j))
#define XB_XSUB(j)  (1280 + 64 * (j))
#define XB_XGEN(j)  (2304 + 64 * (j))
#define XB_TOP      3328
#define XB_TOPGEN   3392
#define XCD_BAR_WORDS 3456
#define XB_SPIN_CAP (1u << 22)
__device__ __forceinline__ unsigned xb_ld(unsigned* p)              { return __hip_atomic_load(p, __ATOMIC_RELAXED, __HIP_MEMORY_SCOPE_AGENT); }
__device__ __forceinline__ unsigned xb_add(unsigned* p, unsigned v) { return __hip_atomic_fetch_add(p, v, __ATOMIC_RELAXED, __HIP_MEMORY_SCOPE_AGENT); }
__device__ __forceinline__ unsigned xb_xcc_id() { return (unsigned)__builtin_amdgcn_s_getreg((3 << 11) | 20) & 0xFu; }
#define XB_SPIN(cond, bar) do { unsigned _sp = 0; while (cond) { __builtin_amdgcn_s_sleep(1); \
    if ((++_sp & 255u) == 0u) { if (xb_ld(&(bar)[XB_TMO])) break; if (_sp > XB_SPIN_CAP) { atomicAdd(&(bar)[XB_TMO], 1u); break; } } } } while (0)
struct XcdBarrier { unsigned* bar; unsigned x; volatile LAS unsigned* st; };
__device__ __forceinline__ XcdBarrier xcd_barrier_post(unsigned* bar, volatile LAS unsigned* st, int tid_in) {
    XcdBarrier b; b.bar = bar; b.x = xb_xcc_id(); b.st = st;
    if (tid_in == 0) (void)xb_add(&bar[XB_XCNT(b.x)], 1u);
    return b;
}
__device__ __forceinline__ void xcd_barrier_complete(unsigned* bar, unsigned x, unsigned& nloc, unsigned& nx) {
    const unsigned G = gridDim.x * gridDim.y * gridDim.z;
    unsigned sum, cnt, mine, sp = 0u;
    for (;;) {
        sum = 0u; cnt = 0u; mine = 0u;
#pragma unroll
        for (unsigned j = 0; j < 16; ++j) { const unsigned c = xb_ld(&bar[XB_XCNT(j)]); sum += c; cnt += (c > 0u) ? 1u : 0u; mine = (j == x) ? c : mine; }
        if (sum == G) break;
        __builtin_amdgcn_s_sleep(1);
        if ((++sp & 255u) == 0u) { if (xb_ld(&bar[XB_TMO])) break; if (sp > XB_SPIN_CAP) { atomicAdd(&bar[XB_TMO], 1u); break; } }
    }
    nloc = mine > 0u ? mine : 1u; nx = cnt > 0u ? cnt : 1u;
}
__device__ __forceinline__ void xcd_barrier(const XcdBarrier& b, int tid_in) {
    asm volatile("s_waitcnt vmcnt(0)" ::: "memory");
    __syncthreads();
    if (tid_in == 0) {
        unsigned* bar = b.bar;
        __builtin_amdgcn_s_waitcnt(0);
        unsigned nloc = b.st[0], nx = b.st[1];
        if (nloc == 0u) { xcd_barrier_complete(bar, b.x, nloc, nx); b.st[0] = nloc; b.st[1] = nx; }
        const unsigned old = xb_add(&bar[XB_XSUB(b.x)], 1u);
        const unsigned gen = old / nloc;
        if (old + 1u == (gen + 1u) * nloc) {
            __builtin_amdgcn_fence(__ATOMIC_RELEASE, "agent");
            asm volatile("s_waitcnt vmcnt(0)" ::: "memory");
            const unsigned og = xb_add(&bar[XB_TOP], 1u);
            const unsigned tg = og / nx;
            if (og + 1u == (tg + 1u) * nx) xb_add(&bar[XB_TOPGEN], 1u);
            else XB_SPIN(xb_ld(&bar[XB_TOPGEN]) == tg, bar);
            __builtin_amdgcn_fence(__ATOMIC_ACQUIRE, "agent");
            xb_add(&bar[XB_XGEN(b.x)], 1u);
            asm volatile("s_waitcnt vmcnt(0)" ::: "memory");
        } else {
            XB_SPIN(xb_ld(&bar[XB_XGEN(b.x)]) == gen, bar);
            __builtin_amdgcn_fence(__ATOMIC_ACQUIRE, "agent");
            asm volatile("s_waitcnt vmcnt(0)" ::: "memory");
        }
    }
    __syncthreads();
}


typedef short bf16x8 __attribute__((ext_vector_type(8)));
typedef short s16x4 __attribute__((ext_vector_type(4)));
typedef float f32x16 __attribute__((ext_vector_type(16)));
typedef unsigned v4u __attribute__((ext_vector_type(4)));
typedef unsigned v2u __attribute__((ext_vector_type(2)));
constexpr int MOE_TILES = NE * 3 * 512;
constexpr float ATT_THR = 5.0f;
template <int DK> struct AttL { static constexpr int KSTR = DK * 2 + 16, KBYTES = 64 * KSTR, VSTR = 136, VBYTES = 64 * VSTR, KPT = 64 * DK / 4 / NTHREADS;
    static constexpr int K_OFF = 0, V_OFF = 2 * KBYTES; };

struct CvArgs { const float* wg; const float* wu; const float* wd; bf16_t* gu; bf16_t* dn; int id0; };
template <int DK, bool CONV>
__device__ __forceinline__ void attn_pass(const bf16_t* Qrow, const bf16_t* Kp, const bf16_t* Vtp, int vt_ld, int nkt, LAS unsigned char* lds, int tid, f32x16 (&oacc)[2], float& l_run, const CvArgs& cvp) {
    typedef AttL<DK> L;
    constexpr bool AUG = DK <= 32;
    const int lane = tid & 63, r = lane & 31, h = lane >> 5;
    bf16x8 qf[DK / 16];
#pragma unroll
    for (int ks = 0; ks < DK / 16; ++ks) qf[ks] = *(const bf16x8*)(Qrow + 16 * ks + 8 * h);
    const short z_ = (short)(tid >> 20);
    bf16x8 aone = {z_, z_, z_, z_, z_, z_, z_, z_}, bneg = {z_, z_, z_, z_, z_, z_, z_, z_};
    if (h == 0) aone[0] = (short)0x3F80;
    float m_run = 0.f;
    v2u kreg[L::KPT]; v4u vreg;
    float cv[8]; const float* csrc = cvp.wg; int cid = 0, cpart = 0;
    { const unsigned zu_ = (unsigned)tid >> 20; const v4u z4_ = {zu_, zu_, zu_, zu_}; const v2u z2_ = {zu_, zu_}; vreg = z4_;
#pragma unroll
      for (int i_ = 0; i_ < L::KPT; ++i_) kreg[i_] = z2_;
#pragma unroll
      for (int i_ = 0; i_ < 8; ++i_) cv[i_] = __uint_as_float(zu_); }
    const int vd = tid >> 3, vpart = tid & 7;
    const unsigned koff = (unsigned)tid * 8u, voff = ((unsigned)vd * (unsigned)vt_ld + (unsigned)vpart * 8u) * 2u, lane4 = (unsigned)lane * 4u;
#define ATT_LOADK(j) do { const char* kb_ = (const char*)Kp + (size_t)(j) * (64 * DK * 2); _Pragma("unroll") for (int i_ = 0; i_ < L::KPT; ++i_) kreg[i_] = *(const v2u*)(kb_ + (koff + (unsigned)i_ * (NTHREADS * 8u))); } while (0)
#define ATT_LOADV(j) do { const char* vb_ = (const char*)Vtp + (size_t)(j) * 128; vreg = *(const v4u*)(vb_ + voff); } while (0)
#define ATT_STOREK(buf) do { _Pragma("unroll") for (int i_ = 0; i_ < L::KPT; ++i_) { const int c_ = tid + i_ * NTHREADS; const int key_ = c_ / (DK / 4), part_ = c_ % (DK / 4); \
            *(LAS v2u*)(lds + L::K_OFF + (buf) * L::KBYTES + key_ * L::KSTR + part_ * 8) = kreg[i_]; } } while (0)
#define ATT_STOREV(buf) do { LAS unsigned char* vp_ = lds + L::V_OFF + (buf) * L::VBYTES + vd * L::VSTR + vpart * 16; *(LAS v2u*)vp_ = (v2u){vreg.x, vreg.y}; *(LAS v2u*)(vp_ + 8) = (v2u){vreg.z, vreg.w}; } while (0)
#define ATT_QK(dst, buf) do { _Pragma("unroll") for (int kb = 0; kb < 2; ++kb) { _Pragma("unroll") for (int i = 0; i < 16; ++i) dst[kb][i] = 0.f; \
        if (AUG) dst[kb] = __builtin_amdgcn_mfma_f32_32x32x16_bf16(aone, bneg, dst[kb], 0, 0, 0); \
        _Pragma("unroll") for (int ks = 0; ks < DK / 16; ++ks) { const bf16x8 a_ = *(const LAS bf16x8*)(lds + L::K_OFF + (buf) * L::KBYTES + (32 * kb + r) * L::KSTR + (16 * ks + 8 * h) * 2); \
            dst[kb] = __builtin_amdgcn_mfma_f32_32x32x16_bf16(a_, qf[ks], dst[kb], 0, 0, 0); } } } while (0)
#define ATT_CV_PRE(R, j) do { if (CONV) { \
        if ((R) == 0) { const int ss_ = min((j) >> 2, 15); cid = min(cvp.id0 + (ss_ >> 2), MOE_TILES - 1); cpart = ss_ & 3; \
            const int mat_ = cid >> 9, tl_ = cid & 511, e_ = mat_ / 3, wh_ = mat_ - 3 * e_; \
            csrc = (wh_ == 0 ? cvp.wg : wh_ == 1 ? cvp.wu : cvp.wd) + (size_t)e_ * D * FF + (size_t)((tl_ >> 4) * 32 + 8 * cpart) * 1024 + (tl_ & 15) * 64; } \
        constexpr int i0_ = (R) == 0 ? 0 : (R) == 1 ? 3 : 6, i1_ = (R) == 0 ? 3 : (R) == 1 ? 6 : (R) == 2 ? 8 : 6; \
        _Pragma("unroll") for (int i_ = i0_; i_ < i1_; ++i_) cv[i_] = *(const float*)((const char*)csrc + (size_t)i_ * 4096 + lane4); } } while (0)
#define ATT_CV_POST(R) do { if (CONV && (R) == 3) { \
        const int mat_ = cid >> 9, tl_ = cid & 511, e_ = mat_ / 3, wh_ = mat_ - 3 * e_, n_ = (tl_ & 15) * 64 + lane; \
        const int row_ = wh_ == 2 ? n_ : ((n_ >> 2) * 8 + (n_ & 3) + 4 * wh_); \
        char* db_ = (char*)(wh_ == 2 ? cvp.dn + (size_t)e_ * D * FF : cvp.gu + (size_t)e_ * 2 * FF * D) + ((tl_ >> 4) * 32 + 8 * cpart) * 2; \
        *(uint4*)(db_ + (unsigned)row_ * 2048u) = make_uint4(pk2(cv[0], cv[1]), pk2(cv[2], cv[3]), pk2(cv[4], cv[5]), pk2(cv[6], cv[7])); } } while (0)
#define ATT_BODY(SC, SN, j, CHK, R) do { \
        ATT_LOADK(min((j) + 2, nkt - 1));                   \
        ATT_LOADV(min((j) + 1, nkt - 1)); \
        ATT_CV_PRE(R, j); \
        ATT_QK(SN, ((j) + 1) & 1);                          \
        if (CHK) { \
            float t0 = fmaxf(fmaxf(SC[0][0], SC[0][1]), SC[0][2]), t1 = fmaxf(fmaxf(SC[0][3], SC[0][4]), SC[0][5]), t2 = fmaxf(fmaxf(SC[0][6], SC[0][7]), SC[0][8]), t3 = fmaxf(fmaxf(SC[0][9], SC[0][10]), SC[0][11]); \
            float t4 = fmaxf(fmaxf(SC[0][12], SC[0][13]), SC[0][14]), t5 = fmaxf(fmaxf(SC[0][15], SC[1][0]), SC[1][1]), t6 = fmaxf(fmaxf(SC[1][2], SC[1][3]), SC[1][4]), t7 = fmaxf(fmaxf(SC[1][5], SC[1][6]), SC[1][7]); \
            float t8 = fmaxf(fmaxf(SC[1][8], SC[1][9]), SC[1][10]), t9 = fmaxf(fmaxf(SC[1][11], SC[1][12]), SC[1][13]), t10 = fmaxf(SC[1][14], SC[1][15]); \
            float tmax = fmaxf(fmaxf(fmaxf(fmaxf(t0, t1), t2), fmaxf(fmaxf(t3, t4), t5)), fmaxf(fmaxf(fmaxf(t6, t7), t8), fmaxf(t9, t10))); \
            tmax = xor32_max(tmax); if (!AUG) tmax -= m_run;            \
            if ((j) == 0 || __any(tmax > ATT_THR)) {                   \
                const float want = (j) == 0 ? tmax : m_run + fmaxf(tmax, 0.f); \
                const float mn = __uint_as_float(pk2(want, 0.f) << 16), dlt = mn - m_run, alpha = __builtin_amdgcn_exp2f(-dlt); \
                _Pragma("unroll") for (int i = 0; i < 16; ++i) { oacc[0][i] *= alpha; oacc[1][i] *= alpha; if (AUG) { SC[0][i] -= dlt; SC[1][i] -= dlt; SN[0][i] -= dlt; SN[1][i] -= dlt; } } \
                l_run *= alpha; m_run = mn; if (AUG && h == 0) bneg[0] = (short)(__float_as_uint(-mn) >> 16); \
            } \
        } \
        float ps0 = 0.f, ps1 = 0.f, ps2 = 0.f, ps3 = 0.f; \
        _Pragma("unroll") for (int kb = 0; kb < 2; ++kb) \
            _Pragma("unroll") for (int i = 0; i < 16; i += 4) { const float mo = AUG ? 0.f : m_run; const float p0 = __builtin_amdgcn_exp2f(SC[kb][i] - mo), p1 = __builtin_amdgcn_exp2f(SC[kb][i + 1] - mo), p2 = __builtin_amdgcn_exp2f(SC[kb][i + 2] - mo), p3 = __builtin_amdgcn_exp2f(SC[kb][i + 3] - mo); \
                SC[kb][i] = p0; SC[kb][i + 1] = p1; SC[kb][i + 2] = p2; SC[kb][i + 3] = p3; ps0 += p0; ps1 += p1; ps2 += p2; ps3 += p3; } \
        l_run += (ps0 + ps1) + (ps2 + ps3); \
        _Pragma("unroll") for (int kb = 0; kb < 2; ++kb) \
            _Pragma("unroll") for (int s2 = 0; s2 < 2; ++s2) { \
                union { bf16x8 v; unsigned u[4]; } pf; \
                _Pragma("unroll") for (int i = 0; i < 4; ++i) pf.u[i] = pk2(SC[kb][8 * s2 + 2 * i], SC[kb][8 * s2 + 2 * i + 1]); \
                _Pragma("unroll") for (int db = 0; db < 2; ++db) { \
                    const LAS unsigned char* vp = lds + L::V_OFF + ((j) & 1) * L::VBYTES + (32 * db + r) * L::VSTR + (32 * kb + 16 * s2 + 4 * h) * 2; \
                    union { bf16x8 v; v2u u[2]; } af; af.u[0] = *(const LAS v2u*)vp; af.u[1] = *(const LAS v2u*)(vp + 16); \
                    oacc[db] = __builtin_amdgcn_mfma_f32_32x32x16_bf16(af.v, pf.v, oacc[db], 0, 0, 0); } } \
        ATT_STOREK((j) & 1);               \
        ATT_STOREV(((j) + 1) & 1);         \
        ATT_CV_POST(R); \
        __syncthreads(); \
    } while (0)
    __syncthreads();
    { v2u k1_[L::KPT]; ATT_LOADK(0); ATT_LOADV(0);
#pragma unroll
      for (int i_ = 0; i_ < L::KPT; ++i_) k1_[i_] = *(const v2u*)((const char*)Kp + (size_t)(64 * DK * 2) + (koff + (unsigned)i_ * (NTHREADS * 8u)));
      ATT_STOREK(0); ATT_STOREV(0);
#pragma unroll
      for (int i_ = 0; i_ < L::KPT; ++i_) kreg[i_] = k1_[i_];
      ATT_STOREK(1); }
    __syncthreads();
    f32x16 sa[2], sb[2];
#pragma unroll
    for (int i = 0; i < 16; ++i) { sb[0][i] = (float)z_; sb[1][i] = (float)z_; }
    ATT_QK(sa, 0);
    __syncthreads();
    if (CONV) {
        for (int j = 0; j < nkt; j += 4) {
            ATT_BODY(sa, sb, j, true, 0);
            ATT_BODY(sb, sa, j + 1, false, 1);
            ATT_BODY(sa, sb, j + 2, false, 2);
            ATT_BODY(sb, sa, j + 3, false, 3);
        }
    } else {
        for (int j = 0; j < nkt; j += 2) {
            ATT_BODY(sa, sb, j, ((j & 3) == 0), -1);
            ATT_BODY(sb, sa, j + 1, false, -1);
        }
    }
#undef ATT_BODY
#undef ATT_CV_PRE
#undef ATT_CV_POST
#undef ATT_LOADK
#undef ATT_LOADV
#undef ATT_STOREK
#undef ATT_STOREV
#undef ATT_QK
}


constexpr int SLD = 65, SHLD = 72, XTLD = 132;
__device__ __forceinline__ int rm32(int t, int h) { return (t & 3) + 8 * (t >> 2) + 4 * h; }
template <bool WITH_Y>
__device__ __forceinline__ void ssd_block(int b, int dir, int k, int hp, const bf16_t* xbc, const float* dtp, const float* alog, float* hs, float* alast, bf16_t* yd, float* lds, int tid) {
    const bool lat = k >= 2; const int c = lat ? (dir ? 33 - k : k - 2) : (dir ? 1 - k : k);
    const int row0 = tok_row(lat, b, c * 128), g = hp >> 1;
    float* sB = lds; bf16_t* sBh = (bf16_t*)lds; bf16_t* sCh = sBh + 128 * SHLD;
    float* sX = WITH_Y ? lds + (2 * 128 * SHLD * 2) / 4 : sB + 128 * SLD; bf16_t* sXT = (bf16_t*)sX;
    float* sDT = sX + 128 * 128; float* sCum = sDT + 256; float* sW = sCum + 256; float* sSc = sW + 256;
    const int wave = tid >> 6, lane = tid & 63, r = lane & 31, h = lane >> 5, hl = wave >> 2, head = 2 * hp + hl;
    float* hsp = hs + (((size_t)(b * 2 + dir) * NCH + k) * 8 + head) * 4096;
    union { bf16x8 v; unsigned u[4]; } hfrag[WITH_Y ? 8 : 1];
    if (WITH_Y) {
#pragma unroll
        for (int Pb = 0; Pb < 2; ++Pb)
#pragma unroll
            for (int ks = 0; ks < 4; ++ks) { const float4 x0 = *(const float4*)(hsp + (32 * Pb + r) * 64 + 16 * ks + 8 * h), x1 = *(const float4*)(hsp + (32 * Pb + r) * 64 + 16 * ks + 8 * h + 4);
                hfrag[Pb * 4 + ks].u[0] = pk2(x0.x, x0.y); hfrag[Pb * 4 + ks].u[1] = pk2(x0.z, x0.w); hfrag[Pb * 4 + ks].u[2] = pk2(x1.x, x1.y); hfrag[Pb * 4 + ks].u[3] = pk2(x1.z, x1.w); }
    }
    uint2 vb[8]; float4 vx[8]; float dx[8]; float dtv = 0.f, dav = 0.f;
#pragma unroll
    for (int u = 0; u < 8; ++u) { const int i = tid + u * NTHREADS, t = i >> 5, c4 = i & 31;
        vb[u] = *(const uint2*)(xbc + (size_t)(row0 + t) * 768 + 512 + (c4 >> 4) * 128 + g * 64 + (c4 & 15) * 4);
        vx[u] = ld4h(xbc + (size_t)(row0 + t) * 768 + hp * 128 + c4 * 4);
        dx[u] = dtp[(size_t)(row0 + t) * 16 + dir * 8 + 2 * hp + (c4 >> 4)]; }
    if (tid < 256) { const int hl = tid >> 7, t = tid & 127, h = 2 * hp + hl; dtv = dtp[(size_t)(row0 + t) * 16 + dir * 8 + h]; dav = dtv * -expf(alog[dir * 8 + h]); }
    __syncthreads();
#pragma unroll
    for (int u = 0; u < 8; ++u) { const int i = tid + u * NTHREADS, t = i >> 5, c4 = i & 31;
        if (WITH_Y) *(uint2*)((c4 >> 4 ? sCh : sBh) + t * SHLD + (c4 & 15) * 4) = vb[u];
        else if (!(c4 >> 4)) { const float4 f = up4(vb[u]); float* d = sB + t * SLD + (c4 & 15) * 4; d[0] = f.x; d[1] = f.y; d[2] = f.z; d[3] = f.w; }
        if (WITH_Y) { const float4 xs = f4scale(vx[u], dx[u]); sXT[(c4 * 4 + 0) * XTLD + t] = (bf16_t)(pk2(xs.x, 0.f)); sXT[(c4 * 4 + 1) * XTLD + t] = (bf16_t)(pk2(xs.y, 0.f)); sXT[(c4 * 4 + 2) * XTLD + t] = (bf16_t)(pk2(xs.z, 0.f)); sXT[(c4 * 4 + 3) * XTLD + t] = (bf16_t)(pk2(xs.w, 0.f)); }
        else *(float4*)(sX + t * 128 + c4 * 4) = f4scale(vx[u], dx[u]); }
    if (tid < 256) { const int t = tid & 127; sSc[(tid & 128) + (dir ? 127 - t : t)] = dav; }
    __syncthreads();
    for (int off = 1; off < 128; off <<= 1) { float v = 0.f; const int sI = tid & 127;
        if (tid < 256) { v = sSc[tid]; if (sI >= off) v += sSc[tid - off]; }
        __syncthreads(); if (tid < 256) sSc[tid] = v; __syncthreads(); }
    if (tid < 256) { const int hl = tid >> 7, sI = tid & 127, t = dir ? 127 - sI : sI; const float cu = sSc[tid], tot = sSc[hl * 128 + 127];
        sCum[hl * 128 + t] = cu; sW[hl * 128 + t] = expf(tot - cu);
        if (!WITH_Y && sI == 127) alast[((size_t)(b * 2 + dir) * NCH + k) * 8 + 2 * hp + hl] = tot; }
    __syncthreads();
    if (WITH_Y) {
        const int I = hl ? 3 - (wave & 3) : (wave & 3), ti = 32 * I + r;
        const float cum_i = sCum[hl * 128 + ti];
        f32x16 Y[2], Yo[2];
#pragma unroll
        for (int i = 0; i < 16; ++i) { Y[0][i] = 0.f; Y[1][i] = 0.f; Yo[0][i] = 0.f; Yo[1][i] = 0.f; }
        bf16x8 cfrag[4];
#pragma unroll
        for (int ks = 0; ks < 4; ++ks) cfrag[ks] = *(const bf16x8*)(sCh + (32 * I + r) * SHLD + 16 * ks + 8 * h);
#pragma unroll
        for (int Pb = 0; Pb < 2; ++Pb)
#pragma unroll
            for (int ks = 0; ks < 4; ++ks) Yo[Pb] = __builtin_amdgcn_mfma_f32_32x32x16_bf16(hfrag[Pb * 4 + ks].v, cfrag[ks], Yo[Pb], 0, 0, 0);
        const int J0 = dir ? I : 0, J1 = dir ? 3 : I;
        for (int J = J0; J <= J1; ++J) {
            f32x16 Gt;
#pragma unroll
            for (int i = 0; i < 16; ++i) Gt[i] = 0.f;
#pragma unroll
            for (int ks = 0; ks < 4; ++ks) Gt = __builtin_amdgcn_mfma_f32_32x32x16_bf16(*(const bf16x8*)(sBh + (32 * J + r) * SHLD + 16 * ks + 8 * h), cfrag[ks], Gt, 0, 0, 0);
#pragma unroll
            for (int t = 0; t < 16; ++t) { const int tj = 32 * J + rm32(t, h); const bool valid = (J != I) || (dir ? tj >= ti : tj <= ti);
                Gt[t] *= valid ? __expf(cum_i - sCum[hl * 128 + tj]) : 0.f; }
#pragma unroll
            for (int s2 = 0; s2 < 2; ++s2) {
                union { bf16x8 v; unsigned u[4]; } pf;
#pragma unroll
                for (int i = 0; i < 4; ++i) pf.u[i] = pk2(Gt[8 * s2 + 2 * i], Gt[8 * s2 + 2 * i + 1]);
#pragma unroll
                for (int Pb = 0; Pb < 2; ++Pb) {
                    const bf16_t* xp = sXT + (hl * 64 + 32 * Pb + r) * XTLD + 32 * J + 16 * s2 + 4 * h;
                    union { bf16x8 v; uint2 u[2]; } af; af.u[0] = *(const uint2*)xp; af.u[1] = *(const uint2*)(xp + 8);
                    Y[Pb] = __builtin_amdgcn_mfma_f32_32x32x16_bf16(af.v, pf.v, Y[Pb], 0, 0, 0);
                }
            }
        }
        const float ei = __expf(cum_i);
        bf16_t* yrow = yd + ((size_t)dir * NTOK + row0 + ti) * 512 + head * 64;
#pragma unroll
        for (int Pb = 0; Pb < 2; ++Pb)
#pragma unroll
            for (int tq = 0; tq < 4; ++tq)
                *(uint2*)(yrow + 32 * Pb + 8 * tq + 4 * h) = pk4(make_float4(Y[Pb][4 * tq] + ei * Yo[Pb][4 * tq], Y[Pb][4 * tq + 1] + ei * Yo[Pb][4 * tq + 1], Y[Pb][4 * tq + 2] + ei * Yo[Pb][4 * tq + 2], Y[Pb][4 * tq + 3] + ei * Yo[Pb][4 * tq + 3]));
    } else {
        const int Pb = (wave >> 1) & 1, Nb = wave & 1;
        f32x16 acc;
#pragma unroll
        for (int i = 0; i < 16; ++i) acc[i] = 0.f;
#pragma unroll 8
        for (int ks = 0; ks < 64; ++ks) { const int j = 2 * ks + h;
            acc = __builtin_amdgcn_mfma_f32_32x32x2f32(sX[j * 128 + hl * 64 + 32 * Pb + r] * sW[hl * 128 + j], sB[j * SLD + 32 * Nb + r], acc, 0, 0, 0); }
#pragma unroll
        for (int t = 0; t < 16; ++t) hsp[(32 * Pb + rm32(t, h)) * 64 + 32 * Nb + r] = acc[t];
    }
}

template <class RM>
__device__ __forceinline__ void cvt_tile(const float* src, int N, bf16_t* dst, int ldd, RM rowmap, int k0, int n0, int lane) {
    const int n = n0 + lane;
    if (n < N) {
        const float* sp = src + (size_t)k0 * N + n;
        float v[32];
#pragma unroll
        for (int kk = 0; kk < 32; ++kk) v[kk] = sp[(size_t)kk * N];
        uint4* dp = (uint4*)(dst + (size_t)rowmap(n) * ldd + k0);
#pragma unroll
        for (int i = 0; i < 4; ++i) dp[i] = make_uint4(pk2(v[8 * i], v[8 * i + 1]), pk2(v[8 * i + 2], v[8 * i + 3]), pk2(v[8 * i + 4], v[8 * i + 5]), pk2(v[8 * i + 6], v[8 * i + 7]));
    }
}
__device__ __forceinline__ int block_excl_scan(int v, int tid, volatile int* sh, int& total) {
    const int lane = tid & 63, wave = tid >> 6; int x = v;
    x += __builtin_amdgcn_update_dpp(0, x, 0x111, 0xf, 0xf, true); x += __builtin_amdgcn_update_dpp(0, x, 0x112, 0xf, 0xf, true);
    x += __builtin_amdgcn_update_dpp(0, x, 0x114, 0xf, 0xf, true); x += __builtin_amdgcn_update_dpp(0, x, 0x118, 0xf, 0xf, true);
    x += __builtin_amdgcn_update_dpp(0, x, 0x142, 0xa, 0xf, false); x += __builtin_amdgcn_update_dpp(0, x, 0x143, 0xc, 0xf, false);
    __syncthreads();
    if (lane == 63) sh[wave] = x;
    __syncthreads();
    int off = 0, tot = 0;
#pragma unroll
    for (int w = 0; w < 8; ++w) { const int c = sh[w]; tot += c; if (w < wave) off += c; }
    total = tot;
    return off + x - v;
}
__device__ __forceinline__ int block_sum(int v, int tid, volatile int* sh, int parity) {
    const int lane = tid & 63, wave = tid >> 6;
    v += __builtin_amdgcn_update_dpp(0, v, 0x111, 0xf, 0xf, true); v += __builtin_amdgcn_update_dpp(0, v, 0x112, 0xf, 0xf, true);
    v += __builtin_amdgcn_update_dpp(0, v, 0x114, 0xf, 0xf, true); v += __builtin_amdgcn_update_dpp(0, v, 0x118, 0xf, 0xf, true);
    v += __builtin_amdgcn_update_dpp(0, v, 0x142, 0xa, 0xf, false); v += __builtin_amdgcn_update_dpp(0, v, 0x143, 0xc, 0xf, false);
    if (lane == 63) sh[parity * 8 + wave] = v;
    __syncthreads();
    int tot = 0;
#pragma unroll
    for (int w = 0; w < 8; ++w) tot += sh[parity * 8 + w];
    return tot;
}

#define MOD ((float*)(kp_->ws + WS_MOD))
#define CTXC ((float*)(kp_->ws + WS_CTXC))
#define AFF ((float*)(kp_->ws + WS_AFF))
#define TOKSLOT ((int*)(kp_->ws + WS_TOKSLOT))
#define SELIDX ((int*)(kp_->ws + WS_SELIDX))
#define SELGATE ((float*)(kp_->ws + WS_SELGATE))
#define DT ((float*)(kp_->ws + WS_DT))
#define HB ((bf16_t*)(kp_->ws + WS_HB))
#define HS ((float*)(kp_->ws + WS_HS))
#define YD ((bf16_t*)(kp_->ws + WS_YD))
#define ALAST ((float*)(kp_->ws + WS_ALAST))
#define ROPE ((float*)(kp_->ws + WS_ROPE))
#define PB ((bf16_t*)(kp_->ws + WS_P))
#define XBC ((bf16_t*)(kp_->ws + WS_XBC))
#define MQ ((bf16_t*)(kp_->ws + WS_MQ))
#define MKV ((bf16_t*)(kp_->ws + WS_MKV))
#define CQB ((bf16_t*)(kp_->ws + WS_CQB))
#define CKVB ((bf16_t*)(kp_->ws + WS_CKVB))
#define MIXB ((bf16_t*)(kp_->ws + WS_MIXB))
#define MOUT ((bf16_t*)(kp_->ws + WS_MOUT))
#define XG ((bf16_t*)(kp_->ws + WS_XG))
#define HID ((bf16_t*)(kp_->ws + WS_HID))
#define Y ((bf16_t*)(kp_->ws + WS_Y))
#define WIN_T ((bf16_t*)(kp_->ws + WS_WIN))
#define WQ_T ((bf16_t*)(kp_->ws + WS_WQ))
#define WKV_T ((bf16_t*)(kp_->ws + WS_WKV))
#define WOUT_T ((bf16_t*)(kp_->ws + WS_WOUT))
#define WGU_T ((bf16_t*)(kp_->ws + WS_WGU))
#define WD_T ((bf16_t*)(kp_->ws + WS_WD))
#define QD ((bf16_t*)(kp_->ws + WS_QD))
#define QDC ((bf16_t*)(kp_->ws + WS_QDC))
#define KD ((bf16_t*)(kp_->ws + WS_KD))
#define VDT ((bf16_t*)(kp_->ws + WS_VDT))
#define QM ((bf16_t*)(kp_->ws + WS_QM))
#define QMC ((bf16_t*)(kp_->ws + WS_QMC))
#define KM ((bf16_t*)(kp_->ws + WS_KM))
#define VMT ((bf16_t*)(kp_->ws + WS_VMT))
#define xcur (kp_->out)
#define XRB ((bf16_t*)(kp_->ws + WS_XRB))
#define XRAW(q) up4(make_uint2(__float_as_uint((q).x), __float_as_uint((q).y)))
#define DTMP XBC
#define modl (MOD + (size_t)l * (NB + 1) * NMOD * D)
typedef const __attribute__((address_space(4))) Prm* KPrm;
#define PHASE_BEGIN() KPrm kp_ = (KPrm)__builtin_amdgcn_kernarg_segment_ptr(); asm volatile("" : "+s"(kp_)); int tid = MK_TID(); asm volatile("" : "+v"(tid)); (void)tid
#define GSYNC() do { XcdBarrier b_; b_.bar = (unsigned*)(kp_->ws + WS_CTL); b_.x = xb_xcc_id(); b_.st = (volatile LAS unsigned*)(ldsb + LDS_BYTES - 64); int t_ = MK_TID(); asm volatile("" : "+v"(t_)); xcd_barrier(b_, t_); } while (0)
#define CVT_MOE_RANGE(LW, ID0, ID1, SLOT, NSLOTS) do { const int lane_ = tid & 63; \
        for (int id = (ID0) + (SLOT); id < (ID1); id += (NSLOTS)) { \
            const int mat = id >> 9, tl = id & 511, e = mat / 3, which = mat % 3, k0 = (tl >> 4) * 32, n0 = (tl & 15) * 64; \
            if (which == 0) cvt_tile(kp_->in[I_WG] + ((size_t)(LW) * NE + e) * D * FF, FF, WGU_T + (size_t)e * 2 * FF * D, D, [](int n) { return (n >> 2) * 8 + (n & 3); }, k0, n0, lane_); \
            else if (which == 1) cvt_tile(kp_->in[I_WU] + ((size_t)(LW) * NE + e) * D * FF, FF, WGU_T + (size_t)e * 2 * FF * D, D, [](int n) { return (n >> 2) * 8 + 4 + (n & 3); }, k0, n0, lane_); \
            else cvt_tile(kp_->in[I_WD] + ((size_t)(LW) * NE + e) * FF * D, D, WD_T + (size_t)e * D * FF, FF, [](int n) { return n; }, k0, n0, lane_); } } while (0)
constexpr int CVT_PER_WAVE = 4;
__global__ void __launch_bounds__(NTHREADS, 2) mk_forward(Prm p) {
    extern __shared__ __attribute__((aligned(16))) unsigned char lds_raw[];
    LAS unsigned char* const ldsb = (LAS unsigned char*)lds_raw;
    volatile LAS unsigned* st = (volatile LAS unsigned*)(ldsb + LDS_BYTES - 64);
    const int wave_s = __builtin_amdgcn_readfirstlane((int)threadIdx.x >> 6);
#define MK_TID() mk_tid_impl(wave_s)
    if (MK_TID() < 16) st[MK_TID()] = 0u;
    __syncthreads();
    (void)xcd_barrier_post((unsigned*)(p.ws + WS_CTL), st, MK_TID());
    const int G = gridDim.x, bid = blockIdx.x;
    const int vcu = (G % 8 == 0) ? (bid % 8) * (G / 8) + bid / 8 : bid;

    {
        PHASE_BEGIN();
        const float* c = kp_->in[I_C]; const float* cc = kp_->in[I_CCTX]; const float* adaw = kp_->in[I_ADAW]; const float* adab = kp_->in[I_ADAB];
        float* sc_l = (float*)lds_raw;
        for (int i = tid; i < (NB + 1) * D; i += NTHREADS) { const int r = i / D, k = i % D; sc_l[i] = siluf(r < NB ? c[(size_t)r * D + k] : cc[k]); }
        __syncthreads();
        {
            float* red = sc_l + (NB + 1) * D;
            const int lane = tid & 63, wv = tid >> 6;
            for (int it = bid; it < DEPTH * (NMOD * D / 64); it += G) {
                const int l = it / (NMOD * D / 64), j = (it % (NMOD * D / 64)) * 64 + lane;
                const float* w = adaw + ((size_t)l * D + wv * 128) * NMOD * D + j;
                float a0 = 0.f, a1 = 0.f, a2 = 0.f, a3 = 0.f, a4 = 0.f;
#pragma unroll 8
                for (int k = 0; k < 128; ++k) { const float wk = w[(size_t)k * NMOD * D]; const int kk = wv * 128 + k;
                    a0 += sc_l[kk] * wk; a1 += sc_l[D + kk] * wk; a2 += sc_l[2 * D + kk] * wk; a3 += sc_l[3 * D + kk] * wk; a4 += sc_l[4 * D + kk] * wk; }
                __syncthreads();
                red[(wv * 5 + 0) * 64 + lane] = a0; red[(wv * 5 + 1) * 64 + lane] = a1; red[(wv * 5 + 2) * 64 + lane] = a2; red[(wv * 5 + 3) * 64 + lane] = a3; red[(wv * 5 + 4) * 64 + lane] = a4;
                __syncthreads();
                if (tid < 5 * 64) { const int r = tid >> 6; float acc = adab[l * NMOD * D + j - lane + (tid & 63)];
#pragma unroll
                    for (int q = 0; q < 8; ++q) acc += red[(q * 5 + r) * 64 + (tid & 63)];
                    MOD[((size_t)l * (NB + 1) + r) * NMOD * D + (j - lane) + (tid & 63)] = acc; }
            }
        }
        ITEMS(i, S * 16) {
            const int t = i >> 4, w = i & 15, ii = w & 7; const float pos = (float)(w < 8 ? t / GRID_W : t % GRID_W);
            const float ang = pos * powf(10000.0f, -(float)ii / 8.0f);
            ROPE[(size_t)t * 32 + (w < 8 ? 0 : 16) + ii] = cosf(ang); ROPE[(size_t)t * 32 + (w < 8 ? 8 : 24) + ii] = sinf(ang);
        }
        GSYNC();
    }

#pragma unroll 1
    for (int l = 0; l < DEPTH; ++l) {
        const bool ctx_out = l < DEPTH - 1;
        const float lambda_init = 0.8f - 0.6f * expf(-0.3f * (float)l);
        const int nrows_out = ctx_out ? NTOK : NLAT;
        const int ER = ctx_out ? ER_MAX : NB * CAP_L;
        int moe_done = 0;

        {
            PHASE_BEGIN();
            {
                const int lane = tid & 63; auto idm = [](int n) { return n; };
                constexpr int T_WIN = (D / 32) * ((IN_COLS + 63) / 64), T_WQ = (192 / 32) * (384 / 64), T_WKV = (128 / 32) * (512 / 64), T_WOUT = (MIXW / 32) * (D / 64);
                WITEMS(id, T_WIN + T_WQ + T_WKV + T_WOUT) {
                    if (id < T_WIN) { const int nt = (IN_COLS + 63) / 64; cvt_tile(kp_->in[I_WIN] + (size_t)l * D * IN_COLS, IN_COLS, WIN_T, D, idm, (id / nt) * 32, (id % nt) * 64, lane); }
                    else if (id < T_WIN + T_WQ) { const int u = id - T_WIN; cvt_tile(kp_->in[I_WQUP] + (size_t)l * 192 * 384, 384, WQ_T, 256, idm, (u / 6) * 32, (u % 6) * 64, lane); }
                    else if (id < T_WIN + T_WQ + T_WKV) { const int u = id - T_WIN - T_WQ; cvt_tile(kp_->in[I_WKVUP] + (size_t)l * 128 * 512, 512, WKV_T, 128, idm, (u / 8) * 32, (u % 8) * 64, lane); }
                    else { const int u = id - T_WIN - T_WQ - T_WKV; cvt_tile(kp_->in[I_WOUT] + (size_t)l * MIXW * D, D, WOUT_T, MIXW, idm, (u / 16) * 32, (u % 16) * 64, lane); }
                }
            }
            { const unsigned zz_ = (unsigned)tid >> 20; const uint4 z4_ = make_uint4(zz_, zz_, zz_, zz_);
            ITEMS(i, (IN_PAD - IN_COLS) * D / 8) ((uint4*)(WIN_T + (size_t)IN_COLS * D))[i] = z4_;
            ITEMS(i, 128 * 256 / 8) ((uint4*)(WQ_T + (size_t)384 * 256))[i] = z4_;
            ITEMS(i, 384 * 8) { const int r = i >> 3, c8 = i & 7; *(uint4*)(WQ_T + (size_t)r * 256 + 192 + c8 * 8) = z4_; } }

            const float* w = kp_->in[I_NMPRE] + l * D;
            const int lane = tid & 63;
            {
                float4 xq[4];
                { const float zf_ = (float)(tid >> 20);
#pragma unroll
                  for (int i = 0; i < 4; ++i) xq[i] = make_float4(zf_, zf_, zf_, zf_); }
                float4* aux = (float4*)lds_raw;
                __syncthreads();
                for (int i = tid; i < 11 * (D / 4); i += NTHREADS) { const int v = i / (D / 4), k4 = i % (D / 4);
                    const float* src = v == 0 ? w : modl + (size_t)((v - 1) % 5) * NMOD * D + ((v - 1) / 5) * D;
                    aux[i] = ((const float4*)src)[k4]; }
                __syncthreads();
                const int wstride = gridDim.x * 8; int r = blockIdx.x * 8 + (tid >> 6);
#define P1_LOAD(rr) do { if (l == 0) { const float4* src_ = (const float4*)((rr) < NLAT ? kp_->in[I_X] + (size_t)(rr) * D : kp_->in[I_CTX] + (size_t)((rr) - NLAT) * D); _Pragma("unroll") for (int i = 0; i < 4; ++i) xq[i] = src_[i * 64 + lane]; } \
                    else { const uint2* s_ = (const uint2*)(XRB + (size_t)(rr) * D); _Pragma("unroll") for (int i = 0; i < 4; ++i) { const uint2 u_ = s_[i * 64 + lane]; xq[i].x = __uint_as_float(u_.x); xq[i].y = __uint_as_float(u_.y); } } } while (0)
                if (r < NTOK) P1_LOAD(r);
                for (; r < NTOK; r += wstride) {
                    const int bsel = r < NLAT ? r / S : NB;
                    float4 v[4]; float ss = 0.f;
#pragma unroll
                    for (int i = 0; i < 4; ++i) { v[i] = l == 0 ? xq[i] : XRAW(xq[i]); ss += f4dot(v[i], v[i]); }
                    if (r + wstride < NTOK) P1_LOAD(r + wstride);
                    ss = wave_sum(ss);
                    const float rs = 1.0f / sqrtf(ss / D + EPS);
#pragma unroll
                    for (int i = 0; i < 4; ++i) { const int k4 = i * 64 + lane; const float4 w4 = aux[k4], sc = aux[(6 + bsel) * (D / 4) + k4], sh = aux[(1 + bsel) * (D / 4) + k4];
                        const float4 o = make_float4(v[i].x * rs * w4.x * (1.0f + sc.x) + sh.x, v[i].y * rs * w4.y * (1.0f + sc.y) + sh.y, v[i].z * rs * w4.z * (1.0f + sc.z) + sh.z, v[i].w * rs * w4.w * (1.0f + sc.w) + sh.w);
                        *(uint2*)(HB + (size_t)r * D + k4 * 4) = pk4(o); }
                }
#undef P1_LOAD
            }
            GSYNC();
        }
        {
            PHASE_BEGIN();
            pg8::Gemm g{HB, WIN_T, NTOK, IN_PAD, D, 0, 0}; pg8::StaticOrder so; so.init(NTOK, IN_PAD, G, bid);
            pg8::EpiBf16 E{PB, IN_COLS, IN_COLS};
            pg8::gemm_phase<pg8::EpiBf16, pg8::StaticOrder, true, true>(ldsb, g, so, E, tid);
            { const int nwg = (NTOK / 256) * (IN_PAD / 256), busy = nwg % G;
              if (busy != 0 && bid >= busy) CVT_MOE_RANGE(l, 0, (G - busy) * 8 * CVT_PER_WAVE, (bid - busy) * 8 + (tid >> 6), (G - busy) * 8);
              moe_done = busy != 0 ? (G - busy) * 8 * CVT_PER_WAVE : 0; }
            GSYNC();
        }
        {
            PHASE_BEGIN();
            const float* cw = kp_->in[I_CONVW] + (size_t)l * 3 * 768; const float* cb = kp_->in[I_CONVB] + (size_t)l * 768;
            {
                float* cwl = (float*)lds_raw;
                __syncthreads();
                for (int i = tid; i < 4 * 768; i += NTHREADS) cwl[i] = i < 3 * 768 ? cw[i] : cb[i - 3 * 768];
                __syncthreads();
                const int stride = gridDim.x * NTHREADS;
                for (int i0 = blockIdx.x * NTHREADS + tid; i0 < NTOK * 192; i0 += 4 * stride) {
                    uint2 u0[4], um[4], up[4];
#pragma unroll
                    for (int q = 0; q < 4; ++q) { const int i = i0 + q * stride; const unsigned z_ = (unsigned)tid >> 20; u0[q] = make_uint2(z_, z_); um[q] = u0[q]; up[q] = u0[q];
                        if (i < NTOK * 192) { const int c = (i % 192) * 4, r = i / 192; const bool lat = r < NLAT; const int L = lat ? S : CTX; const int t = lat ? r % S : (r - NLAT) % CTX;
                            const bf16_t* u = PB + (size_t)r * IN_COLS + C_XBC + c; u0[q] = *(const uint2*)u; if (t > 0) um[q] = *(const uint2*)(u - IN_COLS); if (t < L - 1) up[q] = *(const uint2*)(u + IN_COLS); } }
#pragma unroll
                    for (int q = 0; q < 4; ++q) { const int i = i0 + q * stride;
                        if (i < NTOK * 192) { const int c = (i % 192) * 4, r = i / 192;
                            float4 acc = f4add(*(const float4*)(cwl + 3 * 768 + c), f4mul(*(const float4*)(cwl + 768 + c), up4(u0[q])));
                            acc = f4add(acc, f4mul(*(const float4*)(cwl + c), up4(um[q]))); acc = f4add(acc, f4mul(*(const float4*)(cwl + 2 * 768 + c), up4(up[q])));
                            *(uint2*)(XBC + (size_t)r * 768 + c) = pk4(make_float4(siluf(acc.x), siluf(acc.y), siluf(acc.z), siluf(acc.w))); } }
                }
            }
            const float* dtb = kp_->in[I_DTB] + l * 16;
            ITEMS(i, NTOK * 16) { const int j = i % 16, r = i / 16; DT[i] = softplusf(bf2f(PB[(size_t)r * IN_COLS + C_DT + j]) + dtb[j]); }
            ITEMS(i, NTOK * 16) {
                const int g = i & 15, r = i >> 4; const int hm = g & 7, isk = g >> 3;
                const bool lat = r < NLAT; const int b = lat ? r / S : (r - NLAT) / CTX, t = lat ? r % S : (r - NLAT) % CTX;
                if (!isk && !lat && !ctx_out) continue;
                const bf16_t* vp = PB + (size_t)r * IN_COLS + (isk ? C_DK : C_DQ) + hm * 32;
                float v[32];
#pragma unroll
                for (int k = 0; k < 32; k += 4) { const float4 x = ld4h(vp + k); v[k] = x.x; v[k + 1] = x.y; v[k + 2] = x.z; v[k + 3] = x.w; }
                if (lat) rope32(v, t, ROPE);
                const float sc = isk ? 1.0f : 0.17677669529663687f * 1.4426950408889634f;
                bf16_t* dst = isk ? KD + ((size_t)(b * 8 + hm) * SK + (lat ? CTX + t : t)) * 32 : (lat ? QD + ((size_t)(b * 8 + hm) * S + t) * 32 : QDC + ((size_t)(b * 8 + hm) * CTX + t) * 32);
#pragma unroll
                for (int k = 0; k < 32; k += 8) *(uint4*)(dst + k) = make_uint4(pk2(v[k] * sc, v[k + 1] * sc), pk2(v[k + 2] * sc, v[k + 3] * sc), pk2(v[k + 4] * sc, v[k + 5] * sc), pk2(v[k + 6] * sc, v[k + 7] * sc));
            }
            ITEMS(i, NB * 4 * (SK / 8) * 64) {
                const int d = i & 63, j8 = (i >> 6) % (SK / 8), hh = (i / (64 * (SK / 8))) & 3, b = i / (256 * (SK / 8));
                const int r0 = j8 * 8 < CTX ? tok_row(false, b, j8 * 8) : tok_row(true, b, j8 * 8 - CTX);
                const bf16_t* sp = PB + (size_t)r0 * IN_COLS + C_DV + hh * 64 + d;
                unsigned v[8];
#pragma unroll
                for (int jj = 0; jj < 8; ++jj) v[jj] = sp[(size_t)jj * IN_COLS];
                *(uint4*)(VDT + ((size_t)(b * 4 + hh) * 64 + d) * SK + j8 * 8) = make_uint4(v[0] | (v[1] << 16), v[2] | (v[3] << 16), v[4] | (v[5] << 16), v[6] | (v[7] << 16));
            }
            const float* qn = kp_->in[I_QNORM] + l * 192; const float* kvn = kp_->in[I_KVNORM] + l * 128;
            { const int lane = tid & 63;
            uint2 xq = make_uint2((unsigned)tid >> 20, (unsigned)tid >> 20);
            const float4 wq4 = lane < 48 ? ((const float4*)qn)[lane] : make_float4(0.f, 0.f, 0.f, 0.f), wkv4 = lane < 32 ? ((const float4*)kvn)[lane] : make_float4(0.f, 0.f, 0.f, 0.f);
            const int wstride = gridDim.x * 8; int i = blockIdx.x * 8 + (tid >> 6);
#define NRM_LOAD(ii) do { const int wh_ = (ii) & 1, r_ = (ii) >> 1; if (lane < (wh_ ? 32 : 48)) xq = *(const uint2*)(PB + (size_t)r_ * IN_COLS + (wh_ ? C_CKV : C_CQ) + lane * 4); } while (0)
            if (i < NTOK * 2) NRM_LOAD(i);
            for (; i < NTOK * 2; i += wstride) {
                const int which = i & 1, r = i >> 1; const int n4 = which ? 32 : 48;
                float4 x = make_float4(0.f, 0.f, 0.f, 0.f); if (lane < n4) x = up4(xq);
                if (i + wstride < NTOK * 2) NRM_LOAD(i + wstride);
                const float ss = wave_sum(f4dot(x, x));
                const float rs = 1.0f / sqrtf(ss / (n4 * 4) + EPS);
                bf16_t* dst = which ? CKVB + (size_t)r * 128 : CQB + (size_t)r * 256;
                if (lane < n4) *(uint2*)(dst + lane * 4) = pk4(f4scale(f4mul(x, which ? wkv4 : wq4), rs));
                else if (!which) { const unsigned z_ = (unsigned)tid >> 20; *(uint2*)(dst + lane * 4) = make_uint2(z_, z_); }
            }
#undef NRM_LOAD
            }
            GSYNC();
        }
        {
            PHASE_BEGIN();
            const int half = (G * 5) / 8;
            if (bid < half) {
                pg8::Gemm g{CQB, WQ_T, NTOK, 512, 256, 0, 0}; pg8::StaticOrder so; so.init(NTOK, 512, half, bid);
                pg8::EpiBf16 E{MQ, 384, 384};
                pg8::gemm_phase<pg8::EpiBf16, pg8::StaticOrder, true, true>(ldsb, g, so, E, tid);
            } else {
                pg8::Gemm g{CKVB, WKV_T, NTOK, 512, 128, 0, 0}; pg8::StaticOrder so; so.init(NTOK, 512, G - half, bid - half);
                pg8::EpiBf16 E{MKV, 512, 512};
                pg8::gemm_phase<pg8::EpiBf16, pg8::StaticOrder, true, true>(ldsb, g, so, E, tid);
            }
            for (int it = vcu; it < NB * NCH * 8; it += G) {
                const int hp = it & 3, dir = (it >> 2) & 1, cp = (it >> 3) % NCH, b = it / (8 * NCH);
                const int k = dir ? (cp < 2 ? 1 - cp : 35 - cp) : cp;
                if (k == NCH - 1) continue;
                ssd_block<false>(b, dir, k, hp, XBC, DT, kp_->in[I_ALOG] + l * 16, HS, ALAST, nullptr, (float*)lds_raw, tid);
            }
            GSYNC();
        }
        {
            PHASE_BEGIN();
            ITEMS(i, NTOK * 8) {
                const int g = i & 7, r = i >> 3; const int hh = g & 3, isk = g >> 2;
                const bool lat = r < NLAT; const int b = lat ? r / S : (r - NLAT) / CTX, t = lat ? r % S : (r - NLAT) % CTX;
                if (!isk && !lat && !ctx_out) continue;
                const bf16_t* npb = isk ? MKV + (size_t)r * 512 + hh * 128 : MQ + (size_t)r * 384 + hh * 96;
                const bf16_t* rp = isk ? PB + (size_t)r * IN_COLS + C_KR : npb + 64;
                float v[32], np[64];
#pragma unroll
                for (int k = 0; k < 32; k += 4) { const float4 x = ld4h(rp + k); v[k] = x.x; v[k + 1] = x.y; v[k + 2] = x.z; v[k + 3] = x.w; }
#pragma unroll
                for (int k = 0; k < 64; k += 4) { const float4 x = ld4h(npb + k); np[k] = x.x; np[k + 1] = x.y; np[k + 2] = x.z; np[k + 3] = x.w; }
                if (lat) rope32(v, t, ROPE);
                const float sc = isk ? 1.0f : 0.10206207261596575f * 1.4426950408889634f;
                bf16_t* dst = isk ? KM + ((size_t)(b * 4 + hh) * SK + (lat ? CTX + t : t)) * 96 : (lat ? QM + ((size_t)(b * 4 + hh) * S + t) * 96 : QMC + ((size_t)(b * 4 + hh) * CTX + t) * 96);
#pragma unroll
                for (int k = 0; k < 64; k += 8) *(uint4*)(dst + k) = make_uint4(pk2(np[k] * sc, np[k + 1] * sc), pk2(np[k + 2] * sc, np[k + 3] * sc), pk2(np[k + 4] * sc, np[k + 5] * sc), pk2(np[k + 6] * sc, np[k + 7] * sc));
#pragma unroll
                for (int k = 0; k < 32; k += 8) *(uint4*)(dst + 64 + k) = make_uint4(pk2(v[k] * sc, v[k + 1] * sc), pk2(v[k + 2] * sc, v[k + 3] * sc), pk2(v[k + 4] * sc, v[k + 5] * sc), pk2(v[k + 6] * sc, v[k + 7] * sc));
            }
            ITEMS(i, NB * 4 * (SK / 8) * 64) {
                const int d = i & 63, j8 = (i >> 6) % (SK / 8), hh = (i / (64 * (SK / 8))) & 3, b = i / (256 * (SK / 8));
                const int r0 = j8 * 8 < CTX ? tok_row(false, b, j8 * 8) : tok_row(true, b, j8 * 8 - CTX);
                const bf16_t* sp = MKV + (size_t)r0 * 512 + hh * 128 + 64 + d;
                unsigned v[8];
#pragma unroll
                for (int jj = 0; jj < 8; ++jj) v[jj] = sp[(size_t)jj * 512];
                *(uint4*)(VMT + ((size_t)(b * 4 + hh) * 64 + d) * SK + j8 * 8) = make_uint4(v[0] | (v[1] << 16), v[2] | (v[3] << 16), v[4] | (v[5] << 16), v[6] | (v[7] << 16));
            }
            ITEMS(i, NB * 2 * 8 * 4096) {
                const int e = i & 4095, h = (i >> 12) & 7, bd = i >> 15;
                float* hp0 = HS + ((size_t)bd * NCH * 8 + h) * 4096 + e; const float* al0 = ALAST + (size_t)bd * NCH * 8 + h;
                float sv[NCH - 1], dk[NCH - 1];
#pragma unroll
                for (int k = 0; k < NCH - 1; ++k) { sv[k] = hp0[(size_t)k * 8 * 4096]; dk[k] = al0[k * 8]; }
                float Hc = 0.f;
#pragma unroll
                for (int k = 0; k < NCH; ++k) { hp0[(size_t)k * 8 * 4096] = Hc; if (k < NCH - 1) Hc = Hc * __expf(dk[k]) + sv[k]; }
            }
            GSYNC();
        }
        {
            PHASE_BEGIN();
            for (int kq = 0; kq * G < NB * 2 * NCH * 4; ++kq) {
                int it = vcu + kq * G;
                { const int T_ = NB * 2 * NCH * 4, full_ = (T_ / G) * G, rem_ = T_ - full_;
                  if (ctx_out && kq * G == full_) it = vcu >= G - rem_ ? full_ + vcu - (G - rem_) : T_; }
                if (it >= NB * 2 * NCH * 4) continue;
                const int hp = it & 3, dir = (it >> 2) & 1, cp = (it >> 3) % NCH, b = it / (8 * NCH);
                const int k = dir ? (cp < 2 ? 1 - cp : 35 - cp) : cp;
                if (k < 2 && !ctx_out) continue;
                ssd_block<true>(b, dir, k, hp, XBC, DT, kp_->in[I_ALOG] + l * 16, HS, ALAST, YD, (float*)lds_raw, tid);
            }
            {
                int tid = MK_TID(); asm volatile("" : "+v"(tid));
                const int lane = tid & 63, wave = tid >> 6, qr = lane & 31, hf = lane >> 5;
                const float* lq1 = kp_->in[I_LQ1] + l * 32; const float* lk1 = kp_->in[I_LK1] + l * 32; const float* lq2 = kp_->in[I_LQ2] + l * 32; const float* lk2 = kp_->in[I_LK2] + l * 32;
                const float* subw = kp_->in[I_SUBLN] + l * 64;
                const int nlat = NB * 4 * (S / 256), nit = nlat + (ctx_out ? NB * 4 : 0);
                for (int it = vcu; it < nit; it += G) {
                    const bool lat = it < nlat; const int u = lat ? it : it - nlat;
                    const int qb = lat ? u % (S / 256) : 0, hh = lat ? (u / (S / 256)) % 4 : u % 4, b = lat ? u / (4 * (S / 256)) : u / 4;
                    const int t = qb * 256 + wave * 32 + qr; const int row = tok_row(lat, b, t); const int nkt = lat ? SK / 64 : CTX / 64;
                    f32x16 oacc[2];
                    LAS v4u* const o1s = (LAS v4u*)(ldsb + 98304) + tid;
#pragma unroll 1
                    for (int mp = 0; mp < 2; ++mp) {
                        const int hm = hh * 2 + mp;
                        const bf16_t* qrow = lat ? QD + ((size_t)(b * 8 + hm) * S + t) * 32 : QDC + ((size_t)(b * 8 + hm) * CTX + t) * 32;
                        float l_run = 0.f;
#pragma unroll
                        for (int i = 0; i < 16; ++i) { oacc[0][i] = 0.f; oacc[1][i] = 0.f; }
                        const CvArgs cvp{kp_->in[I_WG] + (size_t)l * NE * D * FF, kp_->in[I_WU] + (size_t)l * NE * D * FF, kp_->in[I_WD] + (size_t)l * NE * FF * D, WGU_T, WD_T,
                                         moe_done + (((lat ? it : 0) * 8 + wave_s) * 2 + mp) * 4};
                        attn_pass<32, true>(qrow, KD + (size_t)(b * 8 + hm) * SK * 32, VDT + (size_t)(b * 4 + hh) * 64 * SK, SK, nkt, ldsb, tid, oacc, l_run, cvp);
                        l_run = xor32_sum(l_run);
                        if (mp == 0) { const float i1 = 1.0f / l_run;
#pragma unroll
                            for (int db = 0; db < 2; ++db)
#pragma unroll
                                for (int q4 = 0; q4 < 2; ++q4) o1s[(db * 2 + q4) * NTHREADS] = (v4u){pk2(oacc[db][8 * q4] * i1, oacc[db][8 * q4 + 1] * i1), pk2(oacc[db][8 * q4 + 2] * i1, oacc[db][8 * q4 + 3] * i1),
                                                                                                   pk2(oacc[db][8 * q4 + 4] * i1, oacc[db][8 * q4 + 5] * i1), pk2(oacc[db][8 * q4 + 6] * i1, oacc[db][8 * q4 + 7] * i1)}; }
                        else {
                            float d1 = 0.f, d2 = 0.f; for (int k = 0; k < 32; ++k) { d1 += lq1[k] * lk1[k]; d2 += lq2[k] * lk2[k]; }
                            const float lam = expf(d1) - expf(d2) + lambda_init;
                            const float i2 = lam / l_run; float ss = 0.f; f32x16 o1[2];
#pragma unroll
                            for (int db = 0; db < 2; ++db)
#pragma unroll
                                for (int q4 = 0; q4 < 2; ++q4) { const v4u pq = o1s[(db * 2 + q4) * NTHREADS]; const unsigned pw[4] = {pq.x, pq.y, pq.z, pq.w};
#pragma unroll
                                    for (int i2_ = 0; i2_ < 8; ++i2_) { const int i = 8 * q4 + i2_; const float a1 = __uint_as_float((i2_ & 1) ? (pw[i2_ >> 1] & 0xffff0000u) : (pw[i2_ >> 1] << 16)); const float v = a1 - oacc[db][i] * i2; o1[db][i] = v; ss += v * v; } }
                            ss = xor32_sum(ss);
                            const float rs = (1.0f - lambda_init) / sqrtf(ss / 64 + EPS);
                            bf16_t* orow = MIXB + (size_t)row * MIXW + 512 + hh * 64;
#pragma unroll
                            for (int db = 0; db < 2; ++db)
#pragma unroll
                                for (int gq = 0; gq < 4; ++gq) { const int d0 = 32 * db + 8 * gq + 4 * hf; const float4 w4 = *(const float4*)(subw + d0);
                                    *(uint2*)(orow + d0) = make_uint2(pk2(o1[db][4 * gq] * rs * w4.x, o1[db][4 * gq + 1] * rs * w4.y), pk2(o1[db][4 * gq + 2] * rs * w4.z, o1[db][4 * gq + 3] * rs * w4.w)); }
                        }
                    }
                }
            }
            moe_done = min(moe_done + NB * 4 * (S / 256) * 8 * 2 * 4, MOE_TILES);
            {
                int tid = MK_TID(); asm volatile("" : "+v"(tid));
                const int lane = tid & 63, wave = tid >> 6, qr = lane & 31, hf = lane >> 5;
                const int nlat = NB * 4 * (S / 256), nit = nlat + (ctx_out ? NB * 4 : 0);
                for (int it = vcu; it < nit; it += G) {
                    const bool lat = it < nlat; const int u = lat ? it : it - nlat;
                    const int qb = lat ? u % (S / 256) : 0, hh = lat ? (u / (S / 256)) % 4 : u % 4, b = lat ? u / (4 * (S / 256)) : u / 4;
                    const int t = qb * 256 + wave * 32 + qr; const int row = tok_row(lat, b, t); const int nkt = lat ? SK / 64 : CTX / 64;
                    const bf16_t* qrow = lat ? QM + ((size_t)(b * 4 + hh) * S + t) * 96 : QMC + ((size_t)(b * 4 + hh) * CTX + t) * 96;
                    f32x16 oacc[2]; float l_run = 0.f;
#pragma unroll
                    for (int i = 0; i < 16; ++i) { oacc[0][i] = 0.f; oacc[1][i] = 0.f; }
                    const CvArgs cvp{kp_->in[I_WG], kp_->in[I_WG], kp_->in[I_WG], WGU_T, WD_T, 0};
                    attn_pass<96, false>(qrow, KM + (size_t)(b * 4 + hh) * SK * 96, VMT + (size_t)(b * 4 + hh) * 64 * SK, SK, nkt, ldsb, tid, oacc, l_run, cvp);
                    l_run = xor32_sum(l_run);
                    const float inv = 1.0f / l_run;
                    bf16_t* orow = MIXB + (size_t)row * MIXW + 768 + hh * 64;
#pragma unroll
                    for (int db = 0; db < 2; ++db)
#pragma unroll
                        for (int gq = 0; gq < 4; ++gq) { const int d0 = 32 * db + 8 * gq + 4 * hf;
                            *(uint2*)(orow + d0) = make_uint2(pk2(oacc[db][4 * gq] * inv, oacc[db][4 * gq + 1] * inv), pk2(oacc[db][4 * gq + 2] * inv, oacc[db][4 * gq + 3] * inv)); }
                }
            }
            GSYNC();
        }
        {
            PHASE_BEGIN();
            const float* nw = kp_->in[I_SSDN] + l * 512; const float* dsk = kp_->in[I_SSDD] + l * 8;
            const int lane = tid & 63;
            uint2 q0, q1, q2, q3; { const unsigned z_ = (unsigned)tid >> 20; q0 = make_uint2(z_, z_); q1 = q0; q2 = q0; q3 = q0; }
            const float4 nw0 = *(const float4*)(nw + lane * 4), nw1 = *(const float4*)(nw + 256 + lane * 4); const float ds0 = dsk[(lane * 4) >> 6], ds1 = dsk[(256 + lane * 4) >> 6];
            const int wstride = gridDim.x * 8; int i = blockIdx.x * 8 + (tid >> 6);
#define GN_LOAD(ii) do { const int g_ = (ii) & 1, r_ = (ii) >> 1, c_ = g_ * 256 + lane * 4; q0 = *(const uint2*)(XBC + (size_t)r_ * 768 + c_); q1 = *(const uint2*)(YD + (size_t)r_ * 512 + c_); \
                q2 = *(const uint2*)(YD + ((size_t)NTOK + r_) * 512 + c_); q3 = *(const uint2*)(PB + (size_t)r_ * IN_COLS + C_Z + c_); } while (0)
            if (i < nrows_out * 2) GN_LOAD(i);
            for (; i < nrows_out * 2; i += wstride) {
                const int g = i & 1, r = i >> 1, c = g * 256 + lane * 4;
                const float4 x = up4(q0), y0 = up4(q1), y1 = up4(q2), z = up4(q3);
                if (i + wstride < nrows_out * 2) GN_LOAD(i + wstride);
                const float ds = g ? ds1 : ds0;
                float4 v = make_float4((ds * x.x + y0.x + y1.x) * siluf(z.x), (ds * x.y + y0.y + y1.y) * siluf(z.y), (ds * x.z + y0.z + y1.z) * siluf(z.z), (ds * x.w + y0.w + y1.w) * siluf(z.w));
                const float ss = wave_sum(f4dot(v, v));
                const float rs = 1.0f / sqrtf(ss / 256 + EPS);
                *(uint2*)(MIXB + (size_t)r * MIXW + c) = pk4(f4scale(f4mul(v, g ? nw1 : nw0), rs));
            }
#undef GN_LOAD
            GSYNC();
        }
        {
            PHASE_BEGIN();
            pg8::Gemm g{MIXB, WOUT_T, nrows_out, D, MIXW, 0, 0}; pg8::StaticOrder so; so.init(nrows_out, D, G, bid);
            pg8::EpiBf16 E{MOUT, D, D};
            pg8::gemm_phase<pg8::EpiBf16, pg8::StaticOrder, true, true>(ldsb, g, so, E, tid);
            { const int nwg = (nrows_out / 256) * (D / 256), busy = nwg % G; const int id0 = moe_done;
              const int id1 = min(id0 + (G - busy) * 8 * CVT_PER_WAVE, MOE_TILES);
              if (busy != 0 && bid >= busy) CVT_MOE_RANGE(l, id0, id1, (bid - busy) * 8 + (tid >> 6), (G - busy) * 8);
              if (busy != 0) moe_done = id1; }
            GSYNC();
        }
        {
            PHASE_BEGIN();
            const float* wpost = kp_->in[I_NMPOST] + l * D; const float* wpre = kp_->in[I_NFPRE] + l * D;
            const float* rw = kp_->in[I_RW] + (size_t)l * D * NE; const float* rb = kp_->in[I_RB] + l * NE;
            const int lane = tid & 63;
            float* rwl = (float*)lds_raw;
            for (int i = tid; i < D * NE / 4; i += NTHREADS) { const int k = i >> 2, e4 = i & 3; ((float4*)rwl)[(((k & 3) * 256 + (k >> 2)) << 2) + e4] = ((const float4*)rw)[i]; }
            float4* aux = (float4*)(rwl + D * NE);
            for (int i = tid; i < 17 * (D / 4); i += NTHREADS) { const int v = i / (D / 4), k4 = i % (D / 4);
                const float* src = v == 0 ? wpost : v == 1 ? wpre : modl + (size_t)((v - 2) % 5) * NMOD * D + (2 + (v - 2) / 5) * D;
                aux[i] = ((const float4*)src)[k4]; }
            __syncthreads();
            float rbv[NE];
#pragma unroll
            for (int e = 0; e < NE; ++e) rbv[e] = rb[e];
            uint2 mq[4]; float4 xq[4];
            { const float zf_ = (float)(tid >> 20);
#pragma unroll
              for (int i = 0; i < 4; ++i) { xq[i] = make_float4(zf_, zf_, zf_, zf_); mq[i] = make_uint2((unsigned)tid >> 20, (unsigned)tid >> 20); } }
            const int wstride = gridDim.x * 8; int r = blockIdx.x * 8 + (tid >> 6);
#define P7_LOAD(rr) do { const bf16_t* m_ = MOUT + (size_t)(rr) * D; _Pragma("unroll") for (int i = 0; i < 4; ++i) mq[i] = *(const uint2*)(m_ + (i * 64 + lane) * 4); \
                if (l == 0) { const float4* xin_ = (const float4*)((rr) < NLAT ? kp_->in[I_X] + (size_t)(rr) * D : kp_->in[I_CTX] + (size_t)((rr) - NLAT) * D); _Pragma("unroll") for (int i = 0; i < 4; ++i) xq[i] = xin_[i * 64 + lane]; } \
                else { const uint2* s_ = (const uint2*)(XRB + (size_t)(rr) * D); _Pragma("unroll") for (int i = 0; i < 4; ++i) { const uint2 u_ = s_[i * 64 + lane]; xq[i].x = __uint_as_float(u_.x); xq[i].y = __uint_as_float(u_.y); } } } while (0)
            if (r < nrows_out) P7_LOAD(r);
            for (; r < nrows_out; r += wstride) {
                uint2* xr = (uint2*)(XRB + (size_t)r * D);
                const int bsel = r < NLAT ? r / S : NB;
                float4 mv[4], xv[4]; float ss = 0.f;
#pragma unroll
                for (int i = 0; i < 4; ++i) { mv[i] = up4(mq[i]); xv[i] = l == 0 ? xq[i] : XRAW(xq[i]); ss += f4dot(mv[i], mv[i]); }
                if (r + wstride < nrows_out) P7_LOAD(r + wstride);
                ss = wave_sum(ss);
                const float rs = 1.0f / sqrtf(ss / D + EPS);
                float s2 = 0.f;
#pragma unroll
                for (int i = 0; i < 4; ++i) { const int k4 = i * 64 + lane;
                    xv[i] = f4add(xv[i], f4mul(aux[(2 + bsel) * (D / 4) + k4], f4scale(f4mul(mv[i], aux[k4]), rs))); xr[k4] = pk4(xv[i]); s2 += f4dot(xv[i], xv[i]); }
                s2 = wave_sum(s2);
                const float r2 = 1.0f / sqrtf(s2 / D + EPS);
                float lg[NE];
#pragma unroll
                for (int e = 0; e < NE; ++e) lg[e] = 0.f;
#pragma unroll
                for (int i = 0; i < 4; ++i) { const int k4 = i * 64 + lane; const float4 w4 = aux[(D / 4) + k4], sc = aux[(12 + bsel) * (D / 4) + k4], sh = aux[(7 + bsel) * (D / 4) + k4];
                    const float hv[4] = {xv[i].x * r2 * w4.x * (1.0f + sc.x) + sh.x, xv[i].y * r2 * w4.y * (1.0f + sc.y) + sh.y, xv[i].z * r2 * w4.z * (1.0f + sc.z) + sh.z, xv[i].w * r2 * w4.w * (1.0f + sc.w) + sh.w};
                    *(uint2*)(HB + (size_t)r * D + k4 * 4) = make_uint2(pk2(hv[0], hv[1]), pk2(hv[2], hv[3]));
#pragma unroll
                    for (int c = 0; c < 4; ++c) { const float4* rwp = (const float4*)(rwl + (size_t)(c * 256 + k4) * NE);
#pragma unroll
                        for (int e4 = 0; e4 < 4; ++e4) { const float4 w = rwp[e4]; lg[4 * e4] += hv[c] * w.x; lg[4 * e4 + 1] += hv[c] * w.y; lg[4 * e4 + 2] += hv[c] * w.z; lg[4 * e4 + 3] += hv[c] * w.w; }
                        SCHED_FENCE(); }
                }
#pragma unroll
                for (int e = 0; e < NE; ++e) lg[e] = wave_sum(lg[e]) + rbv[e];
                float mx = lg[0];
#pragma unroll
                for (int e = 1; e < NE; ++e) mx = fmaxf(mx, lg[e]);
                float sum = 0.f;
#pragma unroll
                for (int e = 0; e < NE; ++e) { lg[e] = expf(lg[e] - mx); sum += lg[e]; }
                const float is = 1.0f / sum;
                float mine = lg[0];
#pragma unroll
                for (int e = 1; e < NE; ++e) mine = lane == e ? lg[e] : mine;
                if (lane < NE) AFF[(size_t)r * NE + lane] = mine * is;
            }
#undef P7_LOAD
            GSYNC();
        }
        {
            PHASE_BEGIN();
            CVT_MOE_RANGE(l, moe_done, MOE_TILES, bid * 8 + (tid >> 6), G * 8);
            {
                volatile int* sh = (volatile int*)lds_raw;
                const int nsel = (ctx_out ? 2 : 1) * NB * NE;
                for (int it = bid; it < nsel; it += G) {
                    const bool lat = it < NB * NE; const int u = lat ? it : it - NB * NE; const int e = u % NE, b = u / NE;
                    const int L = lat ? S : CTX, cap = lat ? CAP_L : CAP_C, npt = lat ? S / NTHREADS : 1, base = tok_row(lat, b, 0);
                    const bool act = lat || tid < CTX;
                    unsigned key[S / NTHREADS];
#pragma unroll
                    for (int i = 0; i < S / NTHREADS; ++i) key[i] = (act && i < npt) ? __float_as_uint(AFF[(size_t)(base + tid * npt + i) * NE + e]) : 0u;
                    __syncthreads();
                    unsigned T = 0u;
                    for (int bit = 30; bit >= 0; --bit) {
                        const unsigned cand = T | (1u << bit); int c = 0;
#pragma unroll
                        for (int i = 0; i < S / NTHREADS; ++i) c += (key[i] >= cand) ? 1 : 0;
                        if (block_sum(c, tid, sh, bit & 1) >= cap) T = cand;
                    }
                    int cg = 0, ct = 0;
#pragma unroll
                    for (int i = 0; i < S / NTHREADS; ++i) { cg += (key[i] > T) ? 1 : 0; ct += (key[i] == T && key[i] != 0u) ? 1 : 0; }
                    int tot_g, tot_t;
                    (void)block_excl_scan(cg, tid, sh, tot_g);
                    int tie_rank = block_excl_scan(ct, tid, sh, tot_t);
                    const int need = cap - tot_g;
                    int sel[S / NTHREADS], cs = 0;
#pragma unroll
                    for (int i = 0; i < S / NTHREADS; ++i) { const bool tie = key[i] == T && key[i] != 0u; sel[i] = (key[i] > T || (tie && tie_rank < need)) ? 1 : 0; tie_rank += tie ? 1 : 0; cs += sel[i]; }
                    int tot_s; int slot = block_excl_scan(cs, tid, sh, tot_s);
#pragma unroll
                    for (int i = 0; i < S / NTHREADS; ++i) if (act && i < npt) {
                        const int row = base + tid * npt + i; int sa = -1;
                        if (sel[i]) { sa = (lat ? b * CAP_L : NB * CAP_L + b * CAP_C) + slot; ++slot; SELIDX[e * ER_MAX + sa] = row; SELGATE[e * ER_MAX + sa] = __uint_as_float(key[i]); }
                        TOKSLOT[(size_t)row * NE + e] = sa;
                    }
                }
            }
            GSYNC();
        }
        {
            PHASE_BEGIN();
            const int used = ctx_out ? NB * (CAP_L + CAP_C) : NB * CAP_L;
            {
                const int lane = tid & 63, wstride = gridDim.x * 8, nrow = NE * ER;
                for (int r0 = (blockIdx.x * 8 + (tid >> 6)) * 4; r0 < nrow; r0 += wstride * 4) {
                    int src[4]; uint4 v0[4], v1[4];
#pragma unroll
                    for (int q = 0; q < 4; ++q) { const int rr = r0 + q, e = rr / ER, slot = rr % ER; src[q] = (rr < nrow && slot < used) ? SELIDX[e * ER_MAX + slot] : -1; }
#pragma unroll
                    for (int q = 0; q < 4; ++q) { const unsigned z_ = (unsigned)tid >> 20; v0[q] = make_uint4(z_, z_, z_, z_); v1[q] = v0[q];
                        if (src[q] >= 0) { const uint4* sp = (const uint4*)(HB + (size_t)src[q] * D); v0[q] = sp[lane]; v1[q] = sp[64 + lane]; } }
#pragma unroll
                    for (int q = 0; q < 4; ++q) if (r0 + q < nrow) { uint4* dp = (uint4*)(XG + (size_t)(r0 + q) * D); dp[lane] = v0[q]; dp[64 + lane] = v1[q]; }
                }
            }
            GSYNC();
        }
        {
            PHASE_BEGIN();
            pg8::Gemm g{XG, WGU_T, NE * ER, 2 * FF, D, ER / 256, (size_t)2 * FF * D * 2}; pg8::StaticOrder so; so.init(NE * ER, 2 * FF, G, bid);
            pg8::EpiSwiGLU E{HID, FF};
            pg8::gemm_phase<pg8::EpiSwiGLU, pg8::StaticOrder, true, true>(ldsb, g, so, E, tid);
            GSYNC();
        }
        {
            PHASE_BEGIN();
            pg8::Gemm g{HID, WD_T, NE * ER, D, FF, ER / 256, (size_t)D * FF * 2}; pg8::StaticOrder so; so.init(NE * ER, D, G, bid);
            pg8::EpiRowScaleBf16 E{Y, D, SELGATE, ER};
            pg8::gemm_phase<pg8::EpiRowScaleBf16, pg8::StaticOrder, true, true>(ldsb, g, so, E, tid);
            GSYNC();
        }
        {
            PHASE_BEGIN();
            const float* wpost = kp_->in[I_NFPOST] + l * D;
            const int lane = tid & 63;
            {
                float4 xq[4]; int slq = -1;
                { const float zf_ = (float)(tid >> 20);
#pragma unroll
                  for (int i = 0; i < 4; ++i) xq[i] = make_float4(zf_, zf_, zf_, zf_); }
                float4* aux = (float4*)lds_raw;
                __syncthreads();
                for (int i = tid; i < 6 * (D / 4); i += NTHREADS) { const int v = i / (D / 4), k4 = i % (D / 4);
                    const float* src = v == 0 ? wpost : modl + (size_t)(v - 1) * NMOD * D + 5 * D;
                    aux[i] = ((const float4*)src)[k4]; }
                __syncthreads();
                const int wstride = gridDim.x * 8; int r = blockIdx.x * 8 + (tid >> 6);
#define P11_LOAD(rr) do { const uint2* xin_ = (const uint2*)(XRB + (size_t)(rr) * D); slq = lane < NE ? TOKSLOT[(size_t)(rr) * NE + lane] : -1; \
                    _Pragma("unroll") for (int i = 0; i < 4; ++i) { const uint2 u_ = xin_[i * 64 + lane]; xq[i].x = __uint_as_float(u_.x); xq[i].y = __uint_as_float(u_.y); } } while (0)
                if (r < nrows_out) P11_LOAD(r);
                for (; r < nrows_out; r += wstride) {
                    const int bsel = r < NLAT ? r / S : NB;
                    const int myslot = slq; float4 xv[4], f[4];
#pragma unroll
                    for (int i = 0; i < 4; ++i) { xv[i] = XRAW(xq[i]); f[i] = make_float4(0.f, 0.f, 0.f, 0.f); }
                    {
                        unsigned msk = (unsigned)__ballot(myslot >= 0) & 0xffffu;
                        const bf16_t* zrow = (const bf16_t*)(kp_->ws + WS_CTL + 32768);
                        const bf16_t* yp[4];
#pragma unroll
                        for (int q = 0; q < 4; ++q) { yp[q] = zrow;
                            if (msk) { const int e = __builtin_ctz(msk); msk &= msk - 1; const int sl = __builtin_amdgcn_readlane(myslot, e); yp[q] = Y + ((size_t)e * ER + sl) * D; } }
                        uint2 yv[4][4];
#pragma unroll
                        for (int q = 0; q < 4; ++q)
#pragma unroll
                            for (int i = 0; i < 4; ++i) yv[q][i] = *(const uint2*)(yp[q] + (i * 64 + lane) * 4);
#pragma unroll
                        for (int q = 0; q < 4; ++q)
#pragma unroll
                            for (int i = 0; i < 4; ++i) f[i] = f4add(f[i], up4(yv[q][i]));
                        while (msk) { const int e = __builtin_ctz(msk); msk &= msk - 1; const int sl = __builtin_amdgcn_readlane(myslot, e); const bf16_t* ypx = Y + ((size_t)e * ER + sl) * D;
#pragma unroll
                            for (int i = 0; i < 4; ++i) f[i] = f4add(f[i], ld4h(ypx + (i * 64 + lane) * 4)); }
                    }
                    if (r + wstride < nrows_out) P11_LOAD(r + wstride);
                    float ss = 0.f;
#pragma unroll
                    for (int i = 0; i < 4; ++i) ss += f4dot(f[i], f[i]);
                    ss = wave_sum(ss);
                    const float rs = 1.0f / sqrtf(ss / D + EPS);
#pragma unroll
                    for (int i = 0; i < 4; ++i) { const int k4 = i * 64 + lane; const float4 xo = f4add(xv[i], f4mul(aux[(1 + bsel) * (D / 4) + k4], f4scale(f4mul(f[i], aux[k4]), rs)));
                        if (l == DEPTH - 1) ((float4*)(xcur + (size_t)r * D))[k4] = xo;
                        else ((uint2*)(XRB + (size_t)r * D))[k4] = pk4(xo); }
                }
#undef P11_LOAD
            }
            GSYNC();
        }
    }
}

extern "C" void kernel_launch(void* const* d_in, const int* in_sizes, int n_in, void* d_out, int out_size, void* d_ws, size_t ws_size, hipStream_t stream) {
    static int grid = 0;
    if (grid == 0) {
        if (n_in != N_IN || out_size != NLAT * D || ws_size < WS_END) { fprintf(stderr, "kernel_launch: unexpected shapes: n_in %d out %d ws %zu (need %zu)\n", n_in, out_size, ws_size, (size_t)WS_END); grid = -1; return; }
        int dev = 0, cus = 0, per_cu = 0;
        (void)hipGetDevice(&dev);
        (void)hipDeviceGetAttribute(&cus, hipDeviceAttributeMultiprocessorCount, dev);
        (void)hipFuncSetAttribute((const void*)mk_forward, hipFuncAttributeMaxDynamicSharedMemorySize, LDS_BYTES);
        (void)hipOccupancyMaxActiveBlocksPerMultiprocessor(&per_cu, (const void*)mk_forward, NTHREADS, LDS_BYTES);
        (void)hipGetLastError();
        if (per_cu < 1) { fprintf(stderr, "kernel_launch: occupancy query says %d blocks/CU\n", per_cu); grid = -1; return; }
        grid = cus;
    }
    if (grid < 0) return;
    (void)hipMemsetAsync((char*)d_ws + WS_CTL, 0, CTL_BYTES, stream);
    Prm p{};
    for (int i = 0; i < N_IN; ++i) p.in[i] = (const float*)d_in[i];
    p.out = (float*)d_out; p.ws = (char*)d_ws;
    void* args[] = {&p};
    hipError_t e = hipLaunchCooperativeKernel((const void*)mk_forward, dim3(grid), dim3(NTHREADS), args, LDS_BYTES, stream);
    if (e != hipSuccess) fprintf(stderr, "kernel_launch: cooperative launch failed: %s (grid %d)\n", hipGetErrorString(e), grid);
}
```

```cpp
#include <hip/hip_runtime.h>
#include <cstdio>
#include <cstdint>

constexpr int D = 1024, NB = 4, S = 4096, CTX = 256, FF = 1024;
constexpr int DEPTH = 2, GRID_W = 64, NMOD = 6, NE = 16;
constexpr int NLAT = NB * S, NCTX = NB * CTX, NTOK = NLAT + NCTX;
constexpr int IN_COLS = 2416, IN_PAD = 2560;
constexpr int C_Z = 0, C_XBC = 512, C_DT = 1280, C_DQ = 1296, C_DK = 1552, C_DV = 1808, C_CQ = 2064, C_CKV = 2256, C_KR = 2384;
constexpr int MIXW = 1024;
constexpr int CAP_L = 2 * S / NE, CAP_C = 2 * CTX / NE;
constexpr int ER_MAX = 2304;
constexpr float EPS = 1e-6f;
static_assert(NB * CAP_L == 2048 && NB * CAP_C == 128, "expert row layout");

enum { I_X = 0, I_C, I_CTX, I_CCTX, I_ADAW, I_ADAB, I_NMPRE, I_NMPOST, I_NFPRE, I_NFPOST, I_WIN, I_CONVW, I_CONVB, I_ALOG, I_DTB, I_SSDD, I_SSDN,
       I_LQ1, I_LK1, I_LQ2, I_LK2, I_SUBLN, I_QNORM, I_WQUP, I_KVNORM, I_WKVUP, I_WOUT, I_RW, I_RB, I_WG, I_WU, I_WD, N_IN };
struct Prm { const float* in[N_IN]; float* out; char* ws; };

typedef unsigned short bf16_t;
constexpr size_t al256(size_t x) { return (x + 255) & ~(size_t)255; }
constexpr size_t WS_CTL = 0, CTL_BYTES = 65536;
constexpr size_t WS_MOD = WS_CTL + CTL_BYTES;
constexpr size_t WS_CTXC = al256(WS_MOD + (size_t)DEPTH * (NB + 1) * NMOD * D * 4);
constexpr size_t WS_AFF = al256(WS_CTXC + (size_t)NCTX * D * 4);
constexpr size_t WS_TOKSLOT = al256(WS_AFF + (size_t)NTOK * NE * 4);
constexpr size_t WS_SELIDX = al256(WS_TOKSLOT + (size_t)NTOK * NE * 4);
constexpr size_t WS_SELGATE = al256(WS_SELIDX + (size_t)NE * ER_MAX * 4);
constexpr size_t WS_DT = al256(WS_SELGATE + (size_t)NE * ER_MAX * 4);
constexpr int NCH = 34;
constexpr size_t WS_ROPE = al256(WS_DT + (size_t)NTOK * 16 * 4);
constexpr size_t WS_ALAST = al256(WS_ROPE + (size_t)S * 32 * 4);
constexpr size_t WS_HB = al256(WS_ALAST + (size_t)NB * 2 * NCH * 8 * 4);
constexpr size_t WS_P = al256(WS_HB + (size_t)NTOK * D * 2);
constexpr size_t WS_G2 = al256(WS_P + (size_t)NTOK * IN_COLS * 4);
constexpr size_t WS_XBC = WS_G2;
constexpr size_t WS_MQ = al256(WS_XBC + (size_t)NTOK * 768 * 4);
constexpr size_t WS_MKV = al256(WS_MQ + (size_t)NTOK * 384 * 4);
constexpr size_t WS_CQB = al256(WS_MKV + (size_t)NTOK * 512 * 4);
constexpr size_t WS_CKVB = al256(WS_CQB + (size_t)NTOK * 256 * 2);
constexpr size_t WS_MIXB = al256(WS_CKVB + (size_t)NTOK * 128 * 2);
constexpr size_t WS_G2END = al256(WS_MIXB + (size_t)NTOK * MIXW * 2);
constexpr size_t WS_HS = WS_HB;
constexpr size_t WS_YD = al256(WS_XBC + (size_t)NTOK * 768 * 2);
constexpr size_t WS_MOUT = WS_P;
constexpr size_t WS_XG = WS_P;
constexpr size_t WS_HID = al256(WS_XG + (size_t)NE * ER_MAX * D * 2);
constexpr size_t WS_Y = WS_G2;
constexpr size_t WS_WIN = WS_G2END;
constexpr size_t WS_WQ = al256(WS_WIN + (size_t)IN_PAD * D * 2);
constexpr size_t WS_WKV = al256(WS_WQ + (size_t)512 * 256 * 2);
constexpr size_t WS_WOUT = al256(WS_WKV + (size_t)512 * 128 * 2);
constexpr size_t WS_WGU = al256(WS_WOUT + (size_t)D * MIXW * 2);
constexpr size_t WS_WD = al256(WS_WGU + (size_t)NE * 2 * FF * D * 2);
constexpr size_t WS_XRB = al256(WS_WD + (size_t)NE * D * FF * 2);
constexpr size_t WS_END = al256(WS_XRB + (size_t)NTOK * D * 2);
constexpr int SK = CTX + S;
constexpr size_t WS_QD = al256(WS_P + (size_t)NTOK * IN_COLS * 2);
constexpr size_t WS_QDC = al256(WS_QD + (size_t)NB * 8 * S * 32 * 2);
constexpr size_t WS_KD = al256(WS_QDC + (size_t)NB * 8 * CTX * 32 * 2);
constexpr size_t WS_VDT = al256(WS_KD + (size_t)NB * 8 * SK * 32 * 2);
constexpr size_t WS_QM = al256(WS_VDT + (size_t)NB * 4 * 64 * SK * 2);
constexpr size_t WS_QMC = al256(WS_QM + (size_t)NB * 4 * S * 96 * 2);
constexpr size_t WS_KM = al256(WS_QMC + (size_t)NB * 4 * CTX * 96 * 2);
constexpr size_t WS_VMT = al256(WS_KM + (size_t)NB * 4 * SK * 96 * 2);
constexpr size_t WS_ATTEND = al256(WS_VMT + (size_t)NB * 4 * 64 * SK * 2);
static_assert(WS_ATTEND <= WS_G2, "attention operands fit in the spare half of the P slot");
static_assert(WS_HID + (size_t)NE * ER_MAX * FF * 2 <= WS_G2, "XG+HID fit in the P region");
static_assert((size_t)NE * ER_MAX * D * 4 <= WS_G2END - WS_G2, "Y fits in the G2 region");
static_assert((size_t)NB * 2 * NCH * 8 * 4096 * 4 <= (size_t)NTOK * D * 2, "HS fits in HB");
static_assert(WS_YD + (size_t)2 * NTOK * 512 * 2 <= WS_MKV, "YD ends below MKV");

#define LAS __attribute__((address_space(3)))
constexpr int NTHREADS = 512;
constexpr int LDS_BYTES = 147456;
#define ITEMS(i, n) for (int i = blockIdx.x * NTHREADS + tid; i < (n); i += gridDim.x * NTHREADS)

__device__ __forceinline__ float siluf(float x) { return x / (1.0f + expf(-x)); }
__device__ __forceinline__ float softplusf(float x) {
    const float e = __builtin_amdgcn_exp2f(x * 1.44269504f);
    const float sm = e * fmaf(e, fmaf(e, 0.33333334f, -0.5f), 1.0f), lg = __builtin_amdgcn_logf(1.0f + e) * 0.69314718f;
    return x > 20.f ? x : (e < 1e-3f ? sm : lg); }
__device__ __forceinline__ unsigned f2bf(float f) { unsigned u = __builtin_bit_cast(unsigned, f); return (u + 0x7fffu + ((u >> 16) & 1u)) >> 16; }
typedef float f32x2_t __attribute__((ext_vector_type(2)));
typedef __bf16 bf16x2_t __attribute__((ext_vector_type(2)));
__device__ __forceinline__ unsigned pk2(float lo, float hi) { const f32x2_t v = {lo, hi}; return __builtin_bit_cast(unsigned, __builtin_convertvector(v, bf16x2_t)); }
__device__ __forceinline__ float bf2f(bf16_t h) { return __builtin_bit_cast(float, (unsigned)h << 16); }
#define SCHED_FENCE() __builtin_amdgcn_sched_barrier(0)
__device__ __forceinline__ int mk_tid_impl(int wave_s) { unsigned z; asm volatile("s_mov_b32 %0, 0" : "=s"(z));
    return (wave_s << 6) | (int)__builtin_amdgcn_mbcnt_hi(~0u, __builtin_amdgcn_mbcnt_lo(~0u, z)); }
__device__ __forceinline__ float dpp_row_shr(float v, int n) {
    const int iv = __builtin_bit_cast(int, v); int r;
    switch (n) { case 1: r = __builtin_amdgcn_update_dpp(0, iv, 0x111, 0xf, 0xf, true); break; case 2: r = __builtin_amdgcn_update_dpp(0, iv, 0x112, 0xf, 0xf, true); break;
                 case 4: r = __builtin_amdgcn_update_dpp(0, iv, 0x114, 0xf, 0xf, true); break; default: r = __builtin_amdgcn_update_dpp(0, iv, 0x118, 0xf, 0xf, true); break; }
    return __builtin_bit_cast(float, r);
}
__device__ __forceinline__ float wave_sum(float v) {
    v += dpp_row_shr(v, 1); v += dpp_row_shr(v, 2); v += dpp_row_shr(v, 4); v += dpp_row_shr(v, 8);
    v += __builtin_bit_cast(float, __builtin_amdgcn_update_dpp(0, __builtin_bit_cast(int, v), 0x142, 0xa, 0xf, false));
    v += __builtin_bit_cast(float, __builtin_amdgcn_update_dpp(0, __builtin_bit_cast(int, v), 0x143, 0xc, 0xf, false));
    return __builtin_bit_cast(float, __builtin_amdgcn_readlane(__builtin_bit_cast(int, v), 63)); }
__device__ __forceinline__ void wave_sum16(float (&v)[16]) {
#define WS16_STEP(ctrl, rmask, bctl) _Pragma("unroll") for (int e = 0; e < 16; ++e) v[e] += __builtin_bit_cast(float, __builtin_amdgcn_update_dpp(0, __builtin_bit_cast(int, v[e]), ctrl, rmask, 0xf, bctl))
    WS16_STEP(0x111, 0xf, true); WS16_STEP(0x112, 0xf, true); WS16_STEP(0x114, 0xf, true); WS16_STEP(0x118, 0xf, true); WS16_STEP(0x142, 0xa, false); WS16_STEP(0x143, 0xc, false);
#undef WS16_STEP
#pragma unroll
    for (int e = 0; e < 16; ++e) v[e] = __builtin_bit_cast(float, __builtin_amdgcn_readlane(__builtin_bit_cast(int, v[e]), 63));
}
__device__ __forceinline__ float xor32_max(float x) { auto t = __builtin_amdgcn_permlane32_swap(__float_as_uint(x), __float_as_uint(x), false, false); return fmaxf(__uint_as_float(t[0]), __uint_as_float(t[1])); }
__device__ __forceinline__ float xor32_sum(float x) { auto t = __builtin_amdgcn_permlane32_swap(__float_as_uint(x), __float_as_uint(x), false, false); return __uint_as_float(t[0]) + __uint_as_float(t[1]); }
#define WITEMS(i, n) for (int i = blockIdx.x * 8 + (tid >> 6); i < (n); i += gridDim.x * 8)
__device__ __forceinline__ float4 f4mul(float4 a, float4 b) { return make_float4(a.x * b.x, a.y * b.y, a.z * b.z, a.w * b.w); }
__device__ __forceinline__ float4 f4add(float4 a, float4 b) { return make_float4(a.x + b.x, a.y + b.y, a.z + b.z, a.w + b.w); }
__device__ __forceinline__ float4 f4scale(float4 a, float s) { return make_float4(a.x * s, a.y * s, a.z * s, a.w * s); }
__device__ __forceinline__ float f4dot(float4 a, float4 b) { return a.x * b.x + a.y * b.y + a.z * b.z + a.w * b.w; }
__device__ __forceinline__ uint2 pk4(float4 v) { return make_uint2(pk2(v.x, v.y), pk2(v.z, v.w)); }
__device__ __forceinline__ float4 up4(uint2 u) { return make_float4(__uint_as_float(u.x << 16), __uint_as_float(u.x & 0xffff0000u), __uint_as_float(u.y << 16), __uint_as_float(u.y & 0xffff0000u)); }
__device__ __forceinline__ float4 ld4h(const bf16_t* p) { return up4(*(const uint2*)p); }

__device__ __forceinline__ void rope32(float* v, int t, const float* tab) {
    const float4* tp = (const float4*)(tab + (size_t)t * 32);
    float cs[32];
#pragma unroll
    for (int i = 0; i < 8; ++i) { const float4 x = tp[i]; cs[4 * i] = x.x; cs[4 * i + 1] = x.y; cs[4 * i + 2] = x.z; cs[4 * i + 3] = x.w; }
#pragma unroll
    for (int i = 0; i < 8; ++i) {
        { const float c = cs[i], sn = cs[8 + i]; const float x1 = v[i], x2 = v[8 + i]; v[i] = x1 * c - x2 * sn; v[8 + i] = x1 * sn + x2 * c; }
        { const float c = cs[16 + i], sn = cs[24 + i]; const float x1 = v[16 + i], x2 = v[24 + i]; v[16 + i] = x1 * c - x2 * sn; v[24 + i] = x1 * sn + x2 * c; }
    }
}
__device__ __forceinline__ int tok_row(bool lat, int b, int t) { return lat ? b * S + t : NLAT + b * CTX + t; }

namespace pg8 {
#define PG8_LAS __attribute__((address_space(3)))
typedef short bf16x8 __attribute__((ext_vector_type(8)));
typedef float f32x4 __attribute__((ext_vector_type(4)));
typedef unsigned u32x4 __attribute__((ext_vector_type(4)));
constexpr int BM = 256, BK = 64, HALF = 128, HTB = HALF * BK * 2  , STAGE_BYTES = 8 * HTB, NXCD = 8, WGM = 16;

__host__ __device__ __forceinline__ int lds_byte(int r, int c) { const int st = (r >> 4) * 2 + (c >> 5), rr = r & 15, cc = c & 31, ob = rr * 64 + cc * 2; return st * 1024 + (ob ^ (((ob >> 9) & 1) << 5)); }
__host__ __device__ __forceinline__ void stage_rc(int b, int& R, int& C) { const int st = b / 1024, sb = b % 1024, swz = sb ^ (((sb >> 9) & 1) << 5); R = (st >> 1) * 16 + swz / 64; C = (st & 1) * 32 + (swz % 64) / 2; }
__host__ __device__ __forceinline__ int perm32(int rho) { const int n = rho >> 4, i = rho & 15; return 8 * (i >> 2) + 4 * n + (i & 3); }

struct Unit { int pm, pn; };
struct Gemm { const bf16_t* A; const bf16_t* Bt; int M, N, K; int grp_tiles; size_t grp_stride; const int* aidx; int a_idx_stride; unsigned a_max; };

struct StaticOrder {
    int nM, nN, nwg, G, c;
    __host__ __device__ void init(int M, int N, int G_, int c_) { nM = M / BM; nN = N / BM; nwg = nM * nN; G = G_; c = c_; }
    __host__ __device__ bool next(int i, Unit& u) const {
        const long L = (long)i * G + c; if (L >= nwg) return false;
        int wgid = (int)L; { const int q = nwg / NXCD, r = nwg % NXCD, xcd = wgid % NXCD, off = wgid / NXCD; wgid = (xcd < r ? xcd * (q + 1) : r * (q + 1) + (xcd - r) * q) + off; }
        const int nig = WGM * nN, gid = wgid / nig, fm = gid * WGM, gsz = (nM - fm) < WGM ? (nM - fm) : WGM;
        u.pm = fm + ((wgid % nig) % gsz); u.pn = (wgid % nig) / gsz; return true;
    }
    __device__ __forceinline__ void a_ready(const Unit&) const {}
    __device__ __forceinline__ void done(const Unit&) const {}
};

__device__ __forceinline__ unsigned cvt_pk_bf16(float lo, float hi) { unsigned r; asm volatile("v_cvt_pk_bf16_f32 %0, %1, %2" : "=v"(r) : "v"(lo), "v"(hi)); return r; }

typedef unsigned u32x2 __attribute__((ext_vector_type(2)));
struct EpiF32 {
    static constexpr bool PERM = false, AFTER_DRAIN = false;
    float* C; int ldc; int ncols;
    __device__ __forceinline__ void operator()(const f32x4 (&acc)[2][2][4][2], const Unit& u, int wr, int wc, int fr, int fq) const {
        const int row0 = u.pm * BM + wr * 64 + fr, col0 = u.pn * BM + wc * 32 + 4 * fq;
#pragma unroll
        for (int ai = 0; ai < 2; ++ai)
#pragma unroll
            for (int m = 0; m < 4; ++m) { float* rowp = C + (size_t)(row0 + ai * HALF + m * 16) * ldc;
#pragma unroll
                for (int bj = 0; bj < 2; ++bj)
#pragma unroll
                    for (int n = 0; n < 2; ++n) { const int col = col0 + bj * HALF + n * 16; if (col < ncols) *(f32x4*)(rowp + col) = acc[ai][bj][m][n]; } }
    }
};
struct EpiRowScaleF32 {
    static constexpr bool PERM = false, AFTER_DRAIN = false;
    float* C; int ldc; const float* gate; int er;
    __device__ __forceinline__ void operator()(const f32x4 (&acc)[2][2][4][2], const Unit& u, int wr, int wc, int fr, int fq) const {
        const int row0 = u.pm * BM + wr * 64 + fr, col0 = u.pn * BM + wc * 32 + 4 * fq;
#pragma unroll
        for (int ai = 0; ai < 2; ++ai)
#pragma unroll
            for (int m = 0; m < 4; ++m) { const int row = row0 + ai * HALF + m * 16; float* rowp = C + (size_t)row * ldc; const float sc = gate[(row / er) * ER_MAX + row % er];
#pragma unroll
                for (int bj = 0; bj < 2; ++bj)
#pragma unroll
                    for (int n = 0; n < 2; ++n) *(f32x4*)(rowp + col0 + bj * HALF + n * 16) = acc[ai][bj][m][n] * sc; }
    }
};
struct EpiSwiGLU {
    static constexpr bool PERM = true, AFTER_DRAIN = false;
    bf16_t* O; int ldo;
    __device__ __forceinline__ void operator()(const f32x4 (&acc)[2][2][4][2], const Unit& u, int wr, int wc, int fr, int fq) const {
        const int row0 = u.pm * BM + wr * 64 + fr, col0 = u.pn * BM + wc * 32 + 8 * fq;
#pragma unroll
        for (int ai = 0; ai < 2; ++ai)
#pragma unroll
            for (int m = 0; m < 4; ++m) { bf16_t* rowp = O + (size_t)(row0 + ai * HALF + m * 16) * ldo;
#pragma unroll
                for (int bj = 0; bj < 2; ++bj) { const f32x4 gt = acc[ai][bj][m][0], up = acc[ai][bj][m][1]; f32x4 h;
#pragma unroll
                    for (int i = 0; i < 4; ++i) h[i] = gt[i] / (1.0f + __expf(-gt[i])) * up[i];
                    u32x2 w; w.x = cvt_pk_bf16(h[0], h[1]); w.y = cvt_pk_bf16(h[2], h[3]);
                    *(u32x2*)(rowp + (col0 + bj * HALF) / 2) = w; } }
    }
};

struct EpiBf16 {
    static constexpr bool PERM = true, AFTER_DRAIN = false;
    bf16_t* O; int ldo; int ncols;
    __device__ __forceinline__ void operator()(const f32x4 (&acc)[2][2][4][2], const Unit& u, int wr, int wc, int fr, int fq) const {
        const int row0 = u.pm * BM + wr * 64 + fr, col0 = u.pn * BM + wc * 32 + 8 * fq;
#pragma unroll
        for (int ai = 0; ai < 2; ++ai)
#pragma unroll
            for (int m = 0; m < 4; ++m) { bf16_t* rowp = O + (size_t)(row0 + ai * HALF + m * 16) * ldo;
#pragma unroll
                for (int bj = 0; bj < 2; ++bj) { const int col = col0 + bj * HALF; const f32x4 v0 = acc[ai][bj][m][0], v1 = acc[ai][bj][m][1];
                    u32x4 w; w.x = cvt_pk_bf16(v0[0], v0[1]); w.y = cvt_pk_bf16(v0[2], v0[3]); w.z = cvt_pk_bf16(v1[0], v1[1]); w.w = cvt_pk_bf16(v1[2], v1[3]);
                    if (col < ncols) *(u32x4*)(rowp + col) = w; } }
    }
};
struct EpiRowScaleBf16 {
    static constexpr bool PERM = true, AFTER_DRAIN = false;
    bf16_t* O; int ldo; const float* gate; int er;
    __device__ __forceinline__ void operator()(const f32x4 (&acc)[2][2][4][2], const Unit& u, int wr, int wc, int fr, int fq) const {
        const int row0 = u.pm * BM + wr * 64 + fr, col0 = u.pn * BM + wc * 32 + 8 * fq;
#pragma unroll
        for (int ai = 0; ai < 2; ++ai)
#pragma unroll
            for (int m = 0; m < 4; ++m) { const int row = row0 + ai * HALF + m * 16; bf16_t* rowp = O + (size_t)row * ldo; const float sc = gate[(row / er) * ER_MAX + row % er];
#pragma unroll
                for (int bj = 0; bj < 2; ++bj) { const f32x4 v0 = acc[ai][bj][m][0] * sc, v1 = acc[ai][bj][m][1] * sc;
                    u32x4 w; w.x = cvt_pk_bf16(v0[0], v0[1]); w.y = cvt_pk_bf16(v0[2], v0[3]); w.z = cvt_pk_bf16(v1[0], v1[1]); w.w = cvt_pk_bf16(v1[2], v1[3]);
                    *(u32x4*)(rowp + col0 + bj * HALF) = w; } }
    }
};
template <class Epi, class Sched, bool ALIGN_EPI = false, bool SP2 = false, bool GATHER = false>
__device__ __forceinline__ void gemm_phase(PG8_LAS unsigned char* lds, const Gemm g, const Sched& S, const Epi& E, int tid_in) {
    int tid_ = tid_in; asm volatile("" : "+v"(tid_));
    const int tid = tid_, wid = __builtin_amdgcn_readfirstlane(tid >> 6), lane = tid & 63, wr = wid >> 2, wc = wid & 3, fr = lane & 15, fq = lane >> 4;
    int K_ = g.K; asm volatile("" : "+s"(K_));
    const int K = K_, nt = K / BK;
    unsigned voffA[2], voffB[2];
#pragma unroll
    for (int i = 0; i < 2; ++i) { int R, C; stage_rc(tid * 16 + i * 8192, R, C); const int Rb = Epi::PERM ? ((R & ~31) + perm32(R & 31)) : R;
        voffA[i] = (unsigned)(R * K + C) * 2u; voffB[i] = (unsigned)(Rb * K + C) * 2u; }
    const size_t kstep = (size_t)(BK * 2);
    const size_t hstep = (size_t)HALF * K * 2;
    const size_t hstepA = GATHER ? (size_t)0 : hstep;
    const size_t tstep = 2 * hstep;
    const unsigned ldsw = (unsigned)wid * 1024u;
    const int aoff = lds_byte(wr * 64 + fr, fq * 8), boff = lds_byte(wc * 32 + fr, fq * 8);
#define PG8_SA(b, h) (((b) * 2 + (h)) * HTB)
#define PG8_SB(b, h) ((4 + (b) * 2 + (h)) * HTB)
#define PG8_STAGE(bufoff, gbase, voff) do { _Pragma("unroll") for (int _i = 0; _i < 2; ++_i) \
        __builtin_amdgcn_global_load_lds((const unsigned*)((const char*)(gbase) + (voff)[_i]), (PG8_LAS unsigned*)(lds + (bufoff) + ldsw + _i * 8192), 16, 0, 0); } while (0)
#define PG8_STAGE_A(bufoff, gbase, h, un) do { if constexpr (GATHER) { const unsigned w0_ = (un) ? vn[h][0] : vc[h][0], w1_ = (un) ? vn[h][1] : vc[h][1]; \
        __builtin_amdgcn_global_load_lds((const unsigned*)((const char*)(gbase) + w0_), (PG8_LAS unsigned*)(lds + (bufoff) + ldsw), 16, 0, 0); \
        __builtin_amdgcn_global_load_lds((const unsigned*)((const char*)(gbase) + w1_), (PG8_LAS unsigned*)(lds + (bufoff) + ldsw + 8192), 16, 0, 0); } \
    else PG8_STAGE(bufoff, gbase, voffA); } while (0)
#define PG8_GLOAD(dst, u) do { _Pragma("unroll") for (int h_ = 0; h_ < 2; ++h_) _Pragma("unroll") for (int i_ = 0; i_ < 2; ++i_) { int R_, C_; stage_rc(tid * 16 + i_ * 8192, R_, C_); \
        const int gq_ = (u).pm / g.grp_tiles, sl_ = ((u).pm - gq_ * g.grp_tiles) * BM + h_ * HALF + R_; dst[h_][i_] = (unsigned)g.aidx[(size_t)gq_ * g.a_idx_stride + sl_]; } } while (0)
#define PG8_GCONV(dst) do { _Pragma("unroll") for (int h_ = 0; h_ < 2; ++h_) _Pragma("unroll") for (int i_ = 0; i_ < 2; ++i_) { int R_, C_; stage_rc(tid * 16 + i_ * 8192, R_, C_); \
        const unsigned ix_ = dst[h_][i_] < g.a_max ? dst[h_][i_] : g.a_max; dst[h_][i_] = ix_ * (unsigned)(K * 2) + (unsigned)C_ * 2u; } } while (0)
#define PG8_LDA(dst, b, h) do { _Pragma("unroll") for (int m = 0; m < 4; ++m) _Pragma("unroll") for (int k = 0; k < 2; ++k) dst[m][k] = *(const PG8_LAS bf16x8*)(lds + PG8_SA(b, h) + aoff + m * 2048 + k * 1024); } while (0)
#define PG8_LDB(dst, b, h) do { _Pragma("unroll") for (int n = 0; n < 2; ++n) _Pragma("unroll") for (int k = 0; k < 2; ++k) dst[n][k] = *(const PG8_LAS bf16x8*)(lds + PG8_SB(b, h) + boff + n * 2048 + k * 1024); } while (0)
#define PG8_MMA(ai, bj, At, Bt) do { __builtin_amdgcn_s_setprio(1); _Pragma("unroll") for (int m = 0; m < 4; ++m) _Pragma("unroll") for (int n = 0; n < 2; ++n) _Pragma("unroll") for (int k = 0; k < 2; ++k) \
        acc[ai][bj][m][n] = __builtin_amdgcn_mfma_f32_16x16x32_bf16(Bt[n][k], At[m][k], acc[ai][bj][m][n], 0, 0, 0); __builtin_amdgcn_s_setprio(0); } while (0)
#define PG8_WAIT_V(n) asm volatile("s_waitcnt vmcnt(" #n ")" ::: "memory")
#define PG8_WAIT_L(n) asm volatile("s_waitcnt lgkmcnt(" #n ")" ::: "memory")
#define PG8_BAR __builtin_amdgcn_s_barrier()
#define PG8_SCHED __builtin_amdgcn_sched_barrier(0)
    Unit cur, nxt; int ui = 0;
    if (!S.next(0, cur)) return;
    f32x4 acc[2][2][4][2];
#pragma unroll
    for (int a = 0; a < 2; ++a)
#pragma unroll
        for (int b = 0; b < 2; ++b)
#pragma unroll
            for (int m = 0; m < 4; ++m)
#pragma unroll
                for (int n = 0; n < 2; ++n) acc[a][b][m][n] = (f32x4){0.f, 0.f, 0.f, 0.f};
    bf16x8 At[4][2], B0[2][2], B1[2][2];
    const char* cA = (const char*)g.A + (GATHER ? (size_t)0 : (size_t)cur.pm * tstep); const char* cB = (const char*)g.Bt + (size_t)cur.pn * tstep + (g.grp_tiles ? (size_t)(cur.pm / g.grp_tiles) * g.grp_stride : (size_t)0);
    unsigned vc[2][2] = {{0u, 0u}, {0u, 0u}}, vn[2][2] = {{0u, 0u}, {0u, 0u}};
    if constexpr (GATHER) { static_assert(SP2, "gather: SP2 path only"); PG8_GLOAD(vc, cur); PG8_GCONV(vc); }
    S.a_ready(cur);
    if constexpr (SP2) {
        PG8_STAGE(PG8_SB(0, 0), cB, voffB); PG8_STAGE(PG8_SB(0, 1), cB + hstep, voffB); PG8_STAGE_A(PG8_SA(0, 0), cA, 0, false); PG8_STAGE_A(PG8_SA(0, 1), cA + hstepA, 1, false);
        if (wr == 1) PG8_BAR;
        PG8_WAIT_V(2); PG8_BAR;
        PG8_STAGE(PG8_SB(1, 0), cB + kstep, voffB); PG8_STAGE_A(PG8_SA(1, 0), cA + kstep, 0, false); PG8_STAGE(PG8_SB(1, 1), cB + hstep + kstep, voffB);
        PG8_WAIT_V(6); PG8_BAR;
    } else {
        PG8_STAGE(PG8_SB(0, 0), cB, voffB); PG8_STAGE_A(PG8_SA(0, 0), cA, 0, false); PG8_STAGE(PG8_SB(0, 1), cB + hstep, voffB); PG8_STAGE_A(PG8_SA(0, 1), cA + hstepA, 1, false);
        if (wr == 1) PG8_BAR;
        PG8_WAIT_V(4); PG8_BAR;
        PG8_STAGE(PG8_SB(1, 0), cB + kstep, voffB); PG8_STAGE_A(PG8_SA(1, 0), cA + kstep, 0, false); PG8_STAGE(PG8_SB(1, 1), cB + hstep + kstep, voffB);
        PG8_WAIT_V(6); PG8_BAR;
    }
    for (;;) {
        const bool has_next = S.next(ui + 1, nxt);
        if constexpr (GATHER) { if (has_next) PG8_GLOAD(vn, nxt); else { vn[0][0] = vc[0][0]; vn[0][1] = vc[0][1]; vn[1][0] = vc[1][0]; vn[1][1] = vc[1][1]; } }
        const char* nA = has_next ? (const char*)g.A + (GATHER ? (size_t)0 : (size_t)nxt.pm * tstep) : cA; const char* nB = has_next ? (const char*)g.Bt + (size_t)nxt.pn * tstep + (g.grp_tiles ? (size_t)(nxt.pm / g.grp_tiles) * g.grp_stride : (size_t)0) : cB;
        for (int t = 0; t < nt; t += 2) {
            const bool last = (t == nt - 2);
            if constexpr (GATHER) { if (t == 4 && has_next) PG8_GCONV(vn); }
            const char* a1 = cA + (size_t)(t + 1) * kstep;
            const char* a2 = last ? nA : cA + (size_t)(t + 2) * kstep; const char* b2 = last ? nB : cB + (size_t)(t + 2) * kstep;
            const char* a3 = a2 + kstep; const char* b3 = b2 + kstep;
            if (last && has_next) S.a_ready(nxt);
            if constexpr (SP2) {
            PG8_LDB(B0, 0, 0); PG8_LDB(B1, 0, 1); PG8_SCHED; PG8_LDA(At, 0, 0); PG8_STAGE_A(PG8_SA(1, 1), a1 + hstepA, 1, false);
            PG8_WAIT_V(8); PG8_WAIT_L(0); PG8_BAR; PG8_MMA(0, 0, At, B0); PG8_MMA(0, 1, At, B1); PG8_BAR; PG8_SCHED;
            PG8_LDA(At, 0, 1); PG8_STAGE(PG8_SB(0, 0), b2, voffB); PG8_STAGE(PG8_SB(0, 1), b2 + hstep, voffB); PG8_STAGE_A(PG8_SA(0, 0), a2, 0, last);
            PG8_WAIT_V(8); PG8_WAIT_L(0); PG8_BAR; PG8_MMA(1, 0, At, B0); PG8_MMA(1, 1, At, B1); PG8_BAR; PG8_SCHED;
            PG8_LDB(B0, 1, 0); PG8_LDB(B1, 1, 1); PG8_SCHED; PG8_LDA(At, 1, 0); PG8_STAGE_A(PG8_SA(0, 1), a2 + hstepA, 1, last);
            PG8_WAIT_V(8); PG8_WAIT_L(0); PG8_BAR; PG8_MMA(0, 0, At, B0); PG8_MMA(0, 1, At, B1); PG8_BAR; PG8_SCHED;
            PG8_LDA(At, 1, 1); PG8_STAGE(PG8_SB(1, 0), b3, voffB); PG8_STAGE(PG8_SB(1, 1), b3 + hstep, voffB); PG8_STAGE_A(PG8_SA(1, 0), a3, 0, last);
            PG8_WAIT_V(8); PG8_WAIT_L(0); PG8_BAR; PG8_MMA(1, 0, At, B0); PG8_MMA(1, 1, At, B1); PG8_BAR; PG8_SCHED;
            } else {
            PG8_LDB(B0, 0, 0); PG8_SCHED; PG8_LDA(At, 0, 0); PG8_STAGE_A(PG8_SA(1, 1), a1 + hstepA, 1, false);
            PG8_WAIT_L(8); PG8_BAR; PG8_WAIT_L(0); PG8_MMA(0, 0, At, B0); PG8_BAR; PG8_SCHED;
            PG8_LDB(B1, 0, 1); PG8_STAGE(PG8_SB(0, 0), b2, voffB);
            PG8_BAR; PG8_WAIT_L(0); PG8_MMA(0, 1, At, B1); PG8_BAR;
            PG8_LDA(At, 0, 1); PG8_STAGE_A(PG8_SA(0, 0), a2, 0, last);
            PG8_BAR; PG8_WAIT_L(0); PG8_MMA(1, 0, At, B0); PG8_BAR; PG8_SCHED;
            PG8_STAGE(PG8_SB(0, 1), b2 + hstep, voffB);
            PG8_WAIT_V(6); PG8_BAR; PG8_MMA(1, 1, At, B1); PG8_BAR;
            PG8_LDB(B0, 1, 0); PG8_SCHED; PG8_LDA(At, 1, 0); PG8_STAGE_A(PG8_SA(0, 1), a2 + hstepA, 1, last);
            PG8_WAIT_L(8); PG8_BAR; PG8_WAIT_L(0); PG8_MMA(0, 0, At, B0); PG8_BAR; PG8_SCHED;
            PG8_LDB(B1, 1, 1); PG8_STAGE(PG8_SB(1, 0), b3, voffB);
            PG8_BAR; PG8_WAIT_L(0); PG8_MMA(0, 1, At, B1); PG8_BAR;
            PG8_LDA(At, 1, 1); PG8_STAGE_A(PG8_SA(1, 0), a3, 0, last);
            PG8_BAR; PG8_WAIT_L(0); PG8_MMA(1, 0, At, B0); PG8_BAR; PG8_SCHED;
            PG8_STAGE(PG8_SB(1, 1), b3 + hstep, voffB);
            PG8_WAIT_V(6); PG8_BAR; PG8_MMA(1, 1, At, B1); PG8_BAR;
            }
        }
        if constexpr (ALIGN_EPI) { if (wr == 0) PG8_BAR; }
        if constexpr (!Epi::AFTER_DRAIN) { E(acc, cur, wr, wc, fr, fq); S.done(cur); }
        if (!has_next) break;
#pragma unroll
        for (int a = 0; a < 2; ++a)
#pragma unroll
            for (int b = 0; b < 2; ++b)
#pragma unroll
                for (int m = 0; m < 4; ++m)
#pragma unroll
                    for (int n = 0; n < 2; ++n) acc[a][b][m][n] = (f32x4){0.f, 0.f, 0.f, 0.f};
        cur = nxt; cA = nA; cB = nB; ++ui;
        if constexpr (GATHER) { vc[0][0] = vn[0][0]; vc[0][1] = vn[0][1]; vc[1][0] = vn[1][0]; vc[1][1] = vn[1][1]; }
        if constexpr (ALIGN_EPI) { if (wr == 1) PG8_BAR; }
    }
    PG8_WAIT_V(0);
    if constexpr (!ALIGN_EPI) { if (wr == 0) PG8_BAR; }
    PG8_BAR;
    if constexpr (Epi::AFTER_DRAIN) { E.fused(acc, cur, wr, wc, fr, fq, lds, wid, lane); S.done(cur); }
#undef PG8_SA
#undef PG8_SB
#undef PG8_STAGE
#undef PG8_STAGE_A
#undef PG8_GLOAD
#undef PG8_GCONV
#undef PG8_LDA
#undef PG8_LDB
#undef PG8_MMA
#undef PG8_WAIT_V
#undef PG8_WAIT_L
#undef PG8_BAR
#undef PG8_SCHED
}
}


#define XB_TMO      128
#define XB_XCNT(j)  (256  + 64 * (j))
#define XB_XSUB(j)  (1280 + 64 * (j))
#define XB_XGEN(j)  (2304 + 64 * (j))
#define XB_TOP      3328
#define XB_TOPGEN   3392
#define XCD_BAR_WORDS 3456
#define XB_SPIN_CAP (1u << 22)
__device__ __forceinline__ unsigned xb_ld(unsigned* p)              { return __hip_atomic_load(p, __ATOMIC_RELAXED, __HIP_MEMORY_SCOPE_AGENT); }
__device__ __forceinline__ unsigned xb_add(unsigned* p, unsigned v) { return __hip_atomic_fetch_add(p, v, __ATOMIC_RELAXED, __HIP_MEMORY_SCOPE_AGENT); }
__device__ __forceinline__ unsigned xb_xcc_id() { return (unsigned)__builtin_amdgcn_s_getreg((3 << 11) | 20) & 0xFu; }
#define XB_SPIN(cond, bar) do { unsigned _sp = 0; while (cond) { __builtin_amdgcn_s_sleep(1); \
    if ((++_sp & 255u) == 0u) { if (xb_ld(&(bar)[XB_TMO])) break; if (_sp > XB_SPIN_CAP) { atomicAdd(&(bar)[XB_TMO], 1u); break; } } } } while (0)
struct XcdBarrier { unsigned* bar; unsigned x; volatile LAS unsigned* st; };
__device__ __forceinline__ XcdBarrier xcd_barrier_post(unsigned* bar, volatile LAS unsigned* st, int tid_in) {
    XcdBarrier b; b.bar = bar; b.x = xb_xcc_id(); b.st = st;
    if (tid_in == 0) (void)xb_add(&bar[XB_XCNT(b.x)], 1u);
    return b;
}
__device__ __forceinline__ void xcd_barrier_complete(unsigned* bar, unsigned x, unsigned& nloc, unsigned& nx) {
    const unsigned G = gridDim.x * gridDim.y * gridDim.z;
    unsigned sum, cnt, mine, sp = 0u;
    for (;;) {
        sum = 0u; cnt = 0u; mine = 0u;
#pragma unroll
        for (unsigned j = 0; j < 16; ++j) { const unsigned c = xb_ld(&bar[XB_XCNT(j)]); sum += c; cnt += (c > 0u) ? 1u : 0u; mine = (j == x) ? c : mine; }
        if (sum == G) break;
        __builtin_amdgcn_s_sleep(1);
        if ((++sp & 255u) == 0u) { if (xb_ld(&bar[XB_TMO])) break; if (sp > XB_SPIN_CAP) { atomicAdd(&bar[XB_TMO], 1u); break; } }
    }
    nloc = mine > 0u ? mine : 1u; nx = cnt > 0u ? cnt : 1u;
}
__device__ __forceinline__ void xcd_barrier(const XcdBarrier& b, int tid_in) {
    asm volatile("s_waitcnt vmcnt(0)" ::: "memory");
    __syncthreads();
    if (tid_in == 0) {
        unsigned* bar = b.bar;
        __builtin_amdgcn_s_waitcnt(0);
        unsigned nloc = b.st[0], nx = b.st[1];
        if (nloc == 0u) { xcd_barrier_complete(bar, b.x, nloc, nx); b.st[0] = nloc; b.st[1] = nx; }
        const unsigned old = xb_add(&bar[XB_XSUB(b.x)], 1u);
        const unsigned gen = old / nloc;
        if (old + 1u == (gen + 1u) * nloc) {
            __builtin_amdgcn_fence(__ATOMIC_RELEASE, "agent");
            asm volatile("s_waitcnt vmcnt(0)" ::: "memory");
            const unsigned og = xb_add(&bar[XB_TOP], 1u);
            const unsigned tg = og / nx;
            if (og + 1u == (tg + 1u) * nx) xb_add(&bar[XB_TOPGEN], 1u);
            else XB_SPIN(xb_ld(&bar[XB_TOPGEN]) == tg, bar);
            __builtin_amdgcn_fence(__ATOMIC_ACQUIRE, "agent");
            xb_add(&bar[XB_XGEN(b.x)], 1u);
            asm volatile("s_waitcnt vmcnt(0)" ::: "memory");
        } else {
            XB_SPIN(xb_ld(&bar[XB_XGEN(b.x)]) == gen, bar);
            __builtin_amdgcn_fence(__ATOMIC_ACQUIRE, "agent");
            asm volatile("s_waitcnt vmcnt(0)" ::: "memory");
        }
    }
    __syncthreads();
}


typedef short bf16x8 __attribute__((ext_vector_type(8)));
typedef short s16x4 __attribute__((ext_vector_type(4)));
typedef float f32x16 __attribute__((ext_vector_type(16)));
typedef unsigned v4u __attribute__((ext_vector_type(4)));
typedef unsigned v2u __attribute__((ext_vector_type(2)));
constexpr int MOE_TILES = NE * 3 * 512;
constexpr float ATT_THR = 5.0f;
template <int DK> struct AttL { static constexpr int KSTR = DK * 2 + 16, KBYTES = 64 * KSTR, VSTR = 192, VBYTES = 64 * VSTR, KPT = 64 * DK / 4 / NTHREADS;
    static constexpr int K_OFF = 0, V_OFF = 2 * KBYTES; };

struct CvArgs { const float* wg; const float* wu; const float* wd; bf16_t* gu; bf16_t* dn; int id0; };
template <int DK, bool CONV>
__device__ __forceinline__ void attn_pass(const bf16_t* Qrow, const bf16_t* Kp, const bf16_t* Vc, const bf16_t* Vl, int vstride, int nkt, LAS unsigned char* lds, int tid, f32x16 (&oacc)[2], float& l_run, const CvArgs& cvp) {
    typedef AttL<DK> L;
    constexpr bool AUG = DK <= 32;
    const int lane = tid & 63, r = lane & 31, h = lane >> 5;
    bf16x8 qf[DK / 16];
#pragma unroll
    for (int ks = 0; ks < DK / 16; ++ks) qf[ks] = *(const bf16x8*)(Qrow + 16 * ks + 8 * h);
    const short z_ = (short)(tid >> 20);
    bf16x8 aone = {z_, z_, z_, z_, z_, z_, z_, z_}, bneg = {z_, z_, z_, z_, z_, z_, z_, z_};
    if (h == 0) aone[0] = (short)0x3F80;
    float m_run = 0.f;
    typedef float f32x4v __attribute__((ext_vector_type(4)));
    float lrun0 = (float)z_, lrun1 = (float)z_;
    bf16x8 aones = {z_, z_, z_, z_, z_, z_, z_, z_};
    if ((lane & 15) < 2 && (lane & 15) == ((lane >> 4) & 1)) aones = (bf16x8){(short)0x3F80, (short)0x3F80, (short)0x3F80, (short)0x3F80, (short)0x3F80, (short)0x3F80, (short)0x3F80, (short)0x3F80};
    v2u kreg[L::KPT]; v4u vreg;
    float cv[8]; const float* csrc = cvp.wg; int cid = 0, cpart = 0;
    { const unsigned zu_ = (unsigned)tid >> 20; const v4u z4_ = {zu_, zu_, zu_, zu_}; const v2u z2_ = {zu_, zu_}; vreg = z4_;
#pragma unroll
      for (int i_ = 0; i_ < L::KPT; ++i_) kreg[i_] = z2_;
#pragma unroll
      for (int i_ = 0; i_ < 8; ++i_) cv[i_] = __uint_as_float(zu_); }
    const int vd = tid >> 3, vpart = tid & 7;
    const unsigned koff = (unsigned)tid * 8u, voff = ((unsigned)vd * (unsigned)vstride + (unsigned)vpart * 8u) * 2u, lane4 = (unsigned)lane * 4u;
#define ATT_LOADK(j) do { const char* kb_ = (const char*)Kp + (size_t)(j) * (64 * DK * 2); _Pragma("unroll") for (int i_ = 0; i_ < L::KPT; ++i_) kreg[i_] = *(const v2u*)(kb_ + (koff + (unsigned)i_ * (NTHREADS * 8u))); } while (0)
#define ATT_LOADV(j) do { const int j_ = (j); const char* vb_ = (const char*)(j_ < CTX / 64 ? Vc + (size_t)j_ * 64 * vstride : Vl + (size_t)(j_ - CTX / 64) * 64 * vstride); vreg = *(const v4u*)(vb_ + voff); } while (0)
#define ATT_STOREK(buf) do { _Pragma("unroll") for (int i_ = 0; i_ < L::KPT; ++i_) { const int c_ = tid + i_ * NTHREADS; const int key_ = c_ / (DK / 4), part_ = c_ % (DK / 4); \
            *(LAS v2u*)(lds + L::K_OFF + (buf) * L::KBYTES + key_ * L::KSTR + part_ * 8) = kreg[i_]; } } while (0)
#define ATT_STOREV(buf) do { LAS unsigned char* vp_ = lds + L::V_OFF + (buf) * L::VBYTES + vd * L::VSTR + vpart * 16; *(LAS v2u*)vp_ = (v2u){vreg.x, vreg.y}; *(LAS v2u*)(vp_ + 8) = (v2u){vreg.z, vreg.w}; } while (0)
#define ATT_KFRAG(buf, f) (*(const LAS bf16x8*)(lds + L::K_OFF + (buf) * L::KBYTES + (32 * ((f) / (DK / 16)) + r) * L::KSTR + (16 * ((f) % (DK / 16)) + 8 * h) * 2))
#define ATT_QK(dst, buf) do { constexpr int NF_ = 2 * (DK / 16), PD_ = NF_ < 4 ? NF_ : 4; bf16x8 ka_[NF_];         \
        _Pragma("unroll") for (int f = 0; f < PD_; ++f) ka_[f] = ATT_KFRAG(buf, f); \
        SCHED_FENCE(); \
        _Pragma("unroll") for (int kb = 0; kb < 2; ++kb) { _Pragma("unroll") for (int i = 0; i < 16; ++i) dst[kb][i] = 0.f; \
            if (AUG) dst[kb] = __builtin_amdgcn_mfma_f32_32x32x16_bf16(aone, bneg, dst[kb], 0, 0, 0); } \
        _Pragma("unroll") for (int f = 0; f < NF_; ++f) { const int kb = f / (DK / 16), ks = f % (DK / 16); \
            dst[kb] = __builtin_amdgcn_mfma_f32_32x32x16_bf16(ka_[f], qf[ks], dst[kb], 0, 0, 0); \
            if (f + PD_ < NF_) { ka_[f + PD_] = ATT_KFRAG(buf, f + PD_); SCHED_FENCE(); } } } while (0)
#define ATT_CV_PRE(R, j) do { if (CONV) { \
        if ((R) == 0) { const int ss_ = min((j) >> 2, 15); cid = min(cvp.id0 + (ss_ >> 2), MOE_TILES - 1); cpart = ss_ & 3; \
            const int mat_ = cid >> 9, tl_ = cid & 511, e_ = mat_ / 3, wh_ = mat_ - 3 * e_; \
            csrc = (wh_ == 0 ? cvp.wg : wh_ == 1 ? cvp.wu : cvp.wd) + (size_t)e_ * D * FF + (size_t)((tl_ >> 4) * 32 + 8 * cpart) * 1024 + (tl_ & 15) * 64; } \
        constexpr int i0_ = (R) == 0 ? 0 : (R) == 1 ? 3 : 6, i1_ = (R) == 0 ? 3 : (R) == 1 ? 6 : (R) == 2 ? 8 : 6; \
        _Pragma("unroll") for (int i_ = i0_; i_ < i1_; ++i_) cv[i_] = *(const float*)((const char*)csrc + (size_t)i_ * 4096 + lane4); } } while (0)
#define ATT_CV_POST(R) do { if (CONV && (R) == 3) { \
        const int mat_ = cid >> 9, tl_ = cid & 511, e_ = mat_ / 3, wh_ = mat_ - 3 * e_, n_ = (tl_ & 15) * 64 + lane; \
        const int row_ = wh_ == 2 ? n_ : ((n_ >> 2) * 8 + (n_ & 3) + 4 * wh_); \
        char* db_ = (char*)(wh_ == 2 ? cvp.dn + (size_t)e_ * D * FF : cvp.gu + (size_t)e_ * 2 * FF * D) + ((tl_ >> 4) * 32 + 8 * cpart) * 2; \
        *(uint4*)(db_ + (unsigned)row_ * 2048u) = make_uint4(pk2(cv[0], cv[1]), pk2(cv[2], cv[3]), pk2(cv[4], cv[5]), pk2(cv[6], cv[7])); } } while (0)
#define ATT_BODY(SC, SN, j, CHK, R) do { \
        ATT_STOREK((j) & 1);                                \
        ATT_STOREV(((j) + 1) & 1);                          \
        ATT_LOADK(min((j) + 3, nkt - 1));                   \
        ATT_LOADV(min((j) + 2, nkt - 1)); \
        ATT_CV_PRE(R, j); \
        ATT_QK(SN, ((j) + 1) & 1);                          \
        if (CHK) { \
            float t0 = fmaxf(fmaxf(SC[0][0], SC[0][1]), SC[0][2]), t1 = fmaxf(fmaxf(SC[0][3], SC[0][4]), SC[0][5]), t2 = fmaxf(fmaxf(SC[0][6], SC[0][7]), SC[0][8]), t3 = fmaxf(fmaxf(SC[0][9], SC[0][10]), SC[0][11]); \
            float t4 = fmaxf(fmaxf(SC[0][12], SC[0][13]), SC[0][14]), t5 = fmaxf(fmaxf(SC[0][15], SC[1][0]), SC[1][1]), t6 = fmaxf(fmaxf(SC[1][2], SC[1][3]), SC[1][4]), t7 = fmaxf(fmaxf(SC[1][5], SC[1][6]), SC[1][7]); \
            float t8 = fmaxf(fmaxf(SC[1][8], SC[1][9]), SC[1][10]), t9 = fmaxf(fmaxf(SC[1][11], SC[1][12]), SC[1][13]), t10 = fmaxf(SC[1][14], SC[1][15]); \
            float tmax = fmaxf(fmaxf(fmaxf(fmaxf(t0, t1), t2), fmaxf(fmaxf(t3, t4), t5)), fmaxf(fmaxf(fmaxf(t6, t7), t8), fmaxf(t9, t10))); \
            tmax = xor32_max(tmax); if (!AUG) tmax -= m_run;            \
            if ((j) == 0 || __any(tmax > ATT_THR)) {                   \
                const float want = (j) == 0 ? tmax : m_run + fmaxf(tmax, 0.f); \
                const float mn = __uint_as_float(pk2(want, 0.f) << 16), dlt = mn - m_run, alpha = __builtin_amdgcn_exp2f(-dlt); \
                _Pragma("unroll") for (int i = 0; i < 16; ++i) { oacc[0][i] *= alpha; oacc[1][i] *= alpha; if (AUG) { SC[0][i] -= dlt; SC[1][i] -= dlt; SN[0][i] -= dlt; SN[1][i] -= dlt; } } \
                { const float a16_ = __builtin_bit_cast(float, __builtin_amdgcn_ds_bpermute(((lane & 15) + 16) * 4, __builtin_bit_cast(int, alpha))); lrun0 *= alpha; lrun1 *= a16_; }     \
                m_run = mn; if (AUG && h == 0) bneg[0] = (short)(__float_as_uint(-mn) >> 16); \
            } \
        } \
        _Pragma("unroll") for (int kb = 0; kb < 2; ++kb) \
            _Pragma("unroll") for (int i = 0; i < 16; i += 4) { const float mo = AUG ? 0.f : m_run; const float p0 = __builtin_amdgcn_exp2f(SC[kb][i] - mo), p1 = __builtin_amdgcn_exp2f(SC[kb][i + 1] - mo), p2 = __builtin_amdgcn_exp2f(SC[kb][i + 2] - mo), p3 = __builtin_amdgcn_exp2f(SC[kb][i + 3] - mo); \
                SC[kb][i] = p0; SC[kb][i + 1] = p1; SC[kb][i + 2] = p2; SC[kb][i + 3] = p3; } \
        f32x4v lacc = {0.f, 0.f, 0.f, 0.f}; \
        {     \
            union AF_ { bf16x8 v; s16x4 q[2]; }; AF_ afb[2][2]; \
              \
            const LAS unsigned char* vb_ = lds + L::V_OFF + ((j) & 1) * L::VBYTES + (4 * h + ((lane & 15) >> 2)) * L::VSTR + (16 * ((lane >> 4) & 1) + 4 * (lane & 3)) * 2; \
            _Pragma("unroll") for (int db = 0; db < 2; ++db) { const LAS unsigned char* vp = vb_ + 64 * db; afb[0][db].q[0] = __builtin_amdgcn_ds_read_tr16_b64_v4i16((LAS s16x4*)vp); afb[0][db].q[1] = __builtin_amdgcn_ds_read_tr16_b64_v4i16((LAS s16x4*)(vp + 8 * L::VSTR)); } \
            _Pragma("unroll") for (int g = 0; g < 4; ++g) { const int kb = g >> 1, s2 = g & 1; \
                union { bf16x8 v; unsigned u[4]; } pf; \
                _Pragma("unroll") for (int i = 0; i < 4; ++i) pf.u[i] = pk2(SC[kb][8 * s2 + 2 * i], SC[kb][8 * s2 + 2 * i + 1]); \
                if (g < 3) { _Pragma("unroll") for (int db = 0; db < 2; ++db) { const LAS unsigned char* vp = vb_ + 64 * db + (g + 1) * 16 * L::VSTR; afb[(g + 1) & 1][db].q[0] = __builtin_amdgcn_ds_read_tr16_b64_v4i16((LAS s16x4*)vp); afb[(g + 1) & 1][db].q[1] = __builtin_amdgcn_ds_read_tr16_b64_v4i16((LAS s16x4*)(vp + 8 * L::VSTR)); } } \
                SCHED_FENCE(); \
                lacc = __builtin_amdgcn_mfma_f32_16x16x32_bf16(aones, pf.v, lacc, 0, 0, 0); \
                _Pragma("unroll") for (int db = 0; db < 2; ++db) oacc[db] = __builtin_amdgcn_mfma_f32_32x32x16_bf16(afb[g & 1][db].v, pf.v, oacc[db], 0, 0, 0); \
            } \
        } \
        lrun0 += lacc[0]; lrun1 += lacc[1]; \
        ATT_CV_POST(R); \
        __syncthreads(); \
    } while (0)
    __syncthreads();
    { v2u k1_[L::KPT]; ATT_LOADK(0); ATT_LOADV(0);
#pragma unroll
      for (int i_ = 0; i_ < L::KPT; ++i_) k1_[i_] = *(const v2u*)((const char*)Kp + (size_t)(64 * DK * 2) + (koff + (unsigned)i_ * (NTHREADS * 8u)));
      ATT_STOREK(0); ATT_STOREV(0);
#pragma unroll
      for (int i_ = 0; i_ < L::KPT; ++i_) kreg[i_] = k1_[i_];
      ATT_STOREK(1);
      ATT_LOADK(2); ATT_LOADV(1); }
    __syncthreads();
    f32x16 sa[2], sb[2];
#pragma unroll
    for (int i = 0; i < 16; ++i) { sb[0][i] = (float)z_; sb[1][i] = (float)z_; }
    ATT_QK(sa, 0);
    __syncthreads();
    if (CONV) {
        for (int j = 0; j < nkt; j += 4) {
            ATT_BODY(sa, sb, j, true, 0);
            ATT_BODY(sb, sa, j + 1, false, 1);
            ATT_BODY(sa, sb, j + 2, false, 2);
            ATT_BODY(sb, sa, j + 3, false, 3);
        }
    } else {
        for (int j = 0; j < nkt; j += 2) {
            ATT_BODY(sa, sb, j, ((j & 3) == 0), -1);
            ATT_BODY(sb, sa, j + 1, false, -1);
        }
    }
    { const float l0_ = __builtin_bit_cast(float, __builtin_amdgcn_ds_bpermute((r & 15) * 4, __builtin_bit_cast(int, lrun0))), l1_ = __builtin_bit_cast(float, __builtin_amdgcn_ds_bpermute((r & 15) * 4, __builtin_bit_cast(int, lrun1)));
      l_run += h == 0 ? (r < 16 ? l0_ : l1_) : 0.f; }
#undef ATT_BODY
#undef ATT_CV_PRE
#undef ATT_CV_POST
#undef ATT_LOADK
#undef ATT_LOADV
#undef ATT_STOREK
#undef ATT_STOREV
#undef ATT_QK
#undef ATT_KFRAG
}


constexpr int SLD = 65, SHLD = 72, XTLD = 260;
#define XTI(row, col) ((row) * XTLD + (col) + 4 * ((row) >> 2))
__device__ __forceinline__ int rm32(int t, int h) { return (t & 3) + 8 * (t >> 2) + 4 * h; }
template <bool WITH_Y>
__device__ __forceinline__ void ssd_block(int b, int dir, int k, int hp, const bf16_t* xbc, const float* dtp, const float* alog, bf16_t* hs, float* alast, bf16_t* yd, float* lds, int tid) {
    const bool lat = k >= 2; const int c = lat ? (dir ? 33 - k : k - 2) : (dir ? 1 - k : k);
    const int row0 = tok_row(lat, b, c * 128), g = hp >> 1;
    float* sB = lds; bf16_t* sBh = (bf16_t*)lds; bf16_t* sCh = sBh + 128 * SHLD;
    float* sX = WITH_Y ? lds + (2 * 128 * SHLD * 2) / 4 : sB + 128 * SLD; bf16_t* sXT = (bf16_t*)sX;
    float* sDT = sX + 17408;            float* sCum = sDT + 256; float* sW = sCum + 256; float* sSc = sW + 256;
    const int wave = tid >> 6, lane = tid & 63, r = lane & 31, h = lane >> 5, hl = wave >> 2, head = 2 * hp + hl;
    bf16_t* hsp = hs + (((size_t)(b * 2 + dir) * NCH + k) * 8 + head) * 4096;
    union { bf16x8 v; unsigned u[4]; } hfrag[WITH_Y ? 8 : 1];
    if (WITH_Y) {
#pragma unroll
        for (int Pb = 0; Pb < 2; ++Pb)
#pragma unroll
            for (int ks = 0; ks < 4; ++ks) { const uint4 x0 = *(const uint4*)(hsp + (32 * Pb + r) * 64 + 16 * ks + 8 * h);
                hfrag[Pb * 4 + ks].u[0] = x0.x; hfrag[Pb * 4 + ks].u[1] = x0.y; hfrag[Pb * 4 + ks].u[2] = x0.z; hfrag[Pb * 4 + ks].u[3] = x0.w; }
    }
    uint2 vb[8]; float4 vx[8]; float dx[8]; float dtv = 0.f, dav = 0.f;
#pragma unroll
    for (int u = 0; u < 8; ++u) { const int c4 = tid & 31, t = 2 * ((tid >> 5) + 16 * (u >> 1)) + (u & 1);
        vb[u] = *(const uint2*)(xbc + (size_t)(row0 + t) * 768 + 512 + (c4 >> 4) * 128 + g * 64 + (c4 & 15) * 4);
        vx[u] = ld4h(xbc + (size_t)(row0 + t) * 768 + hp * 128 + c4 * 4);
        dx[u] = dtp[(size_t)(row0 + t) * 16 + dir * 8 + 2 * hp + (c4 >> 4)]; }
    if (tid < 256) { const int hl = tid >> 7, sI = tid & 127, t = dir ? 127 - sI : sI, h = 2 * hp + hl; dtv = dtp[(size_t)(row0 + t) * 16 + dir * 8 + h]; dav = dtv * -expf(alog[dir * 8 + h]); }
    __syncthreads();
    bf16_t* s1BT = (bf16_t*)lds; bf16_t* s1XT = s1BT + 64 * XTLD;
    if (WITH_Y) {
#pragma unroll
    for (int u = 0; u < 8; ++u) { const int c4 = tid & 31, t = 2 * ((tid >> 5) + 16 * (u >> 1)) + (u & 1);
        *(uint2*)((c4 >> 4 ? sCh : sBh) + t * SHLD + (c4 & 15) * 4) = vb[u]; }
#pragma unroll
    for (int u2 = 0; u2 < 4; ++u2) { const int c4 = tid & 31, t = 2 * ((tid >> 5) + 16 * u2); const float4 xa = f4scale(vx[2 * u2], dx[2 * u2]), xb = f4scale(vx[2 * u2 + 1], dx[2 * u2 + 1]);
        *(unsigned*)(sXT + XTI(c4 * 4 + 0, t)) = pk2(xa.x, xb.x); *(unsigned*)(sXT + XTI(c4 * 4 + 1, t)) = pk2(xa.y, xb.y); *(unsigned*)(sXT + XTI(c4 * 4 + 2, t)) = pk2(xa.z, xb.z); *(unsigned*)(sXT + XTI(c4 * 4 + 3, t)) = pk2(xa.w, xb.w); }
    }
    float cu = dav;
    if (tid < 256) {
#define SCAN_STEP(ctrl, rmask, bctl) cu += __builtin_bit_cast(float, __builtin_amdgcn_update_dpp(0, __builtin_bit_cast(int, cu), ctrl, rmask, 0xf, bctl))
        SCAN_STEP(0x111, 0xf, true); SCAN_STEP(0x112, 0xf, true); SCAN_STEP(0x114, 0xf, true); SCAN_STEP(0x118, 0xf, true); SCAN_STEP(0x142, 0xa, false); SCAN_STEP(0x143, 0xc, false);
#undef SCAN_STEP
        if (lane == 63) sSc[wave] = cu; }
    __syncthreads();
    if (tid < 256) { const int hl = tid >> 7, sI = tid & 127, t = dir ? 127 - sI : sI; const float t0 = sSc[hl * 2], t1 = sSc[hl * 2 + 1], tot = t0 + t1; if (wave & 1) cu += t0;
        sCum[hl * 128 + t] = cu; sW[hl * 128 + t] = expf(tot - cu);
        if (!WITH_Y && sI == 127) alast[((size_t)(b * 2 + dir) * NCH + k) * 8 + 2 * hp + hl] = tot; }
    __syncthreads();
    if (WITH_Y) {
        const int I = hl ? 3 - (wave & 3) : (wave & 3), ti = 32 * I + r;
        const float cum_i = sCum[hl * 128 + ti];
        f32x16 Y[2], Yo[2];
#pragma unroll
        for (int i = 0; i < 16; ++i) { Y[0][i] = 0.f; Y[1][i] = 0.f; Yo[0][i] = 0.f; Yo[1][i] = 0.f; }
        bf16x8 cfrag[4];
#pragma unroll
        for (int ks = 0; ks < 4; ++ks) cfrag[ks] = *(const bf16x8*)(sCh + (32 * I + r) * SHLD + 16 * ks + 8 * h);
#pragma unroll
        for (int Pb = 0; Pb < 2; ++Pb)
#pragma unroll
            for (int ks = 0; ks < 4; ++ks) Yo[Pb] = __builtin_amdgcn_mfma_f32_32x32x16_bf16(hfrag[Pb * 4 + ks].v, cfrag[ks], Yo[Pb], 0, 0, 0);
        const int J0 = dir ? I : 0, J1 = dir ? 3 : I;
        for (int J = J0; J <= J1; ++J) {
            bf16x8 bfr[4]; float4 cj4[4]; union { bf16x8 v; uint2 u[2]; } af[2][2];
#pragma unroll
            for (int ks = 0; ks < 4; ++ks) bfr[ks] = *(const bf16x8*)(sBh + (32 * J + r) * SHLD + 16 * ks + 8 * h);
#pragma unroll
            for (int q = 0; q < 4; ++q) cj4[q] = *(const float4*)(sCum + hl * 128 + 32 * J + 8 * q + 4 * h);
#pragma unroll
            for (int s2 = 0; s2 < 2; ++s2)
#pragma unroll
                for (int Pb = 0; Pb < 2; ++Pb) { const bf16_t* xp = sXT + XTI(hl * 64 + 32 * Pb + r, 32 * J + 16 * s2 + 4 * h); af[s2][Pb].u[0] = *(const uint2*)xp; af[s2][Pb].u[1] = *(const uint2*)(xp + 8); }
            SCHED_FENCE();
            f32x16 Gt;
#pragma unroll
            for (int i = 0; i < 16; ++i) Gt[i] = 0.f;
#pragma unroll
            for (int ks = 0; ks < 4; ++ks) Gt = __builtin_amdgcn_mfma_f32_32x32x16_bf16(bfr[ks], cfrag[ks], Gt, 0, 0, 0);
#pragma unroll
            for (int t = 0; t < 16; ++t) { const int tj = 32 * J + rm32(t, h); const bool valid = (J != I) || (dir ? tj >= ti : tj <= ti);
                const float cj = (t & 3) == 0 ? cj4[t >> 2].x : (t & 3) == 1 ? cj4[t >> 2].y : (t & 3) == 2 ? cj4[t >> 2].z : cj4[t >> 2].w;
                Gt[t] *= valid ? __expf(cum_i - cj) : 0.f; }
#pragma unroll
            for (int s2 = 0; s2 < 2; ++s2) {
                union { bf16x8 v; unsigned u[4]; } pf;
#pragma unroll
                for (int i = 0; i < 4; ++i) pf.u[i] = pk2(Gt[8 * s2 + 2 * i], Gt[8 * s2 + 2 * i + 1]);
#pragma unroll
                for (int Pb = 0; Pb < 2; ++Pb) Y[Pb] = __builtin_amdgcn_mfma_f32_32x32x16_bf16(af[s2][Pb].v, pf.v, Y[Pb], 0, 0, 0);
            }
        }
        const float ei = __expf(cum_i);
        bf16_t* yrow = yd + ((size_t)dir * NTOK + row0 + ti) * 512 + head * 64;
#pragma unroll
        for (int Pb = 0; Pb < 2; ++Pb)
#pragma unroll
            for (int tq = 0; tq < 4; ++tq)
                *(uint2*)(yrow + 32 * Pb + 8 * tq + 4 * h) = pk4(make_float4(Y[Pb][4 * tq] + ei * Yo[Pb][4 * tq], Y[Pb][4 * tq + 1] + ei * Yo[Pb][4 * tq + 1], Y[Pb][4 * tq + 2] + ei * Yo[Pb][4 * tq + 2], Y[Pb][4 * tq + 3] + ei * Yo[Pb][4 * tq + 3]));
    } else {
#pragma unroll
        for (int u2 = 0; u2 < 4; ++u2) { const int c4 = tid & 31, t = 2 * ((tid >> 5) + 16 * u2);
            if (!(c4 >> 4)) { const unsigned a0 = vb[2 * u2].x, a1 = vb[2 * u2].y, b0 = vb[2 * u2 + 1].x, b1 = vb[2 * u2 + 1].y;
                *(unsigned*)(s1BT + XTI(c4 * 4 + 0, t)) = (a0 & 0xffffu) | (b0 << 16); *(unsigned*)(s1BT + XTI(c4 * 4 + 1, t)) = (a0 >> 16) | (b0 & 0xffff0000u);
                *(unsigned*)(s1BT + XTI(c4 * 4 + 2, t)) = (a1 & 0xffffu) | (b1 << 16); *(unsigned*)(s1BT + XTI(c4 * 4 + 3, t)) = (a1 >> 16) | (b1 & 0xffff0000u); }
            const float2 w2 = *(const float2*)(sW + (c4 >> 4) * 128 + t);
            const float4 xa = f4scale(vx[2 * u2], dx[2 * u2] * w2.x), xb = f4scale(vx[2 * u2 + 1], dx[2 * u2 + 1] * w2.y);
            *(unsigned*)(s1XT + XTI(c4 * 4 + 0, t)) = pk2(xa.x, xb.x); *(unsigned*)(s1XT + XTI(c4 * 4 + 1, t)) = pk2(xa.y, xb.y); *(unsigned*)(s1XT + XTI(c4 * 4 + 2, t)) = pk2(xa.z, xb.z); *(unsigned*)(s1XT + XTI(c4 * 4 + 3, t)) = pk2(xa.w, xb.w); }
        __syncthreads();
        const int Pb = (wave >> 1) & 1, Nb = wave & 1;
        f32x16 acc;
#pragma unroll
        for (int i = 0; i < 16; ++i) acc[i] = 0.f;
#pragma unroll
        for (int ks = 0; ks < 8; ++ks) {
            const bf16_t* xp = s1XT + XTI(hl * 64 + 32 * Pb + r, 16 * ks + 4 * h); const bf16_t* bp = s1BT + XTI(32 * Nb + r, 16 * ks + 4 * h);
            union { bf16x8 v; uint2 u[2]; } af, bf; af.u[0] = *(const uint2*)xp; af.u[1] = *(const uint2*)(xp + 8); bf.u[0] = *(const uint2*)bp; bf.u[1] = *(const uint2*)(bp + 8);
            acc = __builtin_amdgcn_mfma_f32_32x32x16_bf16(bf.v, af.v, acc, 0, 0, 0); }
#pragma unroll
        for (int tq = 0; tq < 4; ++tq) *(uint2*)(hsp + (32 * Pb + r) * 64 + 32 * Nb + 8 * tq + 4 * h) = pk4(make_float4(acc[4 * tq], acc[4 * tq + 1], acc[4 * tq + 2], acc[4 * tq + 3]));
    }
}

template <class RM>
__device__ __forceinline__ void cvt_tile(const float* src, int N, bf16_t* dst, int ldd, RM rowmap, int k0, int n0, int lane) {
    const int n = n0 + lane;
    if (n < N) {
        const float* sp = src + (size_t)k0 * N + n;
        float v[32];
#pragma unroll
        for (int kk = 0; kk < 32; ++kk) v[kk] = sp[(size_t)kk * N];
        uint4* dp = (uint4*)(dst + (size_t)rowmap(n) * ldd + k0);
#pragma unroll
        for (int i = 0; i < 4; ++i) dp[i] = make_uint4(pk2(v[8 * i], v[8 * i + 1]), pk2(v[8 * i + 2], v[8 * i + 3]), pk2(v[8 * i + 4], v[8 * i + 5]), pk2(v[8 * i + 6], v[8 * i + 7]));
    }
}
__device__ __forceinline__ int block_excl_scan(int v, int tid, volatile int* sh, int& total) {
    const int lane = tid & 63, wave = tid >> 6; int x = v;
    x += __builtin_amdgcn_update_dpp(0, x, 0x111, 0xf, 0xf, true); x += __builtin_amdgcn_update_dpp(0, x, 0x112, 0xf, 0xf, true);
    x += __builtin_amdgcn_update_dpp(0, x, 0x114, 0xf, 0xf, true); x += __builtin_amdgcn_update_dpp(0, x, 0x118, 0xf, 0xf, true);
    x += __builtin_amdgcn_update_dpp(0, x, 0x142, 0xa, 0xf, false); x += __builtin_amdgcn_update_dpp(0, x, 0x143, 0xc, 0xf, false);
    __syncthreads();
    if (lane == 63) sh[wave] = x;
    __syncthreads();
    int off = 0, tot = 0;
#pragma unroll
    for (int w = 0; w < 8; ++w) { const int c = sh[w]; tot += c; if (w < wave) off += c; }
    total = tot;
    return off + x - v;
}
__device__ __forceinline__ void block_sum2(int v0, int v1, int tid, int* sh, int parity, int& t0, int& t1) {
    const int lane = tid & 63, wave = tid >> 6;
    v0 += __builtin_amdgcn_update_dpp(0, v0, 0x111, 0xf, 0xf, true); v1 += __builtin_amdgcn_update_dpp(0, v1, 0x111, 0xf, 0xf, true);
    v0 += __builtin_amdgcn_update_dpp(0, v0, 0x112, 0xf, 0xf, true); v1 += __builtin_amdgcn_update_dpp(0, v1, 0x112, 0xf, 0xf, true);
    v0 += __builtin_amdgcn_update_dpp(0, v0, 0x114, 0xf, 0xf, true); v1 += __builtin_amdgcn_update_dpp(0, v1, 0x114, 0xf, 0xf, true);
    v0 += __builtin_amdgcn_update_dpp(0, v0, 0x118, 0xf, 0xf, true); v1 += __builtin_amdgcn_update_dpp(0, v1, 0x118, 0xf, 0xf, true);
    v0 += __builtin_amdgcn_update_dpp(0, v0, 0x142, 0xa, 0xf, false); v1 += __builtin_amdgcn_update_dpp(0, v1, 0x142, 0xa, 0xf, false);
    v0 += __builtin_amdgcn_update_dpp(0, v0, 0x143, 0xc, 0xf, false); v1 += __builtin_amdgcn_update_dpp(0, v1, 0x143, 0xc, 0xf, false);
    if (lane == 63) *(int2*)(sh + parity * 16 + wave * 2) = make_int2(v0, v1);
    __syncthreads();
    const int4 a = *(const int4*)(sh + parity * 16), b = *(const int4*)(sh + parity * 16 + 4), c = *(const int4*)(sh + parity * 16 + 8), d = *(const int4*)(sh + parity * 16 + 12);
    t0 = (a.x + a.z) + (b.x + b.z) + (c.x + c.z) + (d.x + d.z); t1 = (a.y + a.w) + (b.y + b.w) + (c.y + c.w) + (d.y + d.w);
}
__device__ __forceinline__ int block_sum(int v, int tid, volatile int* sh, int parity) {
    const int lane = tid & 63, wave = tid >> 6;
    v += __builtin_amdgcn_update_dpp(0, v, 0x111, 0xf, 0xf, true); v += __builtin_amdgcn_update_dpp(0, v, 0x112, 0xf, 0xf, true);
    v += __builtin_amdgcn_update_dpp(0, v, 0x114, 0xf, 0xf, true); v += __builtin_amdgcn_update_dpp(0, v, 0x118, 0xf, 0xf, true);
    v += __builtin_amdgcn_update_dpp(0, v, 0x142, 0xa, 0xf, false); v += __builtin_amdgcn_update_dpp(0, v, 0x143, 0xc, 0xf, false);
    if (lane == 63) sh[parity * 8 + wave] = v;
    __syncthreads();
    int tot = 0;
#pragma unroll
    for (int w = 0; w < 8; ++w) tot += sh[parity * 8 + w];
    return tot;
}

#define MOD ((float*)(kp_->ws + WS_MOD))
#define CTXC ((float*)(kp_->ws + WS_CTXC))
#define AFF ((float*)(kp_->ws + WS_AFF))
#define TOKSLOT ((int*)(kp_->ws + WS_TOKSLOT))
#define SELIDX ((int*)(kp_->ws + WS_SELIDX))
#define SELGATE ((float*)(kp_->ws + WS_SELGATE))
#define DT ((float*)(kp_->ws + WS_DT))
#define HB ((bf16_t*)(kp_->ws + WS_HB))
#define HS ((bf16_t*)(kp_->ws + WS_HS))
#define YD ((bf16_t*)(kp_->ws + WS_YD))
#define ALAST ((float*)(kp_->ws + WS_ALAST))
#define ROPE ((float*)(kp_->ws + WS_ROPE))
#define PB ((bf16_t*)(kp_->ws + WS_P))
#define XBC ((bf16_t*)(kp_->ws + WS_XBC))
#define MQ ((bf16_t*)(kp_->ws + WS_MQ))
#define MKV ((bf16_t*)(kp_->ws + WS_MKV))
#define CQB ((bf16_t*)(kp_->ws + WS_CQB))
#define CKVB ((bf16_t*)(kp_->ws + WS_CKVB))
#define MIXB ((bf16_t*)(kp_->ws + WS_MIXB))
#define MOUT ((bf16_t*)(kp_->ws + WS_MOUT))
#define XG ((bf16_t*)(kp_->ws + WS_XG))
#define HID ((bf16_t*)(kp_->ws + WS_HID))
#define Y ((bf16_t*)(kp_->ws + WS_Y))
#define WIN_T ((bf16_t*)(kp_->ws + WS_WIN))
#define WQ_T ((bf16_t*)(kp_->ws + WS_WQ))
#define WKV_T ((bf16_t*)(kp_->ws + WS_WKV))
#define WOUT_T ((bf16_t*)(kp_->ws + WS_WOUT))
#define WGU_T ((bf16_t*)(kp_->ws + WS_WGU))
#define WD_T ((bf16_t*)(kp_->ws + WS_WD))
#define QD ((bf16_t*)(kp_->ws + WS_QD))
#define QDC ((bf16_t*)(kp_->ws + WS_QDC))
#define KD ((bf16_t*)(kp_->ws + WS_KD))
#define VDT ((bf16_t*)(kp_->ws + WS_VDT))
#define QM ((bf16_t*)(kp_->ws + WS_QM))
#define QMC ((bf16_t*)(kp_->ws + WS_QMC))
#define KM ((bf16_t*)(kp_->ws + WS_KM))
#define VMT ((bf16_t*)(kp_->ws + WS_VMT))
#define xcur (kp_->out)
#define XRB ((bf16_t*)(kp_->ws + WS_XRB))
#define XRAW(q) up4(make_uint2(__float_as_uint((q).x), __float_as_uint((q).y)))
#define DTMP XBC
#define modl (MOD + (size_t)l * (NB + 1) * NMOD * D)
typedef const __attribute__((address_space(4))) Prm* KPrm;
#define PHASE_BEGIN() KPrm kp_ = (KPrm)__builtin_amdgcn_kernarg_segment_ptr(); asm volatile("" : "+s"(kp_)); int tid = MK_TID(); asm volatile("" : "+v"(tid)); (void)tid
#define GSYNC() do { XcdBarrier b_; b_.bar = (unsigned*)(kp_->ws + WS_CTL); b_.x = xb_xcc_id(); b_.st = (volatile LAS unsigned*)(ldsb + LDS_BYTES - 64); int t_ = MK_TID(); asm volatile("" : "+v"(t_)); xcd_barrier(b_, t_); } while (0)
#define CVT_MOE_RANGE(LW, ID0, ID1, SLOT, NSLOTS) do { const int lane_ = tid & 63; \
        for (int id = (ID0) + (SLOT); id < (ID1); id += (NSLOTS)) { \
            const int mat = id >> 9, tl = id & 511, e = mat / 3, which = mat % 3, k0 = (tl >> 4) * 32, n0 = (tl & 15) * 64; \
            if (which == 0) cvt_tile(kp_->in[I_WG] + ((size_t)(LW) * NE + e) * D * FF, FF, WGU_T + (size_t)e * 2 * FF * D, D, [](int n) { return (n >> 2) * 8 + (n & 3); }, k0, n0, lane_); \
            else if (which == 1) cvt_tile(kp_->in[I_WU] + ((size_t)(LW) * NE + e) * D * FF, FF, WGU_T + (size_t)e * 2 * FF * D, D, [](int n) { return (n >> 2) * 8 + 4 + (n & 3); }, k0, n0, lane_); \
            else cvt_tile(kp_->in[I_WD] + ((size_t)(LW) * NE + e) * FF * D, D, WD_T + (size_t)e * D * FF, FF, [](int n) { return n; }, k0, n0, lane_); } } while (0)
constexpr int CVT_PER_WAVE = 4;
__global__ void __launch_bounds__(NTHREADS, 2) mk_forward(Prm p) {
    extern __shared__ __attribute__((aligned(16))) unsigned char lds_raw[];
    LAS unsigned char* const ldsb = (LAS unsigned char*)lds_raw;
    volatile LAS unsigned* st = (volatile LAS unsigned*)(ldsb + LDS_BYTES - 64);
    const int wave_s = __builtin_amdgcn_readfirstlane((int)threadIdx.x >> 6);
#define MK_TID() mk_tid_impl(wave_s)
    if (MK_TID() < 16) st[MK_TID()] = 0u;
    __syncthreads();
    (void)xcd_barrier_post((unsigned*)(p.ws + WS_CTL), st, MK_TID());
    const int G = gridDim.x, bid = blockIdx.x;
    const int vcu = (G % 8 == 0) ? (bid % 8) * (G / 8) + bid / 8 : bid;

    {
        PHASE_BEGIN();
        const float* c = kp_->in[I_C]; const float* cc = kp_->in[I_CCTX]; const float* adaw = kp_->in[I_ADAW]; const float* adab = kp_->in[I_ADAB];
        float* sc_l = (float*)lds_raw;
        for (int i = tid; i < (NB + 1) * D; i += NTHREADS) { const int r = i / D, k = i % D; sc_l[i] = siluf(r < NB ? c[(size_t)r * D + k] : cc[k]); }
        __syncthreads();
        {
            float* red = sc_l + (NB + 1) * D;
            const int lane = tid & 63, wv = tid >> 6;
            for (int it = bid; it < DEPTH * (NMOD * D / 64); it += G) {
                const int l = it / (NMOD * D / 64), j = (it % (NMOD * D / 64)) * 64 + lane;
                const float* w = adaw + ((size_t)l * D + wv * 128) * NMOD * D + j;
                float a0 = 0.f, a1 = 0.f, a2 = 0.f, a3 = 0.f, a4 = 0.f;
#pragma unroll 8
                for (int k = 0; k < 128; ++k) { const float wk = w[(size_t)k * NMOD * D]; const int kk = wv * 128 + k;
                    a0 += sc_l[kk] * wk; a1 += sc_l[D + kk] * wk; a2 += sc_l[2 * D + kk] * wk; a3 += sc_l[3 * D + kk] * wk; a4 += sc_l[4 * D + kk] * wk; }
                __syncthreads();
                red[(wv * 5 + 0) * 64 + lane] = a0; red[(wv * 5 + 1) * 64 + lane] = a1; red[(wv * 5 + 2) * 64 + lane] = a2; red[(wv * 5 + 3) * 64 + lane] = a3; red[(wv * 5 + 4) * 64 + lane] = a4;
                __syncthreads();
                if (tid < 5 * 64) { const int r = tid >> 6; float acc = adab[l * NMOD * D + j - lane + (tid & 63)];
#pragma unroll
                    for (int q = 0; q < 8; ++q) acc += red[(q * 5 + r) * 64 + (tid & 63)];
                    MOD[((size_t)l * (NB + 1) + r) * NMOD * D + (j - lane) + (tid & 63)] = acc; }
            }
        }
        ITEMS(i, S * 16) {
            const int t = i >> 4, w = i & 15, ii = w & 7; const float pos = (float)(w < 8 ? t / GRID_W : t % GRID_W);
            const float ang = pos * powf(10000.0f, -(float)ii / 8.0f);
            ROPE[(size_t)t * 32 + (w < 8 ? 0 : 16) + ii] = cosf(ang); ROPE[(size_t)t * 32 + (w < 8 ? 8 : 24) + ii] = sinf(ang);
        }
        GSYNC();
    }

    int smallw_done = 0;
    const bool idle_sel = (int)gridDim.x > 2 * NB * NE;
#pragma unroll 1
    for (int l = 0; l < DEPTH; ++l) {
        const bool ctx_out = l < DEPTH - 1;
        const float lambda_init = 0.8f - 0.6f * expf(-0.3f * (float)l);
        const int nrows_out = ctx_out ? NTOK : NLAT;
        const int ER = ctx_out ? ER_MAX : NB * CAP_L;
        int moe_done = 0;

        if (l == 0 || !idle_sel) {
            PHASE_BEGIN();
#define SMALLW_CVT(LW, SLOT, NSLOTS) do { const int lane_ = tid & 63; auto idm = [](int n) { return n; }; \
                constexpr int T_WIN = (D / 32) * ((IN_COLS + 63) / 64), T_WQ = (192 / 32) * (384 / 64), T_WKV = (128 / 32) * (512 / 64), T_WOUT = (MIXW / 32) * (D / 64); \
                for (int id = (SLOT); id < T_WIN + T_WQ + T_WKV + T_WOUT; id += (NSLOTS)) { \
                    if (id < T_WIN) { const int nt = (IN_COLS + 63) / 64; cvt_tile(kp_->in[I_WIN] + (size_t)(LW) * D * IN_COLS, IN_COLS, WIN_T, D, idm, (id / nt) * 32, (id % nt) * 64, lane_); } \
                    else if (id < T_WIN + T_WQ) { const int u = id - T_WIN; cvt_tile(kp_->in[I_WQUP] + (size_t)(LW) * 192 * 384, 384, WQ_T, 256, idm, (u / 6) * 32, (u % 6) * 64, lane_); } \
                    else if (id < T_WIN + T_WQ + T_WKV) { const int u = id - T_WIN - T_WQ; cvt_tile(kp_->in[I_WKVUP] + (size_t)(LW) * 128 * 512, 512, WKV_T, 128, idm, (u / 8) * 32, (u % 8) * 64, lane_); } \
                    else { const int u = id - T_WIN - T_WQ - T_WKV; cvt_tile(kp_->in[I_WOUT] + (size_t)(LW) * MIXW * D, D, WOUT_T, MIXW, idm, (u / 16) * 32, (u % 16) * 64, lane_); } } } while (0)
            if (!smallw_done) SMALLW_CVT(l, blockIdx.x * 8 + (tid >> 6), gridDim.x * 8);
            smallw_done = 0;
            { const unsigned zz_ = (unsigned)tid >> 20; const uint4 z4_ = make_uint4(zz_, zz_, zz_, zz_);
            ITEMS(i, (IN_PAD - IN_COLS) * D / 8) ((uint4*)(WIN_T + (size_t)IN_COLS * D))[i] = z4_;
            ITEMS(i, 128 * 256 / 8) ((uint4*)(WQ_T + (size_t)384 * 256))[i] = z4_;
            ITEMS(i, 384 * 8) { const int r = i >> 3, c8 = i & 7; *(uint4*)(WQ_T + (size_t)r * 256 + 192 + c8 * 8) = z4_; } }

            const float* w = kp_->in[I_NMPRE] + l * D;
            const int lane = tid & 63;
            {
                float4 xq[4];
                { const float zf_ = (float)(tid >> 20);
#pragma unroll
                  for (int i = 0; i < 4; ++i) xq[i] = make_float4(zf_, zf_, zf_, zf_); }
                float4* aux = (float4*)lds_raw;
                __syncthreads();
                for (int i = tid; i < 11 * (D / 4); i += NTHREADS) { const int v = i / (D / 4), k4 = i % (D / 4);
                    const float* src = v == 0 ? w : modl + (size_t)((v - 1) % 5) * NMOD * D + ((v - 1) / 5) * D;
                    aux[i] = ((const float4*)src)[k4]; }
                __syncthreads();
                const int wstride = gridDim.x * 8; int r = blockIdx.x * 8 + (tid >> 6);
#define P1_LOAD(rr) do { if (l == 0) { const float4* src_ = (const float4*)((rr) < NLAT ? kp_->in[I_X] + (size_t)(rr) * D : kp_->in[I_CTX] + (size_t)((rr) - NLAT) * D); _Pragma("unroll") for (int i = 0; i < 4; ++i) xq[i] = src_[i * 64 + lane]; } \
                    else { const uint2* s_ = (const uint2*)(XRB + (size_t)(rr) * D); _Pragma("unroll") for (int i = 0; i < 4; ++i) { const uint2 u_ = s_[i * 64 + lane]; xq[i].x = __uint_as_float(u_.x); xq[i].y = __uint_as_float(u_.y); } } } while (0)
                if (r < NTOK) P1_LOAD(r);
                for (; r < NTOK; r += wstride) {
                    const int bsel = r < NLAT ? r / S : NB;
                    float4 v[4]; float ss = 0.f;
#pragma unroll
                    for (int i = 0; i < 4; ++i) { v[i] = l == 0 ? xq[i] : XRAW(xq[i]); ss += f4dot(v[i], v[i]); }
                    if (r + wstride < NTOK) P1_LOAD(r + wstride);
                    ss = wave_sum(ss);
                    const float rs = 1.0f / sqrtf(ss / D + EPS);
#pragma unroll
                    for (int i = 0; i < 4; ++i) { const int k4 = i * 64 + lane; const float4 w4 = aux[k4], sc = aux[(6 + bsel) * (D / 4) + k4], sh = aux[(1 + bsel) * (D / 4) + k4];
                        const float4 o = make_float4(v[i].x * rs * w4.x * (1.0f + sc.x) + sh.x, v[i].y * rs * w4.y * (1.0f + sc.y) + sh.y, v[i].z * rs * w4.z * (1.0f + sc.z) + sh.z, v[i].w * rs * w4.w * (1.0f + sc.w) + sh.w);
                        *(uint2*)(HB + (size_t)r * D + k4 * 4) = pk4(o); }
                }
#undef P1_LOAD
            }
            GSYNC();
        }
        {
            PHASE_BEGIN();
            pg8::Gemm g{HB, WIN_T, NTOK, IN_PAD, D, 0, 0}; pg8::StaticOrder so; so.init(NTOK, IN_PAD, G, bid);
            pg8::EpiBf16 E{PB, IN_COLS, IN_COLS};
            pg8::gemm_phase<pg8::EpiBf16, pg8::StaticOrder, true, true>(ldsb, g, so, E, tid);
            { const int nwg = (NTOK / 256) * (IN_PAD / 256), busy = nwg % G;
              (void)busy; moe_done = 0; }
            GSYNC();
        }
        {
            PHASE_BEGIN();
            const float* cw = kp_->in[I_CONVW] + (size_t)l * 3 * 768; const float* cb = kp_->in[I_CONVB] + (size_t)l * 768;
            {
                float* cwl = (float*)lds_raw;
                __syncthreads();
                for (int i = tid; i < 4 * 768; i += NTHREADS) cwl[i] = i < 3 * 768 ? cw[i] : cb[i - 3 * 768];
                __syncthreads();
                const int stride = gridDim.x * NTHREADS;
                for (int i0 = blockIdx.x * NTHREADS + tid; i0 < NTOK * 192; i0 += 4 * stride) {
                    uint2 u0[4], um[4], up[4];
#pragma unroll
                    for (int q = 0; q < 4; ++q) { const int i = i0 + q * stride; const unsigned z_ = (unsigned)tid >> 20; u0[q] = make_uint2(z_, z_); um[q] = u0[q]; up[q] = u0[q];
                        if (i < NTOK * 192) { const int c = (i % 192) * 4, r = i / 192; const bool lat = r < NLAT; const int L = lat ? S : CTX; const int t = lat ? r % S : (r - NLAT) % CTX;
                            const bf16_t* u = PB + (size_t)r * IN_COLS + C_XBC + c; u0[q] = *(const uint2*)u; if (t > 0) um[q] = *(const uint2*)(u - IN_COLS); if (t < L - 1) up[q] = *(const uint2*)(u + IN_COLS); } }
#pragma unroll
                    for (int q = 0; q < 4; ++q) { const int i = i0 + q * stride;
                        if (i < NTOK * 192) { const int c = (i % 192) * 4, r = i / 192;
                            float4 acc = f4add(*(const float4*)(cwl + 3 * 768 + c), f4mul(*(const float4*)(cwl + 768 + c), up4(u0[q])));
                            acc = f4add(acc, f4mul(*(const float4*)(cwl + c), up4(um[q]))); acc = f4add(acc, f4mul(*(const float4*)(cwl + 2 * 768 + c), up4(up[q])));
                            *(uint2*)(XBC + (size_t)r * 768 + c) = pk4(make_float4(siluf(acc.x), siluf(acc.y), siluf(acc.z), siluf(acc.w))); } }
                }
            }
            const float* dtb = kp_->in[I_DTB] + l * 16;
            ITEMS(i, NTOK * 16) { const int j = i % 16, r = i / 16; DT[i] = softplusf(bf2f(PB[(size_t)r * IN_COLS + C_DT + j]) + dtb[j]); }
            ITEMS(i, NTOK * 16) {
                const int g = i & 15, r = i >> 4; const int hm = g & 7, isk = g >> 3;
                const bool lat = r < NLAT; const int b = lat ? r / S : (r - NLAT) / CTX, t = lat ? r % S : (r - NLAT) % CTX;
                if (!isk && !lat && !ctx_out) continue;
                const bf16_t* vp = PB + (size_t)r * IN_COLS + (isk ? C_DK : C_DQ) + hm * 32;
                float v[32];
#pragma unroll
                for (int k = 0; k < 32; k += 4) { const float4 x = ld4h(vp + k); v[k] = x.x; v[k + 1] = x.y; v[k + 2] = x.z; v[k + 3] = x.w; }
                if (lat) rope32(v, t, ROPE);
                const float sc = isk ? 1.0f : 0.17677669529663687f * 1.4426950408889634f;
                bf16_t* dst = isk ? KD + ((size_t)(b * 8 + hm) * SK + (lat ? CTX + t : t)) * 32 : (lat ? QD + ((size_t)(b * 8 + hm) * S + t) * 32 : QDC + ((size_t)(b * 8 + hm) * CTX + t) * 32);
#pragma unroll
                for (int k = 0; k < 32; k += 8) *(uint4*)(dst + k) = make_uint4(pk2(v[k] * sc, v[k + 1] * sc), pk2(v[k + 2] * sc, v[k + 3] * sc), pk2(v[k + 4] * sc, v[k + 5] * sc), pk2(v[k + 6] * sc, v[k + 7] * sc));
            }
            const float* qn = kp_->in[I_QNORM] + l * 192; const float* kvn = kp_->in[I_KVNORM] + l * 128;
            { const int lane = tid & 63;
            constexpr int NRM_B = 6;
            const float4 wq4 = lane < 48 ? ((const float4*)qn)[lane] : make_float4(0.f, 0.f, 0.f, 0.f), wkv4 = lane < 32 ? ((const float4*)kvn)[lane] : make_float4(0.f, 0.f, 0.f, 0.f);
            const int wstride = gridDim.x * 8;
            for (int i0 = blockIdx.x * 8 + (tid >> 6); i0 < NTOK * 2; i0 += NRM_B * wstride) {
                uint2 xq[NRM_B];
#pragma unroll
                for (int q = 0; q < NRM_B; ++q) { const int ii = i0 + q * wstride, wh_ = ii & 1, r_ = ii >> 1; const unsigned z_ = (unsigned)tid >> 20; xq[q] = make_uint2(z_, z_);
                    if (ii < NTOK * 2 && lane < (wh_ ? 32 : 48)) xq[q] = *(const uint2*)(PB + (size_t)r_ * IN_COLS + (wh_ ? C_CKV : C_CQ) + lane * 4); }
#pragma unroll
                for (int q = 0; q < NRM_B; ++q) { const int i = i0 + q * wstride; if (i >= NTOK * 2) break;
                    const int which = i & 1, r = i >> 1; const int n4 = which ? 32 : 48;
                    float4 x = make_float4(0.f, 0.f, 0.f, 0.f); if (lane < n4) x = up4(xq[q]);
                    const float ss = wave_sum(f4dot(x, x));
                    const float rs = 1.0f / sqrtf(ss / (n4 * 4) + EPS);
                    bf16_t* dst = which ? CKVB + (size_t)r * 128 : CQB + (size_t)r * 256;
                    if (lane < n4) *(uint2*)(dst + lane * 4) = pk4(f4scale(f4mul(x, which ? wkv4 : wq4), rs));
                    else if (!which) { const unsigned z_ = (unsigned)tid >> 20; *(uint2*)(dst + lane * 4) = make_uint2(z_, z_); }
                }
            }
            }
            GSYNC();
        }
        {
            PHASE_BEGIN();
            const int half = (G * 5) / 8;
            if (bid < half) {
                pg8::Gemm g{CQB, WQ_T, NTOK, 512, 256, 0, 0}; pg8::StaticOrder so; so.init(NTOK, 512, half, bid);
                pg8::EpiBf16 E{MQ, 384, 384};
                pg8::gemm_phase<pg8::EpiBf16, pg8::StaticOrder, true, true>(ldsb, g, so, E, tid);
            } else {
                pg8::Gemm g{CKVB, WKV_T, NTOK, 512, 128, 0, 0}; pg8::StaticOrder so; so.init(NTOK, 512, G - half, bid - half);
                pg8::EpiBf16 E{MKV, 512, 512};
                pg8::gemm_phase<pg8::EpiBf16, pg8::StaticOrder, true, true>(ldsb, g, so, E, tid);
            }
            for (int it = vcu; it < NB * NCH * 8; it += G) {
                const int hp = it & 3, dir = (it >> 2) & 1, cp = (it >> 3) % NCH, b = it / (8 * NCH);
                const int k = dir ? (cp < 2 ? 1 - cp : 35 - cp) : cp;
                if (k == NCH - 1) continue;
                ssd_block<false>(b, dir, k, hp, XBC, DT, kp_->in[I_ALOG] + l * 16, HS, ALAST, nullptr, (float*)lds_raw, tid);
            }
            GSYNC();
        }
        {
            PHASE_BEGIN();
            ITEMS(i, NTOK * 8) {
                const int g = i & 7, r = i >> 3; const int hh = g & 3, isk = g >> 2;
                const bool lat = r < NLAT; const int b = lat ? r / S : (r - NLAT) / CTX, t = lat ? r % S : (r - NLAT) % CTX;
                if (!isk && !lat && !ctx_out) continue;
                const bf16_t* npb = isk ? MKV + (size_t)r * 512 + hh * 128 : MQ + (size_t)r * 384 + hh * 96;
                const bf16_t* rp = isk ? PB + (size_t)r * IN_COLS + C_KR : npb + 64;
                float v[32], np[64];
#pragma unroll
                for (int k = 0; k < 32; k += 4) { const float4 x = ld4h(rp + k); v[k] = x.x; v[k + 1] = x.y; v[k + 2] = x.z; v[k + 3] = x.w; }
#pragma unroll
                for (int k = 0; k < 64; k += 4) { const float4 x = ld4h(npb + k); np[k] = x.x; np[k + 1] = x.y; np[k + 2] = x.z; np[k + 3] = x.w; }
                if (lat) rope32(v, t, ROPE);
                const float sc = isk ? 1.0f : 0.10206207261596575f * 1.4426950408889634f;
                bf16_t* dst = isk ? KM + ((size_t)(b * 4 + hh) * SK + (lat ? CTX + t : t)) * 96 : (lat ? QM + ((size_t)(b * 4 + hh) * S + t) * 96 : QMC + ((size_t)(b * 4 + hh) * CTX + t) * 96);
#pragma unroll
                for (int k = 0; k < 64; k += 8) *(uint4*)(dst + k) = make_uint4(pk2(np[k] * sc, np[k + 1] * sc), pk2(np[k + 2] * sc, np[k + 3] * sc), pk2(np[k + 4] * sc, np[k + 5] * sc), pk2(np[k + 6] * sc, np[k + 7] * sc));
#pragma unroll
                for (int k = 0; k < 32; k += 8) *(uint4*)(dst + 64 + k) = make_uint4(pk2(v[k] * sc, v[k + 1] * sc), pk2(v[k + 2] * sc, v[k + 3] * sc), pk2(v[k + 4] * sc, v[k + 5] * sc), pk2(v[k + 6] * sc, v[k + 7] * sc));
            }
            ITEMS(i, NB * 2 * 8 * 2048) {
                const int e = (i & 2047) * 2, h = (i >> 11) & 7, bd = i >> 14;
                unsigned* hp0 = (unsigned*)(HS + ((size_t)bd * NCH * 8 + h) * 4096 + e); const float* al0 = ALAST + (size_t)bd * NCH * 8 + h;
                unsigned sv[NCH - 1]; float dk[NCH - 1];
#pragma unroll
                for (int k = 0; k < NCH - 1; ++k) { sv[k] = hp0[(size_t)k * 8 * 2048]; dk[k] = al0[k * 8]; }
                float H0 = 0.f, H1 = 0.f;
#pragma unroll
                for (int k = 0; k < NCH; ++k) { hp0[(size_t)k * 8 * 2048] = pk2(H0, H1);
                    if (k < NCH - 1) { const float d = __expf(dk[k]); H0 = H0 * d + __uint_as_float(sv[k] << 16); H1 = H1 * d + __uint_as_float(sv[k] & 0xffff0000u); } }
            }
            GSYNC();
        }
        {
            PHASE_BEGIN();
            for (int kq = 0; kq * G < NB * 2 * NCH * 4; ++kq) {
                int it = vcu + kq * G;
                { const int T_ = NB * 2 * NCH * 4, full_ = (T_ / G) * G, rem_ = T_ - full_;
                  if (ctx_out && kq * G == full_) it = vcu >= G - rem_ ? full_ + vcu - (G - rem_) : T_; }
                if (it >= NB * 2 * NCH * 4) continue;
                const int hp = it & 3, dir = (it >> 2) & 1, cp = (it >> 3) % NCH, b = it / (8 * NCH);
                const int k = dir ? (cp < 2 ? 1 - cp : 35 - cp) : cp;
                if (k < 2 && !ctx_out) continue;
                ssd_block<true>(b, dir, k, hp, XBC, DT, kp_->in[I_ALOG] + l * 16, HS, ALAST, YD, (float*)lds_raw, tid);
            }
            {
                int tid = MK_TID(); asm volatile("" : "+v"(tid));
                const int lane = tid & 63, wave = tid >> 6, qr = lane & 31, hf = lane >> 5;
                const float* lq1 = kp_->in[I_LQ1] + l * 32; const float* lk1 = kp_->in[I_LK1] + l * 32; const float* lq2 = kp_->in[I_LQ2] + l * 32; const float* lk2 = kp_->in[I_LK2] + l * 32;
                const float* subw = kp_->in[I_SUBLN] + l * 64;
                const int nlat = NB * 4 * (S / 256), nit = nlat + (ctx_out ? NB * 4 : 0);
                for (int it = vcu; it < nit; it += G) {
                    const bool lat = it < nlat; const int u = lat ? it : it - nlat;
                    const int qb = lat ? u % (S / 256) : 0, hh = lat ? (u / (S / 256)) % 4 : u % 4, b = lat ? u / (4 * (S / 256)) : u / 4;
                    const int t = qb * 256 + wave * 32 + qr; const int row = tok_row(lat, b, t); const int nkt = lat ? SK / 64 : CTX / 64;
                    f32x16 oacc[2];
                    LAS v4u* const o1s = (LAS v4u*)(ldsb + 98304) + tid;
#pragma unroll 1
                    for (int mp = 0; mp < 2; ++mp) {
                        const int hm = hh * 2 + mp;
                        const bf16_t* qrow = lat ? QD + ((size_t)(b * 8 + hm) * S + t) * 32 : QDC + ((size_t)(b * 8 + hm) * CTX + t) * 32;
                        float l_run = 0.f;
#pragma unroll
                        for (int i = 0; i < 16; ++i) { oacc[0][i] = 0.f; oacc[1][i] = 0.f; }
                        const CvArgs cvp{kp_->in[I_WG] + (size_t)l * NE * D * FF, kp_->in[I_WU] + (size_t)l * NE * D * FF, kp_->in[I_WD] + (size_t)l * NE * FF * D, WGU_T, WD_T,
                                         moe_done + (((lat ? it : 0) * 8 + wave_s) * 2 + mp) * 4};
                        attn_pass<32, true>(qrow, KD + (size_t)(b * 8 + hm) * SK * 32, PB + (size_t)(NLAT + b * CTX) * IN_COLS + C_DV + hh * 64, PB + (size_t)(b * S) * IN_COLS + C_DV + hh * 64, IN_COLS, nkt, ldsb, tid, oacc, l_run, cvp);
                        l_run = xor32_sum(l_run);
                        if (mp == 0) { const float i1 = 1.0f / l_run;
#pragma unroll
                            for (int db = 0; db < 2; ++db)
#pragma unroll
                                for (int q4 = 0; q4 < 2; ++q4) o1s[(db * 2 + q4) * NTHREADS] = (v4u){pk2(oacc[db][8 * q4] * i1, oacc[db][8 * q4 + 1] * i1), pk2(oacc[db][8 * q4 + 2] * i1, oacc[db][8 * q4 + 3] * i1),
                                                                                                   pk2(oacc[db][8 * q4 + 4] * i1, oacc[db][8 * q4 + 5] * i1), pk2(oacc[db][8 * q4 + 6] * i1, oacc[db][8 * q4 + 7] * i1)}; }
                        else {
                            float d1 = 0.f, d2 = 0.f; for (int k = 0; k < 32; ++k) { d1 += lq1[k] * lk1[k]; d2 += lq2[k] * lk2[k]; }
                            const float lam = expf(d1) - expf(d2) + lambda_init;
                            const float i2 = lam / l_run; float ss = 0.f; f32x16 o1[2];
#pragma unroll
                            for (int db = 0; db < 2; ++db)
#pragma unroll
                                for (int q4 = 0; q4 < 2; ++q4) { const v4u pq = o1s[(db * 2 + q4) * NTHREADS]; const unsigned pw[4] = {pq.x, pq.y, pq.z, pq.w};
#pragma unroll
                                    for (int i2_ = 0; i2_ < 8; ++i2_) { const int i = 8 * q4 + i2_; const float a1 = __uint_as_float((i2_ & 1) ? (pw[i2_ >> 1] & 0xffff0000u) : (pw[i2_ >> 1] << 16)); const float v = a1 - oacc[db][i] * i2; o1[db][i] = v; ss += v * v; } }
                            ss = xor32_sum(ss);
                            const float rs = (1.0f - lambda_init) / sqrtf(ss / 64 + EPS);
                            bf16_t* orow = MIXB + (size_t)row * MIXW + 512 + hh * 64;
#pragma unroll
                            for (int db = 0; db < 2; ++db)
#pragma unroll
                                for (int gq = 0; gq < 4; ++gq) { const int d0 = 32 * db + 8 * gq + 4 * hf; const float4 w4 = *(const float4*)(subw + d0);
                                    *(uint2*)(orow + d0) = make_uint2(pk2(o1[db][4 * gq] * rs * w4.x, o1[db][4 * gq + 1] * rs * w4.y), pk2(o1[db][4 * gq + 2] * rs * w4.z, o1[db][4 * gq + 3] * rs * w4.w)); }
                        }
                    }
                }
            }
            moe_done = min(moe_done + NB * 4 * (S / 256) * 8 * 2 * 4, MOE_TILES);
            {
                int tid = MK_TID(); asm volatile("" : "+v"(tid));
                const int lane = tid & 63, wave = tid >> 6, qr = lane & 31, hf = lane >> 5;
                const int nlat = NB * 4 * (S / 256), nit = nlat + (ctx_out ? 2 * NB * 4 : 0);
                for (int it = vcu; it < nit; it += G) {
                    const bool lat = it < nlat; const int u = lat ? it : it - nlat - NB * 4;
                    if (u < 0) continue;
                    const int qb = lat ? u % (S / 256) : 0, hh = lat ? (u / (S / 256)) % 4 : u % 4, b = lat ? u / (4 * (S / 256)) : u / 4;
                    const int t = qb * 256 + wave * 32 + qr; const int row = tok_row(lat, b, t); const int nkt = lat ? SK / 64 : CTX / 64;
                    const bf16_t* qrow = lat ? QM + ((size_t)(b * 4 + hh) * S + t) * 96 : QMC + ((size_t)(b * 4 + hh) * CTX + t) * 96;
                    f32x16 oacc[2]; float l_run = 0.f;
#pragma unroll
                    for (int i = 0; i < 16; ++i) { oacc[0][i] = 0.f; oacc[1][i] = 0.f; }
                    const CvArgs cvp{kp_->in[I_WG] + (size_t)l * NE * D * FF, kp_->in[I_WU] + (size_t)l * NE * D * FF, kp_->in[I_WD] + (size_t)l * NE * FF * D, WGU_T, WD_T,
                                     moe_done + ((lat ? it : 0) * 8 + wave_s) * 4};
                    attn_pass<96, true>(qrow, KM + (size_t)(b * 4 + hh) * SK * 96, MKV + (size_t)(NLAT + b * CTX) * 512 + hh * 128 + 64, MKV + (size_t)(b * S) * 512 + hh * 128 + 64, 512, nkt, ldsb, tid, oacc, l_run, cvp);
                    l_run = xor32_sum(l_run);
                    const float inv = 1.0f / l_run;
                    bf16_t* orow = MIXB + (size_t)row * MIXW + 768 + hh * 64;
#pragma unroll
                    for (int db = 0; db < 2; ++db)
#pragma unroll
                        for (int gq = 0; gq < 4; ++gq) { const int d0 = 32 * db + 8 * gq + 4 * hf;
                            *(uint2*)(orow + d0) = make_uint2(pk2(oacc[db][4 * gq] * inv, oacc[db][4 * gq + 1] * inv), pk2(oacc[db][4 * gq + 2] * inv, oacc[db][4 * gq + 3] * inv)); }
                }
            }
            moe_done = min(moe_done + NB * 4 * (S / 256) * 8 * 4, MOE_TILES);
            GSYNC();
        }
        {
            PHASE_BEGIN();
            const float* nw = kp_->in[I_SSDN] + l * 512; const float* dsk = kp_->in[I_SSDD] + l * 8;
            const int lane = tid & 63;
            const float4 nw0 = *(const float4*)(nw + lane * 4), nw1 = *(const float4*)(nw + 256 + lane * 4); const float ds0 = dsk[(lane * 4) >> 6], ds1 = dsk[(256 + lane * 4) >> 6];
            constexpr int GN_B = 4;
            const int wstride = gridDim.x * 8;
            for (int i0 = blockIdx.x * 8 + (tid >> 6); i0 < nrows_out * 2; i0 += GN_B * wstride) {
                uint2 q0[GN_B], q1[GN_B], q2[GN_B], q3[GN_B];
#pragma unroll
                for (int q = 0; q < GN_B; ++q) { const int ii = i0 + q * wstride, g_ = ii & 1, r_ = ii >> 1, c_ = g_ * 256 + lane * 4; const unsigned z_ = (unsigned)tid >> 20;
                    q0[q] = make_uint2(z_, z_); q1[q] = q0[q]; q2[q] = q0[q]; q3[q] = q0[q];
                    if (ii < nrows_out * 2) { q0[q] = *(const uint2*)(XBC + (size_t)r_ * 768 + c_); q1[q] = *(const uint2*)(YD + (size_t)r_ * 512 + c_);
                        q2[q] = *(const uint2*)(YD + ((size_t)NTOK + r_) * 512 + c_); q3[q] = *(const uint2*)(PB + (size_t)r_ * IN_COLS + C_Z + c_); } }
#pragma unroll
                for (int q = 0; q < GN_B; ++q) { const int i = i0 + q * wstride; if (i >= nrows_out * 2) break;
                    const int g = i & 1, r = i >> 1, c = g * 256 + lane * 4;
                    const float4 x = up4(q0[q]), y0 = up4(q1[q]), y1 = up4(q2[q]), z = up4(q3[q]);
                    const float ds = g ? ds1 : ds0;
                    float4 v = make_float4((ds * x.x + y0.x + y1.x) * siluf(z.x), (ds * x.y + y0.y + y1.y) * siluf(z.y), (ds * x.z + y0.z + y1.z) * siluf(z.z), (ds * x.w + y0.w + y1.w) * siluf(z.w));
                    const float ss = wave_sum(f4dot(v, v));
                    const float rs = 1.0f / sqrtf(ss / 256 + EPS);
                    *(uint2*)(MIXB + (size_t)r * MIXW + c) = pk4(f4scale(f4mul(v, g ? nw1 : nw0), rs));
                }
            }
            GSYNC();
        }
        {
            PHASE_BEGIN();
            pg8::Gemm g{MIXB, WOUT_T, nrows_out, D, MIXW, 0, 0}; pg8::StaticOrder so; so.init(nrows_out, D, G, bid);
            pg8::EpiBf16 E{MOUT, D, D};
            pg8::gemm_phase<pg8::EpiBf16, pg8::StaticOrder, true, true>(ldsb, g, so, E, tid);
            { const int nwg = (nrows_out / 256) * (D / 256), busy = nwg % G; const int id0 = moe_done;
              const int id1 = min(id0 + (G - busy) * 8 * CVT_PER_WAVE, MOE_TILES);
              if (busy != 0 && bid >= busy) CVT_MOE_RANGE(l, id0, id1, (bid - busy) * 8 + (tid >> 6), (G - busy) * 8);
              if (busy != 0) moe_done = id1; }
            GSYNC();
        }
        {
            PHASE_BEGIN();
            const float* wpost = kp_->in[I_NMPOST] + l * D; const float* wpre = kp_->in[I_NFPRE] + l * D;
            const float* rw = kp_->in[I_RW] + (size_t)l * D * NE; const float* rb = kp_->in[I_RB] + l * NE;
            const int lane = tid & 63;
            float* rwl = (float*)lds_raw;
            for (int i = tid; i < D * NE / 4; i += NTHREADS) { const int k = i >> 2, e4 = i & 3; ((float4*)rwl)[(((k & 3) * 256 + (k >> 2)) << 2) + e4] = ((const float4*)rw)[i]; }
            float4* aux = (float4*)(rwl + D * NE);
            for (int i = tid; i < 17 * (D / 4); i += NTHREADS) { const int v = i / (D / 4), k4 = i % (D / 4);
                const float* src = v == 0 ? wpost : v == 1 ? wpre : modl + (size_t)((v - 2) % 5) * NMOD * D + (2 + (v - 2) / 5) * D;
                aux[i] = ((const float4*)src)[k4]; }
            __syncthreads();
            float rbv[NE];
#pragma unroll
            for (int e = 0; e < NE; ++e) rbv[e] = rb[e];
            uint2 mq[4]; float4 xq[4];
            { const float zf_ = (float)(tid >> 20);
#pragma unroll
              for (int i = 0; i < 4; ++i) { xq[i] = make_float4(zf_, zf_, zf_, zf_); mq[i] = make_uint2((unsigned)tid >> 20, (unsigned)tid >> 20); } }
            const int wstride = gridDim.x * 8; int r = blockIdx.x * 8 + (tid >> 6);
#define P7_LOAD(rr) do { const bf16_t* m_ = MOUT + (size_t)(rr) * D; _Pragma("unroll") for (int i = 0; i < 4; ++i) mq[i] = *(const uint2*)(m_ + (i * 64 + lane) * 4); \
                if (l == 0) { const float4* xin_ = (const float4*)((rr) < NLAT ? kp_->in[I_X] + (size_t)(rr) * D : kp_->in[I_CTX] + (size_t)((rr) - NLAT) * D); _Pragma("unroll") for (int i = 0; i < 4; ++i) xq[i] = xin_[i * 64 + lane]; } \
                else { const uint2* s_ = (const uint2*)(XRB + (size_t)(rr) * D); _Pragma("unroll") for (int i = 0; i < 4; ++i) { const uint2 u_ = s_[i * 64 + lane]; xq[i].x = __uint_as_float(u_.x); xq[i].y = __uint_as_float(u_.y); } } } while (0)
            if (r < nrows_out) P7_LOAD(r);
            for (; r < nrows_out; r += wstride) {
                uint2* xr = (uint2*)(XRB + (size_t)r * D);
                const int bsel = r < NLAT ? r / S : NB;
                float4 mv[4], xv[4]; float ss = 0.f;
#pragma unroll
                for (int i = 0; i < 4; ++i) { mv[i] = up4(mq[i]); xv[i] = l == 0 ? xq[i] : XRAW(xq[i]); ss += f4dot(mv[i], mv[i]); }
                if (r + wstride < nrows_out) P7_LOAD(r + wstride);
                ss = wave_sum(ss);
                const float rs = 1.0f / sqrtf(ss / D + EPS);
                float s2 = 0.f;
#pragma unroll
                for (int i = 0; i < 4; ++i) { const int k4 = i * 64 + lane;
                    xv[i] = f4add(xv[i], f4mul(aux[(2 + bsel) * (D / 4) + k4], f4scale(f4mul(mv[i], aux[k4]), rs))); xr[k4] = pk4(xv[i]); s2 += f4dot(xv[i], xv[i]); }
                s2 = wave_sum(s2);
                const float r2 = 1.0f / sqrtf(s2 / D + EPS);
                typedef float f32x2 __attribute__((ext_vector_type(2)));
                f32x2 lg2[NE / 2];
#pragma unroll
                for (int e = 0; e < NE / 2; ++e) lg2[e] = (f32x2){0.f, 0.f};
                float4 rwb[2][4];
#pragma unroll
                for (int e4 = 0; e4 < 4; ++e4) rwb[0][e4] = ((const float4*)(rwl + (size_t)lane * NE))[e4];
#pragma unroll
                for (int i = 0; i < 4; ++i) { const int k4 = i * 64 + lane; const float4 w4 = aux[(D / 4) + k4], sc = aux[(12 + bsel) * (D / 4) + k4], sh = aux[(7 + bsel) * (D / 4) + k4];
                    const float hv[4] = {xv[i].x * r2 * w4.x * (1.0f + sc.x) + sh.x, xv[i].y * r2 * w4.y * (1.0f + sc.y) + sh.y, xv[i].z * r2 * w4.z * (1.0f + sc.z) + sh.z, xv[i].w * r2 * w4.w * (1.0f + sc.w) + sh.w};
                    *(uint2*)(HB + (size_t)r * D + k4 * 4) = make_uint2(pk2(hv[0], hv[1]), pk2(hv[2], hv[3]));
#pragma unroll
                    for (int c = 0; c < 4; ++c) { const int g = i * 4 + c;
                        if (g < 15) { const int gn = g + 1, in_ = gn >> 2, cn = gn & 3; const float4* rwn = (const float4*)(rwl + (size_t)(cn * 256 + in_ * 64 + lane) * NE);
#pragma unroll
                            for (int e4 = 0; e4 < 4; ++e4) rwb[gn & 1][e4] = rwn[e4]; }
                        SCHED_FENCE();
#pragma unroll
                        for (int e4 = 0; e4 < 4; ++e4) { const float4 w = rwb[g & 1][e4]; const f32x2 hh2 = {hv[c], hv[c]};
                            lg2[2 * e4] = __builtin_elementwise_fma(hh2, (f32x2){w.x, w.y}, lg2[2 * e4]); lg2[2 * e4 + 1] = __builtin_elementwise_fma(hh2, (f32x2){w.z, w.w}, lg2[2 * e4 + 1]); }
                    }
                }
                float lg[NE];
#pragma unroll
                for (int e = 0; e < NE / 2; ++e) { lg[2 * e] = lg2[e].x; lg[2 * e + 1] = lg2[e].y; }
                wave_sum16(lg);
#pragma unroll
                for (int e = 0; e < NE; ++e) lg[e] += rbv[e];
                float mx = lg[0];
#pragma unroll
                for (int e = 1; e < NE; ++e) mx = fmaxf(mx, lg[e]);
                float sum = 0.f;
#pragma unroll
                for (int e = 0; e < NE; ++e) { lg[e] = __builtin_amdgcn_exp2f((lg[e] - mx) * 1.44269504f); sum += lg[e]; }
                const float is = 1.0f / sum;
                float mine = lg[0];
#pragma unroll
                for (int e = 1; e < NE; ++e) mine = lane == e ? lg[e] : mine;
                if (lane < NE) AFF[(size_t)r * NE + lane] = mine * is;
            }
#undef P7_LOAD
            GSYNC();
        }
        {
            PHASE_BEGIN();
            { const int nsel_ = (ctx_out ? 2 : 1) * NB * NE;
              if (l + 1 < DEPTH && idle_sel) { if (bid >= nsel_) SMALLW_CVT(l + 1, (bid - nsel_) * 8 + (tid >> 6), (G - nsel_) * 8); smallw_done = 1; } }
            { const int nsel_ = (ctx_out ? 2 : 1) * NB * NE;
              if (G > nsel_) { if (bid >= nsel_) CVT_MOE_RANGE(l, moe_done, MOE_TILES, (bid - nsel_) * 8 + (tid >> 6), (G - nsel_) * 8); }
              else CVT_MOE_RANGE(l, moe_done, MOE_TILES, bid * 8 + (tid >> 6), G * 8); }
            {
                volatile int* sh = (volatile int*)lds_raw;
                const int nsel = (ctx_out ? 2 : 1) * NB * NE;
                for (int it = bid; it < nsel; it += G) {
                    const bool lat = it < NB * NE; const int u = lat ? it : it - NB * NE; const int e = u % NE, b = u / NE;
                    const int L = lat ? S : CTX, cap = lat ? CAP_L : CAP_C, npt = lat ? S / NTHREADS : 1, base = tok_row(lat, b, 0);
                    const bool act = lat || tid < CTX;
                    unsigned key[S / NTHREADS];
#pragma unroll
                    for (int i = 0; i < S / NTHREADS; ++i) key[i] = (act && i < npt) ? __float_as_uint(AFF[(size_t)(base + tid * npt + i) * NE + e]) : 0u;
                    __syncthreads();
                    unsigned T = 0u;
                    { const unsigned cand = 1u << 30; int c = 0;
#pragma unroll
                      for (int i = 0; i < S / NTHREADS; ++i) c += (key[i] >= cand) ? 1 : 0;
                      if (block_sum(c, tid, sh, 0) >= cap) T = cand; }
                    __syncthreads();
                    for (int bit = 28; bit >= 0; bit -= 2) {
                        const unsigned c1 = T | (1u << bit), c2 = T | (2u << bit), c3 = T | (3u << bit); int n12 = 0, n3 = 0;
#pragma unroll
                        for (int i = 0; i < S / NTHREADS; ++i) { n12 += ((key[i] >= c1) ? 1 : 0) + ((key[i] >= c2) ? 65536 : 0); n3 += (key[i] >= c3) ? 1 : 0; }
                        int t12, t3; block_sum2(n12, n3, tid, (int*)lds_raw + 64, (bit >> 1) & 1, t12, t3);
                        T = t3 >= cap ? c3 : ((t12 >> 16) >= cap ? c2 : ((t12 & 0xffff) >= cap ? c1 : T));
                    }
                    __syncthreads();
                    int cg = 0, ct = 0;
#pragma unroll
                    for (int i = 0; i < S / NTHREADS; ++i) { cg += (key[i] > T) ? 1 : 0; ct += (key[i] == T && key[i] != 0u) ? 1 : 0; }
                    int tot_g, tot_t;
                    (void)block_excl_scan(cg, tid, sh, tot_g);
                    int tie_rank = block_excl_scan(ct, tid, sh, tot_t);
                    const int need = cap - tot_g;
                    int sel[S / NTHREADS], cs = 0;
#pragma unroll
                    for (int i = 0; i < S / NTHREADS; ++i) { const bool tie = key[i] == T && key[i] != 0u; sel[i] = (key[i] > T || (tie && tie_rank < need)) ? 1 : 0; tie_rank += tie ? 1 : 0; cs += sel[i]; }
                    int tot_s; int slot = block_excl_scan(cs, tid, sh, tot_s);
#pragma unroll
                    for (int i = 0; i < S / NTHREADS; ++i) if (act && i < npt) {
                        const int row = base + tid * npt + i; int sa = -1;
                        if (sel[i]) { sa = (lat ? b * CAP_L : NB * CAP_L + b * CAP_C) + slot; ++slot; SELIDX[e * ER_MAX + sa] = row; SELGATE[e * ER_MAX + sa] = __uint_as_float(key[i]); }
                        TOKSLOT[(size_t)row * NE + e] = sa;
                    }
                }
            }
            GSYNC();
        }
        {
            PHASE_BEGIN();
            pg8::Gemm g{HB, WGU_T, NE * ER, 2 * FF, D, ER / 256, (size_t)2 * FF * D * 2, SELIDX, ER_MAX, (unsigned)(NTOK - 1)}; pg8::StaticOrder so; so.init(NE * ER, 2 * FF, G, bid);
            pg8::EpiSwiGLU E{HID, FF};
            pg8::gemm_phase<pg8::EpiSwiGLU, pg8::StaticOrder, true, true, true>(ldsb, g, so, E, tid);
            GSYNC();
        }
        {
            PHASE_BEGIN();
            pg8::Gemm g{HID, WD_T, NE * ER, D, FF, ER / 256, (size_t)D * FF * 2}; pg8::StaticOrder so; so.init(NE * ER, D, G, bid);
            pg8::EpiRowScaleBf16 E{Y, D, SELGATE, ER};
            pg8::gemm_phase<pg8::EpiRowScaleBf16, pg8::StaticOrder, true, true>(ldsb, g, so, E, tid);
            GSYNC();
        }
        {
            PHASE_BEGIN();
            const float* wpost = kp_->in[I_NFPOST] + l * D;
            const int lane = tid & 63;
            {
                float4 xq[4]; int slq = -1;
                { const float zf_ = (float)(tid >> 20);
#pragma unroll
                  for (int i = 0; i < 4; ++i) xq[i] = make_float4(zf_, zf_, zf_, zf_); }
                float4* aux = (float4*)lds_raw;
                const bool fuse1 = (l + 1 < DEPTH) && idle_sel;
                __syncthreads();
                for (int i = tid; i < (fuse1 ? 17 : 6) * (D / 4); i += NTHREADS) { const int v = i / (D / 4), k4 = i % (D / 4);
                    const float* modn = MOD + (size_t)(l + 1) * (NB + 1) * NMOD * D;
                    const float* src = v == 0 ? wpost : v < 6 ? modl + (size_t)(v - 1) * NMOD * D + 5 * D : v == 6 ? kp_->in[I_NMPRE] + (size_t)(l + 1) * D : modn + (size_t)((v - 7) % 5) * NMOD * D + ((v - 7) / 5) * D;
                    aux[i] = ((const float4*)src)[k4]; }
                __syncthreads();
                const int wstride = gridDim.x * 8; int r = blockIdx.x * 8 + (tid >> 6);
#define P11_LOAD(rr) do { const uint2* xin_ = (const uint2*)(XRB + (size_t)(rr) * D); slq = lane < NE ? TOKSLOT[(size_t)(rr) * NE + lane] : -1; \
                    _Pragma("unroll") for (int i = 0; i < 4; ++i) { const uint2 u_ = xin_[i * 64 + lane]; xq[i].x = __uint_as_float(u_.x); xq[i].y = __uint_as_float(u_.y); } } while (0)
                if (r < nrows_out) P11_LOAD(r);
                for (; r < nrows_out; r += wstride) {
                    const int bsel = r < NLAT ? r / S : NB;
                    const int myslot = slq; float4 xv[4], f[4];
#pragma unroll
                    for (int i = 0; i < 4; ++i) { xv[i] = XRAW(xq[i]); f[i] = make_float4(0.f, 0.f, 0.f, 0.f); }
                    {
                        unsigned msk = (unsigned)__ballot(myslot >= 0) & 0xffffu;
                        const bf16_t* zrow = (const bf16_t*)(kp_->ws + WS_CTL + 32768);
                        const bf16_t* yp[4];
#pragma unroll
                        for (int q = 0; q < 4; ++q) { yp[q] = zrow;
                            if (msk) { const int e = __builtin_ctz(msk); msk &= msk - 1; const int sl = __builtin_amdgcn_readlane(myslot, e); yp[q] = Y + ((size_t)e * ER + sl) * D; } }
                        uint2 yv[4][4];
#pragma unroll
                        for (int q = 0; q < 4; ++q)
#pragma unroll
                            for (int i = 0; i < 4; ++i) yv[q][i] = *(const uint2*)(yp[q] + (i * 64 + lane) * 4);
#pragma unroll
                        for (int q = 0; q < 4; ++q)
#pragma unroll
                            for (int i = 0; i < 4; ++i) f[i] = f4add(f[i], up4(yv[q][i]));
                        while (msk) { const int e = __builtin_ctz(msk); msk &= msk - 1; const int sl = __builtin_amdgcn_readlane(myslot, e); const bf16_t* ypx = Y + ((size_t)e * ER + sl) * D;
#pragma unroll
                            for (int i = 0; i < 4; ++i) f[i] = f4add(f[i], ld4h(ypx + (i * 64 + lane) * 4)); }
                    }
                    if (r + wstride < nrows_out) P11_LOAD(r + wstride);
                    float ss = 0.f;
#pragma unroll
                    for (int i = 0; i < 4; ++i) ss += f4dot(f[i], f[i]);
                    ss = wave_sum(ss);
                    const float rs = 1.0f / sqrtf(ss / D + EPS);
                    float4 xo4[4]; float sn = 0.f;
#pragma unroll
                    for (int i = 0; i < 4; ++i) { const int k4 = i * 64 + lane; const float4 xo = f4add(xv[i], f4mul(aux[(1 + bsel) * (D / 4) + k4], f4scale(f4mul(f[i], aux[k4]), rs))); xo4[i] = xo; sn += f4dot(xo, xo);
                        if (l == DEPTH - 1) ((float4*)(xcur + (size_t)r * D))[k4] = xo;
                        else ((uint2*)(XRB + (size_t)r * D))[k4] = pk4(xo); }
                    if (fuse1) {
                        sn = wave_sum(sn); const float rn = 1.0f / sqrtf(sn / D + EPS);
#pragma unroll
                        for (int i = 0; i < 4; ++i) { const int k4 = i * 64 + lane; const float4 w4 = aux[6 * (D / 4) + k4], sc = aux[(12 + bsel) * (D / 4) + k4], sh = aux[(7 + bsel) * (D / 4) + k4]; const float4 v = xo4[i];
                            const float4 o = make_float4(v.x * rn * w4.x * (1.0f + sc.x) + sh.x, v.y * rn * w4.y * (1.0f + sc.y) + sh.y, v.z * rn * w4.z * (1.0f + sc.z) + sh.z, v.w * rn * w4.w * (1.0f + sc.w) + sh.w);
                            *(uint2*)(HB + (size_t)r * D + k4 * 4) = pk4(o); } }
                }
#undef P11_LOAD
            }
            GSYNC();
        }
    }
}

extern "C" void kernel_launch(void* const* d_in, const int* in_sizes, int n_in, void* d_out, int out_size, void* d_ws, size_t ws_size, hipStream_t stream) {
    static int grid = 0;
    if (grid == 0) {
        if (n_in != N_IN || out_size != NLAT * D || ws_size < WS_END) { fprintf(stderr, "kernel_launch: unexpected shapes: n_in %d out %d ws %zu (need %zu)\n", n_in, out_size, ws_size, (size_t)WS_END); grid = -1; return; }
        int dev = 0, cus = 0, per_cu = 0;
        (void)hipGetDevice(&dev);
        (void)hipDeviceGetAttribute(&cus, hipDeviceAttributeMultiprocessorCount, dev);
        (void)hipFuncSetAttribute((const void*)mk_forward, hipFuncAttributeMaxDynamicSharedMemorySize, LDS_BYTES);
        (void)hipOccupancyMaxActiveBlocksPerMultiprocessor(&per_cu, (const void*)mk_forward, NTHREADS, LDS_BYTES);
        (void)hipGetLastError();
        if (per_cu < 1) { fprintf(stderr, "kernel_launch: occupancy query says %d blocks/CU\n", per_cu); grid = -1; return; }
        grid = cus;
    }
    if (grid < 0) return;
    (void)hipMemsetAsync((char*)d_ws + WS_CTL, 0, CTL_BYTES, stream);
    Prm p{};
    for (int i = 0; i < N_IN; ++i) p.in[i] = (const float*)d_in[i];
    p.out = (float*)d_out; p.ws = (char*)d_ws;
    void* args[] = {&p};
    hipError_t e = hipLaunchCooperativeKernel((const void*)mk_forward, dim3(grid), dim3(NTHREADS), args, LDS_BYTES, stream);
    if (e != hipSuccess) fprintf(stderr, "kernel_launch: cooperative launch failed: %s (grid %d)\n", hipGetErrorString(e), grid);
}
```
